# Optimizing an MI355X kernel written in HIP

```python
import math
import jax, jax.numpy as jnp
from jax import lax
import numpy as np

D_MODEL = 1024
BATCH = 8
SEQ = 2048
DEPTH = 1
DEC_BATCH = 128
DEC_SEQ = 8
PAST_LEN = 16384
PAGE_SIZE = 128

MIX_WIDTH = D_MODEL
S5_WIDTH = MIX_WIDTH // 2
S5_GROUP = 16
S5_GROUPS = S5_WIDTH // S5_GROUP
S5_STATE = 64
HG_WIDTH = MIX_WIDTH - S5_WIDTH
HG_HEAD_DIM = 128
HG_HEADS = HG_WIDTH // HG_HEAD_DIM
HG_CHUNK = 64
IN_COLS = S5_WIDTH + 4 * HG_WIDTH
D_FF = ((-(-8 * D_MODEL // 3) + 255) // 256) * 256
EPS = 1e-6
DT_MIN = 1e-3
DT_MAX = 1e-1

kernel_name = "hymba_s5_hgrn2_decode_step"


def rmsnorm(x, g):
    xf = x.astype(jnp.float32)
    r = xf * lax.rsqrt(jnp.mean(xf * xf, axis=-1, keepdims=True) + EPS)
    return (r * g.astype(jnp.float32)).astype(x.dtype)


def s5_discretize(a_re, a_im, log_dt, b_re, b_im):
    f32 = jnp.float32
    a_re = a_re.astype(f32); a_im = a_im.astype(f32)
    dt = jnp.exp(log_dt.astype(f32))[:, None]
    mag = jnp.exp(a_re * dt)
    ab_re = mag * jnp.cos(a_im * dt)
    ab_im = mag * jnp.sin(a_im * dt)
    den = a_re * a_re + a_im * a_im
    nr = ab_re - 1.0
    ni = ab_im
    f_re = (nr * a_re + ni * a_im) / den
    f_im = (ni * a_re - nr * a_im) / den
    b_re = b_re.astype(f32); b_im = b_im.astype(f32)
    bb_re = f_re[..., None] * b_re - f_im[..., None] * b_im
    bb_im = f_re[..., None] * b_im + f_im[..., None] * b_re
    return ab_re, ab_im, bb_re, bb_im


def s5_combine(e1, e2):
    a1r, a1i, b1r, b1i = e1
    a2r, a2i, b2r, b2i = e2
    return (a2r * a1r - a2i * a1i,
            a2r * a1i + a2i * a1r,
            a2r * b1r - a2i * b1i + b2r,
            a2r * b1i + a2i * b1r + b2i)


def s5_mixer(u, h0_re, h0_im, a_re, a_im, log_dt, b_re, b_im, c_re, c_im, d_skip, w_glu):
    f32 = jnp.float32
    B_, T, _ = u.shape
    ab_re, ab_im, bb_re, bb_im = s5_discretize(a_re, a_im, log_dt, b_re, b_im)
    uf = u.astype(f32)
    ug = uf.reshape(B_, T, S5_GROUPS, S5_GROUP)
    bu_re = jnp.einsum('btgc,gnc->btgn', ug, bb_re)
    bu_im = jnp.einsum('btgc,gnc->btgn', ug, bb_im)
    h0_re = h0_re.astype(f32); h0_im = h0_im.astype(f32)
    bu_re = bu_re.at[:, 0].add(ab_re * h0_re - ab_im * h0_im)
    bu_im = bu_im.at[:, 0].add(ab_re * h0_im + ab_im * h0_re)
    a_r = jnp.broadcast_to(ab_re, bu_re.shape)
    a_i = jnp.broadcast_to(ab_im, bu_im.shape)
    _, _, h_re, h_im = lax.associative_scan(s5_combine, (a_r, a_i, bu_re, bu_im), axis=1)
    y = (jnp.einsum('btgn,gcn->btgc', h_re, c_re.astype(f32))
         - jnp.einsum('btgn,gcn->btgc', h_im, c_im.astype(f32)))
    y = y.reshape(B_, T, S5_WIDTH) + d_skip.astype(f32) * uf
    g = jax.nn.gelu(y)
    out = g * jax.nn.sigmoid(g @ w_glu.astype(f32))
    return out.astype(u.dtype), h_re[:, -1], h_im[:, -1]


def hgrn2_mixer(q, fz, iv, og, lb, s0, g_norm):
    f32 = jnp.float32
    B_, T, _ = q.shape
    f = lb + (1.0 - lb) * jax.nn.sigmoid(fz.astype(f32))
    log_f = jnp.log(f)
    k = 1.0 - f
    chunk = math.gcd(HG_CHUNK, T)
    n_chunks = T // chunk

    def to_chunks(t):
        t = t.astype(f32).reshape(B_, n_chunks, chunk, HG_HEADS, HG_HEAD_DIM)
        return t.transpose(1, 0, 3, 2, 4)

    qc, kc, vc, lc = (to_chunks(t) for t in (q, k, iv, log_f))
    causal = jnp.tril(jnp.ones((chunk, chunk), dtype=bool))[:, :, None]

    def step(S, xs):
        qb, kb, vb, lfb = xs
        G = jnp.cumsum(lfb, axis=-2)
        diff = G[..., :, None, :] - G[..., None, :, :]
        decay = jnp.where(causal, jnp.exp(jnp.where(causal, diff, 0.0)), 0.0)
        att = jnp.einsum('bhtk,bhsk,bhtsk->bhts', qb, kb, decay)
        o = (jnp.einsum('bhts,bhsv->bhtv', att, vb)
             + jnp.einsum('bhtk,bhkv->bhtv', qb * jnp.exp(G), S))
        g_last = G[..., -1:, :]
        S_new = (jnp.exp(g_last[..., 0, :])[..., None] * S
                 + jnp.einsum('bhsk,bhsv->bhkv', kb * jnp.exp(g_last - G), vb))
        return S_new, o

    S_last, o = lax.scan(step, s0.astype(f32), (qc, kc, vc, lc))
    o = o.transpose(1, 0, 3, 2, 4).reshape(B_, T, HG_HEADS, HG_HEAD_DIM)
    o = o * lax.rsqrt(jnp.mean(o * o, axis=-1, keepdims=True) + EPS) * g_norm.astype(f32)
    gate = jax.nn.silu(og.astype(f32)).reshape(B_, T, HG_HEADS, HG_HEAD_DIM)
    o = (o * gate).reshape(B_, T, HG_WIDTH)
    return o.astype(q.dtype), S_last


def trunk(x, st_re, st_im, st_hg, lb_param, norm_mix, w_in, s5_a_re, s5_a_im, s5_log_dt,
          s5_b_re, s5_b_im, s5_c_re, s5_c_im, s5_d, s5_w_glu, hg_norm, w_out,
          norm_ffn, w_gate, w_up, w_down, norm_final):
    lb_all = jnp.cumsum(jax.nn.softmax(lb_param.astype(jnp.float32), axis=0), axis=0)
    new_re, new_im, new_hg = [], [], []
    for l in range(DEPTH):
        h = rmsnorm(x, norm_mix[l])
        proj = h @ w_in[l]
        u = proj[..., :S5_WIDTH]
        q = proj[..., S5_WIDTH:S5_WIDTH + HG_WIDTH]
        fz = proj[..., S5_WIDTH + HG_WIDTH:S5_WIDTH + 2 * HG_WIDTH]
        iv = proj[..., S5_WIDTH + 2 * HG_WIDTH:S5_WIDTH + 3 * HG_WIDTH]
        og = proj[..., S5_WIDTH + 3 * HG_WIDTH:]
        y5, h_re, h_im = s5_mixer(u, st_re[l], st_im[l], s5_a_re[l], s5_a_im[l], s5_log_dt[l],
                                  s5_b_re[l], s5_b_im[l], s5_c_re[l], s5_c_im[l], s5_d[l], s5_w_glu[l])
        yh, S_hg = hgrn2_mixer(q, fz, iv, og, lb_all[l], st_hg[l], hg_norm[l])
        x = x + jnp.concatenate([y5, yh], axis=-1) @ w_out[l]
        h2 = rmsnorm(x, norm_ffn[l])
        x = x + (jax.nn.silu(h2 @ w_gate[l]) * (h2 @ w_up[l])) @ w_down[l]
        new_re.append(h_re); new_im.append(h_im); new_hg.append(S_hg)
    y = rmsnorm(x, norm_final)
    return y, jnp.stack(new_re), jnp.stack(new_im), jnp.stack(new_hg)


def setup_inputs(seed: int = 0) -> dict:
    key = jax.random.key(seed)
    ks = jax.random.split(key, 32)
    f32 = jnp.float32
    nrm = lambda k, s, sc: jax.random.normal(k, s, f32) * sc
    n_idx = jnp.arange(S5_STATE, dtype=f32)
    a_re = -0.5 * jnp.exp(nrm(ks[5], (DEPTH, S5_GROUPS, S5_STATE), 0.02))
    a_im = jnp.pi * n_idx + nrm(ks[6], (DEPTH, S5_GROUPS, S5_STATE), 0.01)
    log_dt = jax.random.uniform(ks[7], (DEPTH, S5_GROUPS), f32, math.log(DT_MIN), math.log(DT_MAX))
    return {
        "x_prompt": nrm(ks[0], (BATCH, SEQ, D_MODEL), 1.0),
        "x_sample": nrm(ks[1], (DEC_BATCH, DEC_SEQ, D_MODEL), 1.0),
        "state_s5_re": nrm(ks[2], (DEPTH, DEC_BATCH, S5_GROUPS, S5_STATE), 0.5),
        "state_s5_im": nrm(ks[3], (DEPTH, DEC_BATCH, S5_GROUPS, S5_STATE), 0.5),
        "state_hgrn": nrm(ks[4], (DEPTH, DEC_BATCH, HG_HEADS, HG_HEAD_DIM, HG_HEAD_DIM), 0.5),
        "lb_param": nrm(ks[8], (DEPTH + 1, HG_WIDTH), 0.5),
        "norm_mix": 1.0 + nrm(ks[9], (DEPTH, D_MODEL), 0.02),
        "w_in": nrm(ks[10], (DEPTH, D_MODEL, IN_COLS), D_MODEL ** -0.5),
        "s5_a_re": a_re,
        "s5_a_im": a_im,
        "s5_log_dt": log_dt,
        "s5_b_re": nrm(ks[11], (DEPTH, S5_GROUPS, S5_STATE, S5_GROUP), (2 * S5_GROUP) ** -0.5),
        "s5_b_im": nrm(ks[12], (DEPTH, S5_GROUPS, S5_STATE, S5_GROUP), (2 * S5_GROUP) ** -0.5),
        "s5_c_re": nrm(ks[13], (DEPTH, S5_GROUPS, S5_GROUP, S5_STATE), (2 * S5_STATE) ** -0.5),
        "s5_c_im": nrm(ks[14], (DEPTH, S5_GROUPS, S5_GROUP, S5_STATE), (2 * S5_STATE) ** -0.5),
        "s5_d": nrm(ks[15], (DEPTH, S5_WIDTH), 1.0),
        "s5_w_glu": nrm(ks[16], (DEPTH, S5_WIDTH, S5_WIDTH), S5_WIDTH ** -0.5),
        "hg_norm": 1.0 + nrm(ks[17], (DEPTH, HG_HEAD_DIM), 0.02),
        "w_out": nrm(ks[18], (DEPTH, MIX_WIDTH, D_MODEL), MIX_WIDTH ** -0.5),
        "norm_ffn": 1.0 + nrm(ks[19], (DEPTH, D_MODEL), 0.02),
        "w_gate": nrm(ks[20], (DEPTH, D_MODEL, D_FF), D_MODEL ** -0.5),
        "w_up": nrm(ks[21], (DEPTH, D_MODEL, D_FF), D_MODEL ** -0.5),
        "w_down": nrm(ks[22], (DEPTH, D_FF, D_MODEL), D_FF ** -0.5),
        "norm_final": 1.0 + nrm(ks[23], (D_MODEL,), 0.02),
    }


def reference(x_prompt, x_sample, state_s5_re, state_s5_im, state_hgrn, lb_param, norm_mix, w_in,
              s5_a_re, s5_a_im, s5_log_dt, s5_b_re, s5_b_im, s5_c_re, s5_c_im, s5_d, s5_w_glu,
              hg_norm, w_out, norm_ffn, w_gate, w_up, w_down, norm_final):
    f32 = jnp.float32
    bp = x_prompt.shape[0]
    zero_re = jnp.zeros((DEPTH, bp, S5_GROUPS, S5_STATE), f32)
    zero_hg = jnp.zeros((DEPTH, bp, HG_HEADS, HG_HEAD_DIM, HG_HEAD_DIM), f32)
    y_prompt, p_re, p_im, p_hg = trunk(
        x_prompt, zero_re, zero_re, zero_hg, lb_param, norm_mix, w_in, s5_a_re, s5_a_im, s5_log_dt,
        s5_b_re, s5_b_im, s5_c_re, s5_c_im, s5_d, s5_w_glu, hg_norm, w_out,
        norm_ffn, w_gate, w_up, w_down, norm_final)
    y_sample, s_re, s_im, s_hg = trunk(
        x_sample, state_s5_re, state_s5_im, state_hgrn, lb_param, norm_mix, w_in, s5_a_re, s5_a_im,
        s5_log_dt, s5_b_re, s5_b_im, s5_c_re, s5_c_im, s5_d, s5_w_glu, hg_norm, w_out,
        norm_ffn, w_gate, w_up, w_down, norm_final)
    return (y_prompt, y_sample, p_re, p_im, p_hg, s_re, s_im, s_hg)
```

```cpp
#include <hip/hip_runtime.h>
#include <hip/hip_cooperative_groups.h>
#include <cstdio>
#include <cstdint>
namespace cg = cooperative_groups;
#define MK_N_LAUNCHES 9
namespace pg8 {
#define PG8_LAS __attribute__((address_space(3)))
typedef unsigned short bf16_t;
typedef short bf16x8 __attribute__((ext_vector_type(8)));
typedef float f32x4 __attribute__((ext_vector_type(4)));
typedef unsigned u32x4 __attribute__((ext_vector_type(4)));
constexpr int BM = 256, BK = 64, HALF = 128, HTB = HALF * BK * 2  , STAGE_BYTES = 8 * HTB, NXCD = 8, WGM = 8;

__host__ __device__ __forceinline__ int lds_byte(int r, int c) { const int st = (r >> 4) * 2 + (c >> 5), rr = r & 15, cc = c & 31, ob = rr * 64 + cc * 2; return st * 1024 + (ob ^ (((ob >> 9) & 1) << 5)); }
__host__ __device__ __forceinline__ void stage_rc(int b, int& R, int& C) { const int st = b / 1024, sb = b % 1024, swz = sb ^ (((sb >> 9) & 1) << 5); R = (st >> 1) * 16 + swz / 64; C = (st & 1) * 32 + (swz % 64) / 2; }
__host__ __device__ __forceinline__ int perm32(int rho) { const int n = rho >> 4, i = rho & 15; return 8 * (i >> 2) + 4 * n + (i & 3); }

struct Unit { int pm, pn; };
struct Gemm { const bf16_t* A; const bf16_t* Bt; int M, N, K; };

struct StaticOrder {
    int nM, nN, nwg, G, c;
    __host__ __device__ void init(int M, int N, int G_, int c_) { nM = M / BM; nN = N / BM; nwg = nM * nN; G = G_; c = c_; }
    __host__ __device__ bool next(int i, Unit& u) const {
        const long L = (long)i * G + c; if (L >= nwg) return false;
        int wgid = (int)L; { const int q = nwg / NXCD, r = nwg % NXCD, xcd = wgid % NXCD, off = wgid / NXCD; wgid = (xcd < r ? xcd * (q + 1) : r * (q + 1) + (xcd - r) * q) + off; }
        const int nig = WGM * nN, gid = wgid / nig, fm = gid * WGM, gsz = (nM - fm) < WGM ? (nM - fm) : WGM;
        u.pm = fm + ((wgid % nig) % gsz); u.pn = (wgid % nig) / gsz; return true;
    }
    __device__ __forceinline__ void a_ready(const Unit&) const {}
    __device__ __forceinline__ void done(const Unit&) const {}
};

__device__ __forceinline__ unsigned cvt_pk_bf16(float lo, float hi) { unsigned r; asm volatile("v_cvt_pk_bf16_f32 %0, %1, %2" : "=v"(r) : "v"(lo), "v"(hi)); return r; }
template <class Epi, class Sched, bool ALIGN_EPI = false, bool SP2 = false>
__device__ __forceinline__ void gemm_phase(PG8_LAS unsigned char* lds, const Gemm g, const Sched& S, const Epi& E) {
    const int tid = threadIdx.x, wid = __builtin_amdgcn_readfirstlane(tid >> 6), lane = tid & 63, wr = wid >> 2, wc = wid & 3, fr = lane & 15, fq = lane >> 4;
    const int K = g.K, nt = K / BK;
    unsigned voffA[2], voffB[2];
#pragma unroll
    for (int i = 0; i < 2; ++i) { int R, C; stage_rc(tid * 16 + i * 8192, R, C); const int Rb = Epi::PERM ? ((R & ~31) + perm32(R & 31)) : R;
        voffA[i] = (unsigned)(R * K + C) * 2u; voffB[i] = (unsigned)(Rb * K + C) * 2u; }
    const size_t kstep = (size_t)(BK * 2);
    const size_t hstep = (size_t)HALF * K * 2;
    const size_t tstep = 2 * hstep;
    const unsigned ldsw = (unsigned)wid * 1024u;
    const int aoff = lds_byte(wr * 64 + fr, fq * 8), boff = lds_byte(wc * 32 + fr, fq * 8);
#define PG8_SA(b, h) (((b) * 2 + (h)) * HTB)
#define PG8_SB(b, h) ((4 + (b) * 2 + (h)) * HTB)
#define PG8_STAGE(bufoff, gbase, voff) do { _Pragma("unroll") for (int _i = 0; _i < 2; ++_i) \
        __builtin_amdgcn_global_load_lds((const unsigned*)((const char*)(gbase) + (voff)[_i]), (PG8_LAS unsigned*)(lds + (bufoff) + ldsw + _i * 8192), 16, 0, 0); } while (0)
#define PG8_LDA(dst, b, h) do { _Pragma("unroll") for (int m = 0; m < 4; ++m) _Pragma("unroll") for (int k = 0; k < 2; ++k) dst[m][k] = *(const PG8_LAS bf16x8*)(lds + PG8_SA(b, h) + aoff + m * 2048 + k * 1024); } while (0)
#define PG8_LDB(dst, b, h) do { _Pragma("unroll") for (int n = 0; n < 2; ++n) _Pragma("unroll") for (int k = 0; k < 2; ++k) dst[n][k] = *(const PG8_LAS bf16x8*)(lds + PG8_SB(b, h) + boff + n * 2048 + k * 1024); } while (0)
#define PG8_MMA(ai, bj, At, Bt) do { __builtin_amdgcn_s_setprio(1); _Pragma("unroll") for (int m = 0; m < 4; ++m) _Pragma("unroll") for (int n = 0; n < 2; ++n) _Pragma("unroll") for (int k = 0; k < 2; ++k) \
        acc[ai][bj][m][n] = __builtin_amdgcn_mfma_f32_16x16x32_bf16(Bt[n][k], At[m][k], acc[ai][bj][m][n], 0, 0, 0); __builtin_amdgcn_s_setprio(0); } while (0)
#define PG8_WAIT_V(n) asm volatile("s_waitcnt vmcnt(" #n ")" ::: "memory")
#define PG8_WAIT_L(n) asm volatile("s_waitcnt lgkmcnt(" #n ")" ::: "memory")
#define PG8_BAR __builtin_amdgcn_s_barrier()
#define PG8_SCHED __builtin_amdgcn_sched_barrier(0)
    Unit cur, nxt; int ui = 0;
    if (!S.next(0, cur)) return;
    f32x4 acc[2][2][4][2];
#pragma unroll
    for (int a = 0; a < 2; ++a)
#pragma unroll
        for (int b = 0; b < 2; ++b)
#pragma unroll
            for (int m = 0; m < 4; ++m)
#pragma unroll
                for (int n = 0; n < 2; ++n) acc[a][b][m][n] = (f32x4){0.f, 0.f, 0.f, 0.f};
    bf16x8 At[4][2], B0[2][2], B1[2][2];
    const char* cA = (const char*)g.A + (size_t)cur.pm * tstep; const char* cB = (const char*)g.Bt + (size_t)cur.pn * tstep;
    S.a_ready(cur);
    if constexpr (SP2) {
        PG8_STAGE(PG8_SB(0, 0), cB, voffB); PG8_STAGE(PG8_SB(0, 1), cB + hstep, voffB); PG8_STAGE(PG8_SA(0, 0), cA, voffA); PG8_STAGE(PG8_SA(0, 1), cA + hstep, voffA);
        if (wr == 1) PG8_BAR;
        PG8_WAIT_V(2); PG8_BAR;
        PG8_STAGE(PG8_SB(1, 0), cB + kstep, voffB); PG8_STAGE(PG8_SA(1, 0), cA + kstep, voffA); PG8_STAGE(PG8_SB(1, 1), cB + hstep + kstep, voffB);
        PG8_WAIT_V(6); PG8_BAR;
    } else {
        PG8_STAGE(PG8_SB(0, 0), cB, voffB); PG8_STAGE(PG8_SA(0, 0), cA, voffA); PG8_STAGE(PG8_SB(0, 1), cB + hstep, voffB); PG8_STAGE(PG8_SA(0, 1), cA + hstep, voffA);
        if (wr == 1) PG8_BAR;
        PG8_WAIT_V(4); PG8_BAR;
        PG8_STAGE(PG8_SB(1, 0), cB + kstep, voffB); PG8_STAGE(PG8_SA(1, 0), cA + kstep, voffA); PG8_STAGE(PG8_SB(1, 1), cB + hstep + kstep, voffB);
        PG8_WAIT_V(6); PG8_BAR;
    }
    for (;;) {
        const bool has_next = S.next(ui + 1, nxt);
        const char* nA = has_next ? (const char*)g.A + (size_t)nxt.pm * tstep : cA; const char* nB = has_next ? (const char*)g.Bt + (size_t)nxt.pn * tstep : cB;
        for (int t = 0; t < nt; t += 2) {
            const bool last = (t == nt - 2);
            const char* a1 = cA + (size_t)(t + 1) * kstep;
            const char* a2 = last ? nA : cA + (size_t)(t + 2) * kstep; const char* b2 = last ? nB : cB + (size_t)(t + 2) * kstep;
            const char* a3 = a2 + kstep; const char* b3 = b2 + kstep;
            if (last && has_next) S.a_ready(nxt);
            if constexpr (SP2) {
            PG8_LDB(B0, 0, 0); PG8_LDB(B1, 0, 1); PG8_SCHED; PG8_LDA(At, 0, 0); PG8_STAGE(PG8_SA(1, 1), a1 + hstep, voffA);
            PG8_WAIT_V(8); PG8_WAIT_L(0); PG8_BAR; PG8_MMA(0, 0, At, B0); PG8_MMA(0, 1, At, B1); PG8_BAR; PG8_SCHED;
            PG8_LDA(At, 0, 1); PG8_STAGE(PG8_SB(0, 0), b2, voffB); PG8_STAGE(PG8_SB(0, 1), b2 + hstep, voffB); PG8_STAGE(PG8_SA(0, 0), a2, voffA);
            PG8_WAIT_V(8); PG8_WAIT_L(0); PG8_BAR; PG8_MMA(1, 0, At, B0); PG8_MMA(1, 1, At, B1); PG8_BAR; PG8_SCHED;
            PG8_LDB(B0, 1, 0); PG8_LDB(B1, 1, 1); PG8_SCHED; PG8_LDA(At, 1, 0); PG8_STAGE(PG8_SA(0, 1), a2 + hstep, voffA);
            PG8_WAIT_V(8); PG8_WAIT_L(0); PG8_BAR; PG8_MMA(0, 0, At, B0); PG8_MMA(0, 1, At, B1); PG8_BAR; PG8_SCHED;
            PG8_LDA(At, 1, 1); PG8_STAGE(PG8_SB(1, 0), b3, voffB); PG8_STAGE(PG8_SB(1, 1), b3 + hstep, voffB); PG8_STAGE(PG8_SA(1, 0), a3, voffA);
            PG8_WAIT_V(8); PG8_WAIT_L(0); PG8_BAR; PG8_MMA(1, 0, At, B0); PG8_MMA(1, 1, At, B1); PG8_BAR; PG8_SCHED;
            } else {
            PG8_LDB(B0, 0, 0); PG8_SCHED; PG8_LDA(At, 0, 0); PG8_STAGE(PG8_SA(1, 1), a1 + hstep, voffA);
            PG8_WAIT_L(8); PG8_BAR; PG8_WAIT_L(0); PG8_MMA(0, 0, At, B0); PG8_BAR; PG8_SCHED;
            PG8_LDB(B1, 0, 1); PG8_STAGE(PG8_SB(0, 0), b2, voffB);
            PG8_BAR; PG8_WAIT_L(0); PG8_MMA(0, 1, At, B1); PG8_BAR;
            PG8_LDA(At, 0, 1); PG8_STAGE(PG8_SA(0, 0), a2, voffA);
            PG8_BAR; PG8_WAIT_L(0); PG8_MMA(1, 0, At, B0); PG8_BAR; PG8_SCHED;
            PG8_STAGE(PG8_SB(0, 1), b2 + hstep, voffB);
            PG8_WAIT_V(6); PG8_BAR; PG8_MMA(1, 1, At, B1); PG8_BAR;
            PG8_LDB(B0, 1, 0); PG8_SCHED; PG8_LDA(At, 1, 0); PG8_STAGE(PG8_SA(0, 1), a2 + hstep, voffA);
            PG8_WAIT_L(8); PG8_BAR; PG8_WAIT_L(0); PG8_MMA(0, 0, At, B0); PG8_BAR; PG8_SCHED;
            PG8_LDB(B1, 1, 1); PG8_STAGE(PG8_SB(1, 0), b3, voffB);
            PG8_BAR; PG8_WAIT_L(0); PG8_MMA(0, 1, At, B1); PG8_BAR;
            PG8_LDA(At, 1, 1); PG8_STAGE(PG8_SA(1, 0), a3, voffA);
            PG8_BAR; PG8_WAIT_L(0); PG8_MMA(1, 0, At, B0); PG8_BAR; PG8_SCHED;
            PG8_STAGE(PG8_SB(1, 1), b3 + hstep, voffB);
            PG8_WAIT_V(6); PG8_BAR; PG8_MMA(1, 1, At, B1); PG8_BAR;
            }
        }
        if constexpr (ALIGN_EPI) { if (wr == 0) PG8_BAR; }
        if constexpr (!Epi::AFTER_DRAIN) { E(acc, cur, wr, wc, fr, fq); S.done(cur); }
        if (!has_next) break;
#pragma unroll
        for (int a = 0; a < 2; ++a)
#pragma unroll
            for (int b = 0; b < 2; ++b)
#pragma unroll
                for (int m = 0; m < 4; ++m)
#pragma unroll
                    for (int n = 0; n < 2; ++n) acc[a][b][m][n] = (f32x4){0.f, 0.f, 0.f, 0.f};
        cur = nxt; cA = nA; cB = nB; ++ui;
        if constexpr (ALIGN_EPI) { if (wr == 1) PG8_BAR; }
    }
    PG8_WAIT_V(0);
    if constexpr (!ALIGN_EPI) { if (wr == 0) PG8_BAR; }
    PG8_BAR;
    if constexpr (Epi::AFTER_DRAIN) { E.fused(acc, cur, wr, wc, fr, fq, lds, wid, lane); S.done(cur); }
#undef PG8_SA
#undef PG8_SB
#undef PG8_STAGE
#undef PG8_LDA
#undef PG8_LDB
#undef PG8_MMA
#undef PG8_WAIT_V
#undef PG8_WAIT_L
#undef PG8_BAR
#undef PG8_SCHED
}
}

#ifndef MK_N_LAUNCHES
#define MK_N_LAUNCHES 1
#endif
constexpr int DM = 1024, PB_B = 8, PB_T = 2048, SB_B = 128, SB_T = 8;
constexpr int MP = PB_B * PB_T, MS = SB_B * SB_T, MTOK = MP + MS;
constexpr int S5W = 512, S5G = 32, S5C = 16, S5N = 64;
constexpr int HGW = 512, HD = 128, HH = 4;
constexpr int INC = 2560, DFF = 2816;
constexpr float EPS = 1e-6f;
constexpr int NPH = 9;
constexpr size_t O_Y = 0, O_PRE = (size_t)MTOK * DM, O_PIM = O_PRE + 16384, O_PHG = O_PIM + 16384, O_SRE = O_PHG + 524288, O_SIM = O_SRE + 262144, O_SHG = O_SIM + 262144;
constexpr size_t MiB = 1u << 20;
constexpr size_t WS_CTL = 0, WS_WIN = 2 * MiB, WS_WGLU = 7 * MiB, WS_WOUT = 8 * MiB, WS_WGU = 10 * MiB, WS_WD = 21 * MiB;
constexpr size_t WS_XN = 27 * MiB, WS_PB = 61 * MiB, WS_FZ = 129 * MiB, WS_ACT = 61 * MiB, WS_GY = 163 * MiB, WS_OH = 180 * MiB, WS_MIX = 197 * MiB, WS_END = 231 * MiB;
constexpr int PBW = 2048;
constexpr int LDS_BYTES = 147456;
constexpr int NWAVES = 8;

#define GAS __attribute__((address_space(1)))
#define LAS __attribute__((address_space(3)))
typedef unsigned short bf16;
typedef unsigned v4u __attribute__((ext_vector_type(4)));
typedef unsigned v2u __attribute__((ext_vector_type(2)));
typedef float f32x4 __attribute__((ext_vector_type(4)));
#define LDS_WAIT() asm volatile("s_waitcnt lgkmcnt(0)" ::: "memory")
__device__ __forceinline__ unsigned f2bf(float f) { unsigned u = __builtin_bit_cast(unsigned, f); return (u + 0x7fffu + ((u >> 16) & 1u)) >> 16; }
__device__ __forceinline__ unsigned pk2(float lo, float hi) { return f2bf(lo) | (f2bf(hi) << 16); }
__device__ __forceinline__ float bf2f(unsigned short h) { return __builtin_bit_cast(float, (unsigned)h << 16); }
__device__ __forceinline__ float bflo(unsigned w) { return __builtin_bit_cast(float, w << 16); }
__device__ __forceinline__ float bfhi(unsigned w) { return __builtin_bit_cast(float, w & 0xffff0000u); }
__device__ __forceinline__ float sigmoidf_(float x) { return 1.0f / (1.0f + __expf(-x)); }
__device__ __forceinline__ float siluf_(float x) { return x / (1.0f + __expf(-x)); }
__device__ __forceinline__ float gelu_tanh(float x) { const float z = 1.5957691216057308f * (x + 0.044715f * x * x * x); return x / (1.0f + __expf(-z)); }
__device__ __forceinline__ float wave_sum(float v) {
#pragma unroll
    for (int o = 1; o < 64; o <<= 1) v += __shfl_xor(v, o);
    return v;
}

struct Args { const float* in[24]; float* out; unsigned char* ws; int ph_lo, ph_hi; };

struct Frame {
    LAS unsigned char* lds;
    int tid, lane, wave, G, bid;
    const float* in[24];
    float* out; unsigned char* ws;
};
__device__ __forceinline__ const float* xrow(const Frame& F, int m) { return m < MP ? F.in[0] + (size_t)m * DM : F.in[1] + (size_t)(m - MP) * DM; }

__device__ __forceinline__ void transpose_item(const float* W, int ldw, bf16* WT, int K, int k0, int sn0, int dn0, LAS float* scr, int lane) {
#pragma unroll 8
    for (int i = 0; i < 32; ++i) { const int kk = 2 * i + (lane >> 5); scr[kk * 33 + (lane & 31)] = W[(size_t)(k0 + kk) * ldw + sn0 + (lane & 31)]; }
    LDS_WAIT(); asm volatile("" ::: "memory");
    const int c = lane & 7;
#pragma unroll
    for (int j = 0; j < 4; ++j) { const int n = (lane >> 3) + 8 * j; const LAS float* s = scr + (8 * c) * 33 + n;
        v4u o; o.x = pk2(s[0 * 33], s[1 * 33]); o.y = pk2(s[2 * 33], s[3 * 33]); o.z = pk2(s[4 * 33], s[5 * 33]); o.w = pk2(s[6 * 33], s[7 * 33]);
        *(GAS v4u*)(WT + (size_t)(dn0 + n) * K + k0 + 8 * c) = o; }
    LDS_WAIT(); asm volatile("" ::: "memory");
}
__device__ __forceinline__ void rms_row_bf16(const float* xr_, const float* gain, bf16* orow, int lane) {
    const GAS f32x4* xr = (const GAS f32x4*)xr_ + lane;
    f32x4 v[4]; float s = 0.f;
#pragma unroll
    for (int j = 0; j < 4; ++j) { v[j] = xr[64 * j]; s += (v[j].x * v[j].x + v[j].y * v[j].y) + (v[j].z * v[j].z + v[j].w * v[j].w); }
    const float rstd = 1.0f / sqrtf(wave_sum(s) * (1.0f / DM) + EPS);
    GAS v2u* o8 = (GAS v2u*)orow + lane;
#pragma unroll
    for (int j = 0; j < 4; ++j) { const f32x4 g = ((const GAS f32x4*)gain)[lane + 64 * j]; v2u w; w.x = pk2(v[j].x * rstd * g.x, v[j].y * rstd * g.y); w.y = pk2(v[j].z * rstd * g.z, v[j].w * rstd * g.w); o8[64 * j] = w; }
}

__device__ __forceinline__ void p0_prologue(Frame& F) {
    LAS float* scr = (LAS float*)(F.lds + F.wave * 16384);
    const int gw = F.bid * NWAVES + F.wave, NGW = F.G * NWAVES;
    bf16* WinT = (bf16*)(F.ws + WS_WIN); bf16* WgluT = (bf16*)(F.ws + WS_WGLU); bf16* WoutT = (bf16*)(F.ws + WS_WOUT); bf16* WguT = (bf16*)(F.ws + WS_WGU); bf16* WdT = (bf16*)(F.ws + WS_WD);
    constexpr int I_IN = (DM / 64) * (INC / 32), I_GLU = (S5W / 64) * (S5W / 32), I_OUT = (DM / 64) * (DM / 32), I_G = (DM / 64) * (DFF / 32), I_D = (DFF / 64) * (DM / 32);
    constexpr int NITEMS = I_IN + I_GLU + I_OUT + 2 * I_G + I_D;
    for (int it = gw; it < NITEMS; it += NGW) {
        int r = it;
        if (r < I_IN) { const int nblk = INC / 32, kb = r / nblk, nb = r % nblk, sn0 = nb * 32; const int seg = sn0 / 512, off = sn0 % 512;
            const int dseg = seg == 0 ? 0 : seg == 1 ? 1 : seg == 2 ? 4 : seg == 3 ? 2 : 3;
            transpose_item(F.in[7], INC, WinT, DM, kb * 64, sn0, dseg * 512 + off, scr, F.lane); continue; } r -= I_IN;
        if (r < I_GLU) { const int nblk = S5W / 32, kb = r / nblk, nb = r % nblk; transpose_item(F.in[16], S5W, WgluT, S5W, kb * 64, nb * 32, nb * 32, scr, F.lane); continue; } r -= I_GLU;
        if (r < I_OUT) { const int nblk = DM / 32, kb = r / nblk, nb = r % nblk; transpose_item(F.in[18], DM, WoutT, DM, kb * 64, nb * 32, nb * 32, scr, F.lane); continue; } r -= I_OUT;
        if (r < I_G) { const int nblk = DFF / 32, kb = r / nblk, nb = r % nblk, sn0 = nb * 32; transpose_item(F.in[20], DFF, WguT, DM, kb * 64, sn0, 256 * (sn0 / 128) + (sn0 % 128), scr, F.lane); continue; } r -= I_G;
        if (r < I_G) { const int nblk = DFF / 32, kb = r / nblk, nb = r % nblk, sn0 = nb * 32; transpose_item(F.in[21], DFF, WguT, DM, kb * 64, sn0, 256 * (sn0 / 128) + 128 + (sn0 % 128), scr, F.lane); continue; } r -= I_G;
        { const int nblk = DM / 32, kb = r / nblk, nb = r % nblk; transpose_item(F.in[22], DM, WdT, DFF, kb * 64, nb * 32, nb * 32, scr, F.lane); }
    }
    bf16* XN = (bf16*)(F.ws + WS_XN);
    for (int m = gw; m < MTOK; m += NGW) rms_row_bf16(xrow(F, m), F.in[6], XN + (size_t)m * DM, F.lane);
}

using pg8::Unit; using pg8::u32x4; using pg8::cvt_pk_bf16; using pg8::BM; using pg8::HALF;
struct EpiIn {
    static constexpr bool PERM = true, AFTER_DRAIN = false;
    bf16* PB; float* FZ;
    __device__ __forceinline__ void operator()(const pg8::f32x4 (&acc)[2][2][4][2], const Unit& u, int wr, int wc, int fr, int fq) const {
        const int row0 = u.pm * BM + wr * 64 + fr;
        if (u.pn < 8) { const int col0 = u.pn * BM + wc * 32 + 8 * fq;
#pragma unroll
            for (int ai = 0; ai < 2; ++ai)
#pragma unroll
                for (int m = 0; m < 4; ++m) { bf16* rowp = PB + (size_t)(row0 + ai * HALF + m * 16) * PBW + col0;
#pragma unroll
                    for (int bj = 0; bj < 2; ++bj) { const pg8::f32x4 v0 = acc[ai][bj][m][0], v1 = acc[ai][bj][m][1]; u32x4 w; w.x = cvt_pk_bf16(v0[0], v0[1]); w.y = cvt_pk_bf16(v0[2], v0[3]); w.z = cvt_pk_bf16(v1[0], v1[1]); w.w = cvt_pk_bf16(v1[2], v1[3]);
                        *(u32x4*)(rowp + bj * HALF) = w; } }
        } else { const int col0 = (u.pn - 8) * BM + wc * 32 + 8 * fq;
#pragma unroll
            for (int ai = 0; ai < 2; ++ai)
#pragma unroll
                for (int m = 0; m < 4; ++m) { float* rowp = FZ + (size_t)(row0 + ai * HALF + m * 16) * 512 + col0;
#pragma unroll
                    for (int bj = 0; bj < 2; ++bj)
#pragma unroll
                        for (int n = 0; n < 2; ++n) *(pg8::f32x4*)(rowp + bj * HALF + 4 * n) = acc[ai][bj][m][n]; }
        }
    }
};
struct EpiGlu {
    static constexpr bool PERM = true, AFTER_DRAIN = false;
    const bf16* GY; bf16* MIX;
    __device__ __forceinline__ void operator()(const pg8::f32x4 (&acc)[2][2][4][2], const Unit& u, int wr, int wc, int fr, int fq) const {
        const int row0 = u.pm * BM + wr * 64 + fr, col0 = u.pn * BM + wc * 32 + 8 * fq;
#pragma unroll
        for (int ai = 0; ai < 2; ++ai)
#pragma unroll
            for (int m = 0; m < 4; ++m) { const size_t r = (size_t)(row0 + ai * HALF + m * 16);
#pragma unroll
                for (int bj = 0; bj < 2; ++bj) { const u32x4 g = *(const u32x4*)(GY + r * 512 + col0 + bj * HALF); const pg8::f32x4 v0 = acc[ai][bj][m][0], v1 = acc[ai][bj][m][1];
                    u32x4 w; w.x = cvt_pk_bf16(bflo(g.x) * sigmoidf_(v0[0]), bfhi(g.x) * sigmoidf_(v0[1])); w.y = cvt_pk_bf16(bflo(g.y) * sigmoidf_(v0[2]), bfhi(g.y) * sigmoidf_(v0[3]));
                    w.z = cvt_pk_bf16(bflo(g.z) * sigmoidf_(v1[0]), bfhi(g.z) * sigmoidf_(v1[1])); w.w = cvt_pk_bf16(bflo(g.w) * sigmoidf_(v1[2]), bfhi(g.w) * sigmoidf_(v1[3]));
                    *(u32x4*)(MIX + r * DM + col0 + bj * HALF) = w; } }
    }
};
struct EpiOut {
    static constexpr bool PERM = false, AFTER_DRAIN = false;
    const float* xp; const float* xs; float* Y;
    __device__ __forceinline__ void operator()(const pg8::f32x4 (&acc)[2][2][4][2], const Unit& u, int wr, int wc, int fr, int fq) const {
        const int row0 = u.pm * BM + wr * 64 + fr, col0 = u.pn * BM + wc * 32 + 4 * fq;
        const float* xb = (u.pm < MP / BM) ? xp : xs - (size_t)MP * DM;
#pragma unroll
        for (int ai = 0; ai < 2; ++ai)
#pragma unroll
            for (int m = 0; m < 4; ++m) { const size_t off = (size_t)(row0 + ai * HALF + m * 16) * DM + col0;
#pragma unroll
                for (int bj = 0; bj < 2; ++bj)
#pragma unroll
                    for (int n = 0; n < 2; ++n) { const pg8::f32x4 xv = *(const pg8::f32x4*)(xb + off + bj * HALF + n * 16); *(pg8::f32x4*)(Y + off + bj * HALF + n * 16) = xv + acc[ai][bj][m][n]; } }
    }
};
struct EpiAct {
    static constexpr bool PERM = true, AFTER_DRAIN = false;
    bf16* ACT;
    __device__ __forceinline__ void operator()(const pg8::f32x4 (&acc)[2][2][4][2], const Unit& u, int wr, int wc, int fr, int fq) const {
        const int row0 = u.pm * BM + wr * 64 + fr, col0 = u.pn * HALF + wc * 32 + 8 * fq;
#pragma unroll
        for (int ai = 0; ai < 2; ++ai)
#pragma unroll
            for (int m = 0; m < 4; ++m) { const pg8::f32x4 g0 = acc[ai][0][m][0], g1 = acc[ai][0][m][1], u0 = acc[ai][1][m][0], u1 = acc[ai][1][m][1];
                u32x4 w; w.x = cvt_pk_bf16(siluf_(g0[0]) * u0[0], siluf_(g0[1]) * u0[1]); w.y = cvt_pk_bf16(siluf_(g0[2]) * u0[2], siluf_(g0[3]) * u0[3]);
                w.z = cvt_pk_bf16(siluf_(g1[0]) * u1[0], siluf_(g1[1]) * u1[1]); w.w = cvt_pk_bf16(siluf_(g1[2]) * u1[2], siluf_(g1[3]) * u1[3]);
                *(u32x4*)(ACT + (size_t)(row0 + ai * HALF + m * 16) * DFF + col0) = w; }
    }
};
struct EpiDown {
    static constexpr bool PERM = false, AFTER_DRAIN = false;
    float* Y;
    __device__ __forceinline__ void operator()(const pg8::f32x4 (&acc)[2][2][4][2], const Unit& u, int wr, int wc, int fr, int fq) const {
        const int row0 = u.pm * BM + wr * 64 + fr, col0 = u.pn * BM + wc * 32 + 4 * fq;
#pragma unroll
        for (int ai = 0; ai < 2; ++ai)
#pragma unroll
            for (int m = 0; m < 4; ++m) { const size_t off = (size_t)(row0 + ai * HALF + m * 16) * DM + col0;
#pragma unroll
                for (int bj = 0; bj < 2; ++bj)
#pragma unroll
                    for (int n = 0; n < 2; ++n) { float* p = Y + off + bj * HALF + n * 16; const pg8::f32x4 xv = *(const pg8::f32x4*)p; *(pg8::f32x4*)p = xv + acc[ai][bj][m][n]; } }
    }
};

__device__ __forceinline__ void s5_simple_item(Frame& F, int item) {
    const int lane = F.lane, n = lane;
    int g, tokbase, T; const float* h0r = nullptr; const float* h0i = nullptr; float* outr; float* outi;
    if (item < PB_B * S5G) { const int b = item / S5G; g = item % S5G; tokbase = b * PB_T; T = PB_T; outr = F.out + O_PRE + (size_t)item * S5N; outi = F.out + O_PIM + (size_t)item * S5N; }
    else { const int idx = item - PB_B * S5G, b = idx / S5G; g = idx % S5G; tokbase = MP + b * SB_T; T = SB_T; h0r = F.in[2] + (size_t)idx * S5N; h0i = F.in[3] + (size_t)idx * S5N; outr = F.out + O_SRE + (size_t)idx * S5N; outi = F.out + O_SIM + (size_t)idx * S5N; }
    const float a_re = F.in[8][g * S5N + n], a_im = F.in[9][g * S5N + n], dt = expf(F.in[10][g]);
    const float mag = expf(a_re * dt), ab_re = mag * cosf(a_im * dt), ab_im = mag * sinf(a_im * dt);
    const float den = a_re * a_re + a_im * a_im, nr = ab_re - 1.0f, ni = ab_im;
    const float f_re = (nr * a_re + ni * a_im) / den, f_im = (ni * a_re - nr * a_im) / den;
    float Bre[16], Bim[16], Cre[16], Cim[16];
#pragma unroll
    for (int c = 0; c < 16; ++c) { const float br = F.in[11][(size_t)(g * S5N + n) * 16 + c], bi = F.in[12][(size_t)(g * S5N + n) * 16 + c];
        Bre[c] = f_re * br - f_im * bi; Bim[c] = f_re * bi + f_im * br;
        Cre[c] = F.in[13][(size_t)(g * 16 + c) * S5N + n]; Cim[c] = F.in[14][(size_t)(g * 16 + c) * S5N + n]; }
    const float dl = F.in[15][g * 16 + (lane & 15)];
    float h_re = h0r ? h0r[n] : 0.f, h_im = h0i ? h0i[n] : 0.f;
    const bf16* PB = (const bf16*)(F.ws + WS_PB); bf16* GY = (bf16*)(F.ws + WS_GY);
    for (int t = 0; t < T; ++t) {
        const float uv = bf2f(PB[(size_t)(tokbase + t) * PBW + g * 16 + (lane & 15)]);
        float bu_re = 0.f, bu_im = 0.f;
#pragma unroll
        for (int c = 0; c < 16; ++c) { const float uc = __shfl(uv, c); bu_re += Bre[c] * uc; bu_im += Bim[c] * uc; }
        const float nre = ab_re * h_re - ab_im * h_im + bu_re, nim = ab_re * h_im + ab_im * h_re + bu_im;
        h_re = nre; h_im = nim;
        float yv = 0.f;
#pragma unroll
        for (int c = 0; c < 16; ++c) { const float p = wave_sum(Cre[c] * h_re - Cim[c] * h_im); yv = ((lane & 15) == c) ? p : yv; }
        const float y = yv + dl * uv;
        if (lane < 16) GY[(size_t)(tokbase + t) * S5W + g * 16 + lane] = (bf16)f2bf(gelu_tanh(y));
    }
    outr[n] = h_re; outi[n] = h_im;
}
__device__ __forceinline__ void hgrn_simple_item(Frame& F, int item) {
    const int tid = F.tid, v = tid & 127, kq = tid >> 7;
    int h, tokbase, T; const float* S0 = nullptr; float* Sout;
    if (item < PB_B * HH) { const int b = item / HH; h = item % HH; tokbase = b * PB_T; T = PB_T; Sout = F.out + O_PHG + (size_t)item * HD * HD; }
    else { const int idx = item - PB_B * HH, b = idx / HH; h = idx % HH; tokbase = MP + b * SB_T; T = SB_T; S0 = F.in[4] + (size_t)idx * HD * HD; Sout = F.out + O_SHG + (size_t)idx * HD * HD; }
    float S[32];
#pragma unroll
    for (int j = 0; j < 32; ++j) S[j] = S0 ? S0[(size_t)(32 * kq + j) * HD + v] : 0.f;
    LAS float* Fs = (LAS float*)F.lds;
    LAS float* Ks = Fs + 1024;
    LAS float* Qs = Ks + 1024;
    LAS float* Vs = Qs + 1024;
    LAS float* OP = Vs + 1024;
    const bf16* PB = (const bf16*)(F.ws + WS_PB); const float* FZ = (const float*)(F.ws + WS_FZ); bf16* OH = (bf16*)(F.ws + WS_OH);
    float lb = 0.f;
    if (tid < 128) { const int col = h * HD + tid; lb = 1.0f / (1.0f + expf(F.in[5][512 + col] - F.in[5][col])); }
    for (int t0 = 0; t0 < T; t0 += 8) {
        if (tid < 128) {
#pragma unroll
            for (int tt = 0; tt < 8; ++tt) { const size_t tok = (size_t)(tokbase + t0 + tt); const float fz = FZ[tok * 512 + h * HD + tid];
                const float sg = 1.0f / (1.0f + expf(-fz)), f = lb + (1.0f - lb) * sg;
                Fs[tt * 128 + tid] = f; Ks[tt * 128 + tid] = 1.0f - f; Qs[tt * 128 + tid] = bf2f(PB[tok * PBW + 512 + h * HD + tid]); }
        } else if (tid < 256) { const int vv = tid - 128;
#pragma unroll
            for (int tt = 0; tt < 8; ++tt) Vs[tt * 128 + vv] = bf2f(PB[(size_t)(tokbase + t0 + tt) * PBW + 1024 + h * HD + vv]);
        }
        __syncthreads();
#pragma unroll 1
        for (int tt = 0; tt < 8; ++tt) { const float iv = Vs[tt * 128 + v]; float o = 0.f;
#pragma unroll
            for (int j = 0; j < 32; j += 4) { const f32x4 f4 = *(const LAS f32x4*)(Fs + tt * 128 + 32 * kq + j), k4 = *(const LAS f32x4*)(Ks + tt * 128 + 32 * kq + j), q4 = *(const LAS f32x4*)(Qs + tt * 128 + 32 * kq + j);
                S[j] = f4.x * S[j] + k4.x * iv; o += S[j] * q4.x; S[j + 1] = f4.y * S[j + 1] + k4.y * iv; o += S[j + 1] * q4.y;
                S[j + 2] = f4.z * S[j + 2] + k4.z * iv; o += S[j + 2] * q4.z; S[j + 3] = f4.w * S[j + 3] + k4.w * iv; o += S[j + 3] * q4.w; }
            OP[(tt * 4 + kq) * 128 + v] = o; }
        __syncthreads();
#pragma unroll
        for (int r = 0; r < 2; ++r) { const int idx = tid + 512 * r, tt = idx >> 7, vv = idx & 127;
            const float o = (OP[(tt * 4 + 0) * 128 + vv] + OP[(tt * 4 + 1) * 128 + vv]) + (OP[(tt * 4 + 2) * 128 + vv] + OP[(tt * 4 + 3) * 128 + vv]);
            OH[(size_t)(tokbase + t0 + tt) * HGW + h * HD + vv] = (bf16)f2bf(o); }
        __syncthreads();
    }
#pragma unroll
    for (int j = 0; j < 32; ++j) Sout[(size_t)(32 * kq + j) * HD + v] = S[j];
}

__device__ __forceinline__ void hg_normgate_row(Frame& F, int tok) {
    const int lane = F.lane;
    const bf16* OH = (const bf16*)(F.ws + WS_OH); const bf16* PB = (const bf16*)(F.ws + WS_PB); bf16* MIX = (bf16*)(F.ws + WS_MIX);
    const v4u o8 = *(const GAS v4u*)(OH + (size_t)tok * HGW + 8 * lane);
    const v4u g8 = *(const GAS v4u*)(PB + (size_t)tok * PBW + 1536 + 8 * lane);
    float o[8] = {bflo(o8.x), bfhi(o8.x), bflo(o8.y), bfhi(o8.y), bflo(o8.z), bfhi(o8.z), bflo(o8.w), bfhi(o8.w)};
    float gt[8] = {bflo(g8.x), bfhi(g8.x), bflo(g8.y), bfhi(g8.y), bflo(g8.z), bfhi(g8.z), bflo(g8.w), bfhi(g8.w)};
    float ss = 0.f;
#pragma unroll
    for (int j = 0; j < 8; ++j) ss += o[j] * o[j];
    ss += __shfl_xor(ss, 1); ss += __shfl_xor(ss, 2); ss += __shfl_xor(ss, 4); ss += __shfl_xor(ss, 8);
    const float rstd = 1.0f / sqrtf(ss * (1.0f / HD) + EPS);
    const f32x4 n0 = *(const GAS f32x4*)(F.in[17] + ((8 * lane) & 127)), n1 = *(const GAS f32x4*)(F.in[17] + ((8 * lane) & 127) + 4);
    const float gn[8] = {n0.x, n0.y, n0.z, n0.w, n1.x, n1.y, n1.z, n1.w};
    float r[8];
#pragma unroll
    for (int j = 0; j < 8; ++j) r[j] = o[j] * rstd * gn[j] * siluf_(gt[j]);
    v4u w; w.x = pk2(r[0], r[1]); w.y = pk2(r[2], r[3]); w.z = pk2(r[4], r[5]); w.w = pk2(r[6], r[7]);
    *(GAS v4u*)(MIX + (size_t)tok * DM + 512 + 8 * lane) = w;
}
__device__ __forceinline__ void final_norm_row(Frame& F, int m) {
    GAS f32x4* xr = (GAS f32x4*)(F.out + O_Y + (size_t)m * DM) + F.lane;
    f32x4 v[4]; float s = 0.f;
#pragma unroll
    for (int j = 0; j < 4; ++j) { v[j] = xr[64 * j]; s += (v[j].x * v[j].x + v[j].y * v[j].y) + (v[j].z * v[j].z + v[j].w * v[j].w); }
    const float rstd = 1.0f / sqrtf(wave_sum(s) * (1.0f / DM) + EPS);
#pragma unroll
    for (int j = 0; j < 4; ++j) { const f32x4 g = ((const GAS f32x4*)F.in[23])[F.lane + 64 * j]; f32x4 o; o.x = v[j].x * rstd * g.x; o.y = v[j].y * rstd * g.y; o.z = v[j].z * rstd * g.z; o.w = v[j].w * rstd * g.w; xr[64 * j] = o; }
}

__global__ void __launch_bounds__(NWAVES * 64, 2) mk_fwd(Args args) {
    extern __shared__ __attribute__((aligned(16))) unsigned char lds[];
    Frame F;
    F.lds = (LAS unsigned char*)lds;
    F.tid = threadIdx.x; F.lane = F.tid & 63; F.wave = __builtin_amdgcn_readfirstlane(F.tid >> 6);
    F.G = gridDim.x; F.bid = blockIdx.x;
#pragma unroll
    for (int i = 0; i < 24; ++i) F.in[i] = args.in[i];
    F.out = args.out; F.ws = args.ws;
    const int lo = args.ph_lo, hi = args.ph_hi;
#define IN(k) (lo <= (k) && (k) < hi)
#if MK_N_LAUNCHES == 1
    cg::grid_group grid = cg::this_grid();
#define SEAM(k) do { if (IN(k) && IN((k) + 1)) grid.sync(); } while (0)
#else
#define SEAM(k) do { } while (0)
#endif
    const int gw = F.bid * NWAVES + F.wave, NGW = F.G * NWAVES;
    bf16* XN = (bf16*)(F.ws + WS_XN); bf16* PB = (bf16*)(F.ws + WS_PB); float* FZ = (float*)(F.ws + WS_FZ); bf16* GY = (bf16*)(F.ws + WS_GY);
    bf16* MIX = (bf16*)(F.ws + WS_MIX); bf16* ACT = (bf16*)(F.ws + WS_ACT);

    if (IN(0)) { p0_prologue(F); } SEAM(0);
    if (IN(1)) {
        pg8::Gemm g{XN, (const bf16*)(F.ws + WS_WIN), MTOK, INC, DM}; pg8::StaticOrder S; S.init(MTOK, INC, F.G, F.bid);
        EpiIn E{PB, FZ};
        pg8::gemm_phase<EpiIn, pg8::StaticOrder, true, true>(F.lds, g, S, E);
    } SEAM(1);
    if (IN(2)) {
        for (int it = gw; it < PB_B * S5G + SB_B * S5G; it += NGW) s5_simple_item(F, it);
        __syncthreads();
        for (int it = F.bid; it < PB_B * HH + SB_B * HH; it += F.G) { hgrn_simple_item(F, it); __syncthreads(); }
    } SEAM(2);
    if (IN(3)) {
        pg8::Gemm g{GY, (const bf16*)(F.ws + WS_WGLU), MTOK, S5W, S5W}; pg8::StaticOrder S; S.init(MTOK, S5W, F.G, F.bid);
        EpiGlu E{GY, MIX};
        pg8::gemm_phase<EpiGlu, pg8::StaticOrder, true, true>(F.lds, g, S, E);
        for (int m = gw; m < MTOK; m += NGW) hg_normgate_row(F, m);
    } SEAM(3);
    if (IN(4)) {
        pg8::Gemm g{MIX, (const bf16*)(F.ws + WS_WOUT), MTOK, DM, DM}; pg8::StaticOrder S; S.init(MTOK, DM, F.G, F.bid);
        EpiOut E{F.in[0], F.in[1], F.out + O_Y};
        pg8::gemm_phase<EpiOut, pg8::StaticOrder, true, true>(F.lds, g, S, E);
    } SEAM(4);
    if (IN(5)) {
        for (int m = gw; m < MTOK; m += NGW) rms_row_bf16(F.out + O_Y + (size_t)m * DM, F.in[19], XN + (size_t)m * DM, F.lane);
    } SEAM(5);
    if (IN(6)) {
        pg8::Gemm g{XN, (const bf16*)(F.ws + WS_WGU), MTOK, 2 * DFF, DM}; pg8::StaticOrder S; S.init(MTOK, 2 * DFF, F.G, F.bid);
        EpiAct E{ACT};
        pg8::gemm_phase<EpiAct, pg8::StaticOrder, true, true>(F.lds, g, S, E);
    } SEAM(6);
    if (IN(7)) {
        pg8::Gemm g{ACT, (const bf16*)(F.ws + WS_WD), MTOK, DM, DFF}; pg8::StaticOrder S; S.init(MTOK, DM, F.G, F.bid);
        EpiDown E{F.out + O_Y};
        pg8::gemm_phase<EpiDown, pg8::StaticOrder, true, true>(F.lds, g, S, E);
    } SEAM(7);
    if (IN(8)) {
        for (int m = gw; m < MTOK; m += NGW) final_norm_row(F, m);
    }
#undef IN
#undef SEAM
}

extern "C" void kernel_launch(void* const* d_in, const int* in_sizes, int n_in, void* d_out, int out_size, void* d_ws, size_t ws_size, hipStream_t stream) {
    static int grid = 0;
    if (grid == 0) {
        if (n_in != 24 || ws_size < WS_END) { fprintf(stderr, "kernel_launch: unexpected n_in %d / ws %zu\n", n_in, ws_size); grid = -1; return; }
        int dev = 0, cus = 0, per_cu = 0;
        if (hipGetDevice(&dev) != hipSuccess || hipDeviceGetAttribute(&cus, hipDeviceAttributeMultiprocessorCount, dev) != hipSuccess) { grid = -1; return; }
        if (hipFuncSetAttribute((const void*)mk_fwd, hipFuncAttributeMaxDynamicSharedMemorySize, LDS_BYTES) != hipSuccess) { fprintf(stderr, "kernel_launch: hipFuncSetAttribute failed\n"); grid = -1; return; }
        if (hipOccupancyMaxActiveBlocksPerMultiprocessor(&per_cu, (const void*)mk_fwd, NWAVES * 64, LDS_BYTES) != hipSuccess || per_cu < 1) { fprintf(stderr, "kernel_launch: occupancy query says %d\n", per_cu); per_cu = 1; }
        (void)hipGetLastError();
        grid = cus;
    }
    if (grid < 0) return;
    Args a{};
    for (int i = 0; i < 24; ++i) a.in[i] = (const float*)d_in[i];
    a.out = (float*)d_out; a.ws = (unsigned char*)d_ws;
#if MK_N_LAUNCHES == 1
    a.ph_lo = 0; a.ph_hi = NPH;
    void* kargs[] = {&a};
    hipError_t e = hipLaunchCooperativeKernel((const void*)mk_fwd, dim3(grid), dim3(NWAVES * 64), kargs, LDS_BYTES, stream);
    if (e != hipSuccess) fprintf(stderr, "kernel_launch: cooperative launch failed: %s (grid %d)\n", hipGetErrorString(e), grid);
#else
    for (int p = 0; p < NPH; ++p) { a.ph_lo = p; a.ph_hi = p + 1; hipLaunchKernelGGL(mk_fwd, dim3(grid), dim3(NWAVES * 64), LDS_BYTES, stream, a); }
#endif
}
```

```cpp
#include <hip/hip_runtime.h>
#include <hip/hip_cooperative_groups.h>
#include <cstdio>
#include <cstdint>
namespace cg = cooperative_groups;
#define MK_N_LAUNCHES 1
namespace pg8 {
#define PG8_LAS __attribute__((address_space(3)))
typedef unsigned short bf16_t;
typedef short bf16x8 __attribute__((ext_vector_type(8)));
typedef float f32x4 __attribute__((ext_vector_type(4)));
typedef unsigned u32x4 __attribute__((ext_vector_type(4)));
constexpr int BM = 256, BK = 64, HALF = 128, HTB = HALF * BK * 2  , STAGE_BYTES = 8 * HTB, NXCD = 8, WGM = 8;

__host__ __device__ __forceinline__ int lds_byte(int r, int c) { const int st = (r >> 4) * 2 + (c >> 5), rr = r & 15, cc = c & 31, ob = rr * 64 + cc * 2; return st * 1024 + (ob ^ (((ob >> 9) & 1) << 5)); }
__host__ __device__ __forceinline__ void stage_rc(int b, int& R, int& C) { const int st = b / 1024, sb = b % 1024, swz = sb ^ (((sb >> 9) & 1) << 5); R = (st >> 1) * 16 + swz / 64; C = (st & 1) * 32 + (swz % 64) / 2; }
__host__ __device__ __forceinline__ int perm32(int rho) { const int n = rho >> 4, i = rho & 15; return 8 * (i >> 2) + 4 * n + (i & 3); }

struct Unit { int pm, pn; };
struct Gemm { const bf16_t* A; const bf16_t* Bt; int M, N, K; };

struct StaticOrder {
    int nM, nN, nwg, G, c;
    __host__ __device__ void init(int M, int N, int G_, int c_) { nM = M / BM; nN = N / BM; nwg = nM * nN; G = G_; c = c_; }
    __host__ __device__ bool next(int i, Unit& u) const {
        const long L = (long)i * G + c; if (L >= nwg) return false;
        int wgid = (int)L; { const int q = nwg / NXCD, r = nwg % NXCD, xcd = wgid % NXCD, off = wgid / NXCD; wgid = (xcd < r ? xcd * (q + 1) : r * (q + 1) + (xcd - r) * q) + off; }
        const int nig = WGM * nN, gid = wgid / nig, fm = gid * WGM, gsz = (nM - fm) < WGM ? (nM - fm) : WGM;
        u.pm = fm + ((wgid % nig) % gsz); u.pn = (wgid % nig) / gsz; return true;
    }
    __device__ __forceinline__ void a_ready(const Unit&) const {}
    __device__ __forceinline__ void done(const Unit&) const {}
};

__device__ __forceinline__ unsigned cvt_pk_bf16(float lo, float hi) { unsigned r; asm volatile("v_cvt_pk_bf16_f32 %0, %1, %2" : "=v"(r) : "v"(lo), "v"(hi)); return r; }
template <class Epi, class Sched, bool ALIGN_EPI = false, bool SP2 = false>
__device__ __forceinline__ void gemm_phase(PG8_LAS unsigned char* lds, const Gemm g, const Sched& S, const Epi& E) {
    const int tid = threadIdx.x, wid = __builtin_amdgcn_readfirstlane(tid >> 6), lane = tid & 63, wr = wid >> 2, wc = wid & 3, fr = lane & 15, fq = lane >> 4;
    const int K = g.K, nt = K / BK;
    unsigned voffA[2], voffB[2];
#pragma unroll
    for (int i = 0; i < 2; ++i) { int R, C; stage_rc(tid * 16 + i * 8192, R, C); const int Rb = Epi::PERM ? ((R & ~31) + perm32(R & 31)) : R;
        voffA[i] = (unsigned)(R * K + C) * 2u; voffB[i] = (unsigned)(Rb * K + C) * 2u; }
    const size_t kstep = (size_t)(BK * 2);
    const size_t hstep = (size_t)HALF * K * 2;
    const size_t tstep = 2 * hstep;
    const unsigned ldsw = (unsigned)wid * 1024u;
    const int aoff = lds_byte(wr * 64 + fr, fq * 8), boff = lds_byte(wc * 32 + fr, fq * 8);
#define PG8_SA(b, h) (((b) * 2 + (h)) * HTB)
#define PG8_SB(b, h) ((4 + (b) * 2 + (h)) * HTB)
#define PG8_STAGE(bufoff, gbase, voff) do { _Pragma("unroll") for (int _i = 0; _i < 2; ++_i) \
        __builtin_amdgcn_global_load_lds((const unsigned*)((const char*)(gbase) + (voff)[_i]), (PG8_LAS unsigned*)(lds + (bufoff) + ldsw + _i * 8192), 16, 0, 0); } while (0)
#define PG8_LDA(dst, b, h) do { _Pragma("unroll") for (int m = 0; m < 4; ++m) _Pragma("unroll") for (int k = 0; k < 2; ++k) dst[m][k] = *(const PG8_LAS bf16x8*)(lds + PG8_SA(b, h) + aoff + m * 2048 + k * 1024); } while (0)
#define PG8_LDB(dst, b, h) do { _Pragma("unroll") for (int n = 0; n < 2; ++n) _Pragma("unroll") for (int k = 0; k < 2; ++k) dst[n][k] = *(const PG8_LAS bf16x8*)(lds + PG8_SB(b, h) + boff + n * 2048 + k * 1024); } while (0)
#define PG8_MMA(ai, bj, At, Bt) do { __builtin_amdgcn_s_setprio(1); _Pragma("unroll") for (int m = 0; m < 4; ++m) _Pragma("unroll") for (int n = 0; n < 2; ++n) _Pragma("unroll") for (int k = 0; k < 2; ++k) \
        acc[ai][bj][m][n] = __builtin_amdgcn_mfma_f32_16x16x32_bf16(Bt[n][k], At[m][k], acc[ai][bj][m][n], 0, 0, 0); __builtin_amdgcn_s_setprio(0); } while (0)
#define PG8_WAIT_V(n) asm volatile("s_waitcnt vmcnt(" #n ")" ::: "memory")
#define PG8_WAIT_L(n) asm volatile("s_waitcnt lgkmcnt(" #n ")" ::: "memory")
#define PG8_BAR __builtin_amdgcn_s_barrier()
#define PG8_SCHED __builtin_amdgcn_sched_barrier(0)
    Unit cur, nxt; int ui = 0;
    if (!S.next(0, cur)) return;
    f32x4 acc[2][2][4][2];
#pragma unroll
    for (int a = 0; a < 2; ++a)
#pragma unroll
        for (int b = 0; b < 2; ++b)
#pragma unroll
            for (int m = 0; m < 4; ++m)
#pragma unroll
                for (int n = 0; n < 2; ++n) acc[a][b][m][n] = (f32x4){0.f, 0.f, 0.f, 0.f};
    bf16x8 At[4][2], B0[2][2], B1[2][2];
    const char* cA = (const char*)g.A + (size_t)cur.pm * tstep; const char* cB = (const char*)g.Bt + (size_t)cur.pn * tstep;
    S.a_ready(cur);
    if constexpr (SP2) {
        PG8_STAGE(PG8_SB(0, 0), cB, voffB); PG8_STAGE(PG8_SB(0, 1), cB + hstep, voffB); PG8_STAGE(PG8_SA(0, 0), cA, voffA); PG8_STAGE(PG8_SA(0, 1), cA + hstep, voffA);
        if (wr == 1) PG8_BAR;
        PG8_WAIT_V(2); PG8_BAR;
        PG8_STAGE(PG8_SB(1, 0), cB + kstep, voffB); PG8_STAGE(PG8_SA(1, 0), cA + kstep, voffA); PG8_STAGE(PG8_SB(1, 1), cB + hstep + kstep, voffB);
        PG8_WAIT_V(6); PG8_BAR;
    } else {
        PG8_STAGE(PG8_SB(0, 0), cB, voffB); PG8_STAGE(PG8_SA(0, 0), cA, voffA); PG8_STAGE(PG8_SB(0, 1), cB + hstep, voffB); PG8_STAGE(PG8_SA(0, 1), cA + hstep, voffA);
        if (wr == 1) PG8_BAR;
        PG8_WAIT_V(4); PG8_BAR;
        PG8_STAGE(PG8_SB(1, 0), cB + kstep, voffB); PG8_STAGE(PG8_SA(1, 0), cA + kstep, voffA); PG8_STAGE(PG8_SB(1, 1), cB + hstep + kstep, voffB);
        PG8_WAIT_V(6); PG8_BAR;
    }
    for (;;) {
        const bool has_next = S.next(ui + 1, nxt);
        const char* nA = has_next ? (const char*)g.A + (size_t)nxt.pm * tstep : cA; const char* nB = has_next ? (const char*)g.Bt + (size_t)nxt.pn * tstep : cB;
        for (int t = 0; t < nt; t += 2) {
            const bool last = (t == nt - 2);
            const char* a1 = cA + (size_t)(t + 1) * kstep;
            const char* a2 = last ? nA : cA + (size_t)(t + 2) * kstep; const char* b2 = last ? nB : cB + (size_t)(t + 2) * kstep;
            const char* a3 = a2 + kstep; const char* b3 = b2 + kstep;
            if (last && has_next) S.a_ready(nxt);
            if constexpr (SP2) {
            PG8_LDB(B0, 0, 0); PG8_LDB(B1, 0, 1); PG8_SCHED; PG8_LDA(At, 0, 0); PG8_STAGE(PG8_SA(1, 1), a1 + hstep, voffA);
            PG8_WAIT_V(8); PG8_WAIT_L(0); PG8_BAR; PG8_MMA(0, 0, At, B0); PG8_MMA(0, 1, At, B1); PG8_BAR; PG8_SCHED;
            PG8_LDA(At, 0, 1); PG8_STAGE(PG8_SB(0, 0), b2, voffB); PG8_STAGE(PG8_SB(0, 1), b2 + hstep, voffB); PG8_STAGE(PG8_SA(0, 0), a2, voffA);
            PG8_WAIT_V(8); PG8_WAIT_L(0); PG8_BAR; PG8_MMA(1, 0, At, B0); PG8_MMA(1, 1, At, B1); PG8_BAR; PG8_SCHED;
            PG8_LDB(B0, 1, 0); PG8_LDB(B1, 1, 1); PG8_SCHED; PG8_LDA(At, 1, 0); PG8_STAGE(PG8_SA(0, 1), a2 + hstep, voffA);
            PG8_WAIT_V(8); PG8_WAIT_L(0); PG8_BAR; PG8_MMA(0, 0, At, B0); PG8_MMA(0, 1, At, B1); PG8_BAR; PG8_SCHED;
            PG8_LDA(At, 1, 1); PG8_STAGE(PG8_SB(1, 0), b3, voffB); PG8_STAGE(PG8_SB(1, 1), b3 + hstep, voffB); PG8_STAGE(PG8_SA(1, 0), a3, voffA);
            PG8_WAIT_V(8); PG8_WAIT_L(0); PG8_BAR; PG8_MMA(1, 0, At, B0); PG8_MMA(1, 1, At, B1); PG8_BAR; PG8_SCHED;
            } else {
            PG8_LDB(B0, 0, 0); PG8_SCHED; PG8_LDA(At, 0, 0); PG8_STAGE(PG8_SA(1, 1), a1 + hstep, voffA);
            PG8_WAIT_L(8); PG8_BAR; PG8_WAIT_L(0); PG8_MMA(0, 0, At, B0); PG8_BAR; PG8_SCHED;
            PG8_LDB(B1, 0, 1); PG8_STAGE(PG8_SB(0, 0), b2, voffB);
            PG8_BAR; PG8_WAIT_L(0); PG8_MMA(0, 1, At, B1); PG8_BAR;
            PG8_LDA(At, 0, 1); PG8_STAGE(PG8_SA(0, 0), a2, voffA);
            PG8_BAR; PG8_WAIT_L(0); PG8_MMA(1, 0, At, B0); PG8_BAR; PG8_SCHED;
            PG8_STAGE(PG8_SB(0, 1), b2 + hstep, voffB);
            PG8_WAIT_V(6); PG8_BAR; PG8_MMA(1, 1, At, B1); PG8_BAR;
            PG8_LDB(B0, 1, 0); PG8_SCHED; PG8_LDA(At, 1, 0); PG8_STAGE(PG8_SA(0, 1), a2 + hstep, voffA);
            PG8_WAIT_L(8); PG8_BAR; PG8_WAIT_L(0); PG8_MMA(0, 0, At, B0); PG8_BAR; PG8_SCHED;
            PG8_LDB(B1, 1, 1); PG8_STAGE(PG8_SB(1, 0), b3, voffB);
            PG8_BAR; PG8_WAIT_L(0); PG8_MMA(0, 1, At, B1); PG8_BAR;
            PG8_LDA(At, 1, 1); PG8_STAGE(PG8_SA(1, 0), a3, voffA);
            PG8_BAR; PG8_WAIT_L(0); PG8_MMA(1, 0, At, B0); PG8_BAR; PG8_SCHED;
            PG8_STAGE(PG8_SB(1, 1), b3 + hstep, voffB);
            PG8_WAIT_V(6); PG8_BAR; PG8_MMA(1, 1, At, B1); PG8_BAR;
            }
        }
        if constexpr (ALIGN_EPI) { if (wr == 0) PG8_BAR; }
        if constexpr (!Epi::AFTER_DRAIN) { E(acc, cur, wr, wc, fr, fq); S.done(cur); }
        if (!has_next) break;
#pragma unroll
        for (int a = 0; a < 2; ++a)
#pragma unroll
            for (int b = 0; b < 2; ++b)
#pragma unroll
                for (int m = 0; m < 4; ++m)
#pragma unroll
                    for (int n = 0; n < 2; ++n) acc[a][b][m][n] = (f32x4){0.f, 0.f, 0.f, 0.f};
        cur = nxt; cA = nA; cB = nB; ++ui;
        if constexpr (ALIGN_EPI) { if (wr == 1) PG8_BAR; }
    }
    PG8_WAIT_V(0);
    if constexpr (!ALIGN_EPI) { if (wr == 0) PG8_BAR; }
    PG8_BAR;
    if constexpr (Epi::AFTER_DRAIN) { E.fused(acc, cur, wr, wc, fr, fq, lds, wid, lane); S.done(cur); }
#undef PG8_SA
#undef PG8_SB
#undef PG8_STAGE
#undef PG8_LDA
#undef PG8_LDB
#undef PG8_MMA
#undef PG8_WAIT_V
#undef PG8_WAIT_L
#undef PG8_BAR
#undef PG8_SCHED
}
}

#ifndef MK_N_LAUNCHES
#define MK_N_LAUNCHES 1
#endif
constexpr int DM = 1024, PB_B = 8, PB_T = 2048, SB_B = 128, SB_T = 8;
constexpr int MP = PB_B * PB_T, MS = SB_B * SB_T, MTOK = MP + MS;
constexpr int S5W = 512, S5G = 32, S5C = 16, S5N = 64;
constexpr int HGW = 512, HD = 128, HH = 4;
constexpr int INC = 2560, DFF = 2816;
constexpr float EPS = 1e-6f;
constexpr int NPH = 9;
constexpr size_t O_Y = 0, O_PRE = (size_t)MTOK * DM, O_PIM = O_PRE + 16384, O_PHG = O_PIM + 16384, O_SRE = O_PHG + 524288, O_SIM = O_SRE + 262144, O_SHG = O_SIM + 262144;
constexpr size_t MiB = 1u << 20;
constexpr size_t WS_CTL = 0, WS_WIN = 2 * MiB, WS_WGLU = 7 * MiB, WS_WOUT = 8 * MiB, WS_WGU = 10 * MiB, WS_WD = 21 * MiB;
constexpr size_t WS_XN = 27 * MiB, WS_PB = 61 * MiB, WS_FZ = 129 * MiB, WS_ACT = 61 * MiB, WS_GY = 163 * MiB, WS_OH = 180 * MiB, WS_MIX = 197 * MiB, WS_END = 231 * MiB;
constexpr int PBW = 2048;
constexpr int LDS_BYTES = 147456;
constexpr int NWAVES = 8;

#define GAS __attribute__((address_space(1)))
#define LAS __attribute__((address_space(3)))
typedef unsigned short bf16;
typedef unsigned v4u __attribute__((ext_vector_type(4)));
typedef unsigned v2u __attribute__((ext_vector_type(2)));
typedef float f32x4 __attribute__((ext_vector_type(4)));
#define LDS_WAIT() asm volatile("s_waitcnt lgkmcnt(0)" ::: "memory")
__device__ __forceinline__ unsigned f2bf(float f) { unsigned u = __builtin_bit_cast(unsigned, f); return (u + 0x7fffu + ((u >> 16) & 1u)) >> 16; }
__device__ __forceinline__ unsigned pk2(float lo, float hi) { return f2bf(lo) | (f2bf(hi) << 16); }
__device__ __forceinline__ float bf2f(unsigned short h) { return __builtin_bit_cast(float, (unsigned)h << 16); }
__device__ __forceinline__ float bflo(unsigned w) { return __builtin_bit_cast(float, w << 16); }
__device__ __forceinline__ float bfhi(unsigned w) { return __builtin_bit_cast(float, w & 0xffff0000u); }
__device__ __forceinline__ float sigmoidf_(float x) { return 1.0f / (1.0f + __expf(-x)); }
__device__ __forceinline__ float siluf_(float x) { return x / (1.0f + __expf(-x)); }
__device__ __forceinline__ float gelu_tanh(float x) { const float z = 1.5957691216057308f * (x + 0.044715f * x * x * x); return x / (1.0f + __expf(-z)); }
__device__ __forceinline__ float wave_sum(float v) {
#pragma unroll
    for (int o = 1; o < 64; o <<= 1) v += __shfl_xor(v, o);
    return v;
}

struct Args { const float* in[24]; float* out; unsigned char* ws; int ph_lo, ph_hi; };

struct Frame {
    LAS unsigned char* lds;
    int tid, lane, wave, G, bid;
    const float* in[24];
    float* out; unsigned char* ws;
};
__device__ __forceinline__ const float* xrow(const Frame& F, int m) { return m < MP ? F.in[0] + (size_t)m * DM : F.in[1] + (size_t)(m - MP) * DM; }

__device__ __forceinline__ void transpose_item(const float* W, int ldw, bf16* WT, int K, int k0, int sn0, int dn0, LAS float* scr, int lane) {
#pragma unroll 8
    for (int i = 0; i < 32; ++i) { const int kk = 2 * i + (lane >> 5); scr[kk * 33 + (lane & 31)] = W[(size_t)(k0 + kk) * ldw + sn0 + (lane & 31)]; }
    LDS_WAIT(); asm volatile("" ::: "memory");
    const int c = lane & 7;
#pragma unroll
    for (int j = 0; j < 4; ++j) { const int n = (lane >> 3) + 8 * j; const LAS float* s = scr + (8 * c) * 33 + n;
        v4u o; o.x = pk2(s[0 * 33], s[1 * 33]); o.y = pk2(s[2 * 33], s[3 * 33]); o.z = pk2(s[4 * 33], s[5 * 33]); o.w = pk2(s[6 * 33], s[7 * 33]);
        *(GAS v4u*)(WT + (size_t)(dn0 + n) * K + k0 + 8 * c) = o; }
    LDS_WAIT(); asm volatile("" ::: "memory");
}
__device__ __forceinline__ void rms_row_bf16(const float* xr_, const float* gain, bf16* orow, int lane) {
    const GAS f32x4* xr = (const GAS f32x4*)xr_ + lane;
    f32x4 v[4]; float s = 0.f;
#pragma unroll
    for (int j = 0; j < 4; ++j) { v[j] = xr[64 * j]; s += (v[j].x * v[j].x + v[j].y * v[j].y) + (v[j].z * v[j].z + v[j].w * v[j].w); }
    const float rstd = 1.0f / sqrtf(wave_sum(s) * (1.0f / DM) + EPS);
    GAS v2u* o8 = (GAS v2u*)orow + lane;
#pragma unroll
    for (int j = 0; j < 4; ++j) { const f32x4 g = ((const GAS f32x4*)gain)[lane + 64 * j]; v2u w; w.x = pk2(v[j].x * rstd * g.x, v[j].y * rstd * g.y); w.y = pk2(v[j].z * rstd * g.z, v[j].w * rstd * g.w); o8[64 * j] = w; }
}

__device__ __forceinline__ void p0_prologue(Frame& F) {
    LAS float* scr = (LAS float*)(F.lds + F.wave * 16384);
    const int gw = F.bid * NWAVES + F.wave, NGW = F.G * NWAVES;
    bf16* WinT = (bf16*)(F.ws + WS_WIN); bf16* WgluT = (bf16*)(F.ws + WS_WGLU); bf16* WoutT = (bf16*)(F.ws + WS_WOUT); bf16* WguT = (bf16*)(F.ws + WS_WGU); bf16* WdT = (bf16*)(F.ws + WS_WD);
    constexpr int I_IN = (DM / 64) * (INC / 32), I_GLU = (S5W / 64) * (S5W / 32), I_OUT = (DM / 64) * (DM / 32), I_G = (DM / 64) * (DFF / 32), I_D = (DFF / 64) * (DM / 32);
    constexpr int NITEMS = I_IN + I_GLU + I_OUT + 2 * I_G + I_D;
    for (int it = gw; it < NITEMS; it += NGW) {
        int r = it;
        if (r < I_IN) { const int nblk = INC / 32, kb = r / nblk, nb = r % nblk, sn0 = nb * 32; const int seg = sn0 / 512, off = sn0 % 512;
            const int dseg = seg == 0 ? 0 : seg == 1 ? 1 : seg == 2 ? 4 : seg == 3 ? 2 : 3;
            transpose_item(F.in[7], INC, WinT, DM, kb * 64, sn0, dseg * 512 + off, scr, F.lane); continue; } r -= I_IN;
        if (r < I_GLU) { const int nblk = S5W / 32, kb = r / nblk, nb = r % nblk; transpose_item(F.in[16], S5W, WgluT, S5W, kb * 64, nb * 32, nb * 32, scr, F.lane); continue; } r -= I_GLU;
        if (r < I_OUT) { const int nblk = DM / 32, kb = r / nblk, nb = r % nblk; transpose_item(F.in[18], DM, WoutT, DM, kb * 64, nb * 32, nb * 32, scr, F.lane); continue; } r -= I_OUT;
        if (r < I_G) { const int nblk = DFF / 32, kb = r / nblk, nb = r % nblk, sn0 = nb * 32; transpose_item(F.in[20], DFF, WguT, DM, kb * 64, sn0, 256 * (sn0 / 128) + (sn0 % 128), scr, F.lane); continue; } r -= I_G;
        if (r < I_G) { const int nblk = DFF / 32, kb = r / nblk, nb = r % nblk, sn0 = nb * 32; transpose_item(F.in[21], DFF, WguT, DM, kb * 64, sn0, 256 * (sn0 / 128) + 128 + (sn0 % 128), scr, F.lane); continue; } r -= I_G;
        { const int nblk = DM / 32, kb = r / nblk, nb = r % nblk; transpose_item(F.in[22], DM, WdT, DFF, kb * 64, nb * 32, nb * 32, scr, F.lane); }
    }
    bf16* XN = (bf16*)(F.ws + WS_XN);
    for (int m = gw; m < MTOK; m += NGW) rms_row_bf16(xrow(F, m), F.in[6], XN + (size_t)m * DM, F.lane);
}

using pg8::Unit; using pg8::u32x4; using pg8::cvt_pk_bf16; using pg8::BM; using pg8::HALF;
struct EpiIn {
    static constexpr bool PERM = true, AFTER_DRAIN = false;
    bf16* PB; float* FZ;
    __device__ __forceinline__ void operator()(const pg8::f32x4 (&acc)[2][2][4][2], const Unit& u, int wr, int wc, int fr, int fq) const {
        const int row0 = u.pm * BM + wr * 64 + fr;
        if (u.pn < 8) { const int col0 = u.pn * BM + wc * 32 + 8 * fq;
#pragma unroll
            for (int ai = 0; ai < 2; ++ai)
#pragma unroll
                for (int m = 0; m < 4; ++m) { bf16* rowp = PB + (size_t)(row0 + ai * HALF + m * 16) * PBW + col0;
#pragma unroll
                    for (int bj = 0; bj < 2; ++bj) { const pg8::f32x4 v0 = acc[ai][bj][m][0], v1 = acc[ai][bj][m][1]; u32x4 w; w.x = cvt_pk_bf16(v0[0], v0[1]); w.y = cvt_pk_bf16(v0[2], v0[3]); w.z = cvt_pk_bf16(v1[0], v1[1]); w.w = cvt_pk_bf16(v1[2], v1[3]);
                        *(u32x4*)(rowp + bj * HALF) = w; } }
        } else { const int col0 = (u.pn - 8) * BM + wc * 32 + 8 * fq;
#pragma unroll
            for (int ai = 0; ai < 2; ++ai)
#pragma unroll
                for (int m = 0; m < 4; ++m) { float* rowp = FZ + (size_t)(row0 + ai * HALF + m * 16) * 512 + col0;
#pragma unroll
                    for (int bj = 0; bj < 2; ++bj)
#pragma unroll
                        for (int n = 0; n < 2; ++n) *(pg8::f32x4*)(rowp + bj * HALF + 4 * n) = acc[ai][bj][m][n]; }
        }
    }
};
struct EpiGlu {
    static constexpr bool PERM = true, AFTER_DRAIN = false;
    const bf16* GY; bf16* MIX;
    __device__ __forceinline__ void operator()(const pg8::f32x4 (&acc)[2][2][4][2], const Unit& u, int wr, int wc, int fr, int fq) const {
        const int row0 = u.pm * BM + wr * 64 + fr, col0 = u.pn * BM + wc * 32 + 8 * fq;
#pragma unroll
        for (int ai = 0; ai < 2; ++ai)
#pragma unroll
            for (int m = 0; m < 4; ++m) { const size_t r = (size_t)(row0 + ai * HALF + m * 16);
#pragma unroll
                for (int bj = 0; bj < 2; ++bj) { const u32x4 g = *(const u32x4*)(GY + r * 512 + col0 + bj * HALF); const pg8::f32x4 v0 = acc[ai][bj][m][0], v1 = acc[ai][bj][m][1];
                    u32x4 w; w.x = cvt_pk_bf16(bflo(g.x) * sigmoidf_(v0[0]), bfhi(g.x) * sigmoidf_(v0[1])); w.y = cvt_pk_bf16(bflo(g.y) * sigmoidf_(v0[2]), bfhi(g.y) * sigmoidf_(v0[3]));
                    w.z = cvt_pk_bf16(bflo(g.z) * sigmoidf_(v1[0]), bfhi(g.z) * sigmoidf_(v1[1])); w.w = cvt_pk_bf16(bflo(g.w) * sigmoidf_(v1[2]), bfhi(g.w) * sigmoidf_(v1[3]));
                    *(u32x4*)(MIX + r * DM + col0 + bj * HALF) = w; } }
    }
};
struct EpiOut {
    static constexpr bool PERM = false, AFTER_DRAIN = false;
    const float* xp; const float* xs; float* Y;
    __device__ __forceinline__ void operator()(const pg8::f32x4 (&acc)[2][2][4][2], const Unit& u, int wr, int wc, int fr, int fq) const {
        const int row0 = u.pm * BM + wr * 64 + fr, col0 = u.pn * BM + wc * 32 + 4 * fq;
        const float* xb = (u.pm < MP / BM) ? xp : xs - (size_t)MP * DM;
#pragma unroll
        for (int ai = 0; ai < 2; ++ai)
#pragma unroll
            for (int m = 0; m < 4; ++m) { const size_t off = (size_t)(row0 + ai * HALF + m * 16) * DM + col0;
#pragma unroll
                for (int bj = 0; bj < 2; ++bj)
#pragma unroll
                    for (int n = 0; n < 2; ++n) { const pg8::f32x4 xv = *(const pg8::f32x4*)(xb + off + bj * HALF + n * 16); *(pg8::f32x4*)(Y + off + bj * HALF + n * 16) = xv + acc[ai][bj][m][n]; } }
    }
};
struct EpiAct {
    static constexpr bool PERM = true, AFTER_DRAIN = false;
    bf16* ACT;
    __device__ __forceinline__ void operator()(const pg8::f32x4 (&acc)[2][2][4][2], const Unit& u, int wr, int wc, int fr, int fq) const {
        const int row0 = u.pm * BM + wr * 64 + fr, col0 = u.pn * HALF + wc * 32 + 8 * fq;
#pragma unroll
        for (int ai = 0; ai < 2; ++ai)
#pragma unroll
            for (int m = 0; m < 4; ++m) { const pg8::f32x4 g0 = acc[ai][0][m][0], g1 = acc[ai][0][m][1], u0 = acc[ai][1][m][0], u1 = acc[ai][1][m][1];
                u32x4 w; w.x = cvt_pk_bf16(siluf_(g0[0]) * u0[0], siluf_(g0[1]) * u0[1]); w.y = cvt_pk_bf16(siluf_(g0[2]) * u0[2], siluf_(g0[3]) * u0[3]);
                w.z = cvt_pk_bf16(siluf_(g1[0]) * u1[0], siluf_(g1[1]) * u1[1]); w.w = cvt_pk_bf16(siluf_(g1[2]) * u1[2], siluf_(g1[3]) * u1[3]);
                *(u32x4*)(ACT + (size_t)(row0 + ai * HALF + m * 16) * DFF + col0) = w; }
    }
};
struct EpiDown {
    static constexpr bool PERM = false, AFTER_DRAIN = false;
    float* Y;
    __device__ __forceinline__ void operator()(const pg8::f32x4 (&acc)[2][2][4][2], const Unit& u, int wr, int wc, int fr, int fq) const {
        const int row0 = u.pm * BM + wr * 64 + fr, col0 = u.pn * BM + wc * 32 + 4 * fq;
#pragma unroll
        for (int ai = 0; ai < 2; ++ai)
#pragma unroll
            for (int m = 0; m < 4; ++m) { const size_t off = (size_t)(row0 + ai * HALF + m * 16) * DM + col0;
#pragma unroll
                for (int bj = 0; bj < 2; ++bj)
#pragma unroll
                    for (int n = 0; n < 2; ++n) { float* p = Y + off + bj * HALF + n * 16; const pg8::f32x4 xv = *(const pg8::f32x4*)p; *(pg8::f32x4*)p = xv + acc[ai][bj][m][n]; } }
    }
};

__device__ __forceinline__ void s5_simple_item(Frame& F, int item) {
    const int lane = F.lane, n = lane;
    int g, tokbase, T; const float* h0r = nullptr; const float* h0i = nullptr; float* outr; float* outi;
    if (item < PB_B * S5G) { const int b = item / S5G; g = item % S5G; tokbase = b * PB_T; T = PB_T; outr = F.out + O_PRE + (size_t)item * S5N; outi = F.out + O_PIM + (size_t)item * S5N; }
    else { const int idx = item - PB_B * S5G, b = idx / S5G; g = idx % S5G; tokbase = MP + b * SB_T; T = SB_T; h0r = F.in[2] + (size_t)idx * S5N; h0i = F.in[3] + (size_t)idx * S5N; outr = F.out + O_SRE + (size_t)idx * S5N; outi = F.out + O_SIM + (size_t)idx * S5N; }
    const float a_re = F.in[8][g * S5N + n], a_im = F.in[9][g * S5N + n], dt = expf(F.in[10][g]);
    const float mag = expf(a_re * dt), ab_re = mag * cosf(a_im * dt), ab_im = mag * sinf(a_im * dt);
    const float den = a_re * a_re + a_im * a_im, nr = ab_re - 1.0f, ni = ab_im;
    const float f_re = (nr * a_re + ni * a_im) / den, f_im = (ni * a_re - nr * a_im) / den;
    float Bre[16], Bim[16], Cre[16], Cim[16];
#pragma unroll
    for (int c = 0; c < 16; ++c) { const float br = F.in[11][(size_t)(g * S5N + n) * 16 + c], bi = F.in[12][(size_t)(g * S5N + n) * 16 + c];
        Bre[c] = f_re * br - f_im * bi; Bim[c] = f_re * bi + f_im * br;
        Cre[c] = F.in[13][(size_t)(g * 16 + c) * S5N + n]; Cim[c] = F.in[14][(size_t)(g * 16 + c) * S5N + n]; }
    const float dl = F.in[15][g * 16 + (lane & 15)];
    float h_re = h0r ? h0r[n] : 0.f, h_im = h0i ? h0i[n] : 0.f;
    const bf16* PB = (const bf16*)(F.ws + WS_PB); bf16* GY = (bf16*)(F.ws + WS_GY);
    for (int t = 0; t < T; ++t) {
        const float uv = bf2f(PB[(size_t)(tokbase + t) * PBW + g * 16 + (lane & 15)]);
        float bu_re = 0.f, bu_im = 0.f;
#pragma unroll
        for (int c = 0; c < 16; ++c) { const float uc = __shfl(uv, c); bu_re += Bre[c] * uc; bu_im += Bim[c] * uc; }
        const float nre = ab_re * h_re - ab_im * h_im + bu_re, nim = ab_re * h_im + ab_im * h_re + bu_im;
        h_re = nre; h_im = nim;
        float yv = 0.f;
#pragma unroll
        for (int c = 0; c < 16; ++c) { const float p = wave_sum(Cre[c] * h_re - Cim[c] * h_im); yv = ((lane & 15) == c) ? p : yv; }
        const float y = yv + dl * uv;
        if (lane < 16) GY[(size_t)(tokbase + t) * S5W + g * 16 + lane] = (bf16)f2bf(gelu_tanh(y));
    }
    outr[n] = h_re; outi[n] = h_im;
}
__device__ __forceinline__ void hgrn_simple_item(Frame& F, int item) {
    const int tid = F.tid, v = tid & 127, kq = tid >> 7;
    int h, tokbase, T; const float* S0 = nullptr; float* Sout;
    if (item < PB_B * HH) { const int b = item / HH; h = item % HH; tokbase = b * PB_T; T = PB_T; Sout = F.out + O_PHG + (size_t)item * HD * HD; }
    else { const int idx = item - PB_B * HH, b = idx / HH; h = idx % HH; tokbase = MP + b * SB_T; T = SB_T; S0 = F.in[4] + (size_t)idx * HD * HD; Sout = F.out + O_SHG + (size_t)idx * HD * HD; }
    float S[32];
#pragma unroll
    for (int j = 0; j < 32; ++j) S[j] = S0 ? S0[(size_t)(32 * kq + j) * HD + v] : 0.f;
    LAS float* Fs = (LAS float*)F.lds;
    LAS float* Ks = Fs + 1024;
    LAS float* Qs = Ks + 1024;
    LAS float* Vs = Qs + 1024;
    LAS float* OP = Vs + 1024;
    const bf16* PB = (const bf16*)(F.ws + WS_PB); const float* FZ = (const float*)(F.ws + WS_FZ); bf16* OH = (bf16*)(F.ws + WS_OH);
    float lb = 0.f;
    if (tid < 128) { const int col = h * HD + tid; lb = 1.0f / (1.0f + expf(F.in[5][512 + col] - F.in[5][col])); }
    for (int t0 = 0; t0 < T; t0 += 8) {
        if (tid < 128) {
#pragma unroll
            for (int tt = 0; tt < 8; ++tt) { const size_t tok = (size_t)(tokbase + t0 + tt); const float fz = FZ[tok * 512 + h * HD + tid];
                const float sg = 1.0f / (1.0f + expf(-fz)), f = lb + (1.0f - lb) * sg;
                Fs[tt * 128 + tid] = f; Ks[tt * 128 + tid] = 1.0f - f; Qs[tt * 128 + tid] = bf2f(PB[tok * PBW + 512 + h * HD + tid]); }
        } else if (tid < 256) { const int vv = tid - 128;
#pragma unroll
            for (int tt = 0; tt < 8; ++tt) Vs[tt * 128 + vv] = bf2f(PB[(size_t)(tokbase + t0 + tt) * PBW + 1024 + h * HD + vv]);
        }
        __syncthreads();
#pragma unroll 1
        for (int tt = 0; tt < 8; ++tt) { const float iv = Vs[tt * 128 + v]; float o = 0.f;
#pragma unroll
            for (int j = 0; j < 32; j += 4) { const f32x4 f4 = *(const LAS f32x4*)(Fs + tt * 128 + 32 * kq + j), k4 = *(const LAS f32x4*)(Ks + tt * 128 + 32 * kq + j), q4 = *(const LAS f32x4*)(Qs + tt * 128 + 32 * kq + j);
                S[j] = f4.x * S[j] + k4.x * iv; o += S[j] * q4.x; S[j + 1] = f4.y * S[j + 1] + k4.y * iv; o += S[j + 1] * q4.y;
                S[j + 2] = f4.z * S[j + 2] + k4.z * iv; o += S[j + 2] * q4.z; S[j + 3] = f4.w * S[j + 3] + k4.w * iv; o += S[j + 3] * q4.w; }
            OP[(tt * 4 + kq) * 128 + v] = o; }
        __syncthreads();
#pragma unroll
        for (int r = 0; r < 2; ++r) { const int idx = tid + 512 * r, tt = idx >> 7, vv = idx & 127;
            const float o = (OP[(tt * 4 + 0) * 128 + vv] + OP[(tt * 4 + 1) * 128 + vv]) + (OP[(tt * 4 + 2) * 128 + vv] + OP[(tt * 4 + 3) * 128 + vv]);
            OH[(size_t)(tokbase + t0 + tt) * HGW + h * HD + vv] = (bf16)f2bf(o); }
        __syncthreads();
    }
#pragma unroll
    for (int j = 0; j < 32; ++j) Sout[(size_t)(32 * kq + j) * HD + v] = S[j];
}

__device__ __forceinline__ void hg_normgate_row(Frame& F, int tok) {
    const int lane = F.lane;
    const bf16* OH = (const bf16*)(F.ws + WS_OH); const bf16* PB = (const bf16*)(F.ws + WS_PB); bf16* MIX = (bf16*)(F.ws + WS_MIX);
    const v4u o8 = *(const GAS v4u*)(OH + (size_t)tok * HGW + 8 * lane);
    const v4u g8 = *(const GAS v4u*)(PB + (size_t)tok * PBW + 1536 + 8 * lane);
    float o[8] = {bflo(o8.x), bfhi(o8.x), bflo(o8.y), bfhi(o8.y), bflo(o8.z), bfhi(o8.z), bflo(o8.w), bfhi(o8.w)};
    float gt[8] = {bflo(g8.x), bfhi(g8.x), bflo(g8.y), bfhi(g8.y), bflo(g8.z), bfhi(g8.z), bflo(g8.w), bfhi(g8.w)};
    float ss = 0.f;
#pragma unroll
    for (int j = 0; j < 8; ++j) ss += o[j] * o[j];
    ss += __shfl_xor(ss, 1); ss += __shfl_xor(ss, 2); ss += __shfl_xor(ss, 4); ss += __shfl_xor(ss, 8);
    const float rstd = 1.0f / sqrtf(ss * (1.0f / HD) + EPS);
    const f32x4 n0 = *(const GAS f32x4*)(F.in[17] + ((8 * lane) & 127)), n1 = *(const GAS f32x4*)(F.in[17] + ((8 * lane) & 127) + 4);
    const float gn[8] = {n0.x, n0.y, n0.z, n0.w, n1.x, n1.y, n1.z, n1.w};
    float r[8];
#pragma unroll
    for (int j = 0; j < 8; ++j) r[j] = o[j] * rstd * gn[j] * siluf_(gt[j]);
    v4u w; w.x = pk2(r[0], r[1]); w.y = pk2(r[2], r[3]); w.z = pk2(r[4], r[5]); w.w = pk2(r[6], r[7]);
    *(GAS v4u*)(MIX + (size_t)tok * DM + 512 + 8 * lane) = w;
}
__device__ __forceinline__ void final_norm_row(Frame& F, int m) {
    GAS f32x4* xr = (GAS f32x4*)(F.out + O_Y + (size_t)m * DM) + F.lane;
    f32x4 v[4]; float s = 0.f;
#pragma unroll
    for (int j = 0; j < 4; ++j) { v[j] = xr[64 * j]; s += (v[j].x * v[j].x + v[j].y * v[j].y) + (v[j].z * v[j].z + v[j].w * v[j].w); }
    const float rstd = 1.0f / sqrtf(wave_sum(s) * (1.0f / DM) + EPS);
#pragma unroll
    for (int j = 0; j < 4; ++j) { const f32x4 g = ((const GAS f32x4*)F.in[23])[F.lane + 64 * j]; f32x4 o; o.x = v[j].x * rstd * g.x; o.y = v[j].y * rstd * g.y; o.z = v[j].z * rstd * g.z; o.w = v[j].w * rstd * g.w; xr[64 * j] = o; }
}

__global__ void __launch_bounds__(NWAVES * 64, 2) mk_fwd(Args args) {
    extern __shared__ __attribute__((aligned(16))) unsigned char lds[];
    Frame F;
    F.lds = (LAS unsigned char*)lds;
    F.tid = threadIdx.x; F.lane = F.tid & 63; F.wave = __builtin_amdgcn_readfirstlane(F.tid >> 6);
    F.G = gridDim.x; F.bid = blockIdx.x;
#pragma unroll
    for (int i = 0; i < 24; ++i) F.in[i] = args.in[i];
    F.out = args.out; F.ws = args.ws;
    const int lo = args.ph_lo, hi = args.ph_hi;
#define IN(k) (lo <= (k) && (k) < hi)
#if MK_N_LAUNCHES == 1
    cg::grid_group grid = cg::this_grid();
#define SEAM(k) do { if (IN(k) && IN((k) + 1)) grid.sync(); } while (0)
#else
#define SEAM(k) do { } while (0)
#endif
    const int gw = F.bid * NWAVES + F.wave, NGW = F.G * NWAVES;
    bf16* XN = (bf16*)(F.ws + WS_XN); bf16* PB = (bf16*)(F.ws + WS_PB); float* FZ = (float*)(F.ws + WS_FZ); bf16* GY = (bf16*)(F.ws + WS_GY);
    bf16* MIX = (bf16*)(F.ws + WS_MIX); bf16* ACT = (bf16*)(F.ws + WS_ACT);

    if (IN(0)) { p0_prologue(F); } SEAM(0);
    if (IN(1)) {
        pg8::Gemm g{XN, (const bf16*)(F.ws + WS_WIN), MTOK, INC, DM}; pg8::StaticOrder S; S.init(MTOK, INC, F.G, F.bid);
        EpiIn E{PB, FZ};
        pg8::gemm_phase<EpiIn, pg8::StaticOrder, true, true>(F.lds, g, S, E);
    } SEAM(1);
    if (IN(2)) {
        for (int it = gw; it < PB_B * S5G + SB_B * S5G; it += NGW) s5_simple_item(F, it);
        __syncthreads();
        for (int it = F.bid; it < PB_B * HH + SB_B * HH; it += F.G) { hgrn_simple_item(F, it); __syncthreads(); }
    } SEAM(2);
    if (IN(3)) {
        pg8::Gemm g{GY, (const bf16*)(F.ws + WS_WGLU), MTOK, S5W, S5W}; pg8::StaticOrder S; S.init(MTOK, S5W, F.G, F.bid);
        EpiGlu E{GY, MIX};
        pg8::gemm_phase<EpiGlu, pg8::StaticOrder, true, true>(F.lds, g, S, E);
        for (int m = gw; m < MTOK; m += NGW) hg_normgate_row(F, m);
    } SEAM(3);
    if (IN(4)) {
        pg8::Gemm g{MIX, (const bf16*)(F.ws + WS_WOUT), MTOK, DM, DM}; pg8::StaticOrder S; S.init(MTOK, DM, F.G, F.bid);
        EpiOut E{F.in[0], F.in[1], F.out + O_Y};
        pg8::gemm_phase<EpiOut, pg8::StaticOrder, true, true>(F.lds, g, S, E);
    } SEAM(4);
    if (IN(5)) {
        for (int m = gw; m < MTOK; m += NGW) rms_row_bf16(F.out + O_Y + (size_t)m * DM, F.in[19], XN + (size_t)m * DM, F.lane);
    } SEAM(5);
    if (IN(6)) {
        pg8::Gemm g{XN, (const bf16*)(F.ws + WS_WGU), MTOK, 2 * DFF, DM}; pg8::StaticOrder S; S.init(MTOK, 2 * DFF, F.G, F.bid);
        EpiAct E{ACT};
        pg8::gemm_phase<EpiAct, pg8::StaticOrder, true, true>(F.lds, g, S, E);
    } SEAM(6);
    if (IN(7)) {
        pg8::Gemm g{ACT, (const bf16*)(F.ws + WS_WD), MTOK, DM, DFF}; pg8::StaticOrder S; S.init(MTOK, DM, F.G, F.bid);
        EpiDown E{F.out + O_Y};
        pg8::gemm_phase<EpiDown, pg8::StaticOrder, true, true>(F.lds, g, S, E);
    } SEAM(7);
    if (IN(8)) {
        for (int m = gw; m < MTOK; m += NGW) final_norm_row(F, m);
    }
#undef IN
#undef SEAM
}

extern "C" void kernel_launch(void* const* d_in, const int* in_sizes, int n_in, void* d_out, int out_size, void* d_ws, size_t ws_size, hipStream_t stream) {
    static int grid = 0;
    if (grid == 0) {
        if (n_in != 24 || ws_size < WS_END) { fprintf(stderr, "kernel_launch: unexpected n_in %d / ws %zu\n", n_in, ws_size); grid = -1; return; }
        int dev = 0, cus = 0, per_cu = 0;
        if (hipGetDevice(&dev) != hipSuccess || hipDeviceGetAttribute(&cus, hipDeviceAttributeMultiprocessorCount, dev) != hipSuccess) { grid = -1; return; }
        if (hipFuncSetAttribute((const void*)mk_fwd, hipFuncAttributeMaxDynamicSharedMemorySize, LDS_BYTES) != hipSuccess) { fprintf(stderr, "kernel_launch: hipFuncSetAttribute failed\n"); grid = -1; return; }
        if (hipOccupancyMaxActiveBlocksPerMultiprocessor(&per_cu, (const void*)mk_fwd, NWAVES * 64, LDS_BYTES) != hipSuccess || per_cu < 1) { fprintf(stderr, "kernel_launch: occupancy query says %d\n", per_cu); per_cu = 1; }
        (void)hipGetLastError();
        grid = cus;
    }
    if (grid < 0) return;
    Args a{};
    for (int i = 0; i < 24; ++i) a.in[i] = (const float*)d_in[i];
    a.out = (float*)d_out; a.ws = (unsigned char*)d_ws;
#if MK_N_LAUNCHES == 1
    a.ph_lo = 0; a.ph_hi = NPH;
    void* kargs[] = {&a};
    hipError_t e = hipLaunchCooperativeKernel((const void*)mk_fwd, dim3(grid), dim3(NWAVES * 64), kargs, LDS_BYTES, stream);
    if (e != hipSuccess) fprintf(stderr, "kernel_launch: cooperative launch failed: %s (grid %d)\n", hipGetErrorString(e), grid);
#else
    for (int p = 0; p < NPH; ++p) { a.ph_lo = p; a.ph_hi = p + 1; hipLaunchKernelGGL(mk_fwd, dim3(grid), dim3(NWAVES * 64), LDS_BYTES, stream, a); }
#endif
}
```

```cpp
#include <hip/hip_runtime.h>
#include <hip/hip_cooperative_groups.h>
#include <cstdio>
#include <cstdint>
namespace cg = cooperative_groups;
#define MK_N_LAUNCHES 1
namespace pg8 {
#define PG8_LAS __attribute__((address_space(3)))
typedef unsigned short bf16_t;
typedef short bf16x8 __attribute__((ext_vector_type(8)));
typedef float f32x4 __attribute__((ext_vector_type(4)));
typedef unsigned u32x4 __attribute__((ext_vector_type(4)));
constexpr int BM = 256, BK = 64, HALF = 128, HTB = HALF * BK * 2  , STAGE_BYTES = 8 * HTB, NXCD = 8, WGM = 8;

__host__ __device__ __forceinline__ int lds_byte(int r, int c) { const int st = (r >> 4) * 2 + (c >> 5), rr = r & 15, cc = c & 31, ob = rr * 64 + cc * 2; return st * 1024 + (ob ^ (((ob >> 9) & 1) << 5)); }
__host__ __device__ __forceinline__ void stage_rc(int b, int& R, int& C) { const int st = b / 1024, sb = b % 1024, swz = sb ^ (((sb >> 9) & 1) << 5); R = (st >> 1) * 16 + swz / 64; C = (st & 1) * 32 + (swz % 64) / 2; }
__host__ __device__ __forceinline__ int perm32(int rho) { const int n = rho >> 4, i = rho & 15; return 8 * (i >> 2) + 4 * n + (i & 3); }

struct Unit { int pm, pn; };
struct Gemm { const bf16_t* A; const bf16_t* Bt; int M, N, K; };

struct StaticOrder {
    int nM, nN, nwg, G, c;
    __host__ __device__ void init(int M, int N, int G_, int c_) { nM = M / BM; nN = N / BM; nwg = nM * nN; G = G_; c = c_; }
    __host__ __device__ bool next(int i, Unit& u) const {
        const long L = (long)i * G + c; if (L >= nwg) return false;
        int wgid = (int)L; { const int q = nwg / NXCD, r = nwg % NXCD, xcd = wgid % NXCD, off = wgid / NXCD; wgid = (xcd < r ? xcd * (q + 1) : r * (q + 1) + (xcd - r) * q) + off; }
        const int nig = WGM * nN, gid = wgid / nig, fm = gid * WGM, gsz = (nM - fm) < WGM ? (nM - fm) : WGM;
        u.pm = fm + ((wgid % nig) % gsz); u.pn = (wgid % nig) / gsz; return true;
    }
    __device__ __forceinline__ void a_ready(const Unit&) const {}
    __device__ __forceinline__ void done(const Unit&) const {}
};

__device__ __forceinline__ unsigned cvt_pk_bf16(float lo, float hi) { unsigned r; asm volatile("v_cvt_pk_bf16_f32 %0, %1, %2" : "=v"(r) : "v"(lo), "v"(hi)); return r; }
template <class Epi, class Sched, bool ALIGN_EPI = false, bool SP2 = false>
__device__ __forceinline__ void gemm_phase(PG8_LAS unsigned char* lds, const Gemm g, const Sched& S, const Epi& E) {
    const int tid = threadIdx.x, wid = __builtin_amdgcn_readfirstlane(tid >> 6), lane = tid & 63, wr = wid >> 2, wc = wid & 3, fr = lane & 15, fq = lane >> 4;
    const int K = g.K, nt = K / BK;
    unsigned voffA[2], voffB[2];
#pragma unroll
    for (int i = 0; i < 2; ++i) { int R, C; stage_rc(tid * 16 + i * 8192, R, C); const int Rb = Epi::PERM ? ((R & ~31) + perm32(R & 31)) : R;
        voffA[i] = (unsigned)(R * K + C) * 2u; voffB[i] = (unsigned)(Rb * K + C) * 2u; }
    const size_t kstep = (size_t)(BK * 2);
    const size_t hstep = (size_t)HALF * K * 2;
    const size_t tstep = 2 * hstep;
    const unsigned ldsw = (unsigned)wid * 1024u;
    const int aoff = lds_byte(wr * 64 + fr, fq * 8), boff = lds_byte(wc * 32 + fr, fq * 8);
#define PG8_SA(b, h) (((b) * 2 + (h)) * HTB)
#define PG8_SB(b, h) ((4 + (b) * 2 + (h)) * HTB)
#define PG8_STAGE(bufoff, gbase, voff) do { _Pragma("unroll") for (int _i = 0; _i < 2; ++_i) \
        __builtin_amdgcn_global_load_lds((const unsigned*)((const char*)(gbase) + (voff)[_i]), (PG8_LAS unsigned*)(lds + (bufoff) + ldsw + _i * 8192), 16, 0, 0); } while (0)
#define PG8_LDA(dst, b, h) do { _Pragma("unroll") for (int m = 0; m < 4; ++m) _Pragma("unroll") for (int k = 0; k < 2; ++k) dst[m][k] = *(const PG8_LAS bf16x8*)(lds + PG8_SA(b, h) + aoff + m * 2048 + k * 1024); } while (0)
#define PG8_LDB(dst, b, h) do { _Pragma("unroll") for (int n = 0; n < 2; ++n) _Pragma("unroll") for (int k = 0; k < 2; ++k) dst[n][k] = *(const PG8_LAS bf16x8*)(lds + PG8_SB(b, h) + boff + n * 2048 + k * 1024); } while (0)
#define PG8_MMA(ai, bj, At, Bt) do { __builtin_amdgcn_s_setprio(1); _Pragma("unroll") for (int m = 0; m < 4; ++m) _Pragma("unroll") for (int n = 0; n < 2; ++n) _Pragma("unroll") for (int k = 0; k < 2; ++k) \
        acc[ai][bj][m][n] = __builtin_amdgcn_mfma_f32_16x16x32_bf16(Bt[n][k], At[m][k], acc[ai][bj][m][n], 0, 0, 0); __builtin_amdgcn_s_setprio(0); } while (0)
#define PG8_WAIT_V(n) asm volatile("s_waitcnt vmcnt(" #n ")" ::: "memory")
#define PG8_WAIT_L(n) asm volatile("s_waitcnt lgkmcnt(" #n ")" ::: "memory")
#define PG8_BAR __builtin_amdgcn_s_barrier()
#define PG8_SCHED __builtin_amdgcn_sched_barrier(0)
    Unit cur, nxt; int ui = 0;
    if (!S.next(0, cur)) return;
    f32x4 acc[2][2][4][2];
#pragma unroll
    for (int a = 0; a < 2; ++a)
#pragma unroll
        for (int b = 0; b < 2; ++b)
#pragma unroll
            for (int m = 0; m < 4; ++m)
#pragma unroll
                for (int n = 0; n < 2; ++n) acc[a][b][m][n] = (f32x4){0.f, 0.f, 0.f, 0.f};
    bf16x8 At[4][2], B0[2][2], B1[2][2];
    const char* cA = (const char*)g.A + (size_t)cur.pm * tstep; const char* cB = (const char*)g.Bt + (size_t)cur.pn * tstep;
    S.a_ready(cur);
    if constexpr (SP2) {
        PG8_STAGE(PG8_SB(0, 0), cB, voffB); PG8_STAGE(PG8_SB(0, 1), cB + hstep, voffB); PG8_STAGE(PG8_SA(0, 0), cA, voffA); PG8_STAGE(PG8_SA(0, 1), cA + hstep, voffA);
        if (wr == 1) PG8_BAR;
        PG8_WAIT_V(2); PG8_BAR;
        PG8_STAGE(PG8_SB(1, 0), cB + kstep, voffB); PG8_STAGE(PG8_SA(1, 0), cA + kstep, voffA); PG8_STAGE(PG8_SB(1, 1), cB + hstep + kstep, voffB);
        PG8_WAIT_V(6); PG8_BAR;
    } else {
        PG8_STAGE(PG8_SB(0, 0), cB, voffB); PG8_STAGE(PG8_SA(0, 0), cA, voffA); PG8_STAGE(PG8_SB(0, 1), cB + hstep, voffB); PG8_STAGE(PG8_SA(0, 1), cA + hstep, voffA);
        if (wr == 1) PG8_BAR;
        PG8_WAIT_V(4); PG8_BAR;
        PG8_STAGE(PG8_SB(1, 0), cB + kstep, voffB); PG8_STAGE(PG8_SA(1, 0), cA + kstep, voffA); PG8_STAGE(PG8_SB(1, 1), cB + hstep + kstep, voffB);
        PG8_WAIT_V(6); PG8_BAR;
    }
    for (;;) {
        const bool has_next = S.next(ui + 1, nxt);
        const char* nA = has_next ? (const char*)g.A + (size_t)nxt.pm * tstep : cA; const char* nB = has_next ? (const char*)g.Bt + (size_t)nxt.pn * tstep : cB;
        for (int t = 0; t < nt; t += 2) {
            const bool last = (t == nt - 2);
            const char* a1 = cA + (size_t)(t + 1) * kstep;
            const char* a2 = last ? nA : cA + (size_t)(t + 2) * kstep; const char* b2 = last ? nB : cB + (size_t)(t + 2) * kstep;
            const char* a3 = a2 + kstep; const char* b3 = b2 + kstep;
            if (last && has_next) S.a_ready(nxt);
            if constexpr (SP2) {
            PG8_LDB(B0, 0, 0); PG8_LDB(B1, 0, 1); PG8_SCHED; PG8_LDA(At, 0, 0); PG8_STAGE(PG8_SA(1, 1), a1 + hstep, voffA);
            PG8_WAIT_V(8); PG8_WAIT_L(0); PG8_BAR; PG8_MMA(0, 0, At, B0); PG8_MMA(0, 1, At, B1); PG8_BAR; PG8_SCHED;
            PG8_LDA(At, 0, 1); PG8_STAGE(PG8_SB(0, 0), b2, voffB); PG8_STAGE(PG8_SB(0, 1), b2 + hstep, voffB); PG8_STAGE(PG8_SA(0, 0), a2, voffA);
            PG8_WAIT_V(8); PG8_WAIT_L(0); PG8_BAR; PG8_MMA(1, 0, At, B0); PG8_MMA(1, 1, At, B1); PG8_BAR; PG8_SCHED;
            PG8_LDB(B0, 1, 0); PG8_LDB(B1, 1, 1); PG8_SCHED; PG8_LDA(At, 1, 0); PG8_STAGE(PG8_SA(0, 1), a2 + hstep, voffA);
            PG8_WAIT_V(8); PG8_WAIT_L(0); PG8_BAR; PG8_MMA(0, 0, At, B0); PG8_MMA(0, 1, At, B1); PG8_BAR; PG8_SCHED;
            PG8_LDA(At, 1, 1); PG8_STAGE(PG8_SB(1, 0), b3, voffB); PG8_STAGE(PG8_SB(1, 1), b3 + hstep, voffB); PG8_STAGE(PG8_SA(1, 0), a3, voffA);
            PG8_WAIT_V(8); PG8_WAIT_L(0); PG8_BAR; PG8_MMA(1, 0, At, B0); PG8_MMA(1, 1, At, B1); PG8_BAR; PG8_SCHED;
            } else {
            PG8_LDB(B0, 0, 0); PG8_SCHED; PG8_LDA(At, 0, 0); PG8_STAGE(PG8_SA(1, 1), a1 + hstep, voffA);
            PG8_WAIT_L(8); PG8_BAR; PG8_WAIT_L(0); PG8_MMA(0, 0, At, B0); PG8_BAR; PG8_SCHED;
            PG8_LDB(B1, 0, 1); PG8_STAGE(PG8_SB(0, 0), b2, voffB);
            PG8_BAR; PG8_WAIT_L(0); PG8_MMA(0, 1, At, B1); PG8_BAR;
            PG8_LDA(At, 0, 1); PG8_STAGE(PG8_SA(0, 0), a2, voffA);
            PG8_BAR; PG8_WAIT_L(0); PG8_MMA(1, 0, At, B0); PG8_BAR; PG8_SCHED;
            PG8_STAGE(PG8_SB(0, 1), b2 + hstep, voffB);
            PG8_WAIT_V(6); PG8_BAR; PG8_MMA(1, 1, At, B1); PG8_BAR;
            PG8_LDB(B0, 1, 0); PG8_SCHED; PG8_LDA(At, 1, 0); PG8_STAGE(PG8_SA(0, 1), a2 + hstep, voffA);
            PG8_WAIT_L(8); PG8_BAR; PG8_WAIT_L(0); PG8_MMA(0, 0, At, B0); PG8_BAR; PG8_SCHED;
            PG8_LDB(B1, 1, 1); PG8_STAGE(PG8_SB(1, 0), b3, voffB);
            PG8_BAR; PG8_WAIT_L(0); PG8_MMA(0, 1, At, B1); PG8_BAR;
            PG8_LDA(At, 1, 1); PG8_STAGE(PG8_SA(1, 0), a3, voffA);
            PG8_BAR; PG8_WAIT_L(0); PG8_MMA(1, 0, At, B0); PG8_BAR; PG8_SCHED;
            PG8_STAGE(PG8_SB(1, 1), b3 + hstep, voffB);
            PG8_WAIT_V(6); PG8_BAR; PG8_MMA(1, 1, At, B1); PG8_BAR;
            }
        }
        if constexpr (ALIGN_EPI) { if (wr == 0) PG8_BAR; }
        if constexpr (!Epi::AFTER_DRAIN) { E(acc, cur, wr, wc, fr, fq); S.done(cur); }
        if (!has_next) break;
#pragma unroll
        for (int a = 0; a < 2; ++a)
#pragma unroll
            for (int b = 0; b < 2; ++b)
#pragma unroll
                for (int m = 0; m < 4; ++m)
#pragma unroll
                    for (int n = 0; n < 2; ++n) acc[a][b][m][n] = (f32x4){0.f, 0.f, 0.f, 0.f};
        cur = nxt; cA = nA; cB = nB; ++ui;
        if constexpr (ALIGN_EPI) { if (wr == 1) PG8_BAR; }
    }
    PG8_WAIT_V(0);
    if constexpr (!ALIGN_EPI) { if (wr == 0) PG8_BAR; }
    PG8_BAR;
    if constexpr (Epi::AFTER_DRAIN) { E.fused(acc, cur, wr, wc, fr, fq, lds, wid, lane); S.done(cur); }
#undef PG8_SA
#undef PG8_SB
#undef PG8_STAGE
#undef PG8_LDA
#undef PG8_LDB
#undef PG8_MMA
#undef PG8_WAIT_V
#undef PG8_WAIT_L
#undef PG8_BAR
#undef PG8_SCHED
}
}

#ifndef S5_SIMPLE
#define S5_SIMPLE 0
#endif
#ifndef MK_N_LAUNCHES
#define MK_N_LAUNCHES 1
#endif
constexpr int DM = 1024, PB_B = 8, PB_T = 2048, SB_B = 128, SB_T = 8;
constexpr int MP = PB_B * PB_T, MS = SB_B * SB_T, MTOK = MP + MS;
constexpr int S5W = 512, S5G = 32, S5C = 16, S5N = 64;
constexpr int HGW = 512, HD = 128, HH = 4;
constexpr int INC = 2560, DFF = 2816;
constexpr float EPS = 1e-6f;
constexpr int NPH = 9;
constexpr size_t O_Y = 0, O_PRE = (size_t)MTOK * DM, O_PIM = O_PRE + 16384, O_PHG = O_PIM + 16384, O_SRE = O_PHG + 524288, O_SIM = O_SRE + 262144, O_SHG = O_SIM + 262144;
constexpr size_t MiB = 1u << 20;
constexpr size_t WS_CTL = 0, WS_WIN = 2 * MiB, WS_WGLU = 7 * MiB, WS_WOUT = 8 * MiB, WS_WGU = 10 * MiB, WS_WD = 21 * MiB;
constexpr size_t WS_XN = 27 * MiB, WS_PB = 61 * MiB, WS_FZ = 129 * MiB, WS_ACT = 61 * MiB, WS_GY = 163 * MiB, WS_OH = 180 * MiB, WS_MIX = 197 * MiB, WS_END = 231 * MiB;
constexpr int PBW = 2048;
constexpr int LDS_BYTES = 147456;
constexpr int NWAVES = 8;

#define GAS __attribute__((address_space(1)))
#define LAS __attribute__((address_space(3)))
typedef unsigned short bf16;
typedef unsigned v4u __attribute__((ext_vector_type(4)));
typedef unsigned v2u __attribute__((ext_vector_type(2)));
typedef float f32x4 __attribute__((ext_vector_type(4)));
#define LDS_WAIT() asm volatile("s_waitcnt lgkmcnt(0)" ::: "memory")
__device__ __forceinline__ unsigned f2bf(float f) { unsigned u = __builtin_bit_cast(unsigned, f); return (u + 0x7fffu + ((u >> 16) & 1u)) >> 16; }
__device__ __forceinline__ unsigned pk2(float lo, float hi) { return f2bf(lo) | (f2bf(hi) << 16); }
__device__ __forceinline__ float bf2f(unsigned short h) { return __builtin_bit_cast(float, (unsigned)h << 16); }
__device__ __forceinline__ float bflo(unsigned w) { return __builtin_bit_cast(float, w << 16); }
__device__ __forceinline__ float bfhi(unsigned w) { return __builtin_bit_cast(float, w & 0xffff0000u); }
__device__ __forceinline__ float sigmoidf_(float x) { return 1.0f / (1.0f + __expf(-x)); }
__device__ __forceinline__ float siluf_(float x) { return x / (1.0f + __expf(-x)); }
__device__ __forceinline__ float gelu_tanh(float x) { const float z = 1.5957691216057308f * (x + 0.044715f * x * x * x); return x / (1.0f + __expf(-z)); }
__device__ __forceinline__ float wave_sum(float v) {
#pragma unroll
    for (int o = 1; o < 64; o <<= 1) v += __shfl_xor(v, o);
    return v;
}

struct Args { const float* in[24]; float* out; unsigned char* ws; int ph_lo, ph_hi; };

struct Frame {
    LAS unsigned char* lds;
    int tid, lane, wave, G, bid;
    const float* in[24];
    float* out; unsigned char* ws;
};
__device__ __forceinline__ const float* xrow(const Frame& F, int m) { return m < MP ? F.in[0] + (size_t)m * DM : F.in[1] + (size_t)(m - MP) * DM; }

__device__ __forceinline__ void transpose_item(const float* W, int ldw, bf16* WT, int K, int k0, int sn0, int dn0, LAS float* scr, int lane) {
#pragma unroll 8
    for (int i = 0; i < 32; ++i) { const int kk = 2 * i + (lane >> 5); scr[kk * 33 + (lane & 31)] = W[(size_t)(k0 + kk) * ldw + sn0 + (lane & 31)]; }
    LDS_WAIT(); asm volatile("" ::: "memory");
    const int c = lane & 7;
#pragma unroll
    for (int j = 0; j < 4; ++j) { const int n = (lane >> 3) + 8 * j; const LAS float* s = scr + (8 * c) * 33 + n;
        v4u o; o.x = pk2(s[0 * 33], s[1 * 33]); o.y = pk2(s[2 * 33], s[3 * 33]); o.z = pk2(s[4 * 33], s[5 * 33]); o.w = pk2(s[6 * 33], s[7 * 33]);
        *(GAS v4u*)(WT + (size_t)(dn0 + n) * K + k0 + 8 * c) = o; }
    LDS_WAIT(); asm volatile("" ::: "memory");
}
__device__ __forceinline__ void rms_row_bf16(const float* xr_, const float* gain, bf16* orow, int lane) {
    const GAS f32x4* xr = (const GAS f32x4*)xr_ + lane;
    f32x4 v[4]; float s = 0.f;
#pragma unroll
    for (int j = 0; j < 4; ++j) { v[j] = xr[64 * j]; s += (v[j].x * v[j].x + v[j].y * v[j].y) + (v[j].z * v[j].z + v[j].w * v[j].w); }
    const float rstd = 1.0f / sqrtf(wave_sum(s) * (1.0f / DM) + EPS);
    GAS v2u* o8 = (GAS v2u*)orow + lane;
#pragma unroll
    for (int j = 0; j < 4; ++j) { const f32x4 g = ((const GAS f32x4*)gain)[lane + 64 * j]; v2u w; w.x = pk2(v[j].x * rstd * g.x, v[j].y * rstd * g.y); w.y = pk2(v[j].z * rstd * g.z, v[j].w * rstd * g.w); o8[64 * j] = w; }
}

__device__ __forceinline__ void p0_prologue(Frame& F) {
    LAS float* scr = (LAS float*)(F.lds + F.wave * 16384);
    const int gw = F.bid * NWAVES + F.wave, NGW = F.G * NWAVES;
    bf16* WinT = (bf16*)(F.ws + WS_WIN); bf16* WgluT = (bf16*)(F.ws + WS_WGLU); bf16* WoutT = (bf16*)(F.ws + WS_WOUT); bf16* WguT = (bf16*)(F.ws + WS_WGU); bf16* WdT = (bf16*)(F.ws + WS_WD);
    constexpr int I_IN = (DM / 64) * (INC / 32), I_GLU = (S5W / 64) * (S5W / 32), I_OUT = (DM / 64) * (DM / 32), I_G = (DM / 64) * (DFF / 32), I_D = (DFF / 64) * (DM / 32);
    constexpr int NITEMS = I_IN + I_GLU + I_OUT + 2 * I_G + I_D;
    for (int it = gw; it < NITEMS; it += NGW) {
        int r = it;
        if (r < I_IN) { const int nblk = INC / 32, kb = r / nblk, nb = r % nblk, sn0 = nb * 32; const int seg = sn0 / 512, off = sn0 % 512;
            const int dseg = seg == 0 ? 0 : seg == 1 ? 1 : seg == 2 ? 4 : seg == 3 ? 2 : 3;
            transpose_item(F.in[7], INC, WinT, DM, kb * 64, sn0, dseg * 512 + off, scr, F.lane); continue; } r -= I_IN;
        if (r < I_GLU) { const int nblk = S5W / 32, kb = r / nblk, nb = r % nblk; transpose_item(F.in[16], S5W, WgluT, S5W, kb * 64, nb * 32, nb * 32, scr, F.lane); continue; } r -= I_GLU;
        if (r < I_OUT) { const int nblk = DM / 32, kb = r / nblk, nb = r % nblk; transpose_item(F.in[18], DM, WoutT, DM, kb * 64, nb * 32, nb * 32, scr, F.lane); continue; } r -= I_OUT;
        if (r < I_G) { const int nblk = DFF / 32, kb = r / nblk, nb = r % nblk, sn0 = nb * 32; transpose_item(F.in[20], DFF, WguT, DM, kb * 64, sn0, 256 * (sn0 / 128) + (sn0 % 128), scr, F.lane); continue; } r -= I_G;
        if (r < I_G) { const int nblk = DFF / 32, kb = r / nblk, nb = r % nblk, sn0 = nb * 32; transpose_item(F.in[21], DFF, WguT, DM, kb * 64, sn0, 256 * (sn0 / 128) + 128 + (sn0 % 128), scr, F.lane); continue; } r -= I_G;
        { const int nblk = DM / 32, kb = r / nblk, nb = r % nblk; transpose_item(F.in[22], DM, WdT, DFF, kb * 64, nb * 32, nb * 32, scr, F.lane); }
    }
    bf16* XN = (bf16*)(F.ws + WS_XN);
    for (int m = gw; m < MTOK; m += NGW) rms_row_bf16(xrow(F, m), F.in[6], XN + (size_t)m * DM, F.lane);
}

using pg8::Unit; using pg8::u32x4; using pg8::cvt_pk_bf16; using pg8::BM; using pg8::HALF;
struct EpiIn {
    static constexpr bool PERM = true, AFTER_DRAIN = false;
    bf16* PB; float* FZ;
    __device__ __forceinline__ void operator()(const pg8::f32x4 (&acc)[2][2][4][2], const Unit& u, int wr, int wc, int fr, int fq) const {
        const int row0 = u.pm * BM + wr * 64 + fr;
        if (u.pn < 8) { const int col0 = u.pn * BM + wc * 32 + 8 * fq;
#pragma unroll
            for (int ai = 0; ai < 2; ++ai)
#pragma unroll
                for (int m = 0; m < 4; ++m) { bf16* rowp = PB + (size_t)(row0 + ai * HALF + m * 16) * PBW + col0;
#pragma unroll
                    for (int bj = 0; bj < 2; ++bj) { const pg8::f32x4 v0 = acc[ai][bj][m][0], v1 = acc[ai][bj][m][1]; u32x4 w; w.x = cvt_pk_bf16(v0[0], v0[1]); w.y = cvt_pk_bf16(v0[2], v0[3]); w.z = cvt_pk_bf16(v1[0], v1[1]); w.w = cvt_pk_bf16(v1[2], v1[3]);
                        *(u32x4*)(rowp + bj * HALF) = w; } }
        } else { const int col0 = (u.pn - 8) * BM + wc * 32 + 8 * fq;
#pragma unroll
            for (int ai = 0; ai < 2; ++ai)
#pragma unroll
                for (int m = 0; m < 4; ++m) { float* rowp = FZ + (size_t)(row0 + ai * HALF + m * 16) * 512 + col0;
#pragma unroll
                    for (int bj = 0; bj < 2; ++bj)
#pragma unroll
                        for (int n = 0; n < 2; ++n) *(pg8::f32x4*)(rowp + bj * HALF + 4 * n) = acc[ai][bj][m][n]; }
        }
    }
};
struct EpiGlu {
    static constexpr bool PERM = true, AFTER_DRAIN = false;
    const bf16* GY; bf16* MIX;
    __device__ __forceinline__ void operator()(const pg8::f32x4 (&acc)[2][2][4][2], const Unit& u, int wr, int wc, int fr, int fq) const {
        const int row0 = u.pm * BM + wr * 64 + fr, col0 = u.pn * BM + wc * 32 + 8 * fq;
#pragma unroll
        for (int ai = 0; ai < 2; ++ai)
#pragma unroll
            for (int m = 0; m < 4; ++m) { const size_t r = (size_t)(row0 + ai * HALF + m * 16);
#pragma unroll
                for (int bj = 0; bj < 2; ++bj) { const u32x4 g = *(const u32x4*)(GY + r * 512 + col0 + bj * HALF); const pg8::f32x4 v0 = acc[ai][bj][m][0], v1 = acc[ai][bj][m][1];
                    u32x4 w; w.x = cvt_pk_bf16(bflo(g.x) * sigmoidf_(v0[0]), bfhi(g.x) * sigmoidf_(v0[1])); w.y = cvt_pk_bf16(bflo(g.y) * sigmoidf_(v0[2]), bfhi(g.y) * sigmoidf_(v0[3]));
                    w.z = cvt_pk_bf16(bflo(g.z) * sigmoidf_(v1[0]), bfhi(g.z) * sigmoidf_(v1[1])); w.w = cvt_pk_bf16(bflo(g.w) * sigmoidf_(v1[2]), bfhi(g.w) * sigmoidf_(v1[3]));
                    *(u32x4*)(MIX + r * DM + col0 + bj * HALF) = w; } }
    }
};
struct EpiOut {
    static constexpr bool PERM = false, AFTER_DRAIN = false;
    const float* xp; const float* xs; float* Y;
    __device__ __forceinline__ void operator()(const pg8::f32x4 (&acc)[2][2][4][2], const Unit& u, int wr, int wc, int fr, int fq) const {
        const int row0 = u.pm * BM + wr * 64 + fr, col0 = u.pn * BM + wc * 32 + 4 * fq;
        const float* xb = (u.pm < MP / BM) ? xp : xs - (size_t)MP * DM;
#pragma unroll
        for (int ai = 0; ai < 2; ++ai)
#pragma unroll
            for (int m = 0; m < 4; ++m) { const size_t off = (size_t)(row0 + ai * HALF + m * 16) * DM + col0;
#pragma unroll
                for (int bj = 0; bj < 2; ++bj)
#pragma unroll
                    for (int n = 0; n < 2; ++n) { const pg8::f32x4 xv = *(const pg8::f32x4*)(xb + off + bj * HALF + n * 16); *(pg8::f32x4*)(Y + off + bj * HALF + n * 16) = xv + acc[ai][bj][m][n]; } }
    }
};
struct EpiAct {
    static constexpr bool PERM = true, AFTER_DRAIN = false;
    bf16* ACT;
    __device__ __forceinline__ void operator()(const pg8::f32x4 (&acc)[2][2][4][2], const Unit& u, int wr, int wc, int fr, int fq) const {
        const int row0 = u.pm * BM + wr * 64 + fr, col0 = u.pn * HALF + wc * 32 + 8 * fq;
#pragma unroll
        for (int ai = 0; ai < 2; ++ai)
#pragma unroll
            for (int m = 0; m < 4; ++m) { const pg8::f32x4 g0 = acc[ai][0][m][0], g1 = acc[ai][0][m][1], u0 = acc[ai][1][m][0], u1 = acc[ai][1][m][1];
                u32x4 w; w.x = cvt_pk_bf16(siluf_(g0[0]) * u0[0], siluf_(g0[1]) * u0[1]); w.y = cvt_pk_bf16(siluf_(g0[2]) * u0[2], siluf_(g0[3]) * u0[3]);
                w.z = cvt_pk_bf16(siluf_(g1[0]) * u1[0], siluf_(g1[1]) * u1[1]); w.w = cvt_pk_bf16(siluf_(g1[2]) * u1[2], siluf_(g1[3]) * u1[3]);
                *(u32x4*)(ACT + (size_t)(row0 + ai * HALF + m * 16) * DFF + col0) = w; }
    }
};
struct EpiDown {
    static constexpr bool PERM = false, AFTER_DRAIN = false;
    float* Y;
    __device__ __forceinline__ void operator()(const pg8::f32x4 (&acc)[2][2][4][2], const Unit& u, int wr, int wc, int fr, int fq) const {
        const int row0 = u.pm * BM + wr * 64 + fr, col0 = u.pn * BM + wc * 32 + 4 * fq;
#pragma unroll
        for (int ai = 0; ai < 2; ++ai)
#pragma unroll
            for (int m = 0; m < 4; ++m) { const size_t off = (size_t)(row0 + ai * HALF + m * 16) * DM + col0;
#pragma unroll
                for (int bj = 0; bj < 2; ++bj)
#pragma unroll
                    for (int n = 0; n < 2; ++n) { float* p = Y + off + bj * HALF + n * 16; const pg8::f32x4 xv = *(const pg8::f32x4*)p; *(pg8::f32x4*)p = xv + acc[ai][bj][m][n]; } }
    }
};

__device__ __forceinline__ void s5_simple_item(Frame& F, int item) {
    const int lane = F.lane, n = lane;
    int g, tokbase, T; const float* h0r = nullptr; const float* h0i = nullptr; float* outr; float* outi;
    if (item < PB_B * S5G) { const int b = item / S5G; g = item % S5G; tokbase = b * PB_T; T = PB_T; outr = F.out + O_PRE + (size_t)item * S5N; outi = F.out + O_PIM + (size_t)item * S5N; }
    else { const int idx = item - PB_B * S5G, b = idx / S5G; g = idx % S5G; tokbase = MP + b * SB_T; T = SB_T; h0r = F.in[2] + (size_t)idx * S5N; h0i = F.in[3] + (size_t)idx * S5N; outr = F.out + O_SRE + (size_t)idx * S5N; outi = F.out + O_SIM + (size_t)idx * S5N; }
    const float a_re = F.in[8][g * S5N + n], a_im = F.in[9][g * S5N + n], dt = expf(F.in[10][g]);
    const float mag = expf(a_re * dt), ab_re = mag * cosf(a_im * dt), ab_im = mag * sinf(a_im * dt);
    const float den = a_re * a_re + a_im * a_im, nr = ab_re - 1.0f, ni = ab_im;
    const float f_re = (nr * a_re + ni * a_im) / den, f_im = (ni * a_re - nr * a_im) / den;
    float Bre[16], Bim[16], Cre[16], Cim[16];
#pragma unroll
    for (int c = 0; c < 16; ++c) { const float br = F.in[11][(size_t)(g * S5N + n) * 16 + c], bi = F.in[12][(size_t)(g * S5N + n) * 16 + c];
        Bre[c] = f_re * br - f_im * bi; Bim[c] = f_re * bi + f_im * br;
        Cre[c] = F.in[13][(size_t)(g * 16 + c) * S5N + n]; Cim[c] = F.in[14][(size_t)(g * 16 + c) * S5N + n]; }
    const float dl = F.in[15][g * 16 + (lane & 15)];
    float h_re = h0r ? h0r[n] : 0.f, h_im = h0i ? h0i[n] : 0.f;
    const bf16* PB = (const bf16*)(F.ws + WS_PB); bf16* GY = (bf16*)(F.ws + WS_GY);
    for (int t = 0; t < T; ++t) {
        const float uv = bf2f(PB[(size_t)(tokbase + t) * PBW + g * 16 + (lane & 15)]);
        float bu_re = 0.f, bu_im = 0.f;
#pragma unroll
        for (int c = 0; c < 16; ++c) { const float uc = __shfl(uv, c); bu_re += Bre[c] * uc; bu_im += Bim[c] * uc; }
        const float nre = ab_re * h_re - ab_im * h_im + bu_re, nim = ab_re * h_im + ab_im * h_re + bu_im;
        h_re = nre; h_im = nim;
        float yv = 0.f;
#pragma unroll
        for (int c = 0; c < 16; ++c) { const float p = wave_sum(Cre[c] * h_re - Cim[c] * h_im); yv = ((lane & 15) == c) ? p : yv; }
        const float y = yv + dl * uv;
        if (lane < 16) GY[(size_t)(tokbase + t) * S5W + g * 16 + lane] = (bf16)f2bf(gelu_tanh(y));
    }
    outr[n] = h_re; outi[n] = h_im;
}
typedef float f32x16 __attribute__((ext_vector_type(16)));
typedef short s16x8 __attribute__((ext_vector_type(8)));
constexpr int S5_LD = 136;
constexpr int L5_WG = 0, L5_VG = 34816, L5_KC = 69632, L5_U = 74240, L5_HS = 91648, L5_HL = 109056, L5_PW = 141824;
__device__ __forceinline__ void s5_fast_item(Frame& F, int item) {
    const int tid = F.tid, lane = F.lane, wave = F.wave;
    const int g = item & 31, b8 = item >> 5;
    LAS bf16* WgT = (LAS bf16*)(F.lds + L5_WG); LAS bf16* VgT = (LAS bf16*)(F.lds + L5_VG); LAS bf16* Kc = (LAS bf16*)(F.lds + L5_KC);
    LAS bf16* Us = (LAS bf16*)(F.lds + L5_U); LAS bf16* HS = (LAS bf16*)(F.lds + L5_HS); LAS float* HL = (LAS float*)(F.lds + L5_HL);
    LAS float* Pre = (LAS float*)(F.lds + L5_PW); LAS float* Pim = Pre + 9 * 64;
    LAS float* Cre = HL, * Cim = HL + 1024, * Bre = HL + 2048, * Bim = HL + 3072; LAS float* Ff = HL + 4096;
    if (tid < 64) { const int n = tid;
        const float a_re = F.in[8][g * S5N + n], a_im = F.in[9][g * S5N + n], dt = expf(F.in[10][g]);
        const float mag = expf(a_re * dt), ab_re = mag * cosf(a_im * dt), ab_im = mag * sinf(a_im * dt);
        const float den = a_re * a_re + a_im * a_im, nr = ab_re - 1.0f, ni = ab_im;
        Ff[n] = (nr * a_re + ni * a_im) / den; Ff[64 + n] = (ni * a_re - nr * a_im) / den;
        float pr = 1.f, pi = 0.f;
#pragma unroll
        for (int j = 0; j < 9; ++j) { Pre[j * 64 + n] = pr; Pim[j * 64 + n] = pi; const float t = pr * ab_re - pi * ab_im; pi = pr * ab_im + pi * ab_re; pr = t; }
    }
    __syncthreads();
#pragma unroll
    for (int i = 0; i < 2; ++i) { const int idx = tid + 512 * i;
        { const int c = idx >> 6, n = idx & 63; Cre[c * 64 + n] = F.in[13][(size_t)(g * 16 + c) * S5N + n]; Cim[c * 64 + n] = F.in[14][(size_t)(g * 16 + c) * S5N + n]; }
        { const int n = idx >> 4, c = idx & 15; const float br = F.in[11][(size_t)(g * S5N + n) * 16 + c], bi = F.in[12][(size_t)(g * S5N + n) * 16 + c], fr = Ff[n], fi = Ff[64 + n];
          Bre[n * 16 + c] = fr * br - fi * bi; Bim[n * 16 + c] = fr * bi + fi * br; } }
    __syncthreads();
#pragma unroll 1
    for (int i = 0; i < 4; ++i) { const int idx = tid + 512 * i, j = idx >> 8, c = (idx >> 4) & 15, cp = idx & 15; float acc = 0.f;
        for (int n = 0; n < 64; ++n) { const float cr = Cre[c * 64 + n], ci = Cim[c * 64 + n], pr = Pre[j * 64 + n], pi = Pim[j * 64 + n];
            const float xr = cr * pr - ci * pi, xi = cr * pi + ci * pr; acc += xr * Bre[n * 16 + cp] - xi * Bim[n * 16 + cp]; }
        Kc[idx] = (bf16)f2bf(acc); }
    if (tid < 256) Kc[2048 + tid] = 0;
#pragma unroll 4
    for (int i = 0; i < 32; ++i) { const int idx = tid + 512 * i, np = idx >> 7, k = idx & 127, s = k >> 4, cp = k & 15, n = np & 63;
        const float pr = Pre[(7 - s) * 64 + n], pi = Pim[(7 - s) * 64 + n], br = Bre[n * 16 + cp], bi = Bim[n * 16 + cp];
        WgT[np * S5_LD + k] = (bf16)f2bf(np < 64 ? pr * br - pi * bi : pr * bi + pi * br); }
#pragma unroll 4
    for (int i = 0; i < 32; ++i) { const int idx = tid + 512 * i, col = idx >> 7, np = idx & 127, t = col >> 4, c = col & 15, n = np & 63;
        const float pr = Pre[(t + 1) * 64 + n], pi = Pim[(t + 1) * 64 + n], cr = Cre[c * 64 + n], ci = Cim[c * 64 + n];
        VgT[col * S5_LD + np] = (bf16)f2bf(np < 64 ? cr * pr - ci * pi : -(cr * pi + ci * pr)); }
    __syncthreads();
    const bf16* PB = (const bf16*)(F.ws + WS_PB); bf16* GY = (bf16*)(F.ws + WS_GY);
    const int rb = wave >> 2, cb = wave & 3, r32 = lane & 31, hh = lane >> 5;
    float h_re = 0.f, h_im = 0.f;
    const float p8r = Pre[8 * 64 + lane], p8i = Pim[8 * 64 + lane];
    const float dl = F.in[15][g * 16 + (lane & 15)];
    for (int seg = 0; seg < 5; ++seg) {
        const bool samp = (seg == 4);
        const int tok0 = samp ? MP + 128 * b8 : b8 * PB_T + seg * 512;
        const int ntok = samp ? 128 : 512;
        if (tid < ntok) { const v4u* src = (const v4u*)(PB + (size_t)(tok0 + tid) * PBW + g * 16); const v4u a = src[0], b = src[1];
            LAS v4u* dst = (LAS v4u*)(Us + (tid >> 3) * S5_LD + (tid & 7) * 16); dst[0] = a; dst[1] = b; }
        __syncthreads();
        { f32x16 acc = {};
#pragma unroll
          for (int s = 0; s < 8; ++s) { const s16x8 a = *(const LAS s16x8*)(Us + (32 * rb + r32) * S5_LD + s * 16 + 8 * hh); const s16x8 b = *(const LAS s16x8*)(WgT + (32 * cb + r32) * S5_LD + s * 16 + 8 * hh);
              acc = __builtin_amdgcn_mfma_f32_32x32x16_bf16(a, b, acc, 0, 0, 0); }
#pragma unroll
          for (int r = 0; r < 16; ++r) HL[(32 * rb + (r & 3) + 8 * (r >> 2) + 4 * hh) * 128 + 32 * cb + r32] = acc[r]; }
        __syncthreads();
        if (wave == 0) {
            if (!samp) {
#pragma unroll 8
                for (int c = 0; c < 64; ++c) { const float xr = HL[c * 128 + lane], xi = HL[c * 128 + 64 + lane];
                    HS[c * S5_LD + lane] = (bf16)f2bf(h_re); HS[c * S5_LD + 64 + lane] = (bf16)f2bf(h_im);
                    const float nr = p8r * h_re - p8i * h_im + xr, ni = p8r * h_im + p8i * h_re + xi; h_re = nr; h_im = ni; }
                if (seg == 3) { F.out[O_PRE + (size_t)(b8 * S5G + g) * S5N + lane] = h_re; F.out[O_PIM + (size_t)(b8 * S5G + g) * S5N + lane] = h_im; }
            } else {
#pragma unroll 4
                for (int r = 0; r < 16; ++r) { const size_t idx = (size_t)((16 * b8 + r) * S5G + g) * S5N + lane; const float sr = F.in[2][idx], si = F.in[3][idx];
                    HS[r * S5_LD + lane] = (bf16)f2bf(sr); HS[r * S5_LD + 64 + lane] = (bf16)f2bf(si);
                    F.out[O_SRE + idx] = p8r * sr - p8i * si + HL[r * 128 + lane]; F.out[O_SIM + idx] = p8r * si + p8i * sr + HL[r * 128 + 64 + lane]; }
            }
        }
        __syncthreads();
        if (!(samp && rb == 1)) { f32x16 acc = {};
            const int tl = 2 * cb + ((lane >> 4) & 1), c = lane & 15;
#pragma unroll
            for (int s = 0; s < 8; ++s) if (s <= 2 * cb + 1) { const int j = tl - s, jj = j < 0 ? 8 : j;
                const s16x8 a = *(const LAS s16x8*)(Us + (32 * rb + r32) * S5_LD + s * 16 + 8 * hh); const s16x8 b = *(const LAS s16x8*)(Kc + (jj * 16 + c) * 16 + 8 * hh);
                acc = __builtin_amdgcn_mfma_f32_32x32x16_bf16(a, b, acc, 0, 0, 0); }
#pragma unroll
            for (int kb = 0; kb < 8; ++kb) { const s16x8 a = *(const LAS s16x8*)(HS + (32 * rb + r32) * S5_LD + kb * 16 + 8 * hh); const s16x8 b = *(const LAS s16x8*)(VgT + (32 * cb + r32) * S5_LD + kb * 16 + 8 * hh);
                acc = __builtin_amdgcn_mfma_f32_32x32x16_bf16(a, b, acc, 0, 0, 0); }
#pragma unroll
            for (int r = 0; r < 16; ++r) { const int row = 32 * rb + (r & 3) + 8 * (r >> 2) + 4 * hh;
                if (!samp || row < 16) { const float u = bf2f(Us[row * S5_LD + tl * 16 + c]); const float y = acc[r] + dl * u;
                    GY[(size_t)(tok0 + row * 8 + tl) * S5W + g * 16 + c] = (bf16)f2bf(gelu_tanh(y)); } }
        }
        __syncthreads();
    }
}
__device__ __forceinline__ void hgrn_simple_item(Frame& F, int item) {
    const int tid = F.tid, v = tid & 127, kq = tid >> 7;
    int h, tokbase, T; const float* S0 = nullptr; float* Sout;
    if (item < PB_B * HH) { const int b = item / HH; h = item % HH; tokbase = b * PB_T; T = PB_T; Sout = F.out + O_PHG + (size_t)item * HD * HD; }
    else { const int idx = item - PB_B * HH, b = idx / HH; h = idx % HH; tokbase = MP + b * SB_T; T = SB_T; S0 = F.in[4] + (size_t)idx * HD * HD; Sout = F.out + O_SHG + (size_t)idx * HD * HD; }
    float S[32];
#pragma unroll
    for (int j = 0; j < 32; ++j) S[j] = S0 ? S0[(size_t)(32 * kq + j) * HD + v] : 0.f;
    LAS float* Fs = (LAS float*)F.lds;
    LAS float* Ks = Fs + 1024;
    LAS float* Qs = Ks + 1024;
    LAS float* Vs = Qs + 1024;
    LAS float* OP = Vs + 1024;
    const bf16* PB = (const bf16*)(F.ws + WS_PB); const float* FZ = (const float*)(F.ws + WS_FZ); bf16* OH = (bf16*)(F.ws + WS_OH);
    float lb = 0.f;
    if (tid < 128) { const int col = h * HD + tid; lb = 1.0f / (1.0f + expf(F.in[5][512 + col] - F.in[5][col])); }
    for (int t0 = 0; t0 < T; t0 += 8) {
        if (tid < 128) {
#pragma unroll
            for (int tt = 0; tt < 8; ++tt) { const size_t tok = (size_t)(tokbase + t0 + tt); const float fz = FZ[tok * 512 + h * HD + tid];
                const float sg = 1.0f / (1.0f + expf(-fz)), f = lb + (1.0f - lb) * sg;
                Fs[tt * 128 + tid] = f; Ks[tt * 128 + tid] = 1.0f - f; Qs[tt * 128 + tid] = bf2f(PB[tok * PBW + 512 + h * HD + tid]); }
        } else if (tid < 256) { const int vv = tid - 128;
#pragma unroll
            for (int tt = 0; tt < 8; ++tt) Vs[tt * 128 + vv] = bf2f(PB[(size_t)(tokbase + t0 + tt) * PBW + 1024 + h * HD + vv]);
        }
        __syncthreads();
#pragma unroll 1
        for (int tt = 0; tt < 8; ++tt) { const float iv = Vs[tt * 128 + v]; float o = 0.f;
#pragma unroll
            for (int j = 0; j < 32; j += 4) { const f32x4 f4 = *(const LAS f32x4*)(Fs + tt * 128 + 32 * kq + j), k4 = *(const LAS f32x4*)(Ks + tt * 128 + 32 * kq + j), q4 = *(const LAS f32x4*)(Qs + tt * 128 + 32 * kq + j);
                S[j] = f4.x * S[j] + k4.x * iv; o += S[j] * q4.x; S[j + 1] = f4.y * S[j + 1] + k4.y * iv; o += S[j + 1] * q4.y;
                S[j + 2] = f4.z * S[j + 2] + k4.z * iv; o += S[j + 2] * q4.z; S[j + 3] = f4.w * S[j + 3] + k4.w * iv; o += S[j + 3] * q4.w; }
            OP[(tt * 4 + kq) * 128 + v] = o; }
        __syncthreads();
#pragma unroll
        for (int r = 0; r < 2; ++r) { const int idx = tid + 512 * r, tt = idx >> 7, vv = idx & 127;
            const float o = (OP[(tt * 4 + 0) * 128 + vv] + OP[(tt * 4 + 1) * 128 + vv]) + (OP[(tt * 4 + 2) * 128 + vv] + OP[(tt * 4 + 3) * 128 + vv]);
            OH[(size_t)(tokbase + t0 + tt) * HGW + h * HD + vv] = (bf16)f2bf(o); }
        __syncthreads();
    }
#pragma unroll
    for (int j = 0; j < 32; ++j) Sout[(size_t)(32 * kq + j) * HD + v] = S[j];
}

__device__ __forceinline__ void hg_normgate_row(Frame& F, int tok) {
    const int lane = F.lane;
    const bf16* OH = (const bf16*)(F.ws + WS_OH); const bf16* PB = (const bf16*)(F.ws + WS_PB); bf16* MIX = (bf16*)(F.ws + WS_MIX);
    const v4u o8 = *(const GAS v4u*)(OH + (size_t)tok * HGW + 8 * lane);
    const v4u g8 = *(const GAS v4u*)(PB + (size_t)tok * PBW + 1536 + 8 * lane);
    float o[8] = {bflo(o8.x), bfhi(o8.x), bflo(o8.y), bfhi(o8.y), bflo(o8.z), bfhi(o8.z), bflo(o8.w), bfhi(o8.w)};
    float gt[8] = {bflo(g8.x), bfhi(g8.x), bflo(g8.y), bfhi(g8.y), bflo(g8.z), bfhi(g8.z), bflo(g8.w), bfhi(g8.w)};
    float ss = 0.f;
#pragma unroll
    for (int j = 0; j < 8; ++j) ss += o[j] * o[j];
    ss += __shfl_xor(ss, 1); ss += __shfl_xor(ss, 2); ss += __shfl_xor(ss, 4); ss += __shfl_xor(ss, 8);
    const float rstd = 1.0f / sqrtf(ss * (1.0f / HD) + EPS);
    const f32x4 n0 = *(const GAS f32x4*)(F.in[17] + ((8 * lane) & 127)), n1 = *(const GAS f32x4*)(F.in[17] + ((8 * lane) & 127) + 4);
    const float gn[8] = {n0.x, n0.y, n0.z, n0.w, n1.x, n1.y, n1.z, n1.w};
    float r[8];
#pragma unroll
    for (int j = 0; j < 8; ++j) r[j] = o[j] * rstd * gn[j] * siluf_(gt[j]);
    v4u w; w.x = pk2(r[0], r[1]); w.y = pk2(r[2], r[3]); w.z = pk2(r[4], r[5]); w.w = pk2(r[6], r[7]);
    *(GAS v4u*)(MIX + (size_t)tok * DM + 512 + 8 * lane) = w;
}
__device__ __forceinline__ void final_norm_row(Frame& F, int m) {
    GAS f32x4* xr = (GAS f32x4*)(F.out + O_Y + (size_t)m * DM) + F.lane;
    f32x4 v[4]; float s = 0.f;
#pragma unroll
    for (int j = 0; j < 4; ++j) { v[j] = xr[64 * j]; s += (v[j].x * v[j].x + v[j].y * v[j].y) + (v[j].z * v[j].z + v[j].w * v[j].w); }
    const float rstd = 1.0f / sqrtf(wave_sum(s) * (1.0f / DM) + EPS);
#pragma unroll
    for (int j = 0; j < 4; ++j) { const f32x4 g = ((const GAS f32x4*)F.in[23])[F.lane + 64 * j]; f32x4 o; o.x = v[j].x * rstd * g.x; o.y = v[j].y * rstd * g.y; o.z = v[j].z * rstd * g.z; o.w = v[j].w * rstd * g.w; xr[64 * j] = o; }
}

__global__ void __launch_bounds__(NWAVES * 64, 2) mk_fwd(Args args) {
    extern __shared__ __attribute__((aligned(16))) unsigned char lds[];
    Frame F;
    F.lds = (LAS unsigned char*)lds;
    F.tid = threadIdx.x; F.lane = F.tid & 63; F.wave = __builtin_amdgcn_readfirstlane(F.tid >> 6);
    F.G = gridDim.x; F.bid = blockIdx.x;
#pragma unroll
    for (int i = 0; i < 24; ++i) F.in[i] = args.in[i];
    F.out = args.out; F.ws = args.ws;
    const int lo = args.ph_lo, hi = args.ph_hi;
#define IN(k) (lo <= (k) && (k) < hi)
#if MK_N_LAUNCHES == 1
    cg::grid_group grid = cg::this_grid();
#define SEAM(k) do { if (IN(k) && IN((k) + 1)) grid.sync(); } while (0)
#else
#define SEAM(k) do { } while (0)
#endif
    const int gw = F.bid * NWAVES + F.wave, NGW = F.G * NWAVES;
    bf16* XN = (bf16*)(F.ws + WS_XN); bf16* PB = (bf16*)(F.ws + WS_PB); float* FZ = (float*)(F.ws + WS_FZ); bf16* GY = (bf16*)(F.ws + WS_GY);
    bf16* MIX = (bf16*)(F.ws + WS_MIX); bf16* ACT = (bf16*)(F.ws + WS_ACT);

    if (IN(0)) { p0_prologue(F); } SEAM(0);
    if (IN(1)) {
        pg8::Gemm g{XN, (const bf16*)(F.ws + WS_WIN), MTOK, INC, DM}; pg8::StaticOrder S; S.init(MTOK, INC, F.G, F.bid);
        EpiIn E{PB, FZ};
        pg8::gemm_phase<EpiIn, pg8::StaticOrder, true, true>(F.lds, g, S, E);
    } SEAM(1);
    if (IN(2)) {
#if S5_SIMPLE
        for (int it = gw; it < PB_B * S5G + SB_B * S5G; it += NGW) s5_simple_item(F, it);
        __syncthreads();
#else
        for (int it = F.bid; it < 256; it += F.G) { s5_fast_item(F, it); __syncthreads(); }
#endif
        for (int it = F.bid; it < PB_B * HH + SB_B * HH; it += F.G) { hgrn_simple_item(F, it); __syncthreads(); }
    } SEAM(2);
    if (IN(3)) {
        pg8::Gemm g{GY, (const bf16*)(F.ws + WS_WGLU), MTOK, S5W, S5W}; pg8::StaticOrder S; S.init(MTOK, S5W, F.G, F.bid);
        EpiGlu E{GY, MIX};
        pg8::gemm_phase<EpiGlu, pg8::StaticOrder, true, true>(F.lds, g, S, E);
        for (int m = gw; m < MTOK; m += NGW) hg_normgate_row(F, m);
    } SEAM(3);
    if (IN(4)) {
        pg8::Gemm g{MIX, (const bf16*)(F.ws + WS_WOUT), MTOK, DM, DM}; pg8::StaticOrder S; S.init(MTOK, DM, F.G, F.bid);
        EpiOut E{F.in[0], F.in[1], F.out + O_Y};
        pg8::gemm_phase<EpiOut, pg8::StaticOrder, true, true>(F.lds, g, S, E);
    } SEAM(4);
    if (IN(5)) {
        for (int m = gw; m < MTOK; m += NGW) rms_row_bf16(F.out + O_Y + (size_t)m * DM, F.in[19], XN + (size_t)m * DM, F.lane);
    } SEAM(5);
    if (IN(6)) {
        pg8::Gemm g{XN, (const bf16*)(F.ws + WS_WGU), MTOK, 2 * DFF, DM}; pg8::StaticOrder S; S.init(MTOK, 2 * DFF, F.G, F.bid);
        EpiAct E{ACT};
        pg8::gemm_phase<EpiAct, pg8::StaticOrder, true, true>(F.lds, g, S, E);
    } SEAM(6);
    if (IN(7)) {
        pg8::Gemm g{ACT, (const bf16*)(F.ws + WS_WD), MTOK, DM, DFF}; pg8::StaticOrder S; S.init(MTOK, DM, F.G, F.bid);
        EpiDown E{F.out + O_Y};
        pg8::gemm_phase<EpiDown, pg8::StaticOrder, true, true>(F.lds, g, S, E);
    } SEAM(7);
    if (IN(8)) {
        for (int m = gw; m < MTOK; m += NGW) final_norm_row(F, m);
    }
#undef IN
#undef SEAM
}

extern "C" void kernel_launch(void* const* d_in, const int* in_sizes, int n_in, void* d_out, int out_size, void* d_ws, size_t ws_size, hipStream_t stream) {
    static int grid = 0;
    if (grid == 0) {
        if (n_in != 24 || ws_size < WS_END) { fprintf(stderr, "kernel_launch: unexpected n_in %d / ws %zu\n", n_in, ws_size); grid = -1; return; }
        int dev = 0, cus = 0, per_cu = 0;
        if (hipGetDevice(&dev) != hipSuccess || hipDeviceGetAttribute(&cus, hipDeviceAttributeMultiprocessorCount, dev) != hipSuccess) { grid = -1; return; }
        if (hipFuncSetAttribute((const void*)mk_fwd, hipFuncAttributeMaxDynamicSharedMemorySize, LDS_BYTES) != hipSuccess) { fprintf(stderr, "kernel_launch: hipFuncSetAttribute failed\n"); grid = -1; return; }
        if (hipOccupancyMaxActiveBlocksPerMultiprocessor(&per_cu, (const void*)mk_fwd, NWAVES * 64, LDS_BYTES) != hipSuccess || per_cu < 1) { fprintf(stderr, "kernel_launch: occupancy query says %d\n", per_cu); per_cu = 1; }
        (void)hipGetLastError();
        grid = cus;
    }
    if (grid < 0) return;
    Args a{};
    for (int i = 0; i < 24; ++i) a.in[i] = (const float*)d_in[i];
    a.out = (float*)d_out; a.ws = (unsigned char*)d_ws;
#if MK_N_LAUNCHES == 1
    a.ph_lo = 0; a.ph_hi = NPH;
    void* kargs[] = {&a};
    hipError_t e = hipLaunchCooperativeKernel((const void*)mk_fwd, dim3(grid), dim3(NWAVES * 64), kargs, LDS_BYTES, stream);
    if (e != hipSuccess) fprintf(stderr, "kernel_launch: cooperative launch failed: %s (grid %d)\n", hipGetErrorString(e), grid);
#else
    for (int p = 0; p < NPH; ++p) { a.ph_lo = p; a.ph_hi = p + 1; hipLaunchKernelGGL(mk_fwd, dim3(grid), dim3(NWAVES * 64), LDS_BYTES, stream, a); }
#endif
}
```

```cpp
#include <hip/hip_runtime.h>
#include <hip/hip_cooperative_groups.h>
#include <cstdio>
#include <cstdint>
namespace cg = cooperative_groups;
#define MK_N_LAUNCHES 1
namespace pg8 {
#define PG8_LAS __attribute__((address_space(3)))
typedef unsigned short bf16_t;
typedef short bf16x8 __attribute__((ext_vector_type(8)));
typedef float f32x4 __attribute__((ext_vector_type(4)));
typedef unsigned u32x4 __attribute__((ext_vector_type(4)));
constexpr int BM = 256, BK = 64, HALF = 128, HTB = HALF * BK * 2  , STAGE_BYTES = 8 * HTB, NXCD = 8, WGM = 8;

__host__ __device__ __forceinline__ int lds_byte(int r, int c) { const int st = (r >> 4) * 2 + (c >> 5), rr = r & 15, cc = c & 31, ob = rr * 64 + cc * 2; return st * 1024 + (ob ^ (((ob >> 9) & 1) << 5)); }
__host__ __device__ __forceinline__ void stage_rc(int b, int& R, int& C) { const int st = b / 1024, sb = b % 1024, swz = sb ^ (((sb >> 9) & 1) << 5); R = (st >> 1) * 16 + swz / 64; C = (st & 1) * 32 + (swz % 64) / 2; }
__host__ __device__ __forceinline__ int perm32(int rho) { const int n = rho >> 4, i = rho & 15; return 8 * (i >> 2) + 4 * n + (i & 3); }

struct Unit { int pm, pn; };
struct Gemm { const bf16_t* A; const bf16_t* Bt; int M, N, K; };

struct StaticOrder {
    int nM, nN, nwg, G, c;
    __host__ __device__ void init(int M, int N, int G_, int c_) { nM = M / BM; nN = N / BM; nwg = nM * nN; G = G_; c = c_; }
    __host__ __device__ bool next(int i, Unit& u) const {
        const long L = (long)i * G + c; if (L >= nwg) return false;
        int wgid = (int)L; { const int q = nwg / NXCD, r = nwg % NXCD, xcd = wgid % NXCD, off = wgid / NXCD; wgid = (xcd < r ? xcd * (q + 1) : r * (q + 1) + (xcd - r) * q) + off; }
        const int nig = WGM * nN, gid = wgid / nig, fm = gid * WGM, gsz = (nM - fm) < WGM ? (nM - fm) : WGM;
        u.pm = fm + ((wgid % nig) % gsz); u.pn = (wgid % nig) / gsz; return true;
    }
    __device__ __forceinline__ void a_ready(const Unit&) const {}
    __device__ __forceinline__ void done(const Unit&) const {}
};

__device__ __forceinline__ unsigned cvt_pk_bf16(float lo, float hi) { unsigned r; asm volatile("v_cvt_pk_bf16_f32 %0, %1, %2" : "=v"(r) : "v"(lo), "v"(hi)); return r; }
template <class Epi, class Sched, bool ALIGN_EPI = false, bool SP2 = false>
__device__ __forceinline__ void gemm_phase(PG8_LAS unsigned char* lds, const Gemm g, const Sched& S, const Epi& E) {
    const int tid = threadIdx.x, wid = __builtin_amdgcn_readfirstlane(tid >> 6), lane = tid & 63, wr = wid >> 2, wc = wid & 3, fr = lane & 15, fq = lane >> 4;
    const int K = g.K, nt = K / BK;
    unsigned voffA[2], voffB[2];
#pragma unroll
    for (int i = 0; i < 2; ++i) { int R, C; stage_rc(tid * 16 + i * 8192, R, C); const int Rb = Epi::PERM ? ((R & ~31) + perm32(R & 31)) : R;
        voffA[i] = (unsigned)(R * K + C) * 2u; voffB[i] = (unsigned)(Rb * K + C) * 2u; }
    const size_t kstep = (size_t)(BK * 2);
    const size_t hstep = (size_t)HALF * K * 2;
    const size_t tstep = 2 * hstep;
    const unsigned ldsw = (unsigned)wid * 1024u;
    const int aoff = lds_byte(wr * 64 + fr, fq * 8), boff = lds_byte(wc * 32 + fr, fq * 8);
#define PG8_SA(b, h) (((b) * 2 + (h)) * HTB)
#define PG8_SB(b, h) ((4 + (b) * 2 + (h)) * HTB)
#define PG8_STAGE(bufoff, gbase, voff) do { _Pragma("unroll") for (int _i = 0; _i < 2; ++_i) \
        __builtin_amdgcn_global_load_lds((const unsigned*)((const char*)(gbase) + (voff)[_i]), (PG8_LAS unsigned*)(lds + (bufoff) + ldsw + _i * 8192), 16, 0, 0); } while (0)
#define PG8_LDA(dst, b, h) do { _Pragma("unroll") for (int m = 0; m < 4; ++m) _Pragma("unroll") for (int k = 0; k < 2; ++k) dst[m][k] = *(const PG8_LAS bf16x8*)(lds + PG8_SA(b, h) + aoff + m * 2048 + k * 1024); } while (0)
#define PG8_LDB(dst, b, h) do { _Pragma("unroll") for (int n = 0; n < 2; ++n) _Pragma("unroll") for (int k = 0; k < 2; ++k) dst[n][k] = *(const PG8_LAS bf16x8*)(lds + PG8_SB(b, h) + boff + n * 2048 + k * 1024); } while (0)
#define PG8_MMA(ai, bj, At, Bt) do { __builtin_amdgcn_s_setprio(1); _Pragma("unroll") for (int m = 0; m < 4; ++m) _Pragma("unroll") for (int n = 0; n < 2; ++n) _Pragma("unroll") for (int k = 0; k < 2; ++k) \
        acc[ai][bj][m][n] = __builtin_amdgcn_mfma_f32_16x16x32_bf16(Bt[n][k], At[m][k], acc[ai][bj][m][n], 0, 0, 0); __builtin_amdgcn_s_setprio(0); } while (0)
#define PG8_WAIT_V(n) asm volatile("s_waitcnt vmcnt(" #n ")" ::: "memory")
#define PG8_WAIT_L(n) asm volatile("s_waitcnt lgkmcnt(" #n ")" ::: "memory")
#define PG8_BAR __builtin_amdgcn_s_barrier()
#define PG8_SCHED __builtin_amdgcn_sched_barrier(0)
    Unit cur, nxt; int ui = 0;
    if (!S.next(0, cur)) return;
    f32x4 acc[2][2][4][2];
#pragma unroll
    for (int a = 0; a < 2; ++a)
#pragma unroll
        for (int b = 0; b < 2; ++b)
#pragma unroll
            for (int m = 0; m < 4; ++m)
#pragma unroll
                for (int n = 0; n < 2; ++n) acc[a][b][m][n] = (f32x4){0.f, 0.f, 0.f, 0.f};
    bf16x8 At[4][2], B0[2][2], B1[2][2];
    const char* cA = (const char*)g.A + (size_t)cur.pm * tstep; const char* cB = (const char*)g.Bt + (size_t)cur.pn * tstep;
    S.a_ready(cur);
    if constexpr (SP2) {
        PG8_STAGE(PG8_SB(0, 0), cB, voffB); PG8_STAGE(PG8_SB(0, 1), cB + hstep, voffB); PG8_STAGE(PG8_SA(0, 0), cA, voffA); PG8_STAGE(PG8_SA(0, 1), cA + hstep, voffA);
        if (wr == 1) PG8_BAR;
        PG8_WAIT_V(2); PG8_BAR;
        PG8_STAGE(PG8_SB(1, 0), cB + kstep, voffB); PG8_STAGE(PG8_SA(1, 0), cA + kstep, voffA); PG8_STAGE(PG8_SB(1, 1), cB + hstep + kstep, voffB);
        PG8_WAIT_V(6); PG8_BAR;
    } else {
        PG8_STAGE(PG8_SB(0, 0), cB, voffB); PG8_STAGE(PG8_SA(0, 0), cA, voffA); PG8_STAGE(PG8_SB(0, 1), cB + hstep, voffB); PG8_STAGE(PG8_SA(0, 1), cA + hstep, voffA);
        if (wr == 1) PG8_BAR;
        PG8_WAIT_V(4); PG8_BAR;
        PG8_STAGE(PG8_SB(1, 0), cB + kstep, voffB); PG8_STAGE(PG8_SA(1, 0), cA + kstep, voffA); PG8_STAGE(PG8_SB(1, 1), cB + hstep + kstep, voffB);
        PG8_WAIT_V(6); PG8_BAR;
    }
    for (;;) {
        const bool has_next = S.next(ui + 1, nxt);
        const char* nA = has_next ? (const char*)g.A + (size_t)nxt.pm * tstep : cA; const char* nB = has_next ? (const char*)g.Bt + (size_t)nxt.pn * tstep : cB;
        for (int t = 0; t < nt; t += 2) {
            const bool last = (t == nt - 2);
            const char* a1 = cA + (size_t)(t + 1) * kstep;
            const char* a2 = last ? nA : cA + (size_t)(t + 2) * kstep; const char* b2 = last ? nB : cB + (size_t)(t + 2) * kstep;
            const char* a3 = a2 + kstep; const char* b3 = b2 + kstep;
            if (last && has_next) S.a_ready(nxt);
            if constexpr (SP2) {
            PG8_LDB(B0, 0, 0); PG8_LDB(B1, 0, 1); PG8_SCHED; PG8_LDA(At, 0, 0); PG8_STAGE(PG8_SA(1, 1), a1 + hstep, voffA);
            PG8_WAIT_V(8); PG8_WAIT_L(0); PG8_BAR; PG8_MMA(0, 0, At, B0); PG8_MMA(0, 1, At, B1); PG8_BAR; PG8_SCHED;
            PG8_LDA(At, 0, 1); PG8_STAGE(PG8_SB(0, 0), b2, voffB); PG8_STAGE(PG8_SB(0, 1), b2 + hstep, voffB); PG8_STAGE(PG8_SA(0, 0), a2, voffA);
            PG8_WAIT_V(8); PG8_WAIT_L(0); PG8_BAR; PG8_MMA(1, 0, At, B0); PG8_MMA(1, 1, At, B1); PG8_BAR; PG8_SCHED;
            PG8_LDB(B0, 1, 0); PG8_LDB(B1, 1, 1); PG8_SCHED; PG8_LDA(At, 1, 0); PG8_STAGE(PG8_SA(0, 1), a2 + hstep, voffA);
            PG8_WAIT_V(8); PG8_WAIT_L(0); PG8_BAR; PG8_MMA(0, 0, At, B0); PG8_MMA(0, 1, At, B1); PG8_BAR; PG8_SCHED;
            PG8_LDA(At, 1, 1); PG8_STAGE(PG8_SB(1, 0), b3, voffB); PG8_STAGE(PG8_SB(1, 1), b3 + hstep, voffB); PG8_STAGE(PG8_SA(1, 0), a3, voffA);
            PG8_WAIT_V(8); PG8_WAIT_L(0); PG8_BAR; PG8_MMA(1, 0, At, B0); PG8_MMA(1, 1, At, B1); PG8_BAR; PG8_SCHED;
            } else {
            PG8_LDB(B0, 0, 0); PG8_SCHED; PG8_LDA(At, 0, 0); PG8_STAGE(PG8_SA(1, 1), a1 + hstep, voffA);
            PG8_WAIT_L(8); PG8_BAR; PG8_WAIT_L(0); PG8_MMA(0, 0, At, B0); PG8_BAR; PG8_SCHED;
            PG8_LDB(B1, 0, 1); PG8_STAGE(PG8_SB(0, 0), b2, voffB);
            PG8_BAR; PG8_WAIT_L(0); PG8_MMA(0, 1, At, B1); PG8_BAR;
            PG8_LDA(At, 0, 1); PG8_STAGE(PG8_SA(0, 0), a2, voffA);
            PG8_BAR; PG8_WAIT_L(0); PG8_MMA(1, 0, At, B0); PG8_BAR; PG8_SCHED;
            PG8_STAGE(PG8_SB(0, 1), b2 + hstep, voffB);
            PG8_WAIT_V(6); PG8_BAR; PG8_MMA(1, 1, At, B1); PG8_BAR;
            PG8_LDB(B0, 1, 0); PG8_SCHED; PG8_LDA(At, 1, 0); PG8_STAGE(PG8_SA(0, 1), a2 + hstep, voffA);
            PG8_WAIT_L(8); PG8_BAR; PG8_WAIT_L(0); PG8_MMA(0, 0, At, B0); PG8_BAR; PG8_SCHED;
            PG8_LDB(B1, 1, 1); PG8_STAGE(PG8_SB(1, 0), b3, voffB);
            PG8_BAR; PG8_WAIT_L(0); PG8_MMA(0, 1, At, B1); PG8_BAR;
            PG8_LDA(At, 1, 1); PG8_STAGE(PG8_SA(1, 0), a3, voffA);
            PG8_BAR; PG8_WAIT_L(0); PG8_MMA(1, 0, At, B0); PG8_BAR; PG8_SCHED;
            PG8_STAGE(PG8_SB(1, 1), b3 + hstep, voffB);
            PG8_WAIT_V(6); PG8_BAR; PG8_MMA(1, 1, At, B1); PG8_BAR;
            }
        }
        if constexpr (ALIGN_EPI) { if (wr == 0) PG8_BAR; }
        if constexpr (!Epi::AFTER_DRAIN) { E(acc, cur, wr, wc, fr, fq); S.done(cur); }
        if (!has_next) break;
#pragma unroll
        for (int a = 0; a < 2; ++a)
#pragma unroll
            for (int b = 0; b < 2; ++b)
#pragma unroll
                for (int m = 0; m < 4; ++m)
#pragma unroll
                    for (int n = 0; n < 2; ++n) acc[a][b][m][n] = (f32x4){0.f, 0.f, 0.f, 0.f};
        cur = nxt; cA = nA; cB = nB; ++ui;
        if constexpr (ALIGN_EPI) { if (wr == 1) PG8_BAR; }
    }
    PG8_WAIT_V(0);
    if constexpr (!ALIGN_EPI) { if (wr == 0) PG8_BAR; }
    PG8_BAR;
    if constexpr (Epi::AFTER_DRAIN) { E.fused(acc, cur, wr, wc, fr, fq, lds, wid, lane); S.done(cur); }
#undef PG8_SA
#undef PG8_SB
#undef PG8_STAGE
#undef PG8_LDA
#undef PG8_LDB
#undef PG8_MMA
#undef PG8_WAIT_V
#undef PG8_WAIT_L
#undef PG8_BAR
#undef PG8_SCHED
}
}

#ifndef S5_SIMPLE
#define S5_SIMPLE 0
#endif
#ifndef HG_SIMPLE
#define HG_SIMPLE 0
#endif
#ifndef MK_N_LAUNCHES
#define MK_N_LAUNCHES 1
#endif
constexpr int DM = 1024, PB_B = 8, PB_T = 2048, SB_B = 128, SB_T = 8;
constexpr int MP = PB_B * PB_T, MS = SB_B * SB_T, MTOK = MP + MS;
constexpr int S5W = 512, S5G = 32, S5C = 16, S5N = 64;
constexpr int HGW = 512, HD = 128, HH = 4;
constexpr int INC = 2560, DFF = 2816;
constexpr float EPS = 1e-6f;
constexpr int NPH = 9;
constexpr size_t O_Y = 0, O_PRE = (size_t)MTOK * DM, O_PIM = O_PRE + 16384, O_PHG = O_PIM + 16384, O_SRE = O_PHG + 524288, O_SIM = O_SRE + 262144, O_SHG = O_SIM + 262144;
constexpr size_t MiB = 1u << 20;
constexpr size_t WS_CTL = 0, WS_WIN = 2 * MiB, WS_WGLU = 7 * MiB, WS_WOUT = 8 * MiB, WS_WGU = 10 * MiB, WS_WD = 21 * MiB;
constexpr size_t WS_XN = 27 * MiB, WS_PB = 61 * MiB, WS_FZ = 129 * MiB, WS_ACT = 61 * MiB, WS_GY = 163 * MiB, WS_OH = 180 * MiB, WS_MIX = 197 * MiB, WS_END = 231 * MiB;
constexpr int PBW = 2048;
constexpr int LDS_BYTES = 147456;
constexpr int NWAVES = 8;

#define GAS __attribute__((address_space(1)))
#define LAS __attribute__((address_space(3)))
typedef unsigned short bf16;
typedef unsigned v4u __attribute__((ext_vector_type(4)));
typedef unsigned v2u __attribute__((ext_vector_type(2)));
typedef float f32x4 __attribute__((ext_vector_type(4)));
#define LDS_WAIT() asm volatile("s_waitcnt lgkmcnt(0)" ::: "memory")
__device__ __forceinline__ unsigned f2bf(float f) { unsigned u = __builtin_bit_cast(unsigned, f); return (u + 0x7fffu + ((u >> 16) & 1u)) >> 16; }
__device__ __forceinline__ unsigned pk2(float lo, float hi) { return f2bf(lo) | (f2bf(hi) << 16); }
__device__ __forceinline__ float bf2f(unsigned short h) { return __builtin_bit_cast(float, (unsigned)h << 16); }
__device__ __forceinline__ float bflo(unsigned w) { return __builtin_bit_cast(float, w << 16); }
__device__ __forceinline__ float bfhi(unsigned w) { return __builtin_bit_cast(float, w & 0xffff0000u); }
__device__ __forceinline__ float sigmoidf_(float x) { return 1.0f / (1.0f + __expf(-x)); }
__device__ __forceinline__ float siluf_(float x) { return x / (1.0f + __expf(-x)); }
__device__ __forceinline__ float gelu_tanh(float x) { const float z = 1.5957691216057308f * (x + 0.044715f * x * x * x); return x / (1.0f + __expf(-z)); }
__device__ __forceinline__ float wave_sum(float v) {
#pragma unroll
    for (int o = 1; o < 64; o <<= 1) v += __shfl_xor(v, o);
    return v;
}

struct Args { const float* in[24]; float* out; unsigned char* ws; int ph_lo, ph_hi; };

struct Frame {
    LAS unsigned char* lds;
    int tid, lane, wave, G, bid;
    const float* in[24];
    float* out; unsigned char* ws;
};
__device__ __forceinline__ const float* xrow(const Frame& F, int m) { return m < MP ? F.in[0] + (size_t)m * DM : F.in[1] + (size_t)(m - MP) * DM; }

__device__ __forceinline__ void transpose_item(const float* W, int ldw, bf16* WT, int K, int k0, int sn0, int dn0, LAS float* scr, int lane) {
#pragma unroll 8
    for (int i = 0; i < 32; ++i) { const int kk = 2 * i + (lane >> 5); scr[kk * 33 + (lane & 31)] = W[(size_t)(k0 + kk) * ldw + sn0 + (lane & 31)]; }
    LDS_WAIT(); asm volatile("" ::: "memory");
    const int c = lane & 7;
#pragma unroll
    for (int j = 0; j < 4; ++j) { const int n = (lane >> 3) + 8 * j; const LAS float* s = scr + (8 * c) * 33 + n;
        v4u o; o.x = pk2(s[0 * 33], s[1 * 33]); o.y = pk2(s[2 * 33], s[3 * 33]); o.z = pk2(s[4 * 33], s[5 * 33]); o.w = pk2(s[6 * 33], s[7 * 33]);
        *(GAS v4u*)(WT + (size_t)(dn0 + n) * K + k0 + 8 * c) = o; }
    LDS_WAIT(); asm volatile("" ::: "memory");
}
__device__ __forceinline__ void rms_row_bf16(const float* xr_, const float* gain, bf16* orow, int lane) {
    const GAS f32x4* xr = (const GAS f32x4*)xr_ + lane;
    f32x4 v[4]; float s = 0.f;
#pragma unroll
    for (int j = 0; j < 4; ++j) { v[j] = xr[64 * j]; s += (v[j].x * v[j].x + v[j].y * v[j].y) + (v[j].z * v[j].z + v[j].w * v[j].w); }
    const float rstd = 1.0f / sqrtf(wave_sum(s) * (1.0f / DM) + EPS);
    GAS v2u* o8 = (GAS v2u*)orow + lane;
#pragma unroll
    for (int j = 0; j < 4; ++j) { const f32x4 g = ((const GAS f32x4*)gain)[lane + 64 * j]; v2u w; w.x = pk2(v[j].x * rstd * g.x, v[j].y * rstd * g.y); w.y = pk2(v[j].z * rstd * g.z, v[j].w * rstd * g.w); o8[64 * j] = w; }
}

__device__ __forceinline__ void p0_prologue(Frame& F) {
    LAS float* scr = (LAS float*)(F.lds + F.wave * 16384);
    const int gw = F.bid * NWAVES + F.wave, NGW = F.G * NWAVES;
    bf16* WinT = (bf16*)(F.ws + WS_WIN); bf16* WgluT = (bf16*)(F.ws + WS_WGLU); bf16* WoutT = (bf16*)(F.ws + WS_WOUT); bf16* WguT = (bf16*)(F.ws + WS_WGU); bf16* WdT = (bf16*)(F.ws + WS_WD);
    constexpr int I_IN = (DM / 64) * (INC / 32), I_GLU = (S5W / 64) * (S5W / 32), I_OUT = (DM / 64) * (DM / 32), I_G = (DM / 64) * (DFF / 32), I_D = (DFF / 64) * (DM / 32);
    constexpr int NITEMS = I_IN + I_GLU + I_OUT + 2 * I_G + I_D;
    for (int it = gw; it < NITEMS; it += NGW) {
        int r = it;
        if (r < I_IN) { const int nblk = INC / 32, kb = r / nblk, nb = r % nblk, sn0 = nb * 32; const int seg = sn0 / 512, off = sn0 % 512;
            const int dseg = seg == 0 ? 0 : seg == 1 ? 1 : seg == 2 ? 4 : seg == 3 ? 2 : 3;
            transpose_item(F.in[7], INC, WinT, DM, kb * 64, sn0, dseg * 512 + off, scr, F.lane); continue; } r -= I_IN;
        if (r < I_GLU) { const int nblk = S5W / 32, kb = r / nblk, nb = r % nblk; transpose_item(F.in[16], S5W, WgluT, S5W, kb * 64, nb * 32, nb * 32, scr, F.lane); continue; } r -= I_GLU;
        if (r < I_OUT) { const int nblk = DM / 32, kb = r / nblk, nb = r % nblk; transpose_item(F.in[18], DM, WoutT, DM, kb * 64, nb * 32, nb * 32, scr, F.lane); continue; } r -= I_OUT;
        if (r < I_G) { const int nblk = DFF / 32, kb = r / nblk, nb = r % nblk, sn0 = nb * 32; transpose_item(F.in[20], DFF, WguT, DM, kb * 64, sn0, 256 * (sn0 / 128) + (sn0 % 128), scr, F.lane); continue; } r -= I_G;
        if (r < I_G) { const int nblk = DFF / 32, kb = r / nblk, nb = r % nblk, sn0 = nb * 32; transpose_item(F.in[21], DFF, WguT, DM, kb * 64, sn0, 256 * (sn0 / 128) + 128 + (sn0 % 128), scr, F.lane); continue; } r -= I_G;
        { const int nblk = DM / 32, kb = r / nblk, nb = r % nblk; transpose_item(F.in[22], DM, WdT, DFF, kb * 64, nb * 32, nb * 32, scr, F.lane); }
    }
    bf16* XN = (bf16*)(F.ws + WS_XN);
    for (int m = gw; m < MTOK; m += NGW) rms_row_bf16(xrow(F, m), F.in[6], XN + (size_t)m * DM, F.lane);
}

using pg8::Unit; using pg8::u32x4; using pg8::cvt_pk_bf16; using pg8::BM; using pg8::HALF;
struct EpiIn {
    static constexpr bool PERM = true, AFTER_DRAIN = false;
    bf16* PB; float* FZ;
    __device__ __forceinline__ void operator()(const pg8::f32x4 (&acc)[2][2][4][2], const Unit& u, int wr, int wc, int fr, int fq) const {
        const int row0 = u.pm * BM + wr * 64 + fr;
        if (u.pn < 8) { const int col0 = u.pn * BM + wc * 32 + 8 * fq;
#pragma unroll
            for (int ai = 0; ai < 2; ++ai)
#pragma unroll
                for (int m = 0; m < 4; ++m) { bf16* rowp = PB + (size_t)(row0 + ai * HALF + m * 16) * PBW + col0;
#pragma unroll
                    for (int bj = 0; bj < 2; ++bj) { const pg8::f32x4 v0 = acc[ai][bj][m][0], v1 = acc[ai][bj][m][1]; u32x4 w; w.x = cvt_pk_bf16(v0[0], v0[1]); w.y = cvt_pk_bf16(v0[2], v0[3]); w.z = cvt_pk_bf16(v1[0], v1[1]); w.w = cvt_pk_bf16(v1[2], v1[3]);
                        *(u32x4*)(rowp + bj * HALF) = w; } }
        } else { const int col0 = (u.pn - 8) * BM + wc * 32 + 8 * fq;
#pragma unroll
            for (int ai = 0; ai < 2; ++ai)
#pragma unroll
                for (int m = 0; m < 4; ++m) { float* rowp = FZ + (size_t)(row0 + ai * HALF + m * 16) * 512 + col0;
#pragma unroll
                    for (int bj = 0; bj < 2; ++bj)
#pragma unroll
                        for (int n = 0; n < 2; ++n) *(pg8::f32x4*)(rowp + bj * HALF + 4 * n) = acc[ai][bj][m][n]; }
        }
    }
};
struct EpiGlu {
    static constexpr bool PERM = true, AFTER_DRAIN = false;
    const bf16* GY; bf16* MIX;
    __device__ __forceinline__ void operator()(const pg8::f32x4 (&acc)[2][2][4][2], const Unit& u, int wr, int wc, int fr, int fq) const {
        const int row0 = u.pm * BM + wr * 64 + fr, col0 = u.pn * BM + wc * 32 + 8 * fq;
#pragma unroll
        for (int ai = 0; ai < 2; ++ai)
#pragma unroll
            for (int m = 0; m < 4; ++m) { const size_t r = (size_t)(row0 + ai * HALF + m * 16);
#pragma unroll
                for (int bj = 0; bj < 2; ++bj) { const u32x4 g = *(const u32x4*)(GY + r * 512 + col0 + bj * HALF); const pg8::f32x4 v0 = acc[ai][bj][m][0], v1 = acc[ai][bj][m][1];
                    u32x4 w; w.x = cvt_pk_bf16(bflo(g.x) * sigmoidf_(v0[0]), bfhi(g.x) * sigmoidf_(v0[1])); w.y = cvt_pk_bf16(bflo(g.y) * sigmoidf_(v0[2]), bfhi(g.y) * sigmoidf_(v0[3]));
                    w.z = cvt_pk_bf16(bflo(g.z) * sigmoidf_(v1[0]), bfhi(g.z) * sigmoidf_(v1[1])); w.w = cvt_pk_bf16(bflo(g.w) * sigmoidf_(v1[2]), bfhi(g.w) * sigmoidf_(v1[3]));
                    *(u32x4*)(MIX + r * DM + col0 + bj * HALF) = w; } }
    }
};
struct EpiOut {
    static constexpr bool PERM = false, AFTER_DRAIN = false;
    const float* xp; const float* xs; float* Y;
    __device__ __forceinline__ void operator()(const pg8::f32x4 (&acc)[2][2][4][2], const Unit& u, int wr, int wc, int fr, int fq) const {
        const int row0 = u.pm * BM + wr * 64 + fr, col0 = u.pn * BM + wc * 32 + 4 * fq;
        const float* xb = (u.pm < MP / BM) ? xp : xs - (size_t)MP * DM;
#pragma unroll
        for (int ai = 0; ai < 2; ++ai)
#pragma unroll
            for (int m = 0; m < 4; ++m) { const size_t off = (size_t)(row0 + ai * HALF + m * 16) * DM + col0;
#pragma unroll
                for (int bj = 0; bj < 2; ++bj)
#pragma unroll
                    for (int n = 0; n < 2; ++n) { const pg8::f32x4 xv = *(const pg8::f32x4*)(xb + off + bj * HALF + n * 16); *(pg8::f32x4*)(Y + off + bj * HALF + n * 16) = xv + acc[ai][bj][m][n]; } }
    }
};
struct EpiAct {
    static constexpr bool PERM = true, AFTER_DRAIN = false;
    bf16* ACT;
    __device__ __forceinline__ void operator()(const pg8::f32x4 (&acc)[2][2][4][2], const Unit& u, int wr, int wc, int fr, int fq) const {
        const int row0 = u.pm * BM + wr * 64 + fr, col0 = u.pn * HALF + wc * 32 + 8 * fq;
#pragma unroll
        for (int ai = 0; ai < 2; ++ai)
#pragma unroll
            for (int m = 0; m < 4; ++m) { const pg8::f32x4 g0 = acc[ai][0][m][0], g1 = acc[ai][0][m][1], u0 = acc[ai][1][m][0], u1 = acc[ai][1][m][1];
                u32x4 w; w.x = cvt_pk_bf16(siluf_(g0[0]) * u0[0], siluf_(g0[1]) * u0[1]); w.y = cvt_pk_bf16(siluf_(g0[2]) * u0[2], siluf_(g0[3]) * u0[3]);
                w.z = cvt_pk_bf16(siluf_(g1[0]) * u1[0], siluf_(g1[1]) * u1[1]); w.w = cvt_pk_bf16(siluf_(g1[2]) * u1[2], siluf_(g1[3]) * u1[3]);
                *(u32x4*)(ACT + (size_t)(row0 + ai * HALF + m * 16) * DFF + col0) = w; }
    }
};
struct EpiDown {
    static constexpr bool PERM = false, AFTER_DRAIN = false;
    float* Y;
    __device__ __forceinline__ void operator()(const pg8::f32x4 (&acc)[2][2][4][2], const Unit& u, int wr, int wc, int fr, int fq) const {
        const int row0 = u.pm * BM + wr * 64 + fr, col0 = u.pn * BM + wc * 32 + 4 * fq;
#pragma unroll
        for (int ai = 0; ai < 2; ++ai)
#pragma unroll
            for (int m = 0; m < 4; ++m) { const size_t off = (size_t)(row0 + ai * HALF + m * 16) * DM + col0;
#pragma unroll
                for (int bj = 0; bj < 2; ++bj)
#pragma unroll
                    for (int n = 0; n < 2; ++n) { float* p = Y + off + bj * HALF + n * 16; const pg8::f32x4 xv = *(const pg8::f32x4*)p; *(pg8::f32x4*)p = xv + acc[ai][bj][m][n]; } }
    }
};

__device__ __forceinline__ void s5_simple_item(Frame& F, int item) {
    const int lane = F.lane, n = lane;
    int g, tokbase, T; const float* h0r = nullptr; const float* h0i = nullptr; float* outr; float* outi;
    if (item < PB_B * S5G) { const int b = item / S5G; g = item % S5G; tokbase = b * PB_T; T = PB_T; outr = F.out + O_PRE + (size_t)item * S5N; outi = F.out + O_PIM + (size_t)item * S5N; }
    else { const int idx = item - PB_B * S5G, b = idx / S5G; g = idx % S5G; tokbase = MP + b * SB_T; T = SB_T; h0r = F.in[2] + (size_t)idx * S5N; h0i = F.in[3] + (size_t)idx * S5N; outr = F.out + O_SRE + (size_t)idx * S5N; outi = F.out + O_SIM + (size_t)idx * S5N; }
    const float a_re = F.in[8][g * S5N + n], a_im = F.in[9][g * S5N + n], dt = expf(F.in[10][g]);
    const float mag = expf(a_re * dt), ab_re = mag * cosf(a_im * dt), ab_im = mag * sinf(a_im * dt);
    const float den = a_re * a_re + a_im * a_im, nr = ab_re - 1.0f, ni = ab_im;
    const float f_re = (nr * a_re + ni * a_im) / den, f_im = (ni * a_re - nr * a_im) / den;
    float Bre[16], Bim[16], Cre[16], Cim[16];
#pragma unroll
    for (int c = 0; c < 16; ++c) { const float br = F.in[11][(size_t)(g * S5N + n) * 16 + c], bi = F.in[12][(size_t)(g * S5N + n) * 16 + c];
        Bre[c] = f_re * br - f_im * bi; Bim[c] = f_re * bi + f_im * br;
        Cre[c] = F.in[13][(size_t)(g * 16 + c) * S5N + n]; Cim[c] = F.in[14][(size_t)(g * 16 + c) * S5N + n]; }
    const float dl = F.in[15][g * 16 + (lane & 15)];
    float h_re = h0r ? h0r[n] : 0.f, h_im = h0i ? h0i[n] : 0.f;
    const bf16* PB = (const bf16*)(F.ws + WS_PB); bf16* GY = (bf16*)(F.ws + WS_GY);
    for (int t = 0; t < T; ++t) {
        const float uv = bf2f(PB[(size_t)(tokbase + t) * PBW + g * 16 + (lane & 15)]);
        float bu_re = 0.f, bu_im = 0.f;
#pragma unroll
        for (int c = 0; c < 16; ++c) { const float uc = __shfl(uv, c); bu_re += Bre[c] * uc; bu_im += Bim[c] * uc; }
        const float nre = ab_re * h_re - ab_im * h_im + bu_re, nim = ab_re * h_im + ab_im * h_re + bu_im;
        h_re = nre; h_im = nim;
        float yv = 0.f;
#pragma unroll
        for (int c = 0; c < 16; ++c) { const float p = wave_sum(Cre[c] * h_re - Cim[c] * h_im); yv = ((lane & 15) == c) ? p : yv; }
        const float y = yv + dl * uv;
        if (lane < 16) GY[(size_t)(tokbase + t) * S5W + g * 16 + lane] = (bf16)f2bf(gelu_tanh(y));
    }
    outr[n] = h_re; outi[n] = h_im;
}
typedef float f32x16 __attribute__((ext_vector_type(16)));
typedef short s16x8 __attribute__((ext_vector_type(8)));
constexpr int S5_LD = 136;
constexpr int L5_WG = 0, L5_VG = 34816, L5_KC = 69632, L5_U = 74240, L5_HS = 91648, L5_HL = 109056, L5_PW = 141824;
__device__ __forceinline__ void s5_fast_item(Frame& F, int item) {
    const int tid = F.tid, lane = F.lane, wave = F.wave;
    const int g = item & 31, b8 = item >> 5;
    LAS bf16* WgT = (LAS bf16*)(F.lds + L5_WG); LAS bf16* VgT = (LAS bf16*)(F.lds + L5_VG); LAS bf16* Kc = (LAS bf16*)(F.lds + L5_KC);
    LAS bf16* Us = (LAS bf16*)(F.lds + L5_U); LAS bf16* HS = (LAS bf16*)(F.lds + L5_HS); LAS float* HL = (LAS float*)(F.lds + L5_HL);
    LAS float* Pre = (LAS float*)(F.lds + L5_PW); LAS float* Pim = Pre + 9 * 64;
    LAS float* Cre = HL, * Cim = HL + 1024, * Bre = HL + 2048, * Bim = HL + 3072; LAS float* Ff = HL + 4096;
    if (tid < 64) { const int n = tid;
        const float a_re = F.in[8][g * S5N + n], a_im = F.in[9][g * S5N + n], dt = expf(F.in[10][g]);
        const float mag = expf(a_re * dt), ab_re = mag * cosf(a_im * dt), ab_im = mag * sinf(a_im * dt);
        const float den = a_re * a_re + a_im * a_im, nr = ab_re - 1.0f, ni = ab_im;
        Ff[n] = (nr * a_re + ni * a_im) / den; Ff[64 + n] = (ni * a_re - nr * a_im) / den;
        float pr = 1.f, pi = 0.f;
#pragma unroll
        for (int j = 0; j < 9; ++j) { Pre[j * 64 + n] = pr; Pim[j * 64 + n] = pi; const float t = pr * ab_re - pi * ab_im; pi = pr * ab_im + pi * ab_re; pr = t; }
    }
    __syncthreads();
#pragma unroll
    for (int i = 0; i < 2; ++i) { const int idx = tid + 512 * i;
        { const int c = idx >> 6, n = idx & 63; Cre[c * 64 + n] = F.in[13][(size_t)(g * 16 + c) * S5N + n]; Cim[c * 64 + n] = F.in[14][(size_t)(g * 16 + c) * S5N + n]; }
        { const int n = idx >> 4, c = idx & 15; const float br = F.in[11][(size_t)(g * S5N + n) * 16 + c], bi = F.in[12][(size_t)(g * S5N + n) * 16 + c], fr = Ff[n], fi = Ff[64 + n];
          Bre[n * 16 + c] = fr * br - fi * bi; Bim[n * 16 + c] = fr * bi + fi * br; } }
    __syncthreads();
#pragma unroll 1
    for (int i = 0; i < 4; ++i) { const int idx = tid + 512 * i, j = idx >> 8, c = (idx >> 4) & 15, cp = idx & 15; float acc = 0.f;
        for (int n = 0; n < 64; ++n) { const float cr = Cre[c * 64 + n], ci = Cim[c * 64 + n], pr = Pre[j * 64 + n], pi = Pim[j * 64 + n];
            const float xr = cr * pr - ci * pi, xi = cr * pi + ci * pr; acc += xr * Bre[n * 16 + cp] - xi * Bim[n * 16 + cp]; }
        Kc[idx] = (bf16)f2bf(acc); }
    if (tid < 256) Kc[2048 + tid] = 0;
#pragma unroll 4
    for (int i = 0; i < 32; ++i) { const int idx = tid + 512 * i, np = idx >> 7, k = idx & 127, s = k >> 4, cp = k & 15, n = np & 63;
        const float pr = Pre[(7 - s) * 64 + n], pi = Pim[(7 - s) * 64 + n], br = Bre[n * 16 + cp], bi = Bim[n * 16 + cp];
        WgT[np * S5_LD + k] = (bf16)f2bf(np < 64 ? pr * br - pi * bi : pr * bi + pi * br); }
#pragma unroll 4
    for (int i = 0; i < 32; ++i) { const int idx = tid + 512 * i, col = idx >> 7, np = idx & 127, t = col >> 4, c = col & 15, n = np & 63;
        const float pr = Pre[(t + 1) * 64 + n], pi = Pim[(t + 1) * 64 + n], cr = Cre[c * 64 + n], ci = Cim[c * 64 + n];
        VgT[col * S5_LD + np] = (bf16)f2bf(np < 64 ? cr * pr - ci * pi : -(cr * pi + ci * pr)); }
    __syncthreads();
    const bf16* PB = (const bf16*)(F.ws + WS_PB); bf16* GY = (bf16*)(F.ws + WS_GY);
    const int rb = wave >> 2, cb = wave & 3, r32 = lane & 31, hh = lane >> 5;
    float h_re = 0.f, h_im = 0.f;
    const float p8r = Pre[8 * 64 + lane], p8i = Pim[8 * 64 + lane];
    const float dl = F.in[15][g * 16 + (lane & 15)];
    for (int seg = 0; seg < 5; ++seg) {
        const bool samp = (seg == 4);
        const int tok0 = samp ? MP + 128 * b8 : b8 * PB_T + seg * 512;
        const int ntok = samp ? 128 : 512;
        if (tid < ntok) { const v4u* src = (const v4u*)(PB + (size_t)(tok0 + tid) * PBW + g * 16); const v4u a = src[0], b = src[1];
            LAS v4u* dst = (LAS v4u*)(Us + (tid >> 3) * S5_LD + (tid & 7) * 16); dst[0] = a; dst[1] = b; }
        __syncthreads();
        { f32x16 acc = {};
#pragma unroll
          for (int s = 0; s < 8; ++s) { const s16x8 a = *(const LAS s16x8*)(Us + (32 * rb + r32) * S5_LD + s * 16 + 8 * hh); const s16x8 b = *(const LAS s16x8*)(WgT + (32 * cb + r32) * S5_LD + s * 16 + 8 * hh);
              acc = __builtin_amdgcn_mfma_f32_32x32x16_bf16(a, b, acc, 0, 0, 0); }
#pragma unroll
          for (int r = 0; r < 16; ++r) HL[(32 * rb + (r & 3) + 8 * (r >> 2) + 4 * hh) * 128 + 32 * cb + r32] = acc[r]; }
        __syncthreads();
        if (wave == 0) {
            if (!samp) {
#pragma unroll 8
                for (int c = 0; c < 64; ++c) { const float xr = HL[c * 128 + lane], xi = HL[c * 128 + 64 + lane];
                    HS[c * S5_LD + lane] = (bf16)f2bf(h_re); HS[c * S5_LD + 64 + lane] = (bf16)f2bf(h_im);
                    const float nr = p8r * h_re - p8i * h_im + xr, ni = p8r * h_im + p8i * h_re + xi; h_re = nr; h_im = ni; }
                if (seg == 3) { F.out[O_PRE + (size_t)(b8 * S5G + g) * S5N + lane] = h_re; F.out[O_PIM + (size_t)(b8 * S5G + g) * S5N + lane] = h_im; }
            } else {
#pragma unroll 4
                for (int r = 0; r < 16; ++r) { const size_t idx = (size_t)((16 * b8 + r) * S5G + g) * S5N + lane; const float sr = F.in[2][idx], si = F.in[3][idx];
                    HS[r * S5_LD + lane] = (bf16)f2bf(sr); HS[r * S5_LD + 64 + lane] = (bf16)f2bf(si);
                    F.out[O_SRE + idx] = p8r * sr - p8i * si + HL[r * 128 + lane]; F.out[O_SIM + idx] = p8r * si + p8i * sr + HL[r * 128 + 64 + lane]; }
            }
        }
        __syncthreads();
        if (!(samp && rb == 1)) { f32x16 acc = {};
            const int tl = 2 * cb + ((lane >> 4) & 1), c = lane & 15;
#pragma unroll
            for (int s = 0; s < 8; ++s) if (s <= 2 * cb + 1) { const int j = tl - s, jj = j < 0 ? 8 : j;
                const s16x8 a = *(const LAS s16x8*)(Us + (32 * rb + r32) * S5_LD + s * 16 + 8 * hh); const s16x8 b = *(const LAS s16x8*)(Kc + (jj * 16 + c) * 16 + 8 * hh);
                acc = __builtin_amdgcn_mfma_f32_32x32x16_bf16(a, b, acc, 0, 0, 0); }
#pragma unroll
            for (int kb = 0; kb < 8; ++kb) { const s16x8 a = *(const LAS s16x8*)(HS + (32 * rb + r32) * S5_LD + kb * 16 + 8 * hh); const s16x8 b = *(const LAS s16x8*)(VgT + (32 * cb + r32) * S5_LD + kb * 16 + 8 * hh);
                acc = __builtin_amdgcn_mfma_f32_32x32x16_bf16(a, b, acc, 0, 0, 0); }
#pragma unroll
            for (int r = 0; r < 16; ++r) { const int row = 32 * rb + (r & 3) + 8 * (r >> 2) + 4 * hh;
                if (!samp || row < 16) { const float u = bf2f(Us[row * S5_LD + tl * 16 + c]); const float y = acc[r] + dl * u;
                    GY[(size_t)(tok0 + row * 8 + tl) * S5W + g * 16 + c] = (bf16)f2bf(gelu_tanh(y)); } }
        }
        __syncthreads();
    }
}
__device__ __forceinline__ void hgrn_simple_item(Frame& F, int item) {
    const int tid = F.tid, v = tid & 127, kq = tid >> 7;
    int h, tokbase, T; const float* S0 = nullptr; float* Sout;
    if (item < PB_B * HH) { const int b = item / HH; h = item % HH; tokbase = b * PB_T; T = PB_T; Sout = F.out + O_PHG + (size_t)item * HD * HD; }
    else { const int idx = item - PB_B * HH, b = idx / HH; h = idx % HH; tokbase = MP + b * SB_T; T = SB_T; S0 = F.in[4] + (size_t)idx * HD * HD; Sout = F.out + O_SHG + (size_t)idx * HD * HD; }
    float S[32];
#pragma unroll
    for (int j = 0; j < 32; ++j) S[j] = S0 ? S0[(size_t)(32 * kq + j) * HD + v] : 0.f;
    LAS float* Fs = (LAS float*)F.lds;
    LAS float* Ks = Fs + 1024;
    LAS float* Qs = Ks + 1024;
    LAS float* Vs = Qs + 1024;
    LAS float* OP = Vs + 1024;
    const bf16* PB = (const bf16*)(F.ws + WS_PB); const float* FZ = (const float*)(F.ws + WS_FZ); bf16* OH = (bf16*)(F.ws + WS_OH);
    float lb = 0.f;
    if (tid < 128) { const int col = h * HD + tid; lb = 1.0f / (1.0f + expf(F.in[5][512 + col] - F.in[5][col])); }
    for (int t0 = 0; t0 < T; t0 += 8) {
        if (tid < 128) {
#pragma unroll
            for (int tt = 0; tt < 8; ++tt) { const size_t tok = (size_t)(tokbase + t0 + tt); const float fz = FZ[tok * 512 + h * HD + tid];
                const float sg = 1.0f / (1.0f + expf(-fz)), f = lb + (1.0f - lb) * sg;
                Fs[tt * 128 + tid] = f; Ks[tt * 128 + tid] = 1.0f - f; Qs[tt * 128 + tid] = bf2f(PB[tok * PBW + 512 + h * HD + tid]); }
        } else if (tid < 256) { const int vv = tid - 128;
#pragma unroll
            for (int tt = 0; tt < 8; ++tt) Vs[tt * 128 + vv] = bf2f(PB[(size_t)(tokbase + t0 + tt) * PBW + 1024 + h * HD + vv]);
        }
        __syncthreads();
#pragma unroll 1
        for (int tt = 0; tt < 8; ++tt) { const float iv = Vs[tt * 128 + v]; float o = 0.f;
#pragma unroll
            for (int j = 0; j < 32; j += 4) { const f32x4 f4 = *(const LAS f32x4*)(Fs + tt * 128 + 32 * kq + j), k4 = *(const LAS f32x4*)(Ks + tt * 128 + 32 * kq + j), q4 = *(const LAS f32x4*)(Qs + tt * 128 + 32 * kq + j);
                S[j] = f4.x * S[j] + k4.x * iv; o += S[j] * q4.x; S[j + 1] = f4.y * S[j + 1] + k4.y * iv; o += S[j + 1] * q4.y;
                S[j + 2] = f4.z * S[j + 2] + k4.z * iv; o += S[j + 2] * q4.z; S[j + 3] = f4.w * S[j + 3] + k4.w * iv; o += S[j + 3] * q4.w; }
            OP[(tt * 4 + kq) * 128 + v] = o; }
        __syncthreads();
#pragma unroll
        for (int r = 0; r < 2; ++r) { const int idx = tid + 512 * r, tt = idx >> 7, vv = idx & 127;
            const float o = (OP[(tt * 4 + 0) * 128 + vv] + OP[(tt * 4 + 1) * 128 + vv]) + (OP[(tt * 4 + 2) * 128 + vv] + OP[(tt * 4 + 3) * 128 + vv]);
            OH[(size_t)(tokbase + t0 + tt) * HGW + h * HD + vv] = (bf16)f2bf(o); }
        __syncthreads();
    }
#pragma unroll
    for (int j = 0; j < 32; ++j) Sout[(size_t)(32 * kq + j) * HD + v] = S[j];
}

typedef float f32x4v __attribute__((ext_vector_type(4)));
constexpr int HG_LDQ = 136, HG_LDT = 72;
constexpr int LH_Q = 0, LH_K = 17408, LH_KT = 34816, LH_VT = 53248, LH_AT = 55552, LH_ST = 64768, LH_TOT = 69120, LH_CV = 71168;
__device__ __forceinline__ void hgrn_prompt_item(Frame& F, int item) {
    const int tid = F.tid, lane = F.lane, wave = F.wave;
    const int bh = item >> 3, vs = item & 7, b = bh >> 2, h = bh & 3;
    LAS bf16* Qs = (LAS bf16*)(F.lds + LH_Q); LAS bf16* Ks = (LAS bf16*)(F.lds + LH_K); LAS bf16* Kt = (LAS bf16*)(F.lds + LH_KT); LAS bf16* Vt = (LAS bf16*)(F.lds + LH_VT);
    LAS bf16* At = (LAS bf16*)(F.lds + LH_AT); LAS bf16* St = (LAS bf16*)(F.lds + LH_ST); LAS float* TOT = (LAS float*)(F.lds + LH_TOT); LAS float* CV = (LAS float*)(F.lds + LH_CV);
    const bf16* PB = (const bf16*)(F.ws + WS_PB); const float* FZ = (const float*)(F.ws + WS_FZ); bf16* OH = (bf16*)(F.ws + WS_OH);
    const int ch = tid & 127, tq = tid >> 7, col = h * HD + ch;
    const float lb = 1.0f / (1.0f + expf(F.in[5][512 + col] - F.in[5][col]));
    const int l15 = lane & 15, kg = lane >> 4;
    f32x4v S = {0.f, 0.f, 0.f, 0.f};
    for (int chunk = 0; chunk < PB_T / 64; ++chunk) {
        const int tok0 = b * PB_T + chunk * 64;
        float gl[16], kk[16], qq[16]; float run = 0.f;
#pragma unroll
        for (int i = 0; i < 16; ++i) { const size_t tok = (size_t)(tok0 + 16 * tq + i); const float fz = FZ[tok * 512 + col]; qq[i] = bf2f(PB[tok * PBW + 512 + col]);
            const float sg = 1.0f / (1.0f + __expf(-fz)), f = lb + (1.0f - lb) * sg; kk[i] = 1.0f - f; run += __log2f(f); gl[i] = run; }
        TOT[tq * 128 + ch] = run;
        { const int tk = tid >> 3, vp = (tid & 7) * 2; const unsigned w = *(const unsigned*)(PB + (size_t)(tok0 + tk) * PBW + 1024 + h * HD + 16 * vs + vp);
          Vt[vp * HG_LDT + tk] = (bf16)(w & 0xffffu); Vt[(vp + 1) * HG_LDT + tk] = (bf16)(w >> 16); }
        __syncthreads();
        { const float t0 = TOT[ch], t1 = TOT[128 + ch], t2 = TOT[256 + ch], t3 = TOT[384 + ch];
          const float gref = t0 + t1, glast = gref + t2 + t3, off = (tq == 0 ? 0.f : tq == 1 ? t0 : tq == 2 ? gref : gref + t2);
          unsigned kp[8];
#pragma unroll
          for (int i = 0; i < 16; ++i) { const float e1 = __builtin_amdgcn_exp2f(off + gl[i] - gref), e2 = __builtin_amdgcn_rcpf(e1);
              const unsigned qb = f2bf(qq[i] * e1), kb = f2bf(kk[i] * e2);
              Qs[(16 * tq + i) * HG_LDQ + ch] = (bf16)qb; Ks[(16 * tq + i) * HG_LDQ + ch] = (bf16)kb;
              if (i & 1) kp[i >> 1] |= kb << 16; else kp[i >> 1] = kb; }
          LAS v4u* kd = (LAS v4u*)(Kt + ch * HG_LDT + 16 * tq); v4u a, c2; a.x = kp[0]; a.y = kp[1]; a.z = kp[2]; a.w = kp[3]; c2.x = kp[4]; c2.y = kp[5]; c2.z = kp[6]; c2.w = kp[7]; kd[0] = a; kd[1] = c2;
          if (tq == 0) { CV[ch] = __builtin_amdgcn_exp2f(gref); CV[128 + ch] = __builtin_amdgcn_exp2f(glast); CV[256 + ch] = __builtin_amdgcn_exp2f(glast - gref); } }
        __syncthreads();
        { const int k0 = 16 * wave + 4 * kg; v2u w; w.x = pk2(CV[k0] * S[0], CV[k0 + 1] * S[1]); w.y = pk2(CV[k0 + 2] * S[2], CV[k0 + 3] * S[3]); *(LAS v2u*)(St + l15 * HG_LDQ + k0) = w; }
        { const int tb = wave >> 1;
#pragma unroll
          for (int sbi = 0; sbi < 2; ++sbi) { const int sb = 2 * (wave & 1) + sbi; f32x4v acc = {0.f, 0.f, 0.f, 0.f};
#pragma unroll
              for (int ks = 0; ks < 4; ++ks) { const s16x8 a = *(const LAS s16x8*)(Qs + (16 * tb + l15) * HG_LDQ + 32 * ks + 8 * kg); const s16x8 bb = *(const LAS s16x8*)(Ks + (16 * sb + l15) * HG_LDQ + 32 * ks + 8 * kg);
                  acc = __builtin_amdgcn_mfma_f32_16x16x32_bf16(a, bb, acc, 0, 0, 0); }
              const int s = 16 * sb + l15;
#pragma unroll
              for (int r = 0; r < 4; ++r) { const int t = 16 * tb + 4 * kg + r; At[t * HG_LDT + s] = (s <= t) ? (bf16)f2bf(acc[r]) : (bf16)0; } } }
        __syncthreads();
        if (wave < 4) { const int tb = wave; f32x4v acc = {0.f, 0.f, 0.f, 0.f};
#pragma unroll
            for (int ks = 0; ks < 2; ++ks) { const s16x8 a = *(const LAS s16x8*)(At + (16 * tb + l15) * HG_LDT + 32 * ks + 8 * kg); const s16x8 bb = *(const LAS s16x8*)(Vt + l15 * HG_LDT + 32 * ks + 8 * kg);
                acc = __builtin_amdgcn_mfma_f32_16x16x32_bf16(a, bb, acc, 0, 0, 0); }
#pragma unroll
            for (int ks = 0; ks < 4; ++ks) { const s16x8 a = *(const LAS s16x8*)(Qs + (16 * tb + l15) * HG_LDQ + 32 * ks + 8 * kg); const s16x8 bb = *(const LAS s16x8*)(St + l15 * HG_LDQ + 32 * ks + 8 * kg);
                acc = __builtin_amdgcn_mfma_f32_16x16x32_bf16(a, bb, acc, 0, 0, 0); }
#pragma unroll
            for (int r = 0; r < 4; ++r) OH[(size_t)(tok0 + 16 * tb + 4 * kg + r) * HGW + h * HD + 16 * vs + l15] = (bf16)f2bf(acc[r]); }
        { f32x4v acc = {0.f, 0.f, 0.f, 0.f};
#pragma unroll
          for (int ks = 0; ks < 2; ++ks) { const s16x8 a = *(const LAS s16x8*)(Kt + (16 * wave + l15) * HG_LDT + 32 * ks + 8 * kg); const s16x8 bb = *(const LAS s16x8*)(Vt + l15 * HG_LDT + 32 * ks + 8 * kg);
              acc = __builtin_amdgcn_mfma_f32_16x16x32_bf16(a, bb, acc, 0, 0, 0); }
          const int k0 = 16 * wave + 4 * kg;
#pragma unroll
          for (int r = 0; r < 4; ++r) S[r] = CV[128 + k0 + r] * S[r] + CV[256 + k0 + r] * acc[r]; }
        __syncthreads();
    }
    { const int k0 = 16 * wave + 4 * kg;
#pragma unroll
      for (int r = 0; r < 4; ++r) F.out[O_PHG + ((size_t)bh * HD + k0 + r) * HD + 16 * vs + l15] = S[r]; }
}
constexpr int LX_Q = 0, LX_K2 = 4096, LX_K3 = 8192, LX_V = 12288, LX_DEC = 16384, LX_ATT = 16896, LX_OP = 17152;
__device__ __forceinline__ void hgrn_sample_item(Frame& F, int idx) {
    const int tid = F.tid, b = idx >> 2, h = idx & 3;
    LAS float* Qs = (LAS float*)(F.lds + LX_Q); LAS float* K2 = (LAS float*)(F.lds + LX_K2); LAS float* K3 = (LAS float*)(F.lds + LX_K3); LAS float* Vs = (LAS float*)(F.lds + LX_V);
    LAS float* DEC = (LAS float*)(F.lds + LX_DEC); LAS float* ATT = (LAS float*)(F.lds + LX_ATT); LAS float* OP = (LAS float*)(F.lds + LX_OP);
    const bf16* PB = (const bf16*)(F.ws + WS_PB); const float* FZ = (const float*)(F.ws + WS_FZ); bf16* OH = (bf16*)(F.ws + WS_OH);
    const float* S0 = F.in[4] + (size_t)idx * HD * HD; float* Sout = F.out + O_SHG + (size_t)idx * HD * HD;
    const int tok0 = MP + b * SB_T;
    const int v = tid & 127, kq = tid >> 7;
    float s0[32];
#pragma unroll
    for (int j = 0; j < 32; ++j) s0[j] = S0[(size_t)(32 * kq + j) * HD + v];
    if (tid < 128) { const int col = h * HD + tid; const float lb = 1.0f / (1.0f + expf(F.in[5][512 + col] - F.in[5][col]));
        float gl[8], kk[8], qq[8]; float run = 0.f;
#pragma unroll
        for (int t = 0; t < 8; ++t) { const size_t tok = (size_t)(tok0 + t); const float fz = FZ[tok * 512 + col]; qq[t] = bf2f(PB[tok * PBW + 512 + col]);
            const float sg = 1.0f / (1.0f + __expf(-fz)), f = lb + (1.0f - lb) * sg; kk[t] = 1.0f - f; run += __log2f(f); gl[t] = run; }
#pragma unroll
        for (int t = 0; t < 8; ++t) { Qs[t * 128 + tid] = qq[t] * __builtin_amdgcn_exp2f(gl[t]); K2[t * 128 + tid] = kk[t] * __builtin_amdgcn_exp2f(-gl[t]); K3[t * 128 + tid] = kk[t] * __builtin_amdgcn_exp2f(run - gl[t]); }
        DEC[tid] = __builtin_amdgcn_exp2f(run);
    } else if (tid < 256) { const int vv = tid - 128;
#pragma unroll
        for (int t = 0; t < 8; ++t) Vs[t * 128 + vv] = bf2f(PB[(size_t)(tok0 + t) * PBW + 1024 + h * HD + vv]);
    }
    __syncthreads();
    { const int p = tid >> 3, part = tid & 7, t = p >> 3, s = p & 7; float a = 0.f;
#pragma unroll
      for (int j = 0; j < 16; ++j) a += Qs[t * 128 + part + 8 * j] * K2[s * 128 + part + 8 * j];
      a += __shfl_xor(a, 1); a += __shfl_xor(a, 2); a += __shfl_xor(a, 4);
      if (part == 0) ATT[p] = (s <= t) ? a : 0.f; }
    float vr[8], o[8];
#pragma unroll
    for (int t = 0; t < 8; ++t) { vr[t] = Vs[t * 128 + v]; o[t] = 0.f; }
#pragma unroll
    for (int j = 0; j < 32; ++j) { const int k = 32 * kq + j; const float sv = s0[j]; float sn = DEC[k] * sv;
#pragma unroll
        for (int t = 0; t < 8; ++t) { o[t] += Qs[t * 128 + k] * sv; sn += K3[t * 128 + k] * vr[t]; }
        Sout[(size_t)k * HD + v] = sn; }
#pragma unroll
    for (int t = 0; t < 8; ++t) OP[(kq * 8 + t) * 128 + v] = o[t];
    __syncthreads();
#pragma unroll
    for (int r = 0; r < 2; ++r) { const int e = tid + 512 * r, t = e >> 7, vv = e & 127;
        float acc = (OP[(0 * 8 + t) * 128 + vv] + OP[(1 * 8 + t) * 128 + vv]) + (OP[(2 * 8 + t) * 128 + vv] + OP[(3 * 8 + t) * 128 + vv]);
#pragma unroll
        for (int s = 0; s < 8; ++s) acc += ATT[t * 8 + s] * Vs[s * 128 + vv];
        OH[(size_t)(tok0 + t) * HGW + h * HD + vv] = (bf16)f2bf(acc); }
    __syncthreads();
}
__device__ __forceinline__ void hg_normgate_row(Frame& F, int tok) {
    const int lane = F.lane;
    const bf16* OH = (const bf16*)(F.ws + WS_OH); const bf16* PB = (const bf16*)(F.ws + WS_PB); bf16* MIX = (bf16*)(F.ws + WS_MIX);
    const v4u o8 = *(const GAS v4u*)(OH + (size_t)tok * HGW + 8 * lane);
    const v4u g8 = *(const GAS v4u*)(PB + (size_t)tok * PBW + 1536 + 8 * lane);
    float o[8] = {bflo(o8.x), bfhi(o8.x), bflo(o8.y), bfhi(o8.y), bflo(o8.z), bfhi(o8.z), bflo(o8.w), bfhi(o8.w)};
    float gt[8] = {bflo(g8.x), bfhi(g8.x), bflo(g8.y), bfhi(g8.y), bflo(g8.z), bfhi(g8.z), bflo(g8.w), bfhi(g8.w)};
    float ss = 0.f;
#pragma unroll
    for (int j = 0; j < 8; ++j) ss += o[j] * o[j];
    ss += __shfl_xor(ss, 1); ss += __shfl_xor(ss, 2); ss += __shfl_xor(ss, 4); ss += __shfl_xor(ss, 8);
    const float rstd = 1.0f / sqrtf(ss * (1.0f / HD) + EPS);
    const f32x4 n0 = *(const GAS f32x4*)(F.in[17] + ((8 * lane) & 127)), n1 = *(const GAS f32x4*)(F.in[17] + ((8 * lane) & 127) + 4);
    const float gn[8] = {n0.x, n0.y, n0.z, n0.w, n1.x, n1.y, n1.z, n1.w};
    float r[8];
#pragma unroll
    for (int j = 0; j < 8; ++j) r[j] = o[j] * rstd * gn[j] * siluf_(gt[j]);
    v4u w; w.x = pk2(r[0], r[1]); w.y = pk2(r[2], r[3]); w.z = pk2(r[4], r[5]); w.w = pk2(r[6], r[7]);
    *(GAS v4u*)(MIX + (size_t)tok * DM + 512 + 8 * lane) = w;
}
__device__ __forceinline__ void final_norm_row(Frame& F, int m) {
    GAS f32x4* xr = (GAS f32x4*)(F.out + O_Y + (size_t)m * DM) + F.lane;
    f32x4 v[4]; float s = 0.f;
#pragma unroll
    for (int j = 0; j < 4; ++j) { v[j] = xr[64 * j]; s += (v[j].x * v[j].x + v[j].y * v[j].y) + (v[j].z * v[j].z + v[j].w * v[j].w); }
    const float rstd = 1.0f / sqrtf(wave_sum(s) * (1.0f / DM) + EPS);
#pragma unroll
    for (int j = 0; j < 4; ++j) { const f32x4 g = ((const GAS f32x4*)F.in[23])[F.lane + 64 * j]; f32x4 o; o.x = v[j].x * rstd * g.x; o.y = v[j].y * rstd * g.y; o.z = v[j].z * rstd * g.z; o.w = v[j].w * rstd * g.w; xr[64 * j] = o; }
}

__global__ void __launch_bounds__(NWAVES * 64, 2) mk_fwd(Args args) {
    extern __shared__ __attribute__((aligned(16))) unsigned char lds[];
    Frame F;
    F.lds = (LAS unsigned char*)lds;
    F.tid = threadIdx.x; F.lane = F.tid & 63; F.wave = __builtin_amdgcn_readfirstlane(F.tid >> 6);
    F.G = gridDim.x; F.bid = blockIdx.x;
#pragma unroll
    for (int i = 0; i < 24; ++i) F.in[i] = args.in[i];
    F.out = args.out; F.ws = args.ws;
    const int lo = args.ph_lo, hi = args.ph_hi;
#define IN(k) (lo <= (k) && (k) < hi)
#if MK_N_LAUNCHES == 1
    cg::grid_group grid = cg::this_grid();
#define SEAM(k) do { if (IN(k) && IN((k) + 1)) grid.sync(); } while (0)
#else
#define SEAM(k) do { } while (0)
#endif
    const int gw = F.bid * NWAVES + F.wave, NGW = F.G * NWAVES;
    bf16* XN = (bf16*)(F.ws + WS_XN); bf16* PB = (bf16*)(F.ws + WS_PB); float* FZ = (float*)(F.ws + WS_FZ); bf16* GY = (bf16*)(F.ws + WS_GY);
    bf16* MIX = (bf16*)(F.ws + WS_MIX); bf16* ACT = (bf16*)(F.ws + WS_ACT);

    if (IN(0)) { p0_prologue(F); } SEAM(0);
    if (IN(1)) {
        pg8::Gemm g{XN, (const bf16*)(F.ws + WS_WIN), MTOK, INC, DM}; pg8::StaticOrder S; S.init(MTOK, INC, F.G, F.bid);
        EpiIn E{PB, FZ};
        pg8::gemm_phase<EpiIn, pg8::StaticOrder, true, true>(F.lds, g, S, E);
    } SEAM(1);
    if (IN(2)) {
#if S5_SIMPLE
        for (int it = gw; it < PB_B * S5G + SB_B * S5G; it += NGW) s5_simple_item(F, it);
        __syncthreads();
#else
        for (int it = F.bid; it < 256; it += F.G) { s5_fast_item(F, it); __syncthreads(); }
#endif
#if HG_SIMPLE
        for (int it = F.bid; it < PB_B * HH + SB_B * HH; it += F.G) { hgrn_simple_item(F, it); __syncthreads(); }
#else
        for (int it = F.bid; it < 256; it += F.G) { const int x = it & 7, i = it >> 3; hgrn_prompt_item(F, ((x * 4 + (i >> 3)) << 3) | (i & 7)); }
        for (int it = F.bid; it < SB_B * HH; it += F.G) hgrn_sample_item(F, it);
#endif
    } SEAM(2);
    if (IN(3)) {
        pg8::Gemm g{GY, (const bf16*)(F.ws + WS_WGLU), MTOK, S5W, S5W}; pg8::StaticOrder S; S.init(MTOK, S5W, F.G, F.bid);
        EpiGlu E{GY, MIX};
        pg8::gemm_phase<EpiGlu, pg8::StaticOrder, true, true>(F.lds, g, S, E);
        for (int m = gw; m < MTOK; m += NGW) hg_normgate_row(F, m);
    } SEAM(3);
    if (IN(4)) {
        pg8::Gemm g{MIX, (const bf16*)(F.ws + WS_WOUT), MTOK, DM, DM}; pg8::StaticOrder S; S.init(MTOK, DM, F.G, F.bid);
        EpiOut E{F.in[0], F.in[1], F.out + O_Y};
        pg8::gemm_phase<EpiOut, pg8::StaticOrder, true, true>(F.lds, g, S, E);
    } SEAM(4);
    if (IN(5)) {
        for (int m = gw; m < MTOK; m += NGW) rms_row_bf16(F.out + O_Y + (size_t)m * DM, F.in[19], XN + (size_t)m * DM, F.lane);
    } SEAM(5);
    if (IN(6)) {
        pg8::Gemm g{XN, (const bf16*)(F.ws + WS_WGU), MTOK, 2 * DFF, DM}; pg8::StaticOrder S; S.init(MTOK, 2 * DFF, F.G, F.bid);
        EpiAct E{ACT};
        pg8::gemm_phase<EpiAct, pg8::StaticOrder, true, true>(F.lds, g, S, E);
    } SEAM(6);
    if (IN(7)) {
        pg8::Gemm g{ACT, (const bf16*)(F.ws + WS_WD), MTOK, DM, DFF}; pg8::StaticOrder S; S.init(MTOK, DM, F.G, F.bid);
        EpiDown E{F.out + O_Y};
        pg8::gemm_phase<EpiDown, pg8::StaticOrder, true, true>(F.lds, g, S, E);
    } SEAM(7);
    if (IN(8)) {
        for (int m = gw; m < MTOK; m += NGW) final_norm_row(F, m);
    }
#undef IN
#undef SEAM
}

extern "C" void kernel_launch(void* const* d_in, const int* in_sizes, int n_in, void* d_out, int out_size, void* d_ws, size_t ws_size, hipStream_t stream) {
    static int grid = 0;
    if (grid == 0) {
        if (n_in != 24 || ws_size < WS_END) { fprintf(stderr, "kernel_launch: unexpected n_in %d / ws %zu\n", n_in, ws_size); grid = -1; return; }
        int dev = 0, cus = 0, per_cu = 0;
        if (hipGetDevice(&dev) != hipSuccess || hipDeviceGetAttribute(&cus, hipDeviceAttributeMultiprocessorCount, dev) != hipSuccess) { grid = -1; return; }
        if (hipFuncSetAttribute((const void*)mk_fwd, hipFuncAttributeMaxDynamicSharedMemorySize, LDS_BYTES) != hipSuccess) { fprintf(stderr, "kernel_launch: hipFuncSetAttribute failed\n"); grid = -1; return; }
        if (hipOccupancyMaxActiveBlocksPerMultiprocessor(&per_cu, (const void*)mk_fwd, NWAVES * 64, LDS_BYTES) != hipSuccess || per_cu < 1) { fprintf(stderr, "kernel_launch: occupancy query says %d\n", per_cu); per_cu = 1; }
        (void)hipGetLastError();
        grid = cus;
    }
    if (grid < 0) return;
    Args a{};
    for (int i = 0; i < 24; ++i) a.in[i] = (const float*)d_in[i];
    a.out = (float*)d_out; a.ws = (unsigned char*)d_ws;
#if MK_N_LAUNCHES == 1
    a.ph_lo = 0; a.ph_hi = NPH;
    void* kargs[] = {&a};
    hipError_t e = hipLaunchCooperativeKernel((const void*)mk_fwd, dim3(grid), dim3(NWAVES * 64), kargs, LDS_BYTES, stream);
    if (e != hipSuccess) fprintf(stderr, "kernel_launch: cooperative launch failed: %s (grid %d)\n", hipGetErrorString(e), grid);
#else
    for (int p = 0; p < NPH; ++p) { a.ph_lo = p; a.ph_hi = p + 1; hipLaunchKernelGGL(mk_fwd, dim3(grid), dim3(NWAVES * 64), LDS_BYTES, stream, a); }
#endif
}
```

```cpp
#include <hip/hip_runtime.h>
#include <hip/hip_cooperative_groups.h>
#include <cstdio>
#include <cstdint>
namespace cg = cooperative_groups;
#define MK_N_LAUNCHES 1
namespace pg8 {
#define PG8_LAS __attribute__((address_space(3)))
typedef unsigned short bf16_t;
typedef short bf16x8 __attribute__((ext_vector_type(8)));
typedef float f32x4 __attribute__((ext_vector_type(4)));
typedef unsigned u32x4 __attribute__((ext_vector_type(4)));
constexpr int BM = 256, BK = 64, HALF = 128, HTB = HALF * BK * 2  , STAGE_BYTES = 8 * HTB, NXCD = 8, WGM = 8;

__host__ __device__ __forceinline__ int lds_byte(int r, int c) { const int st = (r >> 4) * 2 + (c >> 5), rr = r & 15, cc = c & 31, ob = rr * 64 + cc * 2; return st * 1024 + (ob ^ (((ob >> 9) & 1) << 5)); }
__host__ __device__ __forceinline__ void stage_rc(int b, int& R, int& C) { const int st = b / 1024, sb = b % 1024, swz = sb ^ (((sb >> 9) & 1) << 5); R = (st >> 1) * 16 + swz / 64; C = (st & 1) * 32 + (swz % 64) / 2; }
__host__ __device__ __forceinline__ int perm32(int rho) { const int n = rho >> 4, i = rho & 15; return 8 * (i >> 2) + 4 * n + (i & 3); }

struct Unit { int pm, pn; };
struct Gemm { const bf16_t* A; const bf16_t* Bt; int M, N, K; };

struct StaticOrder {
    int nM, nN, nwg, G, c;
    __host__ __device__ void init(int M, int N, int G_, int c_) { nM = M / BM; nN = N / BM; nwg = nM * nN; G = G_; c = c_; }
    __host__ __device__ bool next(int i, Unit& u) const {
        const long L = (long)i * G + c; if (L >= nwg) return false;
        int wgid = (int)L; { const int q = nwg / NXCD, r = nwg % NXCD, xcd = wgid % NXCD, off = wgid / NXCD; wgid = (xcd < r ? xcd * (q + 1) : r * (q + 1) + (xcd - r) * q) + off; }
        const int nig = WGM * nN, gid = wgid / nig, fm = gid * WGM, gsz = (nM - fm) < WGM ? (nM - fm) : WGM;
        u.pm = fm + ((wgid % nig) % gsz); u.pn = (wgid % nig) / gsz; return true;
    }
    __device__ __forceinline__ void a_ready(const Unit&) const {}
    __device__ __forceinline__ void done(const Unit&) const {}
};

__device__ __forceinline__ unsigned cvt_pk_bf16(float lo, float hi) { unsigned r; asm volatile("v_cvt_pk_bf16_f32 %0, %1, %2" : "=v"(r) : "v"(lo), "v"(hi)); return r; }
template <class Epi, class Sched, bool ALIGN_EPI = false, bool SP2 = false>
__device__ __forceinline__ void gemm_phase(PG8_LAS unsigned char* lds, const Gemm g, const Sched& S, const Epi& E) {
    const int tid = threadIdx.x, wid = __builtin_amdgcn_readfirstlane(tid >> 6), lane = tid & 63, wr = wid >> 2, wc = wid & 3, fr = lane & 15, fq = lane >> 4;
    const int K = g.K, nt = K / BK;
    unsigned voffA[2], voffB[2];
#pragma unroll
    for (int i = 0; i < 2; ++i) { int R, C; stage_rc(tid * 16 + i * 8192, R, C); const int Rb = Epi::PERM ? ((R & ~31) + perm32(R & 31)) : R;
        voffA[i] = (unsigned)(R * K + C) * 2u; voffB[i] = (unsigned)(Rb * K + C) * 2u; }
    const size_t kstep = (size_t)(BK * 2);
    const size_t hstep = (size_t)HALF * K * 2;
    const size_t tstep = 2 * hstep;
    const unsigned ldsw = (unsigned)wid * 1024u;
    const int aoff = lds_byte(wr * 64 + fr, fq * 8), boff = lds_byte(wc * 32 + fr, fq * 8);
#define PG8_SA(b, h) (((b) * 2 + (h)) * HTB)
#define PG8_SB(b, h) ((4 + (b) * 2 + (h)) * HTB)
#define PG8_STAGE(bufoff, gbase, voff) do { _Pragma("unroll") for (int _i = 0; _i < 2; ++_i) \
        __builtin_amdgcn_global_load_lds((const unsigned*)((const char*)(gbase) + (voff)[_i]), (PG8_LAS unsigned*)(lds + (bufoff) + ldsw + _i * 8192), 16, 0, 0); } while (0)
#define PG8_LDA(dst, b, h) do { _Pragma("unroll") for (int m = 0; m < 4; ++m) _Pragma("unroll") for (int k = 0; k < 2; ++k) dst[m][k] = *(const PG8_LAS bf16x8*)(lds + PG8_SA(b, h) + aoff + m * 2048 + k * 1024); } while (0)
#define PG8_LDB(dst, b, h) do { _Pragma("unroll") for (int n = 0; n < 2; ++n) _Pragma("unroll") for (int k = 0; k < 2; ++k) dst[n][k] = *(const PG8_LAS bf16x8*)(lds + PG8_SB(b, h) + boff + n * 2048 + k * 1024); } while (0)
#define PG8_MMA(ai, bj, At, Bt) do { __builtin_amdgcn_s_setprio(1); _Pragma("unroll") for (int m = 0; m < 4; ++m) _Pragma("unroll") for (int n = 0; n < 2; ++n) _Pragma("unroll") for (int k = 0; k < 2; ++k) \
        acc[ai][bj][m][n] = __builtin_amdgcn_mfma_f32_16x16x32_bf16(Bt[n][k], At[m][k], acc[ai][bj][m][n], 0, 0, 0); __builtin_amdgcn_s_setprio(0); } while (0)
#define PG8_WAIT_V(n) asm volatile("s_waitcnt vmcnt(" #n ")" ::: "memory")
#define PG8_WAIT_L(n) asm volatile("s_waitcnt lgkmcnt(" #n ")" ::: "memory")
#define PG8_BAR __builtin_amdgcn_s_barrier()
#define PG8_SCHED __builtin_amdgcn_sched_barrier(0)
    Unit cur, nxt; int ui = 0;
    if (!S.next(0, cur)) return;
    f32x4 acc[2][2][4][2];
#pragma unroll
    for (int a = 0; a < 2; ++a)
#pragma unroll
        for (int b = 0; b < 2; ++b)
#pragma unroll
            for (int m = 0; m < 4; ++m)
#pragma unroll
                for (int n = 0; n < 2; ++n) acc[a][b][m][n] = (f32x4){0.f, 0.f, 0.f, 0.f};
    bf16x8 At[4][2], B0[2][2], B1[2][2];
    const char* cA = (const char*)g.A + (size_t)cur.pm * tstep; const char* cB = (const char*)g.Bt + (size_t)cur.pn * tstep;
    S.a_ready(cur);
    if constexpr (SP2) {
        PG8_STAGE(PG8_SB(0, 0), cB, voffB); PG8_STAGE(PG8_SB(0, 1), cB + hstep, voffB); PG8_STAGE(PG8_SA(0, 0), cA, voffA); PG8_STAGE(PG8_SA(0, 1), cA + hstep, voffA);
        if (wr == 1) PG8_BAR;
        PG8_WAIT_V(2); PG8_BAR;
        PG8_STAGE(PG8_SB(1, 0), cB + kstep, voffB); PG8_STAGE(PG8_SA(1, 0), cA + kstep, voffA); PG8_STAGE(PG8_SB(1, 1), cB + hstep + kstep, voffB);
        PG8_WAIT_V(6); PG8_BAR;
    } else {
        PG8_STAGE(PG8_SB(0, 0), cB, voffB); PG8_STAGE(PG8_SA(0, 0), cA, voffA); PG8_STAGE(PG8_SB(0, 1), cB + hstep, voffB); PG8_STAGE(PG8_SA(0, 1), cA + hstep, voffA);
        if (wr == 1) PG8_BAR;
        PG8_WAIT_V(4); PG8_BAR;
        PG8_STAGE(PG8_SB(1, 0), cB + kstep, voffB); PG8_STAGE(PG8_SA(1, 0), cA + kstep, voffA); PG8_STAGE(PG8_SB(1, 1), cB + hstep + kstep, voffB);
        PG8_WAIT_V(6); PG8_BAR;
    }
    for (;;) {
        const bool has_next = S.next(ui + 1, nxt);
        const char* nA = has_next ? (const char*)g.A + (size_t)nxt.pm * tstep : cA; const char* nB = has_next ? (const char*)g.Bt + (size_t)nxt.pn * tstep : cB;
        for (int t = 0; t < nt; t += 2) {
            const bool last = (t == nt - 2);
            const char* a1 = cA + (size_t)(t + 1) * kstep;
            const char* a2 = last ? nA : cA + (size_t)(t + 2) * kstep; const char* b2 = last ? nB : cB + (size_t)(t + 2) * kstep;
            const char* a3 = a2 + kstep; const char* b3 = b2 + kstep;
            if (last && has_next) S.a_ready(nxt);
            if constexpr (SP2) {
            PG8_LDB(B0, 0, 0); PG8_LDB(B1, 0, 1); PG8_SCHED; PG8_LDA(At, 0, 0); PG8_STAGE(PG8_SA(1, 1), a1 + hstep, voffA);
            PG8_WAIT_V(8); PG8_WAIT_L(0); PG8_BAR; PG8_MMA(0, 0, At, B0); PG8_MMA(0, 1, At, B1); PG8_BAR; PG8_SCHED;
            PG8_LDA(At, 0, 1); PG8_STAGE(PG8_SB(0, 0), b2, voffB); PG8_STAGE(PG8_SB(0, 1), b2 + hstep, voffB); PG8_STAGE(PG8_SA(0, 0), a2, voffA);
            PG8_WAIT_V(8); PG8_WAIT_L(0); PG8_BAR; PG8_MMA(1, 0, At, B0); PG8_MMA(1, 1, At, B1); PG8_BAR; PG8_SCHED;
            PG8_LDB(B0, 1, 0); PG8_LDB(B1, 1, 1); PG8_SCHED; PG8_LDA(At, 1, 0); PG8_STAGE(PG8_SA(0, 1), a2 + hstep, voffA);
            PG8_WAIT_V(8); PG8_WAIT_L(0); PG8_BAR; PG8_MMA(0, 0, At, B0); PG8_MMA(0, 1, At, B1); PG8_BAR; PG8_SCHED;
            PG8_LDA(At, 1, 1); PG8_STAGE(PG8_SB(1, 0), b3, voffB); PG8_STAGE(PG8_SB(1, 1), b3 + hstep, voffB); PG8_STAGE(PG8_SA(1, 0), a3, voffA);
            PG8_WAIT_V(8); PG8_WAIT_L(0); PG8_BAR; PG8_MMA(1, 0, At, B0); PG8_MMA(1, 1, At, B1); PG8_BAR; PG8_SCHED;
            } else {
            PG8_LDB(B0, 0, 0); PG8_SCHED; PG8_LDA(At, 0, 0); PG8_STAGE(PG8_SA(1, 1), a1 + hstep, voffA);
            PG8_WAIT_L(8); PG8_BAR; PG8_WAIT_L(0); PG8_MMA(0, 0, At, B0); PG8_BAR; PG8_SCHED;
            PG8_LDB(B1, 0, 1); PG8_STAGE(PG8_SB(0, 0), b2, voffB);
            PG8_BAR; PG8_WAIT_L(0); PG8_MMA(0, 1, At, B1); PG8_BAR;
            PG8_LDA(At, 0, 1); PG8_STAGE(PG8_SA(0, 0), a2, voffA);
            PG8_BAR; PG8_WAIT_L(0); PG8_MMA(1, 0, At, B0); PG8_BAR; PG8_SCHED;
            PG8_STAGE(PG8_SB(0, 1), b2 + hstep, voffB);
            PG8_WAIT_V(6); PG8_BAR; PG8_MMA(1, 1, At, B1); PG8_BAR;
            PG8_LDB(B0, 1, 0); PG8_SCHED; PG8_LDA(At, 1, 0); PG8_STAGE(PG8_SA(0, 1), a2 + hstep, voffA);
            PG8_WAIT_L(8); PG8_BAR; PG8_WAIT_L(0); PG8_MMA(0, 0, At, B0); PG8_BAR; PG8_SCHED;
            PG8_LDB(B1, 1, 1); PG8_STAGE(PG8_SB(1, 0), b3, voffB);
            PG8_BAR; PG8_WAIT_L(0); PG8_MMA(0, 1, At, B1); PG8_BAR;
            PG8_LDA(At, 1, 1); PG8_STAGE(PG8_SA(1, 0), a3, voffA);
            PG8_BAR; PG8_WAIT_L(0); PG8_MMA(1, 0, At, B0); PG8_BAR; PG8_SCHED;
            PG8_STAGE(PG8_SB(1, 1), b3 + hstep, voffB);
            PG8_WAIT_V(6); PG8_BAR; PG8_MMA(1, 1, At, B1); PG8_BAR;
            }
        }
        if constexpr (ALIGN_EPI) { if (wr == 0) PG8_BAR; }
        if constexpr (!Epi::AFTER_DRAIN) { E(acc, cur, wr, wc, fr, fq); S.done(cur); }
        if (!has_next) break;
#pragma unroll
        for (int a = 0; a < 2; ++a)
#pragma unroll
            for (int b = 0; b < 2; ++b)
#pragma unroll
                for (int m = 0; m < 4; ++m)
#pragma unroll
                    for (int n = 0; n < 2; ++n) acc[a][b][m][n] = (f32x4){0.f, 0.f, 0.f, 0.f};
        cur = nxt; cA = nA; cB = nB; ++ui;
        if constexpr (ALIGN_EPI) { if (wr == 1) PG8_BAR; }
    }
    PG8_WAIT_V(0);
    if constexpr (!ALIGN_EPI) { if (wr == 0) PG8_BAR; }
    PG8_BAR;
    if constexpr (Epi::AFTER_DRAIN) { E.fused(acc, cur, wr, wc, fr, fq, lds, wid, lane); S.done(cur); }
#undef PG8_SA
#undef PG8_SB
#undef PG8_STAGE
#undef PG8_LDA
#undef PG8_LDB
#undef PG8_MMA
#undef PG8_WAIT_V
#undef PG8_WAIT_L
#undef PG8_BAR
#undef PG8_SCHED
}
}

#ifndef S5_SIMPLE
#define S5_SIMPLE 0
#endif
#ifndef HG_SIMPLE
#define HG_SIMPLE 0
#endif
#ifndef MK_N_LAUNCHES
#define MK_N_LAUNCHES 1
#endif
constexpr int DM = 1024, PB_B = 8, PB_T = 2048, SB_B = 128, SB_T = 8;
constexpr int MP = PB_B * PB_T, MS = SB_B * SB_T, MTOK = MP + MS;
constexpr int S5W = 512, S5G = 32, S5C = 16, S5N = 64;
constexpr int HGW = 512, HD = 128, HH = 4;
constexpr int INC = 2560, DFF = 2816;
constexpr float EPS = 1e-6f;
constexpr int NPH = 9;
constexpr size_t O_Y = 0, O_PRE = (size_t)MTOK * DM, O_PIM = O_PRE + 16384, O_PHG = O_PIM + 16384, O_SRE = O_PHG + 524288, O_SIM = O_SRE + 262144, O_SHG = O_SIM + 262144;
constexpr size_t MiB = 1u << 20;
constexpr size_t WS_CTL = 0, WS_WIN = 2 * MiB, WS_WGLU = 7 * MiB, WS_WOUT = 8 * MiB, WS_WGU = 10 * MiB, WS_WD = 21 * MiB;
constexpr size_t WS_XN = 27 * MiB, WS_PB = 61 * MiB, WS_FZ = 129 * MiB, WS_ACT = 61 * MiB, WS_GY = 163 * MiB, WS_OH = 180 * MiB, WS_MIX = 197 * MiB, WS_END = 231 * MiB;
constexpr int PBW = 2048;
constexpr int LDS_BYTES = 147456;
constexpr int NWAVES = 8;

#define GAS __attribute__((address_space(1)))
#define LAS __attribute__((address_space(3)))
typedef unsigned short bf16;
typedef unsigned v4u __attribute__((ext_vector_type(4)));
typedef unsigned v2u __attribute__((ext_vector_type(2)));
typedef float f32x4 __attribute__((ext_vector_type(4)));
#define LDS_WAIT() asm volatile("s_waitcnt lgkmcnt(0)" ::: "memory")
__device__ __forceinline__ unsigned f2bf(float f) { unsigned u = __builtin_bit_cast(unsigned, f); return (u + 0x7fffu + ((u >> 16) & 1u)) >> 16; }
__device__ __forceinline__ unsigned pk2(float lo, float hi) { return f2bf(lo) | (f2bf(hi) << 16); }
__device__ __forceinline__ float bf2f(unsigned short h) { return __builtin_bit_cast(float, (unsigned)h << 16); }
__device__ __forceinline__ float bflo(unsigned w) { return __builtin_bit_cast(float, w << 16); }
__device__ __forceinline__ float bfhi(unsigned w) { return __builtin_bit_cast(float, w & 0xffff0000u); }
__device__ __forceinline__ float sigmoidf_(float x) { return 1.0f / (1.0f + __expf(-x)); }
__device__ __forceinline__ float siluf_(float x) { return x / (1.0f + __expf(-x)); }
__device__ __forceinline__ float gelu_tanh(float x) { const float z = 1.5957691216057308f * (x + 0.044715f * x * x * x); return x / (1.0f + __expf(-z)); }
__device__ __forceinline__ float wave_sum(float v) {
#pragma unroll
    for (int o = 1; o < 64; o <<= 1) v += __shfl_xor(v, o);
    return v;
}

struct Args { const float* in[24]; float* out; unsigned char* ws; int ph_lo, ph_hi; };

struct Frame {
    LAS unsigned char* lds;
    int tid, lane, wave, G, bid;
    const float* in[24];
    float* out; unsigned char* ws;
};
__device__ __forceinline__ const float* xrow(const Frame& F, int m) { return m < MP ? F.in[0] + (size_t)m * DM : F.in[1] + (size_t)(m - MP) * DM; }

__device__ __forceinline__ void transpose_item(const float* W, int ldw, bf16* WT, int K, int k0, int sn0, int dn0, LAS float* scr, int lane) {
#pragma unroll 8
    for (int i = 0; i < 32; ++i) { const int kk = 2 * i + (lane >> 5); scr[kk * 33 + (lane & 31)] = W[(size_t)(k0 + kk) * ldw + sn0 + (lane & 31)]; }
    LDS_WAIT(); asm volatile("" ::: "memory");
    const int c = lane & 7;
#pragma unroll
    for (int j = 0; j < 4; ++j) { const int n = (lane >> 3) + 8 * j; const LAS float* s = scr + (8 * c) * 33 + n;
        v4u o; o.x = pk2(s[0 * 33], s[1 * 33]); o.y = pk2(s[2 * 33], s[3 * 33]); o.z = pk2(s[4 * 33], s[5 * 33]); o.w = pk2(s[6 * 33], s[7 * 33]);
        *(GAS v4u*)(WT + (size_t)(dn0 + n) * K + k0 + 8 * c) = o; }
    LDS_WAIT(); asm volatile("" ::: "memory");
}
__device__ __forceinline__ void rms_row_bf16(const float* xr_, const float* gain, bf16* orow, int lane) {
    const GAS f32x4* xr = (const GAS f32x4*)xr_ + lane;
    f32x4 v[4]; float s = 0.f;
#pragma unroll
    for (int j = 0; j < 4; ++j) { v[j] = xr[64 * j]; s += (v[j].x * v[j].x + v[j].y * v[j].y) + (v[j].z * v[j].z + v[j].w * v[j].w); }
    const float rstd = 1.0f / sqrtf(wave_sum(s) * (1.0f / DM) + EPS);
    GAS v2u* o8 = (GAS v2u*)orow + lane;
#pragma unroll
    for (int j = 0; j < 4; ++j) { const f32x4 g = ((const GAS f32x4*)gain)[lane + 64 * j]; v2u w; w.x = pk2(v[j].x * rstd * g.x, v[j].y * rstd * g.y); w.y = pk2(v[j].z * rstd * g.z, v[j].w * rstd * g.w); o8[64 * j] = w; }
}

__device__ __forceinline__ void p0_prologue(Frame& F) {
    LAS float* scr = (LAS float*)(F.lds + F.wave * 16384);
    const int gw = F.bid * NWAVES + F.wave, NGW = F.G * NWAVES;
    bf16* WinT = (bf16*)(F.ws + WS_WIN); bf16* WgluT = (bf16*)(F.ws + WS_WGLU); bf16* WoutT = (bf16*)(F.ws + WS_WOUT); bf16* WguT = (bf16*)(F.ws + WS_WGU); bf16* WdT = (bf16*)(F.ws + WS_WD);
    constexpr int I_IN = (DM / 64) * (INC / 32), I_GLU = (S5W / 64) * (S5W / 32), I_OUT = (DM / 64) * (DM / 32), I_G = (DM / 64) * (DFF / 32), I_D = (DFF / 64) * (DM / 32);
    constexpr int NITEMS = I_IN + I_GLU + I_OUT + 2 * I_G + I_D;
    for (int it = gw; it < NITEMS; it += NGW) {
        int r = it;
        if (r < I_IN) { const int nblk = INC / 32, kb = r / nblk, nb = r % nblk, sn0 = nb * 32; const int seg = sn0 / 512, off = sn0 % 512;
            const int dseg = seg == 0 ? 0 : seg == 1 ? 1 : seg == 2 ? 4 : seg == 3 ? 2 : 3;
            transpose_item(F.in[7], INC, WinT, DM, kb * 64, sn0, dseg * 512 + off, scr, F.lane); continue; } r -= I_IN;
        if (r < I_GLU) { const int nblk = S5W / 32, kb = r / nblk, nb = r % nblk; transpose_item(F.in[16], S5W, WgluT, S5W, kb * 64, nb * 32, nb * 32, scr, F.lane); continue; } r -= I_GLU;
        if (r < I_OUT) { const int nblk = DM / 32, kb = r / nblk, nb = r % nblk; transpose_item(F.in[18], DM, WoutT, DM, kb * 64, nb * 32, nb * 32, scr, F.lane); continue; } r -= I_OUT;
        if (r < I_G) { const int nblk = DFF / 32, kb = r / nblk, nb = r % nblk, sn0 = nb * 32; transpose_item(F.in[20], DFF, WguT, DM, kb * 64, sn0, 256 * (sn0 / 128) + (sn0 % 128), scr, F.lane); continue; } r -= I_G;
        if (r < I_G) { const int nblk = DFF / 32, kb = r / nblk, nb = r % nblk, sn0 = nb * 32; transpose_item(F.in[21], DFF, WguT, DM, kb * 64, sn0, 256 * (sn0 / 128) + 128 + (sn0 % 128), scr, F.lane); continue; } r -= I_G;
        { const int nblk = DM / 32, kb = r / nblk, nb = r % nblk; transpose_item(F.in[22], DM, WdT, DFF, kb * 64, nb * 32, nb * 32, scr, F.lane); }
    }
    bf16* XN = (bf16*)(F.ws + WS_XN);
    for (int m = gw; m < MTOK; m += NGW) rms_row_bf16(xrow(F, m), F.in[6], XN + (size_t)m * DM, F.lane);
}

using pg8::Unit; using pg8::u32x4; using pg8::cvt_pk_bf16; using pg8::BM; using pg8::HALF;
struct EpiIn {
    static constexpr bool PERM = true, AFTER_DRAIN = false;
    bf16* PB; float* FZ;
    __device__ __forceinline__ void operator()(const pg8::f32x4 (&acc)[2][2][4][2], const Unit& u, int wr, int wc, int fr, int fq) const {
        const int row0 = u.pm * BM + wr * 64 + fr;
        if (u.pn < 8) { const int col0 = u.pn * BM + wc * 32 + 8 * fq;
#pragma unroll
            for (int ai = 0; ai < 2; ++ai)
#pragma unroll
                for (int m = 0; m < 4; ++m) { bf16* rowp = PB + (size_t)(row0 + ai * HALF + m * 16) * PBW + col0;
#pragma unroll
                    for (int bj = 0; bj < 2; ++bj) { const pg8::f32x4 v0 = acc[ai][bj][m][0], v1 = acc[ai][bj][m][1]; u32x4 w; w.x = cvt_pk_bf16(v0[0], v0[1]); w.y = cvt_pk_bf16(v0[2], v0[3]); w.z = cvt_pk_bf16(v1[0], v1[1]); w.w = cvt_pk_bf16(v1[2], v1[3]);
                        *(u32x4*)(rowp + bj * HALF) = w; } }
        } else { const int col0 = (u.pn - 8) * BM + wc * 32 + 8 * fq;
#pragma unroll
            for (int ai = 0; ai < 2; ++ai)
#pragma unroll
                for (int m = 0; m < 4; ++m) { float* rowp = FZ + (size_t)(row0 + ai * HALF + m * 16) * 512 + col0;
#pragma unroll
                    for (int bj = 0; bj < 2; ++bj)
#pragma unroll
                        for (int n = 0; n < 2; ++n) *(pg8::f32x4*)(rowp + bj * HALF + 4 * n) = acc[ai][bj][m][n]; }
        }
    }
};
struct EpiGlu {
    static constexpr bool PERM = true, AFTER_DRAIN = false;
    const bf16* GY; bf16* MIX;
    __device__ __forceinline__ void operator()(const pg8::f32x4 (&acc)[2][2][4][2], const Unit& u, int wr, int wc, int fr, int fq) const {
        const int row0 = u.pm * BM + wr * 64 + fr, col0 = u.pn * BM + wc * 32 + 8 * fq;
#pragma unroll
        for (int ai = 0; ai < 2; ++ai)
#pragma unroll
            for (int m = 0; m < 4; ++m) { const size_t r = (size_t)(row0 + ai * HALF + m * 16);
#pragma unroll
                for (int bj = 0; bj < 2; ++bj) { const u32x4 g = *(const u32x4*)(GY + r * 512 + col0 + bj * HALF); const pg8::f32x4 v0 = acc[ai][bj][m][0], v1 = acc[ai][bj][m][1];
                    u32x4 w; w.x = cvt_pk_bf16(bflo(g.x) * sigmoidf_(v0[0]), bfhi(g.x) * sigmoidf_(v0[1])); w.y = cvt_pk_bf16(bflo(g.y) * sigmoidf_(v0[2]), bfhi(g.y) * sigmoidf_(v0[3]));
                    w.z = cvt_pk_bf16(bflo(g.z) * sigmoidf_(v1[0]), bfhi(g.z) * sigmoidf_(v1[1])); w.w = cvt_pk_bf16(bflo(g.w) * sigmoidf_(v1[2]), bfhi(g.w) * sigmoidf_(v1[3]));
                    *(u32x4*)(MIX + r * DM + col0 + bj * HALF) = w; } }
    }
};
struct EpiOut {
    static constexpr bool PERM = false, AFTER_DRAIN = false;
    const float* xp; const float* xs; float* Y;
    __device__ __forceinline__ void operator()(const pg8::f32x4 (&acc)[2][2][4][2], const Unit& u, int wr, int wc, int fr, int fq) const {
        const int row0 = u.pm * BM + wr * 64 + fr, col0 = u.pn * BM + wc * 32 + 4 * fq;
        const float* xb = (u.pm < MP / BM) ? xp : xs - (size_t)MP * DM;
#pragma unroll
        for (int ai = 0; ai < 2; ++ai)
#pragma unroll
            for (int m = 0; m < 4; ++m) { const size_t off = (size_t)(row0 + ai * HALF + m * 16) * DM + col0;
#pragma unroll
                for (int bj = 0; bj < 2; ++bj)
#pragma unroll
                    for (int n = 0; n < 2; ++n) { const pg8::f32x4 xv = *(const pg8::f32x4*)(xb + off + bj * HALF + n * 16); *(pg8::f32x4*)(Y + off + bj * HALF + n * 16) = xv + acc[ai][bj][m][n]; } }
    }
};
struct EpiAct {
    static constexpr bool PERM = true, AFTER_DRAIN = false;
    bf16* ACT;
    __device__ __forceinline__ void operator()(const pg8::f32x4 (&acc)[2][2][4][2], const Unit& u, int wr, int wc, int fr, int fq) const {
        const int row0 = u.pm * BM + wr * 64 + fr, col0 = u.pn * HALF + wc * 32 + 8 * fq;
#pragma unroll
        for (int ai = 0; ai < 2; ++ai)
#pragma unroll
            for (int m = 0; m < 4; ++m) { const pg8::f32x4 g0 = acc[ai][0][m][0], g1 = acc[ai][0][m][1], u0 = acc[ai][1][m][0], u1 = acc[ai][1][m][1];
                u32x4 w; w.x = cvt_pk_bf16(siluf_(g0[0]) * u0[0], siluf_(g0[1]) * u0[1]); w.y = cvt_pk_bf16(siluf_(g0[2]) * u0[2], siluf_(g0[3]) * u0[3]);
                w.z = cvt_pk_bf16(siluf_(g1[0]) * u1[0], siluf_(g1[1]) * u1[1]); w.w = cvt_pk_bf16(siluf_(g1[2]) * u1[2], siluf_(g1[3]) * u1[3]);
                *(u32x4*)(ACT + (size_t)(row0 + ai * HALF + m * 16) * DFF + col0) = w; }
    }
};
struct EpiDown {
    static constexpr bool PERM = false, AFTER_DRAIN = false;
    float* Y;
    __device__ __forceinline__ void operator()(const pg8::f32x4 (&acc)[2][2][4][2], const Unit& u, int wr, int wc, int fr, int fq) const {
        const int row0 = u.pm * BM + wr * 64 + fr, col0 = u.pn * BM + wc * 32 + 4 * fq;
#pragma unroll
        for (int ai = 0; ai < 2; ++ai)
#pragma unroll
            for (int m = 0; m < 4; ++m) { const size_t off = (size_t)(row0 + ai * HALF + m * 16) * DM + col0;
#pragma unroll
                for (int bj = 0; bj < 2; ++bj)
#pragma unroll
                    for (int n = 0; n < 2; ++n) { float* p = Y + off + bj * HALF + n * 16; const pg8::f32x4 xv = *(const pg8::f32x4*)p; *(pg8::f32x4*)p = xv + acc[ai][bj][m][n]; } }
    }
};

__device__ __forceinline__ void s5_simple_item(Frame& F, int item) {
    const int lane = F.lane, n = lane;
    int g, tokbase, T; const float* h0r = nullptr; const float* h0i = nullptr; float* outr; float* outi;
    if (item < PB_B * S5G) { const int b = item / S5G; g = item % S5G; tokbase = b * PB_T; T = PB_T; outr = F.out + O_PRE + (size_t)item * S5N; outi = F.out + O_PIM + (size_t)item * S5N; }
    else { const int idx = item - PB_B * S5G, b = idx / S5G; g = idx % S5G; tokbase = MP + b * SB_T; T = SB_T; h0r = F.in[2] + (size_t)idx * S5N; h0i = F.in[3] + (size_t)idx * S5N; outr = F.out + O_SRE + (size_t)idx * S5N; outi = F.out + O_SIM + (size_t)idx * S5N; }
    const float a_re = F.in[8][g * S5N + n], a_im = F.in[9][g * S5N + n], dt = expf(F.in[10][g]);
    const float mag = expf(a_re * dt), ab_re = mag * cosf(a_im * dt), ab_im = mag * sinf(a_im * dt);
    const float den = a_re * a_re + a_im * a_im, nr = ab_re - 1.0f, ni = ab_im;
    const float f_re = (nr * a_re + ni * a_im) / den, f_im = (ni * a_re - nr * a_im) / den;
    float Bre[16], Bim[16], Cre[16], Cim[16];
#pragma unroll
    for (int c = 0; c < 16; ++c) { const float br = F.in[11][(size_t)(g * S5N + n) * 16 + c], bi = F.in[12][(size_t)(g * S5N + n) * 16 + c];
        Bre[c] = f_re * br - f_im * bi; Bim[c] = f_re * bi + f_im * br;
        Cre[c] = F.in[13][(size_t)(g * 16 + c) * S5N + n]; Cim[c] = F.in[14][(size_t)(g * 16 + c) * S5N + n]; }
    const float dl = F.in[15][g * 16 + (lane & 15)];
    float h_re = h0r ? h0r[n] : 0.f, h_im = h0i ? h0i[n] : 0.f;
    const bf16* PB = (const bf16*)(F.ws + WS_PB); bf16* GY = (bf16*)(F.ws + WS_GY);
    for (int t = 0; t < T; ++t) {
        const float uv = bf2f(PB[(size_t)(tokbase + t) * PBW + g * 16 + (lane & 15)]);
        float bu_re = 0.f, bu_im = 0.f;
#pragma unroll
        for (int c = 0; c < 16; ++c) { const float uc = __shfl(uv, c); bu_re += Bre[c] * uc; bu_im += Bim[c] * uc; }
        const float nre = ab_re * h_re - ab_im * h_im + bu_re, nim = ab_re * h_im + ab_im * h_re + bu_im;
        h_re = nre; h_im = nim;
        float yv = 0.f;
#pragma unroll
        for (int c = 0; c < 16; ++c) { const float p = wave_sum(Cre[c] * h_re - Cim[c] * h_im); yv = ((lane & 15) == c) ? p : yv; }
        const float y = yv + dl * uv;
        if (lane < 16) GY[(size_t)(tokbase + t) * S5W + g * 16 + lane] = (bf16)f2bf(gelu_tanh(y));
    }
    outr[n] = h_re; outi[n] = h_im;
}
typedef float f32x16 __attribute__((ext_vector_type(16)));
typedef short s16x8 __attribute__((ext_vector_type(8)));
constexpr int S5_LD = 136;
constexpr int L5_WG = 0, L5_VG = 34816, L5_KC = 69632, L5_U = 74240, L5_HS = 91648, L5_HL = 109056, L5_PW = 141824;
__device__ __forceinline__ void s5_fast_item(Frame& F, int item) {
    const int tid = F.tid, lane = F.lane, wave = F.wave;
    const int g = item & 31, b8 = item >> 5;
    LAS bf16* WgT = (LAS bf16*)(F.lds + L5_WG); LAS bf16* VgT = (LAS bf16*)(F.lds + L5_VG); LAS bf16* Kc = (LAS bf16*)(F.lds + L5_KC);
    LAS bf16* Us = (LAS bf16*)(F.lds + L5_U); LAS bf16* HS = (LAS bf16*)(F.lds + L5_HS); LAS float* HL = (LAS float*)(F.lds + L5_HL);
    LAS float* Pre = (LAS float*)(F.lds + L5_PW); LAS float* Pim = Pre + 9 * 64;
    LAS float* Cre = HL, * Cim = HL + 1024, * Bre = HL + 2048, * Bim = HL + 3072; LAS float* Ff = HL + 4096;
    if (tid < 64) { const int n = tid;
        const float a_re = F.in[8][g * S5N + n], a_im = F.in[9][g * S5N + n], dt = expf(F.in[10][g]);
        const float mag = expf(a_re * dt), ab_re = mag * cosf(a_im * dt), ab_im = mag * sinf(a_im * dt);
        const float den = a_re * a_re + a_im * a_im, nr = ab_re - 1.0f, ni = ab_im;
        Ff[n] = (nr * a_re + ni * a_im) / den; Ff[64 + n] = (ni * a_re - nr * a_im) / den;
        float pr = 1.f, pi = 0.f;
#pragma unroll
        for (int j = 0; j < 9; ++j) { Pre[j * 64 + n] = pr; Pim[j * 64 + n] = pi; const float t = pr * ab_re - pi * ab_im; pi = pr * ab_im + pi * ab_re; pr = t; }
    }
    __syncthreads();
#pragma unroll
    for (int i = 0; i < 2; ++i) { const int idx = tid + 512 * i;
        { const int c = idx >> 6, n = idx & 63; Cre[c * 64 + n] = F.in[13][(size_t)(g * 16 + c) * S5N + n]; Cim[c * 64 + n] = F.in[14][(size_t)(g * 16 + c) * S5N + n]; }
        { const int n = idx >> 4, c = idx & 15; const float br = F.in[11][(size_t)(g * S5N + n) * 16 + c], bi = F.in[12][(size_t)(g * S5N + n) * 16 + c], fr = Ff[n], fi = Ff[64 + n];
          Bre[n * 16 + c] = fr * br - fi * bi; Bim[n * 16 + c] = fr * bi + fi * br; } }
    __syncthreads();
#pragma unroll 1
    for (int i = 0; i < 4; ++i) { const int idx = tid + 512 * i, j = idx >> 8, c = (idx >> 4) & 15, cp = idx & 15; float acc = 0.f;
        for (int n = 0; n < 64; ++n) { const float cr = Cre[c * 64 + n], ci = Cim[c * 64 + n], pr = Pre[j * 64 + n], pi = Pim[j * 64 + n];
            const float xr = cr * pr - ci * pi, xi = cr * pi + ci * pr; acc += xr * Bre[n * 16 + cp] - xi * Bim[n * 16 + cp]; }
        Kc[idx] = (bf16)f2bf(acc); }
    if (tid < 256) Kc[2048 + tid] = 0;
#pragma unroll 4
    for (int i = 0; i < 32; ++i) { const int idx = tid + 512 * i, np = idx >> 7, k = idx & 127, s = k >> 4, cp = k & 15, n = np & 63;
        const float pr = Pre[(7 - s) * 64 + n], pi = Pim[(7 - s) * 64 + n], br = Bre[n * 16 + cp], bi = Bim[n * 16 + cp];
        WgT[np * S5_LD + k] = (bf16)f2bf(np < 64 ? pr * br - pi * bi : pr * bi + pi * br); }
#pragma unroll 4
    for (int i = 0; i < 32; ++i) { const int idx = tid + 512 * i, col = idx >> 7, np = idx & 127, t = col >> 4, c = col & 15, n = np & 63;
        const float pr = Pre[(t + 1) * 64 + n], pi = Pim[(t + 1) * 64 + n], cr = Cre[c * 64 + n], ci = Cim[c * 64 + n];
        VgT[col * S5_LD + np] = (bf16)f2bf(np < 64 ? cr * pr - ci * pi : -(cr * pi + ci * pr)); }
    __syncthreads();
    const bf16* PB = (const bf16*)(F.ws + WS_PB); bf16* GY = (bf16*)(F.ws + WS_GY);
    const int rb = wave >> 2, cb = wave & 3, r32 = lane & 31, hh = lane >> 5;
    float h_re = 0.f, h_im = 0.f;
    const float p8r = Pre[8 * 64 + lane], p8i = Pim[8 * 64 + lane];
    const float dl = F.in[15][g * 16 + (lane & 15)];
    for (int seg = 0; seg < 5; ++seg) {
        const bool samp = (seg == 4);
        const int tok0 = samp ? MP + 128 * b8 : b8 * PB_T + seg * 512;
        const int ntok = samp ? 128 : 512;
        if (tid < ntok) { const v4u* src = (const v4u*)(PB + (size_t)(tok0 + tid) * PBW + g * 16); const v4u a = src[0], b = src[1];
            LAS v4u* dst = (LAS v4u*)(Us + (tid >> 3) * S5_LD + (tid & 7) * 16); dst[0] = a; dst[1] = b; }
        __syncthreads();
        { f32x16 acc = {};
#pragma unroll
          for (int s = 0; s < 8; ++s) { const s16x8 a = *(const LAS s16x8*)(Us + (32 * rb + r32) * S5_LD + s * 16 + 8 * hh); const s16x8 b = *(const LAS s16x8*)(WgT + (32 * cb + r32) * S5_LD + s * 16 + 8 * hh);
              acc = __builtin_amdgcn_mfma_f32_32x32x16_bf16(a, b, acc, 0, 0, 0); }
#pragma unroll
          for (int r = 0; r < 16; ++r) HL[(32 * rb + (r & 3) + 8 * (r >> 2) + 4 * hh) * 128 + 32 * cb + r32] = acc[r]; }
        __syncthreads();
        if (wave == 0) {
            if (!samp) {
#pragma unroll 8
                for (int c = 0; c < 64; ++c) { const float xr = HL[c * 128 + lane], xi = HL[c * 128 + 64 + lane];
                    HS[c * S5_LD + lane] = (bf16)f2bf(h_re); HS[c * S5_LD + 64 + lane] = (bf16)f2bf(h_im);
                    const float nr = p8r * h_re - p8i * h_im + xr, ni = p8r * h_im + p8i * h_re + xi; h_re = nr; h_im = ni; }
                if (seg == 3) { F.out[O_PRE + (size_t)(b8 * S5G + g) * S5N + lane] = h_re; F.out[O_PIM + (size_t)(b8 * S5G + g) * S5N + lane] = h_im; }
            } else {
#pragma unroll 4
                for (int r = 0; r < 16; ++r) { const size_t idx = (size_t)((16 * b8 + r) * S5G + g) * S5N + lane; const float sr = F.in[2][idx], si = F.in[3][idx];
                    HS[r * S5_LD + lane] = (bf16)f2bf(sr); HS[r * S5_LD + 64 + lane] = (bf16)f2bf(si);
                    F.out[O_SRE + idx] = p8r * sr - p8i * si + HL[r * 128 + lane]; F.out[O_SIM + idx] = p8r * si + p8i * sr + HL[r * 128 + 64 + lane]; }
            }
        }
        __syncthreads();
        if (!(samp && rb == 1)) { f32x16 acc = {};
            const int tl = 2 * cb + ((lane >> 4) & 1), c = lane & 15;
#pragma unroll
            for (int s = 0; s < 8; ++s) if (s <= 2 * cb + 1) { const int j = tl - s, jj = j < 0 ? 8 : j;
                const s16x8 a = *(const LAS s16x8*)(Us + (32 * rb + r32) * S5_LD + s * 16 + 8 * hh); const s16x8 b = *(const LAS s16x8*)(Kc + (jj * 16 + c) * 16 + 8 * hh);
                acc = __builtin_amdgcn_mfma_f32_32x32x16_bf16(a, b, acc, 0, 0, 0); }
#pragma unroll
            for (int kb = 0; kb < 8; ++kb) { const s16x8 a = *(const LAS s16x8*)(HS + (32 * rb + r32) * S5_LD + kb * 16 + 8 * hh); const s16x8 b = *(const LAS s16x8*)(VgT + (32 * cb + r32) * S5_LD + kb * 16 + 8 * hh);
                acc = __builtin_amdgcn_mfma_f32_32x32x16_bf16(a, b, acc, 0, 0, 0); }
#pragma unroll
            for (int r = 0; r < 16; ++r) { const int row = 32 * rb + (r & 3) + 8 * (r >> 2) + 4 * hh;
                if (!samp || row < 16) { const float u = bf2f(Us[row * S5_LD + tl * 16 + c]); const float y = acc[r] + dl * u;
                    GY[(size_t)(tok0 + row * 8 + tl) * S5W + g * 16 + c] = (bf16)f2bf(gelu_tanh(y)); } }
        }
        __syncthreads();
    }
}
__device__ __forceinline__ void hgrn_simple_item(Frame& F, int item) {
    const int tid = F.tid, v = tid & 127, kq = tid >> 7;
    int h, tokbase, T; const float* S0 = nullptr; float* Sout;
    if (item < PB_B * HH) { const int b = item / HH; h = item % HH; tokbase = b * PB_T; T = PB_T; Sout = F.out + O_PHG + (size_t)item * HD * HD; }
    else { const int idx = item - PB_B * HH, b = idx / HH; h = idx % HH; tokbase = MP + b * SB_T; T = SB_T; S0 = F.in[4] + (size_t)idx * HD * HD; Sout = F.out + O_SHG + (size_t)idx * HD * HD; }
    float S[32];
#pragma unroll
    for (int j = 0; j < 32; ++j) S[j] = S0 ? S0[(size_t)(32 * kq + j) * HD + v] : 0.f;
    LAS float* Fs = (LAS float*)F.lds;
    LAS float* Ks = Fs + 1024;
    LAS float* Qs = Ks + 1024;
    LAS float* Vs = Qs + 1024;
    LAS float* OP = Vs + 1024;
    const bf16* PB = (const bf16*)(F.ws + WS_PB); const float* FZ = (const float*)(F.ws + WS_FZ); bf16* OH = (bf16*)(F.ws + WS_OH);
    float lb = 0.f;
    if (tid < 128) { const int col = h * HD + tid; lb = 1.0f / (1.0f + expf(F.in[5][512 + col] - F.in[5][col])); }
    for (int t0 = 0; t0 < T; t0 += 8) {
        if (tid < 128) {
#pragma unroll
            for (int tt = 0; tt < 8; ++tt) { const size_t tok = (size_t)(tokbase + t0 + tt); const float fz = FZ[tok * 512 + h * HD + tid];
                const float sg = 1.0f / (1.0f + expf(-fz)), f = lb + (1.0f - lb) * sg;
                Fs[tt * 128 + tid] = f; Ks[tt * 128 + tid] = 1.0f - f; Qs[tt * 128 + tid] = bf2f(PB[tok * PBW + 512 + h * HD + tid]); }
        } else if (tid < 256) { const int vv = tid - 128;
#pragma unroll
            for (int tt = 0; tt < 8; ++tt) Vs[tt * 128 + vv] = bf2f(PB[(size_t)(tokbase + t0 + tt) * PBW + 1024 + h * HD + vv]);
        }
        __syncthreads();
#pragma unroll 1
        for (int tt = 0; tt < 8; ++tt) { const float iv = Vs[tt * 128 + v]; float o = 0.f;
#pragma unroll
            for (int j = 0; j < 32; j += 4) { const f32x4 f4 = *(const LAS f32x4*)(Fs + tt * 128 + 32 * kq + j), k4 = *(const LAS f32x4*)(Ks + tt * 128 + 32 * kq + j), q4 = *(const LAS f32x4*)(Qs + tt * 128 + 32 * kq + j);
                S[j] = f4.x * S[j] + k4.x * iv; o += S[j] * q4.x; S[j + 1] = f4.y * S[j + 1] + k4.y * iv; o += S[j + 1] * q4.y;
                S[j + 2] = f4.z * S[j + 2] + k4.z * iv; o += S[j + 2] * q4.z; S[j + 3] = f4.w * S[j + 3] + k4.w * iv; o += S[j + 3] * q4.w; }
            OP[(tt * 4 + kq) * 128 + v] = o; }
        __syncthreads();
#pragma unroll
        for (int r = 0; r < 2; ++r) { const int idx = tid + 512 * r, tt = idx >> 7, vv = idx & 127;
            const float o = (OP[(tt * 4 + 0) * 128 + vv] + OP[(tt * 4 + 1) * 128 + vv]) + (OP[(tt * 4 + 2) * 128 + vv] + OP[(tt * 4 + 3) * 128 + vv]);
            OH[(size_t)(tokbase + t0 + tt) * HGW + h * HD + vv] = (bf16)f2bf(o); }
        __syncthreads();
    }
#pragma unroll
    for (int j = 0; j < 32; ++j) Sout[(size_t)(32 * kq + j) * HD + v] = S[j];
}

typedef float f32x4v __attribute__((ext_vector_type(4)));
constexpr int HG_LDQ = 136, HG_LDT = 72;
constexpr int LH_Q = 0, LH_K = 17408, LH_KT = 34816, LH_VT = 53248, LH_AT = 55552, LH_ST = 64768, LH_TOT = 69120, LH_CV = 71168;
__device__ __forceinline__ void hgrn_prompt_item(Frame& F, int item) {
    const int tid = F.tid, lane = F.lane, wave = F.wave;
    const int bh = item >> 3, vs = item & 7, b = bh >> 2, h = bh & 3;
    LAS bf16* Qs = (LAS bf16*)(F.lds + LH_Q); LAS bf16* Ks = (LAS bf16*)(F.lds + LH_K); LAS bf16* Kt = (LAS bf16*)(F.lds + LH_KT); LAS bf16* Vt = (LAS bf16*)(F.lds + LH_VT);
    LAS bf16* At = (LAS bf16*)(F.lds + LH_AT); LAS bf16* St = (LAS bf16*)(F.lds + LH_ST); LAS float* TOT = (LAS float*)(F.lds + LH_TOT); LAS float* CV = (LAS float*)(F.lds + LH_CV);
    const bf16* PB = (const bf16*)(F.ws + WS_PB); const float* FZ = (const float*)(F.ws + WS_FZ); bf16* OH = (bf16*)(F.ws + WS_OH);
    const int ch = tid & 127, tq = tid >> 7, col = h * HD + ch;
    const float lb = 1.0f / (1.0f + expf(F.in[5][512 + col] - F.in[5][col]));
    const int l15 = lane & 15, kg = lane >> 4;
    f32x4v S = {0.f, 0.f, 0.f, 0.f};
    for (int chunk = 0; chunk < PB_T / 64; ++chunk) {
        const int tok0 = b * PB_T + chunk * 64;
        float gl[16], kk[16], qq[16]; float run = 0.f;
#pragma unroll
        for (int i = 0; i < 16; ++i) { const size_t tok = (size_t)(tok0 + 16 * tq + i); const float fz = FZ[tok * 512 + col]; qq[i] = bf2f(PB[tok * PBW + 512 + col]);
            const float sg = 1.0f / (1.0f + __expf(-fz)), f = lb + (1.0f - lb) * sg; kk[i] = 1.0f - f; run += __log2f(f); gl[i] = run; }
        TOT[tq * 128 + ch] = run;
        { const int tk = tid >> 3, vp = (tid & 7) * 2; const unsigned w = *(const unsigned*)(PB + (size_t)(tok0 + tk) * PBW + 1024 + h * HD + 16 * vs + vp);
          Vt[vp * HG_LDT + tk] = (bf16)(w & 0xffffu); Vt[(vp + 1) * HG_LDT + tk] = (bf16)(w >> 16); }
        __syncthreads();
        { const float t0 = TOT[ch], t1 = TOT[128 + ch], t2 = TOT[256 + ch], t3 = TOT[384 + ch];
          const float gref = t0 + t1, glast = gref + t2 + t3, off = (tq == 0 ? 0.f : tq == 1 ? t0 : tq == 2 ? gref : gref + t2);
          unsigned kp[8];
#pragma unroll
          for (int i = 0; i < 16; ++i) { const float e1 = __builtin_amdgcn_exp2f(off + gl[i] - gref), e2 = __builtin_amdgcn_rcpf(e1);
              const unsigned qb = f2bf(qq[i] * e1), kb = f2bf(kk[i] * e2);
              Qs[(16 * tq + i) * HG_LDQ + ch] = (bf16)qb; Ks[(16 * tq + i) * HG_LDQ + ch] = (bf16)kb;
              if (i & 1) kp[i >> 1] |= kb << 16; else kp[i >> 1] = kb; }
          LAS v4u* kd = (LAS v4u*)(Kt + ch * HG_LDT + 16 * tq); v4u a, c2; a.x = kp[0]; a.y = kp[1]; a.z = kp[2]; a.w = kp[3]; c2.x = kp[4]; c2.y = kp[5]; c2.z = kp[6]; c2.w = kp[7]; kd[0] = a; kd[1] = c2;
          if (tq == 0) { CV[ch] = __builtin_amdgcn_exp2f(gref); CV[128 + ch] = __builtin_amdgcn_exp2f(glast); CV[256 + ch] = __builtin_amdgcn_exp2f(glast - gref); } }
        __syncthreads();
        { const int k0 = 16 * wave + 4 * kg; v2u w; w.x = pk2(CV[k0] * S[0], CV[k0 + 1] * S[1]); w.y = pk2(CV[k0 + 2] * S[2], CV[k0 + 3] * S[3]); *(LAS v2u*)(St + l15 * HG_LDQ + k0) = w; }
        { const int tb = wave >> 1;
#pragma unroll
          for (int sbi = 0; sbi < 2; ++sbi) { const int sb = 2 * (wave & 1) + sbi; f32x4v acc = {0.f, 0.f, 0.f, 0.f};
#pragma unroll
              for (int ks = 0; ks < 4; ++ks) { const s16x8 a = *(const LAS s16x8*)(Qs + (16 * tb + l15) * HG_LDQ + 32 * ks + 8 * kg); const s16x8 bb = *(const LAS s16x8*)(Ks + (16 * sb + l15) * HG_LDQ + 32 * ks + 8 * kg);
                  acc = __builtin_amdgcn_mfma_f32_16x16x32_bf16(a, bb, acc, 0, 0, 0); }
              const int s = 16 * sb + l15;
#pragma unroll
              for (int r = 0; r < 4; ++r) { const int t = 16 * tb + 4 * kg + r; At[t * HG_LDT + s] = (s <= t) ? (bf16)f2bf(acc[r]) : (bf16)0; } } }
        __syncthreads();
        if (wave < 4) { const int tb = wave; f32x4v acc = {0.f, 0.f, 0.f, 0.f};
#pragma unroll
            for (int ks = 0; ks < 2; ++ks) { const s16x8 a = *(const LAS s16x8*)(At + (16 * tb + l15) * HG_LDT + 32 * ks + 8 * kg); const s16x8 bb = *(const LAS s16x8*)(Vt + l15 * HG_LDT + 32 * ks + 8 * kg);
                acc = __builtin_amdgcn_mfma_f32_16x16x32_bf16(a, bb, acc, 0, 0, 0); }
#pragma unroll
            for (int ks = 0; ks < 4; ++ks) { const s16x8 a = *(const LAS s16x8*)(Qs + (16 * tb + l15) * HG_LDQ + 32 * ks + 8 * kg); const s16x8 bb = *(const LAS s16x8*)(St + l15 * HG_LDQ + 32 * ks + 8 * kg);
                acc = __builtin_amdgcn_mfma_f32_16x16x32_bf16(a, bb, acc, 0, 0, 0); }
#pragma unroll
            for (int r = 0; r < 4; ++r) OH[(size_t)(tok0 + 16 * tb + 4 * kg + r) * HGW + h * HD + 16 * vs + l15] = (bf16)f2bf(acc[r]); }
        { f32x4v acc = {0.f, 0.f, 0.f, 0.f};
#pragma unroll
          for (int ks = 0; ks < 2; ++ks) { const s16x8 a = *(const LAS s16x8*)(Kt + (16 * wave + l15) * HG_LDT + 32 * ks + 8 * kg); const s16x8 bb = *(const LAS s16x8*)(Vt + l15 * HG_LDT + 32 * ks + 8 * kg);
              acc = __builtin_amdgcn_mfma_f32_16x16x32_bf16(a, bb, acc, 0, 0, 0); }
          const int k0 = 16 * wave + 4 * kg;
#pragma unroll
          for (int r = 0; r < 4; ++r) S[r] = CV[128 + k0 + r] * S[r] + CV[256 + k0 + r] * acc[r]; }
        __syncthreads();
    }
    { const int k0 = 16 * wave + 4 * kg;
#pragma unroll
      for (int r = 0; r < 4; ++r) F.out[O_PHG + ((size_t)bh * HD + k0 + r) * HD + 16 * vs + l15] = S[r]; }
}
constexpr int LX_Q = 0, LX_K2 = 4096, LX_K3 = 8192, LX_V = 12288, LX_DEC = 16384, LX_ATT = 16896, LX_OP = 17152;
__device__ __forceinline__ void hgrn_sample_item(Frame& F, int idx) {
    const int tid = F.tid, b = idx >> 2, h = idx & 3;
    LAS float* Qs = (LAS float*)(F.lds + LX_Q); LAS float* K2 = (LAS float*)(F.lds + LX_K2); LAS float* K3 = (LAS float*)(F.lds + LX_K3); LAS float* Vs = (LAS float*)(F.lds + LX_V);
    LAS float* DEC = (LAS float*)(F.lds + LX_DEC); LAS float* ATT = (LAS float*)(F.lds + LX_ATT); LAS float* OP = (LAS float*)(F.lds + LX_OP);
    const bf16* PB = (const bf16*)(F.ws + WS_PB); const float* FZ = (const float*)(F.ws + WS_FZ); bf16* OH = (bf16*)(F.ws + WS_OH);
    const float* S0 = F.in[4] + (size_t)idx * HD * HD; float* Sout = F.out + O_SHG + (size_t)idx * HD * HD;
    const int tok0 = MP + b * SB_T;
    const int v = tid & 127, kq = tid >> 7;
    float s0[32];
#pragma unroll
    for (int j = 0; j < 32; ++j) s0[j] = S0[(size_t)(32 * kq + j) * HD + v];
    if (tid < 128) { const int col = h * HD + tid; const float lb = 1.0f / (1.0f + expf(F.in[5][512 + col] - F.in[5][col]));
        float gl[8], kk[8], qq[8]; float run = 0.f;
#pragma unroll
        for (int t = 0; t < 8; ++t) { const size_t tok = (size_t)(tok0 + t); const float fz = FZ[tok * 512 + col]; qq[t] = bf2f(PB[tok * PBW + 512 + col]);
            const float sg = 1.0f / (1.0f + __expf(-fz)), f = lb + (1.0f - lb) * sg; kk[t] = 1.0f - f; run += __log2f(f); gl[t] = run; }
#pragma unroll
        for (int t = 0; t < 8; ++t) { Qs[t * 128 + tid] = qq[t] * __builtin_amdgcn_exp2f(gl[t]); K2[t * 128 + tid] = kk[t] * __builtin_amdgcn_exp2f(-gl[t]); K3[t * 128 + tid] = kk[t] * __builtin_amdgcn_exp2f(run - gl[t]); }
        DEC[tid] = __builtin_amdgcn_exp2f(run);
    } else if (tid < 256) { const int vv = tid - 128;
#pragma unroll
        for (int t = 0; t < 8; ++t) Vs[t * 128 + vv] = bf2f(PB[(size_t)(tok0 + t) * PBW + 1024 + h * HD + vv]);
    }
    __syncthreads();
    { const int p = tid >> 3, part = tid & 7, t = p >> 3, s = p & 7; float a = 0.f;
#pragma unroll
      for (int j = 0; j < 16; ++j) a += Qs[t * 128 + part + 8 * j] * K2[s * 128 + part + 8 * j];
      a += __shfl_xor(a, 1); a += __shfl_xor(a, 2); a += __shfl_xor(a, 4);
      if (part == 0) ATT[p] = (s <= t) ? a : 0.f; }
    float vr[8], o[8];
#pragma unroll
    for (int t = 0; t < 8; ++t) { vr[t] = Vs[t * 128 + v]; o[t] = 0.f; }
#pragma unroll
    for (int j = 0; j < 32; ++j) { const int k = 32 * kq + j; const float sv = s0[j]; float sn = DEC[k] * sv;
#pragma unroll
        for (int t = 0; t < 8; ++t) { o[t] += Qs[t * 128 + k] * sv; sn += K3[t * 128 + k] * vr[t]; }
        Sout[(size_t)k * HD + v] = sn; }
#pragma unroll
    for (int t = 0; t < 8; ++t) OP[(kq * 8 + t) * 128 + v] = o[t];
    __syncthreads();
#pragma unroll
    for (int r = 0; r < 2; ++r) { const int e = tid + 512 * r, t = e >> 7, vv = e & 127;
        float acc = (OP[(0 * 8 + t) * 128 + vv] + OP[(1 * 8 + t) * 128 + vv]) + (OP[(2 * 8 + t) * 128 + vv] + OP[(3 * 8 + t) * 128 + vv]);
#pragma unroll
        for (int s = 0; s < 8; ++s) acc += ATT[t * 8 + s] * Vs[s * 128 + vv];
        OH[(size_t)(tok0 + t) * HGW + h * HD + vv] = (bf16)f2bf(acc); }
    __syncthreads();
}
__device__ __forceinline__ void hg_normgate_row(Frame& F, int tok) {
    const int lane = F.lane;
    const bf16* OH = (const bf16*)(F.ws + WS_OH); const bf16* PB = (const bf16*)(F.ws + WS_PB); bf16* MIX = (bf16*)(F.ws + WS_MIX);
    const v4u o8 = *(const GAS v4u*)(OH + (size_t)tok * HGW + 8 * lane);
    const v4u g8 = *(const GAS v4u*)(PB + (size_t)tok * PBW + 1536 + 8 * lane);
    float o[8] = {bflo(o8.x), bfhi(o8.x), bflo(o8.y), bfhi(o8.y), bflo(o8.z), bfhi(o8.z), bflo(o8.w), bfhi(o8.w)};
    float gt[8] = {bflo(g8.x), bfhi(g8.x), bflo(g8.y), bfhi(g8.y), bflo(g8.z), bfhi(g8.z), bflo(g8.w), bfhi(g8.w)};
    float ss = 0.f;
#pragma unroll
    for (int j = 0; j < 8; ++j) ss += o[j] * o[j];
    ss += __shfl_xor(ss, 1); ss += __shfl_xor(ss, 2); ss += __shfl_xor(ss, 4); ss += __shfl_xor(ss, 8);
    const float rstd = 1.0f / sqrtf(ss * (1.0f / HD) + EPS);
    const f32x4 n0 = *(const GAS f32x4*)(F.in[17] + ((8 * lane) & 127)), n1 = *(const GAS f32x4*)(F.in[17] + ((8 * lane) & 127) + 4);
    const float gn[8] = {n0.x, n0.y, n0.z, n0.w, n1.x, n1.y, n1.z, n1.w};
    float r[8];
#pragma unroll
    for (int j = 0; j < 8; ++j) r[j] = o[j] * rstd * gn[j] * siluf_(gt[j]);
    v4u w; w.x = pk2(r[0], r[1]); w.y = pk2(r[2], r[3]); w.z = pk2(r[4], r[5]); w.w = pk2(r[6], r[7]);
    *(GAS v4u*)(MIX + (size_t)tok * DM + 512 + 8 * lane) = w;
}
__device__ __forceinline__ void final_norm_row(Frame& F, int m) {
    GAS f32x4* xr = (GAS f32x4*)(F.out + O_Y + (size_t)m * DM) + F.lane;
    f32x4 v[4]; float s = 0.f;
#pragma unroll
    for (int j = 0; j < 4; ++j) { v[j] = xr[64 * j]; s += (v[j].x * v[j].x + v[j].y * v[j].y) + (v[j].z * v[j].z + v[j].w * v[j].w); }
    const float rstd = 1.0f / sqrtf(wave_sum(s) * (1.0f / DM) + EPS);
#pragma unroll
    for (int j = 0; j < 4; ++j) { const f32x4 g = ((const GAS f32x4*)F.in[23])[F.lane + 64 * j]; f32x4 o; o.x = v[j].x * rstd * g.x; o.y = v[j].y * rstd * g.y; o.z = v[j].z * rstd * g.z; o.w = v[j].w * rstd * g.w; xr[64 * j] = o; }
}

typedef GAS unsigned gu32;
#define RLX_AGENT __ATOMIC_RELAXED, __HIP_MEMORY_SCOPE_AGENT
constexpr int MISC_OFF = LDS_BYTES - 512;
constexpr int CW_BAR = 4096;
constexpr size_t CTL_ZERO_BYTES = 65536;
#define XB_TMO      128
#define XB_XCNT(j)  (256  + 64 * (j))
#define XB_XSUB(j)  (1280 + 64 * (j))
#define XB_XGEN(j)  (2304 + 64 * (j))
#define XB_TOP      3328
#define XB_TOPGEN   3392
#define XCD_BAR_WORDS 3456
#define XB_SPIN_CAP (1u << 18)

__device__ __forceinline__ unsigned xb_ld(unsigned* p)              { return __hip_atomic_load(p, __ATOMIC_RELAXED, __HIP_MEMORY_SCOPE_AGENT); }
__device__ __forceinline__ unsigned xb_add(unsigned* p, unsigned v) { return __hip_atomic_fetch_add(p, v, __ATOMIC_RELAXED, __HIP_MEMORY_SCOPE_AGENT); }
__device__ __forceinline__ unsigned xb_xcc_id() { return (unsigned)__builtin_amdgcn_s_getreg((3 << 11) | 20) & 0xFu; }
#define XB_SPIN(cond, bar) do { unsigned _sp = 0; while (cond) { __builtin_amdgcn_s_sleep(1); \
    if ((++_sp & 255u) == 0u) { if (xb_ld(&(bar)[XB_TMO])) break; if (_sp > XB_SPIN_CAP) { atomicAdd(&(bar)[XB_TMO], 1u); break; } } } } while (0)

struct XcdBarrier {
    unsigned* bar; unsigned x;
    volatile LAS unsigned* st;
};

__device__ __forceinline__ XcdBarrier xcd_barrier_post(unsigned* bar, volatile LAS unsigned* st) {
    XcdBarrier b; b.bar = bar; b.x = xb_xcc_id(); b.st = st;
    if (threadIdx.x == 0) (void)xb_add(&bar[XB_XCNT(b.x)], 1u);
    return b;
}
__device__ __forceinline__ void xcd_barrier_complete(unsigned* bar, unsigned x, unsigned& nloc, unsigned& nx) {
    const unsigned G = gridDim.x * gridDim.y * gridDim.z;
    unsigned sum, cnt, mine, sp = 0u;
    for (;;) {
        sum = 0u; cnt = 0u; mine = 0u;
#pragma unroll
        for (unsigned j = 0; j < 16; ++j) { const unsigned c = xb_ld(&bar[XB_XCNT(j)]); sum += c; cnt += (c > 0u) ? 1u : 0u; mine = (j == x) ? c : mine; }
        if (sum == G) break;
        __builtin_amdgcn_s_sleep(1);
        if ((++sp & 255u) == 0u) { if (xb_ld(&bar[XB_TMO])) break; if (sp > XB_SPIN_CAP) { atomicAdd(&bar[XB_TMO], 1u); break; } }
    }
    nloc = mine > 0u ? mine : 1u; nx = cnt > 0u ? cnt : 1u;
}

__device__ __forceinline__ void xcd_barrier(const XcdBarrier& b) {
    asm volatile("s_waitcnt vmcnt(0)" ::: "memory");
    __syncthreads();
    if (threadIdx.x == 0) {
        unsigned* bar = b.bar;
        __builtin_amdgcn_s_waitcnt(0);
        unsigned nloc = b.st[0], nx = b.st[1];
        if (nloc == 0u) { xcd_barrier_complete(bar, b.x, nloc, nx); b.st[0] = nloc; b.st[1] = nx; }
        const unsigned old = xb_add(&bar[XB_XSUB(b.x)], 1u);
        const unsigned gen = old / nloc;
        if (old + 1u == (gen + 1u) * nloc) {
            __builtin_amdgcn_fence(__ATOMIC_RELEASE, "agent");
            asm volatile("s_waitcnt vmcnt(0)" ::: "memory");
            const unsigned og = xb_add(&bar[XB_TOP], 1u);
            const unsigned tg = og / nx;
            if (og + 1u == (tg + 1u) * nx) xb_add(&bar[XB_TOPGEN], 1u);
            else XB_SPIN(xb_ld(&bar[XB_TOPGEN]) == tg, bar);
            __builtin_amdgcn_fence(__ATOMIC_ACQUIRE, "agent");
            xb_add(&bar[XB_XGEN(b.x)], 1u);
            asm volatile("s_waitcnt vmcnt(0)" ::: "memory");
        } else {
            XB_SPIN(xb_ld(&bar[XB_XGEN(b.x)]) == gen, bar);
            __builtin_amdgcn_fence(__ATOMIC_ACQUIRE, "agent");
            asm volatile("s_waitcnt vmcnt(0)" ::: "memory");
        }
    }
    __syncthreads();
}

__global__ void __launch_bounds__(NWAVES * 64, 2) mk_fwd(Args args) {
    extern __shared__ __attribute__((aligned(16))) unsigned char lds[];
    Frame F;
    F.lds = (LAS unsigned char*)lds;
    F.tid = threadIdx.x; F.lane = F.tid & 63; F.wave = __builtin_amdgcn_readfirstlane(F.tid >> 6);
    F.G = gridDim.x; F.bid = blockIdx.x;
#pragma unroll
    for (int i = 0; i < 24; ++i) F.in[i] = args.in[i];
    F.out = args.out; F.ws = args.ws;
    const int lo = args.ph_lo, hi = args.ph_hi;
#define IN(k) (lo <= (k) && (k) < hi)
#if MK_N_LAUNCHES == 1
    volatile LAS unsigned* MISC = (volatile LAS unsigned*)(F.lds + MISC_OFF);
    if (F.tid < 32) MISC[F.tid] = 0u;
    __syncthreads();
    XcdBarrier bar = xcd_barrier_post((unsigned*)(F.ws + WS_CTL) + CW_BAR, MISC + 8);
#define SEAM(k) do { if (IN(k) && IN((k) + 1)) xcd_barrier(bar); } while (0)
#else
#define SEAM(k) do { } while (0)
#endif
    const int gw = F.bid * NWAVES + F.wave, NGW = F.G * NWAVES;
    bf16* XN = (bf16*)(F.ws + WS_XN); bf16* PB = (bf16*)(F.ws + WS_PB); float* FZ = (float*)(F.ws + WS_FZ); bf16* GY = (bf16*)(F.ws + WS_GY);
    bf16* MIX = (bf16*)(F.ws + WS_MIX); bf16* ACT = (bf16*)(F.ws + WS_ACT);

    if (IN(0)) { p0_prologue(F); } SEAM(0);
    if (IN(1)) {
        pg8::Gemm g{XN, (const bf16*)(F.ws + WS_WIN), MTOK, INC, DM}; pg8::StaticOrder S; S.init(MTOK, INC, F.G, F.bid);
        EpiIn E{PB, FZ};
        pg8::gemm_phase<EpiIn, pg8::StaticOrder, true, true>(F.lds, g, S, E);
    } SEAM(1);
    if (IN(2)) {
#if S5_SIMPLE
        for (int it = gw; it < PB_B * S5G + SB_B * S5G; it += NGW) s5_simple_item(F, it);
        __syncthreads();
#else
        for (int it = F.bid; it < 256; it += F.G) { s5_fast_item(F, it); __syncthreads(); }
#endif
#if HG_SIMPLE
        for (int it = F.bid; it < PB_B * HH + SB_B * HH; it += F.G) { hgrn_simple_item(F, it); __syncthreads(); }
#else
        for (int it = F.bid; it < 256; it += F.G) { const int x = it & 7, i = it >> 3; hgrn_prompt_item(F, ((x * 4 + (i >> 3)) << 3) | (i & 7)); }
        for (int it = F.bid; it < SB_B * HH; it += F.G) hgrn_sample_item(F, it);
#endif
    } SEAM(2);
    if (IN(3)) {
        pg8::Gemm g{GY, (const bf16*)(F.ws + WS_WGLU), MTOK, S5W, S5W}; pg8::StaticOrder S; S.init(MTOK, S5W, F.G, F.bid);
        EpiGlu E{GY, MIX};
        pg8::gemm_phase<EpiGlu, pg8::StaticOrder, true, true>(F.lds, g, S, E);
        for (int m = gw; m < MTOK; m += NGW) hg_normgate_row(F, m);
    } SEAM(3);
    if (IN(4)) {
        pg8::Gemm g{MIX, (const bf16*)(F.ws + WS_WOUT), MTOK, DM, DM}; pg8::StaticOrder S; S.init(MTOK, DM, F.G, F.bid);
        EpiOut E{F.in[0], F.in[1], F.out + O_Y};
        pg8::gemm_phase<EpiOut, pg8::StaticOrder, true, true>(F.lds, g, S, E);
    } SEAM(4);
    if (IN(5)) {
        for (int m = gw; m < MTOK; m += NGW) rms_row_bf16(F.out + O_Y + (size_t)m * DM, F.in[19], XN + (size_t)m * DM, F.lane);
    } SEAM(5);
    if (IN(6)) {
        pg8::Gemm g{XN, (const bf16*)(F.ws + WS_WGU), MTOK, 2 * DFF, DM}; pg8::StaticOrder S; S.init(MTOK, 2 * DFF, F.G, F.bid);
        EpiAct E{ACT};
        pg8::gemm_phase<EpiAct, pg8::StaticOrder, true, true>(F.lds, g, S, E);
    } SEAM(6);
    if (IN(7)) {
        pg8::Gemm g{ACT, (const bf16*)(F.ws + WS_WD), MTOK, DM, DFF}; pg8::StaticOrder S; S.init(MTOK, DM, F.G, F.bid);
        EpiDown E{F.out + O_Y};
        pg8::gemm_phase<EpiDown, pg8::StaticOrder, true, true>(F.lds, g, S, E);
    } SEAM(7);
    if (IN(8)) {
        for (int m = gw; m < MTOK; m += NGW) final_norm_row(F, m);
    }
#undef IN
#undef SEAM
}

extern "C" void kernel_launch(void* const* d_in, const int* in_sizes, int n_in, void* d_out, int out_size, void* d_ws, size_t ws_size, hipStream_t stream) {
    static int grid = 0;
    if (grid == 0) {
        if (n_in != 24 || ws_size < WS_END) { fprintf(stderr, "kernel_launch: unexpected n_in %d / ws %zu\n", n_in, ws_size); grid = -1; return; }
        int dev = 0, cus = 0, per_cu = 0;
        if (hipGetDevice(&dev) != hipSuccess || hipDeviceGetAttribute(&cus, hipDeviceAttributeMultiprocessorCount, dev) != hipSuccess) { grid = -1; return; }
        if (hipFuncSetAttribute((const void*)mk_fwd, hipFuncAttributeMaxDynamicSharedMemorySize, LDS_BYTES) != hipSuccess) { fprintf(stderr, "kernel_launch: hipFuncSetAttribute failed\n"); grid = -1; return; }
        if (hipOccupancyMaxActiveBlocksPerMultiprocessor(&per_cu, (const void*)mk_fwd, NWAVES * 64, LDS_BYTES) != hipSuccess || per_cu < 1) { fprintf(stderr, "kernel_launch: occupancy query says %d\n", per_cu); per_cu = 1; }
        (void)hipGetLastError();
        grid = cus;
    }
    if (grid < 0) return;
    if (hipMemsetAsync((char*)d_ws + WS_CTL, 0, CTL_ZERO_BYTES, stream) != hipSuccess) { fprintf(stderr, "kernel_launch: memset failed\n"); return; }
    Args a{};
    for (int i = 0; i < 24; ++i) a.in[i] = (const float*)d_in[i];
    a.out = (float*)d_out; a.ws = (unsigned char*)d_ws;
#if MK_N_LAUNCHES == 1
    a.ph_lo = 0; a.ph_hi = NPH;
    void* kargs[] = {&a};
    hipError_t e = hipLaunchCooperativeKernel((const void*)mk_fwd, dim3(grid), dim3(NWAVES * 64), kargs, LDS_BYTES, stream);
    if (e != hipSuccess) fprintf(stderr, "kernel_launch: cooperative launch failed: %s (grid %d)\n", hipGetErrorString(e), grid);
#else
    for (int p = 0; p < NPH; ++p) { a.ph_lo = p; a.ph_hi = p + 1; hipLaunchKernelGGL(mk_fwd, dim3(grid), dim3(NWAVES * 64), LDS_BYTES, stream, a); }
#endif
}
```

```cpp
#include <hip/hip_runtime.h>
#include <hip/hip_cooperative_groups.h>
#include <cstdio>
#include <cstdint>
namespace cg = cooperative_groups;
#define MK_N_LAUNCHES 1
namespace pg8 {
#define PG8_LAS __attribute__((address_space(3)))
typedef unsigned short bf16_t;
typedef short bf16x8 __attribute__((ext_vector_type(8)));
typedef float f32x4 __attribute__((ext_vector_type(4)));
typedef unsigned u32x4 __attribute__((ext_vector_type(4)));
constexpr int BM = 256, BK = 64, HALF = 128, HTB = HALF * BK * 2  , STAGE_BYTES = 8 * HTB, NXCD = 8, WGM = 8;

__host__ __device__ __forceinline__ int lds_byte(int r, int c) { const int st = (r >> 4) * 2 + (c >> 5), rr = r & 15, cc = c & 31, ob = rr * 64 + cc * 2; return st * 1024 + (ob ^ (((ob >> 9) & 1) << 5)); }
__host__ __device__ __forceinline__ void stage_rc(int b, int& R, int& C) { const int st = b / 1024, sb = b % 1024, swz = sb ^ (((sb >> 9) & 1) << 5); R = (st >> 1) * 16 + swz / 64; C = (st & 1) * 32 + (swz % 64) / 2; }
__host__ __device__ __forceinline__ int perm32(int rho) { const int n = rho >> 4, i = rho & 15; return 8 * (i >> 2) + 4 * n + (i & 3); }

struct Unit { int pm, pn; };
struct Gemm { const bf16_t* A; const bf16_t* Bt; int M, N, K; };

struct StaticOrder {
    int nM, nN, nwg, G, c;
    __host__ __device__ void init(int M, int N, int G_, int c_) { nM = M / BM; nN = N / BM; nwg = nM * nN; G = G_; c = c_; }
    __host__ __device__ bool next(int i, Unit& u) const {
        const long L = (long)i * G + c; if (L >= nwg) return false;
        int wgid = (int)L; { const int q = nwg / NXCD, r = nwg % NXCD, xcd = wgid % NXCD, off = wgid / NXCD; wgid = (xcd < r ? xcd * (q + 1) : r * (q + 1) + (xcd - r) * q) + off; }
        const int nig = WGM * nN, gid = wgid / nig, fm = gid * WGM, gsz = (nM - fm) < WGM ? (nM - fm) : WGM;
        u.pm = fm + ((wgid % nig) % gsz); u.pn = (wgid % nig) / gsz; return true;
    }
    __device__ __forceinline__ void a_ready(const Unit&) const {}
    __device__ __forceinline__ void done(const Unit&) const {}
};

__device__ __forceinline__ unsigned cvt_pk_bf16(float lo, float hi) { unsigned r; asm volatile("v_cvt_pk_bf16_f32 %0, %1, %2" : "=v"(r) : "v"(lo), "v"(hi)); return r; }
template <class Epi, class Sched, bool ALIGN_EPI = false, bool SP2 = false>
__device__ __forceinline__ void gemm_phase(PG8_LAS unsigned char* lds, const Gemm g, const Sched& S, const Epi& E) {
    const int tid = threadIdx.x, wid = __builtin_amdgcn_readfirstlane(tid >> 6), lane = tid & 63, wr = wid >> 2, wc = wid & 3, fr = lane & 15, fq = lane >> 4;
    const int K = g.K, nt = K / BK;
    unsigned voffA[2], voffB[2];
#pragma unroll
    for (int i = 0; i < 2; ++i) { int R, C; stage_rc(tid * 16 + i * 8192, R, C); const int Rb = Epi::PERM ? ((R & ~31) + perm32(R & 31)) : R;
        voffA[i] = (unsigned)(R * K + C) * 2u; voffB[i] = (unsigned)(Rb * K + C) * 2u; }
    const size_t kstep = (size_t)(BK * 2);
    const size_t hstep = (size_t)HALF * K * 2;
    const size_t tstep = 2 * hstep;
    const unsigned ldsw = (unsigned)wid * 1024u;
    const int aoff = lds_byte(wr * 64 + fr, fq * 8), boff = lds_byte(wc * 32 + fr, fq * 8);
#define PG8_SA(b, h) (((b) * 2 + (h)) * HTB)
#define PG8_SB(b, h) ((4 + (b) * 2 + (h)) * HTB)
#define PG8_STAGE(bufoff, gbase, voff) do { _Pragma("unroll") for (int _i = 0; _i < 2; ++_i) \
        __builtin_amdgcn_global_load_lds((const unsigned*)((const char*)(gbase) + (voff)[_i]), (PG8_LAS unsigned*)(lds + (bufoff) + ldsw + _i * 8192), 16, 0, 0); } while (0)
#define PG8_LDA(dst, b, h) do { _Pragma("unroll") for (int m = 0; m < 4; ++m) _Pragma("unroll") for (int k = 0; k < 2; ++k) dst[m][k] = *(const PG8_LAS bf16x8*)(lds + PG8_SA(b, h) + aoff + m * 2048 + k * 1024); } while (0)
#define PG8_LDB(dst, b, h) do { _Pragma("unroll") for (int n = 0; n < 2; ++n) _Pragma("unroll") for (int k = 0; k < 2; ++k) dst[n][k] = *(const PG8_LAS bf16x8*)(lds + PG8_SB(b, h) + boff + n * 2048 + k * 1024); } while (0)
#define PG8_MMA(ai, bj, At, Bt) do { __builtin_amdgcn_s_setprio(1); _Pragma("unroll") for (int m = 0; m < 4; ++m) _Pragma("unroll") for (int n = 0; n < 2; ++n) _Pragma("unroll") for (int k = 0; k < 2; ++k) \
        acc[ai][bj][m][n] = __builtin_amdgcn_mfma_f32_16x16x32_bf16(Bt[n][k], At[m][k], acc[ai][bj][m][n], 0, 0, 0); __builtin_amdgcn_s_setprio(0); } while (0)
#define PG8_WAIT_V(n) asm volatile("s_waitcnt vmcnt(" #n ")" ::: "memory")
#define PG8_WAIT_L(n) asm volatile("s_waitcnt lgkmcnt(" #n ")" ::: "memory")
#define PG8_BAR __builtin_amdgcn_s_barrier()
#define PG8_SCHED __builtin_amdgcn_sched_barrier(0)
    Unit cur, nxt; int ui = 0;
    if (!S.next(0, cur)) return;
    f32x4 acc[2][2][4][2];
#pragma unroll
    for (int a = 0; a < 2; ++a)
#pragma unroll
        for (int b = 0; b < 2; ++b)
#pragma unroll
            for (int m = 0; m < 4; ++m)
#pragma unroll
                for (int n = 0; n < 2; ++n) acc[a][b][m][n] = (f32x4){0.f, 0.f, 0.f, 0.f};
    bf16x8 At[4][2], B0[2][2], B1[2][2];
    const char* cA = (const char*)g.A + (size_t)cur.pm * tstep; const char* cB = (const char*)g.Bt + (size_t)cur.pn * tstep;
    S.a_ready(cur);
    if constexpr (SP2) {
        PG8_STAGE(PG8_SB(0, 0), cB, voffB); PG8_STAGE(PG8_SB(0, 1), cB + hstep, voffB); PG8_STAGE(PG8_SA(0, 0), cA, voffA); PG8_STAGE(PG8_SA(0, 1), cA + hstep, voffA);
        if (wr == 1) PG8_BAR;
        PG8_WAIT_V(2); PG8_BAR;
        PG8_STAGE(PG8_SB(1, 0), cB + kstep, voffB); PG8_STAGE(PG8_SA(1, 0), cA + kstep, voffA); PG8_STAGE(PG8_SB(1, 1), cB + hstep + kstep, voffB);
        PG8_WAIT_V(6); PG8_BAR;
    } else {
        PG8_STAGE(PG8_SB(0, 0), cB, voffB); PG8_STAGE(PG8_SA(0, 0), cA, voffA); PG8_STAGE(PG8_SB(0, 1), cB + hstep, voffB); PG8_STAGE(PG8_SA(0, 1), cA + hstep, voffA);
        if (wr == 1) PG8_BAR;
        PG8_WAIT_V(4); PG8_BAR;
        PG8_STAGE(PG8_SB(1, 0), cB + kstep, voffB); PG8_STAGE(PG8_SA(1, 0), cA + kstep, voffA); PG8_STAGE(PG8_SB(1, 1), cB + hstep + kstep, voffB);
        PG8_WAIT_V(6); PG8_BAR;
    }
    for (;;) {
        const bool has_next = S.next(ui + 1, nxt);
        const char* nA = has_next ? (const char*)g.A + (size_t)nxt.pm * tstep : cA; const char* nB = has_next ? (const char*)g.Bt + (size_t)nxt.pn * tstep : cB;
        for (int t = 0; t < nt; t += 2) {
            const bool last = (t == nt - 2);
            const char* a1 = cA + (size_t)(t + 1) * kstep;
            const char* a2 = last ? nA : cA + (size_t)(t + 2) * kstep; const char* b2 = last ? nB : cB + (size_t)(t + 2) * kstep;
            const char* a3 = a2 + kstep; const char* b3 = b2 + kstep;
            if (last && has_next) S.a_ready(nxt);
            if constexpr (SP2) {
            PG8_LDB(B0, 0, 0); PG8_LDB(B1, 0, 1); PG8_SCHED; PG8_LDA(At, 0, 0); PG8_STAGE(PG8_SA(1, 1), a1 + hstep, voffA);
            PG8_WAIT_V(8); PG8_WAIT_L(0); PG8_BAR; PG8_MMA(0, 0, At, B0); PG8_MMA(0, 1, At, B1); PG8_BAR; PG8_SCHED;
            PG8_LDA(At, 0, 1); PG8_STAGE(PG8_SB(0, 0), b2, voffB); PG8_STAGE(PG8_SB(0, 1), b2 + hstep, voffB); PG8_STAGE(PG8_SA(0, 0), a2, voffA);
            PG8_WAIT_V(8); PG8_WAIT_L(0); PG8_BAR; PG8_MMA(1, 0, At, B0); PG8_MMA(1, 1, At, B1); PG8_BAR; PG8_SCHED;
            PG8_LDB(B0, 1, 0); PG8_LDB(B1, 1, 1); PG8_SCHED; PG8_LDA(At, 1, 0); PG8_STAGE(PG8_SA(0, 1), a2 + hstep, voffA);
            PG8_WAIT_V(8); PG8_WAIT_L(0); PG8_BAR; PG8_MMA(0, 0, At, B0); PG8_MMA(0, 1, At, B1); PG8_BAR; PG8_SCHED;
            PG8_LDA(At, 1, 1); PG8_STAGE(PG8_SB(1, 0), b3, voffB); PG8_STAGE(PG8_SB(1, 1), b3 + hstep, voffB); PG8_STAGE(PG8_SA(1, 0), a3, voffA);
            PG8_WAIT_V(8); PG8_WAIT_L(0); PG8_BAR; PG8_MMA(1, 0, At, B0); PG8_MMA(1, 1, At, B1); PG8_BAR; PG8_SCHED;
            } else {
            PG8_LDB(B0, 0, 0); PG8_SCHED; PG8_LDA(At, 0, 0); PG8_STAGE(PG8_SA(1, 1), a1 + hstep, voffA);
            PG8_WAIT_L(8); PG8_BAR; PG8_WAIT_L(0); PG8_MMA(0, 0, At, B0); PG8_BAR; PG8_SCHED;
            PG8_LDB(B1, 0, 1); PG8_STAGE(PG8_SB(0, 0), b2, voffB);
            PG8_BAR; PG8_WAIT_L(0); PG8_MMA(0, 1, At, B1); PG8_BAR;
            PG8_LDA(At, 0, 1); PG8_STAGE(PG8_SA(0, 0), a2, voffA);
            PG8_BAR; PG8_WAIT_L(0); PG8_MMA(1, 0, At, B0); PG8_BAR; PG8_SCHED;
            PG8_STAGE(PG8_SB(0, 1), b2 + hstep, voffB);
            PG8_WAIT_V(6); PG8_BAR; PG8_MMA(1, 1, At, B1); PG8_BAR;
            PG8_LDB(B0, 1, 0); PG8_SCHED; PG8_LDA(At, 1, 0); PG8_STAGE(PG8_SA(0, 1), a2 + hstep, voffA);
            PG8_WAIT_L(8); PG8_BAR; PG8_WAIT_L(0); PG8_MMA(0, 0, At, B0); PG8_BAR; PG8_SCHED;
            PG8_LDB(B1, 1, 1); PG8_STAGE(PG8_SB(1, 0), b3, voffB);
            PG8_BAR; PG8_WAIT_L(0); PG8_MMA(0, 1, At, B1); PG8_BAR;
            PG8_LDA(At, 1, 1); PG8_STAGE(PG8_SA(1, 0), a3, voffA);
            PG8_BAR; PG8_WAIT_L(0); PG8_MMA(1, 0, At, B0); PG8_BAR; PG8_SCHED;
            PG8_STAGE(PG8_SB(1, 1), b3 + hstep, voffB);
            PG8_WAIT_V(6); PG8_BAR; PG8_MMA(1, 1, At, B1); PG8_BAR;
            }
        }
        if constexpr (ALIGN_EPI) { if (wr == 0) PG8_BAR; }
        if constexpr (!Epi::AFTER_DRAIN) { E(acc, cur, wr, wc, fr, fq); S.done(cur); }
        if (!has_next) break;
#pragma unroll
        for (int a = 0; a < 2; ++a)
#pragma unroll
            for (int b = 0; b < 2; ++b)
#pragma unroll
                for (int m = 0; m < 4; ++m)
#pragma unroll
                    for (int n = 0; n < 2; ++n) acc[a][b][m][n] = (f32x4){0.f, 0.f, 0.f, 0.f};
        cur = nxt; cA = nA; cB = nB; ++ui;
        if constexpr (ALIGN_EPI) { if (wr == 1) PG8_BAR; }
    }
    PG8_WAIT_V(0);
    if constexpr (!ALIGN_EPI) { if (wr == 0) PG8_BAR; }
    PG8_BAR;
    if constexpr (Epi::AFTER_DRAIN) { E.fused(acc, cur, wr, wc, fr, fq, lds, wid, lane); S.done(cur); }
#undef PG8_SA
#undef PG8_SB
#undef PG8_STAGE
#undef PG8_LDA
#undef PG8_LDB
#undef PG8_MMA
#undef PG8_WAIT_V
#undef PG8_WAIT_L
#undef PG8_BAR
#undef PG8_SCHED
}
}

#ifndef S5_SIMPLE
#define S5_SIMPLE 0
#endif
#ifndef HG_SIMPLE
#define HG_SIMPLE 0
#endif
#ifndef REP0
#define REP0 1
#define REP1 1
#define REP2 1
#define REP3 1
#define REP4 1
#define REP6 1
#endif
#ifndef MK_N_LAUNCHES
#define MK_N_LAUNCHES 1
#endif
constexpr int DM = 1024, PB_B = 8, PB_T = 2048, SB_B = 128, SB_T = 8;
constexpr int MP = PB_B * PB_T, MS = SB_B * SB_T, MTOK = MP + MS;
constexpr int S5W = 512, S5G = 32, S5C = 16, S5N = 64;
constexpr int HGW = 512, HD = 128, HH = 4;
constexpr int INC = 2560, DFF = 2816;
constexpr float EPS = 1e-6f;
constexpr int NPH = 10;
constexpr size_t O_Y = 0, O_PRE = (size_t)MTOK * DM, O_PIM = O_PRE + 16384, O_PHG = O_PIM + 16384, O_SRE = O_PHG + 524288, O_SIM = O_SRE + 262144, O_SHG = O_SIM + 262144;
constexpr size_t MiB = 1u << 20;
constexpr size_t WS_CTL = 0, WS_WIN = 2 * MiB, WS_WGLU = 7 * MiB, WS_WOUT = 8 * MiB, WS_WGU = 10 * MiB, WS_WD = 21 * MiB;
constexpr size_t WS_XN = 27 * MiB, WS_PB = 61 * MiB, WS_FZ = 129 * MiB, WS_ACT = 61 * MiB, WS_GY = 163 * MiB, WS_OH = 180 * MiB, WS_MIX = 197 * MiB, WS_END = 231 * MiB;
constexpr int PBW = 2048;
constexpr int LDS_BYTES = 147456;
constexpr int NWAVES = 8;

#define GAS __attribute__((address_space(1)))
#define LAS __attribute__((address_space(3)))
typedef unsigned short bf16;
typedef unsigned v4u __attribute__((ext_vector_type(4)));
typedef unsigned v2u __attribute__((ext_vector_type(2)));
typedef float f32x4 __attribute__((ext_vector_type(4)));
#define LDS_WAIT() asm volatile("s_waitcnt lgkmcnt(0)" ::: "memory")
__device__ __forceinline__ unsigned f2bf(float f) { unsigned u = __builtin_bit_cast(unsigned, f); return (u + 0x7fffu + ((u >> 16) & 1u)) >> 16; }
__device__ __forceinline__ unsigned pk2(float lo, float hi) { return f2bf(lo) | (f2bf(hi) << 16); }
__device__ __forceinline__ float bf2f(unsigned short h) { return __builtin_bit_cast(float, (unsigned)h << 16); }
__device__ __forceinline__ float bflo(unsigned w) { return __builtin_bit_cast(float, w << 16); }
__device__ __forceinline__ float bfhi(unsigned w) { return __builtin_bit_cast(float, w & 0xffff0000u); }
__device__ __forceinline__ float sigmoidf_(float x) { return 1.0f / (1.0f + __expf(-x)); }
__device__ __forceinline__ float siluf_(float x) { return x / (1.0f + __expf(-x)); }
__device__ __forceinline__ float gelu_tanh(float x) { const float z = 1.5957691216057308f * (x + 0.044715f * x * x * x); return x / (1.0f + __expf(-z)); }
__device__ __forceinline__ float wave_sum(float v) {
#pragma unroll
    for (int o = 1; o < 64; o <<= 1) v += __shfl_xor(v, o);
    return v;
}

struct Args { const float* in[24]; float* out; unsigned char* ws; int ph_lo, ph_hi; };

struct Frame {
    LAS unsigned char* lds;
    int tid, lane, wave, G, bid;
    const float* in[24];
    float* out; unsigned char* ws;
};
__device__ __forceinline__ const float* xrow(const Frame& F, int m) { return m < MP ? F.in[0] + (size_t)m * DM : F.in[1] + (size_t)(m - MP) * DM; }

__device__ __forceinline__ void transpose_item(const float* W, int ldw, bf16* WT, int K, int k0, int sn0, int dn0, LAS float* scr, int lane) {
#pragma unroll 8
    for (int i = 0; i < 32; ++i) { const int kk = 2 * i + (lane >> 5); scr[kk * 33 + (lane & 31)] = W[(size_t)(k0 + kk) * ldw + sn0 + (lane & 31)]; }
    LDS_WAIT(); asm volatile("" ::: "memory");
    const int c = lane & 7;
#pragma unroll
    for (int j = 0; j < 4; ++j) { const int n = (lane >> 3) + 8 * j; const LAS float* s = scr + (8 * c) * 33 + n;
        v4u o; o.x = pk2(s[0 * 33], s[1 * 33]); o.y = pk2(s[2 * 33], s[3 * 33]); o.z = pk2(s[4 * 33], s[5 * 33]); o.w = pk2(s[6 * 33], s[7 * 33]);
        *(GAS v4u*)(WT + (size_t)(dn0 + n) * K + k0 + 8 * c) = o; }
    LDS_WAIT(); asm volatile("" ::: "memory");
}
__device__ __forceinline__ void rms_row_bf16(const float* xr_, const float* gain, bf16* orow, int lane) {
    const GAS f32x4* xr = (const GAS f32x4*)xr_ + lane;
    f32x4 v[4]; float s = 0.f;
#pragma unroll
    for (int j = 0; j < 4; ++j) { v[j] = xr[64 * j]; s += (v[j].x * v[j].x + v[j].y * v[j].y) + (v[j].z * v[j].z + v[j].w * v[j].w); }
    const float rstd = 1.0f / sqrtf(wave_sum(s) * (1.0f / DM) + EPS);
    GAS v2u* o8 = (GAS v2u*)orow + lane;
#pragma unroll
    for (int j = 0; j < 4; ++j) { const f32x4 g = ((const GAS f32x4*)gain)[lane + 64 * j]; v2u w; w.x = pk2(v[j].x * rstd * g.x, v[j].y * rstd * g.y); w.y = pk2(v[j].z * rstd * g.z, v[j].w * rstd * g.w); o8[64 * j] = w; }
}

__device__ __forceinline__ void p0_prologue(Frame& F) {
    LAS float* scr = (LAS float*)(F.lds + F.wave * 16384);
    const int gw = F.bid * NWAVES + F.wave, NGW = F.G * NWAVES;
    bf16* WinT = (bf16*)(F.ws + WS_WIN); bf16* WgluT = (bf16*)(F.ws + WS_WGLU); bf16* WoutT = (bf16*)(F.ws + WS_WOUT); bf16* WguT = (bf16*)(F.ws + WS_WGU); bf16* WdT = (bf16*)(F.ws + WS_WD);
    constexpr int I_IN = (DM / 64) * (INC / 32), I_GLU = (S5W / 64) * (S5W / 32), I_OUT = (DM / 64) * (DM / 32), I_G = (DM / 64) * (DFF / 32), I_D = (DFF / 64) * (DM / 32);
    constexpr int NITEMS = I_IN + I_GLU + I_OUT + 2 * I_G + I_D;
    for (int it = gw; it < NITEMS; it += NGW) {
        int r = it;
        if (r < I_IN) { const int nblk = INC / 32, kb = r / nblk, nb = r % nblk, sn0 = nb * 32; const int seg = sn0 / 512, off = sn0 % 512;
            const int dseg = seg == 0 ? 0 : seg == 1 ? 1 : seg == 2 ? 4 : seg == 3 ? 2 : 3;
            transpose_item(F.in[7], INC, WinT, DM, kb * 64, sn0, dseg * 512 + off, scr, F.lane); continue; } r -= I_IN;
        if (r < I_GLU) { const int nblk = S5W / 32, kb = r / nblk, nb = r % nblk; transpose_item(F.in[16], S5W, WgluT, S5W, kb * 64, nb * 32, nb * 32, scr, F.lane); continue; } r -= I_GLU;
        if (r < I_OUT) { const int nblk = DM / 32, kb = r / nblk, nb = r % nblk; transpose_item(F.in[18], DM, WoutT, DM, kb * 64, nb * 32, nb * 32, scr, F.lane); continue; } r -= I_OUT;
        if (r < I_G) { const int nblk = DFF / 32, kb = r / nblk, nb = r % nblk, sn0 = nb * 32; transpose_item(F.in[20], DFF, WguT, DM, kb * 64, sn0, 256 * (sn0 / 128) + (sn0 % 128), scr, F.lane); continue; } r -= I_G;
        if (r < I_G) { const int nblk = DFF / 32, kb = r / nblk, nb = r % nblk, sn0 = nb * 32; transpose_item(F.in[21], DFF, WguT, DM, kb * 64, sn0, 256 * (sn0 / 128) + 128 + (sn0 % 128), scr, F.lane); continue; } r -= I_G;
        { const int nblk = DM / 32, kb = r / nblk, nb = r % nblk; transpose_item(F.in[22], DM, WdT, DFF, kb * 64, nb * 32, nb * 32, scr, F.lane); }
    }
    bf16* XN = (bf16*)(F.ws + WS_XN);
    for (int m = gw; m < MTOK; m += NGW) rms_row_bf16(xrow(F, m), F.in[6], XN + (size_t)m * DM, F.lane);
}

using pg8::Unit; using pg8::u32x4; using pg8::cvt_pk_bf16; using pg8::BM; using pg8::HALF;
struct EpiIn {
    static constexpr bool PERM = true, AFTER_DRAIN = false;
    bf16* PB; float* FZ;
    __device__ __forceinline__ void operator()(const pg8::f32x4 (&acc)[2][2][4][2], const Unit& u, int wr, int wc, int fr, int fq) const {
        const int row0 = u.pm * BM + wr * 64 + fr;
        if (u.pn < 8) { const int col0 = u.pn * BM + wc * 32 + 8 * fq;
#pragma unroll
            for (int ai = 0; ai < 2; ++ai)
#pragma unroll
                for (int m = 0; m < 4; ++m) { bf16* rowp = PB + (size_t)(row0 + ai * HALF + m * 16) * PBW + col0;
#pragma unroll
                    for (int bj = 0; bj < 2; ++bj) { const pg8::f32x4 v0 = acc[ai][bj][m][0], v1 = acc[ai][bj][m][1]; u32x4 w; w.x = cvt_pk_bf16(v0[0], v0[1]); w.y = cvt_pk_bf16(v0[2], v0[3]); w.z = cvt_pk_bf16(v1[0], v1[1]); w.w = cvt_pk_bf16(v1[2], v1[3]);
                        *(u32x4*)(rowp + bj * HALF) = w; } }
        } else { const int col0 = (u.pn - 8) * BM + wc * 32 + 8 * fq;
#pragma unroll
            for (int ai = 0; ai < 2; ++ai)
#pragma unroll
                for (int m = 0; m < 4; ++m) { float* rowp = FZ + (size_t)(row0 + ai * HALF + m * 16) * 512 + col0;
#pragma unroll
                    for (int bj = 0; bj < 2; ++bj)
#pragma unroll
                        for (int n = 0; n < 2; ++n) *(pg8::f32x4*)(rowp + bj * HALF + 4 * n) = acc[ai][bj][m][n]; }
        }
    }
};
struct EpiGlu {
    static constexpr bool PERM = true, AFTER_DRAIN = false;
    const bf16* GY; bf16* MIX;
    __device__ __forceinline__ void operator()(const pg8::f32x4 (&acc)[2][2][4][2], const Unit& u, int wr, int wc, int fr, int fq) const {
        const int row0 = u.pm * BM + wr * 64 + fr, col0 = u.pn * BM + wc * 32 + 8 * fq;
#pragma unroll
        for (int ai = 0; ai < 2; ++ai)
#pragma unroll
            for (int m = 0; m < 4; ++m) { const size_t r = (size_t)(row0 + ai * HALF + m * 16);
#pragma unroll
                for (int bj = 0; bj < 2; ++bj) { const u32x4 g = *(const u32x4*)(GY + r * 512 + col0 + bj * HALF); const pg8::f32x4 v0 = acc[ai][bj][m][0], v1 = acc[ai][bj][m][1];
                    u32x4 w; w.x = cvt_pk_bf16(bflo(g.x) * sigmoidf_(v0[0]), bfhi(g.x) * sigmoidf_(v0[1])); w.y = cvt_pk_bf16(bflo(g.y) * sigmoidf_(v0[2]), bfhi(g.y) * sigmoidf_(v0[3]));
                    w.z = cvt_pk_bf16(bflo(g.z) * sigmoidf_(v1[0]), bfhi(g.z) * sigmoidf_(v1[1])); w.w = cvt_pk_bf16(bflo(g.w) * sigmoidf_(v1[2]), bfhi(g.w) * sigmoidf_(v1[3]));
                    *(u32x4*)(MIX + r * DM + col0 + bj * HALF) = w; } }
    }
};
struct EpiOut {
    static constexpr bool PERM = false, AFTER_DRAIN = false;
    const float* xp; const float* xs; float* Y;
    __device__ __forceinline__ void operator()(const pg8::f32x4 (&acc)[2][2][4][2], const Unit& u, int wr, int wc, int fr, int fq) const {
        const int row0 = u.pm * BM + wr * 64 + fr, col0 = u.pn * BM + wc * 32 + 4 * fq;
        const float* xb = (u.pm < MP / BM) ? xp : xs - (size_t)MP * DM;
#pragma unroll
        for (int ai = 0; ai < 2; ++ai)
#pragma unroll
            for (int m = 0; m < 4; ++m) { const size_t off = (size_t)(row0 + ai * HALF + m * 16) * DM + col0;
#pragma unroll
                for (int bj = 0; bj < 2; ++bj)
#pragma unroll
                    for (int n = 0; n < 2; ++n) { const pg8::f32x4 xv = *(const pg8::f32x4*)(xb + off + bj * HALF + n * 16); *(pg8::f32x4*)(Y + off + bj * HALF + n * 16) = xv + acc[ai][bj][m][n]; } }
    }
};
struct EpiAct {
    static constexpr bool PERM = true, AFTER_DRAIN = false;
    bf16* ACT;
    __device__ __forceinline__ void operator()(const pg8::f32x4 (&acc)[2][2][4][2], const Unit& u, int wr, int wc, int fr, int fq) const {
        const int row0 = u.pm * BM + wr * 64 + fr, col0 = u.pn * HALF + wc * 32 + 8 * fq;
#pragma unroll
        for (int ai = 0; ai < 2; ++ai)
#pragma unroll
            for (int m = 0; m < 4; ++m) { const pg8::f32x4 g0 = acc[ai][0][m][0], g1 = acc[ai][0][m][1], u0 = acc[ai][1][m][0], u1 = acc[ai][1][m][1];
                u32x4 w; w.x = cvt_pk_bf16(siluf_(g0[0]) * u0[0], siluf_(g0[1]) * u0[1]); w.y = cvt_pk_bf16(siluf_(g0[2]) * u0[2], siluf_(g0[3]) * u0[3]);
                w.z = cvt_pk_bf16(siluf_(g1[0]) * u1[0], siluf_(g1[1]) * u1[1]); w.w = cvt_pk_bf16(siluf_(g1[2]) * u1[2], siluf_(g1[3]) * u1[3]);
                *(u32x4*)(ACT + (size_t)(row0 + ai * HALF + m * 16) * DFF + col0) = w; }
    }
};
struct EpiDown {
    static constexpr bool PERM = false, AFTER_DRAIN = false;
    float* Y;
    __device__ __forceinline__ void operator()(const pg8::f32x4 (&acc)[2][2][4][2], const Unit& u, int wr, int wc, int fr, int fq) const {
        const int row0 = u.pm * BM + wr * 64 + fr, col0 = u.pn * BM + wc * 32 + 4 * fq;
#pragma unroll
        for (int ai = 0; ai < 2; ++ai)
#pragma unroll
            for (int m = 0; m < 4; ++m) { const size_t off = (size_t)(row0 + ai * HALF + m * 16) * DM + col0;
#pragma unroll
                for (int bj = 0; bj < 2; ++bj)
#pragma unroll
                    for (int n = 0; n < 2; ++n) { float* p = Y + off + bj * HALF + n * 16; const pg8::f32x4 xv = *(const pg8::f32x4*)p; *(pg8::f32x4*)p = xv + acc[ai][bj][m][n]; } }
    }
};

typedef float f32x16 __attribute__((ext_vector_type(16)));
typedef short s16x8 __attribute__((ext_vector_type(8)));
constexpr int S5_LD = 136;
constexpr int L5_WG = 0, L5_VG = 34816, L5_KC = 69632, L5_U = 74240, L5_HS = 91648, L5_HL = 109056, L5_PW = 141824;
template <int MODE> __device__ __forceinline__ void s5_fast_item(Frame& F, int item) {
    const int tid = F.tid, lane = F.lane, wave = F.wave;
    const int g = item & 31, b8 = item >> 5;
    LAS bf16* WgT = (LAS bf16*)(F.lds + L5_WG); LAS bf16* VgT = (LAS bf16*)(F.lds + L5_VG); LAS bf16* Kc = (LAS bf16*)(F.lds + L5_KC);
    LAS bf16* Us = (LAS bf16*)(F.lds + L5_U); LAS bf16* HS = (LAS bf16*)(F.lds + L5_HS); LAS float* HL = (LAS float*)(F.lds + L5_HL);
    LAS float* Pre = (LAS float*)(F.lds + L5_PW); LAS float* Pim = Pre + 9 * 64;
    LAS float* Cre = HL, * Cim = HL + 1024, * Bre = HL + 2048, * Bim = HL + 3072; LAS float* Ff = HL + 4096;
    if (tid < 64) { const int n = tid;
        const float a_re = F.in[8][g * S5N + n], a_im = F.in[9][g * S5N + n], dt = expf(F.in[10][g]);
        const float mag = expf(a_re * dt), ab_re = mag * cosf(a_im * dt), ab_im = mag * sinf(a_im * dt);
        const float den = a_re * a_re + a_im * a_im, nr = ab_re - 1.0f, ni = ab_im;
        Ff[n] = (nr * a_re + ni * a_im) / den; Ff[64 + n] = (ni * a_re - nr * a_im) / den;
        float pr = 1.f, pi = 0.f;
#pragma unroll
        for (int j = 0; j < 9; ++j) { Pre[j * 64 + n] = pr; Pim[j * 64 + n] = pi; const float t = pr * ab_re - pi * ab_im; pi = pr * ab_im + pi * ab_re; pr = t; }
    }
    __syncthreads();
#pragma unroll
    for (int i = 0; i < 2; ++i) { const int idx = tid + 512 * i;
        { const int c = idx >> 6, n = idx & 63; Cre[c * 64 + n] = F.in[13][(size_t)(g * 16 + c) * S5N + n]; Cim[c * 64 + n] = F.in[14][(size_t)(g * 16 + c) * S5N + n]; }
        { const int n = idx >> 4, c = idx & 15; const float br = F.in[11][(size_t)(g * S5N + n) * 16 + c], bi = F.in[12][(size_t)(g * S5N + n) * 16 + c], fr = Ff[n], fi = Ff[64 + n];
          Bre[n * 16 + c] = fr * br - fi * bi; Bim[n * 16 + c] = fr * bi + fi * br; } }
    __syncthreads();
#pragma unroll 1
    for (int i = 0; i < 4; ++i) { const int idx = tid + 512 * i, j = idx >> 8, c = (idx >> 4) & 15, cp = idx & 15; float acc = 0.f;
        for (int n = 0; n < 64; ++n) { const float cr = Cre[c * 64 + n], ci = Cim[c * 64 + n], pr = Pre[j * 64 + n], pi = Pim[j * 64 + n];
            const float xr = cr * pr - ci * pi, xi = cr * pi + ci * pr; acc += xr * Bre[n * 16 + cp] - xi * Bim[n * 16 + cp]; }
        Kc[idx] = (bf16)f2bf(acc); }
    if (tid < 256) Kc[2048 + tid] = 0;
#pragma unroll 4
    for (int i = 0; i < 32; ++i) { const int idx = tid + 512 * i, np = idx >> 7, k = idx & 127, s = k >> 4, cp = k & 15, n = np & 63;
        const float pr = Pre[(7 - s) * 64 + n], pi = Pim[(7 - s) * 64 + n], br = Bre[n * 16 + cp], bi = Bim[n * 16 + cp];
        WgT[np * S5_LD + k] = (bf16)f2bf(np < 64 ? pr * br - pi * bi : pr * bi + pi * br); }
#pragma unroll 4
    for (int i = 0; i < 32; ++i) { const int idx = tid + 512 * i, col = idx >> 7, np = idx & 127, t = col >> 4, c = col & 15, n = np & 63;
        const float pr = Pre[(t + 1) * 64 + n], pi = Pim[(t + 1) * 64 + n], cr = Cre[c * 64 + n], ci = Cim[c * 64 + n];
        VgT[col * S5_LD + np] = (bf16)f2bf(np < 64 ? cr * pr - ci * pi : -(cr * pi + ci * pr)); }
    __syncthreads();
    if (MODE == 1) return;
    const bf16* PB = (const bf16*)(F.ws + WS_PB); bf16* GY = (bf16*)(F.ws + WS_GY);
    const int rb = wave >> 2, cb = wave & 3, r32 = lane & 31, hh = lane >> 5;
    float h_re = 0.f, h_im = 0.f;
    const float p8r = Pre[8 * 64 + lane], p8i = Pim[8 * 64 + lane];
    const float dl = F.in[15][g * 16 + (lane & 15)];
    for (int seg = 0; seg < 5; ++seg) {
        const bool samp = (seg == 4);
        const int tok0 = samp ? MP + 128 * b8 : b8 * PB_T + seg * 512;
        const int ntok = samp ? 128 : 512;
        if (tid < ntok) { const v4u* src = (const v4u*)(PB + (size_t)(tok0 + tid) * PBW + g * 16); const v4u a = src[0], b = src[1];
            LAS v4u* dst = (LAS v4u*)(Us + (tid >> 3) * S5_LD + (tid & 7) * 16); dst[0] = a; dst[1] = b; }
        __syncthreads();
        { f32x16 acc = {};
#pragma unroll
          for (int s = 0; s < 8; ++s) { const s16x8 a = *(const LAS s16x8*)(Us + (32 * rb + r32) * S5_LD + s * 16 + 8 * hh); const s16x8 b = *(const LAS s16x8*)(WgT + (32 * cb + r32) * S5_LD + s * 16 + 8 * hh);
              acc = __builtin_amdgcn_mfma_f32_32x32x16_bf16(a, b, acc, 0, 0, 0); }
#pragma unroll
          for (int r = 0; r < 16; ++r) HL[(32 * rb + (r & 3) + 8 * (r >> 2) + 4 * hh) * 128 + 32 * cb + r32] = acc[r]; }
        __syncthreads();
        if (wave == 0) {
            if (!samp) {
#pragma unroll 8
                for (int c = 0; c < 64; ++c) { const float xr = HL[c * 128 + lane], xi = HL[c * 128 + 64 + lane];
                    HS[c * S5_LD + lane] = (bf16)f2bf(h_re); HS[c * S5_LD + 64 + lane] = (bf16)f2bf(h_im);
                    const float nr = p8r * h_re - p8i * h_im + xr, ni = p8r * h_im + p8i * h_re + xi; h_re = nr; h_im = ni; }
                if (seg == 3) { F.out[O_PRE + (size_t)(b8 * S5G + g) * S5N + lane] = h_re; F.out[O_PIM + (size_t)(b8 * S5G + g) * S5N + lane] = h_im; }
            } else {
#pragma unroll 4
                for (int r = 0; r < 16; ++r) { const size_t idx = (size_t)((16 * b8 + r) * S5G + g) * S5N + lane; const float sr = F.in[2][idx], si = F.in[3][idx];
                    HS[r * S5_LD + lane] = (bf16)f2bf(sr); HS[r * S5_LD + 64 + lane] = (bf16)f2bf(si);
                    F.out[O_SRE + idx] = p8r * sr - p8i * si + HL[r * 128 + lane]; F.out[O_SIM + idx] = p8r * si + p8i * sr + HL[r * 128 + 64 + lane]; }
            }
        }
        __syncthreads();
        if (MODE != 2 && !(samp && rb == 1)) { f32x16 acc = {};
            const int tl = 2 * cb + ((lane >> 4) & 1), c = lane & 15;
#pragma unroll
            for (int s = 0; s < 8; ++s) if (s <= 2 * cb + 1) { const int j = tl - s, jj = j < 0 ? 8 : j;
                const s16x8 a = *(const LAS s16x8*)(Us + (32 * rb + r32) * S5_LD + s * 16 + 8 * hh); const s16x8 b = *(const LAS s16x8*)(Kc + (jj * 16 + c) * 16 + 8 * hh);
                acc = __builtin_amdgcn_mfma_f32_32x32x16_bf16(a, b, acc, 0, 0, 0); }
#pragma unroll
            for (int kb = 0; kb < 8; ++kb) { const s16x8 a = *(const LAS s16x8*)(HS + (32 * rb + r32) * S5_LD + kb * 16 + 8 * hh); const s16x8 b = *(const LAS s16x8*)(VgT + (32 * cb + r32) * S5_LD + kb * 16 + 8 * hh);
                acc = __builtin_amdgcn_mfma_f32_32x32x16_bf16(a, b, acc, 0, 0, 0); }
#pragma unroll
            for (int r = 0; r < 16; ++r) { const int row = 32 * rb + (r & 3) + 8 * (r >> 2) + 4 * hh;
                if (!samp || row < 16) { const float u = bf2f(Us[row * S5_LD + tl * 16 + c]); const float y = acc[r] + dl * u;
                    GY[(size_t)(tok0 + row * 8 + tl) * S5W + g * 16 + c] = (bf16)f2bf(gelu_tanh(y)); } }
        }
        __syncthreads();
    }
}
typedef float f32x4v __attribute__((ext_vector_type(4)));
constexpr int HG_LDQ = 136, HG_LDT = 72;
constexpr size_t WS_DSC = WS_XN;
constexpr size_t WS_DEC = WS_CTL + 1 * MiB;
#define HG_GATES(NEEDQ) \
    float gl[16], kk[16], qq[16]; float run = 0.f; \
    _Pragma("unroll") for (int i = 0; i < 16; ++i) { const size_t tok = (size_t)(tok0 + 16 * tq + i); const float fz = FZ[tok * 512 + col]; if (NEEDQ) qq[i] = bf2f(PB[tok * PBW + 512 + col]); \
        const float sg = 1.0f / (1.0f + __expf(-fz)), f = lb + (1.0f - lb) * sg; kk[i] = 1.0f - f; run += __log2f(f); gl[i] = run; } \
    TOT[tq * 128 + ch] = run;
#define HG_VT_LOAD() \
    _Pragma("unroll") for (int i = 0; i < 2; ++i) { const int p = tid + 512 * i, vg = p >> 6, tk = p & 63; const v4u w = *(const v4u*)(PB + (size_t)(tok0 + tk) * PBW + 1024 + h * HD + vg * 8); \
        LAS bf16* d = Vt + (vg * 8) * HG_LDT + tk; d[0] = (bf16)(w.x & 0xffffu); d[HG_LDT] = (bf16)(w.x >> 16); d[2 * HG_LDT] = (bf16)(w.y & 0xffffu); d[3 * HG_LDT] = (bf16)(w.y >> 16); \
        d[4 * HG_LDT] = (bf16)(w.z & 0xffffu); d[5 * HG_LDT] = (bf16)(w.z >> 16); d[6 * HG_LDT] = (bf16)(w.w & 0xffffu); d[7 * HG_LDT] = (bf16)(w.w >> 16); }

constexpr int LA_KT = 0, LA_VT = 18432, LA_TOT = 36864;
__device__ __forceinline__ void hgA_item(Frame& F, int item) {
    const int tid = F.tid, lane = F.lane, wave = F.wave;
    const int bh = item >> 5, chunk = item & 31, b = bh >> 2, h = bh & 3, tok0 = b * PB_T + chunk * 64;
    LAS bf16* Kt = (LAS bf16*)(F.lds + LA_KT); LAS bf16* Vt = (LAS bf16*)(F.lds + LA_VT); LAS float* TOT = (LAS float*)(F.lds + LA_TOT);
    const bf16* PB = (const bf16*)(F.ws + WS_PB); const float* FZ = (const float*)(F.ws + WS_FZ);
    bf16* DSC = (bf16*)(F.ws + WS_DSC) + (size_t)item * HD * HD; float* DEC = (float*)(F.ws + WS_DEC) + (size_t)item * HD;
    const int ch = tid & 127, tq = tid >> 7, col = h * HD + ch;
    const float lb = 1.0f / (1.0f + expf(F.in[5][512 + col] - F.in[5][col]));
    HG_GATES(false)
    HG_VT_LOAD()
    __syncthreads();
    { const float t0 = TOT[ch], t1 = TOT[128 + ch], t2 = TOT[256 + ch], t3 = TOT[384 + ch];
      const float glast = (t0 + t1) + (t2 + t3), off = (tq == 0 ? 0.f : tq == 1 ? t0 : tq == 2 ? t0 + t1 : t0 + t1 + t2);
      unsigned kp[8];
#pragma unroll
      for (int i = 0; i < 16; ++i) { const unsigned kb = f2bf(kk[i] * __builtin_amdgcn_exp2f(glast - (off + gl[i]))); if (i & 1) kp[i >> 1] |= kb << 16; else kp[i >> 1] = kb; }
      LAS v4u* kd = (LAS v4u*)(Kt + ch * HG_LDT + 16 * tq); v4u a, c2; a.x = kp[0]; a.y = kp[1]; a.z = kp[2]; a.w = kp[3]; c2.x = kp[4]; c2.y = kp[5]; c2.z = kp[6]; c2.w = kp[7]; kd[0] = a; kd[1] = c2;
      if (tq == 0) DEC[ch] = __builtin_amdgcn_exp2f(glast); }
    __syncthreads();
    { const int r32 = lane & 31, hh = lane >> 5, kb = wave >> 1;
#pragma unroll
      for (int vbi = 0; vbi < 2; ++vbi) { const int vb = 2 * (wave & 1) + vbi; f32x16 acc = {};
#pragma unroll
          for (int ks = 0; ks < 4; ++ks) { const s16x8 a = *(const LAS s16x8*)(Kt + (32 * kb + r32) * HG_LDT + 16 * ks + 8 * hh); const s16x8 bb = *(const LAS s16x8*)(Vt + (32 * vb + r32) * HG_LDT + 16 * ks + 8 * hh);
              acc = __builtin_amdgcn_mfma_f32_32x32x16_bf16(a, bb, acc, 0, 0, 0); }
          bf16* dst = DSC + (size_t)(32 * vb + r32) * HD + 32 * kb + 4 * hh;
#pragma unroll
          for (int q = 0; q < 4; ++q) { v2u w; w.x = pk2(acc[4 * q], acc[4 * q + 1]); w.y = pk2(acc[4 * q + 2], acc[4 * q + 3]); *(v2u*)(dst + 8 * q) = w; } } }
    __syncthreads();
}
__device__ __forceinline__ void hg_scan(Frame& F) {
    bf16* DSC = (bf16*)(F.ws + WS_DSC); const float* DEC = (const float*)(F.ws + WS_DEC);
    for (int T = F.bid * 512 + F.tid; T < 32 * 4096; T += F.G * 512) {
        const int bh = T >> 12, e = T & 4095, v = e >> 5, k4 = (e & 31) * 4;
        f32x4 S = {0.f, 0.f, 0.f, 0.f};
#pragma unroll 1
        for (int c0 = 0; c0 < 32; c0 += 8) {
            v2u x[8]; f32x4 d[8];
#pragma unroll
            for (int c = 0; c < 8; ++c) { const size_t it = (size_t)(bh * 32 + c0 + c); x[c] = *(const v2u*)(DSC + (it * HD + v) * HD + k4); d[c] = *(const f32x4*)(DEC + it * HD + k4); }
#pragma unroll
            for (int c = 0; c < 8; ++c) { const size_t it = (size_t)(bh * 32 + c0 + c); v2u o; o.x = pk2(S.x, S.y); o.y = pk2(S.z, S.w); *(v2u*)(DSC + (it * HD + v) * HD + k4) = o;
                S.x = d[c].x * S.x + bflo(x[c].x); S.y = d[c].y * S.y + bfhi(x[c].x); S.z = d[c].z * S.z + bflo(x[c].y); S.w = d[c].w * S.w + bfhi(x[c].y); }
        }
        float* o = F.out + O_PHG + (size_t)bh * HD * HD + (size_t)k4 * HD + v;
        o[0] = S.x; o[HD] = S.y; o[2 * HD] = S.z; o[3 * HD] = S.w;
    }
}
constexpr int LC_QS = 0, LC_QH = 17408, LC_KS = 34816, LC_VT = 52224, LC_AT = 70656, LC_SC = 79872, LC_TOT = 114688, LC_SS = 116736;
__device__ __forceinline__ void hgC_item(Frame& F, int item) {
    const int tid = F.tid, lane = F.lane, wave = F.wave;
    const int bh = item >> 5, chunk = item & 31, b = bh >> 2, h = bh & 3, tok0 = b * PB_T + chunk * 64;
    LAS bf16* Qs = (LAS bf16*)(F.lds + LC_QS); LAS bf16* Qh = (LAS bf16*)(F.lds + LC_QH); LAS bf16* Ks = (LAS bf16*)(F.lds + LC_KS); LAS bf16* Vt = (LAS bf16*)(F.lds + LC_VT);
    LAS bf16* At = (LAS bf16*)(F.lds + LC_AT); LAS bf16* SC = (LAS bf16*)(F.lds + LC_SC); LAS float* TOT = (LAS float*)(F.lds + LC_TOT); LAS float* SS = (LAS float*)(F.lds + LC_SS);
    const bf16* PB = (const bf16*)(F.ws + WS_PB); const float* FZ = (const float*)(F.ws + WS_FZ); bf16* MIX = (bf16*)(F.ws + WS_MIX);
    const bf16* DSC = (const bf16*)(F.ws + WS_DSC) + (size_t)item * HD * HD;
    const int ch = tid & 127, tq = tid >> 7, col = h * HD + ch;
    const float lb = 1.0f / (1.0f + expf(F.in[5][512 + col] - F.in[5][col]));
#pragma unroll
    for (int i = 0; i < 4; ++i) { const int p = tid + 512 * i, v = p >> 4, kg = (p & 15) * 8; *(LAS v4u*)(SC + v * HG_LDQ + kg) = *(const v4u*)(DSC + (size_t)v * HD + kg); }
    HG_GATES(true)
    HG_VT_LOAD()
    __syncthreads();
    { const float t0 = TOT[ch], t1 = TOT[128 + ch], t2 = TOT[256 + ch];
      const float gref = t0 + t1, off = (tq == 0 ? 0.f : tq == 1 ? t0 : tq == 2 ? gref : gref + t2);
#pragma unroll
      for (int i = 0; i < 16; ++i) { const float G = off + gl[i], e1 = __builtin_amdgcn_exp2f(G - gref), e2 = __builtin_amdgcn_rcpf(e1), e3 = __builtin_amdgcn_exp2f(G);
          Qs[(16 * tq + i) * HG_LDQ + ch] = (bf16)f2bf(qq[i] * e1); Ks[(16 * tq + i) * HG_LDQ + ch] = (bf16)f2bf(kk[i] * e2); Qh[(16 * tq + i) * HG_LDQ + ch] = (bf16)f2bf(qq[i] * e3); } }
    __syncthreads();
    const int r32 = lane & 31, hh = lane >> 5;
    if (wave < 4) { const int tb = wave >> 1, sb = wave & 1; f32x16 acc = {};
        if (sb <= tb) {
#pragma unroll
            for (int ks = 0; ks < 8; ++ks) { const s16x8 a = *(const LAS s16x8*)(Qs + (32 * tb + r32) * HG_LDQ + 16 * ks + 8 * hh); const s16x8 bb = *(const LAS s16x8*)(Ks + (32 * sb + r32) * HG_LDQ + 16 * ks + 8 * hh);
                acc = __builtin_amdgcn_mfma_f32_32x32x16_bf16(a, bb, acc, 0, 0, 0); } }
        const int s = 32 * sb + r32;
#pragma unroll
        for (int r = 0; r < 16; ++r) { const int t = 32 * tb + (r & 3) + 8 * (r >> 2) + 4 * hh; At[t * HG_LDT + s] = (s <= t) ? (bf16)f2bf(acc[r]) : (bf16)0; } }
    __syncthreads();
    const int tb = wave >> 2, vb = wave & 3, t = 32 * tb + r32;
    v2u og[4];
#pragma unroll
    for (int q = 0; q < 4; ++q) og[q] = *(const v2u*)(PB + (size_t)(tok0 + t) * PBW + 1536 + h * HD + 32 * vb + 8 * q + 4 * hh);
    f32x16 acc = {};
#pragma unroll
    for (int ks = 0; ks < 4; ++ks) if (ks < 2 * tb + 2) { const s16x8 a = *(const LAS s16x8*)(Vt + (32 * vb + r32) * HG_LDT + 16 * ks + 8 * hh); const s16x8 bb = *(const LAS s16x8*)(At + t * HG_LDT + 16 * ks + 8 * hh);
        acc = __builtin_amdgcn_mfma_f32_32x32x16_bf16(a, bb, acc, 0, 0, 0); }
#pragma unroll
    for (int ks = 0; ks < 8; ++ks) { const s16x8 a = *(const LAS s16x8*)(SC + (32 * vb + r32) * HG_LDQ + 16 * ks + 8 * hh); const s16x8 bb = *(const LAS s16x8*)(Qh + t * HG_LDQ + 16 * ks + 8 * hh);
        acc = __builtin_amdgcn_mfma_f32_32x32x16_bf16(a, bb, acc, 0, 0, 0); }
    { float ss = 0.f;
#pragma unroll
      for (int r = 0; r < 16; ++r) ss += acc[r] * acc[r];
      ss += __shfl_xor(ss, 32);
      if (hh == 0) SS[t * 4 + vb] = ss; }
    __syncthreads();
    { const f32x4 s4 = *(const LAS f32x4*)(SS + t * 4); const float rstd = 1.0f / sqrtf(((s4.x + s4.y) + (s4.z + s4.w)) * (1.0f / HD) + EPS);
#pragma unroll
      for (int q = 0; q < 4; ++q) { const int v0 = 32 * vb + 8 * q + 4 * hh; const f32x4 gn = *(const GAS f32x4*)(F.in[17] + v0);
          v2u w; w.x = pk2(acc[4 * q] * rstd * gn.x * siluf_(bflo(og[q].x)), acc[4 * q + 1] * rstd * gn.y * siluf_(bfhi(og[q].x)));
          w.y = pk2(acc[4 * q + 2] * rstd * gn.z * siluf_(bflo(og[q].y)), acc[4 * q + 3] * rstd * gn.w * siluf_(bfhi(og[q].y)));
          *(v2u*)(MIX + (size_t)(tok0 + t) * DM + 512 + h * HD + v0) = w; } }
    __syncthreads();
}
constexpr int LX_Q = 0, LX_K2 = 4096, LX_K3 = 8192, LX_V = 12288, LX_DEC = 16384, LX_ATT = 16896, LX_OP = 17152, LX_OT = 33536;
__device__ __forceinline__ void hgrn_sample_item(Frame& F, int idx) {
    const int tid = F.tid, b = idx >> 2, h = idx & 3;
    LAS float* Qs = (LAS float*)(F.lds + LX_Q); LAS float* K2 = (LAS float*)(F.lds + LX_K2); LAS float* K3 = (LAS float*)(F.lds + LX_K3); LAS float* Vs = (LAS float*)(F.lds + LX_V);
    LAS float* DEC = (LAS float*)(F.lds + LX_DEC); LAS float* ATT = (LAS float*)(F.lds + LX_ATT); LAS float* OP = (LAS float*)(F.lds + LX_OP); LAS float* OT = (LAS float*)(F.lds + LX_OT);
    const bf16* PB = (const bf16*)(F.ws + WS_PB); const float* FZ = (const float*)(F.ws + WS_FZ); bf16* MIX = (bf16*)(F.ws + WS_MIX);
    const float* S0 = F.in[4] + (size_t)idx * HD * HD; float* Sout = F.out + O_SHG + (size_t)idx * HD * HD;
    const int tok0 = MP + b * SB_T;
    const int v = tid & 127, kq = tid >> 7;
    float s0[32];
#pragma unroll
    for (int j = 0; j < 32; ++j) s0[j] = S0[(size_t)(32 * kq + j) * HD + v];
    if (tid < 128) { const int col = h * HD + tid; const float lb = 1.0f / (1.0f + expf(F.in[5][512 + col] - F.in[5][col]));
        float gl[8], kk[8], qq[8]; float run = 0.f;
#pragma unroll
        for (int t = 0; t < 8; ++t) { const size_t tok = (size_t)(tok0 + t); const float fz = FZ[tok * 512 + col]; qq[t] = bf2f(PB[tok * PBW + 512 + col]);
            const float sg = 1.0f / (1.0f + __expf(-fz)), f = lb + (1.0f - lb) * sg; kk[t] = 1.0f - f; run += __log2f(f); gl[t] = run; }
#pragma unroll
        for (int t = 0; t < 8; ++t) { Qs[t * 128 + tid] = qq[t] * __builtin_amdgcn_exp2f(gl[t]); K2[t * 128 + tid] = kk[t] * __builtin_amdgcn_exp2f(-gl[t]); K3[t * 128 + tid] = kk[t] * __builtin_amdgcn_exp2f(run - gl[t]); }
        DEC[tid] = __builtin_amdgcn_exp2f(run);
    } else if (tid < 256) { const int vv = tid - 128;
#pragma unroll
        for (int t = 0; t < 8; ++t) Vs[t * 128 + vv] = bf2f(PB[(size_t)(tok0 + t) * PBW + 1024 + h * HD + vv]);
    }
    __syncthreads();
    { const int p = tid >> 3, part = tid & 7, t = p >> 3, s = p & 7; float a = 0.f;
#pragma unroll
      for (int j = 0; j < 16; ++j) a += Qs[t * 128 + part + 8 * j] * K2[s * 128 + part + 8 * j];
      a += __shfl_xor(a, 1); a += __shfl_xor(a, 2); a += __shfl_xor(a, 4);
      if (part == 0) ATT[p] = (s <= t) ? a : 0.f; }
    float vr[8], o[8];
#pragma unroll
    for (int t = 0; t < 8; ++t) { vr[t] = Vs[t * 128 + v]; o[t] = 0.f; }
#pragma unroll
    for (int j = 0; j < 32; ++j) { const int k = 32 * kq + j; const float sv = s0[j]; float sn = DEC[k] * sv;
#pragma unroll
        for (int t = 0; t < 8; ++t) { o[t] += Qs[t * 128 + k] * sv; sn += K3[t * 128 + k] * vr[t]; }
        Sout[(size_t)k * HD + v] = sn; }
#pragma unroll
    for (int t = 0; t < 8; ++t) OP[(kq * 8 + t) * 128 + v] = o[t];
    __syncthreads();
#pragma unroll
    for (int r = 0; r < 2; ++r) { const int e = tid + 512 * r, t = e >> 7, vv = e & 127;
        float acc = (OP[(0 * 8 + t) * 128 + vv] + OP[(1 * 8 + t) * 128 + vv]) + (OP[(2 * 8 + t) * 128 + vv] + OP[(3 * 8 + t) * 128 + vv]);
#pragma unroll
        for (int s = 0; s < 8; ++s) acc += ATT[t * 8 + s] * Vs[s * 128 + vv];
        OT[t * 128 + vv] = acc; }
    __syncthreads();
    { const int t = F.wave, lane = F.lane; const float o0 = OT[t * 128 + 2 * lane], o1 = OT[t * 128 + 2 * lane + 1];
      const float rstd = 1.0f / sqrtf(wave_sum(o0 * o0 + o1 * o1) * (1.0f / HD) + EPS);
      const unsigned gw2 = *(const unsigned*)(PB + (size_t)(tok0 + t) * PBW + 1536 + h * HD + 2 * lane);
      const float g0 = F.in[17][2 * lane], g1 = F.in[17][2 * lane + 1];
      *(unsigned*)(MIX + (size_t)(tok0 + t) * DM + 512 + h * HD + 2 * lane) = pk2(o0 * rstd * g0 * siluf_(bflo(gw2)), o1 * rstd * g1 * siluf_(bfhi(gw2))); }
    __syncthreads();
}
__device__ __forceinline__ void final_norm_row(Frame& F, int m) {
    GAS f32x4* xr = (GAS f32x4*)(F.out + O_Y + (size_t)m * DM) + F.lane;
    f32x4 v[4]; float s = 0.f;
#pragma unroll
    for (int j = 0; j < 4; ++j) { v[j] = xr[64 * j]; s += (v[j].x * v[j].x + v[j].y * v[j].y) + (v[j].z * v[j].z + v[j].w * v[j].w); }
    const float rstd = 1.0f / sqrtf(wave_sum(s) * (1.0f / DM) + EPS);
#pragma unroll
    for (int j = 0; j < 4; ++j) { const f32x4 g = ((const GAS f32x4*)F.in[23])[F.lane + 64 * j]; f32x4 o; o.x = v[j].x * rstd * g.x; o.y = v[j].y * rstd * g.y; o.z = v[j].z * rstd * g.z; o.w = v[j].w * rstd * g.w; xr[64 * j] = o; }
}

typedef GAS unsigned gu32;
#define RLX_AGENT __ATOMIC_RELAXED, __HIP_MEMORY_SCOPE_AGENT
constexpr int MISC_OFF = LDS_BYTES - 512;
constexpr int CW_QUEUE = 8192;
constexpr int CW_BAR = 4096;
constexpr size_t CTL_ZERO_BYTES = 65536;
#define XB_TMO      128
#define XB_XCNT(j)  (256  + 64 * (j))
#define XB_XSUB(j)  (1280 + 64 * (j))
#define XB_XGEN(j)  (2304 + 64 * (j))
#define XB_TOP      3328
#define XB_TOPGEN   3392
#define XCD_BAR_WORDS 3456
#define XB_SPIN_CAP (1u << 18)

__device__ __forceinline__ unsigned xb_ld(unsigned* p)              { return __hip_atomic_load(p, __ATOMIC_RELAXED, __HIP_MEMORY_SCOPE_AGENT); }
__device__ __forceinline__ unsigned xb_add(unsigned* p, unsigned v) { return __hip_atomic_fetch_add(p, v, __ATOMIC_RELAXED, __HIP_MEMORY_SCOPE_AGENT); }
__device__ __forceinline__ unsigned xb_xcc_id() { return (unsigned)__builtin_amdgcn_s_getreg((3 << 11) | 20) & 0xFu; }
#define XB_SPIN(cond, bar) do { unsigned _sp = 0; while (cond) { __builtin_amdgcn_s_sleep(1); \
    if ((++_sp & 255u) == 0u) { if (xb_ld(&(bar)[XB_TMO])) break; if (_sp > XB_SPIN_CAP) { atomicAdd(&(bar)[XB_TMO], 1u); break; } } } } while (0)

struct XcdBarrier {
    unsigned* bar; unsigned x;
    volatile LAS unsigned* st;
};

__device__ __forceinline__ XcdBarrier xcd_barrier_post(unsigned* bar, volatile LAS unsigned* st) {
    XcdBarrier b; b.bar = bar; b.x = xb_xcc_id(); b.st = st;
    if (threadIdx.x == 0) (void)xb_add(&bar[XB_XCNT(b.x)], 1u);
    return b;
}
__device__ __forceinline__ void xcd_barrier_complete(unsigned* bar, unsigned x, unsigned& nloc, unsigned& nx) {
    const unsigned G = gridDim.x * gridDim.y * gridDim.z;
    unsigned sum, cnt, mine, sp = 0u;
    for (;;) {
        sum = 0u; cnt = 0u; mine = 0u;
#pragma unroll
        for (unsigned j = 0; j < 16; ++j) { const unsigned c = xb_ld(&bar[XB_XCNT(j)]); sum += c; cnt += (c > 0u) ? 1u : 0u; mine = (j == x) ? c : mine; }
        if (sum == G) break;
        __builtin_amdgcn_s_sleep(1);
        if ((++sp & 255u) == 0u) { if (xb_ld(&bar[XB_TMO])) break; if (sp > XB_SPIN_CAP) { atomicAdd(&bar[XB_TMO], 1u); break; } }
    }
    nloc = mine > 0u ? mine : 1u; nx = cnt > 0u ? cnt : 1u;
}

__device__ __forceinline__ void xcd_barrier(const XcdBarrier& b) {
    asm volatile("s_waitcnt vmcnt(0)" ::: "memory");
    __syncthreads();
    if (threadIdx.x == 0) {
        unsigned* bar = b.bar;
        __builtin_amdgcn_s_waitcnt(0);
        unsigned nloc = b.st[0], nx = b.st[1];
        if (nloc == 0u) { xcd_barrier_complete(bar, b.x, nloc, nx); b.st[0] = nloc; b.st[1] = nx; }
        const unsigned old = xb_add(&bar[XB_XSUB(b.x)], 1u);
        const unsigned gen = old / nloc;
        if (old + 1u == (gen + 1u) * nloc) {
            __builtin_amdgcn_fence(__ATOMIC_RELEASE, "agent");
            asm volatile("s_waitcnt vmcnt(0)" ::: "memory");
            const unsigned og = xb_add(&bar[XB_TOP], 1u);
            const unsigned tg = og / nx;
            if (og + 1u == (tg + 1u) * nx) xb_add(&bar[XB_TOPGEN], 1u);
            else XB_SPIN(xb_ld(&bar[XB_TOPGEN]) == tg, bar);
            __builtin_amdgcn_fence(__ATOMIC_ACQUIRE, "agent");
            xb_add(&bar[XB_XGEN(b.x)], 1u);
            asm volatile("s_waitcnt vmcnt(0)" ::: "memory");
        } else {
            XB_SPIN(xb_ld(&bar[XB_XGEN(b.x)]) == gen, bar);
            __builtin_amdgcn_fence(__ATOMIC_ACQUIRE, "agent");
            asm volatile("s_waitcnt vmcnt(0)" ::: "memory");
        }
    }
    __syncthreads();
}

__global__ void __launch_bounds__(NWAVES * 64, 2) mk_fwd(Args args) {
    extern __shared__ __attribute__((aligned(16))) unsigned char lds[];
    Frame F;
    F.lds = (LAS unsigned char*)lds;
    F.tid = threadIdx.x; F.lane = F.tid & 63; F.wave = __builtin_amdgcn_readfirstlane(F.tid >> 6);
    F.G = gridDim.x; F.bid = blockIdx.x;
#pragma unroll
    for (int i = 0; i < 24; ++i) F.in[i] = args.in[i];
    F.out = args.out; F.ws = args.ws;
    const int lo = args.ph_lo, hi = args.ph_hi;
#define IN(k) (lo <= (k) && (k) < hi)
#if MK_N_LAUNCHES == 1
    volatile LAS unsigned* MISC = (volatile LAS unsigned*)(F.lds + MISC_OFF);
    if (F.tid < 32) MISC[F.tid] = 0u;
    __syncthreads();
    XcdBarrier bar = xcd_barrier_post((unsigned*)(F.ws + WS_CTL) + CW_BAR, MISC + 8);
#define SEAM(k) do { if (IN(k) && IN((k) + 1)) xcd_barrier(bar); } while (0)
#else
#define SEAM(k) do { } while (0)
#endif
    const int gw = F.bid * NWAVES + F.wave, NGW = F.G * NWAVES;
    bf16* XN = (bf16*)(F.ws + WS_XN); bf16* PB = (bf16*)(F.ws + WS_PB); float* FZ = (float*)(F.ws + WS_FZ); bf16* GY = (bf16*)(F.ws + WS_GY);
    bf16* MIX = (bf16*)(F.ws + WS_MIX); bf16* ACT = (bf16*)(F.ws + WS_ACT);

    if (IN(0)) { p0_prologue(F); } SEAM(0);
    if (IN(1)) {
        pg8::Gemm g{XN, (const bf16*)(F.ws + WS_WIN), MTOK, INC, DM}; pg8::StaticOrder S; S.init(MTOK, INC, F.G, F.bid);
        EpiIn E{PB, FZ};
        pg8::gemm_phase<EpiIn, pg8::StaticOrder, true, true>(F.lds, g, S, E);
    } SEAM(1);
    if (IN(2)) {
        for (int it = F.bid; it < 256; it += F.G) { s5_fast_item<0>(F, it); __syncthreads(); }
        for (int it = F.bid; it < 1024; it += F.G) hgA_item(F, it);
        for (int it = F.bid; it < SB_B * HH; it += F.G) hgrn_sample_item(F, it);
    } SEAM(2);
    if (IN(3)) { hg_scan(F); } SEAM(3);
    if (IN(4)) {
        pg8::Gemm g{GY, (const bf16*)(F.ws + WS_WGLU), MTOK, S5W, S5W}; pg8::StaticOrder S; S.init(MTOK, S5W, F.G, F.bid);
        EpiGlu E{GY, MIX};
        pg8::gemm_phase<EpiGlu, pg8::StaticOrder, true, true>(F.lds, g, S, E);
        __syncthreads();
        gu32* ctr = (gu32*)(F.ws + WS_CTL) + CW_QUEUE; volatile LAS int* slot = (volatile LAS int*)(F.lds + MISC_OFF + 64);
        for (;;) { if (F.tid == 0) *slot = (int)__hip_atomic_fetch_add(ctr, 1u, RLX_AGENT); __syncthreads(); const int it = *slot; if (it >= 1024) break; hgC_item(F, it); }
    } SEAM(4);
    if (IN(5)) {
        pg8::Gemm g{MIX, (const bf16*)(F.ws + WS_WOUT), MTOK, DM, DM}; pg8::StaticOrder S; S.init(MTOK, DM, F.G, F.bid);
        EpiOut E{F.in[0], F.in[1], F.out + O_Y};
        pg8::gemm_phase<EpiOut, pg8::StaticOrder, true, true>(F.lds, g, S, E);
    } SEAM(5);
    if (IN(6)) {
        for (int m = gw; m < MTOK; m += NGW) rms_row_bf16(F.out + O_Y + (size_t)m * DM, F.in[19], XN + (size_t)m * DM, F.lane);
    } SEAM(6);
    if (IN(7)) {
        pg8::Gemm g{XN, (const bf16*)(F.ws + WS_WGU), MTOK, 2 * DFF, DM}; pg8::StaticOrder S; S.init(MTOK, 2 * DFF, F.G, F.bid);
        EpiAct E{ACT};
        pg8::gemm_phase<EpiAct, pg8::StaticOrder, true, true>(F.lds, g, S, E);
    } SEAM(7);
    if (IN(8)) {
        pg8::Gemm g{ACT, (const bf16*)(F.ws + WS_WD), MTOK, DM, DFF}; pg8::StaticOrder S; S.init(MTOK, DM, F.G, F.bid);
        EpiDown E{F.out + O_Y};
        pg8::gemm_phase<EpiDown, pg8::StaticOrder, true, true>(F.lds, g, S, E);
    } SEAM(8);
    if (IN(9)) {
        for (int m = gw; m < MTOK; m += NGW) final_norm_row(F, m);
    }
#undef IN
#undef SEAM
}

extern "C" void kernel_launch(void* const* d_in, const int* in_sizes, int n_in, void* d_out, int out_size, void* d_ws, size_t ws_size, hipStream_t stream) {
    static int grid = 0;
    if (grid == 0) {
        if (n_in != 24 || ws_size < WS_END) { fprintf(stderr, "kernel_launch: unexpected n_in %d / ws %zu\n", n_in, ws_size); grid = -1; return; }
        int dev = 0, cus = 0, per_cu = 0;
        if (hipGetDevice(&dev) != hipSuccess || hipDeviceGetAttribute(&cus, hipDeviceAttributeMultiprocessorCount, dev) != hipSuccess) { grid = -1; return; }
        if (hipFuncSetAttribute((const void*)mk_fwd, hipFuncAttributeMaxDynamicSharedMemorySize, LDS_BYTES) != hipSuccess) { fprintf(stderr, "kernel_launch: hipFuncSetAttribute failed\n"); grid = -1; return; }
        if (hipOccupancyMaxActiveBlocksPerMultiprocessor(&per_cu, (const void*)mk_fwd, NWAVES * 64, LDS_BYTES) != hipSuccess || per_cu < 1) { fprintf(stderr, "kernel_launch: occupancy query says %d\n", per_cu); per_cu = 1; }
        (void)hipGetLastError();
        grid = cus;
    }
    if (grid < 0) return;
    if (hipMemsetAsync((char*)d_ws + WS_CTL, 0, CTL_ZERO_BYTES, stream) != hipSuccess) { fprintf(stderr, "kernel_launch: memset failed\n"); return; }
    Args a{};
    for (int i = 0; i < 24; ++i) a.in[i] = (const float*)d_in[i];
    a.out = (float*)d_out; a.ws = (unsigned char*)d_ws;
#if MK_N_LAUNCHES == 1
    a.ph_lo = 0; a.ph_hi = NPH;
    void* kargs[] = {&a};
    hipError_t e = hipLaunchCooperativeKernel((const void*)mk_fwd, dim3(grid), dim3(NWAVES * 64), kargs, LDS_BYTES, stream);
    if (e != hipSuccess) fprintf(stderr, "kernel_launch: cooperative launch failed: %s (grid %d)\n", hipGetErrorString(e), grid);
#else
    for (int p = 0; p < NPH; ++p) { a.ph_lo = p; a.ph_hi = p + 1; hipLaunchKernelGGL(mk_fwd, dim3(grid), dim3(NWAVES * 64), LDS_BYTES, stream, a); }
#endif
}
```

```cpp
#include <hip/hip_runtime.h>
#include <hip/hip_cooperative_groups.h>
#include <cstdio>
#include <cstdint>
namespace cg = cooperative_groups;
#define MK_N_LAUNCHES 1
namespace pg8 {
#define PG8_LAS __attribute__((address_space(3)))
typedef unsigned short bf16_t;
typedef short bf16x8 __attribute__((ext_vector_type(8)));
typedef float f32x4 __attribute__((ext_vector_type(4)));
typedef unsigned u32x4 __attribute__((ext_vector_type(4)));
constexpr int BM = 256, BK = 64, HALF = 128, HTB = HALF * BK * 2  , STAGE_BYTES = 8 * HTB, NXCD = 8, WGM = 8;

__host__ __device__ __forceinline__ int lds_byte(int r, int c) { const int st = (r >> 4) * 2 + (c >> 5), rr = r & 15, cc = c & 31, ob = rr * 64 + cc * 2; return st * 1024 + (ob ^ (((ob >> 9) & 1) << 5)); }
__host__ __device__ __forceinline__ void stage_rc(int b, int& R, int& C) { const int st = b / 1024, sb = b % 1024, swz = sb ^ (((sb >> 9) & 1) << 5); R = (st >> 1) * 16 + swz / 64; C = (st & 1) * 32 + (swz % 64) / 2; }
__host__ __device__ __forceinline__ int perm32(int rho) { const int n = rho >> 4, i = rho & 15; return 8 * (i >> 2) + 4 * n + (i & 3); }

struct Unit { int pm, pn; };
struct Gemm { const bf16_t* A; const bf16_t* Bt; int M, N, K; };

struct StaticOrder {
    int nM, nN, nwg, G, c;
    __host__ __device__ void init(int M, int N, int G_, int c_) { nM = M / BM; nN = N / BM; nwg = nM * nN; G = G_; c = c_; }
    __host__ __device__ bool next(int i, Unit& u) const {
        const long L = (long)i * G + c; if (L >= nwg) return false;
        int wgid = (int)L; { const int q = nwg / NXCD, r = nwg % NXCD, xcd = wgid % NXCD, off = wgid / NXCD; wgid = (xcd < r ? xcd * (q + 1) : r * (q + 1) + (xcd - r) * q) + off; }
        const int nig = WGM * nN, gid = wgid / nig, fm = gid * WGM, gsz = (nM - fm) < WGM ? (nM - fm) : WGM;
        u.pm = fm + ((wgid % nig) % gsz); u.pn = (wgid % nig) / gsz; return true;
    }
    __device__ __forceinline__ void a_ready(const Unit&) const {}
    __device__ __forceinline__ void done(const Unit&) const {}
};

__device__ __forceinline__ unsigned cvt_pk_bf16(float lo, float hi) { unsigned r; asm volatile("v_cvt_pk_bf16_f32 %0, %1, %2" : "=v"(r) : "v"(lo), "v"(hi)); return r; }
template <class Epi, class Sched, bool ALIGN_EPI = false, bool SP2 = false, bool AGM = false  >
__device__ __forceinline__ void gemm_phase(PG8_LAS unsigned char* lds, const Gemm g, const Sched& S, const Epi& E) {
    const int tid = threadIdx.x, wid = __builtin_amdgcn_readfirstlane(tid >> 6), lane = tid & 63, wr = wid >> 2, wc = wid & 3, fr = lane & 15, fq = lane >> 4;
    const int K = g.K, nt = K / BK;
    unsigned voffA[2], voffB[2];
#pragma unroll
    for (int i = 0; i < 2; ++i) { int R, C; stage_rc(tid * 16 + i * 8192, R, C); const int Rb = Epi::PERM ? ((R & ~31) + perm32(R & 31)) : R;
        voffA[i] = AGM ? (unsigned)((((C >> 4) * g.M + R) * 16 + (C & 15)) * 2) : (unsigned)(R * K + C) * 2u; voffB[i] = (unsigned)(Rb * K + C) * 2u; }
    const size_t kstep = (size_t)(BK * 2);
    const size_t hstep = (size_t)HALF * K * 2;
    const size_t tstep = 2 * hstep;
    const size_t kstepA = AGM ? (size_t)4 * g.M * 32 : kstep, hstepA = AGM ? (size_t)HALF * 32 : hstep, tstepA = 2 * hstepA;
    const unsigned ldsw = (unsigned)wid * 1024u;
    const int aoff = lds_byte(wr * 64 + fr, fq * 8), boff = lds_byte(wc * 32 + fr, fq * 8);
#define PG8_SA(b, h) (((b) * 2 + (h)) * HTB)
#define PG8_SB(b, h) ((4 + (b) * 2 + (h)) * HTB)
#define PG8_STAGE(bufoff, gbase, voff) do { _Pragma("unroll") for (int _i = 0; _i < 2; ++_i) \
        __builtin_amdgcn_global_load_lds((const unsigned*)((const char*)(gbase) + (voff)[_i]), (PG8_LAS unsigned*)(lds + (bufoff) + ldsw + _i * 8192), 16, 0, 0); } while (0)
#define PG8_LDA(dst, b, h) do { _Pragma("unroll") for (int m = 0; m < 4; ++m) _Pragma("unroll") for (int k = 0; k < 2; ++k) dst[m][k] = *(const PG8_LAS bf16x8*)(lds + PG8_SA(b, h) + aoff + m * 2048 + k * 1024); } while (0)
#define PG8_LDB(dst, b, h) do { _Pragma("unroll") for (int n = 0; n < 2; ++n) _Pragma("unroll") for (int k = 0; k < 2; ++k) dst[n][k] = *(const PG8_LAS bf16x8*)(lds + PG8_SB(b, h) + boff + n * 2048 + k * 1024); } while (0)
#define PG8_MMA(ai, bj, At, Bt) do { __builtin_amdgcn_s_setprio(1); _Pragma("unroll") for (int m = 0; m < 4; ++m) _Pragma("unroll") for (int n = 0; n < 2; ++n) _Pragma("unroll") for (int k = 0; k < 2; ++k) \
        acc[ai][bj][m][n] = __builtin_amdgcn_mfma_f32_16x16x32_bf16(Bt[n][k], At[m][k], acc[ai][bj][m][n], 0, 0, 0); __builtin_amdgcn_s_setprio(0); } while (0)
#define PG8_WAIT_V(n) asm volatile("s_waitcnt vmcnt(" #n ")" ::: "memory")
#define PG8_WAIT_L(n) asm volatile("s_waitcnt lgkmcnt(" #n ")" ::: "memory")
#define PG8_BAR __builtin_amdgcn_s_barrier()
#define PG8_SCHED __builtin_amdgcn_sched_barrier(0)
    Unit cur, nxt; int ui = 0;
    if (!S.next(0, cur)) return;
    f32x4 acc[2][2][4][2];
#pragma unroll
    for (int a = 0; a < 2; ++a)
#pragma unroll
        for (int b = 0; b < 2; ++b)
#pragma unroll
            for (int m = 0; m < 4; ++m)
#pragma unroll
                for (int n = 0; n < 2; ++n) acc[a][b][m][n] = (f32x4){0.f, 0.f, 0.f, 0.f};
    bf16x8 At[4][2], B0[2][2], B1[2][2];
    const char* cA = (const char*)g.A + (size_t)cur.pm * tstepA; const char* cB = (const char*)g.Bt + (size_t)cur.pn * tstep;
    S.a_ready(cur);
    if constexpr (SP2) {
        PG8_STAGE(PG8_SB(0, 0), cB, voffB); PG8_STAGE(PG8_SB(0, 1), cB + hstep, voffB); PG8_STAGE(PG8_SA(0, 0), cA, voffA); PG8_STAGE(PG8_SA(0, 1), cA + hstepA, voffA);
        if (wr == 1) PG8_BAR;
        PG8_WAIT_V(2); PG8_BAR;
        PG8_STAGE(PG8_SB(1, 0), cB + kstep, voffB); PG8_STAGE(PG8_SA(1, 0), cA + kstepA, voffA); PG8_STAGE(PG8_SB(1, 1), cB + hstep + kstep, voffB);
        PG8_WAIT_V(6); PG8_BAR;
    } else {
        PG8_STAGE(PG8_SB(0, 0), cB, voffB); PG8_STAGE(PG8_SA(0, 0), cA, voffA); PG8_STAGE(PG8_SB(0, 1), cB + hstep, voffB); PG8_STAGE(PG8_SA(0, 1), cA + hstepA, voffA);
        if (wr == 1) PG8_BAR;
        PG8_WAIT_V(4); PG8_BAR;
        PG8_STAGE(PG8_SB(1, 0), cB + kstep, voffB); PG8_STAGE(PG8_SA(1, 0), cA + kstepA, voffA); PG8_STAGE(PG8_SB(1, 1), cB + hstep + kstep, voffB);
        PG8_WAIT_V(6); PG8_BAR;
    }
    for (;;) {
        const bool has_next = S.next(ui + 1, nxt);
        const char* nA = has_next ? (const char*)g.A + (size_t)nxt.pm * tstepA : cA; const char* nB = has_next ? (const char*)g.Bt + (size_t)nxt.pn * tstep : cB;
        for (int t = 0; t < nt; t += 2) {
            const bool last = (t == nt - 2);
            const char* a1 = cA + (size_t)(t + 1) * kstepA;
            const char* a2 = last ? nA : cA + (size_t)(t + 2) * kstepA; const char* b2 = last ? nB : cB + (size_t)(t + 2) * kstep;
            const char* a3 = a2 + kstepA; const char* b3 = b2 + kstep;
            if (last && has_next) S.a_ready(nxt);
            if constexpr (SP2) {
            PG8_LDB(B0, 0, 0); PG8_LDB(B1, 0, 1); PG8_SCHED; PG8_LDA(At, 0, 0); PG8_STAGE(PG8_SA(1, 1), a1 + hstepA, voffA);
            PG8_WAIT_V(8); PG8_WAIT_L(0); PG8_BAR; PG8_MMA(0, 0, At, B0); PG8_MMA(0, 1, At, B1); PG8_BAR; PG8_SCHED;
            PG8_LDA(At, 0, 1); PG8_STAGE(PG8_SB(0, 0), b2, voffB); PG8_STAGE(PG8_SB(0, 1), b2 + hstep, voffB); PG8_STAGE(PG8_SA(0, 0), a2, voffA);
            PG8_WAIT_V(8); PG8_WAIT_L(0); PG8_BAR; PG8_MMA(1, 0, At, B0); PG8_MMA(1, 1, At, B1); PG8_BAR; PG8_SCHED;
            PG8_LDB(B0, 1, 0); PG8_LDB(B1, 1, 1); PG8_SCHED; PG8_LDA(At, 1, 0); PG8_STAGE(PG8_SA(0, 1), a2 + hstepA, voffA);
            PG8_WAIT_V(8); PG8_WAIT_L(0); PG8_BAR; PG8_MMA(0, 0, At, B0); PG8_MMA(0, 1, At, B1); PG8_BAR; PG8_SCHED;
            PG8_LDA(At, 1, 1); PG8_STAGE(PG8_SB(1, 0), b3, voffB); PG8_STAGE(PG8_SB(1, 1), b3 + hstep, voffB); PG8_STAGE(PG8_SA(1, 0), a3, voffA);
            PG8_WAIT_V(8); PG8_WAIT_L(0); PG8_BAR; PG8_MMA(1, 0, At, B0); PG8_MMA(1, 1, At, B1); PG8_BAR; PG8_SCHED;
            } else {
            PG8_LDB(B0, 0, 0); PG8_SCHED; PG8_LDA(At, 0, 0); PG8_STAGE(PG8_SA(1, 1), a1 + hstepA, voffA);
            PG8_WAIT_L(8); PG8_BAR; PG8_WAIT_L(0); PG8_MMA(0, 0, At, B0); PG8_BAR; PG8_SCHED;
            PG8_LDB(B1, 0, 1); PG8_STAGE(PG8_SB(0, 0), b2, voffB);
            PG8_BAR; PG8_WAIT_L(0); PG8_MMA(0, 1, At, B1); PG8_BAR;
            PG8_LDA(At, 0, 1); PG8_STAGE(PG8_SA(0, 0), a2, voffA);
            PG8_BAR; PG8_WAIT_L(0); PG8_MMA(1, 0, At, B0); PG8_BAR; PG8_SCHED;
            PG8_STAGE(PG8_SB(0, 1), b2 + hstep, voffB);
            PG8_WAIT_V(6); PG8_BAR; PG8_MMA(1, 1, At, B1); PG8_BAR;
            PG8_LDB(B0, 1, 0); PG8_SCHED; PG8_LDA(At, 1, 0); PG8_STAGE(PG8_SA(0, 1), a2 + hstepA, voffA);
            PG8_WAIT_L(8); PG8_BAR; PG8_WAIT_L(0); PG8_MMA(0, 0, At, B0); PG8_BAR; PG8_SCHED;
            PG8_LDB(B1, 1, 1); PG8_STAGE(PG8_SB(1, 0), b3, voffB);
            PG8_BAR; PG8_WAIT_L(0); PG8_MMA(0, 1, At, B1); PG8_BAR;
            PG8_LDA(At, 1, 1); PG8_STAGE(PG8_SA(1, 0), a3, voffA);
            PG8_BAR; PG8_WAIT_L(0); PG8_MMA(1, 0, At, B0); PG8_BAR; PG8_SCHED;
            PG8_STAGE(PG8_SB(1, 1), b3 + hstep, voffB);
            PG8_WAIT_V(6); PG8_BAR; PG8_MMA(1, 1, At, B1); PG8_BAR;
            }
        }
        if constexpr (ALIGN_EPI) { if (wr == 0) PG8_BAR; }
        if constexpr (!Epi::AFTER_DRAIN) { E(acc, cur, wr, wc, fr, fq); S.done(cur); }
        if (!has_next) break;
#pragma unroll
        for (int a = 0; a < 2; ++a)
#pragma unroll
            for (int b = 0; b < 2; ++b)
#pragma unroll
                for (int m = 0; m < 4; ++m)
#pragma unroll
                    for (int n = 0; n < 2; ++n) acc[a][b][m][n] = (f32x4){0.f, 0.f, 0.f, 0.f};
        cur = nxt; cA = nA; cB = nB; ++ui;
        if constexpr (ALIGN_EPI) { if (wr == 1) PG8_BAR; }
    }
    PG8_WAIT_V(0);
    if constexpr (!ALIGN_EPI) { if (wr == 0) PG8_BAR; }
    PG8_BAR;
    if constexpr (Epi::AFTER_DRAIN) { E.fused(acc, cur, wr, wc, fr, fq, lds, wid, lane); S.done(cur); }
#undef PG8_SA
#undef PG8_SB
#undef PG8_STAGE
#undef PG8_LDA
#undef PG8_LDB
#undef PG8_MMA
#undef PG8_WAIT_V
#undef PG8_WAIT_L
#undef PG8_BAR
#undef PG8_SCHED
}
}

#ifndef S5_SIMPLE
#define S5_SIMPLE 0
#endif
#ifndef HG_SIMPLE
#define HG_SIMPLE 0
#endif
#ifndef REP0
#define REP0 1
#define REP1 1
#define REP2 1
#define REP3 1
#define REP4 1
#define REP6 1
#endif
#ifndef MK_N_LAUNCHES
#define MK_N_LAUNCHES 1
#endif
constexpr int DM = 1024, PB_B = 8, PB_T = 2048, SB_B = 128, SB_T = 8;
constexpr int MP = PB_B * PB_T, MS = SB_B * SB_T, MTOK = MP + MS;
constexpr int S5W = 512, S5G = 32, S5C = 16, S5N = 64;
constexpr int HGW = 512, HD = 128, HH = 4;
constexpr int INC = 2560, DFF = 2816;
constexpr float EPS = 1e-6f;
constexpr int NPH = 10;
constexpr size_t O_Y = 0, O_PRE = (size_t)MTOK * DM, O_PIM = O_PRE + 16384, O_PHG = O_PIM + 16384, O_SRE = O_PHG + 524288, O_SIM = O_SRE + 262144, O_SHG = O_SIM + 262144;
constexpr size_t MiB = 1u << 20;
constexpr size_t WS_CTL = 0, WS_WIN = 2 * MiB, WS_WGLU = 7 * MiB, WS_WOUT = 8 * MiB, WS_WGU = 10 * MiB, WS_WD = 21 * MiB;
constexpr size_t WS_XN = 27 * MiB, WS_PB = 61 * MiB, WS_FZ = 129 * MiB, WS_ACT = 61 * MiB, WS_GY = 163 * MiB, WS_OH = 180 * MiB, WS_MIX = 197 * MiB, WS_END = 234 * MiB;
constexpr int PBW = 2048;
constexpr int LDS_BYTES = 147456;
constexpr int NWAVES = 8;

#define GAS __attribute__((address_space(1)))
#define LAS __attribute__((address_space(3)))
typedef unsigned short bf16;
typedef unsigned v4u __attribute__((ext_vector_type(4)));
typedef unsigned v2u __attribute__((ext_vector_type(2)));
typedef float f32x4 __attribute__((ext_vector_type(4)));
#define LDS_WAIT() asm volatile("s_waitcnt lgkmcnt(0)" ::: "memory")
__device__ __forceinline__ unsigned f2bf(float f) { unsigned u = __builtin_bit_cast(unsigned, f); return (u + 0x7fffu + ((u >> 16) & 1u)) >> 16; }
__device__ __forceinline__ unsigned pk2(float lo, float hi) { return f2bf(lo) | (f2bf(hi) << 16); }
__device__ __forceinline__ float bf2f(unsigned short h) { return __builtin_bit_cast(float, (unsigned)h << 16); }
__device__ __forceinline__ float bflo(unsigned w) { return __builtin_bit_cast(float, w << 16); }
__device__ __forceinline__ float bfhi(unsigned w) { return __builtin_bit_cast(float, w & 0xffff0000u); }
__device__ __forceinline__ float sigmoidf_(float x) { return 1.0f / (1.0f + __expf(-x)); }
__device__ __forceinline__ float siluf_(float x) { return x / (1.0f + __expf(-x)); }
__device__ __forceinline__ float gelu_tanh(float x) { const float z = 1.5957691216057308f * (x + 0.044715f * x * x * x); return x / (1.0f + __expf(-z)); }
__device__ __forceinline__ float wave_sum(float v) {
#pragma unroll
    for (int o = 1; o < 64; o <<= 1) v += __shfl_xor(v, o);
    return v;
}

struct Args { const float* in[24]; float* out; unsigned char* ws; int ph_lo, ph_hi; };

struct Frame {
    LAS unsigned char* lds;
    int tid, lane, wave, G, bid;
    const float* in[24];
    float* out; unsigned char* ws;
};
__device__ __forceinline__ const float* xrow(const Frame& F, int m) { return m < MP ? F.in[0] + (size_t)m * DM : F.in[1] + (size_t)(m - MP) * DM; }

__device__ __forceinline__ void transpose_item(const float* W, int ldw, bf16* WT, int K, int k0, int sn0, int dn0, LAS float* scr, int lane) {
#pragma unroll 8
    for (int i = 0; i < 32; ++i) { const int kk = 2 * i + (lane >> 5); scr[kk * 33 + (lane & 31)] = W[(size_t)(k0 + kk) * ldw + sn0 + (lane & 31)]; }
    LDS_WAIT(); asm volatile("" ::: "memory");
    const int c = lane & 7;
#pragma unroll
    for (int j = 0; j < 4; ++j) { const int n = (lane >> 3) + 8 * j; const LAS float* s = scr + (8 * c) * 33 + n;
        v4u o; o.x = pk2(s[0 * 33], s[1 * 33]); o.y = pk2(s[2 * 33], s[3 * 33]); o.z = pk2(s[4 * 33], s[5 * 33]); o.w = pk2(s[6 * 33], s[7 * 33]);
        *(GAS v4u*)(WT + (size_t)(dn0 + n) * K + k0 + 8 * c) = o; }
    LDS_WAIT(); asm volatile("" ::: "memory");
}
__device__ __forceinline__ void rms_row_bf16(const float* xr_, const float* gain, bf16* orow, int lane) {
    const GAS f32x4* xr = (const GAS f32x4*)xr_ + lane;
    f32x4 v[4]; float s = 0.f;
#pragma unroll
    for (int j = 0; j < 4; ++j) { v[j] = xr[64 * j]; s += (v[j].x * v[j].x + v[j].y * v[j].y) + (v[j].z * v[j].z + v[j].w * v[j].w); }
    const float rstd = 1.0f / sqrtf(wave_sum(s) * (1.0f / DM) + EPS);
    GAS v2u* o8 = (GAS v2u*)orow + lane;
#pragma unroll
    for (int j = 0; j < 4; ++j) { const f32x4 g = ((const GAS f32x4*)gain)[lane + 64 * j]; v2u w; w.x = pk2(v[j].x * rstd * g.x, v[j].y * rstd * g.y); w.y = pk2(v[j].z * rstd * g.z, v[j].w * rstd * g.w); o8[64 * j] = w; }
}

__device__ __forceinline__ void s5_tables_item(Frame& F, int item);
__device__ __forceinline__ void p0_prologue(Frame& F) {
    for (int it = F.bid; it < 256; it += F.G) s5_tables_item(F, it);
    LAS float* scr = (LAS float*)(F.lds + F.wave * 16384);
    const int gw = F.bid * NWAVES + F.wave, NGW = F.G * NWAVES;
    bf16* WinT = (bf16*)(F.ws + WS_WIN); bf16* WgluT = (bf16*)(F.ws + WS_WGLU); bf16* WoutT = (bf16*)(F.ws + WS_WOUT); bf16* WguT = (bf16*)(F.ws + WS_WGU); bf16* WdT = (bf16*)(F.ws + WS_WD);
    constexpr int I_IN = (DM / 64) * (INC / 32), I_GLU = (S5W / 64) * (S5W / 32), I_OUT = (DM / 64) * (DM / 32), I_G = (DM / 64) * (DFF / 32), I_D = (DFF / 64) * (DM / 32);
    constexpr int NITEMS = I_IN + I_GLU + I_OUT + 2 * I_G + I_D;
    for (int it = gw; it < NITEMS; it += NGW) {
        int r = it;
        if (r < I_IN) { const int nblk = INC / 32, kb = r / nblk, nb = r % nblk, sn0 = nb * 32; const int seg = sn0 / 512, off = sn0 % 512;
            const int dseg = seg == 0 ? 0 : seg == 1 ? 1 : seg == 2 ? 4 : seg == 3 ? 2 : 3;
            transpose_item(F.in[7], INC, WinT, DM, kb * 64, sn0, dseg * 512 + off, scr, F.lane); continue; } r -= I_IN;
        if (r < I_GLU) { const int nblk = S5W / 32, kb = r / nblk, nb = r % nblk; transpose_item(F.in[16], S5W, WgluT, S5W, kb * 64, nb * 32, nb * 32, scr, F.lane); continue; } r -= I_GLU;
        if (r < I_OUT) { const int nblk = DM / 32, kb = r / nblk, nb = r % nblk; transpose_item(F.in[18], DM, WoutT, DM, kb * 64, nb * 32, nb * 32, scr, F.lane); continue; } r -= I_OUT;
        if (r < I_G) { const int nblk = DFF / 32, kb = r / nblk, nb = r % nblk, sn0 = nb * 32; transpose_item(F.in[20], DFF, WguT, DM, kb * 64, sn0, 256 * (sn0 / 128) + (sn0 % 128), scr, F.lane); continue; } r -= I_G;
        if (r < I_G) { const int nblk = DFF / 32, kb = r / nblk, nb = r % nblk, sn0 = nb * 32; transpose_item(F.in[21], DFF, WguT, DM, kb * 64, sn0, 256 * (sn0 / 128) + 128 + (sn0 % 128), scr, F.lane); continue; } r -= I_G;
        { const int nblk = DM / 32, kb = r / nblk, nb = r % nblk; transpose_item(F.in[22], DM, WdT, DFF, kb * 64, nb * 32, nb * 32, scr, F.lane); }
    }
    bf16* XN = (bf16*)(F.ws + WS_XN);
    for (int m = gw; m < MTOK; m += NGW) rms_row_bf16(xrow(F, m), F.in[6], XN + (size_t)m * DM, F.lane);
}

using pg8::Unit; using pg8::u32x4; using pg8::cvt_pk_bf16; using pg8::BM; using pg8::HALF;
struct EpiIn {
    static constexpr bool PERM = true, AFTER_DRAIN = false;
    bf16* PB; float* FZ; bf16* U5;
    __device__ __forceinline__ void operator()(const pg8::f32x4 (&acc)[2][2][4][2], const Unit& u, int wr, int wc, int fr, int fq) const {
        const int row0 = u.pm * BM + wr * 64 + fr;
        if (u.pn < 2) { const int col0 = u.pn * BM + wc * 32 + 8 * fq;
#pragma unroll
            for (int ai = 0; ai < 2; ++ai)
#pragma unroll
                for (int m = 0; m < 4; ++m) { const size_t r = (size_t)(row0 + ai * HALF + m * 16);
#pragma unroll
                    for (int bj = 0; bj < 2; ++bj) { const int col = col0 + bj * HALF; const pg8::f32x4 v0 = acc[ai][bj][m][0], v1 = acc[ai][bj][m][1]; u32x4 w; w.x = cvt_pk_bf16(v0[0], v0[1]); w.y = cvt_pk_bf16(v0[2], v0[3]); w.z = cvt_pk_bf16(v1[0], v1[1]); w.w = cvt_pk_bf16(v1[2], v1[3]);
                        *(u32x4*)(U5 + ((size_t)(col >> 4) * MTOK + r) * 16 + (col & 15)) = w; } }
        } else if (u.pn < 8) { const int col0 = u.pn * BM + wc * 32 + 8 * fq;
#pragma unroll
            for (int ai = 0; ai < 2; ++ai)
#pragma unroll
                for (int m = 0; m < 4; ++m) { bf16* rowp = PB + (size_t)(row0 + ai * HALF + m * 16) * PBW + col0;
#pragma unroll
                    for (int bj = 0; bj < 2; ++bj) { const pg8::f32x4 v0 = acc[ai][bj][m][0], v1 = acc[ai][bj][m][1]; u32x4 w; w.x = cvt_pk_bf16(v0[0], v0[1]); w.y = cvt_pk_bf16(v0[2], v0[3]); w.z = cvt_pk_bf16(v1[0], v1[1]); w.w = cvt_pk_bf16(v1[2], v1[3]);
                        *(u32x4*)(rowp + bj * HALF) = w; } }
        } else { const int col0 = (u.pn - 8) * BM + wc * 32 + 8 * fq;
#pragma unroll
            for (int ai = 0; ai < 2; ++ai)
#pragma unroll
                for (int m = 0; m < 4; ++m) { float* rowp = FZ + (size_t)(row0 + ai * HALF + m * 16) * 512 + col0;
#pragma unroll
                    for (int bj = 0; bj < 2; ++bj)
#pragma unroll
                        for (int n = 0; n < 2; ++n) *(pg8::f32x4*)(rowp + bj * HALF + 4 * n) = acc[ai][bj][m][n]; }
        }
    }
};
struct EpiGlu {
    static constexpr bool PERM = true, AFTER_DRAIN = false;
    const bf16* GY; bf16* MIX;
    __device__ __forceinline__ void operator()(const pg8::f32x4 (&acc)[2][2][4][2], const Unit& u, int wr, int wc, int fr, int fq) const {
        const int row0 = u.pm * BM + wr * 64 + fr, col0 = u.pn * BM + wc * 32 + 8 * fq;
#pragma unroll
        for (int ai = 0; ai < 2; ++ai)
#pragma unroll
            for (int m = 0; m < 4; ++m) { const size_t r = (size_t)(row0 + ai * HALF + m * 16);
#pragma unroll
                for (int bj = 0; bj < 2; ++bj) { const int col = col0 + bj * HALF; const u32x4 g = *(const u32x4*)(GY + ((size_t)(col >> 4) * MTOK + r) * 16 + (col & 15)); const pg8::f32x4 v0 = acc[ai][bj][m][0], v1 = acc[ai][bj][m][1];
                    u32x4 w; w.x = cvt_pk_bf16(bflo(g.x) * sigmoidf_(v0[0]), bfhi(g.x) * sigmoidf_(v0[1])); w.y = cvt_pk_bf16(bflo(g.y) * sigmoidf_(v0[2]), bfhi(g.y) * sigmoidf_(v0[3]));
                    w.z = cvt_pk_bf16(bflo(g.z) * sigmoidf_(v1[0]), bfhi(g.z) * sigmoidf_(v1[1])); w.w = cvt_pk_bf16(bflo(g.w) * sigmoidf_(v1[2]), bfhi(g.w) * sigmoidf_(v1[3]));
                    *(u32x4*)(MIX + r * DM + col0 + bj * HALF) = w; } }
    }
};
struct EpiOut {
    static constexpr bool PERM = false, AFTER_DRAIN = false;
    const float* xp; const float* xs; float* Y;
    __device__ __forceinline__ void operator()(const pg8::f32x4 (&acc)[2][2][4][2], const Unit& u, int wr, int wc, int fr, int fq) const {
        const int row0 = u.pm * BM + wr * 64 + fr, col0 = u.pn * BM + wc * 32 + 4 * fq;
        const float* xb = (u.pm < MP / BM) ? xp : xs - (size_t)MP * DM;
#pragma unroll
        for (int ai = 0; ai < 2; ++ai)
#pragma unroll
            for (int m = 0; m < 4; ++m) { const size_t off = (size_t)(row0 + ai * HALF + m * 16) * DM + col0;
#pragma unroll
                for (int bj = 0; bj < 2; ++bj)
#pragma unroll
                    for (int n = 0; n < 2; ++n) { const pg8::f32x4 xv = *(const pg8::f32x4*)(xb + off + bj * HALF + n * 16); *(pg8::f32x4*)(Y + off + bj * HALF + n * 16) = xv + acc[ai][bj][m][n]; } }
    }
};
struct EpiAct {
    static constexpr bool PERM = true, AFTER_DRAIN = false;
    bf16* ACT;
    __device__ __forceinline__ void operator()(const pg8::f32x4 (&acc)[2][2][4][2], const Unit& u, int wr, int wc, int fr, int fq) const {
        const int row0 = u.pm * BM + wr * 64 + fr, col0 = u.pn * HALF + wc * 32 + 8 * fq;
#pragma unroll
        for (int ai = 0; ai < 2; ++ai)
#pragma unroll
            for (int m = 0; m < 4; ++m) { const pg8::f32x4 g0 = acc[ai][0][m][0], g1 = acc[ai][0][m][1], u0 = acc[ai][1][m][0], u1 = acc[ai][1][m][1];
                u32x4 w; w.x = cvt_pk_bf16(siluf_(g0[0]) * u0[0], siluf_(g0[1]) * u0[1]); w.y = cvt_pk_bf16(siluf_(g0[2]) * u0[2], siluf_(g0[3]) * u0[3]);
                w.z = cvt_pk_bf16(siluf_(g1[0]) * u1[0], siluf_(g1[1]) * u1[1]); w.w = cvt_pk_bf16(siluf_(g1[2]) * u1[2], siluf_(g1[3]) * u1[3]);
                *(u32x4*)(ACT + (size_t)(row0 + ai * HALF + m * 16) * DFF + col0) = w; }
    }
};
struct EpiDown {
    static constexpr bool PERM = false, AFTER_DRAIN = false;
    float* Y;
    __device__ __forceinline__ void operator()(const pg8::f32x4 (&acc)[2][2][4][2], const Unit& u, int wr, int wc, int fr, int fq) const {
        const int row0 = u.pm * BM + wr * 64 + fr, col0 = u.pn * BM + wc * 32 + 4 * fq;
#pragma unroll
        for (int ai = 0; ai < 2; ++ai)
#pragma unroll
            for (int m = 0; m < 4; ++m) { const size_t off = (size_t)(row0 + ai * HALF + m * 16) * DM + col0;
#pragma unroll
                for (int bj = 0; bj < 2; ++bj)
#pragma unroll
                    for (int n = 0; n < 2; ++n) { float* p = Y + off + bj * HALF + n * 16; const pg8::f32x4 xv = *(const pg8::f32x4*)p; *(pg8::f32x4*)p = xv + acc[ai][bj][m][n]; } }
    }
};

typedef float f32x16 __attribute__((ext_vector_type(16)));
typedef short s16x8 __attribute__((ext_vector_type(8)));
constexpr size_t WS_U5 = WS_OH, WS_T5 = 231 * MiB;
constexpr size_t T5_STRIDE = 73728, T5_VG = 32768, T5_KC = 65536;
constexpr int S5_LD = 136;
__device__ __forceinline__ void s5_tables_item(Frame& F, int item) {
    const int tid = F.tid, g = item >> 3, part = item & 7;
    LAS float* Pre = (LAS float*)F.lds; LAS float* Pim = Pre + 9 * 64; LAS float* Ff = Pim + 9 * 64;
    LAS float* Cre = Ff + 128, * Cim = Cre + 1024, * Bre = Cim + 1024, * Bim = Bre + 1024;
    if (tid < 64) { const int n = tid;
        const float a_re = F.in[8][g * S5N + n], a_im = F.in[9][g * S5N + n], dt = expf(F.in[10][g]);
        const float mag = expf(a_re * dt), ab_re = mag * cosf(a_im * dt), ab_im = mag * sinf(a_im * dt);
        const float den = a_re * a_re + a_im * a_im, nr = ab_re - 1.0f, ni = ab_im;
        Ff[n] = (nr * a_re + ni * a_im) / den; Ff[64 + n] = (ni * a_re - nr * a_im) / den;
        float pr = 1.f, pi = 0.f;
#pragma unroll
        for (int j = 0; j < 9; ++j) { Pre[j * 64 + n] = pr; Pim[j * 64 + n] = pi; const float t = pr * ab_re - pi * ab_im; pi = pr * ab_im + pi * ab_re; pr = t; }
    }
    __syncthreads();
#pragma unroll
    for (int i = 0; i < 2; ++i) { const int idx = tid + 512 * i;
        { const int c = idx >> 6, n = idx & 63; Cre[c * 64 + n] = F.in[13][(size_t)(g * 16 + c) * S5N + n]; Cim[c * 64 + n] = F.in[14][(size_t)(g * 16 + c) * S5N + n]; }
        { const int n = idx >> 4, c = idx & 15; const float br = F.in[11][(size_t)(g * S5N + n) * 16 + c], bi = F.in[12][(size_t)(g * S5N + n) * 16 + c], fr = Ff[n], fi = Ff[64 + n];
          Bre[n * 16 + c] = fr * br - fi * bi; Bim[n * 16 + c] = fr * bi + fi * br; } }
    __syncthreads();
    bf16* WG = (bf16*)(F.ws + WS_T5 + (size_t)g * T5_STRIDE); bf16* VG = (bf16*)(F.ws + WS_T5 + (size_t)g * T5_STRIDE + T5_VG); bf16* KC = (bf16*)(F.ws + WS_T5 + (size_t)g * T5_STRIDE + T5_KC);
    if (tid < 256) { const int j = part, c = tid >> 4, cp = tid & 15; float acc = 0.f;
#pragma unroll 4
        for (int n = 0; n < 64; ++n) { const float cr = Cre[c * 64 + n], ci = Cim[c * 64 + n], pr = Pre[j * 64 + n], pi = Pim[j * 64 + n];
            const float xr = cr * pr - ci * pi, xi = cr * pi + ci * pr; acc += xr * Bre[n * 16 + cp] - xi * Bim[n * 16 + cp]; }
        KC[j * 256 + tid] = (bf16)f2bf(acc);
    } else if (part == 0) KC[2048 + tid - 256] = 0;
#pragma unroll
    for (int i = 0; i < 4; ++i) { const int idx = tid + 512 * i, np = 16 * part + (idx >> 7), k = idx & 127, s = k >> 4, cp = k & 15, n = np & 63;
        const float pr = Pre[(7 - s) * 64 + n], pi = Pim[(7 - s) * 64 + n], br = Bre[n * 16 + cp], bi = Bim[n * 16 + cp];
        WG[np * 128 + k] = (bf16)f2bf(np < 64 ? pr * br - pi * bi : pr * bi + pi * br); }
#pragma unroll
    for (int i = 0; i < 4; ++i) { const int idx = tid + 512 * i, col = 16 * part + (idx >> 7), np = idx & 127, t = col >> 4, c = col & 15, n = np & 63;
        const float pr = Pre[(t + 1) * 64 + n], pi = Pim[(t + 1) * 64 + n], cr = Cre[c * 64 + n], ci = Cim[c * 64 + n];
        VG[col * 128 + np] = (bf16)f2bf(np < 64 ? cr * pr - ci * pi : -(cr * pi + ci * pr)); }
    __syncthreads();
}
constexpr int L5_WG = 0, L5_VG = 34816, L5_KC = 69632, L5_U = 74240, L5_HS = 91648, L5_HL = 109056, L5_L8 = 141824;
__device__ __forceinline__ void s5_item(Frame& F, int item) {
    const int tid = F.tid, lane = F.lane, wave = F.wave;
    const int g = item & 31, b8 = item >> 5;
    LAS bf16* WgT = (LAS bf16*)(F.lds + L5_WG); LAS bf16* VgT = (LAS bf16*)(F.lds + L5_VG); LAS bf16* Kc = (LAS bf16*)(F.lds + L5_KC);
    LAS bf16* Us = (LAS bf16*)(F.lds + L5_U); LAS bf16* HS = (LAS bf16*)(F.lds + L5_HS); LAS float* HL = (LAS float*)(F.lds + L5_HL); LAS float* L8 = (LAS float*)(F.lds + L5_L8);
    LAS bf16* YS = (LAS bf16*)(F.lds + L5_HL);
    const bf16* U5 = (const bf16*)(F.ws + WS_U5) + (size_t)g * MTOK * 16; bf16* GY = (bf16*)(F.ws + WS_GY) + (size_t)g * MTOK * 16;
    { const bf16* WG = (const bf16*)(F.ws + WS_T5 + (size_t)g * T5_STRIDE); const bf16* VG = WG + T5_VG / 2; const bf16* KC = WG + T5_KC / 2;
#pragma unroll
      for (int i = 0; i < 4; ++i) { const int p = tid + 512 * i, r = p >> 4, kg = (p & 15) * 8; *(LAS v4u*)(WgT + r * S5_LD + kg) = *(const v4u*)(WG + r * 128 + kg); *(LAS v4u*)(VgT + r * S5_LD + kg) = *(const v4u*)(VG + r * 128 + kg); }
      if (tid < 288) *(LAS v4u*)(Kc + tid * 8) = *(const v4u*)(KC + tid * 8); }
    float qr[9], qi[9];
    { const float a_re = F.in[8][g * S5N + lane], a_im = F.in[9][g * S5N + lane], dt = expf(F.in[10][g]);
      const float mag = expf(a_re * dt); float p8r = mag * cosf(a_im * dt), p8i = mag * sinf(a_im * dt);
#pragma unroll
      for (int i = 0; i < 3; ++i) { const float t = p8r * p8r - p8i * p8i; p8i = 2.0f * p8r * p8i; p8r = t; }
      qr[0] = 1.f; qi[0] = 0.f;
#pragma unroll
      for (int i = 1; i < 9; ++i) { qr[i] = qr[i - 1] * p8r - qi[i - 1] * p8i; qi[i] = qr[i - 1] * p8i + qi[i - 1] * p8r; } }
    const float dl = F.in[15][g * 16 + (lane & 15)];
    const int rb = wave >> 2, cb = wave & 3, r32 = lane & 31, hh = lane >> 5;
    float h_re = 0.f, h_im = 0.f;
    float sre[2], sim[2];
#pragma unroll
    for (int i = 0; i < 2; ++i) { const size_t idx = (size_t)((16 * b8 + 2 * wave + i) * S5G + g) * S5N + lane; sre[i] = F.in[2][idx]; sim[i] = F.in[3][idx]; }
    v4u un0, un1;
    { const v4u* src = (const v4u*)(U5 + (size_t)(b8 * PB_T) * 16); un0 = src[tid]; un1 = src[tid + 512]; }
    for (int seg = 0; seg < 5; ++seg) {
        const bool samp = (seg == 4);
        const int tok0 = samp ? MP + 128 * b8 : b8 * PB_T + seg * 512;
        { const int p0 = tid, p1 = tid + 512;
          *(LAS v4u*)(Us + (p0 >> 4) * S5_LD + ((p0 >> 1) & 7) * 16 + (p0 & 1) * 8) = un0; *(LAS v4u*)(Us + (p1 >> 4) * S5_LD + ((p1 >> 1) & 7) * 16 + (p1 & 1) * 8) = un1;
          if (seg < 3) { const v4u* src = (const v4u*)(U5 + (size_t)(b8 * PB_T + (seg + 1) * 512) * 16); un0 = src[tid]; un1 = src[tid + 512]; }
          else if (seg == 3) { const v4u* src = (const v4u*)(U5 + (size_t)(MP + 128 * b8) * 16); if (tid < 256) un0 = src[tid]; } }
        __syncthreads();
        { f32x16 acc = {};
#pragma unroll
          for (int s = 0; s < 8; ++s) { const s16x8 a = *(const LAS s16x8*)(Us + (32 * rb + r32) * S5_LD + s * 16 + 8 * hh); const s16x8 b = *(const LAS s16x8*)(WgT + (32 * cb + r32) * S5_LD + s * 16 + 8 * hh);
              acc = __builtin_amdgcn_mfma_f32_32x32x16_bf16(a, b, acc, 0, 0, 0); }
#pragma unroll
          for (int r = 0; r < 16; ++r) HL[(32 * rb + (r & 3) + 8 * (r >> 2) + 4 * hh) * 128 + 32 * cb + r32] = acc[r]; }
        __syncthreads();
        if (!samp) {
            float xr[8], xi[8], lr[9], li[9];
#pragma unroll
            for (int i = 0; i < 8; ++i) { xr[i] = HL[(8 * wave + i) * 128 + lane]; xi[i] = HL[(8 * wave + i) * 128 + 64 + lane]; }
            lr[0] = 0.f; li[0] = 0.f;
#pragma unroll
            for (int i = 0; i < 8; ++i) { lr[i + 1] = qr[1] * lr[i] - qi[1] * li[i] + xr[i]; li[i + 1] = qr[1] * li[i] + qi[1] * lr[i] + xi[i]; }
            L8[wave * 128 + lane] = lr[8]; L8[wave * 128 + 64 + lane] = li[8];
            __syncthreads();
            float cr = h_re, ci = h_im, mr = h_re, mi = h_im;
#pragma unroll
            for (int w = 0; w < 8; ++w) { const float tr = L8[w * 128 + lane], ti = L8[w * 128 + 64 + lane];
                const float nr = qr[8] * cr - qi[8] * ci + tr, ni = qr[8] * ci + qi[8] * cr + ti; cr = nr; ci = ni; if (w + 1 == wave) { mr = cr; mi = ci; } }
            h_re = cr; h_im = ci;
#pragma unroll
            for (int i = 0; i < 8; ++i) { const float sr = lr[i] + qr[i] * mr - qi[i] * mi, si = li[i] + qr[i] * mi + qi[i] * mr;
                HS[(8 * wave + i) * S5_LD + lane] = (bf16)f2bf(sr); HS[(8 * wave + i) * S5_LD + 64 + lane] = (bf16)f2bf(si); }
            if (seg == 3 && wave == 0) { F.out[O_PRE + (size_t)(b8 * S5G + g) * S5N + lane] = h_re; F.out[O_PIM + (size_t)(b8 * S5G + g) * S5N + lane] = h_im; }
        } else {
#pragma unroll
            for (int i = 0; i < 2; ++i) { const int r = 2 * wave + i; const size_t idx = (size_t)((16 * b8 + r) * S5G + g) * S5N + lane;
                HS[r * S5_LD + lane] = (bf16)f2bf(sre[i]); HS[r * S5_LD + 64 + lane] = (bf16)f2bf(sim[i]);
                F.out[O_SRE + idx] = qr[1] * sre[i] - qi[1] * sim[i] + HL[r * 128 + lane]; F.out[O_SIM + idx] = qr[1] * sim[i] + qi[1] * sre[i] + HL[r * 128 + 64 + lane]; }
        }
        __syncthreads();
        if (!(samp && rb == 1)) { f32x16 acc = {};
            const int tl = 2 * cb + ((lane >> 4) & 1), c = lane & 15;
#pragma unroll
            for (int s = 0; s < 8; ++s) if (s <= 2 * cb + 1) { const int j = tl - s, jj = j < 0 ? 8 : j;
                const s16x8 a = *(const LAS s16x8*)(Us + (32 * rb + r32) * S5_LD + s * 16 + 8 * hh); const s16x8 b = *(const LAS s16x8*)(Kc + (jj * 16 + c) * 16 + 8 * hh);
                acc = __builtin_amdgcn_mfma_f32_32x32x16_bf16(a, b, acc, 0, 0, 0); }
#pragma unroll
            for (int kb = 0; kb < 8; ++kb) { const s16x8 a = *(const LAS s16x8*)(HS + (32 * rb + r32) * S5_LD + kb * 16 + 8 * hh); const s16x8 b = *(const LAS s16x8*)(VgT + (32 * cb + r32) * S5_LD + kb * 16 + 8 * hh);
                acc = __builtin_amdgcn_mfma_f32_32x32x16_bf16(a, b, acc, 0, 0, 0); }
#pragma unroll
            for (int r = 0; r < 16; ++r) { const int row = 32 * rb + (r & 3) + 8 * (r >> 2) + 4 * hh;
                const float u = bf2f(Us[row * S5_LD + tl * 16 + c]); YS[row * 128 + 32 * cb + r32] = (bf16)f2bf(gelu_tanh(acc[r] + dl * u)); }
        }
        __syncthreads();
        { v4u* dst = (v4u*)(GY + (size_t)tok0 * 16);
          if (!samp) { dst[tid] = *(const LAS v4u*)(YS + tid * 8); dst[tid + 512] = *(const LAS v4u*)(YS + (tid + 512) * 8); }
          else if (tid < 256) dst[tid] = *(const LAS v4u*)(YS + tid * 8); }
        __syncthreads();
    }
}
typedef float f32x4v __attribute__((ext_vector_type(4)));
constexpr int HG_LDQ = 136, HG_LDT = 72;
constexpr size_t WS_DSC = WS_XN;
constexpr size_t WS_DEC = WS_CTL + 1 * MiB;
#define HG_GATES(NEEDQ) \
    float gl[16], kk[16], qq[16]; float run = 0.f; \
    _Pragma("unroll") for (int i = 0; i < 16; ++i) { const size_t tok = (size_t)(tok0 + 16 * tq + i); const float fz = FZ[tok * 512 + col]; if (NEEDQ) qq[i] = bf2f(PB[tok * PBW + 512 + col]); \
        const float sg = 1.0f / (1.0f + __expf(-fz)), f = lb + (1.0f - lb) * sg; kk[i] = 1.0f - f; run += __log2f(f); gl[i] = run; } \
    TOT[tq * 128 + ch] = run;
#define HG_VT_LOAD() \
    _Pragma("unroll") for (int i = 0; i < 2; ++i) { const int p = tid + 512 * i, vg = p >> 6, tk = p & 63; const v4u w = *(const v4u*)(PB + (size_t)(tok0 + tk) * PBW + 1024 + h * HD + vg * 8); \
        LAS bf16* d = Vt + (vg * 8) * HG_LDT + tk; d[0] = (bf16)(w.x & 0xffffu); d[HG_LDT] = (bf16)(w.x >> 16); d[2 * HG_LDT] = (bf16)(w.y & 0xffffu); d[3 * HG_LDT] = (bf16)(w.y >> 16); \
        d[4 * HG_LDT] = (bf16)(w.z & 0xffffu); d[5 * HG_LDT] = (bf16)(w.z >> 16); d[6 * HG_LDT] = (bf16)(w.w & 0xffffu); d[7 * HG_LDT] = (bf16)(w.w >> 16); }

constexpr int LA_KT = 0, LA_VT = 18432, LA_TOT = 36864;
__device__ __forceinline__ void hgA_item(Frame& F, int item) {
    const int tid = F.tid, lane = F.lane, wave = F.wave;
    const int bh = item >> 5, chunk = item & 31, b = bh >> 2, h = bh & 3, tok0 = b * PB_T + chunk * 64;
    LAS bf16* Kt = (LAS bf16*)(F.lds + LA_KT); LAS bf16* Vt = (LAS bf16*)(F.lds + LA_VT); LAS float* TOT = (LAS float*)(F.lds + LA_TOT);
    const bf16* PB = (const bf16*)(F.ws + WS_PB); const float* FZ = (const float*)(F.ws + WS_FZ);
    bf16* DSC = (bf16*)(F.ws + WS_DSC) + (size_t)item * HD * HD; float* DEC = (float*)(F.ws + WS_DEC) + (size_t)item * HD;
    const int ch = tid & 127, tq = tid >> 7, col = h * HD + ch;
    const float lb = 1.0f / (1.0f + expf(F.in[5][512 + col] - F.in[5][col]));
    HG_GATES(false)
    HG_VT_LOAD()
    __syncthreads();
    { const float t0 = TOT[ch], t1 = TOT[128 + ch], t2 = TOT[256 + ch], t3 = TOT[384 + ch];
      const float glast = (t0 + t1) + (t2 + t3), off = (tq == 0 ? 0.f : tq == 1 ? t0 : tq == 2 ? t0 + t1 : t0 + t1 + t2);
      unsigned kp[8];
#pragma unroll
      for (int i = 0; i < 16; ++i) { const unsigned kb = f2bf(kk[i] * __builtin_amdgcn_exp2f(glast - (off + gl[i]))); if (i & 1) kp[i >> 1] |= kb << 16; else kp[i >> 1] = kb; }
      LAS v4u* kd = (LAS v4u*)(Kt + ch * HG_LDT + 16 * tq); v4u a, c2; a.x = kp[0]; a.y = kp[1]; a.z = kp[2]; a.w = kp[3]; c2.x = kp[4]; c2.y = kp[5]; c2.z = kp[6]; c2.w = kp[7]; kd[0] = a; kd[1] = c2;
      if (tq == 0) DEC[ch] = __builtin_amdgcn_exp2f(glast); }
    __syncthreads();
    { const int r32 = lane & 31, hh = lane >> 5, kb = wave >> 1;
#pragma unroll
      for (int vbi = 0; vbi < 2; ++vbi) { const int vb = 2 * (wave & 1) + vbi; f32x16 acc = {};
#pragma unroll
          for (int ks = 0; ks < 4; ++ks) { const s16x8 a = *(const LAS s16x8*)(Kt + (32 * kb + r32) * HG_LDT + 16 * ks + 8 * hh); const s16x8 bb = *(const LAS s16x8*)(Vt + (32 * vb + r32) * HG_LDT + 16 * ks + 8 * hh);
              acc = __builtin_amdgcn_mfma_f32_32x32x16_bf16(a, bb, acc, 0, 0, 0); }
          bf16* dst = DSC + (size_t)(32 * vb + r32) * HD + 32 * kb + 4 * hh;
#pragma unroll
          for (int q = 0; q < 4; ++q) { v2u w; w.x = pk2(acc[4 * q], acc[4 * q + 1]); w.y = pk2(acc[4 * q + 2], acc[4 * q + 3]); *(v2u*)(dst + 8 * q) = w; } } }
    __syncthreads();
}
__device__ __forceinline__ void hg_scan(Frame& F) {
    bf16* DSC = (bf16*)(F.ws + WS_DSC); const float* DEC = (const float*)(F.ws + WS_DEC);
    for (int T = F.bid * 512 + F.tid; T < 32 * 4096; T += F.G * 512) {
        const int bh = T >> 12, e = T & 4095, v = e >> 5, k4 = (e & 31) * 4;
        f32x4 S = {0.f, 0.f, 0.f, 0.f};
#pragma unroll 1
        for (int c0 = 0; c0 < 32; c0 += 8) {
            v2u x[8]; f32x4 d[8];
#pragma unroll
            for (int c = 0; c < 8; ++c) { const size_t it = (size_t)(bh * 32 + c0 + c); x[c] = *(const v2u*)(DSC + (it * HD + v) * HD + k4); d[c] = *(const f32x4*)(DEC + it * HD + k4); }
#pragma unroll
            for (int c = 0; c < 8; ++c) { const size_t it = (size_t)(bh * 32 + c0 + c); v2u o; o.x = pk2(S.x, S.y); o.y = pk2(S.z, S.w); *(v2u*)(DSC + (it * HD + v) * HD + k4) = o;
                S.x = d[c].x * S.x + bflo(x[c].x); S.y = d[c].y * S.y + bfhi(x[c].x); S.z = d[c].z * S.z + bflo(x[c].y); S.w = d[c].w * S.w + bfhi(x[c].y); }
        }
        float* o = F.out + O_PHG + (size_t)bh * HD * HD + (size_t)k4 * HD + v;
        o[0] = S.x; o[HD] = S.y; o[2 * HD] = S.z; o[3 * HD] = S.w;
    }
}
constexpr int LC_QS = 0, LC_QH = 17408, LC_KS = 34816, LC_VT = 52224, LC_AT = 70656, LC_SC = 79872, LC_TOT = 114688, LC_SS = 116736;
__device__ __forceinline__ void hgC_item(Frame& F, int item) {
    const int tid = F.tid, lane = F.lane, wave = F.wave;
    const int bh = item >> 5, chunk = item & 31, b = bh >> 2, h = bh & 3, tok0 = b * PB_T + chunk * 64;
    LAS bf16* Qs = (LAS bf16*)(F.lds + LC_QS); LAS bf16* Qh = (LAS bf16*)(F.lds + LC_QH); LAS bf16* Ks = (LAS bf16*)(F.lds + LC_KS); LAS bf16* Vt = (LAS bf16*)(F.lds + LC_VT);
    LAS bf16* At = (LAS bf16*)(F.lds + LC_AT); LAS bf16* SC = (LAS bf16*)(F.lds + LC_SC); LAS float* TOT = (LAS float*)(F.lds + LC_TOT); LAS float* SS = (LAS float*)(F.lds + LC_SS);
    const bf16* PB = (const bf16*)(F.ws + WS_PB); const float* FZ = (const float*)(F.ws + WS_FZ); bf16* MIX = (bf16*)(F.ws + WS_MIX);
    const bf16* DSC = (const bf16*)(F.ws + WS_DSC) + (size_t)item * HD * HD;
    const int ch = tid & 127, tq = tid >> 7, col = h * HD + ch;
    const float lb = 1.0f / (1.0f + expf(F.in[5][512 + col] - F.in[5][col]));
#pragma unroll
    for (int i = 0; i < 4; ++i) { const int p = tid + 512 * i, v = p >> 4, kg = (p & 15) * 8; *(LAS v4u*)(SC + v * HG_LDQ + kg) = *(const v4u*)(DSC + (size_t)v * HD + kg); }
    HG_GATES(true)
    HG_VT_LOAD()
    __syncthreads();
    { const float t0 = TOT[ch], t1 = TOT[128 + ch], t2 = TOT[256 + ch];
      const float gref = t0 + t1, off = (tq == 0 ? 0.f : tq == 1 ? t0 : tq == 2 ? gref : gref + t2);
#pragma unroll
      for (int i = 0; i < 16; ++i) { const float G = off + gl[i], e1 = __builtin_amdgcn_exp2f(G - gref), e2 = __builtin_amdgcn_rcpf(e1), e3 = __builtin_amdgcn_exp2f(G);
          Qs[(16 * tq + i) * HG_LDQ + ch] = (bf16)f2bf(qq[i] * e1); Ks[(16 * tq + i) * HG_LDQ + ch] = (bf16)f2bf(kk[i] * e2); Qh[(16 * tq + i) * HG_LDQ + ch] = (bf16)f2bf(qq[i] * e3); } }
    __syncthreads();
    const int r32 = lane & 31, hh = lane >> 5;
    if (wave < 4) { const int tb = wave >> 1, sb = wave & 1; f32x16 acc = {};
        if (sb <= tb) {
#pragma unroll
            for (int ks = 0; ks < 8; ++ks) { const s16x8 a = *(const LAS s16x8*)(Qs + (32 * tb + r32) * HG_LDQ + 16 * ks + 8 * hh); const s16x8 bb = *(const LAS s16x8*)(Ks + (32 * sb + r32) * HG_LDQ + 16 * ks + 8 * hh);
                acc = __builtin_amdgcn_mfma_f32_32x32x16_bf16(a, bb, acc, 0, 0, 0); } }
        const int s = 32 * sb + r32;
#pragma unroll
        for (int r = 0; r < 16; ++r) { const int t = 32 * tb + (r & 3) + 8 * (r >> 2) + 4 * hh; At[t * HG_LDT + s] = (s <= t) ? (bf16)f2bf(acc[r]) : (bf16)0; } }
    __syncthreads();
    const int tb = wave >> 2, vb = wave & 3, t = 32 * tb + r32;
    v2u og[4];
#pragma unroll
    for (int q = 0; q < 4; ++q) og[q] = *(const v2u*)(PB + (size_t)(tok0 + t) * PBW + 1536 + h * HD + 32 * vb + 8 * q + 4 * hh);
    f32x16 acc = {};
#pragma unroll
    for (int ks = 0; ks < 4; ++ks) if (ks < 2 * tb + 2) { const s16x8 a = *(const LAS s16x8*)(Vt + (32 * vb + r32) * HG_LDT + 16 * ks + 8 * hh); const s16x8 bb = *(const LAS s16x8*)(At + t * HG_LDT + 16 * ks + 8 * hh);
        acc = __builtin_amdgcn_mfma_f32_32x32x16_bf16(a, bb, acc, 0, 0, 0); }
#pragma unroll
    for (int ks = 0; ks < 8; ++ks) { const s16x8 a = *(const LAS s16x8*)(SC + (32 * vb + r32) * HG_LDQ + 16 * ks + 8 * hh); const s16x8 bb = *(const LAS s16x8*)(Qh + t * HG_LDQ + 16 * ks + 8 * hh);
        acc = __builtin_amdgcn_mfma_f32_32x32x16_bf16(a, bb, acc, 0, 0, 0); }
    { float ss = 0.f;
#pragma unroll
      for (int r = 0; r < 16; ++r) ss += acc[r] * acc[r];
      ss += __shfl_xor(ss, 32);
      if (hh == 0) SS[t * 4 + vb] = ss; }
    __syncthreads();
    { const f32x4 s4 = *(const LAS f32x4*)(SS + t * 4); const float rstd = 1.0f / sqrtf(((s4.x + s4.y) + (s4.z + s4.w)) * (1.0f / HD) + EPS);
#pragma unroll
      for (int q = 0; q < 4; ++q) { const int v0 = 32 * vb + 8 * q + 4 * hh; const f32x4 gn = *(const GAS f32x4*)(F.in[17] + v0);
          v2u w; w.x = pk2(acc[4 * q] * rstd * gn.x * siluf_(bflo(og[q].x)), acc[4 * q + 1] * rstd * gn.y * siluf_(bfhi(og[q].x)));
          w.y = pk2(acc[4 * q + 2] * rstd * gn.z * siluf_(bflo(og[q].y)), acc[4 * q + 3] * rstd * gn.w * siluf_(bfhi(og[q].y)));
          *(v2u*)(MIX + (size_t)(tok0 + t) * DM + 512 + h * HD + v0) = w; } }
    __syncthreads();
}
constexpr int LX_Q = 0, LX_K2 = 4096, LX_K3 = 8192, LX_V = 12288, LX_DEC = 16384, LX_ATT = 16896, LX_OP = 17152, LX_OT = 33536;
__device__ __forceinline__ void hgrn_sample_item(Frame& F, int idx) {
    const int tid = F.tid, b = idx >> 2, h = idx & 3;
    LAS float* Qs = (LAS float*)(F.lds + LX_Q); LAS float* K2 = (LAS float*)(F.lds + LX_K2); LAS float* K3 = (LAS float*)(F.lds + LX_K3); LAS float* Vs = (LAS float*)(F.lds + LX_V);
    LAS float* DEC = (LAS float*)(F.lds + LX_DEC); LAS float* ATT = (LAS float*)(F.lds + LX_ATT); LAS float* OP = (LAS float*)(F.lds + LX_OP); LAS float* OT = (LAS float*)(F.lds + LX_OT);
    const bf16* PB = (const bf16*)(F.ws + WS_PB); const float* FZ = (const float*)(F.ws + WS_FZ); bf16* MIX = (bf16*)(F.ws + WS_MIX);
    const float* S0 = F.in[4] + (size_t)idx * HD * HD; float* Sout = F.out + O_SHG + (size_t)idx * HD * HD;
    const int tok0 = MP + b * SB_T;
    const int v = tid & 127, kq = tid >> 7;
    float s0[32];
#pragma unroll
    for (int j = 0; j < 32; ++j) s0[j] = S0[(size_t)(32 * kq + j) * HD + v];
    if (tid < 128) { const int col = h * HD + tid; const float lb = 1.0f / (1.0f + expf(F.in[5][512 + col] - F.in[5][col]));
        float gl[8], kk[8], qq[8]; float run = 0.f;
#pragma unroll
        for (int t = 0; t < 8; ++t) { const size_t tok = (size_t)(tok0 + t); const float fz = FZ[tok * 512 + col]; qq[t] = bf2f(PB[tok * PBW + 512 + col]);
            const float sg = 1.0f / (1.0f + __expf(-fz)), f = lb + (1.0f - lb) * sg; kk[t] = 1.0f - f; run += __log2f(f); gl[t] = run; }
#pragma unroll
        for (int t = 0; t < 8; ++t) { Qs[t * 128 + tid] = qq[t] * __builtin_amdgcn_exp2f(gl[t]); K2[t * 128 + tid] = kk[t] * __builtin_amdgcn_exp2f(-gl[t]); K3[t * 128 + tid] = kk[t] * __builtin_amdgcn_exp2f(run - gl[t]); }
        DEC[tid] = __builtin_amdgcn_exp2f(run);
    } else if (tid < 256) { const int vv = tid - 128;
#pragma unroll
        for (int t = 0; t < 8; ++t) Vs[t * 128 + vv] = bf2f(PB[(size_t)(tok0 + t) * PBW + 1024 + h * HD + vv]);
    }
    __syncthreads();
    { const int p = tid >> 3, part = tid & 7, t = p >> 3, s = p & 7; float a = 0.f;
#pragma unroll
      for (int j = 0; j < 16; ++j) a += Qs[t * 128 + part + 8 * j] * K2[s * 128 + part + 8 * j];
      a += __shfl_xor(a, 1); a += __shfl_xor(a, 2); a += __shfl_xor(a, 4);
      if (part == 0) ATT[p] = (s <= t) ? a : 0.f; }
    float vr[8], o[8];
#pragma unroll
    for (int t = 0; t < 8; ++t) { vr[t] = Vs[t * 128 + v]; o[t] = 0.f; }
#pragma unroll
    for (int j = 0; j < 32; ++j) { const int k = 32 * kq + j; const float sv = s0[j]; float sn = DEC[k] * sv;
#pragma unroll
        for (int t = 0; t < 8; ++t) { o[t] += Qs[t * 128 + k] * sv; sn += K3[t * 128 + k] * vr[t]; }
        Sout[(size_t)k * HD + v] = sn; }
#pragma unroll
    for (int t = 0; t < 8; ++t) OP[(kq * 8 + t) * 128 + v] = o[t];
    __syncthreads();
#pragma unroll
    for (int r = 0; r < 2; ++r) { const int e = tid + 512 * r, t = e >> 7, vv = e & 127;
        float acc = (OP[(0 * 8 + t) * 128 + vv] + OP[(1 * 8 + t) * 128 + vv]) + (OP[(2 * 8 + t) * 128 + vv] + OP[(3 * 8 + t) * 128 + vv]);
#pragma unroll
        for (int s = 0; s < 8; ++s) acc += ATT[t * 8 + s] * Vs[s * 128 + vv];
        OT[t * 128 + vv] = acc; }
    __syncthreads();
    { const int t = F.wave, lane = F.lane; const float o0 = OT[t * 128 + 2 * lane], o1 = OT[t * 128 + 2 * lane + 1];
      const float rstd = 1.0f / sqrtf(wave_sum(o0 * o0 + o1 * o1) * (1.0f / HD) + EPS);
      const unsigned gw2 = *(const unsigned*)(PB + (size_t)(tok0 + t) * PBW + 1536 + h * HD + 2 * lane);
      const float g0 = F.in[17][2 * lane], g1 = F.in[17][2 * lane + 1];
      *(unsigned*)(MIX + (size_t)(tok0 + t) * DM + 512 + h * HD + 2 * lane) = pk2(o0 * rstd * g0 * siluf_(bflo(gw2)), o1 * rstd * g1 * siluf_(bfhi(gw2))); }
    __syncthreads();
}
__device__ __forceinline__ void final_norm_row(Frame& F, int m) {
    GAS f32x4* xr = (GAS f32x4*)(F.out + O_Y + (size_t)m * DM) + F.lane;
    f32x4 v[4]; float s = 0.f;
#pragma unroll
    for (int j = 0; j < 4; ++j) { v[j] = xr[64 * j]; s += (v[j].x * v[j].x + v[j].y * v[j].y) + (v[j].z * v[j].z + v[j].w * v[j].w); }
    const float rstd = 1.0f / sqrtf(wave_sum(s) * (1.0f / DM) + EPS);
#pragma unroll
    for (int j = 0; j < 4; ++j) { const f32x4 g = ((const GAS f32x4*)F.in[23])[F.lane + 64 * j]; f32x4 o; o.x = v[j].x * rstd * g.x; o.y = v[j].y * rstd * g.y; o.z = v[j].z * rstd * g.z; o.w = v[j].w * rstd * g.w; xr[64 * j] = o; }
}

typedef GAS unsigned gu32;
#define RLX_AGENT __ATOMIC_RELAXED, __HIP_MEMORY_SCOPE_AGENT
constexpr int MISC_OFF = LDS_BYTES - 512;
constexpr int CW_QUEUE = 8192;
constexpr int CW_BAR = 4096;
constexpr size_t CTL_ZERO_BYTES = 65536;
#define XB_TMO      128
#define XB_XCNT(j)  (256  + 64 * (j))
#define XB_XSUB(j)  (1280 + 64 * (j))
#define XB_XGEN(j)  (2304 + 64 * (j))
#define XB_TOP      3328
#define XB_TOPGEN   3392
#define XCD_BAR_WORDS 3456
#define XB_SPIN_CAP (1u << 18)

__device__ __forceinline__ unsigned xb_ld(unsigned* p)              { return __hip_atomic_load(p, __ATOMIC_RELAXED, __HIP_MEMORY_SCOPE_AGENT); }
__device__ __forceinline__ unsigned xb_add(unsigned* p, unsigned v) { return __hip_atomic_fetch_add(p, v, __ATOMIC_RELAXED, __HIP_MEMORY_SCOPE_AGENT); }
__device__ __forceinline__ unsigned xb_xcc_id() { return (unsigned)__builtin_amdgcn_s_getreg((3 << 11) | 20) & 0xFu; }
#define XB_SPIN(cond, bar) do { unsigned _sp = 0; while (cond) { __builtin_amdgcn_s_sleep(1); \
    if ((++_sp & 255u) == 0u) { if (xb_ld(&(bar)[XB_TMO])) break; if (_sp > XB_SPIN_CAP) { atomicAdd(&(bar)[XB_TMO], 1u); break; } } } } while (0)

struct XcdBarrier {
    unsigned* bar; unsigned x;
    volatile LAS unsigned* st;
};

__device__ __forceinline__ XcdBarrier xcd_barrier_post(unsigned* bar, volatile LAS unsigned* st) {
    XcdBarrier b; b.bar = bar; b.x = xb_xcc_id(); b.st = st;
    if (threadIdx.x == 0) (void)xb_add(&bar[XB_XCNT(b.x)], 1u);
    return b;
}
__device__ __forceinline__ void xcd_barrier_complete(unsigned* bar, unsigned x, unsigned& nloc, unsigned& nx) {
    const unsigned G = gridDim.x * gridDim.y * gridDim.z;
    unsigned sum, cnt, mine, sp = 0u;
    for (;;) {
        sum = 0u; cnt = 0u; mine = 0u;
#pragma unroll
        for (unsigned j = 0; j < 16; ++j) { const unsigned c = xb_ld(&bar[XB_XCNT(j)]); sum += c; cnt += (c > 0u) ? 1u : 0u; mine = (j == x) ? c : mine; }
        if (sum == G) break;
        __builtin_amdgcn_s_sleep(1);
        if ((++sp & 255u) == 0u) { if (xb_ld(&bar[XB_TMO])) break; if (sp > XB_SPIN_CAP) { atomicAdd(&bar[XB_TMO], 1u); break; } }
    }
    nloc = mine > 0u ? mine : 1u; nx = cnt > 0u ? cnt : 1u;
}

__device__ __forceinline__ void xcd_barrier(const XcdBarrier& b) {
    asm volatile("s_waitcnt vmcnt(0)" ::: "memory");
    __syncthreads();
    if (threadIdx.x == 0) {
        unsigned* bar = b.bar;
        __builtin_amdgcn_s_waitcnt(0);
        unsigned nloc = b.st[0], nx = b.st[1];
        if (nloc == 0u) { xcd_barrier_complete(bar, b.x, nloc, nx); b.st[0] = nloc; b.st[1] = nx; }
        const unsigned old = xb_add(&bar[XB_XSUB(b.x)], 1u);
        const unsigned gen = old / nloc;
        if (old + 1u == (gen + 1u) * nloc) {
            __builtin_amdgcn_fence(__ATOMIC_RELEASE, "agent");
            asm volatile("s_waitcnt vmcnt(0)" ::: "memory");
            const unsigned og = xb_add(&bar[XB_TOP], 1u);
            const unsigned tg = og / nx;
            if (og + 1u == (tg + 1u) * nx) xb_add(&bar[XB_TOPGEN], 1u);
            else XB_SPIN(xb_ld(&bar[XB_TOPGEN]) == tg, bar);
            __builtin_amdgcn_fence(__ATOMIC_ACQUIRE, "agent");
            xb_add(&bar[XB_XGEN(b.x)], 1u);
            asm volatile("s_waitcnt vmcnt(0)" ::: "memory");
        } else {
            XB_SPIN(xb_ld(&bar[XB_XGEN(b.x)]) == gen, bar);
            __builtin_amdgcn_fence(__ATOMIC_ACQUIRE, "agent");
            asm volatile("s_waitcnt vmcnt(0)" ::: "memory");
        }
    }
    __syncthreads();
}

__global__ void __launch_bounds__(NWAVES * 64, 2) mk_fwd(Args args) {
    extern __shared__ __attribute__((aligned(16))) unsigned char lds[];
    Frame F;
    F.lds = (LAS unsigned char*)lds;
    F.tid = threadIdx.x; F.lane = F.tid & 63; F.wave = __builtin_amdgcn_readfirstlane(F.tid >> 6);
    F.G = gridDim.x; F.bid = blockIdx.x;
#pragma unroll
    for (int i = 0; i < 24; ++i) F.in[i] = args.in[i];
    F.out = args.out; F.ws = args.ws;
    const int lo = args.ph_lo, hi = args.ph_hi;
#define IN(k) (lo <= (k) && (k) < hi)
#if MK_N_LAUNCHES == 1
    volatile LAS unsigned* MISC = (volatile LAS unsigned*)(F.lds + MISC_OFF);
    if (F.tid < 32) MISC[F.tid] = 0u;
    __syncthreads();
    XcdBarrier bar = xcd_barrier_post((unsigned*)(F.ws + WS_CTL) + CW_BAR, MISC + 8);
#define SEAM(k) do { if (IN(k) && IN((k) + 1)) xcd_barrier(bar); } while (0)
#else
#define SEAM(k) do { } while (0)
#endif
    const int gw = F.bid * NWAVES + F.wave, NGW = F.G * NWAVES;
    bf16* XN = (bf16*)(F.ws + WS_XN); bf16* PB = (bf16*)(F.ws + WS_PB); float* FZ = (float*)(F.ws + WS_FZ); bf16* GY = (bf16*)(F.ws + WS_GY);
    bf16* MIX = (bf16*)(F.ws + WS_MIX); bf16* ACT = (bf16*)(F.ws + WS_ACT);

    if (IN(0)) { p0_prologue(F); } SEAM(0);
    if (IN(1)) {
        pg8::Gemm g{XN, (const bf16*)(F.ws + WS_WIN), MTOK, INC, DM}; pg8::StaticOrder S; S.init(MTOK, INC, F.G, F.bid);
        EpiIn E{PB, FZ, (bf16*)(F.ws + WS_U5)};
        pg8::gemm_phase<EpiIn, pg8::StaticOrder, true, true>(F.lds, g, S, E);
    } SEAM(1);
    if (IN(2)) {
        for (int it = F.bid; it < 256; it += F.G) s5_item(F, it);
        for (int it = F.bid; it < 1024; it += F.G) hgA_item(F, it);
        for (int it = F.bid; it < SB_B * HH; it += F.G) hgrn_sample_item(F, it);
    } SEAM(2);
    if (IN(3)) { hg_scan(F); } SEAM(3);
    if (IN(4)) {
        pg8::Gemm g{GY, (const bf16*)(F.ws + WS_WGLU), MTOK, S5W, S5W}; pg8::StaticOrder S; S.init(MTOK, S5W, F.G, F.bid);
        EpiGlu E{GY, MIX};
        pg8::gemm_phase<EpiGlu, pg8::StaticOrder, true, true, true>(F.lds, g, S, E);
        __syncthreads();
        gu32* ctr = (gu32*)(F.ws + WS_CTL) + CW_QUEUE; volatile LAS int* slot = (volatile LAS int*)(F.lds + MISC_OFF + 64);
        for (;;) { if (F.tid == 0) *slot = (int)__hip_atomic_fetch_add(ctr, 1u, RLX_AGENT); __syncthreads(); const int it = *slot; if (it >= 1024) break; hgC_item(F, it); }
    } SEAM(4);
    if (IN(5)) {
        pg8::Gemm g{MIX, (const bf16*)(F.ws + WS_WOUT), MTOK, DM, DM}; pg8::StaticOrder S; S.init(MTOK, DM, F.G, F.bid);
        EpiOut E{F.in[0], F.in[1], F.out + O_Y};
        pg8::gemm_phase<EpiOut, pg8::StaticOrder, true, true>(F.lds, g, S, E);
    } SEAM(5);
    if (IN(6)) {
        for (int m = gw; m < MTOK; m += NGW) rms_row_bf16(F.out + O_Y + (size_t)m * DM, F.in[19], XN + (size_t)m * DM, F.lane);
    } SEAM(6);
    if (IN(7)) {
        pg8::Gemm g{XN, (const bf16*)(F.ws + WS_WGU), MTOK, 2 * DFF, DM}; pg8::StaticOrder S; S.init(MTOK, 2 * DFF, F.G, F.bid);
        EpiAct E{ACT};
        pg8::gemm_phase<EpiAct, pg8::StaticOrder, true, true>(F.lds, g, S, E);
    } SEAM(7);
    if (IN(8)) {
        pg8::Gemm g{ACT, (const bf16*)(F.ws + WS_WD), MTOK, DM, DFF}; pg8::StaticOrder S; S.init(MTOK, DM, F.G, F.bid);
        EpiDown E{F.out + O_Y};
        pg8::gemm_phase<EpiDown, pg8::StaticOrder, true, true>(F.lds, g, S, E);
    } SEAM(8);
    if (IN(9)) {
        for (int m = gw; m < MTOK; m += NGW) final_norm_row(F, m);
    }
#undef IN
#undef SEAM
}

extern "C" void kernel_launch(void* const* d_in, const int* in_sizes, int n_in, void* d_out, int out_size, void* d_ws, size_t ws_size, hipStream_t stream) {
    static int grid = 0;
    if (grid == 0) {
        if (n_in != 24 || ws_size < WS_END) { fprintf(stderr, "kernel_launch: unexpected n_in %d / ws %zu\n", n_in, ws_size); grid = -1; return; }
        int dev = 0, cus = 0, per_cu = 0;
        if (hipGetDevice(&dev) != hipSuccess || hipDeviceGetAttribute(&cus, hipDeviceAttributeMultiprocessorCount, dev) != hipSuccess) { grid = -1; return; }
        if (hipFuncSetAttribute((const void*)mk_fwd, hipFuncAttributeMaxDynamicSharedMemorySize, LDS_BYTES) != hipSuccess) { fprintf(stderr, "kernel_launch: hipFuncSetAttribute failed\n"); grid = -1; return; }
        if (hipOccupancyMaxActiveBlocksPerMultiprocessor(&per_cu, (const void*)mk_fwd, NWAVES * 64, LDS_BYTES) != hipSuccess || per_cu < 1) { fprintf(stderr, "kernel_launch: occupancy query says %d\n", per_cu); per_cu = 1; }
        (void)hipGetLastError();
        grid = cus;
    }
    if (grid < 0) return;
    if (hipMemsetAsync((char*)d_ws + WS_CTL, 0, CTL_ZERO_BYTES, stream) != hipSuccess) { fprintf(stderr, "kernel_launch: memset failed\n"); return; }
    Args a{};
    for (int i = 0; i < 24; ++i) a.in[i] = (const float*)d_in[i];
    a.out = (float*)d_out; a.ws = (unsigned char*)d_ws;
#if MK_N_LAUNCHES == 1
    a.ph_lo = 0; a.ph_hi = NPH;
    void* kargs[] = {&a};
    hipError_t e = hipLaunchCooperativeKernel((const void*)mk_fwd, dim3(grid), dim3(NWAVES * 64), kargs, LDS_BYTES, stream);
    if (e != hipSuccess) fprintf(stderr, "kernel_launch: cooperative launch failed: %s (grid %d)\n", hipGetErrorString(e), grid);
#else
    for (int p = 0; p < NPH; ++p) { a.ph_lo = p; a.ph_hi = p + 1; hipLaunchKernelGGL(mk_fwd, dim3(grid), dim3(NWAVES * 64), LDS_BYTES, stream, a); }
#endif
}
```

```cpp
#include <hip/hip_runtime.h>
#include <hip/hip_cooperative_groups.h>
#include <cstdio>
#include <cstdint>
namespace cg = cooperative_groups;
#define MK_N_LAUNCHES 1
namespace pg8 {
#define PG8_LAS __attribute__((address_space(3)))
typedef unsigned short bf16_t;
typedef short bf16x8 __attribute__((ext_vector_type(8)));
typedef float f32x4 __attribute__((ext_vector_type(4)));
typedef unsigned u32x4 __attribute__((ext_vector_type(4)));
constexpr int BM = 256, BK = 64, HALF = 128, HTB = HALF * BK * 2  , STAGE_BYTES = 8 * HTB, NXCD = 8, WGM = 8;

__host__ __device__ __forceinline__ int lds_byte(int r, int c) { const int st = (r >> 4) * 2 + (c >> 5), rr = r & 15, cc = c & 31, ob = rr * 64 + cc * 2; return st * 1024 + (ob ^ (((ob >> 9) & 1) << 5)); }
__host__ __device__ __forceinline__ void stage_rc(int b, int& R, int& C) { const int st = b / 1024, sb = b % 1024, swz = sb ^ (((sb >> 9) & 1) << 5); R = (st >> 1) * 16 + swz / 64; C = (st & 1) * 32 + (swz % 64) / 2; }
__host__ __device__ __forceinline__ int perm32(int rho) { const int n = rho >> 4, i = rho & 15; return 8 * (i >> 2) + 4 * n + (i & 3); }

struct Unit { int pm, pn; };
struct Gemm { const bf16_t* A; const bf16_t* Bt; int M, N, K; };

struct StaticOrder {
    int nM, nN, nwg, G, c;
    __host__ __device__ void init(int M, int N, int G_, int c_) { nM = M / BM; nN = N / BM; nwg = nM * nN; G = G_; c = c_; }
    __host__ __device__ bool next(int i, Unit& u) const {
        const long L = (long)i * G + c; if (L >= nwg) return false;
        int wgid = (int)L; { const int q = nwg / NXCD, r = nwg % NXCD, xcd = wgid % NXCD, off = wgid / NXCD; wgid = (xcd < r ? xcd * (q + 1) : r * (q + 1) + (xcd - r) * q) + off; }
        const int nig = WGM * nN, gid = wgid / nig, fm = gid * WGM, gsz = (nM - fm) < WGM ? (nM - fm) : WGM;
        u.pm = fm + ((wgid % nig) % gsz); u.pn = (wgid % nig) / gsz; return true;
    }
    __device__ __forceinline__ void a_ready(const Unit&) const {}
    __device__ __forceinline__ void done(const Unit&) const {}
};

__device__ __forceinline__ unsigned cvt_pk_bf16(float lo, float hi) { unsigned r; asm volatile("v_cvt_pk_bf16_f32 %0, %1, %2" : "=v"(r) : "v"(lo), "v"(hi)); return r; }
template <class Epi, class Sched, bool ALIGN_EPI = false, bool SP2 = false, bool AGM = false  >
__device__ __forceinline__ void gemm_phase(PG8_LAS unsigned char* lds, const Gemm g, const Sched& S, const Epi& E) {
    const int tid = threadIdx.x, wid = __builtin_amdgcn_readfirstlane(tid >> 6), lane = tid & 63, wr = wid >> 2, wc = wid & 3, fr = lane & 15, fq = lane >> 4;
    const int K = g.K, nt = K / BK;
    unsigned voffA[2], voffB[2];
#pragma unroll
    for (int i = 0; i < 2; ++i) { int R, C; stage_rc(tid * 16 + i * 8192, R, C); const int Rb = Epi::PERM ? ((R & ~31) + perm32(R & 31)) : R;
        voffA[i] = AGM ? (unsigned)((((C >> 4) * g.M + R) * 16 + (C & 15)) * 2) : (unsigned)(R * K + C) * 2u; voffB[i] = (unsigned)(Rb * K + C) * 2u; }
    const size_t kstep = (size_t)(BK * 2);
    const size_t hstep = (size_t)HALF * K * 2;
    const size_t tstep = 2 * hstep;
    const size_t kstepA = AGM ? (size_t)4 * g.M * 32 : kstep, hstepA = AGM ? (size_t)HALF * 32 : hstep, tstepA = 2 * hstepA;
    const unsigned ldsw = (unsigned)wid * 1024u;
    const int aoff = lds_byte(wr * 64 + fr, fq * 8), boff = lds_byte(wc * 32 + fr, fq * 8);
#define PG8_SA(b, h) (((b) * 2 + (h)) * HTB)
#define PG8_SB(b, h) ((4 + (b) * 2 + (h)) * HTB)
#define PG8_STAGE(bufoff, gbase, voff) do { _Pragma("unroll") for (int _i = 0; _i < 2; ++_i) \
        __builtin_amdgcn_global_load_lds((const unsigned*)((const char*)(gbase) + (voff)[_i]), (PG8_LAS unsigned*)(lds + (bufoff) + ldsw + _i * 8192), 16, 0, 0); } while (0)
#define PG8_LDA(dst, b, h) do { _Pragma("unroll") for (int m = 0; m < 4; ++m) _Pragma("unroll") for (int k = 0; k < 2; ++k) dst[m][k] = *(const PG8_LAS bf16x8*)(lds + PG8_SA(b, h) + aoff + m * 2048 + k * 1024); } while (0)
#define PG8_LDB(dst, b, h) do { _Pragma("unroll") for (int n = 0; n < 2; ++n) _Pragma("unroll") for (int k = 0; k < 2; ++k) dst[n][k] = *(const PG8_LAS bf16x8*)(lds + PG8_SB(b, h) + boff + n * 2048 + k * 1024); } while (0)
#define PG8_MMA(ai, bj, At, Bt) do { __builtin_amdgcn_s_setprio(1); _Pragma("unroll") for (int m = 0; m < 4; ++m) _Pragma("unroll") for (int n = 0; n < 2; ++n) _Pragma("unroll") for (int k = 0; k < 2; ++k) \
        acc[ai][bj][m][n] = __builtin_amdgcn_mfma_f32_16x16x32_bf16(Bt[n][k], At[m][k], acc[ai][bj][m][n], 0, 0, 0); __builtin_amdgcn_s_setprio(0); } while (0)
#define PG8_WAIT_V(n) asm volatile("s_waitcnt vmcnt(" #n ")" ::: "memory")
#define PG8_WAIT_L(n) asm volatile("s_waitcnt lgkmcnt(" #n ")" ::: "memory")
#define PG8_BAR __builtin_amdgcn_s_barrier()
#define PG8_SCHED __builtin_amdgcn_sched_barrier(0)
    Unit cur, nxt; int ui = 0;
    if (!S.next(0, cur)) return;
    f32x4 acc[2][2][4][2];
#pragma unroll
    for (int a = 0; a < 2; ++a)
#pragma unroll
        for (int b = 0; b < 2; ++b)
#pragma unroll
            for (int m = 0; m < 4; ++m)
#pragma unroll
                for (int n = 0; n < 2; ++n) acc[a][b][m][n] = (f32x4){0.f, 0.f, 0.f, 0.f};
    bf16x8 At[4][2], B0[2][2], B1[2][2];
    const char* cA = (const char*)g.A + (size_t)cur.pm * tstepA; const char* cB = (const char*)g.Bt + (size_t)cur.pn * tstep;
    S.a_ready(cur);
    if constexpr (SP2) {
        PG8_STAGE(PG8_SB(0, 0), cB, voffB); PG8_STAGE(PG8_SB(0, 1), cB + hstep, voffB); PG8_STAGE(PG8_SA(0, 0), cA, voffA); PG8_STAGE(PG8_SA(0, 1), cA + hstepA, voffA);
        if (wr == 1) PG8_BAR;
        PG8_WAIT_V(2); PG8_BAR;
        PG8_STAGE(PG8_SB(1, 0), cB + kstep, voffB); PG8_STAGE(PG8_SA(1, 0), cA + kstepA, voffA); PG8_STAGE(PG8_SB(1, 1), cB + hstep + kstep, voffB);
        PG8_WAIT_V(6); PG8_BAR;
    } else {
        PG8_STAGE(PG8_SB(0, 0), cB, voffB); PG8_STAGE(PG8_SA(0, 0), cA, voffA); PG8_STAGE(PG8_SB(0, 1), cB + hstep, voffB); PG8_STAGE(PG8_SA(0, 1), cA + hstepA, voffA);
        if (wr == 1) PG8_BAR;
        PG8_WAIT_V(4); PG8_BAR;
        PG8_STAGE(PG8_SB(1, 0), cB + kstep, voffB); PG8_STAGE(PG8_SA(1, 0), cA + kstepA, voffA); PG8_STAGE(PG8_SB(1, 1), cB + hstep + kstep, voffB);
        PG8_WAIT_V(6); PG8_BAR;
    }
    for (;;) {
        const bool has_next = S.next(ui + 1, nxt);
        const char* nA = has_next ? (const char*)g.A + (size_t)nxt.pm * tstepA : cA; const char* nB = has_next ? (const char*)g.Bt + (size_t)nxt.pn * tstep : cB;
        for (int t = 0; t < nt; t += 2) {
            const bool last = (t == nt - 2);
            const char* a1 = cA + (size_t)(t + 1) * kstepA;
            const char* a2 = last ? nA : cA + (size_t)(t + 2) * kstepA; const char* b2 = last ? nB : cB + (size_t)(t + 2) * kstep;
            const char* a3 = a2 + kstepA; const char* b3 = b2 + kstep;
            if (last && has_next) S.a_ready(nxt);
            if constexpr (SP2) {
            PG8_LDB(B0, 0, 0); PG8_LDB(B1, 0, 1); PG8_SCHED; PG8_LDA(At, 0, 0); PG8_STAGE(PG8_SA(1, 1), a1 + hstepA, voffA);
            PG8_WAIT_V(8); PG8_WAIT_L(0); PG8_BAR; PG8_MMA(0, 0, At, B0); PG8_MMA(0, 1, At, B1); PG8_BAR; PG8_SCHED;
            PG8_LDA(At, 0, 1); PG8_STAGE(PG8_SB(0, 0), b2, voffB); PG8_STAGE(PG8_SB(0, 1), b2 + hstep, voffB); PG8_STAGE(PG8_SA(0, 0), a2, voffA);
            PG8_WAIT_V(8); PG8_WAIT_L(0); PG8_BAR; PG8_MMA(1, 0, At, B0); PG8_MMA(1, 1, At, B1); PG8_BAR; PG8_SCHED;
            PG8_LDB(B0, 1, 0); PG8_LDB(B1, 1, 1); PG8_SCHED; PG8_LDA(At, 1, 0); PG8_STAGE(PG8_SA(0, 1), a2 + hstepA, voffA);
            PG8_WAIT_V(8); PG8_WAIT_L(0); PG8_BAR; PG8_MMA(0, 0, At, B0); PG8_MMA(0, 1, At, B1); PG8_BAR; PG8_SCHED;
            PG8_LDA(At, 1, 1); PG8_STAGE(PG8_SB(1, 0), b3, voffB); PG8_STAGE(PG8_SB(1, 1), b3 + hstep, voffB); PG8_STAGE(PG8_SA(1, 0), a3, voffA);
            PG8_WAIT_V(8); PG8_WAIT_L(0); PG8_BAR; PG8_MMA(1, 0, At, B0); PG8_MMA(1, 1, At, B1); PG8_BAR; PG8_SCHED;
            } else {
            PG8_LDB(B0, 0, 0); PG8_SCHED; PG8_LDA(At, 0, 0); PG8_STAGE(PG8_SA(1, 1), a1 + hstepA, voffA);
            PG8_WAIT_L(8); PG8_BAR; PG8_WAIT_L(0); PG8_MMA(0, 0, At, B0); PG8_BAR; PG8_SCHED;
            PG8_LDB(B1, 0, 1); PG8_STAGE(PG8_SB(0, 0), b2, voffB);
            PG8_BAR; PG8_WAIT_L(0); PG8_MMA(0, 1, At, B1); PG8_BAR;
            PG8_LDA(At, 0, 1); PG8_STAGE(PG8_SA(0, 0), a2, voffA);
            PG8_BAR; PG8_WAIT_L(0); PG8_MMA(1, 0, At, B0); PG8_BAR; PG8_SCHED;
            PG8_STAGE(PG8_SB(0, 1), b2 + hstep, voffB);
            PG8_WAIT_V(6); PG8_BAR; PG8_MMA(1, 1, At, B1); PG8_BAR;
            PG8_LDB(B0, 1, 0); PG8_SCHED; PG8_LDA(At, 1, 0); PG8_STAGE(PG8_SA(0, 1), a2 + hstepA, voffA);
            PG8_WAIT_L(8); PG8_BAR; PG8_WAIT_L(0); PG8_MMA(0, 0, At, B0); PG8_BAR; PG8_SCHED;
            PG8_LDB(B1, 1, 1); PG8_STAGE(PG8_SB(1, 0), b3, voffB);
            PG8_BAR; PG8_WAIT_L(0); PG8_MMA(0, 1, At, B1); PG8_BAR;
            PG8_LDA(At, 1, 1); PG8_STAGE(PG8_SA(1, 0), a3, voffA);
            PG8_BAR; PG8_WAIT_L(0); PG8_MMA(1, 0, At, B0); PG8_BAR; PG8_SCHED;
            PG8_STAGE(PG8_SB(1, 1), b3 + hstep, voffB);
            PG8_WAIT_V(6); PG8_BAR; PG8_MMA(1, 1, At, B1); PG8_BAR;
            }
        }
        if constexpr (ALIGN_EPI) { if (wr == 0) PG8_BAR; }
        if constexpr (!Epi::AFTER_DRAIN) { E(acc, cur, wr, wc, fr, fq); S.done(cur); }
        if (!has_next) break;
#pragma unroll
        for (int a = 0; a < 2; ++a)
#pragma unroll
            for (int b = 0; b < 2; ++b)
#pragma unroll
                for (int m = 0; m < 4; ++m)
#pragma unroll
                    for (int n = 0; n < 2; ++n) acc[a][b][m][n] = (f32x4){0.f, 0.f, 0.f, 0.f};
        cur = nxt; cA = nA; cB = nB; ++ui;
        if constexpr (ALIGN_EPI) { if (wr == 1) PG8_BAR; }
    }
    PG8_WAIT_V(0);
    if constexpr (!ALIGN_EPI) { if (wr == 0) PG8_BAR; }
    PG8_BAR;
    if constexpr (Epi::AFTER_DRAIN) { E.fused(acc, cur, wr, wc, fr, fq, lds, wid, lane); S.done(cur); }
#undef PG8_SA
#undef PG8_SB
#undef PG8_STAGE
#undef PG8_LDA
#undef PG8_LDB
#undef PG8_MMA
#undef PG8_WAIT_V
#undef PG8_WAIT_L
#undef PG8_BAR
#undef PG8_SCHED
}
}

#ifndef S5_SIMPLE
#define S5_SIMPLE 0
#endif
#ifndef HG_SIMPLE
#define HG_SIMPLE 0
#endif
#ifndef REP0
#define REP0 1
#define REP1 1
#define REP2 1
#define REP3 1
#define REP4 1
#define REP6 1
#endif
#ifndef REP_S5
#define REP_S5 1
#endif
#ifndef REP_HGA
#define REP_HGA 1
#endif
#ifndef REP_HGC
#define REP_HGC 1
#endif
#ifndef MK_N_LAUNCHES
#define MK_N_LAUNCHES 1
#endif
constexpr int DM = 1024, PB_B = 8, PB_T = 2048, SB_B = 128, SB_T = 8;
constexpr int MP = PB_B * PB_T, MS = SB_B * SB_T, MTOK = MP + MS;
constexpr int S5W = 512, S5G = 32, S5C = 16, S5N = 64;
constexpr int HGW = 512, HD = 128, HH = 4;
constexpr int INC = 2560, DFF = 2816;
constexpr float EPS = 1e-6f;
constexpr int NPH = 8;
constexpr size_t O_Y = 0, O_PRE = (size_t)MTOK * DM, O_PIM = O_PRE + 16384, O_PHG = O_PIM + 16384, O_SRE = O_PHG + 524288, O_SIM = O_SRE + 262144, O_SHG = O_SIM + 262144;
constexpr size_t MiB = 1u << 20;
constexpr size_t WS_CTL = 0, WS_WIN = 2 * MiB, WS_WGLU = 7 * MiB, WS_WOUT = 8 * MiB, WS_WGU = 10 * MiB, WS_WD = 21 * MiB;
constexpr size_t WS_XN = 27 * MiB, WS_PB = 61 * MiB, WS_FZ = 129 * MiB, WS_ACT = 61 * MiB, WS_GY = 163 * MiB, WS_OH = 180 * MiB, WS_MIX = 197 * MiB, WS_END = 234 * MiB;
constexpr int PBW = 2048;
constexpr int LDS_BYTES = 147456;
constexpr int NWAVES = 8;
constexpr int CW_SS1 = 16384, CW_SS2 = 36864, CW_CNT = 57344, CW_CNTS = 61440;

#define GAS __attribute__((address_space(1)))
#define LAS __attribute__((address_space(3)))
typedef unsigned short bf16;
typedef unsigned v4u __attribute__((ext_vector_type(4)));
typedef unsigned v2u __attribute__((ext_vector_type(2)));
typedef float f32x4 __attribute__((ext_vector_type(4)));
#define LDS_WAIT() asm volatile("s_waitcnt lgkmcnt(0)" ::: "memory")
__device__ __forceinline__ unsigned f2bf(float f) { unsigned u = __builtin_bit_cast(unsigned, f); return (u + 0x7fffu + ((u >> 16) & 1u)) >> 16; }
__device__ __forceinline__ unsigned pk2(float lo, float hi) { return f2bf(lo) | (f2bf(hi) << 16); }
__device__ __forceinline__ float bf2f(unsigned short h) { return __builtin_bit_cast(float, (unsigned)h << 16); }
__device__ __forceinline__ float bflo(unsigned w) { return __builtin_bit_cast(float, w << 16); }
__device__ __forceinline__ float bfhi(unsigned w) { return __builtin_bit_cast(float, w & 0xffff0000u); }
__device__ __forceinline__ float sigmoidf_(float x) { return 1.0f / (1.0f + __expf(-x)); }
__device__ __forceinline__ float siluf_(float x) { return x / (1.0f + __expf(-x)); }
__device__ __forceinline__ float gelu_tanh(float x) { const float z = 1.5957691216057308f * (x + 0.044715f * x * x * x); return x / (1.0f + __expf(-z)); }
__device__ __forceinline__ float wave_sum(float v) {
#pragma unroll
    for (int o = 1; o < 64; o <<= 1) v += __shfl_xor(v, o);
    return v;
}

struct Args { const float* in[24]; float* out; unsigned char* ws; int ph_lo, ph_hi; };

struct Frame {
    LAS unsigned char* lds;
    int tid, lane, wave, G, bid;
    const float* in[24];
    float* out; unsigned char* ws;
};
__device__ __forceinline__ const float* xrow(const Frame& F, int m) { return m < MP ? F.in[0] + (size_t)m * DM : F.in[1] + (size_t)(m - MP) * DM; }

__device__ __forceinline__ void transpose_item(const float* W, int ldw, bf16* WT, int K, int k0, int sn0, int dn0, LAS float* scr, int lane) {
#pragma unroll 8
    for (int i = 0; i < 32; ++i) { const int kk = 2 * i + (lane >> 5); scr[kk * 33 + (lane & 31)] = W[(size_t)(k0 + kk) * ldw + sn0 + (lane & 31)]; }
    LDS_WAIT(); asm volatile("" ::: "memory");
    const int c = lane & 7;
#pragma unroll
    for (int j = 0; j < 4; ++j) { const int n = (lane >> 3) + 8 * j; const LAS float* s = scr + (8 * c) * 33 + n;
        v4u o; o.x = pk2(s[0 * 33], s[1 * 33]); o.y = pk2(s[2 * 33], s[3 * 33]); o.z = pk2(s[4 * 33], s[5 * 33]); o.w = pk2(s[6 * 33], s[7 * 33]);
        *(GAS v4u*)(WT + (size_t)(dn0 + n) * K + k0 + 8 * c) = o; }
    LDS_WAIT(); asm volatile("" ::: "memory");
}
__device__ __forceinline__ void rms_row_bf16(const float* xr_, const float* gain, bf16* orow, int lane) {
    const GAS f32x4* xr = (const GAS f32x4*)xr_ + lane;
    f32x4 v[4]; float s = 0.f;
#pragma unroll
    for (int j = 0; j < 4; ++j) { v[j] = xr[64 * j]; s += (v[j].x * v[j].x + v[j].y * v[j].y) + (v[j].z * v[j].z + v[j].w * v[j].w); }
    const float rstd = 1.0f / sqrtf(wave_sum(s) * (1.0f / DM) + EPS);
    GAS v2u* o8 = (GAS v2u*)orow + lane;
#pragma unroll
    for (int j = 0; j < 4; ++j) { const f32x4 g = ((const GAS f32x4*)gain)[lane + 64 * j]; v2u w; w.x = pk2(v[j].x * rstd * g.x, v[j].y * rstd * g.y); w.y = pk2(v[j].z * rstd * g.z, v[j].w * rstd * g.w); o8[64 * j] = w; }
}

__device__ __forceinline__ void s5_tables_item(Frame& F, int item);
__device__ __forceinline__ void p0_prologue(Frame& F) {
    for (int it = F.bid; it < 256; it += F.G) s5_tables_item(F, it);
    LAS float* scr = (LAS float*)(F.lds + F.wave * 16384);
    const int gw = F.bid * NWAVES + F.wave, NGW = F.G * NWAVES;
    bf16* WinT = (bf16*)(F.ws + WS_WIN); bf16* WgluT = (bf16*)(F.ws + WS_WGLU); bf16* WoutT = (bf16*)(F.ws + WS_WOUT); bf16* WguT = (bf16*)(F.ws + WS_WGU); bf16* WdT = (bf16*)(F.ws + WS_WD);
    constexpr int I_IN = (DM / 64) * (INC / 32), I_GLU = (S5W / 64) * (S5W / 32), I_OUT = (DM / 64) * (DM / 32), I_G = (DM / 64) * (DFF / 32), I_D = (DFF / 64) * (DM / 32);
    constexpr int NITEMS = I_IN + I_GLU + I_OUT + 2 * I_G + I_D;
    for (int it = gw; it < NITEMS; it += NGW) {
        int r = it;
        if (r < I_IN) { const int nblk = INC / 32, kb = r / nblk, nb = r % nblk, sn0 = nb * 32; const int seg = sn0 / 512, off = sn0 % 512;
            const int dseg = seg == 0 ? 0 : seg == 1 ? 1 : seg == 2 ? 4 : seg == 3 ? 2 : 3;
            transpose_item(F.in[7], INC, WinT, DM, kb * 64, sn0, dseg * 512 + off, scr, F.lane); continue; } r -= I_IN;
        if (r < I_GLU) { const int nblk = S5W / 32, kb = r / nblk, nb = r % nblk; transpose_item(F.in[16], S5W, WgluT, S5W, kb * 64, nb * 32, nb * 32, scr, F.lane); continue; } r -= I_GLU;
        if (r < I_OUT) { const int nblk = DM / 32, kb = r / nblk, nb = r % nblk; transpose_item(F.in[18], DM, WoutT, DM, kb * 64, nb * 32, nb * 32, scr, F.lane); continue; } r -= I_OUT;
        if (r < I_G) { const int nblk = DFF / 32, kb = r / nblk, nb = r % nblk, sn0 = nb * 32; transpose_item(F.in[20], DFF, WguT, DM, kb * 64, sn0, 256 * (sn0 / 128) + (sn0 % 128), scr, F.lane); continue; } r -= I_G;
        if (r < I_G) { const int nblk = DFF / 32, kb = r / nblk, nb = r % nblk, sn0 = nb * 32; transpose_item(F.in[21], DFF, WguT, DM, kb * 64, sn0, 256 * (sn0 / 128) + 128 + (sn0 % 128), scr, F.lane); continue; } r -= I_G;
        { const int nblk = DM / 32, kb = r / nblk, nb = r % nblk; transpose_item(F.in[22], DM, WdT, DFF, kb * 64, nb * 32, nb * 32, scr, F.lane); }
    }
    bf16* XN = (bf16*)(F.ws + WS_XN);
    for (int m = gw; m < MTOK; m += NGW) rms_row_bf16(xrow(F, m), F.in[6], XN + (size_t)m * DM, F.lane);
}

using pg8::Unit; using pg8::u32x4; using pg8::cvt_pk_bf16; using pg8::BM; using pg8::HALF;
struct EpiIn {
    static constexpr bool PERM = true, AFTER_DRAIN = false;
    bf16* PB; float* FZ; bf16* U5;
    __device__ __forceinline__ void operator()(const pg8::f32x4 (&acc)[2][2][4][2], const Unit& u, int wr, int wc, int fr, int fq) const {
        const int row0 = u.pm * BM + wr * 64 + fr;
        if (u.pn < 2) { const int col0 = u.pn * BM + wc * 32 + 8 * fq;
#pragma unroll
            for (int ai = 0; ai < 2; ++ai)
#pragma unroll
                for (int m = 0; m < 4; ++m) { const size_t r = (size_t)(row0 + ai * HALF + m * 16);
#pragma unroll
                    for (int bj = 0; bj < 2; ++bj) { const int col = col0 + bj * HALF; const pg8::f32x4 v0 = acc[ai][bj][m][0], v1 = acc[ai][bj][m][1]; u32x4 w; w.x = cvt_pk_bf16(v0[0], v0[1]); w.y = cvt_pk_bf16(v0[2], v0[3]); w.z = cvt_pk_bf16(v1[0], v1[1]); w.w = cvt_pk_bf16(v1[2], v1[3]);
                        *(u32x4*)(U5 + ((size_t)(col >> 4) * MTOK + r) * 16 + (col & 15)) = w; } }
        } else if (u.pn < 8) { const int col0 = u.pn * BM + wc * 32 + 8 * fq;
#pragma unroll
            for (int ai = 0; ai < 2; ++ai)
#pragma unroll
                for (int m = 0; m < 4; ++m) { bf16* rowp = PB + (size_t)(row0 + ai * HALF + m * 16) * PBW + col0;
#pragma unroll
                    for (int bj = 0; bj < 2; ++bj) { const pg8::f32x4 v0 = acc[ai][bj][m][0], v1 = acc[ai][bj][m][1]; u32x4 w; w.x = cvt_pk_bf16(v0[0], v0[1]); w.y = cvt_pk_bf16(v0[2], v0[3]); w.z = cvt_pk_bf16(v1[0], v1[1]); w.w = cvt_pk_bf16(v1[2], v1[3]);
                        *(u32x4*)(rowp + bj * HALF) = w; } }
        } else { const int col0 = (u.pn - 8) * BM + wc * 32 + 8 * fq;
#pragma unroll
            for (int ai = 0; ai < 2; ++ai)
#pragma unroll
                for (int m = 0; m < 4; ++m) { float* rowp = FZ + (size_t)(row0 + ai * HALF + m * 16) * 512 + col0;
#pragma unroll
                    for (int bj = 0; bj < 2; ++bj)
#pragma unroll
                        for (int n = 0; n < 2; ++n) *(pg8::f32x4*)(rowp + bj * HALF + 4 * n) = acc[ai][bj][m][n]; }
        }
    }
};
struct EpiGlu {
    static constexpr bool PERM = true, AFTER_DRAIN = false;
    const bf16* GY; bf16* MIX;
    __device__ __forceinline__ void operator()(const pg8::f32x4 (&acc)[2][2][4][2], const Unit& u, int wr, int wc, int fr, int fq) const {
        const int row0 = u.pm * BM + wr * 64 + fr, col0 = u.pn * BM + wc * 32 + 8 * fq;
#pragma unroll
        for (int ai = 0; ai < 2; ++ai)
#pragma unroll
            for (int m = 0; m < 4; ++m) { const size_t r = (size_t)(row0 + ai * HALF + m * 16);
#pragma unroll
                for (int bj = 0; bj < 2; ++bj) { const int col = col0 + bj * HALF; const u32x4 g = *(const u32x4*)(GY + ((size_t)(col >> 4) * MTOK + r) * 16 + (col & 15)); const pg8::f32x4 v0 = acc[ai][bj][m][0], v1 = acc[ai][bj][m][1];
                    u32x4 w; w.x = cvt_pk_bf16(bflo(g.x) * sigmoidf_(v0[0]), bfhi(g.x) * sigmoidf_(v0[1])); w.y = cvt_pk_bf16(bflo(g.y) * sigmoidf_(v0[2]), bfhi(g.y) * sigmoidf_(v0[3]));
                    w.z = cvt_pk_bf16(bflo(g.z) * sigmoidf_(v1[0]), bfhi(g.z) * sigmoidf_(v1[1])); w.w = cvt_pk_bf16(bflo(g.w) * sigmoidf_(v1[2]), bfhi(g.w) * sigmoidf_(v1[3]));
                    *(u32x4*)(MIX + r * DM + col0 + bj * HALF) = w; } }
    }
};
__device__ __forceinline__ float rstd_of(float ss) { return 1.0f / sqrtf(ss * (1.0f / DM) + EPS); }
__device__ __forceinline__ float atomic_read_f32(float* p) { return __hip_atomic_fetch_add(p, 0.0f, __ATOMIC_RELAXED, __HIP_MEMORY_SCOPE_AGENT); }
__device__ __forceinline__ void wait_count(unsigned* cnt, unsigned want) {
    for (unsigned sp = 0; sp < (1u << 22); ++sp) { if (__hip_atomic_load(cnt, __ATOMIC_RELAXED, __HIP_MEMORY_SCOPE_AGENT) >= want) break; __builtin_amdgcn_s_sleep(2); }
}
struct EpiOut {
    static constexpr bool PERM = true, AFTER_DRAIN = false;
    const float* xp; float* Y; bf16* XN; const float* gain; float* SS1;
    __device__ __forceinline__ void operator()(const pg8::f32x4 (&acc)[2][2][4][2], const Unit& u, int wr, int wc, int fr, int fq) const {
        const int row0 = u.pm * BM + wr * 64 + fr, col0 = u.pn * BM + wc * 32 + 8 * fq;
        pg8::f32x4 gn[2][2];
#pragma unroll
        for (int bj = 0; bj < 2; ++bj)
#pragma unroll
            for (int n = 0; n < 2; ++n) gn[bj][n] = *(const pg8::f32x4*)(gain + col0 + bj * HALF + 4 * n);
#pragma unroll
        for (int ai = 0; ai < 2; ++ai)
#pragma unroll
            for (int m = 0; m < 4; ++m) { const int row = row0 + ai * HALF + m * 16; const size_t off = (size_t)row * DM + col0; float ss = 0.f;
#pragma unroll
                for (int bj = 0; bj < 2; ++bj) { const pg8::f32x4 x0 = *(const pg8::f32x4*)(xp + off + bj * HALF) + acc[ai][bj][m][0], x1 = *(const pg8::f32x4*)(xp + off + bj * HALF + 4) + acc[ai][bj][m][1];
                    *(pg8::f32x4*)(Y + off + bj * HALF) = x0; *(pg8::f32x4*)(Y + off + bj * HALF + 4) = x1;
                    ss += (x0[0] * x0[0] + x0[1] * x0[1]) + (x0[2] * x0[2] + x0[3] * x0[3]) + (x1[0] * x1[0] + x1[1] * x1[1]) + (x1[2] * x1[2] + x1[3] * x1[3]);
                    const pg8::f32x4 h0 = x0 * gn[bj][0], h1 = x1 * gn[bj][1]; u32x4 w; w.x = cvt_pk_bf16(h0[0], h0[1]); w.y = cvt_pk_bf16(h0[2], h0[3]); w.z = cvt_pk_bf16(h1[0], h1[1]); w.w = cvt_pk_bf16(h1[2], h1[3]);
                    *(u32x4*)(XN + off + bj * HALF) = w; }
                ss += __shfl_xor(ss, 16); ss += __shfl_xor(ss, 32);
                if (fq == 0) __hip_atomic_fetch_add(SS1 + row, ss, __ATOMIC_RELAXED, __HIP_MEMORY_SCOPE_AGENT); }
    }
};
struct EpiAct {
    static constexpr bool PERM = true, AFTER_DRAIN = false;
    bf16* ACT; const float* SS1;
    __device__ __forceinline__ void operator()(const pg8::f32x4 (&acc)[2][2][4][2], const Unit& u, int wr, int wc, int fr, int fq) const {
        const int row0 = u.pm * BM + wr * 64 + fr, col0 = u.pn * HALF + wc * 32 + 8 * fq;
#pragma unroll
        for (int ai = 0; ai < 2; ++ai)
#pragma unroll
            for (int m = 0; m < 4; ++m) { const int row = row0 + ai * HALF + m * 16; const float rs = rstd_of(SS1[row]);
                const pg8::f32x4 g0 = acc[ai][0][m][0] * rs, g1 = acc[ai][0][m][1] * rs, u0 = acc[ai][1][m][0] * rs, u1 = acc[ai][1][m][1] * rs;
                u32x4 w; w.x = cvt_pk_bf16(siluf_(g0[0]) * u0[0], siluf_(g0[1]) * u0[1]); w.y = cvt_pk_bf16(siluf_(g0[2]) * u0[2], siluf_(g0[3]) * u0[3]);
                w.z = cvt_pk_bf16(siluf_(g1[0]) * u1[0], siluf_(g1[1]) * u1[1]); w.w = cvt_pk_bf16(siluf_(g1[2]) * u1[2], siluf_(g1[3]) * u1[3]);
                *(u32x4*)(ACT + (size_t)row * DFF + col0) = w; }
    }
};
struct EpiDown {
    static constexpr bool PERM = true, AFTER_DRAIN = false;
    float* Y; const float* gain; float* SS2; unsigned* cnt;
    __device__ __forceinline__ void operator()(pg8::f32x4 (&acc)[2][2][4][2], const Unit& u, int wr, int wc, int fr, int fq) const {
        const int row0 = u.pm * BM + wr * 64 + fr, col0 = u.pn * BM + wc * 32 + 8 * fq;
#pragma unroll
        for (int ai = 0; ai < 2; ++ai)
#pragma unroll
            for (int m = 0; m < 4; ++m) { const int row = row0 + ai * HALF + m * 16; const size_t off = (size_t)row * DM + col0; float ss = 0.f;
#pragma unroll
                for (int bj = 0; bj < 2; ++bj) { const pg8::f32x4 x0 = *(const pg8::f32x4*)(Y + off + bj * HALF) + acc[ai][bj][m][0], x1 = *(const pg8::f32x4*)(Y + off + bj * HALF + 4) + acc[ai][bj][m][1];
                    acc[ai][bj][m][0] = x0; acc[ai][bj][m][1] = x1;
                    ss += (x0[0] * x0[0] + x0[1] * x0[1]) + (x0[2] * x0[2] + x0[3] * x0[3]) + (x1[0] * x1[0] + x1[1] * x1[1]) + (x1[2] * x1[2] + x1[3] * x1[3]); }
                ss += __shfl_xor(ss, 16); ss += __shfl_xor(ss, 32);
                if (fq == 0) __hip_atomic_fetch_add(SS2 + row, ss, __ATOMIC_RELAXED, __HIP_MEMORY_SCOPE_AGENT); }
        asm volatile("s_waitcnt vmcnt(0)" ::: "memory");
        unsigned* c = cnt + 64 * u.pm;
        if (threadIdx.x % 64 == 0) __hip_atomic_fetch_add(c, 1u, __ATOMIC_RELAXED, __HIP_MEMORY_SCOPE_AGENT);
        wait_count(c, 32u);
        pg8::f32x4 gn[2][2];
#pragma unroll
        for (int bj = 0; bj < 2; ++bj)
#pragma unroll
            for (int n = 0; n < 2; ++n) gn[bj][n] = *(const pg8::f32x4*)(gain + col0 + bj * HALF + 4 * n);
        float rs[2][4];
#pragma unroll
        for (int ai = 0; ai < 2; ++ai)
#pragma unroll
            for (int m = 0; m < 4; ++m) { float s = 0.f; if (fq == 0) s = atomic_read_f32(SS2 + row0 + ai * HALF + m * 16); rs[ai][m] = rstd_of(__shfl(s, fr)); }
#pragma unroll
        for (int ai = 0; ai < 2; ++ai)
#pragma unroll
            for (int m = 0; m < 4; ++m) { const size_t off = (size_t)(row0 + ai * HALF + m * 16) * DM + col0;
#pragma unroll
                for (int bj = 0; bj < 2; ++bj) { *(pg8::f32x4*)(Y + off + bj * HALF) = acc[ai][bj][m][0] * rs[ai][m] * gn[bj][0]; *(pg8::f32x4*)(Y + off + bj * HALF + 4) = acc[ai][bj][m][1] * rs[ai][m] * gn[bj][1]; } }
    }
};

typedef float f32x16 __attribute__((ext_vector_type(16)));
typedef short s16x8 __attribute__((ext_vector_type(8)));
constexpr size_t WS_U5 = WS_OH, WS_T5 = 231 * MiB;
constexpr size_t T5_STRIDE = 73728, T5_VG = 32768, T5_KC = 65536;
constexpr int S5_LD = 136;
__device__ __forceinline__ void s5_tables_item(Frame& F, int item) {
    const int tid = F.tid, g = item >> 3, part = item & 7;
    LAS float* Pre = (LAS float*)F.lds; LAS float* Pim = Pre + 9 * 64; LAS float* Ff = Pim + 9 * 64;
    LAS float* Cre = Ff + 128, * Cim = Cre + 1024, * Bre = Cim + 1024, * Bim = Bre + 1024;
    if (tid < 64) { const int n = tid;
        const float a_re = F.in[8][g * S5N + n], a_im = F.in[9][g * S5N + n], dt = expf(F.in[10][g]);
        const float mag = expf(a_re * dt), ab_re = mag * cosf(a_im * dt), ab_im = mag * sinf(a_im * dt);
        const float den = a_re * a_re + a_im * a_im, nr = ab_re - 1.0f, ni = ab_im;
        Ff[n] = (nr * a_re + ni * a_im) / den; Ff[64 + n] = (ni * a_re - nr * a_im) / den;
        float pr = 1.f, pi = 0.f;
#pragma unroll
        for (int j = 0; j < 9; ++j) { Pre[j * 64 + n] = pr; Pim[j * 64 + n] = pi; const float t = pr * ab_re - pi * ab_im; pi = pr * ab_im + pi * ab_re; pr = t; }
    }
    __syncthreads();
#pragma unroll
    for (int i = 0; i < 2; ++i) { const int idx = tid + 512 * i;
        { const int c = idx >> 6, n = idx & 63; Cre[c * 64 + n] = F.in[13][(size_t)(g * 16 + c) * S5N + n]; Cim[c * 64 + n] = F.in[14][(size_t)(g * 16 + c) * S5N + n]; }
        { const int n = idx >> 4, c = idx & 15; const float br = F.in[11][(size_t)(g * S5N + n) * 16 + c], bi = F.in[12][(size_t)(g * S5N + n) * 16 + c], fr = Ff[n], fi = Ff[64 + n];
          Bre[n * 16 + c] = fr * br - fi * bi; Bim[n * 16 + c] = fr * bi + fi * br; } }
    __syncthreads();
    bf16* WG = (bf16*)(F.ws + WS_T5 + (size_t)g * T5_STRIDE); bf16* VG = (bf16*)(F.ws + WS_T5 + (size_t)g * T5_STRIDE + T5_VG); bf16* KC = (bf16*)(F.ws + WS_T5 + (size_t)g * T5_STRIDE + T5_KC);
    if (tid < 256) { const int j = part, c = tid >> 4, cp = tid & 15; float acc = 0.f;
#pragma unroll 4
        for (int n = 0; n < 64; ++n) { const float cr = Cre[c * 64 + n], ci = Cim[c * 64 + n], pr = Pre[j * 64 + n], pi = Pim[j * 64 + n];
            const float xr = cr * pr - ci * pi, xi = cr * pi + ci * pr; acc += xr * Bre[n * 16 + cp] - xi * Bim[n * 16 + cp]; }
        KC[j * 256 + tid] = (bf16)f2bf(acc);
    } else if (part == 0) KC[2048 + tid - 256] = 0;
#pragma unroll
    for (int i = 0; i < 4; ++i) { const int idx = tid + 512 * i, np = 16 * part + (idx >> 7), k = idx & 127, s = k >> 4, cp = k & 15, n = np & 63;
        const float pr = Pre[(7 - s) * 64 + n], pi = Pim[(7 - s) * 64 + n], br = Bre[n * 16 + cp], bi = Bim[n * 16 + cp];
        WG[np * 128 + k] = (bf16)f2bf(np < 64 ? pr * br - pi * bi : pr * bi + pi * br); }
#pragma unroll
    for (int i = 0; i < 4; ++i) { const int idx = tid + 512 * i, col = 16 * part + (idx >> 7), np = idx & 127, t = col >> 4, c = col & 15, n = np & 63;
        const float pr = Pre[(t + 1) * 64 + n], pi = Pim[(t + 1) * 64 + n], cr = Cre[c * 64 + n], ci = Cim[c * 64 + n];
        VG[col * 128 + np] = (bf16)f2bf(np < 64 ? cr * pr - ci * pi : -(cr * pi + ci * pr)); }
    __syncthreads();
}
constexpr int L5_WG = 0, L5_VG = 34816, L5_KC = 69632, L5_U = 74240, L5_HS = 91648, L5_HL = 109056, L5_L8 = 141824;
__device__ __forceinline__ void s5_item(Frame& F, int item) {
    const int tid = F.tid, lane = F.lane, wave = F.wave;
    const int g = item & 31, b8 = item >> 5;
    LAS bf16* WgT = (LAS bf16*)(F.lds + L5_WG); LAS bf16* VgT = (LAS bf16*)(F.lds + L5_VG); LAS bf16* Kc = (LAS bf16*)(F.lds + L5_KC);
    LAS bf16* Us = (LAS bf16*)(F.lds + L5_U); LAS bf16* HS = (LAS bf16*)(F.lds + L5_HS); LAS float* HL = (LAS float*)(F.lds + L5_HL); LAS float* L8 = (LAS float*)(F.lds + L5_L8);
    LAS bf16* YS = (LAS bf16*)(F.lds + L5_HL);
    const bf16* U5 = (const bf16*)(F.ws + WS_U5) + (size_t)g * MTOK * 16; bf16* GY = (bf16*)(F.ws + WS_GY) + (size_t)g * MTOK * 16;
    { const bf16* WG = (const bf16*)(F.ws + WS_T5 + (size_t)g * T5_STRIDE); const bf16* VG = WG + T5_VG / 2; const bf16* KC = WG + T5_KC / 2;
#pragma unroll
      for (int i = 0; i < 4; ++i) { const int p = tid + 512 * i, r = p >> 4, kg = (p & 15) * 8; *(LAS v4u*)(WgT + r * S5_LD + kg) = *(const v4u*)(WG + r * 128 + kg); *(LAS v4u*)(VgT + r * S5_LD + kg) = *(const v4u*)(VG + r * 128 + kg); }
      if (tid < 288) *(LAS v4u*)(Kc + tid * 8) = *(const v4u*)(KC + tid * 8); }
    float qr[9], qi[9];
    { const float a_re = F.in[8][g * S5N + lane], a_im = F.in[9][g * S5N + lane], dt = expf(F.in[10][g]);
      const float mag = expf(a_re * dt); float p8r = mag * cosf(a_im * dt), p8i = mag * sinf(a_im * dt);
#pragma unroll
      for (int i = 0; i < 3; ++i) { const float t = p8r * p8r - p8i * p8i; p8i = 2.0f * p8r * p8i; p8r = t; }
      qr[0] = 1.f; qi[0] = 0.f;
#pragma unroll
      for (int i = 1; i < 9; ++i) { qr[i] = qr[i - 1] * p8r - qi[i - 1] * p8i; qi[i] = qr[i - 1] * p8i + qi[i - 1] * p8r; } }
    const float dl = F.in[15][g * 16 + (lane & 15)];
    const int rb = wave >> 2, cb = wave & 3, r32 = lane & 31, hh = lane >> 5;
    float h_re = 0.f, h_im = 0.f;
    float sre[2], sim[2];
#pragma unroll
    for (int i = 0; i < 2; ++i) { const size_t idx = (size_t)((16 * b8 + 2 * wave + i) * S5G + g) * S5N + lane; sre[i] = F.in[2][idx]; sim[i] = F.in[3][idx]; }
    v4u un0, un1;
    { const v4u* src = (const v4u*)(U5 + (size_t)(b8 * PB_T) * 16); un0 = src[tid]; un1 = src[tid + 512]; }
    for (int seg = 0; seg < 5; ++seg) {
        const bool samp = (seg == 4);
        const int tok0 = samp ? MP + 128 * b8 : b8 * PB_T + seg * 512;
        { const int p0 = tid, p1 = tid + 512;
          *(LAS v4u*)(Us + (p0 >> 4) * S5_LD + ((p0 >> 1) & 7) * 16 + (p0 & 1) * 8) = un0; *(LAS v4u*)(Us + (p1 >> 4) * S5_LD + ((p1 >> 1) & 7) * 16 + (p1 & 1) * 8) = un1;
          if (seg < 3) { const v4u* src = (const v4u*)(U5 + (size_t)(b8 * PB_T + (seg + 1) * 512) * 16); un0 = src[tid]; un1 = src[tid + 512]; }
          else if (seg == 3) { const v4u* src = (const v4u*)(U5 + (size_t)(MP + 128 * b8) * 16); if (tid < 256) un0 = src[tid]; } }
        __syncthreads();
        { f32x16 acc = {};
#pragma unroll
          for (int s = 0; s < 8; ++s) { const s16x8 a = *(const LAS s16x8*)(Us + (32 * rb + r32) * S5_LD + s * 16 + 8 * hh); const s16x8 b = *(const LAS s16x8*)(WgT + (32 * cb + r32) * S5_LD + s * 16 + 8 * hh);
              acc = __builtin_amdgcn_mfma_f32_32x32x16_bf16(a, b, acc, 0, 0, 0); }
#pragma unroll
          for (int r = 0; r < 16; ++r) HL[(32 * rb + (r & 3) + 8 * (r >> 2) + 4 * hh) * 128 + 32 * cb + r32] = acc[r]; }
        __syncthreads();
        if (!samp) {
            float xr[8], xi[8], lr[9], li[9];
#pragma unroll
            for (int i = 0; i < 8; ++i) { xr[i] = HL[(8 * wave + i) * 128 + lane]; xi[i] = HL[(8 * wave + i) * 128 + 64 + lane]; }
            lr[0] = 0.f; li[0] = 0.f;
#pragma unroll
            for (int i = 0; i < 8; ++i) { lr[i + 1] = qr[1] * lr[i] - qi[1] * li[i] + xr[i]; li[i + 1] = qr[1] * li[i] + qi[1] * lr[i] + xi[i]; }
            L8[wave * 128 + lane] = lr[8]; L8[wave * 128 + 64 + lane] = li[8];
            __syncthreads();
            float cr = h_re, ci = h_im, mr = h_re, mi = h_im;
#pragma unroll
            for (int w = 0; w < 8; ++w) { const float tr = L8[w * 128 + lane], ti = L8[w * 128 + 64 + lane];
                const float nr = qr[8] * cr - qi[8] * ci + tr, ni = qr[8] * ci + qi[8] * cr + ti; cr = nr; ci = ni; if (w + 1 == wave) { mr = cr; mi = ci; } }
            h_re = cr; h_im = ci;
#pragma unroll
            for (int i = 0; i < 8; ++i) { const float sr = lr[i] + qr[i] * mr - qi[i] * mi, si = li[i] + qr[i] * mi + qi[i] * mr;
                HS[(8 * wave + i) * S5_LD + lane] = (bf16)f2bf(sr); HS[(8 * wave + i) * S5_LD + 64 + lane] = (bf16)f2bf(si); }
            if (seg == 3 && wave == 0) { F.out[O_PRE + (size_t)(b8 * S5G + g) * S5N + lane] = h_re; F.out[O_PIM + (size_t)(b8 * S5G + g) * S5N + lane] = h_im; }
        } else {
#pragma unroll
            for (int i = 0; i < 2; ++i) { const int r = 2 * wave + i; const size_t idx = (size_t)((16 * b8 + r) * S5G + g) * S5N + lane;
                HS[r * S5_LD + lane] = (bf16)f2bf(sre[i]); HS[r * S5_LD + 64 + lane] = (bf16)f2bf(sim[i]);
                F.out[O_SRE + idx] = qr[1] * sre[i] - qi[1] * sim[i] + HL[r * 128 + lane]; F.out[O_SIM + idx] = qr[1] * sim[i] + qi[1] * sre[i] + HL[r * 128 + 64 + lane]; }
        }
        __syncthreads();
        if (!(samp && rb == 1)) { f32x16 acc = {};
            const int tl = 2 * cb + ((lane >> 4) & 1), c = lane & 15;
#pragma unroll
            for (int s = 0; s < 8; ++s) if (s <= 2 * cb + 1) { const int j = tl - s, jj = j < 0 ? 8 : j;
                const s16x8 a = *(const LAS s16x8*)(Us + (32 * rb + r32) * S5_LD + s * 16 + 8 * hh); const s16x8 b = *(const LAS s16x8*)(Kc + (jj * 16 + c) * 16 + 8 * hh);
                acc = __builtin_amdgcn_mfma_f32_32x32x16_bf16(a, b, acc, 0, 0, 0); }
#pragma unroll
            for (int kb = 0; kb < 8; ++kb) { const s16x8 a = *(const LAS s16x8*)(HS + (32 * rb + r32) * S5_LD + kb * 16 + 8 * hh); const s16x8 b = *(const LAS s16x8*)(VgT + (32 * cb + r32) * S5_LD + kb * 16 + 8 * hh);
                acc = __builtin_amdgcn_mfma_f32_32x32x16_bf16(a, b, acc, 0, 0, 0); }
#pragma unroll
            for (int r = 0; r < 16; ++r) { const int row = 32 * rb + (r & 3) + 8 * (r >> 2) + 4 * hh;
                const float u = bf2f(Us[row * S5_LD + tl * 16 + c]); YS[row * 128 + 32 * cb + r32] = (bf16)f2bf(gelu_tanh(acc[r] + dl * u)); }
        }
        __syncthreads();
        { v4u* dst = (v4u*)(GY + (size_t)tok0 * 16);
          if (!samp) { dst[tid] = *(const LAS v4u*)(YS + tid * 8); dst[tid + 512] = *(const LAS v4u*)(YS + (tid + 512) * 8); }
          else if (tid < 256) dst[tid] = *(const LAS v4u*)(YS + tid * 8); }
        __syncthreads();
    }
}
typedef float f32x4v __attribute__((ext_vector_type(4)));
constexpr int HG_LDQ = 136, HG_LDT = 72;
constexpr size_t WS_DSC = WS_XN;
constexpr size_t WS_DEC = WS_CTL + 1 * MiB;
#define HG_GATES(NEEDQ) \
    float gl[16], kk[16], qq[16]; float run = 0.f; \
    _Pragma("unroll") for (int i = 0; i < 16; ++i) { const size_t tok = (size_t)(tok0 + 16 * tq + i); const float fz = FZ[tok * 512 + col]; if (NEEDQ) qq[i] = bf2f(PB[tok * PBW + 512 + col]); \
        const float sg = 1.0f / (1.0f + __expf(-fz)), f = lb + (1.0f - lb) * sg; kk[i] = 1.0f - f; run += __log2f(f); gl[i] = run; } \
    TOT[tq * 128 + ch] = run;
#define HG_VT_LOAD() \
    _Pragma("unroll") for (int i = 0; i < 2; ++i) { const int p = tid + 512 * i, vg = p >> 6, tk = p & 63; const v4u w = *(const v4u*)(PB + (size_t)(tok0 + tk) * PBW + 1024 + h * HD + vg * 8); \
        LAS bf16* d = Vt + (vg * 8) * HG_LDT + tk; d[0] = (bf16)(w.x & 0xffffu); d[HG_LDT] = (bf16)(w.x >> 16); d[2 * HG_LDT] = (bf16)(w.y & 0xffffu); d[3 * HG_LDT] = (bf16)(w.y >> 16); \
        d[4 * HG_LDT] = (bf16)(w.z & 0xffffu); d[5 * HG_LDT] = (bf16)(w.z >> 16); d[6 * HG_LDT] = (bf16)(w.w & 0xffffu); d[7 * HG_LDT] = (bf16)(w.w >> 16); }

constexpr int LA_KT = 0, LA_VT = 18432, LA_TOT = 36864;
__device__ __forceinline__ void hgA_item(Frame& F, int item) {
    const int tid = F.tid, lane = F.lane, wave = F.wave;
    const int bh = item >> 5, chunk = item & 31, b = bh >> 2, h = bh & 3, tok0 = b * PB_T + chunk * 64;
    LAS bf16* Kt = (LAS bf16*)(F.lds + LA_KT); LAS bf16* Vt = (LAS bf16*)(F.lds + LA_VT); LAS float* TOT = (LAS float*)(F.lds + LA_TOT);
    const bf16* PB = (const bf16*)(F.ws + WS_PB); const float* FZ = (const float*)(F.ws + WS_FZ);
    bf16* DSC = (bf16*)(F.ws + WS_DSC) + (size_t)item * HD * HD; float* DEC = (float*)(F.ws + WS_DEC) + (size_t)item * HD;
    const int ch = tid & 127, tq = tid >> 7, col = h * HD + ch;
    const float lb = 1.0f / (1.0f + expf(F.in[5][512 + col] - F.in[5][col]));
    HG_GATES(false)
    HG_VT_LOAD()
    __syncthreads();
    { const float t0 = TOT[ch], t1 = TOT[128 + ch], t2 = TOT[256 + ch], t3 = TOT[384 + ch];
      const float glast = (t0 + t1) + (t2 + t3), off = (tq == 0 ? 0.f : tq == 1 ? t0 : tq == 2 ? t0 + t1 : t0 + t1 + t2);
      unsigned kp[8];
#pragma unroll
      for (int i = 0; i < 16; ++i) { const unsigned kb = f2bf(kk[i] * __builtin_amdgcn_exp2f(glast - (off + gl[i]))); if (i & 1) kp[i >> 1] |= kb << 16; else kp[i >> 1] = kb; }
      LAS v4u* kd = (LAS v4u*)(Kt + ch * HG_LDT + 16 * tq); v4u a, c2; a.x = kp[0]; a.y = kp[1]; a.z = kp[2]; a.w = kp[3]; c2.x = kp[4]; c2.y = kp[5]; c2.z = kp[6]; c2.w = kp[7]; kd[0] = a; kd[1] = c2;
      if (tq == 0) DEC[ch] = __builtin_amdgcn_exp2f(glast); }
    __syncthreads();
    { const int r32 = lane & 31, hh = lane >> 5, kb = wave >> 1;
#pragma unroll
      for (int vbi = 0; vbi < 2; ++vbi) { const int vb = 2 * (wave & 1) + vbi; f32x16 acc = {};
#pragma unroll
          for (int ks = 0; ks < 4; ++ks) { const s16x8 a = *(const LAS s16x8*)(Kt + (32 * kb + r32) * HG_LDT + 16 * ks + 8 * hh); const s16x8 bb = *(const LAS s16x8*)(Vt + (32 * vb + r32) * HG_LDT + 16 * ks + 8 * hh);
              acc = __builtin_amdgcn_mfma_f32_32x32x16_bf16(a, bb, acc, 0, 0, 0); }
          bf16* dst = DSC + (size_t)(32 * vb + r32) * HD + 32 * kb + 4 * hh;
#pragma unroll
          for (int q = 0; q < 4; ++q) { v2u w; w.x = pk2(acc[4 * q], acc[4 * q + 1]); w.y = pk2(acc[4 * q + 2], acc[4 * q + 3]); *(v2u*)(dst + 8 * q) = w; } } }
    __syncthreads();
}
__device__ __forceinline__ void hg_scan(Frame& F) {
    bf16* DSC = (bf16*)(F.ws + WS_DSC); const float* DEC = (const float*)(F.ws + WS_DEC);
    for (int T = F.bid * 512 + F.tid; T < 32 * 4096; T += F.G * 512) {
        const int bh = T >> 12, e = T & 4095, v = e >> 5, k4 = (e & 31) * 4;
        f32x4 S = {0.f, 0.f, 0.f, 0.f};
#pragma unroll 1
        for (int c0 = 0; c0 < 32; c0 += 8) {
            v2u x[8]; f32x4 d[8];
#pragma unroll
            for (int c = 0; c < 8; ++c) { const size_t it = (size_t)(bh * 32 + c0 + c); x[c] = *(const v2u*)(DSC + (it * HD + v) * HD + k4); d[c] = *(const f32x4*)(DEC + it * HD + k4); }
#pragma unroll
            for (int c = 0; c < 8; ++c) { const size_t it = (size_t)(bh * 32 + c0 + c); v2u o; o.x = pk2(S.x, S.y); o.y = pk2(S.z, S.w); *(v2u*)(DSC + (it * HD + v) * HD + k4) = o;
                S.x = d[c].x * S.x + bflo(x[c].x); S.y = d[c].y * S.y + bfhi(x[c].x); S.z = d[c].z * S.z + bflo(x[c].y); S.w = d[c].w * S.w + bfhi(x[c].y); }
        }
        float* o = F.out + O_PHG + (size_t)bh * HD * HD + (size_t)k4 * HD + v;
        o[0] = S.x; o[HD] = S.y; o[2 * HD] = S.z; o[3 * HD] = S.w;
    }
}
constexpr int LC_QS = 0, LC_QH = 17408, LC_KS = 34816, LC_VT = 52224, LC_AT = 70656, LC_SC = 79872, LC_TOT = 114688, LC_SS = 116736;
__device__ __forceinline__ void hgC_item(Frame& F, int item) {
    const int tid = F.tid, lane = F.lane, wave = F.wave;
    const int bh = item >> 5, chunk = item & 31, b = bh >> 2, h = bh & 3, tok0 = b * PB_T + chunk * 64;
    LAS bf16* Qs = (LAS bf16*)(F.lds + LC_QS); LAS bf16* Qh = (LAS bf16*)(F.lds + LC_QH); LAS bf16* Ks = (LAS bf16*)(F.lds + LC_KS); LAS bf16* Vt = (LAS bf16*)(F.lds + LC_VT);
    LAS bf16* At = (LAS bf16*)(F.lds + LC_AT); LAS bf16* SC = (LAS bf16*)(F.lds + LC_SC); LAS float* TOT = (LAS float*)(F.lds + LC_TOT); LAS float* SS = (LAS float*)(F.lds + LC_SS);
    const bf16* PB = (const bf16*)(F.ws + WS_PB); const float* FZ = (const float*)(F.ws + WS_FZ); bf16* MIX = (bf16*)(F.ws + WS_MIX);
    const bf16* DSC = (const bf16*)(F.ws + WS_DSC) + (size_t)item * HD * HD;
    const int ch = tid & 127, tq = tid >> 7, col = h * HD + ch;
    const float lb = 1.0f / (1.0f + expf(F.in[5][512 + col] - F.in[5][col]));
#pragma unroll
    for (int i = 0; i < 4; ++i) { const int p = tid + 512 * i, v = p >> 4, kg = (p & 15) * 8; *(LAS v4u*)(SC + v * HG_LDQ + kg) = *(const v4u*)(DSC + (size_t)v * HD + kg); }
    HG_GATES(true)
    HG_VT_LOAD()
    __syncthreads();
    { const float t0 = TOT[ch], t1 = TOT[128 + ch], t2 = TOT[256 + ch];
      const float gref = t0 + t1, off = (tq == 0 ? 0.f : tq == 1 ? t0 : tq == 2 ? gref : gref + t2);
#pragma unroll
      for (int i = 0; i < 16; ++i) { const float G = off + gl[i], e1 = __builtin_amdgcn_exp2f(G - gref), e2 = __builtin_amdgcn_rcpf(e1), e3 = __builtin_amdgcn_exp2f(G);
          Qs[(16 * tq + i) * HG_LDQ + ch] = (bf16)f2bf(qq[i] * e1); Ks[(16 * tq + i) * HG_LDQ + ch] = (bf16)f2bf(kk[i] * e2); Qh[(16 * tq + i) * HG_LDQ + ch] = (bf16)f2bf(qq[i] * e3); } }
    __syncthreads();
    const int r32 = lane & 31, hh = lane >> 5;
    if (wave < 4) { const int tb = wave >> 1, sb = wave & 1; f32x16 acc = {};
        if (sb <= tb) {
#pragma unroll
            for (int ks = 0; ks < 8; ++ks) { const s16x8 a = *(const LAS s16x8*)(Qs + (32 * tb + r32) * HG_LDQ + 16 * ks + 8 * hh); const s16x8 bb = *(const LAS s16x8*)(Ks + (32 * sb + r32) * HG_LDQ + 16 * ks + 8 * hh);
                acc = __builtin_amdgcn_mfma_f32_32x32x16_bf16(a, bb, acc, 0, 0, 0); } }
        const int s = 32 * sb + r32;
#pragma unroll
        for (int r = 0; r < 16; ++r) { const int t = 32 * tb + (r & 3) + 8 * (r >> 2) + 4 * hh; At[t * HG_LDT + s] = (s <= t) ? (bf16)f2bf(acc[r]) : (bf16)0; } }
    __syncthreads();
    const int tb = wave >> 2, vb = wave & 3, t = 32 * tb + r32;
    v2u og[4];
#pragma unroll
    for (int q = 0; q < 4; ++q) og[q] = *(const v2u*)(PB + (size_t)(tok0 + t) * PBW + 1536 + h * HD + 32 * vb + 8 * q + 4 * hh);
    f32x16 acc = {};
#pragma unroll
    for (int ks = 0; ks < 4; ++ks) if (ks < 2 * tb + 2) { const s16x8 a = *(const LAS s16x8*)(Vt + (32 * vb + r32) * HG_LDT + 16 * ks + 8 * hh); const s16x8 bb = *(const LAS s16x8*)(At + t * HG_LDT + 16 * ks + 8 * hh);
        acc = __builtin_amdgcn_mfma_f32_32x32x16_bf16(a, bb, acc, 0, 0, 0); }
#pragma unroll
    for (int ks = 0; ks < 8; ++ks) { const s16x8 a = *(const LAS s16x8*)(SC + (32 * vb + r32) * HG_LDQ + 16 * ks + 8 * hh); const s16x8 bb = *(const LAS s16x8*)(Qh + t * HG_LDQ + 16 * ks + 8 * hh);
        acc = __builtin_amdgcn_mfma_f32_32x32x16_bf16(a, bb, acc, 0, 0, 0); }
    { float ss = 0.f;
#pragma unroll
      for (int r = 0; r < 16; ++r) ss += acc[r] * acc[r];
      ss += __shfl_xor(ss, 32);
      if (hh == 0) SS[t * 4 + vb] = ss; }
    __syncthreads();
    { const f32x4 s4 = *(const LAS f32x4*)(SS + t * 4); const float rstd = 1.0f / sqrtf(((s4.x + s4.y) + (s4.z + s4.w)) * (1.0f / HD) + EPS);
#pragma unroll
      for (int q = 0; q < 4; ++q) { const int v0 = 32 * vb + 8 * q + 4 * hh; const f32x4 gn = *(const GAS f32x4*)(F.in[17] + v0);
          v2u w; w.x = pk2(acc[4 * q] * rstd * gn.x * siluf_(bflo(og[q].x)), acc[4 * q + 1] * rstd * gn.y * siluf_(bfhi(og[q].x)));
          w.y = pk2(acc[4 * q + 2] * rstd * gn.z * siluf_(bflo(og[q].y)), acc[4 * q + 3] * rstd * gn.w * siluf_(bfhi(og[q].y)));
          *(v2u*)(MIX + (size_t)(tok0 + t) * DM + 512 + h * HD + v0) = w; } }
    __syncthreads();
}
constexpr int LX_Q = 0, LX_K2 = 4096, LX_K3 = 8192, LX_V = 12288, LX_DEC = 16384, LX_ATT = 16896, LX_OP = 17152, LX_OT = 33536;
__device__ __forceinline__ void hgrn_sample_item(Frame& F, int idx) {
    const int tid = F.tid, b = idx >> 2, h = idx & 3;
    LAS float* Qs = (LAS float*)(F.lds + LX_Q); LAS float* K2 = (LAS float*)(F.lds + LX_K2); LAS float* K3 = (LAS float*)(F.lds + LX_K3); LAS float* Vs = (LAS float*)(F.lds + LX_V);
    LAS float* DEC = (LAS float*)(F.lds + LX_DEC); LAS float* ATT = (LAS float*)(F.lds + LX_ATT); LAS float* OP = (LAS float*)(F.lds + LX_OP); LAS float* OT = (LAS float*)(F.lds + LX_OT);
    const bf16* PB = (const bf16*)(F.ws + WS_PB); const float* FZ = (const float*)(F.ws + WS_FZ); bf16* MIX = (bf16*)(F.ws + WS_MIX);
    const float* S0 = F.in[4] + (size_t)idx * HD * HD; float* Sout = F.out + O_SHG + (size_t)idx * HD * HD;
    const int tok0 = MP + b * SB_T;
    const int v = tid & 127, kq = tid >> 7;
    float s0[32];
#pragma unroll
    for (int j = 0; j < 32; ++j) s0[j] = S0[(size_t)(32 * kq + j) * HD + v];
    if (tid < 128) { const int col = h * HD + tid; const float lb = 1.0f / (1.0f + expf(F.in[5][512 + col] - F.in[5][col]));
        float gl[8], kk[8], qq[8]; float run = 0.f;
#pragma unroll
        for (int t = 0; t < 8; ++t) { const size_t tok = (size_t)(tok0 + t); const float fz = FZ[tok * 512 + col]; qq[t] = bf2f(PB[tok * PBW + 512 + col]);
            const float sg = 1.0f / (1.0f + __expf(-fz)), f = lb + (1.0f - lb) * sg; kk[t] = 1.0f - f; run += __log2f(f); gl[t] = run; }
#pragma unroll
        for (int t = 0; t < 8; ++t) { Qs[t * 128 + tid] = qq[t] * __builtin_amdgcn_exp2f(gl[t]); K2[t * 128 + tid] = kk[t] * __builtin_amdgcn_exp2f(-gl[t]); K3[t * 128 + tid] = kk[t] * __builtin_amdgcn_exp2f(run - gl[t]); }
        DEC[tid] = __builtin_amdgcn_exp2f(run);
    } else if (tid < 256) { const int vv = tid - 128;
#pragma unroll
        for (int t = 0; t < 8; ++t) Vs[t * 128 + vv] = bf2f(PB[(size_t)(tok0 + t) * PBW + 1024 + h * HD + vv]);
    }
    __syncthreads();
    { const int p = tid >> 3, part = tid & 7, t = p >> 3, s = p & 7; float a = 0.f;
#pragma unroll
      for (int j = 0; j < 16; ++j) a += Qs[t * 128 + part + 8 * j] * K2[s * 128 + part + 8 * j];
      a += __shfl_xor(a, 1); a += __shfl_xor(a, 2); a += __shfl_xor(a, 4);
      if (part == 0) ATT[p] = (s <= t) ? a : 0.f; }
    float vr[8], o[8];
#pragma unroll
    for (int t = 0; t < 8; ++t) { vr[t] = Vs[t * 128 + v]; o[t] = 0.f; }
#pragma unroll
    for (int j = 0; j < 32; ++j) { const int k = 32 * kq + j; const float sv = s0[j]; float sn = DEC[k] * sv;
#pragma unroll
        for (int t = 0; t < 8; ++t) { o[t] += Qs[t * 128 + k] * sv; sn += K3[t * 128 + k] * vr[t]; }
        Sout[(size_t)k * HD + v] = sn; }
#pragma unroll
    for (int t = 0; t < 8; ++t) OP[(kq * 8 + t) * 128 + v] = o[t];
    __syncthreads();
#pragma unroll
    for (int r = 0; r < 2; ++r) { const int e = tid + 512 * r, t = e >> 7, vv = e & 127;
        float acc = (OP[(0 * 8 + t) * 128 + vv] + OP[(1 * 8 + t) * 128 + vv]) + (OP[(2 * 8 + t) * 128 + vv] + OP[(3 * 8 + t) * 128 + vv]);
#pragma unroll
        for (int s = 0; s < 8; ++s) acc += ATT[t * 8 + s] * Vs[s * 128 + vv];
        OT[t * 128 + vv] = acc; }
    __syncthreads();
    { const int t = F.wave, lane = F.lane; const float o0 = OT[t * 128 + 2 * lane], o1 = OT[t * 128 + 2 * lane + 1];
      const float rstd = 1.0f / sqrtf(wave_sum(o0 * o0 + o1 * o1) * (1.0f / HD) + EPS);
      const unsigned gw2 = *(const unsigned*)(PB + (size_t)(tok0 + t) * PBW + 1536 + h * HD + 2 * lane);
      const float g0 = F.in[17][2 * lane], g1 = F.in[17][2 * lane + 1];
      *(unsigned*)(MIX + (size_t)(tok0 + t) * DM + 512 + h * HD + 2 * lane) = pk2(o0 * rstd * g0 * siluf_(bflo(gw2)), o1 * rstd * g1 * siluf_(bfhi(gw2))); }
    __syncthreads();
}
constexpr int SG_LD = 68;
template <int KSTEPS  >
__device__ __forceinline__ void small_gemm_tile(Frame& F, const bf16* A, int lda, const bf16* Bt, int K, int r0, int c0, float (&v)[8]) {
    const int lane = F.lane, wave = F.wave, fr = lane & 15, fq = lane >> 4;
    f32x4v acc[4][4];
#pragma unroll
    for (int a = 0; a < 4; ++a)
#pragma unroll
        for (int b = 0; b < 4; ++b) acc[a][b] = (f32x4v){0.f, 0.f, 0.f, 0.f};
    const bf16* ap = A + (size_t)(r0 + fr) * lda + wave * (KSTEPS * 32) + 8 * fq;
    const bf16* bp = Bt + (size_t)(c0 + fr) * K + wave * (KSTEPS * 32) + 8 * fq;
#pragma unroll 2
    for (int ks = 0; ks < KSTEPS; ++ks) {
        s16x8 af[4], bf[4];
#pragma unroll
        for (int i = 0; i < 4; ++i) { af[i] = *(const s16x8*)(ap + (size_t)(16 * i) * lda + 32 * ks); bf[i] = *(const s16x8*)(bp + (size_t)(16 * i) * K + 32 * ks); }
#pragma unroll
        for (int a = 0; a < 4; ++a)
#pragma unroll
            for (int b = 0; b < 4; ++b) acc[a][b] = __builtin_amdgcn_mfma_f32_16x16x32_bf16(bf[b], af[a], acc[a][b], 0, 0, 0);
    }
    LAS float* part = (LAS float*)F.lds + wave * (64 * SG_LD);
#pragma unroll
    for (int a = 0; a < 4; ++a)
#pragma unroll
        for (int b = 0; b < 4; ++b) *(LAS f32x4v*)(part + (16 * a + fr) * SG_LD + 16 * b + 4 * fq) = acc[a][b];
    __syncthreads();
    { const int row = F.tid >> 3, cg8 = (F.tid & 7) * 8; const LAS float* p = (const LAS float*)F.lds + row * SG_LD + cg8;
      f32x4v s0 = {0.f, 0.f, 0.f, 0.f}, s1 = {0.f, 0.f, 0.f, 0.f};
#pragma unroll
      for (int w = 0; w < 8; ++w) { s0 += *(const LAS f32x4v*)(p + w * (64 * SG_LD)); s1 += *(const LAS f32x4v*)(p + w * (64 * SG_LD) + 4); }
      v[0] = s0[0]; v[1] = s0[1]; v[2] = s0[2]; v[3] = s0[3]; v[4] = s1[0]; v[5] = s1[1]; v[6] = s1[2]; v[7] = s1[3]; }
    __syncthreads();
}

__device__ __forceinline__ void outproj_sample_tile(Frame& F, int tile) {
    const int rm = tile >> 4, cn = tile & 15; float v[8];
    small_gemm_tile<4>(F, (const bf16*)(F.ws + WS_MIX), DM, (const bf16*)(F.ws + WS_WOUT), DM, MP + 64 * rm, 64 * cn, v);
    const int row = MP + 64 * rm + (F.tid >> 3), col = 64 * cn + 8 * (F.tid & 7); const size_t off = (size_t)row * DM + col;
    const float* xs = F.in[1] + (size_t)(row - MP) * DM + col; float* Y = F.out + O_Y; bf16* XN = (bf16*)(F.ws + WS_XN); float* SS1 = (float*)(F.ws + WS_CTL) + CW_SS1;
    const f32x4v xa = *(const f32x4v*)xs, xb = *(const f32x4v*)(xs + 4), ga = *(const f32x4v*)(F.in[19] + col), gb = *(const f32x4v*)(F.in[19] + col + 4);
    const f32x4v x0 = {xa[0] + v[0], xa[1] + v[1], xa[2] + v[2], xa[3] + v[3]}, x1 = {xb[0] + v[4], xb[1] + v[5], xb[2] + v[6], xb[3] + v[7]};
    *(f32x4v*)(Y + off) = x0; *(f32x4v*)(Y + off + 4) = x1;
    v4u w; w.x = pk2(x0[0] * ga[0], x0[1] * ga[1]); w.y = pk2(x0[2] * ga[2], x0[3] * ga[3]); w.z = pk2(x1[0] * gb[0], x1[1] * gb[1]); w.w = pk2(x1[2] * gb[2], x1[3] * gb[3]);
    *(v4u*)(XN + off) = w;
    float ss = (x0[0] * x0[0] + x0[1] * x0[1]) + (x0[2] * x0[2] + x0[3] * x0[3]) + (x1[0] * x1[0] + x1[1] * x1[1]) + (x1[2] * x1[2] + x1[3] * x1[3]);
    ss += __shfl_xor(ss, 1); ss += __shfl_xor(ss, 2); ss += __shfl_xor(ss, 4);
    if ((F.tid & 7) == 0) __hip_atomic_fetch_add(SS1 + row, ss, __ATOMIC_RELAXED, __HIP_MEMORY_SCOPE_AGENT);
}
__device__ __forceinline__ void down_sample_tile(Frame& F, int tile) {
    const int rm = tile >> 4, cn = tile & 15; float v[8];
    small_gemm_tile<11>(F, (const bf16*)(F.ws + WS_ACT), DFF, (const bf16*)(F.ws + WS_WD), DFF, MP + 64 * rm, 64 * cn, v);
    const int row = MP + 64 * rm + (F.tid >> 3), col = 64 * cn + 8 * (F.tid & 7); const size_t off = (size_t)row * DM + col;
    float* Y = F.out + O_Y; float* SS2 = (float*)(F.ws + WS_CTL) + CW_SS2; unsigned* cnt = (unsigned*)(F.ws + WS_CTL) + CW_CNTS + 64 * rm;
    const f32x4v xa = *(const f32x4v*)(Y + off), xb = *(const f32x4v*)(Y + off + 4), ga = *(const f32x4v*)(F.in[23] + col), gb = *(const f32x4v*)(F.in[23] + col + 4);
    const f32x4v x0 = {xa[0] + v[0], xa[1] + v[1], xa[2] + v[2], xa[3] + v[3]}, x1 = {xb[0] + v[4], xb[1] + v[5], xb[2] + v[6], xb[3] + v[7]};
    float ss = (x0[0] * x0[0] + x0[1] * x0[1]) + (x0[2] * x0[2] + x0[3] * x0[3]) + (x1[0] * x1[0] + x1[1] * x1[1]) + (x1[2] * x1[2] + x1[3] * x1[3]);
    ss += __shfl_xor(ss, 1); ss += __shfl_xor(ss, 2); ss += __shfl_xor(ss, 4);
    if ((F.tid & 7) == 0) __hip_atomic_fetch_add(SS2 + row, ss, __ATOMIC_RELAXED, __HIP_MEMORY_SCOPE_AGENT);
    asm volatile("s_waitcnt vmcnt(0)" ::: "memory");
    __syncthreads();
    if (F.tid == 0) { __hip_atomic_fetch_add(cnt, 1u, __ATOMIC_RELAXED, __HIP_MEMORY_SCOPE_AGENT); wait_count(cnt, 16u); }
    __syncthreads();
    float s = 0.f; if ((F.tid & 7) == 0) s = atomic_read_f32(SS2 + row);
    const float rs = rstd_of(__shfl(s, F.lane & ~7));
    *(f32x4v*)(Y + off) = (f32x4v){x0[0] * rs * ga[0], x0[1] * rs * ga[1], x0[2] * rs * ga[2], x0[3] * rs * ga[3]};
    *(f32x4v*)(Y + off + 4) = (f32x4v){x1[0] * rs * gb[0], x1[1] * rs * gb[1], x1[2] * rs * gb[2], x1[3] * rs * gb[3]};
}
typedef GAS unsigned gu32;
#define RLX_AGENT __ATOMIC_RELAXED, __HIP_MEMORY_SCOPE_AGENT
constexpr int MISC_OFF = LDS_BYTES - 512;
constexpr int CW_QUEUE = 8192;
constexpr int CW_BAR = 4096;
constexpr size_t CTL_ZERO_BYTES = 262144;
#define XB_TMO      128
#define XB_XCNT(j)  (256  + 64 * (j))
#define XB_XSUB(j)  (1280 + 64 * (j))
#define XB_XGEN(j)  (2304 + 64 * (j))
#define XB_TOP      3328
#define XB_TOPGEN   3392
#define XCD_BAR_WORDS 3456
#define XB_SPIN_CAP (1u << 18)

__device__ __forceinline__ unsigned xb_ld(unsigned* p)              { return __hip_atomic_load(p, __ATOMIC_RELAXED, __HIP_MEMORY_SCOPE_AGENT); }
__device__ __forceinline__ unsigned xb_add(unsigned* p, unsigned v) { return __hip_atomic_fetch_add(p, v, __ATOMIC_RELAXED, __HIP_MEMORY_SCOPE_AGENT); }
__device__ __forceinline__ unsigned xb_xcc_id() { return (unsigned)__builtin_amdgcn_s_getreg((3 << 11) | 20) & 0xFu; }
#define XB_SPIN(cond, bar) do { unsigned _sp = 0; while (cond) { __builtin_amdgcn_s_sleep(1); \
    if ((++_sp & 255u) == 0u) { if (xb_ld(&(bar)[XB_TMO])) break; if (_sp > XB_SPIN_CAP) { atomicAdd(&(bar)[XB_TMO], 1u); break; } } } } while (0)

struct XcdBarrier {
    unsigned* bar; unsigned x;
    volatile LAS unsigned* st;
};

__device__ __forceinline__ XcdBarrier xcd_barrier_post(unsigned* bar, volatile LAS unsigned* st) {
    XcdBarrier b; b.bar = bar; b.x = xb_xcc_id(); b.st = st;
    if (threadIdx.x == 0) (void)xb_add(&bar[XB_XCNT(b.x)], 1u);
    return b;
}
__device__ __forceinline__ void xcd_barrier_complete(unsigned* bar, unsigned x, unsigned& nloc, unsigned& nx) {
    const unsigned G = gridDim.x * gridDim.y * gridDim.z;
    unsigned sum, cnt, mine, sp = 0u;
    for (;;) {
        sum = 0u; cnt = 0u; mine = 0u;
#pragma unroll
        for (unsigned j = 0; j < 16; ++j) { const unsigned c = xb_ld(&bar[XB_XCNT(j)]); sum += c; cnt += (c > 0u) ? 1u : 0u; mine = (j == x) ? c : mine; }
        if (sum == G) break;
        __builtin_amdgcn_s_sleep(1);
        if ((++sp & 255u) == 0u) { if (xb_ld(&bar[XB_TMO])) break; if (sp > XB_SPIN_CAP) { atomicAdd(&bar[XB_TMO], 1u); break; } }
    }
    nloc = mine > 0u ? mine : 1u; nx = cnt > 0u ? cnt : 1u;
}

__device__ __forceinline__ void xcd_barrier(const XcdBarrier& b) {
    asm volatile("s_waitcnt vmcnt(0)" ::: "memory");
    __syncthreads();
    if (threadIdx.x == 0) {
        unsigned* bar = b.bar;
        __builtin_amdgcn_s_waitcnt(0);
        unsigned nloc = b.st[0], nx = b.st[1];
        if (nloc == 0u) { xcd_barrier_complete(bar, b.x, nloc, nx); b.st[0] = nloc; b.st[1] = nx; }
        const unsigned old = xb_add(&bar[XB_XSUB(b.x)], 1u);
        const unsigned gen = old / nloc;
        if (old + 1u == (gen + 1u) * nloc) {
            __builtin_amdgcn_fence(__ATOMIC_RELEASE, "agent");
            asm volatile("s_waitcnt vmcnt(0)" ::: "memory");
            const unsigned og = xb_add(&bar[XB_TOP], 1u);
            const unsigned tg = og / nx;
            if (og + 1u == (tg + 1u) * nx) xb_add(&bar[XB_TOPGEN], 1u);
            else XB_SPIN(xb_ld(&bar[XB_TOPGEN]) == tg, bar);
            __builtin_amdgcn_fence(__ATOMIC_ACQUIRE, "agent");
            xb_add(&bar[XB_XGEN(b.x)], 1u);
            asm volatile("s_waitcnt vmcnt(0)" ::: "memory");
        } else {
            XB_SPIN(xb_ld(&bar[XB_XGEN(b.x)]) == gen, bar);
            __builtin_amdgcn_fence(__ATOMIC_ACQUIRE, "agent");
            asm volatile("s_waitcnt vmcnt(0)" ::: "memory");
        }
    }
    __syncthreads();
}

__global__ void __launch_bounds__(NWAVES * 64, 2) mk_fwd(Args args) {
    extern __shared__ __attribute__((aligned(16))) unsigned char lds[];
    Frame F;
    F.lds = (LAS unsigned char*)lds;
    F.tid = threadIdx.x; F.lane = F.tid & 63; F.wave = __builtin_amdgcn_readfirstlane(F.tid >> 6);
    F.G = gridDim.x; F.bid = blockIdx.x;
#pragma unroll
    for (int i = 0; i < 24; ++i) F.in[i] = args.in[i];
    F.out = args.out; F.ws = args.ws;
    const int lo = args.ph_lo, hi = args.ph_hi;
#define IN(k) (lo <= (k) && (k) < hi)
#if MK_N_LAUNCHES == 1
    volatile LAS unsigned* MISC = (volatile LAS unsigned*)(F.lds + MISC_OFF);
    if (F.tid < 32) MISC[F.tid] = 0u;
    __syncthreads();
    XcdBarrier bar = xcd_barrier_post((unsigned*)(F.ws + WS_CTL) + CW_BAR, MISC + 8);
#define SEAM(k) do { if (IN(k) && IN((k) + 1)) xcd_barrier(bar); } while (0)
#else
#define SEAM(k) do { } while (0)
#endif
    const int gw = F.bid * NWAVES + F.wave, NGW = F.G * NWAVES;
    bf16* XN = (bf16*)(F.ws + WS_XN); bf16* PB = (bf16*)(F.ws + WS_PB); float* FZ = (float*)(F.ws + WS_FZ); bf16* GY = (bf16*)(F.ws + WS_GY);
    bf16* MIX = (bf16*)(F.ws + WS_MIX); bf16* ACT = (bf16*)(F.ws + WS_ACT);

    if (IN(0)) { p0_prologue(F); } SEAM(0);
    if (IN(1)) {
        pg8::Gemm g{XN, (const bf16*)(F.ws + WS_WIN), MTOK, INC, DM}; pg8::StaticOrder S; S.init(MTOK, INC, F.G, F.bid);
        EpiIn E{PB, FZ, (bf16*)(F.ws + WS_U5)};
        pg8::gemm_phase<EpiIn, pg8::StaticOrder, true, true>(F.lds, g, S, E);
    } SEAM(1);
    if (IN(2)) {
        for (int it = F.bid; it < 256; it += F.G) s5_item(F, it);
#if REP_S5 == 2
        for (int it = F.bid; it < 256; it += F.G) s5_item(F, it);
#endif
        for (int it = F.bid; it < 1024; it += F.G) hgA_item(F, it);
#if REP_HGA == 2
        for (int it = F.bid; it < 1024; it += F.G) hgA_item(F, it);
#endif
        for (int it = F.bid; it < SB_B * HH; it += F.G) hgrn_sample_item(F, it);
    } SEAM(2);
    if (IN(3)) { hg_scan(F); } SEAM(3);
    if (IN(4)) {
        pg8::Gemm g{GY, (const bf16*)(F.ws + WS_WGLU), MTOK, S5W, S5W}; pg8::StaticOrder S; S.init(MTOK, S5W, F.G, F.bid);
        EpiGlu E{GY, MIX};
        pg8::gemm_phase<EpiGlu, pg8::StaticOrder, true, true, true>(F.lds, g, S, E);
        __syncthreads();
        gu32* ctr = (gu32*)(F.ws + WS_CTL) + CW_QUEUE; volatile LAS int* slot = (volatile LAS int*)(F.lds + MISC_OFF + 64);
        for (;;) { if (F.tid == 0) *slot = (int)__hip_atomic_fetch_add(ctr, 1u, RLX_AGENT); __syncthreads(); const int it = *slot; if (it >= 1024) break; hgC_item(F, it); }
#if REP_HGC == 2
        __syncthreads();
        for (;;) { if (F.tid == 0) *slot = (int)__hip_atomic_fetch_add(ctr + 64, 1u, RLX_AGENT); __syncthreads(); const int it = *slot; if (it >= 1024) break; hgC_item(F, it); }
#endif
    } SEAM(4);
    if (IN(5)) {
        pg8::Gemm g{MIX, (const bf16*)(F.ws + WS_WOUT), MP, DM, DM}; pg8::StaticOrder S; S.init(MP, DM, F.G, F.bid);
        EpiOut E{F.in[0], F.out + O_Y, XN, F.in[19], (float*)(F.ws + WS_CTL) + CW_SS1};
        pg8::gemm_phase<EpiOut, pg8::StaticOrder, true, true>(F.lds, g, S, E);
        __syncthreads();
        for (int it = F.bid; it < 256; it += F.G) outproj_sample_tile(F, it);
    } SEAM(5);
    if (IN(6)) {
        pg8::Gemm g{XN, (const bf16*)(F.ws + WS_WGU), MTOK, 2 * DFF, DM}; pg8::StaticOrder S; S.init(MTOK, 2 * DFF, F.G, F.bid);
        EpiAct E{ACT, (const float*)(F.ws + WS_CTL) + CW_SS1};
        pg8::gemm_phase<EpiAct, pg8::StaticOrder, true, true>(F.lds, g, S, E);
    } SEAM(6);
    if (IN(7)) {
        pg8::Gemm g{ACT, (const bf16*)(F.ws + WS_WD), MP, DM, DFF}; pg8::StaticOrder S; S.init(MP, DM, F.G, F.bid);
        EpiDown E{F.out + O_Y, F.in[23], (float*)(F.ws + WS_CTL) + CW_SS2, (unsigned*)(F.ws + WS_CTL) + CW_CNT};
        pg8::gemm_phase<EpiDown, pg8::StaticOrder, true, true>(F.lds, g, S, E);
        __syncthreads();
        for (int it = F.bid; it < 256; it += F.G) down_sample_tile(F, it);
    }
#undef IN
#undef SEAM
}

extern "C" void kernel_launch(void* const* d_in, const int* in_sizes, int n_in, void* d_out, int out_size, void* d_ws, size_t ws_size, hipStream_t stream) {
    static int grid = 0;
    if (grid == 0) {
        if (n_in != 24 || ws_size < WS_END) { fprintf(stderr, "kernel_launch: unexpected n_in %d / ws %zu\n", n_in, ws_size); grid = -1; return; }
        int dev = 0, cus = 0, per_cu = 0;
        if (hipGetDevice(&dev) != hipSuccess || hipDeviceGetAttribute(&cus, hipDeviceAttributeMultiprocessorCount, dev) != hipSuccess) { grid = -1; return; }
        if (hipFuncSetAttribute((const void*)mk_fwd, hipFuncAttributeMaxDynamicSharedMemorySize, LDS_BYTES) != hipSuccess) { fprintf(stderr, "kernel_launch: hipFuncSetAttribute failed\n"); grid = -1; return; }
        if (hipOccupancyMaxActiveBlocksPerMultiprocessor(&per_cu, (const void*)mk_fwd, NWAVES * 64, LDS_BYTES) != hipSuccess || per_cu < 1) { fprintf(stderr, "kernel_launch: occupancy query says %d\n", per_cu); per_cu = 1; }
        (void)hipGetLastError();
        grid = cus;
    }
    if (grid < 0) return;
    if (hipMemsetAsync((char*)d_ws + WS_CTL, 0, CTL_ZERO_BYTES, stream) != hipSuccess) { fprintf(stderr, "kernel_launch: memset failed\n"); return; }
    Args a{};
    for (int i = 0; i < 24; ++i) a.in[i] = (const float*)d_in[i];
    a.out = (float*)d_out; a.ws = (unsigned char*)d_ws;
#if MK_N_LAUNCHES == 1
    a.ph_lo = 0; a.ph_hi = NPH;
    void* kargs[] = {&a};
    hipError_t e = hipLaunchCooperativeKernel((const void*)mk_fwd, dim3(grid), dim3(NWAVES * 64), kargs, LDS_BYTES, stream);
    if (e != hipSuccess) fprintf(stderr, "kernel_launch: cooperative launch failed: %s (grid %d)\n", hipGetErrorString(e), grid);
#else
    for (int p = 0; p < NPH; ++p) { a.ph_lo = p; a.ph_hi = p + 1; hipLaunchKernelGGL(mk_fwd, dim3(grid), dim3(NWAVES * 64), LDS_BYTES, stream, a); }
#endif
}
```

```cpp
#include <hip/hip_runtime.h>
#include <hip/hip_cooperative_groups.h>
#include <cstdio>
#include <cstdint>
namespace cg = cooperative_groups;
#define MK_N_LAUNCHES 1
namespace pg8 {
#define PG8_LAS __attribute__((address_space(3)))
typedef unsigned short bf16_t;
typedef short bf16x8 __attribute__((ext_vector_type(8)));
typedef float f32x4 __attribute__((ext_vector_type(4)));
typedef unsigned u32x4 __attribute__((ext_vector_type(4)));
constexpr int BM = 256, BK = 64, HALF = 128, HTB = HALF * BK * 2  , STAGE_BYTES = 8 * HTB, NXCD = 8, WGM = 8;

__host__ __device__ __forceinline__ int lds_byte(int r, int c) { const int st = (r >> 4) * 2 + (c >> 5), rr = r & 15, cc = c & 31, ob = rr * 64 + cc * 2; return st * 1024 + (ob ^ (((ob >> 9) & 1) << 5)); }
__host__ __device__ __forceinline__ void stage_rc(int b, int& R, int& C) { const int st = b / 1024, sb = b % 1024, swz = sb ^ (((sb >> 9) & 1) << 5); R = (st >> 1) * 16 + swz / 64; C = (st & 1) * 32 + (swz % 64) / 2; }
__host__ __device__ __forceinline__ int perm32(int rho) { const int n = rho >> 4, i = rho & 15; return 8 * (i >> 2) + 4 * n + (i & 3); }

struct Unit { int pm, pn; };
struct Gemm { const bf16_t* A; const bf16_t* Bt; int M, N, K; };

struct StaticOrder {
    int nM, nN, nwg, G, c;
    __host__ __device__ void init(int M, int N, int G_, int c_) { nM = M / BM; nN = N / BM; nwg = nM * nN; G = G_; c = c_; }
    __host__ __device__ bool next(int i, Unit& u) const {
        const long L = (long)i * G + c; if (L >= nwg) return false;
        int wgid = (int)L; { const int q = nwg / NXCD, r = nwg % NXCD, xcd = wgid % NXCD, off = wgid / NXCD; wgid = (xcd < r ? xcd * (q + 1) : r * (q + 1) + (xcd - r) * q) + off; }
        const int nig = WGM * nN, gid = wgid / nig, fm = gid * WGM, gsz = (nM - fm) < WGM ? (nM - fm) : WGM;
        u.pm = fm + ((wgid % nig) % gsz); u.pn = (wgid % nig) / gsz; return true;
    }
    __device__ __forceinline__ void a_ready(const Unit&) const {}
    __device__ __forceinline__ void done(const Unit&) const {}
};

__device__ __forceinline__ unsigned cvt_pk_bf16(float lo, float hi) { unsigned r; asm volatile("v_cvt_pk_bf16_f32 %0, %1, %2" : "=v"(r) : "v"(lo), "v"(hi)); return r; }
template <class Epi, class Sched, bool ALIGN_EPI = false, bool SP2 = false, bool AGM = false  >
__device__ __forceinline__ void gemm_phase(PG8_LAS unsigned char* lds, const Gemm g, const Sched& S, const Epi& E) {
    const int tid = threadIdx.x, wid = __builtin_amdgcn_readfirstlane(tid >> 6), lane = tid & 63, wr = wid >> 2, wc = wid & 3, fr = lane & 15, fq = lane >> 4;
    const int K = g.K, nt = K / BK;
    unsigned voffA[2], voffB[2];
#pragma unroll
    for (int i = 0; i < 2; ++i) { int R, C; stage_rc(tid * 16 + i * 8192, R, C); const int Rb = Epi::PERM ? ((R & ~31) + perm32(R & 31)) : R;
        voffA[i] = AGM ? (unsigned)((((C >> 4) * g.M + R) * 16 + (C & 15)) * 2) : (unsigned)(R * K + C) * 2u; voffB[i] = (unsigned)(Rb * K + C) * 2u; }
    const size_t kstep = (size_t)(BK * 2);
    const size_t hstep = (size_t)HALF * K * 2;
    const size_t tstep = 2 * hstep;
    const size_t kstepA = AGM ? (size_t)4 * g.M * 32 : kstep, hstepA = AGM ? (size_t)HALF * 32 : hstep, tstepA = 2 * hstepA;
    const unsigned ldsw = (unsigned)wid * 1024u;
    const int aoff = lds_byte(wr * 64 + fr, fq * 8), boff = lds_byte(wc * 32 + fr, fq * 8);
#define PG8_SA(b, h) (((b) * 2 + (h)) * HTB)
#define PG8_SB(b, h) ((4 + (b) * 2 + (h)) * HTB)
#define PG8_STAGE(bufoff, gbase, voff) do { _Pragma("unroll") for (int _i = 0; _i < 2; ++_i) \
        __builtin_amdgcn_global_load_lds((const unsigned*)((const char*)(gbase) + (voff)[_i]), (PG8_LAS unsigned*)(lds + (bufoff) + ldsw + _i * 8192), 16, 0, 0); } while (0)
#define PG8_LDA(dst, b, h) do { _Pragma("unroll") for (int m = 0; m < 4; ++m) _Pragma("unroll") for (int k = 0; k < 2; ++k) dst[m][k] = *(const PG8_LAS bf16x8*)(lds + PG8_SA(b, h) + aoff + m * 2048 + k * 1024); } while (0)
#define PG8_LDB(dst, b, h) do { _Pragma("unroll") for (int n = 0; n < 2; ++n) _Pragma("unroll") for (int k = 0; k < 2; ++k) dst[n][k] = *(const PG8_LAS bf16x8*)(lds + PG8_SB(b, h) + boff + n * 2048 + k * 1024); } while (0)
#define PG8_MMA(ai, bj, At, Bt) do { __builtin_amdgcn_s_setprio(1); _Pragma("unroll") for (int m = 0; m < 4; ++m) _Pragma("unroll") for (int n = 0; n < 2; ++n) _Pragma("unroll") for (int k = 0; k < 2; ++k) \
        acc[ai][bj][m][n] = __builtin_amdgcn_mfma_f32_16x16x32_bf16(Bt[n][k], At[m][k], acc[ai][bj][m][n], 0, 0, 0); __builtin_amdgcn_s_setprio(0); } while (0)
#define PG8_WAIT_V(n) asm volatile("s_waitcnt vmcnt(" #n ")" ::: "memory")
#define PG8_WAIT_L(n) asm volatile("s_waitcnt lgkmcnt(" #n ")" ::: "memory")
#define PG8_BAR __builtin_amdgcn_s_barrier()
#define PG8_SCHED __builtin_amdgcn_sched_barrier(0)
    Unit cur, nxt; int ui = 0;
    if (!S.next(0, cur)) return;
    f32x4 acc[2][2][4][2];
#pragma unroll
    for (int a = 0; a < 2; ++a)
#pragma unroll
        for (int b = 0; b < 2; ++b)
#pragma unroll
            for (int m = 0; m < 4; ++m)
#pragma unroll
                for (int n = 0; n < 2; ++n) acc[a][b][m][n] = (f32x4){0.f, 0.f, 0.f, 0.f};
    bf16x8 At[4][2], B0[2][2], B1[2][2];
    const char* cA = (const char*)g.A + (size_t)cur.pm * tstepA; const char* cB = (const char*)g.Bt + (size_t)cur.pn * tstep;
    S.a_ready(cur);
    if constexpr (SP2) {
        PG8_STAGE(PG8_SB(0, 0), cB, voffB); PG8_STAGE(PG8_SB(0, 1), cB + hstep, voffB); PG8_STAGE(PG8_SA(0, 0), cA, voffA); PG8_STAGE(PG8_SA(0, 1), cA + hstepA, voffA);
        if (wr == 1) PG8_BAR;
        PG8_WAIT_V(2); PG8_BAR;
        PG8_STAGE(PG8_SB(1, 0), cB + kstep, voffB); PG8_STAGE(PG8_SA(1, 0), cA + kstepA, voffA); PG8_STAGE(PG8_SB(1, 1), cB + hstep + kstep, voffB);
        PG8_WAIT_V(6); PG8_BAR;
    } else {
        PG8_STAGE(PG8_SB(0, 0), cB, voffB); PG8_STAGE(PG8_SA(0, 0), cA, voffA); PG8_STAGE(PG8_SB(0, 1), cB + hstep, voffB); PG8_STAGE(PG8_SA(0, 1), cA + hstepA, voffA);
        if (wr == 1) PG8_BAR;
        PG8_WAIT_V(4); PG8_BAR;
        PG8_STAGE(PG8_SB(1, 0), cB + kstep, voffB); PG8_STAGE(PG8_SA(1, 0), cA + kstepA, voffA); PG8_STAGE(PG8_SB(1, 1), cB + hstep + kstep, voffB);
        PG8_WAIT_V(6); PG8_BAR;
    }
    for (;;) {
        const bool has_next = S.next(ui + 1, nxt);
        const char* nA = has_next ? (const char*)g.A + (size_t)nxt.pm * tstepA : cA; const char* nB = has_next ? (const char*)g.Bt + (size_t)nxt.pn * tstep : cB;
        for (int t = 0; t < nt; t += 2) {
            const bool last = (t == nt - 2);
            const char* a1 = cA + (size_t)(t + 1) * kstepA;
            const char* a2 = last ? nA : cA + (size_t)(t + 2) * kstepA; const char* b2 = last ? nB : cB + (size_t)(t + 2) * kstep;
            const char* a3 = a2 + kstepA; const char* b3 = b2 + kstep;
            if (last && has_next) S.a_ready(nxt);
            if constexpr (SP2) {
            PG8_LDB(B0, 0, 0); PG8_LDB(B1, 0, 1); PG8_SCHED; PG8_LDA(At, 0, 0); PG8_STAGE(PG8_SA(1, 1), a1 + hstepA, voffA);
            PG8_WAIT_V(8); PG8_WAIT_L(0); PG8_BAR; PG8_MMA(0, 0, At, B0); PG8_MMA(0, 1, At, B1); PG8_BAR; PG8_SCHED;
            PG8_LDA(At, 0, 1); PG8_STAGE(PG8_SB(0, 0), b2, voffB); PG8_STAGE(PG8_SB(0, 1), b2 + hstep, voffB); PG8_STAGE(PG8_SA(0, 0), a2, voffA);
            PG8_WAIT_V(8); PG8_WAIT_L(0); PG8_BAR; PG8_MMA(1, 0, At, B0); PG8_MMA(1, 1, At, B1); PG8_BAR; PG8_SCHED;
            PG8_LDB(B0, 1, 0); PG8_LDB(B1, 1, 1); PG8_SCHED; PG8_LDA(At, 1, 0); PG8_STAGE(PG8_SA(0, 1), a2 + hstepA, voffA);
            PG8_WAIT_V(8); PG8_WAIT_L(0); PG8_BAR; PG8_MMA(0, 0, At, B0); PG8_MMA(0, 1, At, B1); PG8_BAR; PG8_SCHED;
            PG8_LDA(At, 1, 1); PG8_STAGE(PG8_SB(1, 0), b3, voffB); PG8_STAGE(PG8_SB(1, 1), b3 + hstep, voffB); PG8_STAGE(PG8_SA(1, 0), a3, voffA);
            PG8_WAIT_V(8); PG8_WAIT_L(0); PG8_BAR; PG8_MMA(1, 0, At, B0); PG8_MMA(1, 1, At, B1); PG8_BAR; PG8_SCHED;
            } else {
            PG8_LDB(B0, 0, 0); PG8_SCHED; PG8_LDA(At, 0, 0); PG8_STAGE(PG8_SA(1, 1), a1 + hstepA, voffA);
            PG8_WAIT_L(8); PG8_BAR; PG8_WAIT_L(0); PG8_MMA(0, 0, At, B0); PG8_BAR; PG8_SCHED;
            PG8_LDB(B1, 0, 1); PG8_STAGE(PG8_SB(0, 0), b2, voffB);
            PG8_BAR; PG8_WAIT_L(0); PG8_MMA(0, 1, At, B1); PG8_BAR;
            PG8_LDA(At, 0, 1); PG8_STAGE(PG8_SA(0, 0), a2, voffA);
            PG8_BAR; PG8_WAIT_L(0); PG8_MMA(1, 0, At, B0); PG8_BAR; PG8_SCHED;
            PG8_STAGE(PG8_SB(0, 1), b2 + hstep, voffB);
            PG8_WAIT_V(6); PG8_BAR; PG8_MMA(1, 1, At, B1); PG8_BAR;
            PG8_LDB(B0, 1, 0); PG8_SCHED; PG8_LDA(At, 1, 0); PG8_STAGE(PG8_SA(0, 1), a2 + hstepA, voffA);
            PG8_WAIT_L(8); PG8_BAR; PG8_WAIT_L(0); PG8_MMA(0, 0, At, B0); PG8_BAR; PG8_SCHED;
            PG8_LDB(B1, 1, 1); PG8_STAGE(PG8_SB(1, 0), b3, voffB);
            PG8_BAR; PG8_WAIT_L(0); PG8_MMA(0, 1, At, B1); PG8_BAR;
            PG8_LDA(At, 1, 1); PG8_STAGE(PG8_SA(1, 0), a3, voffA);
            PG8_BAR; PG8_WAIT_L(0); PG8_MMA(1, 0, At, B0); PG8_BAR; PG8_SCHED;
            PG8_STAGE(PG8_SB(1, 1), b3 + hstep, voffB);
            PG8_WAIT_V(6); PG8_BAR; PG8_MMA(1, 1, At, B1); PG8_BAR;
            }
        }
        if constexpr (ALIGN_EPI) { if (wr == 0) PG8_BAR; }
        if constexpr (!Epi::AFTER_DRAIN) { E(acc, cur, wr, wc, fr, fq); S.done(cur); }
        if (!has_next) break;
#pragma unroll
        for (int a = 0; a < 2; ++a)
#pragma unroll
            for (int b = 0; b < 2; ++b)
#pragma unroll
                for (int m = 0; m < 4; ++m)
#pragma unroll
                    for (int n = 0; n < 2; ++n) acc[a][b][m][n] = (f32x4){0.f, 0.f, 0.f, 0.f};
        cur = nxt; cA = nA; cB = nB; ++ui;
        if constexpr (ALIGN_EPI) { if (wr == 1) PG8_BAR; }
    }
    PG8_WAIT_V(0);
    if constexpr (!ALIGN_EPI) { if (wr == 0) PG8_BAR; }
    PG8_BAR;
    if constexpr (Epi::AFTER_DRAIN) { E.fused(acc, cur, wr, wc, fr, fq, lds, wid, lane); S.done(cur); }
#undef PG8_SA
#undef PG8_SB
#undef PG8_STAGE
#undef PG8_LDA
#undef PG8_LDB
#undef PG8_MMA
#undef PG8_WAIT_V
#undef PG8_WAIT_L
#undef PG8_BAR
#undef PG8_SCHED
}
}

#ifndef S5_SIMPLE
#define S5_SIMPLE 0
#endif
#ifndef HG_SIMPLE
#define HG_SIMPLE 0
#endif
#ifndef REP0
#define REP0 1
#define REP1 1
#define REP2 1
#define REP3 1
#define REP4 1
#define REP6 1
#endif
#ifndef REP_S5
#define REP_S5 1
#endif
#ifndef REP_HGA
#define REP_HGA 1
#endif
#ifndef REP_HGC
#define REP_HGC 1
#endif
#ifndef REP_P1
#define REP_P1 1
#endif
#ifndef REP_P6
#define REP_P6 1
#endif
#ifndef REP_P0
#define REP_P0 1
#endif
#ifndef REP_GLU
#define REP_GLU 1
#endif
#ifndef REP_P3
#define REP_P3 1
#endif
#ifndef REP_P5
#define REP_P5 1
#endif
#ifndef REP_P7
#define REP_P7 1
#endif
#ifndef MK_N_LAUNCHES
#define MK_N_LAUNCHES 1
#endif
constexpr int DM = 1024, PB_B = 8, PB_T = 2048, SB_B = 128, SB_T = 8;
constexpr int MP = PB_B * PB_T, MS = SB_B * SB_T, MTOK = MP + MS;
constexpr int S5W = 512, S5G = 32, S5C = 16, S5N = 64;
constexpr int HGW = 512, HD = 128, HH = 4;
constexpr int INC = 2560, DFF = 2816;
constexpr float EPS = 1e-6f;
constexpr int NPH = 8;
constexpr size_t O_Y = 0, O_PRE = (size_t)MTOK * DM, O_PIM = O_PRE + 16384, O_PHG = O_PIM + 16384, O_SRE = O_PHG + 524288, O_SIM = O_SRE + 262144, O_SHG = O_SIM + 262144;
constexpr size_t MiB = 1u << 20;
constexpr size_t WS_CTL = 0, WS_WIN = 2 * MiB, WS_WGLU = 7 * MiB, WS_WOUT = 8 * MiB, WS_WGU = 10 * MiB, WS_WD = 21 * MiB;
constexpr size_t WS_XN = 27 * MiB, WS_PB = 61 * MiB, WS_FZ = 129 * MiB, WS_ACT = 61 * MiB, WS_GY = 163 * MiB, WS_OH = 180 * MiB, WS_MIX = 197 * MiB, WS_END = 234 * MiB;
constexpr int PBW = 2048;
constexpr int LDS_BYTES = 147456;
constexpr int NWAVES = 8;
constexpr int CW_SS1 = 16384, CW_SS2 = 36864, CW_CNT = 57344, CW_CNTS = 61440;

#define GAS __attribute__((address_space(1)))
#define LAS __attribute__((address_space(3)))
typedef unsigned short bf16;
typedef unsigned v4u __attribute__((ext_vector_type(4)));
typedef unsigned v2u __attribute__((ext_vector_type(2)));
typedef float f32x4 __attribute__((ext_vector_type(4)));
#define LDS_WAIT() asm volatile("s_waitcnt lgkmcnt(0)" ::: "memory")
__device__ __forceinline__ unsigned f2bf(float f) { unsigned u = __builtin_bit_cast(unsigned, f); return (u + 0x7fffu + ((u >> 16) & 1u)) >> 16; }
__device__ __forceinline__ unsigned pk2(float lo, float hi) { return f2bf(lo) | (f2bf(hi) << 16); }
__device__ __forceinline__ float bf2f(unsigned short h) { return __builtin_bit_cast(float, (unsigned)h << 16); }
__device__ __forceinline__ float bflo(unsigned w) { return __builtin_bit_cast(float, w << 16); }
__device__ __forceinline__ float bfhi(unsigned w) { return __builtin_bit_cast(float, w & 0xffff0000u); }
__device__ __forceinline__ float sigmoidf_(float x) { return __builtin_amdgcn_rcpf(1.0f + __builtin_amdgcn_exp2f(-1.4426950408889634f * x)); }
__device__ __forceinline__ float siluf_(float x) { return x * __builtin_amdgcn_rcpf(1.0f + __builtin_amdgcn_exp2f(-1.4426950408889634f * x)); }
__device__ __forceinline__ float gelu_tanh(float x) { const float z = -2.302208198144325f * (x + 0.044715f * x * x * x); return x * __builtin_amdgcn_rcpf(1.0f + __builtin_amdgcn_exp2f(z)); }
__device__ __forceinline__ float wave_sum(float v) {
#pragma unroll
    for (int o = 1; o < 64; o <<= 1) v += __shfl_xor(v, o);
    return v;
}

struct Args { const float* in[24]; float* out; unsigned char* ws; int ph_lo, ph_hi; };

struct Frame {
    LAS unsigned char* lds;
    int tid, lane, wave, G, bid;
    const float* in[24];
    float* out; unsigned char* ws;
};
__device__ __forceinline__ const float* xrow(const Frame& F, int m) { return m < MP ? F.in[0] + (size_t)m * DM : F.in[1] + (size_t)(m - MP) * DM; }

__device__ __forceinline__ void transpose_item(const float* W, int ldw, bf16* WT, int K, int k0, int sn0, int dn0, LAS float* scr, int lane, const float* kgain = nullptr) {
#pragma unroll 8
    for (int i = 0; i < 32; ++i) { const int kk = 2 * i + (lane >> 5); float w = W[(size_t)(k0 + kk) * ldw + sn0 + (lane & 31)]; if (kgain) w *= kgain[k0 + kk]; scr[kk * 33 + (lane & 31)] = w; }
    LDS_WAIT(); asm volatile("" ::: "memory");
    const int c = lane & 7;
#pragma unroll
    for (int j = 0; j < 4; ++j) { const int n = (lane >> 3) + 8 * j; const LAS float* s = scr + (8 * c) * 33 + n;
        v4u o; o.x = pk2(s[0 * 33], s[1 * 33]); o.y = pk2(s[2 * 33], s[3 * 33]); o.z = pk2(s[4 * 33], s[5 * 33]); o.w = pk2(s[6 * 33], s[7 * 33]);
        *(GAS v4u*)(WT + (size_t)(dn0 + n) * K + k0 + 8 * c) = o; }
    LDS_WAIT(); asm volatile("" ::: "memory");
}
__device__ __forceinline__ void rms_row_bf16(const float* xr_, const float* gain, bf16* orow, int lane) {
    const GAS f32x4* xr = (const GAS f32x4*)xr_ + lane;
    f32x4 v[4]; float s = 0.f;
#pragma unroll
    for (int j = 0; j < 4; ++j) { v[j] = xr[64 * j]; s += (v[j].x * v[j].x + v[j].y * v[j].y) + (v[j].z * v[j].z + v[j].w * v[j].w); }
    const float rstd = 1.0f / sqrtf(wave_sum(s) * (1.0f / DM) + EPS);
    GAS v2u* o8 = (GAS v2u*)orow + lane;
#pragma unroll
    for (int j = 0; j < 4; ++j) { const f32x4 g = ((const GAS f32x4*)gain)[lane + 64 * j]; v2u w; w.x = pk2(v[j].x * rstd * g.x, v[j].y * rstd * g.y); w.y = pk2(v[j].z * rstd * g.z, v[j].w * rstd * g.w); o8[64 * j] = w; }
}

__device__ __forceinline__ void s5_tables_item(Frame& F, int item);
__device__ __forceinline__ void p0_prologue(Frame& F) {
    for (int it = F.bid; it < 256; it += F.G) s5_tables_item(F, it);
    LAS float* scr = (LAS float*)(F.lds + F.wave * 16384);
    const int gw = F.bid * NWAVES + F.wave, NGW = F.G * NWAVES;
    bf16* WinT = (bf16*)(F.ws + WS_WIN); bf16* WgluT = (bf16*)(F.ws + WS_WGLU); bf16* WoutT = (bf16*)(F.ws + WS_WOUT); bf16* WguT = (bf16*)(F.ws + WS_WGU); bf16* WdT = (bf16*)(F.ws + WS_WD);
    constexpr int I_IN = (DM / 64) * (INC / 32), I_GLU = (S5W / 64) * (S5W / 32), I_OUT = (DM / 64) * (DM / 32), I_G = (DM / 64) * (DFF / 32), I_D = (DFF / 64) * (DM / 32);
    constexpr int NITEMS = I_IN + I_GLU + I_OUT + 2 * I_G + I_D;
    for (int it = gw; it < NITEMS; it += NGW) {
        int r = it;
        if (r < I_IN) { const int nblk = INC / 32, kb = r / nblk, nb = r % nblk, sn0 = nb * 32; const int seg = sn0 / 512, off = sn0 % 512;
            const int dseg = seg == 0 ? 0 : seg == 1 ? 1 : seg == 2 ? 4 : seg == 3 ? 2 : 3;
            transpose_item(F.in[7], INC, WinT, DM, kb * 64, sn0, dseg * 512 + off, scr, F.lane); continue; } r -= I_IN;
        if (r < I_GLU) { const int nblk = S5W / 32, kb = r / nblk, nb = r % nblk; transpose_item(F.in[16], S5W, WgluT, S5W, kb * 64, nb * 32, nb * 32, scr, F.lane); continue; } r -= I_GLU;
        if (r < I_OUT) { const int nblk = DM / 32, kb = r / nblk, nb = r % nblk; transpose_item(F.in[18], DM, WoutT, DM, kb * 64, nb * 32, nb * 32, scr, F.lane); continue; } r -= I_OUT;
        if (r < I_G) { const int nblk = DFF / 32, kb = r / nblk, nb = r % nblk, sn0 = nb * 32; transpose_item(F.in[20], DFF, WguT, DM, kb * 64, sn0, 256 * (sn0 / 128) + (sn0 % 128), scr, F.lane, F.in[19]); continue; } r -= I_G;
        if (r < I_G) { const int nblk = DFF / 32, kb = r / nblk, nb = r % nblk, sn0 = nb * 32; transpose_item(F.in[21], DFF, WguT, DM, kb * 64, sn0, 256 * (sn0 / 128) + 128 + (sn0 % 128), scr, F.lane, F.in[19]); continue; } r -= I_G;
        { const int nblk = DM / 32, kb = r / nblk, nb = r % nblk; transpose_item(F.in[22], DM, WdT, DFF, kb * 64, nb * 32, nb * 32, scr, F.lane); }
    }
    bf16* XN = (bf16*)(F.ws + WS_XN);
    for (int m = gw; m < MTOK; m += NGW) rms_row_bf16(xrow(F, m), F.in[6], XN + (size_t)m * DM, F.lane);
}

using pg8::Unit; using pg8::u32x4; using pg8::cvt_pk_bf16; using pg8::BM; using pg8::HALF;
struct EpiIn {
    static constexpr bool PERM = true, AFTER_DRAIN = false;
    bf16* PB; float* FZ; bf16* U5;
    __device__ __forceinline__ void operator()(const pg8::f32x4 (&acc)[2][2][4][2], const Unit& u, int wr, int wc, int fr, int fq) const {
        const int row0 = u.pm * BM + wr * 64 + fr;
        if (u.pn < 2) { const int col0 = u.pn * BM + wc * 32 + 8 * fq;
#pragma unroll
            for (int ai = 0; ai < 2; ++ai)
#pragma unroll
                for (int m = 0; m < 4; ++m) { const size_t r = (size_t)(row0 + ai * HALF + m * 16);
#pragma unroll
                    for (int bj = 0; bj < 2; ++bj) { const int col = col0 + bj * HALF; const pg8::f32x4 v0 = acc[ai][bj][m][0], v1 = acc[ai][bj][m][1]; u32x4 w; w.x = cvt_pk_bf16(v0[0], v0[1]); w.y = cvt_pk_bf16(v0[2], v0[3]); w.z = cvt_pk_bf16(v1[0], v1[1]); w.w = cvt_pk_bf16(v1[2], v1[3]);
                        *(u32x4*)(U5 + ((size_t)(col >> 4) * MTOK + r) * 16 + (col & 15)) = w; } }
        } else if (u.pn < 8) { const int col0 = u.pn * BM + wc * 32 + 8 * fq;
#pragma unroll
            for (int ai = 0; ai < 2; ++ai)
#pragma unroll
                for (int m = 0; m < 4; ++m) { bf16* rowp = PB + (size_t)(row0 + ai * HALF + m * 16) * PBW + col0;
#pragma unroll
                    for (int bj = 0; bj < 2; ++bj) { const pg8::f32x4 v0 = acc[ai][bj][m][0], v1 = acc[ai][bj][m][1]; u32x4 w; w.x = cvt_pk_bf16(v0[0], v0[1]); w.y = cvt_pk_bf16(v0[2], v0[3]); w.z = cvt_pk_bf16(v1[0], v1[1]); w.w = cvt_pk_bf16(v1[2], v1[3]);
                        *(u32x4*)(rowp + bj * HALF) = w; } }
        } else { const int col0 = (u.pn - 8) * BM + wc * 32 + 8 * fq;
#pragma unroll
            for (int ai = 0; ai < 2; ++ai)
#pragma unroll
                for (int m = 0; m < 4; ++m) { float* rowp = FZ + (size_t)(row0 + ai * HALF + m * 16) * 512 + col0;
#pragma unroll
                    for (int bj = 0; bj < 2; ++bj)
#pragma unroll
                        for (int n = 0; n < 2; ++n) *(pg8::f32x4*)(rowp + bj * HALF + 4 * n) = acc[ai][bj][m][n]; }
        }
    }
};
struct EpiGlu {
    static constexpr bool PERM = true, AFTER_DRAIN = false;
    const bf16* GY; bf16* MIX;
    __device__ __forceinline__ void operator()(const pg8::f32x4 (&acc)[2][2][4][2], const Unit& u, int wr, int wc, int fr, int fq) const {
        const int row0 = u.pm * BM + wr * 64 + fr, col0 = u.pn * BM + wc * 32 + 8 * fq;
#pragma unroll
        for (int ai = 0; ai < 2; ++ai)
#pragma unroll
            for (int m = 0; m < 4; ++m) { const size_t r = (size_t)(row0 + ai * HALF + m * 16);
#pragma unroll
                for (int bj = 0; bj < 2; ++bj) { const int col = col0 + bj * HALF; const u32x4 g = *(const u32x4*)(GY + ((size_t)(col >> 4) * MTOK + r) * 16 + (col & 15)); const pg8::f32x4 v0 = acc[ai][bj][m][0], v1 = acc[ai][bj][m][1];
                    u32x4 w; w.x = cvt_pk_bf16(bflo(g.x) * sigmoidf_(v0[0]), bfhi(g.x) * sigmoidf_(v0[1])); w.y = cvt_pk_bf16(bflo(g.y) * sigmoidf_(v0[2]), bfhi(g.y) * sigmoidf_(v0[3]));
                    w.z = cvt_pk_bf16(bflo(g.z) * sigmoidf_(v1[0]), bfhi(g.z) * sigmoidf_(v1[1])); w.w = cvt_pk_bf16(bflo(g.w) * sigmoidf_(v1[2]), bfhi(g.w) * sigmoidf_(v1[3]));
                    *(u32x4*)(MIX + r * DM + col0 + bj * HALF) = w; } }
    }
};
__device__ __forceinline__ float rstd_of(float ss) { return 1.0f / sqrtf(ss * (1.0f / DM) + EPS); }
__device__ __forceinline__ float atomic_read_f32(float* p) { return __hip_atomic_fetch_add(p, 0.0f, __ATOMIC_RELAXED, __HIP_MEMORY_SCOPE_AGENT); }
__device__ __forceinline__ void wait_count(unsigned* cnt, unsigned want) {
    for (unsigned sp = 0; sp < (1u << 22); ++sp) { if (__hip_atomic_load(cnt, __ATOMIC_RELAXED, __HIP_MEMORY_SCOPE_AGENT) >= want) break; __builtin_amdgcn_s_sleep(2); }
}
struct EpiOut {
    static constexpr bool PERM = true, AFTER_DRAIN = false;
    const float* xp; bf16* XN; float* SS1;
    __device__ __forceinline__ void operator()(const pg8::f32x4 (&acc)[2][2][4][2], const Unit& u, int wr, int wc, int fr, int fq) const {
        const int row0 = u.pm * BM + wr * 64 + fr, col0 = u.pn * BM + wc * 32 + 8 * fq;
#pragma unroll
        for (int ai = 0; ai < 2; ++ai)
#pragma unroll
            for (int m = 0; m < 4; ++m) { const int row = row0 + ai * HALF + m * 16; const size_t off = (size_t)row * DM + col0; float ss = 0.f;
#pragma unroll
                for (int bj = 0; bj < 2; ++bj) { const pg8::f32x4 x0 = *(const pg8::f32x4*)(xp + off + bj * HALF) + acc[ai][bj][m][0], x1 = *(const pg8::f32x4*)(xp + off + bj * HALF + 4) + acc[ai][bj][m][1];
                    ss += (x0[0] * x0[0] + x0[1] * x0[1]) + (x0[2] * x0[2] + x0[3] * x0[3]) + (x1[0] * x1[0] + x1[1] * x1[1]) + (x1[2] * x1[2] + x1[3] * x1[3]);
                    u32x4 w; w.x = cvt_pk_bf16(x0[0], x0[1]); w.y = cvt_pk_bf16(x0[2], x0[3]); w.z = cvt_pk_bf16(x1[0], x1[1]); w.w = cvt_pk_bf16(x1[2], x1[3]);
                    *(u32x4*)(XN + off + bj * HALF) = w; }
                ss += __shfl_xor(ss, 16); ss += __shfl_xor(ss, 32);
                if (fq == 0) __hip_atomic_fetch_add(SS1 + row, ss, __ATOMIC_RELAXED, __HIP_MEMORY_SCOPE_AGENT); }
    }
};
struct EpiAct {
    static constexpr bool PERM = true, AFTER_DRAIN = false;
    bf16* ACT; const float* SS1;
    __device__ __forceinline__ void operator()(const pg8::f32x4 (&acc)[2][2][4][2], const Unit& u, int wr, int wc, int fr, int fq) const {
        const int row0 = u.pm * BM + wr * 64 + fr, col0 = u.pn * HALF + wc * 32 + 8 * fq;
#pragma unroll
        for (int ai = 0; ai < 2; ++ai)
#pragma unroll
            for (int m = 0; m < 4; ++m) { const int row = row0 + ai * HALF + m * 16; const float rs = rstd_of(SS1[row]);
                const pg8::f32x4 g0 = acc[ai][0][m][0] * rs, g1 = acc[ai][0][m][1] * rs, u0 = acc[ai][1][m][0] * rs, u1 = acc[ai][1][m][1] * rs;
                u32x4 w; w.x = cvt_pk_bf16(siluf_(g0[0]) * u0[0], siluf_(g0[1]) * u0[1]); w.y = cvt_pk_bf16(siluf_(g0[2]) * u0[2], siluf_(g0[3]) * u0[3]);
                w.z = cvt_pk_bf16(siluf_(g1[0]) * u1[0], siluf_(g1[1]) * u1[1]); w.w = cvt_pk_bf16(siluf_(g1[2]) * u1[2], siluf_(g1[3]) * u1[3]);
                *(u32x4*)(ACT + (size_t)row * DFF + col0) = w; }
    }
};
struct EpiDown {
    static constexpr bool PERM = true, AFTER_DRAIN = false;
    const bf16* X1; const float* gain; float* SS2; unsigned* cnt; float* YO;
    __device__ __forceinline__ void operator()(pg8::f32x4 (&acc)[2][2][4][2], const Unit& u, int wr, int wc, int fr, int fq) const {
        const int row0 = u.pm * BM + wr * 64 + fr, col0 = u.pn * BM + wc * 32 + 8 * fq;
#pragma unroll
        for (int ai = 0; ai < 2; ++ai)
#pragma unroll
            for (int m = 0; m < 4; ++m) { const int row = row0 + ai * HALF + m * 16; const size_t off = (size_t)row * DM + col0; float ss = 0.f;
#pragma unroll
                for (int bj = 0; bj < 2; ++bj) { const u32x4 xb = *(const u32x4*)(X1 + off + bj * HALF);
                    const pg8::f32x4 x0 = (pg8::f32x4){bflo(xb.x), bfhi(xb.x), bflo(xb.y), bfhi(xb.y)} + acc[ai][bj][m][0], x1 = (pg8::f32x4){bflo(xb.z), bfhi(xb.z), bflo(xb.w), bfhi(xb.w)} + acc[ai][bj][m][1];
                    acc[ai][bj][m][0] = x0; acc[ai][bj][m][1] = x1;
                    ss += (x0[0] * x0[0] + x0[1] * x0[1]) + (x0[2] * x0[2] + x0[3] * x0[3]) + (x1[0] * x1[0] + x1[1] * x1[1]) + (x1[2] * x1[2] + x1[3] * x1[3]); }
                ss += __shfl_xor(ss, 16); ss += __shfl_xor(ss, 32);
                if (fq == 0) __hip_atomic_fetch_add(SS2 + row, ss, __ATOMIC_RELAXED, __HIP_MEMORY_SCOPE_AGENT); }
        asm volatile("s_waitcnt vmcnt(0)" ::: "memory");
        unsigned* c = cnt + 64 * u.pm;
        if (threadIdx.x % 64 == 0) __hip_atomic_fetch_add(c, 1u, __ATOMIC_RELAXED, __HIP_MEMORY_SCOPE_AGENT);
        wait_count(c, 32u);
        pg8::f32x4 gn[2][2];
#pragma unroll
        for (int bj = 0; bj < 2; ++bj)
#pragma unroll
            for (int n = 0; n < 2; ++n) gn[bj][n] = *(const pg8::f32x4*)(gain + col0 + bj * HALF + 4 * n);
        float rs[2][4];
#pragma unroll
        for (int ai = 0; ai < 2; ++ai)
#pragma unroll
            for (int m = 0; m < 4; ++m) { float s = 0.f; if (fq == 0) s = atomic_read_f32(SS2 + row0 + ai * HALF + m * 16); rs[ai][m] = rstd_of(__shfl(s, fr)); }
#pragma unroll
        for (int ai = 0; ai < 2; ++ai)
#pragma unroll
            for (int m = 0; m < 4; ++m) { const size_t off = (size_t)(row0 + ai * HALF + m * 16) * DM + col0;
#pragma unroll
                for (int bj = 0; bj < 2; ++bj) { *(pg8::f32x4*)(YO + off + bj * HALF) = acc[ai][bj][m][0] * rs[ai][m] * gn[bj][0]; *(pg8::f32x4*)(YO + off + bj * HALF + 4) = acc[ai][bj][m][1] * rs[ai][m] * gn[bj][1]; } }
    }
};

typedef float f32x16 __attribute__((ext_vector_type(16)));
typedef short s16x8 __attribute__((ext_vector_type(8)));
constexpr size_t WS_U5 = WS_OH, WS_T5 = 231 * MiB;
constexpr size_t T5_STRIDE = 73728, T5_VG = 32768, T5_KC = 65536;
constexpr int S5_LD = 136;
__device__ __forceinline__ void s5_tables_item(Frame& F, int item) {
    const int tid = F.tid, g = item >> 3, part = item & 7;
    LAS float* Pre = (LAS float*)F.lds; LAS float* Pim = Pre + 9 * 64; LAS float* Ff = Pim + 9 * 64;
    LAS float* Cre = Ff + 128, * Cim = Cre + 1024, * Bre = Cim + 1024, * Bim = Bre + 1024;
    if (tid < 64) { const int n = tid;
        const float a_re = F.in[8][g * S5N + n], a_im = F.in[9][g * S5N + n], dt = expf(F.in[10][g]);
        const float mag = expf(a_re * dt), ab_re = mag * cosf(a_im * dt), ab_im = mag * sinf(a_im * dt);
        const float den = a_re * a_re + a_im * a_im, nr = ab_re - 1.0f, ni = ab_im;
        Ff[n] = (nr * a_re + ni * a_im) / den; Ff[64 + n] = (ni * a_re - nr * a_im) / den;
        float pr = 1.f, pi = 0.f;
#pragma unroll
        for (int j = 0; j < 9; ++j) { Pre[j * 64 + n] = pr; Pim[j * 64 + n] = pi; const float t = pr * ab_re - pi * ab_im; pi = pr * ab_im + pi * ab_re; pr = t; }
    }
    __syncthreads();
#pragma unroll
    for (int i = 0; i < 2; ++i) { const int idx = tid + 512 * i;
        { const int c = idx >> 6, n = idx & 63; Cre[c * 64 + n] = F.in[13][(size_t)(g * 16 + c) * S5N + n]; Cim[c * 64 + n] = F.in[14][(size_t)(g * 16 + c) * S5N + n]; }
        { const int n = idx >> 4, c = idx & 15; const float br = F.in[11][(size_t)(g * S5N + n) * 16 + c], bi = F.in[12][(size_t)(g * S5N + n) * 16 + c], fr = Ff[n], fi = Ff[64 + n];
          Bre[n * 16 + c] = fr * br - fi * bi; Bim[n * 16 + c] = fr * bi + fi * br; } }
    __syncthreads();
    bf16* WG = (bf16*)(F.ws + WS_T5 + (size_t)g * T5_STRIDE); bf16* VG = (bf16*)(F.ws + WS_T5 + (size_t)g * T5_STRIDE + T5_VG); bf16* KC = (bf16*)(F.ws + WS_T5 + (size_t)g * T5_STRIDE + T5_KC);
    if (tid < 256) { const int j = part, c = tid >> 4, cp = tid & 15; float acc = 0.f;
#pragma unroll 4
        for (int n = 0; n < 64; ++n) { const float cr = Cre[c * 64 + n], ci = Cim[c * 64 + n], pr = Pre[j * 64 + n], pi = Pim[j * 64 + n];
            const float xr = cr * pr - ci * pi, xi = cr * pi + ci * pr; acc += xr * Bre[n * 16 + cp] - xi * Bim[n * 16 + cp]; }
        KC[j * 256 + tid] = (bf16)f2bf(acc);
    } else if (part == 0) KC[2048 + tid - 256] = 0;
#pragma unroll
    for (int i = 0; i < 4; ++i) { const int idx = tid + 512 * i, np = 16 * part + (idx >> 7), k = idx & 127, s = k >> 4, cp = k & 15, n = np & 63;
        const float pr = Pre[(7 - s) * 64 + n], pi = Pim[(7 - s) * 64 + n], br = Bre[n * 16 + cp], bi = Bim[n * 16 + cp];
        WG[np * 128 + k] = (bf16)f2bf(np < 64 ? pr * br - pi * bi : pr * bi + pi * br); }
#pragma unroll
    for (int i = 0; i < 4; ++i) { const int idx = tid + 512 * i, col = 16 * part + (idx >> 7), np = idx & 127, t = col >> 4, c = col & 15, n = np & 63;
        const float pr = Pre[(t + 1) * 64 + n], pi = Pim[(t + 1) * 64 + n], cr = Cre[c * 64 + n], ci = Cim[c * 64 + n];
        VG[col * 128 + np] = (bf16)f2bf(np < 64 ? cr * pr - ci * pi : -(cr * pi + ci * pr)); }
    __syncthreads();
}
constexpr int L5_WG = 0, L5_VG = 34816, L5_KC = 69632, L5_U = 74240, L5_HS = 91648, L5_HL = 109056, L5_L8 = 141824;
__device__ __forceinline__ void s5_item(Frame& F, int item) {
    const int tid = F.tid, lane = F.lane, wave = F.wave;
    const int g = item & 31, b8 = item >> 5;
    LAS bf16* WgT = (LAS bf16*)(F.lds + L5_WG); LAS bf16* VgT = (LAS bf16*)(F.lds + L5_VG); LAS bf16* Kc = (LAS bf16*)(F.lds + L5_KC);
    LAS bf16* Us = (LAS bf16*)(F.lds + L5_U); LAS bf16* HS = (LAS bf16*)(F.lds + L5_HS); LAS float* HL = (LAS float*)(F.lds + L5_HL); LAS float* L8 = (LAS float*)(F.lds + L5_L8);
    LAS bf16* YS = (LAS bf16*)(F.lds + L5_HL);
    const bf16* U5 = (const bf16*)(F.ws + WS_U5) + (size_t)g * MTOK * 16; bf16* GY = (bf16*)(F.ws + WS_GY) + (size_t)g * MTOK * 16;
    { const bf16* WG = (const bf16*)(F.ws + WS_T5 + (size_t)g * T5_STRIDE); const bf16* VG = WG + T5_VG / 2; const bf16* KC = WG + T5_KC / 2;
#pragma unroll
      for (int i = 0; i < 4; ++i) { const int p = tid + 512 * i, r = p >> 4, kg = (p & 15) * 8; *(LAS v4u*)(WgT + r * S5_LD + kg) = *(const v4u*)(WG + r * 128 + kg); *(LAS v4u*)(VgT + r * S5_LD + kg) = *(const v4u*)(VG + r * 128 + kg); }
      if (tid < 288) *(LAS v4u*)(Kc + tid * 8) = *(const v4u*)(KC + tid * 8); }
    float qr[9], qi[9];
    { const float a_re = F.in[8][g * S5N + lane], a_im = F.in[9][g * S5N + lane], dt = expf(F.in[10][g]);
      const float mag = expf(a_re * dt); float p8r = mag * cosf(a_im * dt), p8i = mag * sinf(a_im * dt);
#pragma unroll
      for (int i = 0; i < 3; ++i) { const float t = p8r * p8r - p8i * p8i; p8i = 2.0f * p8r * p8i; p8r = t; }
      qr[0] = 1.f; qi[0] = 0.f;
#pragma unroll
      for (int i = 1; i < 9; ++i) { qr[i] = qr[i - 1] * p8r - qi[i - 1] * p8i; qi[i] = qr[i - 1] * p8i + qi[i - 1] * p8r; } }
    const float dl = F.in[15][g * 16 + (lane & 15)];
    const int rb = wave >> 2, cb = wave & 3, r32 = lane & 31, hh = lane >> 5;
    float h_re = 0.f, h_im = 0.f;
    float sre[2], sim[2];
#pragma unroll
    for (int i = 0; i < 2; ++i) { const size_t idx = (size_t)((16 * b8 + 2 * wave + i) * S5G + g) * S5N + lane; sre[i] = F.in[2][idx]; sim[i] = F.in[3][idx]; }
    v4u un0, un1;
    { const v4u* src = (const v4u*)(U5 + (size_t)(b8 * PB_T) * 16); un0 = src[tid]; un1 = src[tid + 512]; }
    for (int seg = 0; seg < 5; ++seg) {
        const bool samp = (seg == 4);
        const int tok0 = samp ? MP + 128 * b8 : b8 * PB_T + seg * 512;
        { const int p0 = tid, p1 = tid + 512;
          *(LAS v4u*)(Us + (p0 >> 4) * S5_LD + ((p0 >> 1) & 7) * 16 + (p0 & 1) * 8) = un0; *(LAS v4u*)(Us + (p1 >> 4) * S5_LD + ((p1 >> 1) & 7) * 16 + (p1 & 1) * 8) = un1;
          if (seg < 3) { const v4u* src = (const v4u*)(U5 + (size_t)(b8 * PB_T + (seg + 1) * 512) * 16); un0 = src[tid]; un1 = src[tid + 512]; }
          else if (seg == 3) { const v4u* src = (const v4u*)(U5 + (size_t)(MP + 128 * b8) * 16); if (tid < 256) un0 = src[tid]; } }
        __syncthreads();
        { f32x16 acc = {};
#pragma unroll
          for (int s = 0; s < 8; ++s) { const s16x8 a = *(const LAS s16x8*)(Us + (32 * rb + r32) * S5_LD + s * 16 + 8 * hh); const s16x8 b = *(const LAS s16x8*)(WgT + (32 * cb + r32) * S5_LD + s * 16 + 8 * hh);
              acc = __builtin_amdgcn_mfma_f32_32x32x16_bf16(a, b, acc, 0, 0, 0); }
#pragma unroll
          for (int r = 0; r < 16; ++r) HL[(32 * rb + (r & 3) + 8 * (r >> 2) + 4 * hh) * 128 + 32 * cb + r32] = acc[r]; }
        __syncthreads();
        if (!samp) {
            float xr[8], xi[8], lr[9], li[9];
#pragma unroll
            for (int i = 0; i < 8; ++i) { xr[i] = HL[(8 * wave + i) * 128 + lane]; xi[i] = HL[(8 * wave + i) * 128 + 64 + lane]; }
            lr[0] = 0.f; li[0] = 0.f;
#pragma unroll
            for (int i = 0; i < 8; ++i) { lr[i + 1] = qr[1] * lr[i] - qi[1] * li[i] + xr[i]; li[i + 1] = qr[1] * li[i] + qi[1] * lr[i] + xi[i]; }
            L8[wave * 128 + lane] = lr[8]; L8[wave * 128 + 64 + lane] = li[8];
            __syncthreads();
            float cr = h_re, ci = h_im, mr = h_re, mi = h_im;
#pragma unroll
            for (int w = 0; w < 8; ++w) { const float tr = L8[w * 128 + lane], ti = L8[w * 128 + 64 + lane];
                const float nr = qr[8] * cr - qi[8] * ci + tr, ni = qr[8] * ci + qi[8] * cr + ti; cr = nr; ci = ni; if (w + 1 == wave) { mr = cr; mi = ci; } }
            h_re = cr; h_im = ci;
#pragma unroll
            for (int i = 0; i < 8; ++i) { const float sr = lr[i] + qr[i] * mr - qi[i] * mi, si = li[i] + qr[i] * mi + qi[i] * mr;
                HS[(8 * wave + i) * S5_LD + lane] = (bf16)f2bf(sr); HS[(8 * wave + i) * S5_LD + 64 + lane] = (bf16)f2bf(si); }
            if (seg == 3 && wave == 0) { F.out[O_PRE + (size_t)(b8 * S5G + g) * S5N + lane] = h_re; F.out[O_PIM + (size_t)(b8 * S5G + g) * S5N + lane] = h_im; }
        } else {
#pragma unroll
            for (int i = 0; i < 2; ++i) { const int r = 2 * wave + i; const size_t idx = (size_t)((16 * b8 + r) * S5G + g) * S5N + lane;
                HS[r * S5_LD + lane] = (bf16)f2bf(sre[i]); HS[r * S5_LD + 64 + lane] = (bf16)f2bf(sim[i]);
                F.out[O_SRE + idx] = qr[1] * sre[i] - qi[1] * sim[i] + HL[r * 128 + lane]; F.out[O_SIM + idx] = qr[1] * sim[i] + qi[1] * sre[i] + HL[r * 128 + 64 + lane]; }
        }
        __syncthreads();
        if (!(samp && rb == 1)) { f32x16 acc = {};
            const int tl = 2 * cb + ((lane >> 4) & 1), c = lane & 15;
#pragma unroll
            for (int s = 0; s < 8; ++s) if (s <= 2 * cb + 1) { const int j = tl - s, jj = j < 0 ? 8 : j;
                const s16x8 a = *(const LAS s16x8*)(Us + (32 * rb + r32) * S5_LD + s * 16 + 8 * hh); const s16x8 b = *(const LAS s16x8*)(Kc + (jj * 16 + c) * 16 + 8 * hh);
                acc = __builtin_amdgcn_mfma_f32_32x32x16_bf16(a, b, acc, 0, 0, 0); }
#pragma unroll
            for (int kb = 0; kb < 8; ++kb) { const s16x8 a = *(const LAS s16x8*)(HS + (32 * rb + r32) * S5_LD + kb * 16 + 8 * hh); const s16x8 b = *(const LAS s16x8*)(VgT + (32 * cb + r32) * S5_LD + kb * 16 + 8 * hh);
                acc = __builtin_amdgcn_mfma_f32_32x32x16_bf16(a, b, acc, 0, 0, 0); }
#pragma unroll
            for (int r = 0; r < 16; ++r) { const int row = 32 * rb + (r & 3) + 8 * (r >> 2) + 4 * hh;
                const float u = bf2f(Us[row * S5_LD + tl * 16 + c]); YS[row * 128 + 32 * cb + r32] = (bf16)f2bf(gelu_tanh(acc[r] + dl * u)); }
        }
        __syncthreads();
        { v4u* dst = (v4u*)(GY + (size_t)tok0 * 16);
          if (!samp) { dst[tid] = *(const LAS v4u*)(YS + tid * 8); dst[tid + 512] = *(const LAS v4u*)(YS + (tid + 512) * 8); }
          else if (tid < 256) dst[tid] = *(const LAS v4u*)(YS + tid * 8); }
        __syncthreads();
    }
}
typedef float f32x4v __attribute__((ext_vector_type(4)));
constexpr int HG_LDQ = 136, HG_LDT = 72;
constexpr size_t WS_DSC = WS_XN;
constexpr size_t WS_DEC = WS_CTL + 1 * MiB;
#define HG_GATES(NEEDQ) \
    float gl[16], kk[16], qq[16]; float run = 0.f; \
    _Pragma("unroll") for (int i = 0; i < 16; ++i) { const size_t tok = (size_t)(tok0 + 16 * tq + i); const float fz = FZ[tok * 512 + col]; if (NEEDQ) qq[i] = bf2f(PB[tok * PBW + 512 + col]); \
        const float sg = 1.0f / (1.0f + __expf(-fz)), f = lb + (1.0f - lb) * sg; kk[i] = 1.0f - f; run += __log2f(f); gl[i] = run; } \
    TOT[tq * 128 + ch] = run;
#define HG_VT_LOAD() \
    _Pragma("unroll") for (int i = 0; i < 2; ++i) { const int p = tid + 512 * i, vg = p >> 6, tk = p & 63; const v4u w = *(const v4u*)(PB + (size_t)(tok0 + tk) * PBW + 1024 + h * HD + vg * 8); \
        LAS bf16* d = Vt + (vg * 8) * HG_LDT + tk; d[0] = (bf16)(w.x & 0xffffu); d[HG_LDT] = (bf16)(w.x >> 16); d[2 * HG_LDT] = (bf16)(w.y & 0xffffu); d[3 * HG_LDT] = (bf16)(w.y >> 16); \
        d[4 * HG_LDT] = (bf16)(w.z & 0xffffu); d[5 * HG_LDT] = (bf16)(w.z >> 16); d[6 * HG_LDT] = (bf16)(w.w & 0xffffu); d[7 * HG_LDT] = (bf16)(w.w >> 16); }

constexpr int LA_KT = 0, LA_VT = 18432, LA_TOT = 36864;
__device__ __forceinline__ void hgA_item(Frame& F, int item) {
    const int tid = F.tid, lane = F.lane, wave = F.wave;
    const int bh = item >> 5, chunk = item & 31, b = bh >> 2, h = bh & 3, tok0 = b * PB_T + chunk * 64;
    LAS bf16* Kt = (LAS bf16*)(F.lds + LA_KT); LAS bf16* Vt = (LAS bf16*)(F.lds + LA_VT); LAS float* TOT = (LAS float*)(F.lds + LA_TOT);
    const bf16* PB = (const bf16*)(F.ws + WS_PB); const float* FZ = (const float*)(F.ws + WS_FZ);
    bf16* DSC = (bf16*)(F.ws + WS_DSC) + (size_t)item * HD * HD; float* DEC = (float*)(F.ws + WS_DEC) + (size_t)item * HD;
    const int ch = tid & 127, tq = tid >> 7, col = h * HD + ch;
    const float lb = 1.0f / (1.0f + expf(F.in[5][512 + col] - F.in[5][col]));
    HG_GATES(false)
    HG_VT_LOAD()
    __syncthreads();
    { const float t0 = TOT[ch], t1 = TOT[128 + ch], t2 = TOT[256 + ch], t3 = TOT[384 + ch];
      const float glast = (t0 + t1) + (t2 + t3), off = (tq == 0 ? 0.f : tq == 1 ? t0 : tq == 2 ? t0 + t1 : t0 + t1 + t2);
      unsigned kp[8];
#pragma unroll
      for (int i = 0; i < 16; ++i) { const unsigned kb = f2bf(kk[i] * __builtin_amdgcn_exp2f(glast - (off + gl[i]))); if (i & 1) kp[i >> 1] |= kb << 16; else kp[i >> 1] = kb; }
      LAS v4u* kd = (LAS v4u*)(Kt + ch * HG_LDT + 16 * tq); v4u a, c2; a.x = kp[0]; a.y = kp[1]; a.z = kp[2]; a.w = kp[3]; c2.x = kp[4]; c2.y = kp[5]; c2.z = kp[6]; c2.w = kp[7]; kd[0] = a; kd[1] = c2;
      if (tq == 0) DEC[ch] = __builtin_amdgcn_exp2f(glast); }
    __syncthreads();
    { const int r32 = lane & 31, hh = lane >> 5, kb = wave >> 1;
#pragma unroll
      for (int vbi = 0; vbi < 2; ++vbi) { const int vb = 2 * (wave & 1) + vbi; f32x16 acc = {};
#pragma unroll
          for (int ks = 0; ks < 4; ++ks) { const s16x8 a = *(const LAS s16x8*)(Kt + (32 * kb + r32) * HG_LDT + 16 * ks + 8 * hh); const s16x8 bb = *(const LAS s16x8*)(Vt + (32 * vb + r32) * HG_LDT + 16 * ks + 8 * hh);
              acc = __builtin_amdgcn_mfma_f32_32x32x16_bf16(a, bb, acc, 0, 0, 0); }
          bf16* dst = DSC + (size_t)(32 * vb + r32) * HD + 32 * kb + 4 * hh;
#pragma unroll
          for (int q = 0; q < 4; ++q) { v2u w; w.x = pk2(acc[4 * q], acc[4 * q + 1]); w.y = pk2(acc[4 * q + 2], acc[4 * q + 3]); *(v2u*)(dst + 8 * q) = w; } } }
    __syncthreads();
}
__device__ __forceinline__ void hg_scan(Frame& F, bf16* DSO) {
    bf16* DSC = (bf16*)(F.ws + WS_DSC); const float* DEC = (const float*)(F.ws + WS_DEC);
    for (int T = F.bid * 512 + F.tid; T < 32 * 4096; T += F.G * 512) {
        const int bh = T >> 12, e = T & 4095, v = e >> 5, k4 = (e & 31) * 4;
        f32x4 S = {0.f, 0.f, 0.f, 0.f};
#pragma unroll 1
        for (int c0 = 0; c0 < 32; c0 += 8) {
            v2u x[8]; f32x4 d[8];
#pragma unroll
            for (int c = 0; c < 8; ++c) { const size_t it = (size_t)(bh * 32 + c0 + c); x[c] = *(const v2u*)(DSC + (it * HD + v) * HD + k4); d[c] = *(const f32x4*)(DEC + it * HD + k4); }
#pragma unroll
            for (int c = 0; c < 8; ++c) { const size_t it = (size_t)(bh * 32 + c0 + c); v2u o; o.x = pk2(S.x, S.y); o.y = pk2(S.z, S.w); *(v2u*)(DSO + (it * HD + v) * HD + k4) = o;
                S.x = d[c].x * S.x + bflo(x[c].x); S.y = d[c].y * S.y + bfhi(x[c].x); S.z = d[c].z * S.z + bflo(x[c].y); S.w = d[c].w * S.w + bfhi(x[c].y); }
        }
        float* o = F.out + O_PHG + (size_t)bh * HD * HD + (size_t)k4 * HD + v;
        o[0] = S.x; o[HD] = S.y; o[2 * HD] = S.z; o[3 * HD] = S.w;
    }
}
constexpr int LC_QS = 0, LC_QH = 17408, LC_KS = 34816, LC_VT = 52224, LC_AT = 70656, LC_SC = 79872, LC_TOT = 114688, LC_SS = 116736;
__device__ __forceinline__ void hgC_item(Frame& F, int item) {
    const int tid = F.tid, lane = F.lane, wave = F.wave;
    const int bh = item >> 5, chunk = item & 31, b = bh >> 2, h = bh & 3, tok0 = b * PB_T + chunk * 64;
    LAS bf16* Qs = (LAS bf16*)(F.lds + LC_QS); LAS bf16* Qh = (LAS bf16*)(F.lds + LC_QH); LAS bf16* Ks = (LAS bf16*)(F.lds + LC_KS); LAS bf16* Vt = (LAS bf16*)(F.lds + LC_VT);
    LAS bf16* At = (LAS bf16*)(F.lds + LC_AT); LAS bf16* SC = (LAS bf16*)(F.lds + LC_SC); LAS float* TOT = (LAS float*)(F.lds + LC_TOT); LAS float* SS = (LAS float*)(F.lds + LC_SS);
    const bf16* PB = (const bf16*)(F.ws + WS_PB); const float* FZ = (const float*)(F.ws + WS_FZ); bf16* MIX = (bf16*)(F.ws + WS_MIX);
    const bf16* DSC = (const bf16*)(F.ws + WS_DSC) + (size_t)item * HD * HD;
    const int ch = tid & 127, tq = tid >> 7, col = h * HD + ch;
    const float lb = 1.0f / (1.0f + expf(F.in[5][512 + col] - F.in[5][col]));
#pragma unroll
    for (int i = 0; i < 4; ++i) { const int p = tid + 512 * i, v = p >> 4, kg = (p & 15) * 8; *(LAS v4u*)(SC + v * HG_LDQ + kg) = *(const v4u*)(DSC + (size_t)v * HD + kg); }
    HG_GATES(true)
    HG_VT_LOAD()
    __syncthreads();
    { const float t0 = TOT[ch], t1 = TOT[128 + ch], t2 = TOT[256 + ch];
      const float gref = t0 + t1, off = (tq == 0 ? 0.f : tq == 1 ? t0 : tq == 2 ? gref : gref + t2);
#pragma unroll
      for (int i = 0; i < 16; ++i) { const float G = off + gl[i], e1 = __builtin_amdgcn_exp2f(G - gref), e2 = __builtin_amdgcn_rcpf(e1), e3 = __builtin_amdgcn_exp2f(G);
          Qs[(16 * tq + i) * HG_LDQ + ch] = (bf16)f2bf(qq[i] * e1); Ks[(16 * tq + i) * HG_LDQ + ch] = (bf16)f2bf(kk[i] * e2); Qh[(16 * tq + i) * HG_LDQ + ch] = (bf16)f2bf(qq[i] * e3); } }
    __syncthreads();
    const int r32 = lane & 31, hh = lane >> 5;
    if (wave < 4) { const int tb = wave >> 1, sb = wave & 1; f32x16 acc = {};
        if (sb <= tb) {
#pragma unroll
            for (int ks = 0; ks < 8; ++ks) { const s16x8 a = *(const LAS s16x8*)(Qs + (32 * tb + r32) * HG_LDQ + 16 * ks + 8 * hh); const s16x8 bb = *(const LAS s16x8*)(Ks + (32 * sb + r32) * HG_LDQ + 16 * ks + 8 * hh);
                acc = __builtin_amdgcn_mfma_f32_32x32x16_bf16(a, bb, acc, 0, 0, 0); } }
        const int s = 32 * sb + r32;
#pragma unroll
        for (int r = 0; r < 16; ++r) { const int t = 32 * tb + (r & 3) + 8 * (r >> 2) + 4 * hh; At[t * HG_LDT + s] = (s <= t) ? (bf16)f2bf(acc[r]) : (bf16)0; } }
    __syncthreads();
    const int tb = wave >> 2, vb = wave & 3, t = 32 * tb + r32;
    v2u og[4];
#pragma unroll
    for (int q = 0; q < 4; ++q) og[q] = *(const v2u*)(PB + (size_t)(tok0 + t) * PBW + 1536 + h * HD + 32 * vb + 8 * q + 4 * hh);
    f32x16 acc = {};
#pragma unroll
    for (int ks = 0; ks < 4; ++ks) if (ks < 2 * tb + 2) { const s16x8 a = *(const LAS s16x8*)(Vt + (32 * vb + r32) * HG_LDT + 16 * ks + 8 * hh); const s16x8 bb = *(const LAS s16x8*)(At + t * HG_LDT + 16 * ks + 8 * hh);
        acc = __builtin_amdgcn_mfma_f32_32x32x16_bf16(a, bb, acc, 0, 0, 0); }
#pragma unroll
    for (int ks = 0; ks < 8; ++ks) { const s16x8 a = *(const LAS s16x8*)(SC + (32 * vb + r32) * HG_LDQ + 16 * ks + 8 * hh); const s16x8 bb = *(const LAS s16x8*)(Qh + t * HG_LDQ + 16 * ks + 8 * hh);
        acc = __builtin_amdgcn_mfma_f32_32x32x16_bf16(a, bb, acc, 0, 0, 0); }
    { float ss = 0.f;
#pragma unroll
      for (int r = 0; r < 16; ++r) ss += acc[r] * acc[r];
      ss += __shfl_xor(ss, 32);
      if (hh == 0) SS[t * 4 + vb] = ss; }
    __syncthreads();
    { const f32x4 s4 = *(const LAS f32x4*)(SS + t * 4); const float rstd = 1.0f / sqrtf(((s4.x + s4.y) + (s4.z + s4.w)) * (1.0f / HD) + EPS);
#pragma unroll
      for (int q = 0; q < 4; ++q) { const int v0 = 32 * vb + 8 * q + 4 * hh; const f32x4 gn = *(const GAS f32x4*)(F.in[17] + v0);
          v2u w; w.x = pk2(acc[4 * q] * rstd * gn.x * siluf_(bflo(og[q].x)), acc[4 * q + 1] * rstd * gn.y * siluf_(bfhi(og[q].x)));
          w.y = pk2(acc[4 * q + 2] * rstd * gn.z * siluf_(bflo(og[q].y)), acc[4 * q + 3] * rstd * gn.w * siluf_(bfhi(og[q].y)));
          *(v2u*)(MIX + (size_t)(tok0 + t) * DM + 512 + h * HD + v0) = w; } }
    __syncthreads();
}
constexpr int LX_Q = 0, LX_K2 = 4096, LX_K3 = 8192, LX_V = 12288, LX_DEC = 16384, LX_ATT = 16896, LX_OP = 17152, LX_OT = 33536;
__device__ __forceinline__ void hgrn_sample_item(Frame& F, int idx) {
    const int tid = F.tid, b = idx >> 2, h = idx & 3;
    LAS float* Qs = (LAS float*)(F.lds + LX_Q); LAS float* K2 = (LAS float*)(F.lds + LX_K2); LAS float* K3 = (LAS float*)(F.lds + LX_K3); LAS float* Vs = (LAS float*)(F.lds + LX_V);
    LAS float* DEC = (LAS float*)(F.lds + LX_DEC); LAS float* ATT = (LAS float*)(F.lds + LX_ATT); LAS float* OP = (LAS float*)(F.lds + LX_OP); LAS float* OT = (LAS float*)(F.lds + LX_OT);
    const bf16* PB = (const bf16*)(F.ws + WS_PB); const float* FZ = (const float*)(F.ws + WS_FZ); bf16* MIX = (bf16*)(F.ws + WS_MIX);
    const float* S0 = F.in[4] + (size_t)idx * HD * HD; float* Sout = F.out + O_SHG + (size_t)idx * HD * HD;
    const int tok0 = MP + b * SB_T;
    const int v = tid & 127, kq = tid >> 7;
    float s0[32];
#pragma unroll
    for (int j = 0; j < 32; ++j) s0[j] = S0[(size_t)(32 * kq + j) * HD + v];
    if (tid < 128) { const int col = h * HD + tid; const float lb = 1.0f / (1.0f + expf(F.in[5][512 + col] - F.in[5][col]));
        float gl[8], kk[8], qq[8]; float run = 0.f;
#pragma unroll
        for (int t = 0; t < 8; ++t) { const size_t tok = (size_t)(tok0 + t); const float fz = FZ[tok * 512 + col]; qq[t] = bf2f(PB[tok * PBW + 512 + col]);
            const float sg = 1.0f / (1.0f + __expf(-fz)), f = lb + (1.0f - lb) * sg; kk[t] = 1.0f - f; run += __log2f(f); gl[t] = run; }
#pragma unroll
        for (int t = 0; t < 8; ++t) { Qs[t * 128 + tid] = qq[t] * __builtin_amdgcn_exp2f(gl[t]); K2[t * 128 + tid] = kk[t] * __builtin_amdgcn_exp2f(-gl[t]); K3[t * 128 + tid] = kk[t] * __builtin_amdgcn_exp2f(run - gl[t]); }
        DEC[tid] = __builtin_amdgcn_exp2f(run);
    } else if (tid < 256) { const int vv = tid - 128;
#pragma unroll
        for (int t = 0; t < 8; ++t) Vs[t * 128 + vv] = bf2f(PB[(size_t)(tok0 + t) * PBW + 1024 + h * HD + vv]);
    }
    __syncthreads();
    { const int p = tid >> 3, part = tid & 7, t = p >> 3, s = p & 7; float a = 0.f;
#pragma unroll
      for (int j = 0; j < 16; ++j) a += Qs[t * 128 + part + 8 * j] * K2[s * 128 + part + 8 * j];
      a += __shfl_xor(a, 1); a += __shfl_xor(a, 2); a += __shfl_xor(a, 4);
      if (part == 0) ATT[p] = (s <= t) ? a : 0.f; }
    float vr[8], o[8];
#pragma unroll
    for (int t = 0; t < 8; ++t) { vr[t] = Vs[t * 128 + v]; o[t] = 0.f; }
#pragma unroll
    for (int j = 0; j < 32; ++j) { const int k = 32 * kq + j; const float sv = s0[j]; float sn = DEC[k] * sv;
#pragma unroll
        for (int t = 0; t < 8; ++t) { o[t] += Qs[t * 128 + k] * sv; sn += K3[t * 128 + k] * vr[t]; }
        Sout[(size_t)k * HD + v] = sn; }
#pragma unroll
    for (int t = 0; t < 8; ++t) OP[(kq * 8 + t) * 128 + v] = o[t];
    __syncthreads();
#pragma unroll
    for (int r = 0; r < 2; ++r) { const int e = tid + 512 * r, t = e >> 7, vv = e & 127;
        float acc = (OP[(0 * 8 + t) * 128 + vv] + OP[(1 * 8 + t) * 128 + vv]) + (OP[(2 * 8 + t) * 128 + vv] + OP[(3 * 8 + t) * 128 + vv]);
#pragma unroll
        for (int s = 0; s < 8; ++s) acc += ATT[t * 8 + s] * Vs[s * 128 + vv];
        OT[t * 128 + vv] = acc; }
    __syncthreads();
    { const int t = F.wave, lane = F.lane; const float o0 = OT[t * 128 + 2 * lane], o1 = OT[t * 128 + 2 * lane + 1];
      const float rstd = 1.0f / sqrtf(wave_sum(o0 * o0 + o1 * o1) * (1.0f / HD) + EPS);
      const unsigned gw2 = *(const unsigned*)(PB + (size_t)(tok0 + t) * PBW + 1536 + h * HD + 2 * lane);
      const float g0 = F.in[17][2 * lane], g1 = F.in[17][2 * lane + 1];
      *(unsigned*)(MIX + (size_t)(tok0 + t) * DM + 512 + h * HD + 2 * lane) = pk2(o0 * rstd * g0 * siluf_(bflo(gw2)), o1 * rstd * g1 * siluf_(bfhi(gw2))); }
    __syncthreads();
}
constexpr int SG_LD = 68;
template <int KSTEPS  >
__device__ __forceinline__ void small_gemm_tile(Frame& F, const bf16* A, int lda, const bf16* Bt, int K, int r0, int c0, float (&v)[8]) {
    const int lane = F.lane, wave = F.wave, fr = lane & 15, fq = lane >> 4;
    f32x4v acc[4][4];
#pragma unroll
    for (int a = 0; a < 4; ++a)
#pragma unroll
        for (int b = 0; b < 4; ++b) acc[a][b] = (f32x4v){0.f, 0.f, 0.f, 0.f};
    const bf16* ap = A + (size_t)(r0 + fr) * lda + wave * (KSTEPS * 32) + 8 * fq;
    const bf16* bp = Bt + (size_t)(c0 + fr) * K + wave * (KSTEPS * 32) + 8 * fq;
#pragma unroll 2
    for (int ks = 0; ks < KSTEPS; ++ks) {
        s16x8 af[4], bf[4];
#pragma unroll
        for (int i = 0; i < 4; ++i) { af[i] = *(const s16x8*)(ap + (size_t)(16 * i) * lda + 32 * ks); bf[i] = *(const s16x8*)(bp + (size_t)(16 * i) * K + 32 * ks); }
#pragma unroll
        for (int a = 0; a < 4; ++a)
#pragma unroll
            for (int b = 0; b < 4; ++b) acc[a][b] = __builtin_amdgcn_mfma_f32_16x16x32_bf16(bf[b], af[a], acc[a][b], 0, 0, 0);
    }
    LAS float* part = (LAS float*)F.lds + wave * (64 * SG_LD);
#pragma unroll
    for (int a = 0; a < 4; ++a)
#pragma unroll
        for (int b = 0; b < 4; ++b) *(LAS f32x4v*)(part + (16 * a + fr) * SG_LD + 16 * b + 4 * fq) = acc[a][b];
    __syncthreads();
    { const int row = F.tid >> 3, cg8 = (F.tid & 7) * 8; const LAS float* p = (const LAS float*)F.lds + row * SG_LD + cg8;
      f32x4v s0 = {0.f, 0.f, 0.f, 0.f}, s1 = {0.f, 0.f, 0.f, 0.f};
#pragma unroll
      for (int w = 0; w < 8; ++w) { s0 += *(const LAS f32x4v*)(p + w * (64 * SG_LD)); s1 += *(const LAS f32x4v*)(p + w * (64 * SG_LD) + 4); }
      v[0] = s0[0]; v[1] = s0[1]; v[2] = s0[2]; v[3] = s0[3]; v[4] = s1[0]; v[5] = s1[1]; v[6] = s1[2]; v[7] = s1[3]; }
    __syncthreads();
}

__device__ __forceinline__ void outproj_sample_tile(Frame& F, int tile, float* SS1) {
    const int rm = tile >> 4, cn = tile & 15; float v[8];
    small_gemm_tile<4>(F, (const bf16*)(F.ws + WS_MIX), DM, (const bf16*)(F.ws + WS_WOUT), DM, MP + 64 * rm, 64 * cn, v);
    const int row = MP + 64 * rm + (F.tid >> 3), col = 64 * cn + 8 * (F.tid & 7); const size_t off = (size_t)row * DM + col;
    const float* xs = F.in[1] + (size_t)(row - MP) * DM + col; bf16* XN = (bf16*)(F.ws + WS_XN);
    const f32x4v xa = *(const f32x4v*)xs, xb = *(const f32x4v*)(xs + 4);
    const f32x4v x0 = {xa[0] + v[0], xa[1] + v[1], xa[2] + v[2], xa[3] + v[3]}, x1 = {xb[0] + v[4], xb[1] + v[5], xb[2] + v[6], xb[3] + v[7]};
    v4u w; w.x = pk2(x0[0], x0[1]); w.y = pk2(x0[2], x0[3]); w.z = pk2(x1[0], x1[1]); w.w = pk2(x1[2], x1[3]);
    *(v4u*)(XN + off) = w;
    float ss = (x0[0] * x0[0] + x0[1] * x0[1]) + (x0[2] * x0[2] + x0[3] * x0[3]) + (x1[0] * x1[0] + x1[1] * x1[1]) + (x1[2] * x1[2] + x1[3] * x1[3]);
    ss += __shfl_xor(ss, 1); ss += __shfl_xor(ss, 2); ss += __shfl_xor(ss, 4);
    if ((F.tid & 7) == 0) __hip_atomic_fetch_add(SS1 + row, ss, __ATOMIC_RELAXED, __HIP_MEMORY_SCOPE_AGENT);
}
__device__ __forceinline__ void down_sample_tile(Frame& F, int tile, float* SS2, unsigned* cntb, float* YO) {
    const int rm = tile >> 4, cn = tile & 15; float v[8];
    small_gemm_tile<11>(F, (const bf16*)(F.ws + WS_ACT), DFF, (const bf16*)(F.ws + WS_WD), DFF, MP + 64 * rm, 64 * cn, v);
    const int row = MP + 64 * rm + (F.tid >> 3), col = 64 * cn + 8 * (F.tid & 7); const size_t off = (size_t)row * DM + col;
    unsigned* cnt = cntb + 64 * rm; const v4u xw = *(const v4u*)((const bf16*)(F.ws + WS_XN) + off);
    const f32x4v xa = {bflo(xw.x), bfhi(xw.x), bflo(xw.y), bfhi(xw.y)}, xb = {bflo(xw.z), bfhi(xw.z), bflo(xw.w), bfhi(xw.w)}, ga = *(const f32x4v*)(F.in[23] + col), gb = *(const f32x4v*)(F.in[23] + col + 4);
    const f32x4v x0 = {xa[0] + v[0], xa[1] + v[1], xa[2] + v[2], xa[3] + v[3]}, x1 = {xb[0] + v[4], xb[1] + v[5], xb[2] + v[6], xb[3] + v[7]};
    float ss = (x0[0] * x0[0] + x0[1] * x0[1]) + (x0[2] * x0[2] + x0[3] * x0[3]) + (x1[0] * x1[0] + x1[1] * x1[1]) + (x1[2] * x1[2] + x1[3] * x1[3]);
    ss += __shfl_xor(ss, 1); ss += __shfl_xor(ss, 2); ss += __shfl_xor(ss, 4);
    if ((F.tid & 7) == 0) __hip_atomic_fetch_add(SS2 + row, ss, __ATOMIC_RELAXED, __HIP_MEMORY_SCOPE_AGENT);
    asm volatile("s_waitcnt vmcnt(0)" ::: "memory");
    __syncthreads();
    if (F.tid == 0) { __hip_atomic_fetch_add(cnt, 1u, __ATOMIC_RELAXED, __HIP_MEMORY_SCOPE_AGENT); wait_count(cnt, 16u); }
    __syncthreads();
    float s = 0.f; if ((F.tid & 7) == 0) s = atomic_read_f32(SS2 + row);
    const float rs = rstd_of(__shfl(s, F.lane & ~7));
    *(f32x4v*)(YO + off) = (f32x4v){x0[0] * rs * ga[0], x0[1] * rs * ga[1], x0[2] * rs * ga[2], x0[3] * rs * ga[3]};
    *(f32x4v*)(YO + off + 4) = (f32x4v){x1[0] * rs * gb[0], x1[1] * rs * gb[1], x1[2] * rs * gb[2], x1[3] * rs * gb[3]};
}
typedef GAS unsigned gu32;
#define RLX_AGENT __ATOMIC_RELAXED, __HIP_MEMORY_SCOPE_AGENT
constexpr int MISC_OFF = LDS_BYTES - 512;
constexpr int CW_QUEUE = 8192;
constexpr int CW_BAR = 4096;
constexpr size_t CTL_ZERO_BYTES = 524288;
constexpr int CW_DUMMY = 65536;
#define XB_TMO      128
#define XB_XCNT(j)  (256  + 64 * (j))
#define XB_XSUB(j)  (1280 + 64 * (j))
#define XB_XGEN(j)  (2304 + 64 * (j))
#define XB_TOP      3328
#define XB_TOPGEN   3392
#define XCD_BAR_WORDS 3456
#define XB_SPIN_CAP (1u << 18)

__device__ __forceinline__ unsigned xb_ld(unsigned* p)              { return __hip_atomic_load(p, __ATOMIC_RELAXED, __HIP_MEMORY_SCOPE_AGENT); }
__device__ __forceinline__ unsigned xb_add(unsigned* p, unsigned v) { return __hip_atomic_fetch_add(p, v, __ATOMIC_RELAXED, __HIP_MEMORY_SCOPE_AGENT); }
__device__ __forceinline__ unsigned xb_xcc_id() { return (unsigned)__builtin_amdgcn_s_getreg((3 << 11) | 20) & 0xFu; }
#define XB_SPIN(cond, bar) do { unsigned _sp = 0; while (cond) { __builtin_amdgcn_s_sleep(1); \
    if ((++_sp & 255u) == 0u) { if (xb_ld(&(bar)[XB_TMO])) break; if (_sp > XB_SPIN_CAP) { atomicAdd(&(bar)[XB_TMO], 1u); break; } } } } while (0)

struct XcdBarrier {
    unsigned* bar; unsigned x;
    volatile LAS unsigned* st;
};

__device__ __forceinline__ XcdBarrier xcd_barrier_post(unsigned* bar, volatile LAS unsigned* st) {
    XcdBarrier b; b.bar = bar; b.x = xb_xcc_id(); b.st = st;
    if (threadIdx.x == 0) (void)xb_add(&bar[XB_XCNT(b.x)], 1u);
    return b;
}
__device__ __forceinline__ void xcd_barrier_complete(unsigned* bar, unsigned x, unsigned& nloc, unsigned& nx) {
    const unsigned G = gridDim.x * gridDim.y * gridDim.z;
    unsigned sum, cnt, mine, sp = 0u;
    for (;;) {
        sum = 0u; cnt = 0u; mine = 0u;
#pragma unroll
        for (unsigned j = 0; j < 16; ++j) { const unsigned c = xb_ld(&bar[XB_XCNT(j)]); sum += c; cnt += (c > 0u) ? 1u : 0u; mine = (j == x) ? c : mine; }
        if (sum == G) break;
        __builtin_amdgcn_s_sleep(1);
        if ((++sp & 255u) == 0u) { if (xb_ld(&bar[XB_TMO])) break; if (sp > XB_SPIN_CAP) { atomicAdd(&bar[XB_TMO], 1u); break; } }
    }
    nloc = mine > 0u ? mine : 1u; nx = cnt > 0u ? cnt : 1u;
}

__device__ __forceinline__ void xcd_barrier(const XcdBarrier& b) {
    asm volatile("s_waitcnt vmcnt(0)" ::: "memory");
    __syncthreads();
    if (threadIdx.x == 0) {
        unsigned* bar = b.bar;
        __builtin_amdgcn_s_waitcnt(0);
        unsigned nloc = b.st[0], nx = b.st[1];
        if (nloc == 0u) { xcd_barrier_complete(bar, b.x, nloc, nx); b.st[0] = nloc; b.st[1] = nx; }
        const unsigned old = xb_add(&bar[XB_XSUB(b.x)], 1u);
        const unsigned gen = old / nloc;
        if (old + 1u == (gen + 1u) * nloc) {
            __builtin_amdgcn_fence(__ATOMIC_RELEASE, "agent");
            asm volatile("s_waitcnt vmcnt(0)" ::: "memory");
            const unsigned og = xb_add(&bar[XB_TOP], 1u);
            const unsigned tg = og / nx;
            if (og + 1u == (tg + 1u) * nx) xb_add(&bar[XB_TOPGEN], 1u);
            else XB_SPIN(xb_ld(&bar[XB_TOPGEN]) == tg, bar);
            __builtin_amdgcn_fence(__ATOMIC_ACQUIRE, "agent");
            xb_add(&bar[XB_XGEN(b.x)], 1u);
            asm volatile("s_waitcnt vmcnt(0)" ::: "memory");
        } else {
            XB_SPIN(xb_ld(&bar[XB_XGEN(b.x)]) == gen, bar);
            __builtin_amdgcn_fence(__ATOMIC_ACQUIRE, "agent");
            asm volatile("s_waitcnt vmcnt(0)" ::: "memory");
        }
    }
    __syncthreads();
}

__global__ void __launch_bounds__(NWAVES * 64, 2) mk_fwd(Args args) {
    extern __shared__ __attribute__((aligned(16))) unsigned char lds[];
    Frame F;
    F.lds = (LAS unsigned char*)lds;
    F.tid = threadIdx.x; F.lane = F.tid & 63; F.wave = __builtin_amdgcn_readfirstlane(F.tid >> 6);
    F.G = gridDim.x; F.bid = blockIdx.x;
#pragma unroll
    for (int i = 0; i < 24; ++i) F.in[i] = args.in[i];
    F.out = args.out; F.ws = args.ws;
    const int lo = args.ph_lo, hi = args.ph_hi;
#define IN(k) (lo <= (k) && (k) < hi)
#if MK_N_LAUNCHES == 1
    volatile LAS unsigned* MISC = (volatile LAS unsigned*)(F.lds + MISC_OFF);
    if (F.tid < 32) MISC[F.tid] = 0u;
    __syncthreads();
    XcdBarrier bar = xcd_barrier_post((unsigned*)(F.ws + WS_CTL) + CW_BAR, MISC + 8);
#define SEAM(k) do { if (IN(k) && IN((k) + 1)) xcd_barrier(bar); } while (0)
#else
#define SEAM(k) do { } while (0)
#endif
    const int gw = F.bid * NWAVES + F.wave, NGW = F.G * NWAVES;
    bf16* XN = (bf16*)(F.ws + WS_XN); bf16* PB = (bf16*)(F.ws + WS_PB); float* FZ = (float*)(F.ws + WS_FZ); bf16* GY = (bf16*)(F.ws + WS_GY);
    bf16* MIX = (bf16*)(F.ws + WS_MIX); bf16* ACT = (bf16*)(F.ws + WS_ACT);

    if (IN(0)) { p0_prologue(F);
#if REP_P0 == 2
        __syncthreads(); p0_prologue(F);
#endif
    } SEAM(0);
    if (IN(1)) {
        pg8::Gemm g{XN, (const bf16*)(F.ws + WS_WIN), MTOK, INC, DM}; pg8::StaticOrder S; S.init(MTOK, INC, F.G, F.bid);
        EpiIn E{PB, FZ, (bf16*)(F.ws + WS_U5)};
        pg8::gemm_phase<EpiIn, pg8::StaticOrder, true, true>(F.lds, g, S, E);
#if REP_P1 == 2
        __syncthreads();
        pg8::gemm_phase<EpiIn, pg8::StaticOrder, true, true>(F.lds, g, S, E);
#endif
    } SEAM(1);
    if (IN(2)) {
        for (int it = F.bid; it < 256; it += F.G) s5_item(F, it);
#if REP_S5 == 2
        for (int it = F.bid; it < 256; it += F.G) s5_item(F, it);
#endif
        for (int it = F.bid; it < 1024; it += F.G) hgA_item(F, it);
#if REP_HGA == 2
        for (int it = F.bid; it < 1024; it += F.G) hgA_item(F, it);
#endif
        for (int it = F.bid; it < SB_B * HH; it += F.G) hgrn_sample_item(F, it);
    } SEAM(2);
    if (IN(3)) {
#if REP_P3 == 2
        hg_scan(F, (bf16*)(F.ws + WS_MIX)); __syncthreads();
#endif
        hg_scan(F, (bf16*)(F.ws + WS_DSC)); } SEAM(3);
    if (IN(4)) {
        pg8::Gemm g{GY, (const bf16*)(F.ws + WS_WGLU), MTOK, S5W, S5W}; pg8::StaticOrder S; S.init(MTOK, S5W, F.G, F.bid);
        EpiGlu E{GY, MIX};
        pg8::gemm_phase<EpiGlu, pg8::StaticOrder, true, true, true>(F.lds, g, S, E);
#if REP_GLU == 2
        __syncthreads();
        pg8::gemm_phase<EpiGlu, pg8::StaticOrder, true, true, true>(F.lds, g, S, E);
#endif
        __syncthreads();
        gu32* ctr = (gu32*)(F.ws + WS_CTL) + CW_QUEUE; volatile LAS int* slot = (volatile LAS int*)(F.lds + MISC_OFF + 64);
        for (;;) { if (F.tid == 0) *slot = (int)__hip_atomic_fetch_add(ctr, 1u, RLX_AGENT); __syncthreads(); const int it = *slot; if (it >= 1024) break; hgC_item(F, it); }
#if REP_HGC == 2
        __syncthreads();
        for (;;) { if (F.tid == 0) *slot = (int)__hip_atomic_fetch_add(ctr + 64, 1u, RLX_AGENT); __syncthreads(); const int it = *slot; if (it >= 1024) break; hgC_item(F, it); }
#endif
    } SEAM(4);
    if (IN(5)) {
        pg8::Gemm g{MIX, (const bf16*)(F.ws + WS_WOUT), MP, DM, DM}; pg8::StaticOrder S; S.init(MP, DM, F.G, F.bid);
#if REP_P5 >= 2
        { EpiOut E2{F.in[0], XN, (float*)(F.ws + WS_CTL) + CW_DUMMY};
#if REP_P5 == 2 || REP_P5 == 3
          pg8::gemm_phase<EpiOut, pg8::StaticOrder, true, true>(F.lds, g, S, E2);
          __syncthreads();
#endif
#if REP_P5 == 2 || REP_P5 == 4
          for (int it = F.bid; it < 256; it += F.G) outproj_sample_tile(F, it, (float*)(F.ws + WS_CTL) + CW_DUMMY);
          __syncthreads();
#endif
        }
#endif
        EpiOut E{F.in[0], XN, (float*)(F.ws + WS_CTL) + CW_SS1};
        pg8::gemm_phase<EpiOut, pg8::StaticOrder, true, true>(F.lds, g, S, E);
        __syncthreads();
        for (int it = F.bid; it < 256; it += F.G) outproj_sample_tile(F, it, (float*)(F.ws + WS_CTL) + CW_SS1);
    } SEAM(5);
    if (IN(6)) {
        pg8::Gemm g{XN, (const bf16*)(F.ws + WS_WGU), MTOK, 2 * DFF, DM}; pg8::StaticOrder S; S.init(MTOK, 2 * DFF, F.G, F.bid);
        EpiAct E{ACT, (const float*)(F.ws + WS_CTL) + CW_SS1};
        pg8::gemm_phase<EpiAct, pg8::StaticOrder, true, true>(F.lds, g, S, E);
#if REP_P6 == 2
        __syncthreads();
        pg8::gemm_phase<EpiAct, pg8::StaticOrder, true, true>(F.lds, g, S, E);
#endif
    } SEAM(6);
    if (IN(7)) {
        pg8::Gemm g{ACT, (const bf16*)(F.ws + WS_WD), MP, DM, DFF}; pg8::StaticOrder S; S.init(MP, DM, F.G, F.bid);
#if REP_P7 == 2
        { float* YD = (float*)(F.ws + WS_GY) - 0;
          EpiDown E2{XN, F.in[23], (float*)(F.ws + WS_CTL) + CW_DUMMY, (unsigned*)(F.ws + WS_CTL) + CW_DUMMY + 20480, YD};
          pg8::gemm_phase<EpiDown, pg8::StaticOrder, true, true>(F.lds, g, S, E2);
          __syncthreads();
          for (int it = F.bid; it < 256; it += F.G) down_sample_tile(F, it, (float*)(F.ws + WS_CTL) + CW_DUMMY, (unsigned*)(F.ws + WS_CTL) + CW_DUMMY + 20480 + 4096, YD);
          __syncthreads(); }
#endif
        EpiDown E{XN, F.in[23], (float*)(F.ws + WS_CTL) + CW_SS2, (unsigned*)(F.ws + WS_CTL) + CW_CNT, F.out + O_Y};
        pg8::gemm_phase<EpiDown, pg8::StaticOrder, true, true>(F.lds, g, S, E);
        __syncthreads();
        for (int it = F.bid; it < 256; it += F.G) down_sample_tile(F, it, (float*)(F.ws + WS_CTL) + CW_SS2, (unsigned*)(F.ws + WS_CTL) + CW_CNTS, F.out + O_Y);
    }
#undef IN
#undef SEAM
}

extern "C" void kernel_launch(void* const* d_in, const int* in_sizes, int n_in, void* d_out, int out_size, void* d_ws, size_t ws_size, hipStream_t stream) {
    static int grid = 0;
    if (grid == 0) {
        if (n_in != 24 || ws_size < WS_END) { fprintf(stderr, "kernel_launch: unexpected n_in %d / ws %zu\n", n_in, ws_size); grid = -1; return; }
        int dev = 0, cus = 0, per_cu = 0;
        if (hipGetDevice(&dev) != hipSuccess || hipDeviceGetAttribute(&cus, hipDeviceAttributeMultiprocessorCount, dev) != hipSuccess) { grid = -1; return; }
        if (hipFuncSetAttribute((const void*)mk_fwd, hipFuncAttributeMaxDynamicSharedMemorySize, LDS_BYTES) != hipSuccess) { fprintf(stderr, "kernel_launch: hipFuncSetAttribute failed\n"); grid = -1; return; }
        if (hipOccupancyMaxActiveBlocksPerMultiprocessor(&per_cu, (const void*)mk_fwd, NWAVES * 64, LDS_BYTES) != hipSuccess || per_cu < 1) { fprintf(stderr, "kernel_launch: occupancy query says %d\n", per_cu); per_cu = 1; }
        (void)hipGetLastError();
        grid = cus;
    }
    if (grid < 0) return;
    if (hipMemsetAsync((char*)d_ws + WS_CTL, 0, CTL_ZERO_BYTES, stream) != hipSuccess) { fprintf(stderr, "kernel_launch: memset failed\n"); return; }
    Args a{};
    for (int i = 0; i < 24; ++i) a.in[i] = (const float*)d_in[i];
    a.out = (float*)d_out; a.ws = (unsigned char*)d_ws;
#if MK_N_LAUNCHES == 1
    a.ph_lo = 0; a.ph_hi = NPH;
    void* kargs[] = {&a};
    hipError_t e = hipLaunchCooperativeKernel((const void*)mk_fwd, dim3(grid), dim3(NWAVES * 64), kargs, LDS_BYTES, stream);
    if (e != hipSuccess) fprintf(stderr, "kernel_launch: cooperative launch failed: %s (grid %d)\n", hipGetErrorString(e), grid);
#else
    for (int p = 0; p < NPH; ++p) { a.ph_lo = p; a.ph_hi = p + 1; hipLaunchKernelGGL(mk_fwd, dim3(grid), dim3(NWAVES * 64), LDS_BYTES, stream, a); }
#endif
}
```

```cpp
#include <hip/hip_runtime.h>
#include <hip/hip_cooperative_groups.h>
#include <cstdio>
#include <cstdint>
namespace cg = cooperative_groups;
#define MK_N_LAUNCHES 1
namespace pg8 {
#define PG8_LAS __attribute__((address_space(3)))
typedef unsigned short bf16_t;
typedef short bf16x8 __attribute__((ext_vector_type(8)));
typedef float f32x4 __attribute__((ext_vector_type(4)));
typedef unsigned u32x4 __attribute__((ext_vector_type(4)));
constexpr int BM = 256, BK = 64, HALF = 128, HTB = HALF * BK * 2  , STAGE_BYTES = 8 * HTB, NXCD = 8, WGM = 8;

__host__ __device__ __forceinline__ int lds_byte(int r, int c) { const int st = (r >> 4) * 2 + (c >> 5), rr = r & 15, cc = c & 31, ob = rr * 64 + cc * 2; return st * 1024 + (ob ^ (((ob >> 9) & 1) << 5)); }
__host__ __device__ __forceinline__ void stage_rc(int b, int& R, int& C) { const int st = b / 1024, sb = b % 1024, swz = sb ^ (((sb >> 9) & 1) << 5); R = (st >> 1) * 16 + swz / 64; C = (st & 1) * 32 + (swz % 64) / 2; }
__host__ __device__ __forceinline__ int perm32(int rho) { const int n = rho >> 4, i = rho & 15; return 8 * (i >> 2) + 4 * n + (i & 3); }

struct Unit { int pm, pn; };
struct Gemm { const bf16_t* A; const bf16_t* Bt; int M, N, K; };

struct StaticOrder {
    int nM, nN, nwg, G, c;
    __host__ __device__ void init(int M, int N, int G_, int c_) { nM = M / BM; nN = N / BM; nwg = nM * nN; G = G_; c = c_; }
    __host__ __device__ bool next(int i, Unit& u) const {
        const long L = (long)i * G + c; if (L >= nwg) return false;
        int wgid = (int)L; { const int q = nwg / NXCD, r = nwg % NXCD, xcd = wgid % NXCD, off = wgid / NXCD; wgid = (xcd < r ? xcd * (q + 1) : r * (q + 1) + (xcd - r) * q) + off; }
        const int nig = WGM * nN, gid = wgid / nig, fm = gid * WGM, gsz = (nM - fm) < WGM ? (nM - fm) : WGM;
        u.pm = fm + ((wgid % nig) % gsz); u.pn = (wgid % nig) / gsz; return true;
    }
    __device__ __forceinline__ void a_ready(const Unit&) const {}
    __device__ __forceinline__ void done(const Unit&) const {}
};

__device__ __forceinline__ unsigned cvt_pk_bf16(float lo, float hi) { unsigned r; asm volatile("v_cvt_pk_bf16_f32 %0, %1, %2" : "=v"(r) : "v"(lo), "v"(hi)); return r; }
template <class Epi, class Sched, bool ALIGN_EPI = false, bool SP2 = false, bool AGM = false  >
__device__ __forceinline__ void gemm_phase(PG8_LAS unsigned char* lds, const Gemm g, const Sched& S, const Epi& E) {
    const int tid = threadIdx.x, wid = __builtin_amdgcn_readfirstlane(tid >> 6), lane = tid & 63, wr = wid >> 2, wc = wid & 3, fr = lane & 15, fq = lane >> 4;
    const int K = g.K, nt = K / BK;
    unsigned voffA[2], voffB[2];
#pragma unroll
    for (int i = 0; i < 2; ++i) { int R, C; stage_rc(tid * 16 + i * 8192, R, C); const int Rb = Epi::PERM ? ((R & ~31) + perm32(R & 31)) : R;
        voffA[i] = AGM ? (unsigned)((((C >> 4) * g.M + R) * 16 + (C & 15)) * 2) : (unsigned)(R * K + C) * 2u; voffB[i] = (unsigned)(Rb * K + C) * 2u; }
    const size_t kstep = (size_t)(BK * 2);
    const size_t hstep = (size_t)HALF * K * 2;
    const size_t tstep = 2 * hstep;
    const size_t kstepA = AGM ? (size_t)4 * g.M * 32 : kstep, hstepA = AGM ? (size_t)HALF * 32 : hstep, tstepA = 2 * hstepA;
    const unsigned ldsw = (unsigned)wid * 1024u;
    const int aoff = lds_byte(wr * 64 + fr, fq * 8), boff = lds_byte(wc * 32 + fr, fq * 8);
#define PG8_SA(b, h) (((b) * 2 + (h)) * HTB)
#define PG8_SB(b, h) ((4 + (b) * 2 + (h)) * HTB)
#define PG8_STAGE(bufoff, gbase, voff) do { _Pragma("unroll") for (int _i = 0; _i < 2; ++_i) \
        __builtin_amdgcn_global_load_lds((const unsigned*)((const char*)(gbase) + (voff)[_i]), (PG8_LAS unsigned*)(lds + (bufoff) + ldsw + _i * 8192), 16, 0, 0); } while (0)
#define PG8_LDA(dst, b, h) do { _Pragma("unroll") for (int m = 0; m < 4; ++m) _Pragma("unroll") for (int k = 0; k < 2; ++k) dst[m][k] = *(const PG8_LAS bf16x8*)(lds + PG8_SA(b, h) + aoff + m * 2048 + k * 1024); } while (0)
#define PG8_LDB(dst, b, h) do { _Pragma("unroll") for (int n = 0; n < 2; ++n) _Pragma("unroll") for (int k = 0; k < 2; ++k) dst[n][k] = *(const PG8_LAS bf16x8*)(lds + PG8_SB(b, h) + boff + n * 2048 + k * 1024); } while (0)
#define PG8_MMA(ai, bj, At, Bt) do { __builtin_amdgcn_s_setprio(1); _Pragma("unroll") for (int m = 0; m < 4; ++m) _Pragma("unroll") for (int n = 0; n < 2; ++n) _Pragma("unroll") for (int k = 0; k < 2; ++k) \
        acc[ai][bj][m][n] = __builtin_amdgcn_mfma_f32_16x16x32_bf16(Bt[n][k], At[m][k], acc[ai][bj][m][n], 0, 0, 0); __builtin_amdgcn_s_setprio(0); } while (0)
#define PG8_WAIT_V(n) asm volatile("s_waitcnt vmcnt(" #n ")" ::: "memory")
#define PG8_WAIT_L(n) asm volatile("s_waitcnt lgkmcnt(" #n ")" ::: "memory")
#define PG8_BAR __builtin_amdgcn_s_barrier()
#define PG8_SCHED __builtin_amdgcn_sched_barrier(0)
    Unit cur, nxt; int ui = 0;
    if (!S.next(0, cur)) return;
    f32x4 acc[2][2][4][2];
#pragma unroll
    for (int a = 0; a < 2; ++a)
#pragma unroll
        for (int b = 0; b < 2; ++b)
#pragma unroll
            for (int m = 0; m < 4; ++m)
#pragma unroll
                for (int n = 0; n < 2; ++n) acc[a][b][m][n] = (f32x4){0.f, 0.f, 0.f, 0.f};
    bf16x8 At[4][2], B0[2][2], B1[2][2];
    const char* cA = (const char*)g.A + (size_t)cur.pm * tstepA; const char* cB = (const char*)g.Bt + (size_t)cur.pn * tstep;
    S.a_ready(cur);
    if constexpr (SP2) {
        PG8_STAGE(PG8_SB(0, 0), cB, voffB); PG8_STAGE(PG8_SB(0, 1), cB + hstep, voffB); PG8_STAGE(PG8_SA(0, 0), cA, voffA); PG8_STAGE(PG8_SA(0, 1), cA + hstepA, voffA);
        if (wr == 1) PG8_BAR;
        PG8_WAIT_V(2); PG8_BAR;
        PG8_STAGE(PG8_SB(1, 0), cB + kstep, voffB); PG8_STAGE(PG8_SA(1, 0), cA + kstepA, voffA); PG8_STAGE(PG8_SB(1, 1), cB + hstep + kstep, voffB);
        PG8_WAIT_V(6); PG8_BAR;
    } else {
        PG8_STAGE(PG8_SB(0, 0), cB, voffB); PG8_STAGE(PG8_SA(0, 0), cA, voffA); PG8_STAGE(PG8_SB(0, 1), cB + hstep, voffB); PG8_STAGE(PG8_SA(0, 1), cA + hstepA, voffA);
        if (wr == 1) PG8_BAR;
        PG8_WAIT_V(4); PG8_BAR;
        PG8_STAGE(PG8_SB(1, 0), cB + kstep, voffB); PG8_STAGE(PG8_SA(1, 0), cA + kstepA, voffA); PG8_STAGE(PG8_SB(1, 1), cB + hstep + kstep, voffB);
        PG8_WAIT_V(6); PG8_BAR;
    }
    for (;;) {
        const bool has_next = S.next(ui + 1, nxt);
        const char* nA = has_next ? (const char*)g.A + (size_t)nxt.pm * tstepA : cA; const char* nB = has_next ? (const char*)g.Bt + (size_t)nxt.pn * tstep : cB;
        for (int t = 0; t < nt; t += 2) {
            const bool last = (t == nt - 2);
            const char* a1 = cA + (size_t)(t + 1) * kstepA;
            const char* a2 = last ? nA : cA + (size_t)(t + 2) * kstepA; const char* b2 = last ? nB : cB + (size_t)(t + 2) * kstep;
            const char* a3 = a2 + kstepA; const char* b3 = b2 + kstep;
            if (last && has_next) S.a_ready(nxt);
            if constexpr (SP2) {
            PG8_LDB(B0, 0, 0); PG8_LDB(B1, 0, 1); PG8_SCHED; PG8_LDA(At, 0, 0); PG8_STAGE(PG8_SA(1, 1), a1 + hstepA, voffA);
            PG8_WAIT_V(8); PG8_WAIT_L(0); PG8_BAR; PG8_MMA(0, 0, At, B0); PG8_MMA(0, 1, At, B1); PG8_BAR; PG8_SCHED;
            PG8_LDA(At, 0, 1); PG8_STAGE(PG8_SB(0, 0), b2, voffB); PG8_STAGE(PG8_SB(0, 1), b2 + hstep, voffB); PG8_STAGE(PG8_SA(0, 0), a2, voffA);
            PG8_WAIT_V(8); PG8_WAIT_L(0); PG8_BAR; PG8_MMA(1, 0, At, B0); PG8_MMA(1, 1, At, B1); PG8_BAR; PG8_SCHED;
            PG8_LDB(B0, 1, 0); PG8_LDB(B1, 1, 1); PG8_SCHED; PG8_LDA(At, 1, 0); PG8_STAGE(PG8_SA(0, 1), a2 + hstepA, voffA);
            PG8_WAIT_V(8); PG8_WAIT_L(0); PG8_BAR; PG8_MMA(0, 0, At, B0); PG8_MMA(0, 1, At, B1); PG8_BAR; PG8_SCHED;
            PG8_LDA(At, 1, 1); PG8_STAGE(PG8_SB(1, 0), b3, voffB); PG8_STAGE(PG8_SB(1, 1), b3 + hstep, voffB); PG8_STAGE(PG8_SA(1, 0), a3, voffA);
            PG8_WAIT_V(8); PG8_WAIT_L(0); PG8_BAR; PG8_MMA(1, 0, At, B0); PG8_MMA(1, 1, At, B1); PG8_BAR; PG8_SCHED;
            } else {
            PG8_LDB(B0, 0, 0); PG8_SCHED; PG8_LDA(At, 0, 0); PG8_STAGE(PG8_SA(1, 1), a1 + hstepA, voffA);
            PG8_WAIT_L(8); PG8_BAR; PG8_WAIT_L(0); PG8_MMA(0, 0, At, B0); PG8_BAR; PG8_SCHED;
            PG8_LDB(B1, 0, 1); PG8_STAGE(PG8_SB(0, 0), b2, voffB);
            PG8_BAR; PG8_WAIT_L(0); PG8_MMA(0, 1, At, B1); PG8_BAR;
            PG8_LDA(At, 0, 1); PG8_STAGE(PG8_SA(0, 0), a2, voffA);
            PG8_BAR; PG8_WAIT_L(0); PG8_MMA(1, 0, At, B0); PG8_BAR; PG8_SCHED;
            PG8_STAGE(PG8_SB(0, 1), b2 + hstep, voffB);
            PG8_WAIT_V(6); PG8_BAR; PG8_MMA(1, 1, At, B1); PG8_BAR;
            PG8_LDB(B0, 1, 0); PG8_SCHED; PG8_LDA(At, 1, 0); PG8_STAGE(PG8_SA(0, 1), a2 + hstepA, voffA);
            PG8_WAIT_L(8); PG8_BAR; PG8_WAIT_L(0); PG8_MMA(0, 0, At, B0); PG8_BAR; PG8_SCHED;
            PG8_LDB(B1, 1, 1); PG8_STAGE(PG8_SB(1, 0), b3, voffB);
            PG8_BAR; PG8_WAIT_L(0); PG8_MMA(0, 1, At, B1); PG8_BAR;
            PG8_LDA(At, 1, 1); PG8_STAGE(PG8_SA(1, 0), a3, voffA);
            PG8_BAR; PG8_WAIT_L(0); PG8_MMA(1, 0, At, B0); PG8_BAR; PG8_SCHED;
            PG8_STAGE(PG8_SB(1, 1), b3 + hstep, voffB);
            PG8_WAIT_V(6); PG8_BAR; PG8_MMA(1, 1, At, B1); PG8_BAR;
            }
        }
        if constexpr (ALIGN_EPI) { if (wr == 0) PG8_BAR; }
        if constexpr (!Epi::AFTER_DRAIN) { E(acc, cur, wr, wc, fr, fq); S.done(cur); }
        if (!has_next) break;
#pragma unroll
        for (int a = 0; a < 2; ++a)
#pragma unroll
            for (int b = 0; b < 2; ++b)
#pragma unroll
                for (int m = 0; m < 4; ++m)
#pragma unroll
                    for (int n = 0; n < 2; ++n) acc[a][b][m][n] = (f32x4){0.f, 0.f, 0.f, 0.f};
        cur = nxt; cA = nA; cB = nB; ++ui;
        if constexpr (ALIGN_EPI) { if (wr == 1) PG8_BAR; }
    }
    PG8_WAIT_V(0);
    if constexpr (!ALIGN_EPI) { if (wr == 0) PG8_BAR; }
    PG8_BAR;
    if constexpr (Epi::AFTER_DRAIN) { E.fused(acc, cur, wr, wc, fr, fq, lds, wid, lane); S.done(cur); }
#undef PG8_SA
#undef PG8_SB
#undef PG8_STAGE
#undef PG8_LDA
#undef PG8_LDB
#undef PG8_MMA
#undef PG8_WAIT_V
#undef PG8_WAIT_L
#undef PG8_BAR
#undef PG8_SCHED
}
}

#ifndef S5_SIMPLE
#define S5_SIMPLE 0
#endif
#ifndef HG_SIMPLE
#define HG_SIMPLE 0
#endif
#ifndef REP0
#define REP0 1
#define REP1 1
#define REP2 1
#define REP3 1
#define REP4 1
#define REP6 1
#endif
#ifndef REP_S5
#define REP_S5 1
#endif
#ifndef REP_HGA
#define REP_HGA 1
#endif
#ifndef REP_HGC
#define REP_HGC 1
#endif
#ifndef REP_P1
#define REP_P1 1
#endif
#ifndef REP_P6
#define REP_P6 1
#endif
#ifndef REP_P0
#define REP_P0 1
#endif
#ifndef REP_GLU
#define REP_GLU 1
#endif
#ifndef REP_P3
#define REP_P3 1
#endif
#ifndef REP_P5
#define REP_P5 1
#endif
#ifndef REP_P7
#define REP_P7 1
#endif
#ifndef REP_BAR
#define REP_BAR 1
#endif
#ifndef MK_N_LAUNCHES
#define MK_N_LAUNCHES 1
#endif
constexpr int DM = 1024, PB_B = 8, PB_T = 2048, SB_B = 128, SB_T = 8;
constexpr int MP = PB_B * PB_T, MS = SB_B * SB_T, MTOK = MP + MS;
constexpr int S5W = 512, S5G = 32, S5C = 16, S5N = 64;
constexpr int HGW = 512, HD = 128, HH = 4;
constexpr int INC = 2560, DFF = 2816;
constexpr float EPS = 1e-6f;
constexpr int NPH = 8;
constexpr size_t O_Y = 0, O_PRE = (size_t)MTOK * DM, O_PIM = O_PRE + 16384, O_PHG = O_PIM + 16384, O_SRE = O_PHG + 524288, O_SIM = O_SRE + 262144, O_SHG = O_SIM + 262144;
constexpr size_t MiB = 1u << 20;
constexpr size_t WS_CTL = 0, WS_WIN = 2 * MiB, WS_WGLU = 7 * MiB, WS_WOUT = 8 * MiB, WS_WGU = 10 * MiB, WS_WD = 21 * MiB;
constexpr size_t WS_XN = 27 * MiB, WS_PB = 61 * MiB, WS_FZ = 129 * MiB, WS_ACT = 61 * MiB, WS_GY = 163 * MiB, WS_OH = 180 * MiB, WS_MIX = 197 * MiB, WS_END = 234 * MiB;
constexpr int PBW = 2048;
constexpr int LDS_BYTES = 147456;
constexpr int NWAVES = 8;
constexpr int CW_SS1 = 16384, CW_SS2 = 36864, CW_CNT = 57344, CW_CNTS = 61440;

#define GAS __attribute__((address_space(1)))
#define LAS __attribute__((address_space(3)))
typedef unsigned short bf16;
typedef unsigned v4u __attribute__((ext_vector_type(4)));
typedef unsigned v2u __attribute__((ext_vector_type(2)));
typedef float f32x4 __attribute__((ext_vector_type(4)));
#define LDS_WAIT() asm volatile("s_waitcnt lgkmcnt(0)" ::: "memory")
__device__ __forceinline__ unsigned f2bf(float f) { unsigned u = __builtin_bit_cast(unsigned, f); return (u + 0x7fffu + ((u >> 16) & 1u)) >> 16; }
__device__ __forceinline__ unsigned pk2(float lo, float hi) { return f2bf(lo) | (f2bf(hi) << 16); }
__device__ __forceinline__ float bf2f(unsigned short h) { return __builtin_bit_cast(float, (unsigned)h << 16); }
__device__ __forceinline__ float bflo(unsigned w) { return __builtin_bit_cast(float, w << 16); }
__device__ __forceinline__ float bfhi(unsigned w) { return __builtin_bit_cast(float, w & 0xffff0000u); }
__device__ __forceinline__ float sigmoidf_(float x) { return __builtin_amdgcn_rcpf(1.0f + __builtin_amdgcn_exp2f(-1.4426950408889634f * x)); }
__device__ __forceinline__ float siluf_(float x) { return x * __builtin_amdgcn_rcpf(1.0f + __builtin_amdgcn_exp2f(-1.4426950408889634f * x)); }
__device__ __forceinline__ float gelu_tanh(float x) { const float z = -2.302208198144325f * (x + 0.044715f * x * x * x); return x * __builtin_amdgcn_rcpf(1.0f + __builtin_amdgcn_exp2f(z)); }
__device__ __forceinline__ float wave_sum(float v) {
#pragma unroll
    for (int o = 1; o < 64; o <<= 1) v += __shfl_xor(v, o);
    return v;
}

struct Args { const float* in[24]; float* out; unsigned char* ws; int ph_lo, ph_hi; };

struct Frame {
    LAS unsigned char* lds;
    int tid, lane, wave, G, bid;
    const float* in[24];
    float* out; unsigned char* ws;
};
__device__ __forceinline__ const float* xrow(const Frame& F, int m) { return m < MP ? F.in[0] + (size_t)m * DM : F.in[1] + (size_t)(m - MP) * DM; }

__device__ __forceinline__ void transpose_item(const float* W, int ldw, bf16* WT, int K, int k0, int sn0, int dn0, int lane, const float* kgain = nullptr) {
    const int k = k0 + 4 * (lane & 15), nl = 4 * (lane >> 4);
    f32x4 r[4][4];
#pragma unroll
    for (int nb = 0; nb < 4; ++nb)
#pragma unroll
        for (int j = 0; j < 4; ++j) r[nb][j] = *(const GAS f32x4*)(W + (size_t)(k + j) * ldw + sn0 + nl + 16 * nb);
    f32x4 g = {1.f, 1.f, 1.f, 1.f}; if (kgain) g = *(const GAS f32x4*)(kgain + k);
#pragma unroll
    for (int nb = 0; nb < 4; ++nb) { const f32x4 a = r[nb][0] * g.x, b = r[nb][1] * g.y, c = r[nb][2] * g.z, d = r[nb][3] * g.w;
        bf16* o = WT + (size_t)(dn0 + nl + 16 * nb) * K + k;
        v2u w; w.x = pk2(a.x, b.x); w.y = pk2(c.x, d.x); *(GAS v2u*)o = w;
        w.x = pk2(a.y, b.y); w.y = pk2(c.y, d.y); *(GAS v2u*)(o + K) = w;
        w.x = pk2(a.z, b.z); w.y = pk2(c.z, d.z); *(GAS v2u*)(o + 2 * (size_t)K) = w;
        w.x = pk2(a.w, b.w); w.y = pk2(c.w, d.w); *(GAS v2u*)(o + 3 * (size_t)K) = w; }
}
__device__ __forceinline__ void rms_row4_bf16(const float* x0_, const float* gain, bf16* o0, int lane) {
    f32x4 v[4][4]; float s[4];
#pragma unroll
    for (int r = 0; r < 4; ++r)
#pragma unroll
        for (int j = 0; j < 4; ++j) v[r][j] = ((const GAS f32x4*)(x0_ + (size_t)r * DM))[lane + 64 * j];
#pragma unroll
    for (int r = 0; r < 4; ++r) { s[r] = 0.f;
#pragma unroll
        for (int j = 0; j < 4; ++j) s[r] += (v[r][j].x * v[r][j].x + v[r][j].y * v[r][j].y) + (v[r][j].z * v[r][j].z + v[r][j].w * v[r][j].w); }
#pragma unroll
    for (int o = 1; o < 64; o <<= 1) { s[0] += __shfl_xor(s[0], o); s[1] += __shfl_xor(s[1], o); s[2] += __shfl_xor(s[2], o); s[3] += __shfl_xor(s[3], o); }
#pragma unroll
    for (int j = 0; j < 4; ++j) { const f32x4 g = ((const GAS f32x4*)gain)[lane + 64 * j];
#pragma unroll
        for (int r = 0; r < 4; ++r) { const float rs = 1.0f / sqrtf(s[r] * (1.0f / DM) + EPS);
            v2u w; w.x = pk2(v[r][j].x * rs * g.x, v[r][j].y * rs * g.y); w.y = pk2(v[r][j].z * rs * g.z, v[r][j].w * rs * g.w); ((GAS v2u*)(o0 + (size_t)r * DM))[lane + 64 * j] = w; } }
}

__device__ __forceinline__ void s5_tables_item(Frame& F, int item);
__device__ __forceinline__ void p0_prologue(Frame& F) {
    const int gw = F.bid * NWAVES + F.wave, NGW = F.G * NWAVES;
    bf16* XN = (bf16*)(F.ws + WS_XN);
    for (int m = 4 * gw; m < MTOK; m += 4 * NGW) rms_row4_bf16(xrow(F, m), F.in[6], XN + (size_t)m * DM, F.lane);
    bf16* WinT = (bf16*)(F.ws + WS_WIN);
    constexpr int I_IN = (DM / 64) * (INC / 64);
    for (int r = gw; r < I_IN; r += NGW) { const int nblk = INC / 64, kb = r / nblk, nb = r % nblk, sn0 = nb * 64; const int seg = sn0 / 512, off = sn0 % 512;
        const int dseg = seg == 0 ? 0 : seg == 1 ? 1 : seg == 2 ? 4 : seg == 3 ? 2 : 3;
        transpose_item(F.in[7], INC, WinT, DM, kb * 64, sn0, dseg * 512 + off, F.lane); }
    for (int it = F.bid; it < 256; it += F.G) s5_tables_item(F, it);
}

__device__ __forceinline__ void deferred_transposes(Frame& F, int gw, int ngw) {
    bf16* WgluT = (bf16*)(F.ws + WS_WGLU); bf16* WoutT = (bf16*)(F.ws + WS_WOUT); bf16* WguT = (bf16*)(F.ws + WS_WGU); bf16* WdT = (bf16*)(F.ws + WS_WD);
    constexpr int I_GLU = (S5W / 64) * (S5W / 64), I_OUT = (DM / 64) * (DM / 64), I_G = (DM / 64) * (DFF / 64), I_D = (DFF / 64) * (DM / 64);
    constexpr int NITEMS = I_GLU + I_OUT + 2 * I_G + I_D;
    for (int it = gw; it < NITEMS; it += ngw) {
        int r = it;
        if (r < I_GLU) { const int nblk = S5W / 64, kb = r / nblk, nb = r % nblk; transpose_item(F.in[16], S5W, WgluT, S5W, kb * 64, nb * 64, nb * 64, F.lane); continue; } r -= I_GLU;
        if (r < I_OUT) { const int nblk = DM / 64, kb = r / nblk, nb = r % nblk; transpose_item(F.in[18], DM, WoutT, DM, kb * 64, nb * 64, nb * 64, F.lane); continue; } r -= I_OUT;
        if (r < I_G) { const int nblk = DFF / 64, kb = r / nblk, nb = r % nblk, sn0 = nb * 64; transpose_item(F.in[20], DFF, WguT, DM, kb * 64, sn0, 256 * (sn0 / 128) + (sn0 % 128), F.lane, F.in[19]); continue; } r -= I_G;
        if (r < I_G) { const int nblk = DFF / 64, kb = r / nblk, nb = r % nblk, sn0 = nb * 64; transpose_item(F.in[21], DFF, WguT, DM, kb * 64, sn0, 256 * (sn0 / 128) + 128 + (sn0 % 128), F.lane, F.in[19]); continue; } r -= I_G;
        { const int nblk = DM / 64, kb = r / nblk, nb = r % nblk; transpose_item(F.in[22], DM, WdT, DFF, kb * 64, nb * 64, nb * 64, F.lane); }
    }
}

using pg8::Unit; using pg8::u32x4; using pg8::cvt_pk_bf16; using pg8::BM; using pg8::HALF;
struct EpiIn {
    static constexpr bool PERM = true, AFTER_DRAIN = false;
    bf16* PB; float* FZ; bf16* U5;
    __device__ __forceinline__ void operator()(const pg8::f32x4 (&acc)[2][2][4][2], const Unit& u, int wr, int wc, int fr, int fq) const {
        const int row0 = u.pm * BM + wr * 64 + fr;
        if (u.pn < 2) { const int col0 = u.pn * BM + wc * 32 + 8 * fq;
#pragma unroll
            for (int ai = 0; ai < 2; ++ai)
#pragma unroll
                for (int m = 0; m < 4; ++m) { const size_t r = (size_t)(row0 + ai * HALF + m * 16);
#pragma unroll
                    for (int bj = 0; bj < 2; ++bj) { const int col = col0 + bj * HALF; const pg8::f32x4 v0 = acc[ai][bj][m][0], v1 = acc[ai][bj][m][1]; u32x4 w; w.x = cvt_pk_bf16(v0[0], v0[1]); w.y = cvt_pk_bf16(v0[2], v0[3]); w.z = cvt_pk_bf16(v1[0], v1[1]); w.w = cvt_pk_bf16(v1[2], v1[3]);
                        *(u32x4*)(U5 + ((size_t)(col >> 4) * MTOK + r) * 16 + (col & 15)) = w; } }
        } else if (u.pn < 8) { const int col0 = u.pn * BM + wc * 32 + 8 * fq;
#pragma unroll
            for (int ai = 0; ai < 2; ++ai)
#pragma unroll
                for (int m = 0; m < 4; ++m) { bf16* rowp = PB + (size_t)(row0 + ai * HALF + m * 16) * PBW + col0;
#pragma unroll
                    for (int bj = 0; bj < 2; ++bj) { const pg8::f32x4 v0 = acc[ai][bj][m][0], v1 = acc[ai][bj][m][1]; u32x4 w; w.x = cvt_pk_bf16(v0[0], v0[1]); w.y = cvt_pk_bf16(v0[2], v0[3]); w.z = cvt_pk_bf16(v1[0], v1[1]); w.w = cvt_pk_bf16(v1[2], v1[3]);
                        *(u32x4*)(rowp + bj * HALF) = w; } }
        } else { const int col0 = (u.pn - 8) * BM + wc * 32 + 8 * fq;
#pragma unroll
            for (int ai = 0; ai < 2; ++ai)
#pragma unroll
                for (int m = 0; m < 4; ++m) { float* rowp = FZ + (size_t)(row0 + ai * HALF + m * 16) * 512 + col0;
#pragma unroll
                    for (int bj = 0; bj < 2; ++bj)
#pragma unroll
                        for (int n = 0; n < 2; ++n) *(pg8::f32x4*)(rowp + bj * HALF + 4 * n) = acc[ai][bj][m][n]; }
        }
    }
};
struct EpiGlu {
    static constexpr bool PERM = true, AFTER_DRAIN = false;
    const bf16* GY; bf16* MIX;
    __device__ __forceinline__ void operator()(const pg8::f32x4 (&acc)[2][2][4][2], const Unit& u, int wr, int wc, int fr, int fq) const {
        const int row0 = u.pm * BM + wr * 64 + fr, col0 = u.pn * BM + wc * 32 + 8 * fq;
#pragma unroll
        for (int ai = 0; ai < 2; ++ai)
#pragma unroll
            for (int m = 0; m < 4; ++m) { const size_t r = (size_t)(row0 + ai * HALF + m * 16);
#pragma unroll
                for (int bj = 0; bj < 2; ++bj) { const int col = col0 + bj * HALF; const u32x4 g = *(const u32x4*)(GY + ((size_t)(col >> 4) * MTOK + r) * 16 + (col & 15)); const pg8::f32x4 v0 = acc[ai][bj][m][0], v1 = acc[ai][bj][m][1];
                    u32x4 w; w.x = cvt_pk_bf16(bflo(g.x) * sigmoidf_(v0[0]), bfhi(g.x) * sigmoidf_(v0[1])); w.y = cvt_pk_bf16(bflo(g.y) * sigmoidf_(v0[2]), bfhi(g.y) * sigmoidf_(v0[3]));
                    w.z = cvt_pk_bf16(bflo(g.z) * sigmoidf_(v1[0]), bfhi(g.z) * sigmoidf_(v1[1])); w.w = cvt_pk_bf16(bflo(g.w) * sigmoidf_(v1[2]), bfhi(g.w) * sigmoidf_(v1[3]));
                    *(u32x4*)(MIX + r * DM + col0 + bj * HALF) = w; } }
    }
};
__device__ __forceinline__ float rstd_of(float ss) { return 1.0f / sqrtf(ss * (1.0f / DM) + EPS); }
__device__ __forceinline__ float atomic_read_f32(float* p) { return __hip_atomic_fetch_add(p, 0.0f, __ATOMIC_RELAXED, __HIP_MEMORY_SCOPE_AGENT); }
__device__ __forceinline__ void wait_count(unsigned* cnt, unsigned want) {
    for (unsigned sp = 0; sp < (1u << 22); ++sp) { if (__hip_atomic_load(cnt, __ATOMIC_RELAXED, __HIP_MEMORY_SCOPE_AGENT) >= want) break; __builtin_amdgcn_s_sleep(2); }
}
struct EpiOut {
    static constexpr bool PERM = true, AFTER_DRAIN = false;
    const float* xp; bf16* XN; float* SS1;
    __device__ __forceinline__ void operator()(const pg8::f32x4 (&acc)[2][2][4][2], const Unit& u, int wr, int wc, int fr, int fq) const {
        const int row0 = u.pm * BM + wr * 64 + fr, col0 = u.pn * BM + wc * 32 + 8 * fq;
#pragma unroll
        for (int ai = 0; ai < 2; ++ai)
#pragma unroll
            for (int m = 0; m < 4; ++m) { const int row = row0 + ai * HALF + m * 16; const size_t off = (size_t)row * DM + col0; float ss = 0.f;
#pragma unroll
                for (int bj = 0; bj < 2; ++bj) { const pg8::f32x4 x0 = *(const pg8::f32x4*)(xp + off + bj * HALF) + acc[ai][bj][m][0], x1 = *(const pg8::f32x4*)(xp + off + bj * HALF + 4) + acc[ai][bj][m][1];
                    ss += (x0[0] * x0[0] + x0[1] * x0[1]) + (x0[2] * x0[2] + x0[3] * x0[3]) + (x1[0] * x1[0] + x1[1] * x1[1]) + (x1[2] * x1[2] + x1[3] * x1[3]);
                    u32x4 w; w.x = cvt_pk_bf16(x0[0], x0[1]); w.y = cvt_pk_bf16(x0[2], x0[3]); w.z = cvt_pk_bf16(x1[0], x1[1]); w.w = cvt_pk_bf16(x1[2], x1[3]);
                    *(u32x4*)(XN + off + bj * HALF) = w; }
                ss += __shfl_xor(ss, 16); ss += __shfl_xor(ss, 32);
                if (fq == 0) __hip_atomic_fetch_add(SS1 + row, ss, __ATOMIC_RELAXED, __HIP_MEMORY_SCOPE_AGENT); }
    }
};
struct EpiAct {
    static constexpr bool PERM = true, AFTER_DRAIN = false;
    bf16* ACT; const float* SS1;
    __device__ __forceinline__ void operator()(const pg8::f32x4 (&acc)[2][2][4][2], const Unit& u, int wr, int wc, int fr, int fq) const {
        const int row0 = u.pm * BM + wr * 64 + fr, col0 = u.pn * HALF + wc * 32 + 8 * fq;
#pragma unroll
        for (int ai = 0; ai < 2; ++ai)
#pragma unroll
            for (int m = 0; m < 4; ++m) { const int row = row0 + ai * HALF + m * 16; const float rs = rstd_of(SS1[row]);
                const pg8::f32x4 g0 = acc[ai][0][m][0] * rs, g1 = acc[ai][0][m][1] * rs, u0 = acc[ai][1][m][0] * rs, u1 = acc[ai][1][m][1] * rs;
                u32x4 w; w.x = cvt_pk_bf16(siluf_(g0[0]) * u0[0], siluf_(g0[1]) * u0[1]); w.y = cvt_pk_bf16(siluf_(g0[2]) * u0[2], siluf_(g0[3]) * u0[3]);
                w.z = cvt_pk_bf16(siluf_(g1[0]) * u1[0], siluf_(g1[1]) * u1[1]); w.w = cvt_pk_bf16(siluf_(g1[2]) * u1[2], siluf_(g1[3]) * u1[3]);
                *(u32x4*)(ACT + (size_t)row * DFF + col0) = w; }
    }
};
struct EpiDown {
    static constexpr bool PERM = true, AFTER_DRAIN = false;
    const bf16* X1; const float* gain; float* SS2; unsigned* cnt; float* YO;
    __device__ __forceinline__ void operator()(pg8::f32x4 (&acc)[2][2][4][2], const Unit& u, int wr, int wc, int fr, int fq) const {
        const int row0 = u.pm * BM + wr * 64 + fr, col0 = u.pn * BM + wc * 32 + 8 * fq;
#pragma unroll
        for (int ai = 0; ai < 2; ++ai)
#pragma unroll
            for (int m = 0; m < 4; ++m) { const int row = row0 + ai * HALF + m * 16; const size_t off = (size_t)row * DM + col0; float ss = 0.f;
#pragma unroll
                for (int bj = 0; bj < 2; ++bj) { const u32x4 xb = *(const u32x4*)(X1 + off + bj * HALF);
                    const pg8::f32x4 x0 = (pg8::f32x4){bflo(xb.x), bfhi(xb.x), bflo(xb.y), bfhi(xb.y)} + acc[ai][bj][m][0], x1 = (pg8::f32x4){bflo(xb.z), bfhi(xb.z), bflo(xb.w), bfhi(xb.w)} + acc[ai][bj][m][1];
                    acc[ai][bj][m][0] = x0; acc[ai][bj][m][1] = x1;
                    ss += (x0[0] * x0[0] + x0[1] * x0[1]) + (x0[2] * x0[2] + x0[3] * x0[3]) + (x1[0] * x1[0] + x1[1] * x1[1]) + (x1[2] * x1[2] + x1[3] * x1[3]); }
                ss += __shfl_xor(ss, 16); ss += __shfl_xor(ss, 32);
                if (fq == 0) __hip_atomic_fetch_add(SS2 + row, ss, __ATOMIC_RELAXED, __HIP_MEMORY_SCOPE_AGENT); }
        asm volatile("s_waitcnt vmcnt(0)" ::: "memory");
        unsigned* c = cnt + 64 * u.pm;
        if (threadIdx.x % 64 == 0) __hip_atomic_fetch_add(c, 1u, __ATOMIC_RELAXED, __HIP_MEMORY_SCOPE_AGENT);
        wait_count(c, 32u);
        pg8::f32x4 gn[2][2];
#pragma unroll
        for (int bj = 0; bj < 2; ++bj)
#pragma unroll
            for (int n = 0; n < 2; ++n) gn[bj][n] = *(const pg8::f32x4*)(gain + col0 + bj * HALF + 4 * n);
        float rs[2][4];
#pragma unroll
        for (int ai = 0; ai < 2; ++ai)
#pragma unroll
            for (int m = 0; m < 4; ++m) { float s = 0.f; if (fq == 0) s = atomic_read_f32(SS2 + row0 + ai * HALF + m * 16); rs[ai][m] = rstd_of(__shfl(s, fr)); }
#pragma unroll
        for (int ai = 0; ai < 2; ++ai)
#pragma unroll
            for (int m = 0; m < 4; ++m) { const size_t off = (size_t)(row0 + ai * HALF + m * 16) * DM + col0;
#pragma unroll
                for (int bj = 0; bj < 2; ++bj) { *(pg8::f32x4*)(YO + off + bj * HALF) = acc[ai][bj][m][0] * rs[ai][m] * gn[bj][0]; *(pg8::f32x4*)(YO + off + bj * HALF + 4) = acc[ai][bj][m][1] * rs[ai][m] * gn[bj][1]; } }
    }
};

typedef float f32x16 __attribute__((ext_vector_type(16)));
typedef short s16x8 __attribute__((ext_vector_type(8)));
constexpr size_t WS_U5 = WS_OH, WS_T5 = 231 * MiB;
constexpr size_t T5_STRIDE = 73728, T5_VG = 32768, T5_KC = 65536;
constexpr int S5_LD = 136;
__device__ __forceinline__ void s5_tables_item(Frame& F, int item) {
    const int tid = F.tid, g = item >> 3, part = item & 7;
    LAS float* Pre = (LAS float*)F.lds; LAS float* Pim = Pre + 9 * 64; LAS float* Ff = Pim + 9 * 64;
    LAS float* Cre = Ff + 128, * Cim = Cre + 1024, * Bre = Cim + 1024, * Bim = Bre + 1024;
    if (tid < 64) { const int n = tid;
        const float a_re = F.in[8][g * S5N + n], a_im = F.in[9][g * S5N + n], dt = expf(F.in[10][g]);
        const float mag = expf(a_re * dt), ab_re = mag * cosf(a_im * dt), ab_im = mag * sinf(a_im * dt);
        const float den = a_re * a_re + a_im * a_im, nr = ab_re - 1.0f, ni = ab_im;
        Ff[n] = (nr * a_re + ni * a_im) / den; Ff[64 + n] = (ni * a_re - nr * a_im) / den;
        float pr = 1.f, pi = 0.f;
#pragma unroll
        for (int j = 0; j < 9; ++j) { Pre[j * 64 + n] = pr; Pim[j * 64 + n] = pi; const float t = pr * ab_re - pi * ab_im; pi = pr * ab_im + pi * ab_re; pr = t; }
    }
    __syncthreads();
#pragma unroll
    for (int i = 0; i < 2; ++i) { const int idx = tid + 512 * i;
        { const int c = idx >> 6, n = idx & 63; Cre[c * 64 + n] = F.in[13][(size_t)(g * 16 + c) * S5N + n]; Cim[c * 64 + n] = F.in[14][(size_t)(g * 16 + c) * S5N + n]; }
        { const int n = idx >> 4, c = idx & 15; const float br = F.in[11][(size_t)(g * S5N + n) * 16 + c], bi = F.in[12][(size_t)(g * S5N + n) * 16 + c], fr = Ff[n], fi = Ff[64 + n];
          Bre[n * 16 + c] = fr * br - fi * bi; Bim[n * 16 + c] = fr * bi + fi * br; } }
    __syncthreads();
    bf16* WG = (bf16*)(F.ws + WS_T5 + (size_t)g * T5_STRIDE); bf16* VG = (bf16*)(F.ws + WS_T5 + (size_t)g * T5_STRIDE + T5_VG); bf16* KC = (bf16*)(F.ws + WS_T5 + (size_t)g * T5_STRIDE + T5_KC);
    if (tid < 256) { const int j = part, c = tid >> 4, cp = tid & 15; float acc = 0.f;
#pragma unroll 4
        for (int n = 0; n < 64; ++n) { const float cr = Cre[c * 64 + n], ci = Cim[c * 64 + n], pr = Pre[j * 64 + n], pi = Pim[j * 64 + n];
            const float xr = cr * pr - ci * pi, xi = cr * pi + ci * pr; acc += xr * Bre[n * 16 + cp] - xi * Bim[n * 16 + cp]; }
        KC[j * 256 + tid] = (bf16)f2bf(acc);
    } else if (part == 0) KC[2048 + tid - 256] = 0;
#pragma unroll
    for (int i = 0; i < 4; ++i) { const int idx = tid + 512 * i, np = 16 * part + (idx >> 7), k = idx & 127, s = k >> 4, cp = k & 15, n = np & 63;
        const float pr = Pre[(7 - s) * 64 + n], pi = Pim[(7 - s) * 64 + n], br = Bre[n * 16 + cp], bi = Bim[n * 16 + cp];
        WG[np * 128 + k] = (bf16)f2bf(np < 64 ? pr * br - pi * bi : pr * bi + pi * br); }
#pragma unroll
    for (int i = 0; i < 4; ++i) { const int idx = tid + 512 * i, col = 16 * part + (idx >> 7), np = idx & 127, t = col >> 4, c = col & 15, n = np & 63;
        const float pr = Pre[(t + 1) * 64 + n], pi = Pim[(t + 1) * 64 + n], cr = Cre[c * 64 + n], ci = Cim[c * 64 + n];
        VG[col * 128 + np] = (bf16)f2bf(np < 64 ? cr * pr - ci * pi : -(cr * pi + ci * pr)); }
    __syncthreads();
}
constexpr int L5_WG = 0, L5_VG = 34816, L5_KC = 69632, L5_U = 74240, L5_HS = 91648, L5_HL = 109056, L5_L8 = 141824;
__device__ __forceinline__ void s5_item(Frame& F, int item) {
    const int tid = F.tid, lane = F.lane, wave = F.wave;
    const int g = item & 31, b8 = item >> 5;
    LAS bf16* WgT = (LAS bf16*)(F.lds + L5_WG); LAS bf16* VgT = (LAS bf16*)(F.lds + L5_VG); LAS bf16* Kc = (LAS bf16*)(F.lds + L5_KC);
    LAS bf16* Us = (LAS bf16*)(F.lds + L5_U); LAS bf16* HS = (LAS bf16*)(F.lds + L5_HS); LAS float* HL = (LAS float*)(F.lds + L5_HL); LAS float* L8 = (LAS float*)(F.lds + L5_L8);
    LAS bf16* YS = (LAS bf16*)(F.lds + L5_HL);
    const bf16* U5 = (const bf16*)(F.ws + WS_U5) + (size_t)g * MTOK * 16; bf16* GY = (bf16*)(F.ws + WS_GY) + (size_t)g * MTOK * 16;
    { const bf16* WG = (const bf16*)(F.ws + WS_T5 + (size_t)g * T5_STRIDE); const bf16* VG = WG + T5_VG / 2; const bf16* KC = WG + T5_KC / 2;
#pragma unroll
      for (int i = 0; i < 4; ++i) { const int p = tid + 512 * i, r = p >> 4, kg = (p & 15) * 8; *(LAS v4u*)(WgT + r * S5_LD + kg) = *(const v4u*)(WG + r * 128 + kg); *(LAS v4u*)(VgT + r * S5_LD + kg) = *(const v4u*)(VG + r * 128 + kg); }
      if (tid < 288) *(LAS v4u*)(Kc + tid * 8) = *(const v4u*)(KC + tid * 8); }
    float qr[9], qi[9];
    { const float a_re = F.in[8][g * S5N + lane], a_im = F.in[9][g * S5N + lane], dt = expf(F.in[10][g]);
      const float mag = expf(a_re * dt); float p8r = mag * cosf(a_im * dt), p8i = mag * sinf(a_im * dt);
#pragma unroll
      for (int i = 0; i < 3; ++i) { const float t = p8r * p8r - p8i * p8i; p8i = 2.0f * p8r * p8i; p8r = t; }
      qr[0] = 1.f; qi[0] = 0.f;
#pragma unroll
      for (int i = 1; i < 9; ++i) { qr[i] = qr[i - 1] * p8r - qi[i - 1] * p8i; qi[i] = qr[i - 1] * p8i + qi[i - 1] * p8r; } }
    const float dl = F.in[15][g * 16 + (lane & 15)];
    const int rb = wave >> 2, cb = wave & 3, r32 = lane & 31, hh = lane >> 5;
    float h_re = 0.f, h_im = 0.f;
    float sre[2], sim[2];
#pragma unroll
    for (int i = 0; i < 2; ++i) { const size_t idx = (size_t)((16 * b8 + 2 * wave + i) * S5G + g) * S5N + lane; sre[i] = F.in[2][idx]; sim[i] = F.in[3][idx]; }
    v4u un0, un1;
    { const v4u* src = (const v4u*)(U5 + (size_t)(b8 * PB_T) * 16); un0 = src[tid]; un1 = src[tid + 512]; }
    for (int seg = 0; seg < 5; ++seg) {
        const bool samp = (seg == 4);
        const int tok0 = samp ? MP + 128 * b8 : b8 * PB_T + seg * 512;
        { const int p0 = tid, p1 = tid + 512;
          *(LAS v4u*)(Us + (p0 >> 4) * S5_LD + ((p0 >> 1) & 7) * 16 + (p0 & 1) * 8) = un0; *(LAS v4u*)(Us + (p1 >> 4) * S5_LD + ((p1 >> 1) & 7) * 16 + (p1 & 1) * 8) = un1;
          if (seg < 3) { const v4u* src = (const v4u*)(U5 + (size_t)(b8 * PB_T + (seg + 1) * 512) * 16); un0 = src[tid]; un1 = src[tid + 512]; }
          else if (seg == 3) { const v4u* src = (const v4u*)(U5 + (size_t)(MP + 128 * b8) * 16); if (tid < 256) un0 = src[tid]; } }
        __syncthreads();
        { f32x16 acc = {};
#pragma unroll
          for (int s = 0; s < 8; ++s) { const s16x8 a = *(const LAS s16x8*)(Us + (32 * rb + r32) * S5_LD + s * 16 + 8 * hh); const s16x8 b = *(const LAS s16x8*)(WgT + (32 * cb + r32) * S5_LD + s * 16 + 8 * hh);
              acc = __builtin_amdgcn_mfma_f32_32x32x16_bf16(a, b, acc, 0, 0, 0); }
#pragma unroll
          for (int r = 0; r < 16; ++r) HL[(32 * rb + (r & 3) + 8 * (r >> 2) + 4 * hh) * 128 + 32 * cb + r32] = acc[r]; }
        __syncthreads();
        if (!samp) {
            float xr[8], xi[8], lr[9], li[9];
#pragma unroll
            for (int i = 0; i < 8; ++i) { xr[i] = HL[(8 * wave + i) * 128 + lane]; xi[i] = HL[(8 * wave + i) * 128 + 64 + lane]; }
            lr[0] = 0.f; li[0] = 0.f;
#pragma unroll
            for (int i = 0; i < 8; ++i) { lr[i + 1] = qr[1] * lr[i] - qi[1] * li[i] + xr[i]; li[i + 1] = qr[1] * li[i] + qi[1] * lr[i] + xi[i]; }
            L8[wave * 128 + lane] = lr[8]; L8[wave * 128 + 64 + lane] = li[8];
            __syncthreads();
            float cr = h_re, ci = h_im, mr = h_re, mi = h_im;
#pragma unroll
            for (int w = 0; w < 8; ++w) { const float tr = L8[w * 128 + lane], ti = L8[w * 128 + 64 + lane];
                const float nr = qr[8] * cr - qi[8] * ci + tr, ni = qr[8] * ci + qi[8] * cr + ti; cr = nr; ci = ni; if (w + 1 == wave) { mr = cr; mi = ci; } }
            h_re = cr; h_im = ci;
#pragma unroll
            for (int i = 0; i < 8; ++i) { const float sr = lr[i] + qr[i] * mr - qi[i] * mi, si = li[i] + qr[i] * mi + qi[i] * mr;
                HS[(8 * wave + i) * S5_LD + lane] = (bf16)f2bf(sr); HS[(8 * wave + i) * S5_LD + 64 + lane] = (bf16)f2bf(si); }
            if (seg == 3 && wave == 0) { F.out[O_PRE + (size_t)(b8 * S5G + g) * S5N + lane] = h_re; F.out[O_PIM + (size_t)(b8 * S5G + g) * S5N + lane] = h_im; }
        } else {
#pragma unroll
            for (int i = 0; i < 2; ++i) { const int r = 2 * wave + i; const size_t idx = (size_t)((16 * b8 + r) * S5G + g) * S5N + lane;
                HS[r * S5_LD + lane] = (bf16)f2bf(sre[i]); HS[r * S5_LD + 64 + lane] = (bf16)f2bf(sim[i]);
                F.out[O_SRE + idx] = qr[1] * sre[i] - qi[1] * sim[i] + HL[r * 128 + lane]; F.out[O_SIM + idx] = qr[1] * sim[i] + qi[1] * sre[i] + HL[r * 128 + 64 + lane]; }
        }
        __syncthreads();
        if (!(samp && rb == 1)) { f32x16 acc = {};
            const int tl = 2 * cb + ((lane >> 4) & 1), c = lane & 15;
#pragma unroll
            for (int s = 0; s < 8; ++s) if (s <= 2 * cb + 1) { const int j = tl - s, jj = j < 0 ? 8 : j;
                const s16x8 a = *(const LAS s16x8*)(Us + (32 * rb + r32) * S5_LD + s * 16 + 8 * hh); const s16x8 b = *(const LAS s16x8*)(Kc + (jj * 16 + c) * 16 + 8 * hh);
                acc = __builtin_amdgcn_mfma_f32_32x32x16_bf16(a, b, acc, 0, 0, 0); }
#pragma unroll
            for (int kb = 0; kb < 8; ++kb) { const s16x8 a = *(const LAS s16x8*)(HS + (32 * rb + r32) * S5_LD + kb * 16 + 8 * hh); const s16x8 b = *(const LAS s16x8*)(VgT + (32 * cb + r32) * S5_LD + kb * 16 + 8 * hh);
                acc = __builtin_amdgcn_mfma_f32_32x32x16_bf16(a, b, acc, 0, 0, 0); }
#pragma unroll
            for (int r = 0; r < 16; ++r) { const int row = 32 * rb + (r & 3) + 8 * (r >> 2) + 4 * hh;
                const float u = bf2f(Us[row * S5_LD + tl * 16 + c]); YS[row * 128 + 32 * cb + r32] = (bf16)f2bf(gelu_tanh(acc[r] + dl * u)); }
        }
        __syncthreads();
        { v4u* dst = (v4u*)(GY + (size_t)tok0 * 16);
          if (!samp) { dst[tid] = *(const LAS v4u*)(YS + tid * 8); dst[tid + 512] = *(const LAS v4u*)(YS + (tid + 512) * 8); }
          else if (tid < 256) dst[tid] = *(const LAS v4u*)(YS + tid * 8); }
        __syncthreads();
    }
}
typedef float f32x4v __attribute__((ext_vector_type(4)));
constexpr int HG_LDQ = 136, HG_LDT = 72;
constexpr size_t WS_DSC = WS_XN;
constexpr size_t WS_DEC = WS_CTL + 1 * MiB;
struct HgRaw { float fz[16]; unsigned short q[16]; v4u v0, v1; };
template <bool NEEDQ> __device__ __forceinline__ void hg_load_raw(HgRaw& R, const bf16* PB, const float* FZ, int item, int tid) {
    const int bh = item >> 5, chunk = item & 31, b = bh >> 2, h = bh & 3, tok0 = b * PB_T + chunk * 64, ch = tid & 127, tq = tid >> 7, col = h * HD + ch;
#pragma unroll
    for (int i = 0; i < 16; ++i) { const size_t tok = (size_t)(tok0 + 16 * tq + i); R.fz[i] = FZ[tok * 512 + col]; if (NEEDQ) R.q[i] = PB[tok * PBW + 512 + col]; }
    { const int p = tid, vg = p >> 6, tk = p & 63; R.v0 = *(const v4u*)(PB + (size_t)(tok0 + tk) * PBW + 1024 + h * HD + vg * 8); }
    { const int p = tid + 512, vg = p >> 6, tk = p & 63; R.v1 = *(const v4u*)(PB + (size_t)(tok0 + tk) * PBW + 1024 + h * HD + vg * 8); }
}
#define HG_GATES_R(R) \
    float gl[16], kk[16]; float run = 0.f; \
    _Pragma("unroll") for (int i = 0; i < 16; ++i) { const float sg = __builtin_amdgcn_rcpf(1.0f + __builtin_amdgcn_exp2f(-1.4426950408889634f * R.fz[i])), f = lb + (1.0f - lb) * sg; kk[i] = 1.0f - f; run += __log2f(f); gl[i] = run; } \
    TOT[tq * 128 + ch] = run;
#define HG_VT_STORE(R) \
    { const int vg = tid >> 6, tk = tid & 63; LAS bf16* d = Vt + (vg * 8) * HG_LDT + tk; const v4u w = R.v0; d[0] = (bf16)(w.x & 0xffffu); d[HG_LDT] = (bf16)(w.x >> 16); d[2 * HG_LDT] = (bf16)(w.y & 0xffffu); d[3 * HG_LDT] = (bf16)(w.y >> 16); \
        d[4 * HG_LDT] = (bf16)(w.z & 0xffffu); d[5 * HG_LDT] = (bf16)(w.z >> 16); d[6 * HG_LDT] = (bf16)(w.w & 0xffffu); d[7 * HG_LDT] = (bf16)(w.w >> 16); } \
    { const int vg = (tid + 512) >> 6, tk = tid & 63; LAS bf16* d = Vt + (vg * 8) * HG_LDT + tk; const v4u w = R.v1; d[0] = (bf16)(w.x & 0xffffu); d[HG_LDT] = (bf16)(w.x >> 16); d[2 * HG_LDT] = (bf16)(w.y & 0xffffu); d[3 * HG_LDT] = (bf16)(w.y >> 16); \
        d[4 * HG_LDT] = (bf16)(w.z & 0xffffu); d[5 * HG_LDT] = (bf16)(w.z >> 16); d[6 * HG_LDT] = (bf16)(w.w & 0xffffu); d[7 * HG_LDT] = (bf16)(w.w >> 16); }

constexpr int LA_KT = 0, LA_VT = 18432, LA_TOT = 36864;
__device__ __forceinline__ void hgA_loop(Frame& F) {
    const int tid = F.tid, lane = F.lane, wave = F.wave;
    LAS bf16* Kt = (LAS bf16*)(F.lds + LA_KT); LAS bf16* Vt = (LAS bf16*)(F.lds + LA_VT); LAS float* TOT = (LAS float*)(F.lds + LA_TOT);
    const bf16* PB = (const bf16*)(F.ws + WS_PB); const float* FZ = (const float*)(F.ws + WS_FZ);
    const int ch = tid & 127, tq = tid >> 7;
    int item = F.bid; if (item >= 1024) return;
    HgRaw R; hg_load_raw<false>(R, PB, FZ, item, tid);
    for (; item < 1024; item += F.G) {
        const int bh = item >> 5, h = bh & 3, col = h * HD + ch;
        bf16* DSC = (bf16*)(F.ws + WS_DSC) + (size_t)item * HD * HD; float* DEC = (float*)(F.ws + WS_DEC) + (size_t)item * HD;
        const float lb = 1.0f / (1.0f + __expf(F.in[5][512 + col] - F.in[5][col]));
        HG_GATES_R(R)
        HG_VT_STORE(R)
        if (item + F.G < 1024) hg_load_raw<false>(R, PB, FZ, item + F.G, tid);
        __syncthreads();
        { const float t0 = TOT[ch], t1 = TOT[128 + ch], t2 = TOT[256 + ch], t3 = TOT[384 + ch];
          const float glast = (t0 + t1) + (t2 + t3), off = (tq == 0 ? 0.f : tq == 1 ? t0 : tq == 2 ? t0 + t1 : t0 + t1 + t2);
          unsigned kp[8];
#pragma unroll
          for (int i = 0; i < 16; ++i) { const unsigned kb = f2bf(kk[i] * __builtin_amdgcn_exp2f(glast - (off + gl[i]))); if (i & 1) kp[i >> 1] |= kb << 16; else kp[i >> 1] = kb; }
          LAS v4u* kd = (LAS v4u*)(Kt + ch * HG_LDT + 16 * tq); v4u a, c2; a.x = kp[0]; a.y = kp[1]; a.z = kp[2]; a.w = kp[3]; c2.x = kp[4]; c2.y = kp[5]; c2.z = kp[6]; c2.w = kp[7]; kd[0] = a; kd[1] = c2;
          if (tq == 0) DEC[ch] = __builtin_amdgcn_exp2f(glast); }
        __syncthreads();
        { const int r32 = lane & 31, hh = lane >> 5, kb = wave >> 1;
#pragma unroll
          for (int vbi = 0; vbi < 2; ++vbi) { const int vb = 2 * (wave & 1) + vbi; f32x16 acc = {};
#pragma unroll
              for (int ks = 0; ks < 4; ++ks) { const s16x8 a = *(const LAS s16x8*)(Kt + (32 * kb + r32) * HG_LDT + 16 * ks + 8 * hh); const s16x8 bb = *(const LAS s16x8*)(Vt + (32 * vb + r32) * HG_LDT + 16 * ks + 8 * hh);
                  acc = __builtin_amdgcn_mfma_f32_32x32x16_bf16(a, bb, acc, 0, 0, 0); }
              bf16* dst = DSC + (size_t)(32 * vb + r32) * HD + 32 * kb + 4 * hh;
#pragma unroll
              for (int q = 0; q < 4; ++q) { v2u w; w.x = pk2(acc[4 * q], acc[4 * q + 1]); w.y = pk2(acc[4 * q + 2], acc[4 * q + 3]); *(v2u*)(dst + 8 * q) = w; } } }
        __syncthreads();
    }
}
__device__ __forceinline__ void hg_scan(Frame& F, bf16* DSO) {
    bf16* DSC = (bf16*)(F.ws + WS_DSC); const float* DEC = (const float*)(F.ws + WS_DEC);
    for (int T = F.bid * 512 + F.tid; T < 32 * 4096; T += F.G * 512) {
        const int bh = T >> 12, e = T & 4095, v = e >> 5, k4 = (e & 31) * 4;
        f32x4 S = {0.f, 0.f, 0.f, 0.f};
#pragma unroll 1
        for (int c0 = 0; c0 < 32; c0 += 8) {
            v2u x[8]; f32x4 d[8];
#pragma unroll
            for (int c = 0; c < 8; ++c) { const size_t it = (size_t)(bh * 32 + c0 + c); x[c] = *(const v2u*)(DSC + (it * HD + v) * HD + k4); d[c] = *(const f32x4*)(DEC + it * HD + k4); }
#pragma unroll
            for (int c = 0; c < 8; ++c) { const size_t it = (size_t)(bh * 32 + c0 + c); v2u o; o.x = pk2(S.x, S.y); o.y = pk2(S.z, S.w); *(v2u*)(DSO + (it * HD + v) * HD + k4) = o;
                S.x = d[c].x * S.x + bflo(x[c].x); S.y = d[c].y * S.y + bfhi(x[c].x); S.z = d[c].z * S.z + bflo(x[c].y); S.w = d[c].w * S.w + bfhi(x[c].y); }
        }
        float* o = F.out + O_PHG + (size_t)bh * HD * HD + (size_t)k4 * HD + v;
        o[0] = S.x; o[HD] = S.y; o[2 * HD] = S.z; o[3 * HD] = S.w;
    }
}
constexpr int LC_QS = 0, LC_QH = 17408, LC_KS = 34816, LC_VT = 52224, LC_AT = 70656, LC_SC = 79872, LC_TOT = 114688, LC_SS = 116736, LC_SLOT = 117760;
__device__ __forceinline__ void hgC_loop(Frame& F, unsigned* ctr) {
    const int tid = F.tid, lane = F.lane, wave = F.wave;
    LAS bf16* Qs = (LAS bf16*)(F.lds + LC_QS); LAS bf16* Qh = (LAS bf16*)(F.lds + LC_QH); LAS bf16* Ks = (LAS bf16*)(F.lds + LC_KS); LAS bf16* Vt = (LAS bf16*)(F.lds + LC_VT);
    LAS bf16* At = (LAS bf16*)(F.lds + LC_AT); LAS bf16* SC = (LAS bf16*)(F.lds + LC_SC); LAS float* TOT = (LAS float*)(F.lds + LC_TOT); LAS float* SS = (LAS float*)(F.lds + LC_SS);
    volatile LAS int* slot = (volatile LAS int*)(F.lds + LC_SLOT);
    const bf16* PB = (const bf16*)(F.ws + WS_PB); const float* FZ = (const float*)(F.ws + WS_FZ); bf16* MIX = (bf16*)(F.ws + WS_MIX);
    const int ch = tid & 127, tq = tid >> 7, r32 = lane & 31, hh = lane >> 5;
    if (tid == 0) { slot[0] = (int)__hip_atomic_fetch_add(ctr, 1u, __ATOMIC_RELAXED, __HIP_MEMORY_SCOPE_AGENT); slot[1] = (int)__hip_atomic_fetch_add(ctr, 1u, __ATOMIC_RELAXED, __HIP_MEMORY_SCOPE_AGENT); }
    __syncthreads();
    int item = slot[0], nxt = slot[1], par = 0;
    if (item >= 1024) return;
    HgRaw R; v4u sc[4];
    hg_load_raw<true>(R, PB, FZ, item, tid);
    { const bf16* DSC = (const bf16*)(F.ws + WS_DSC) + (size_t)item * HD * HD;
#pragma unroll
      for (int i = 0; i < 4; ++i) { const int p = tid + 512 * i; sc[i] = *(const v4u*)(DSC + (size_t)(p >> 4) * HD + (p & 15) * 8); } }
    for (;;) {
        const int bh = item >> 5, chunk = item & 31, b = bh >> 2, h = bh & 3, tok0 = b * PB_T + chunk * 64, col = h * HD + ch;
        const float lb = 1.0f / (1.0f + __expf(F.in[5][512 + col] - F.in[5][col]));
#pragma unroll
        for (int i = 0; i < 4; ++i) { const int p = tid + 512 * i; *(LAS v4u*)(SC + (p >> 4) * HG_LDQ + (p & 15) * 8) = sc[i]; }
        HG_GATES_R(R)
        float qq[16];
#pragma unroll
        for (int i = 0; i < 16; ++i) qq[i] = bf2f(R.q[i]);
        HG_VT_STORE(R)
        if (tid == 0) slot[par] = (int)__hip_atomic_fetch_add(ctr, 1u, __ATOMIC_RELAXED, __HIP_MEMORY_SCOPE_AGENT);
        if (nxt < 1024) { hg_load_raw<true>(R, PB, FZ, nxt, tid); const bf16* DSC = (const bf16*)(F.ws + WS_DSC) + (size_t)nxt * HD * HD;
#pragma unroll
            for (int i = 0; i < 4; ++i) { const int p = tid + 512 * i; sc[i] = *(const v4u*)(DSC + (size_t)(p >> 4) * HD + (p & 15) * 8); } }
        __syncthreads();
        const int nn = slot[par];
        { const float t0 = TOT[ch], t1 = TOT[128 + ch], t2 = TOT[256 + ch];
          const float gref = t0 + t1, off = (tq == 0 ? 0.f : tq == 1 ? t0 : tq == 2 ? gref : gref + t2);
#pragma unroll
          for (int i = 0; i < 16; ++i) { const float G = off + gl[i], e1 = __builtin_amdgcn_exp2f(G - gref), e2 = __builtin_amdgcn_rcpf(e1), e3 = __builtin_amdgcn_exp2f(G);
              Qs[(16 * tq + i) * HG_LDQ + ch] = (bf16)f2bf(qq[i] * e1); Ks[(16 * tq + i) * HG_LDQ + ch] = (bf16)f2bf(kk[i] * e2); Qh[(16 * tq + i) * HG_LDQ + ch] = (bf16)f2bf(qq[i] * e3); } }
        __syncthreads();
        if (wave < 4) { const int tb = wave >> 1, sb = wave & 1; f32x16 acc = {};
            if (sb <= tb) {
#pragma unroll
                for (int ks = 0; ks < 8; ++ks) { const s16x8 a = *(const LAS s16x8*)(Qs + (32 * tb + r32) * HG_LDQ + 16 * ks + 8 * hh); const s16x8 bb = *(const LAS s16x8*)(Ks + (32 * sb + r32) * HG_LDQ + 16 * ks + 8 * hh);
                    acc = __builtin_amdgcn_mfma_f32_32x32x16_bf16(a, bb, acc, 0, 0, 0); } }
            const int s = 32 * sb + r32;
#pragma unroll
            for (int r = 0; r < 16; ++r) { const int t = 32 * tb + (r & 3) + 8 * (r >> 2) + 4 * hh; At[t * HG_LDT + s] = (s <= t) ? (bf16)f2bf(acc[r]) : (bf16)0; } }
        __syncthreads();
        const int tb = wave >> 2, vb = wave & 3, t = 32 * tb + r32;
        v2u og[4];
#pragma unroll
        for (int q = 0; q < 4; ++q) og[q] = *(const v2u*)(PB + (size_t)(tok0 + t) * PBW + 1536 + h * HD + 32 * vb + 8 * q + 4 * hh);
        f32x16 acc = {};
#pragma unroll
        for (int ks = 0; ks < 4; ++ks) if (ks < 2 * tb + 2) { const s16x8 a = *(const LAS s16x8*)(Vt + (32 * vb + r32) * HG_LDT + 16 * ks + 8 * hh); const s16x8 bb = *(const LAS s16x8*)(At + t * HG_LDT + 16 * ks + 8 * hh);
            acc = __builtin_amdgcn_mfma_f32_32x32x16_bf16(a, bb, acc, 0, 0, 0); }
#pragma unroll
        for (int ks = 0; ks < 8; ++ks) { const s16x8 a = *(const LAS s16x8*)(SC + (32 * vb + r32) * HG_LDQ + 16 * ks + 8 * hh); const s16x8 bb = *(const LAS s16x8*)(Qh + t * HG_LDQ + 16 * ks + 8 * hh);
            acc = __builtin_amdgcn_mfma_f32_32x32x16_bf16(a, bb, acc, 0, 0, 0); }
        { float ss = 0.f;
#pragma unroll
          for (int r = 0; r < 16; ++r) ss += acc[r] * acc[r];
          ss += __shfl_xor(ss, 32);
          if (hh == 0) SS[t * 4 + vb] = ss; }
        __syncthreads();
        { const f32x4 s4 = *(const LAS f32x4*)(SS + t * 4); const float rstd = 1.0f / sqrtf(((s4.x + s4.y) + (s4.z + s4.w)) * (1.0f / HD) + EPS);
#pragma unroll
          for (int q = 0; q < 4; ++q) { const int v0 = 32 * vb + 8 * q + 4 * hh; const f32x4 gn = *(const GAS f32x4*)(F.in[17] + v0);
              v2u w; w.x = pk2(acc[4 * q] * rstd * gn.x * siluf_(bflo(og[q].x)), acc[4 * q + 1] * rstd * gn.y * siluf_(bfhi(og[q].x)));
              w.y = pk2(acc[4 * q + 2] * rstd * gn.z * siluf_(bflo(og[q].y)), acc[4 * q + 3] * rstd * gn.w * siluf_(bfhi(og[q].y)));
              *(v2u*)(MIX + (size_t)(tok0 + t) * DM + 512 + h * HD + v0) = w; } }
        __syncthreads();
        if (nxt >= 1024) break;
        item = nxt; nxt = nn; par ^= 1;
    }
}
constexpr int LX_Q = 0, LX_K2 = 4096, LX_K3 = 8192, LX_V = 12288, LX_DEC = 16384, LX_ATT = 16896, LX_OP = 17152, LX_OT = 33536;
__device__ __forceinline__ void hgrn_sample_item(Frame& F, int idx) {
    const int tid = F.tid, b = idx >> 2, h = idx & 3;
    LAS float* Qs = (LAS float*)(F.lds + LX_Q); LAS float* K2 = (LAS float*)(F.lds + LX_K2); LAS float* K3 = (LAS float*)(F.lds + LX_K3); LAS float* Vs = (LAS float*)(F.lds + LX_V);
    LAS float* DEC = (LAS float*)(F.lds + LX_DEC); LAS float* ATT = (LAS float*)(F.lds + LX_ATT); LAS float* OP = (LAS float*)(F.lds + LX_OP); LAS float* OT = (LAS float*)(F.lds + LX_OT);
    const bf16* PB = (const bf16*)(F.ws + WS_PB); const float* FZ = (const float*)(F.ws + WS_FZ); bf16* MIX = (bf16*)(F.ws + WS_MIX);
    const float* S0 = F.in[4] + (size_t)idx * HD * HD; float* Sout = F.out + O_SHG + (size_t)idx * HD * HD;
    const int tok0 = MP + b * SB_T;
    const int v = tid & 127, kq = tid >> 7;
    float s0[32];
#pragma unroll
    for (int j = 0; j < 32; ++j) s0[j] = S0[(size_t)(32 * kq + j) * HD + v];
    if (tid < 128) { const int col = h * HD + tid; const float lb = 1.0f / (1.0f + expf(F.in[5][512 + col] - F.in[5][col]));
        float gl[8], kk[8], qq[8]; float run = 0.f;
#pragma unroll
        for (int t = 0; t < 8; ++t) { const size_t tok = (size_t)(tok0 + t); const float fz = FZ[tok * 512 + col]; qq[t] = bf2f(PB[tok * PBW + 512 + col]);
            const float sg = 1.0f / (1.0f + __expf(-fz)), f = lb + (1.0f - lb) * sg; kk[t] = 1.0f - f; run += __log2f(f); gl[t] = run; }
#pragma unroll
        for (int t = 0; t < 8; ++t) { Qs[t * 128 + tid] = qq[t] * __builtin_amdgcn_exp2f(gl[t]); K2[t * 128 + tid] = kk[t] * __builtin_amdgcn_exp2f(-gl[t]); K3[t * 128 + tid] = kk[t] * __builtin_amdgcn_exp2f(run - gl[t]); }
        DEC[tid] = __builtin_amdgcn_exp2f(run);
    } else if (tid < 256) { const int vv = tid - 128;
#pragma unroll
        for (int t = 0; t < 8; ++t) Vs[t * 128 + vv] = bf2f(PB[(size_t)(tok0 + t) * PBW + 1024 + h * HD + vv]);
    }
    __syncthreads();
    { const int p = tid >> 3, part = tid & 7, t = p >> 3, s = p & 7; float a = 0.f;
#pragma unroll
      for (int j = 0; j < 16; ++j) a += Qs[t * 128 + part + 8 * j] * K2[s * 128 + part + 8 * j];
      a += __shfl_xor(a, 1); a += __shfl_xor(a, 2); a += __shfl_xor(a, 4);
      if (part == 0) ATT[p] = (s <= t) ? a : 0.f; }
    float vr[8], o[8];
#pragma unroll
    for (int t = 0; t < 8; ++t) { vr[t] = Vs[t * 128 + v]; o[t] = 0.f; }
#pragma unroll
    for (int j = 0; j < 32; ++j) { const int k = 32 * kq + j; const float sv = s0[j]; float sn = DEC[k] * sv;
#pragma unroll
        for (int t = 0; t < 8; ++t) { o[t] += Qs[t * 128 + k] * sv; sn += K3[t * 128 + k] * vr[t]; }
        Sout[(size_t)k * HD + v] = sn; }
#pragma unroll
    for (int t = 0; t < 8; ++t) OP[(kq * 8 + t) * 128 + v] = o[t];
    __syncthreads();
#pragma unroll
    for (int r = 0; r < 2; ++r) { const int e = tid + 512 * r, t = e >> 7, vv = e & 127;
        float acc = (OP[(0 * 8 + t) * 128 + vv] + OP[(1 * 8 + t) * 128 + vv]) + (OP[(2 * 8 + t) * 128 + vv] + OP[(3 * 8 + t) * 128 + vv]);
#pragma unroll
        for (int s = 0; s < 8; ++s) acc += ATT[t * 8 + s] * Vs[s * 128 + vv];
        OT[t * 128 + vv] = acc; }
    __syncthreads();
    { const int t = F.wave, lane = F.lane; const float o0 = OT[t * 128 + 2 * lane], o1 = OT[t * 128 + 2 * lane + 1];
      const float rstd = 1.0f / sqrtf(wave_sum(o0 * o0 + o1 * o1) * (1.0f / HD) + EPS);
      const unsigned gw2 = *(const unsigned*)(PB + (size_t)(tok0 + t) * PBW + 1536 + h * HD + 2 * lane);
      const float g0 = F.in[17][2 * lane], g1 = F.in[17][2 * lane + 1];
      *(unsigned*)(MIX + (size_t)(tok0 + t) * DM + 512 + h * HD + 2 * lane) = pk2(o0 * rstd * g0 * siluf_(bflo(gw2)), o1 * rstd * g1 * siluf_(bfhi(gw2))); }
    __syncthreads();
}
constexpr int SG_LD = 68;
template <int KSTEPS  >
__device__ __forceinline__ void small_gemm_tile(Frame& F, const bf16* A, int lda, const bf16* Bt, int K, int r0, int c0, float (&v)[8]) {
    const int lane = F.lane, wave = F.wave, fr = lane & 15, fq = lane >> 4;
    f32x4v acc[4][4];
#pragma unroll
    for (int a = 0; a < 4; ++a)
#pragma unroll
        for (int b = 0; b < 4; ++b) acc[a][b] = (f32x4v){0.f, 0.f, 0.f, 0.f};
    const bf16* ap = A + (size_t)(r0 + fr) * lda + wave * (KSTEPS * 32) + 8 * fq;
    const bf16* bp = Bt + (size_t)(c0 + fr) * K + wave * (KSTEPS * 32) + 8 * fq;
#pragma unroll 2
    for (int ks = 0; ks < KSTEPS; ++ks) {
        s16x8 af[4], bf[4];
#pragma unroll
        for (int i = 0; i < 4; ++i) { af[i] = *(const s16x8*)(ap + (size_t)(16 * i) * lda + 32 * ks); bf[i] = *(const s16x8*)(bp + (size_t)(16 * i) * K + 32 * ks); }
#pragma unroll
        for (int a = 0; a < 4; ++a)
#pragma unroll
            for (int b = 0; b < 4; ++b) acc[a][b] = __builtin_amdgcn_mfma_f32_16x16x32_bf16(bf[b], af[a], acc[a][b], 0, 0, 0);
    }
    LAS float* part = (LAS float*)F.lds + wave * (64 * SG_LD);
#pragma unroll
    for (int a = 0; a < 4; ++a)
#pragma unroll
        for (int b = 0; b < 4; ++b) *(LAS f32x4v*)(part + (16 * a + fr) * SG_LD + 16 * b + 4 * fq) = acc[a][b];
    __syncthreads();
    { const int row = F.tid >> 3, cg8 = (F.tid & 7) * 8; const LAS float* p = (const LAS float*)F.lds + row * SG_LD + cg8;
      f32x4v s0 = {0.f, 0.f, 0.f, 0.f}, s1 = {0.f, 0.f, 0.f, 0.f};
#pragma unroll
      for (int w = 0; w < 8; ++w) { s0 += *(const LAS f32x4v*)(p + w * (64 * SG_LD)); s1 += *(const LAS f32x4v*)(p + w * (64 * SG_LD) + 4); }
      v[0] = s0[0]; v[1] = s0[1]; v[2] = s0[2]; v[3] = s0[3]; v[4] = s1[0]; v[5] = s1[1]; v[6] = s1[2]; v[7] = s1[3]; }
    __syncthreads();
}

__device__ __forceinline__ void outproj_sample_tile(Frame& F, int tile, float* SS1) {
    const int rm = tile >> 4, cn = tile & 15; float v[8];
    small_gemm_tile<4>(F, (const bf16*)(F.ws + WS_MIX), DM, (const bf16*)(F.ws + WS_WOUT), DM, MP + 64 * rm, 64 * cn, v);
    const int row = MP + 64 * rm + (F.tid >> 3), col = 64 * cn + 8 * (F.tid & 7); const size_t off = (size_t)row * DM + col;
    const float* xs = F.in[1] + (size_t)(row - MP) * DM + col; bf16* XN = (bf16*)(F.ws + WS_XN);
    const f32x4v xa = *(const f32x4v*)xs, xb = *(const f32x4v*)(xs + 4);
    const f32x4v x0 = {xa[0] + v[0], xa[1] + v[1], xa[2] + v[2], xa[3] + v[3]}, x1 = {xb[0] + v[4], xb[1] + v[5], xb[2] + v[6], xb[3] + v[7]};
    v4u w; w.x = pk2(x0[0], x0[1]); w.y = pk2(x0[2], x0[3]); w.z = pk2(x1[0], x1[1]); w.w = pk2(x1[2], x1[3]);
    *(v4u*)(XN + off) = w;
    float ss = (x0[0] * x0[0] + x0[1] * x0[1]) + (x0[2] * x0[2] + x0[3] * x0[3]) + (x1[0] * x1[0] + x1[1] * x1[1]) + (x1[2] * x1[2] + x1[3] * x1[3]);
    ss += __shfl_xor(ss, 1); ss += __shfl_xor(ss, 2); ss += __shfl_xor(ss, 4);
    if ((F.tid & 7) == 0) __hip_atomic_fetch_add(SS1 + row, ss, __ATOMIC_RELAXED, __HIP_MEMORY_SCOPE_AGENT);
}
__device__ __forceinline__ void down_sample_tile(Frame& F, int tile, float* SS2, unsigned* cntb, float* YO) {
    const int rm = tile >> 4, cn = tile & 15; float v[8];
    small_gemm_tile<11>(F, (const bf16*)(F.ws + WS_ACT), DFF, (const bf16*)(F.ws + WS_WD), DFF, MP + 64 * rm, 64 * cn, v);
    const int row = MP + 64 * rm + (F.tid >> 3), col = 64 * cn + 8 * (F.tid & 7); const size_t off = (size_t)row * DM + col;
    unsigned* cnt = cntb + 64 * rm; const v4u xw = *(const v4u*)((const bf16*)(F.ws + WS_XN) + off);
    const f32x4v xa = {bflo(xw.x), bfhi(xw.x), bflo(xw.y), bfhi(xw.y)}, xb = {bflo(xw.z), bfhi(xw.z), bflo(xw.w), bfhi(xw.w)}, ga = *(const f32x4v*)(F.in[23] + col), gb = *(const f32x4v*)(F.in[23] + col + 4);
    const f32x4v x0 = {xa[0] + v[0], xa[1] + v[1], xa[2] + v[2], xa[3] + v[3]}, x1 = {xb[0] + v[4], xb[1] + v[5], xb[2] + v[6], xb[3] + v[7]};
    float ss = (x0[0] * x0[0] + x0[1] * x0[1]) + (x0[2] * x0[2] + x0[3] * x0[3]) + (x1[0] * x1[0] + x1[1] * x1[1]) + (x1[2] * x1[2] + x1[3] * x1[3]);
    ss += __shfl_xor(ss, 1); ss += __shfl_xor(ss, 2); ss += __shfl_xor(ss, 4);
    if ((F.tid & 7) == 0) __hip_atomic_fetch_add(SS2 + row, ss, __ATOMIC_RELAXED, __HIP_MEMORY_SCOPE_AGENT);
    asm volatile("s_waitcnt vmcnt(0)" ::: "memory");
    __syncthreads();
    if (F.tid == 0) { __hip_atomic_fetch_add(cnt, 1u, __ATOMIC_RELAXED, __HIP_MEMORY_SCOPE_AGENT); wait_count(cnt, 16u); }
    __syncthreads();
    float s = 0.f; if ((F.tid & 7) == 0) s = atomic_read_f32(SS2 + row);
    const float rs = rstd_of(__shfl(s, F.lane & ~7));
    *(f32x4v*)(YO + off) = (f32x4v){x0[0] * rs * ga[0], x0[1] * rs * ga[1], x0[2] * rs * ga[2], x0[3] * rs * ga[3]};
    *(f32x4v*)(YO + off + 4) = (f32x4v){x1[0] * rs * gb[0], x1[1] * rs * gb[1], x1[2] * rs * gb[2], x1[3] * rs * gb[3]};
}
typedef GAS unsigned gu32;
#define RLX_AGENT __ATOMIC_RELAXED, __HIP_MEMORY_SCOPE_AGENT
constexpr int MISC_OFF = LDS_BYTES - 512;
constexpr int CW_QUEUE = 8192;
constexpr int CW_BAR = 4096;
constexpr size_t CTL_ZERO_BYTES = 524288;
constexpr int CW_DUMMY = 65536;
#define XB_TMO      128
#define XB_XCNT(j)  (256  + 64 * (j))
#define XB_XSUB(j)  (1280 + 64 * (j))
#define XB_XGEN(j)  (2304 + 64 * (j))
#define XB_TOP      3328
#define XB_TOPGEN   3392
#define XCD_BAR_WORDS 3456
#define XB_SPIN_CAP (1u << 18)

__device__ __forceinline__ unsigned xb_ld(unsigned* p)              { return __hip_atomic_load(p, __ATOMIC_RELAXED, __HIP_MEMORY_SCOPE_AGENT); }
__device__ __forceinline__ unsigned xb_add(unsigned* p, unsigned v) { return __hip_atomic_fetch_add(p, v, __ATOMIC_RELAXED, __HIP_MEMORY_SCOPE_AGENT); }
__device__ __forceinline__ unsigned xb_xcc_id() { return (unsigned)__builtin_amdgcn_s_getreg((3 << 11) | 20) & 0xFu; }
#define XB_SPIN(cond, bar) do { unsigned _sp = 0; while (cond) { __builtin_amdgcn_s_sleep(1); \
    if ((++_sp & 255u) == 0u) { if (xb_ld(&(bar)[XB_TMO])) break; if (_sp > XB_SPIN_CAP) { atomicAdd(&(bar)[XB_TMO], 1u); break; } } } } while (0)

struct XcdBarrier {
    unsigned* bar; unsigned x;
    volatile LAS unsigned* st;
};

__device__ __forceinline__ XcdBarrier xcd_barrier_post(unsigned* bar, volatile LAS unsigned* st) {
    XcdBarrier b; b.bar = bar; b.x = xb_xcc_id(); b.st = st;
    if (threadIdx.x == 0) (void)xb_add(&bar[XB_XCNT(b.x)], 1u);
    return b;
}
__device__ __forceinline__ void xcd_barrier_complete(unsigned* bar, unsigned x, unsigned& nloc, unsigned& nx) {
    const unsigned G = gridDim.x * gridDim.y * gridDim.z;
    unsigned sum, cnt, mine, sp = 0u;
    for (;;) {
        sum = 0u; cnt = 0u; mine = 0u;
#pragma unroll
        for (unsigned j = 0; j < 16; ++j) { const unsigned c = xb_ld(&bar[XB_XCNT(j)]); sum += c; cnt += (c > 0u) ? 1u : 0u; mine = (j == x) ? c : mine; }
        if (sum == G) break;
        __builtin_amdgcn_s_sleep(1);
        if ((++sp & 255u) == 0u) { if (xb_ld(&bar[XB_TMO])) break; if (sp > XB_SPIN_CAP) { atomicAdd(&bar[XB_TMO], 1u); break; } }
    }
    nloc = mine > 0u ? mine : 1u; nx = cnt > 0u ? cnt : 1u;
}

__device__ __forceinline__ void xcd_barrier(const XcdBarrier& b) {
    asm volatile("s_waitcnt vmcnt(0)" ::: "memory");
    __syncthreads();
    if (threadIdx.x == 0) {
        unsigned* bar = b.bar;
        __builtin_amdgcn_s_waitcnt(0);
        unsigned nloc = b.st[0], nx = b.st[1];
        if (nloc == 0u) { xcd_barrier_complete(bar, b.x, nloc, nx); b.st[0] = nloc; b.st[1] = nx; }
        const unsigned old = xb_add(&bar[XB_XSUB(b.x)], 1u);
        const unsigned gen = old / nloc;
        if (old + 1u == (gen + 1u) * nloc) {
            __builtin_amdgcn_fence(__ATOMIC_RELEASE, "agent");
            asm volatile("s_waitcnt vmcnt(0)" ::: "memory");
            const unsigned og = xb_add(&bar[XB_TOP], 1u);
            const unsigned tg = og / nx;
            if (og + 1u == (tg + 1u) * nx) xb_add(&bar[XB_TOPGEN], 1u);
            else XB_SPIN(xb_ld(&bar[XB_TOPGEN]) == tg, bar);
            __builtin_amdgcn_fence(__ATOMIC_ACQUIRE, "agent");
            xb_add(&bar[XB_XGEN(b.x)], 1u);
            asm volatile("s_waitcnt vmcnt(0)" ::: "memory");
        } else {
            XB_SPIN(xb_ld(&bar[XB_XGEN(b.x)]) == gen, bar);
            __builtin_amdgcn_fence(__ATOMIC_ACQUIRE, "agent");
            asm volatile("s_waitcnt vmcnt(0)" ::: "memory");
        }
    }
    __syncthreads();
}

__global__ void __launch_bounds__(NWAVES * 64, 2) mk_fwd(Args args) {
    extern __shared__ __attribute__((aligned(16))) unsigned char lds[];
    Frame F;
    F.lds = (LAS unsigned char*)lds;
    F.tid = threadIdx.x; F.lane = F.tid & 63; F.wave = __builtin_amdgcn_readfirstlane(F.tid >> 6);
    F.G = gridDim.x; F.bid = blockIdx.x;
#pragma unroll
    for (int i = 0; i < 24; ++i) F.in[i] = args.in[i];
    F.out = args.out; F.ws = args.ws;
    const int lo = args.ph_lo, hi = args.ph_hi;
#define IN(k) (lo <= (k) && (k) < hi)
#if MK_N_LAUNCHES == 1
    volatile LAS unsigned* MISC = (volatile LAS unsigned*)(F.lds + MISC_OFF);
    if (F.tid < 32) MISC[F.tid] = 0u;
    __syncthreads();
    XcdBarrier bar = xcd_barrier_post((unsigned*)(F.ws + WS_CTL) + CW_BAR, MISC + 8);
#if defined(PROBE_PH)
    if (F.bid == 0 && F.tid == 0) { const unsigned long long t_ = __builtin_amdgcn_s_memrealtime(); MISC[32] = (unsigned)t_; MISC[33] = (unsigned)(t_ >> 32); }
#endif
#if defined(PROBE_PH)
#define SEAM(k) do { if (IN(k) && IN((k) + 1)) { xcd_barrier(bar); if (F.bid == 0 && F.tid == 0) { const unsigned long long t_ = __builtin_amdgcn_s_memrealtime(); MISC[32 + 2 * ((k) + 1)] = (unsigned)t_; MISC[33 + 2 * ((k) + 1)] = (unsigned)(t_ >> 32); } } } while (0)
#elif REP_BAR == 2
#define SEAM(k) do { if (IN(k) && IN((k) + 1)) { xcd_barrier(bar); xcd_barrier(bar); } } while (0)
#else
#define SEAM(k) do { if (IN(k) && IN((k) + 1)) xcd_barrier(bar); } while (0)
#endif
#else
#define SEAM(k) do { } while (0)
#endif
    const int gw = F.bid * NWAVES + F.wave, NGW = F.G * NWAVES;
    bf16* XN = (bf16*)(F.ws + WS_XN); bf16* PB = (bf16*)(F.ws + WS_PB); float* FZ = (float*)(F.ws + WS_FZ); bf16* GY = (bf16*)(F.ws + WS_GY);
    bf16* MIX = (bf16*)(F.ws + WS_MIX); bf16* ACT = (bf16*)(F.ws + WS_ACT);

    if (IN(0)) { p0_prologue(F);
#if REP_P0 == 2
        __syncthreads(); p0_prologue(F);
#endif
    } SEAM(0);
    if (IN(1)) {
        pg8::Gemm g{XN, (const bf16*)(F.ws + WS_WIN), MTOK, INC, DM}; pg8::StaticOrder S; S.init(MTOK, INC, F.G, F.bid);
        EpiIn E{PB, FZ, (bf16*)(F.ws + WS_U5)};
        pg8::gemm_phase<EpiIn, pg8::StaticOrder, true, true>(F.lds, g, S, E);
        { const int nunits = (MTOK / 256) * (INC / 256), rem = nunits % F.G;
          if (rem == 0) deferred_transposes(F, gw, NGW); else if (F.bid >= rem) deferred_transposes(F, (F.bid - rem) * NWAVES + F.wave, (F.G - rem) * NWAVES); }
#if REP_P1 == 2
        __syncthreads();
        pg8::gemm_phase<EpiIn, pg8::StaticOrder, true, true>(F.lds, g, S, E);
#endif
    } SEAM(1);
    if (IN(2)) {
        for (int it = F.bid; it < 256; it += F.G) s5_item(F, it);
#if REP_S5 == 2
        for (int it = F.bid; it < 256; it += F.G) s5_item(F, it);
#endif
        hgA_loop(F);
#if REP_HGA == 2
        hgA_loop(F);
#endif
        for (int it = F.bid; it < SB_B * HH; it += F.G) hgrn_sample_item(F, it);
    } SEAM(2);
    if (IN(3)) {
#if REP_P3 == 2
        hg_scan(F, (bf16*)(F.ws + WS_MIX)); __syncthreads();
#endif
        hg_scan(F, (bf16*)(F.ws + WS_DSC)); } SEAM(3);
    if (IN(4)) {
        pg8::Gemm g{GY, (const bf16*)(F.ws + WS_WGLU), MTOK, S5W, S5W}; pg8::StaticOrder S; S.init(MTOK, S5W, F.G, F.bid);
        EpiGlu E{GY, MIX};
        pg8::gemm_phase<EpiGlu, pg8::StaticOrder, true, true, true>(F.lds, g, S, E);
#if REP_GLU == 2
        __syncthreads();
        pg8::gemm_phase<EpiGlu, pg8::StaticOrder, true, true, true>(F.lds, g, S, E);
#endif
        __syncthreads();
        hgC_loop(F, (unsigned*)(F.ws + WS_CTL) + CW_QUEUE);
#if REP_HGC == 2
        __syncthreads();
        hgC_loop(F, (unsigned*)(F.ws + WS_CTL) + CW_QUEUE + 64);
#endif
    } SEAM(4);
    if (IN(5)) {
        pg8::Gemm g{MIX, (const bf16*)(F.ws + WS_WOUT), MP, DM, DM}; pg8::StaticOrder S; S.init(MP, DM, F.G, F.bid);
#if REP_P5 >= 2
        { EpiOut E2{F.in[0], XN, (float*)(F.ws + WS_CTL) + CW_DUMMY};
#if REP_P5 == 2 || REP_P5 == 3
          pg8::gemm_phase<EpiOut, pg8::StaticOrder, true, true>(F.lds, g, S, E2);
          __syncthreads();
#endif
#if REP_P5 == 2 || REP_P5 == 4
          for (int it = F.bid; it < 256; it += F.G) outproj_sample_tile(F, it, (float*)(F.ws + WS_CTL) + CW_DUMMY);
          __syncthreads();
#endif
        }
#endif
        EpiOut E{F.in[0], XN, (float*)(F.ws + WS_CTL) + CW_SS1};
        pg8::gemm_phase<EpiOut, pg8::StaticOrder, true, true>(F.lds, g, S, E);
        __syncthreads();
        for (int it = F.bid; it < 256; it += F.G) outproj_sample_tile(F, it, (float*)(F.ws + WS_CTL) + CW_SS1);
    } SEAM(5);
    if (IN(6)) {
        pg8::Gemm g{XN, (const bf16*)(F.ws + WS_WGU), MTOK, 2 * DFF, DM}; pg8::StaticOrder S; S.init(MTOK, 2 * DFF, F.G, F.bid);
        EpiAct E{ACT, (const float*)(F.ws + WS_CTL) + CW_SS1};
        pg8::gemm_phase<EpiAct, pg8::StaticOrder, true, true>(F.lds, g, S, E);
#if REP_P6 == 2
        __syncthreads();
        pg8::gemm_phase<EpiAct, pg8::StaticOrder, true, true>(F.lds, g, S, E);
#endif
    } SEAM(6);
    if (IN(7)) {
        pg8::Gemm g{ACT, (const bf16*)(F.ws + WS_WD), MP, DM, DFF}; pg8::StaticOrder S; S.init(MP, DM, F.G, F.bid);
#if REP_P7 == 2
        { float* YD = (float*)(F.ws + WS_GY) - 0;
          EpiDown E2{XN, F.in[23], (float*)(F.ws + WS_CTL) + CW_DUMMY, (unsigned*)(F.ws + WS_CTL) + CW_DUMMY + 20480, YD};
          pg8::gemm_phase<EpiDown, pg8::StaticOrder, true, true>(F.lds, g, S, E2);
          __syncthreads();
          for (int it = F.bid; it < 256; it += F.G) down_sample_tile(F, it, (float*)(F.ws + WS_CTL) + CW_DUMMY, (unsigned*)(F.ws + WS_CTL) + CW_DUMMY + 20480 + 4096, YD);
          __syncthreads(); }
#endif
        EpiDown E{XN, F.in[23], (float*)(F.ws + WS_CTL) + CW_SS2, (unsigned*)(F.ws + WS_CTL) + CW_CNT, F.out + O_Y};
        Unit u0; const bool has_u = S.next(0, u0); const int grp = has_u ? (u0.pm & 1) : 0;
        const int stile = (F.G == 256 && has_u) ? grp * 128 + (u0.pm >> 1) * 4 + u0.pn : F.bid;
        if (F.G == 256 && grp == 0) { down_sample_tile(F, stile, (float*)(F.ws + WS_CTL) + CW_SS2, (unsigned*)(F.ws + WS_CTL) + CW_CNTS, F.out + O_Y); __syncthreads(); }
        pg8::gemm_phase<EpiDown, pg8::StaticOrder, true, true>(F.lds, g, S, E);
        __syncthreads();
        if (F.G != 256) { for (int it = F.bid; it < 256; it += F.G) down_sample_tile(F, it, (float*)(F.ws + WS_CTL) + CW_SS2, (unsigned*)(F.ws + WS_CTL) + CW_CNTS, F.out + O_Y); }
        else if (grp == 1) down_sample_tile(F, stile, (float*)(F.ws + WS_CTL) + CW_SS2, (unsigned*)(F.ws + WS_CTL) + CW_CNTS, F.out + O_Y);
    }
#if defined(PROBE_PH)
    if (F.bid == 0 && F.tid == 0) {
        const unsigned long long tn = __builtin_amdgcn_s_memrealtime();
        const unsigned long long t0 = ((unsigned long long)MISC[33 + 2 * PROBE_PH] << 32) | MISC[32 + 2 * PROBE_PH];
        const unsigned long long t1 = (PROBE_PH == NPH - 1) ? tn : (((unsigned long long)MISC[35 + 2 * PROBE_PH] << 32) | MISC[34 + 2 * PROBE_PH]);
        const unsigned long long wait = 4ull * (t1 - t0);
        while (__builtin_amdgcn_s_memrealtime() - tn < wait) __builtin_amdgcn_s_sleep(8);
    }
#endif
#undef IN
#undef SEAM
}

extern "C" void kernel_launch(void* const* d_in, const int* in_sizes, int n_in, void* d_out, int out_size, void* d_ws, size_t ws_size, hipStream_t stream) {
    static int grid = 0;
    if (grid == 0) {
        if (n_in != 24 || ws_size < WS_END) { fprintf(stderr, "kernel_launch: unexpected n_in %d / ws %zu\n", n_in, ws_size); grid = -1; return; }
        int dev = 0, cus = 0, per_cu = 0;
        if (hipGetDevice(&dev) != hipSuccess || hipDeviceGetAttribute(&cus, hipDeviceAttributeMultiprocessorCount, dev) != hipSuccess) { grid = -1; return; }
        if (hipFuncSetAttribute((const void*)mk_fwd, hipFuncAttributeMaxDynamicSharedMemorySize, LDS_BYTES) != hipSuccess) { fprintf(stderr, "kernel_launch: hipFuncSetAttribute failed\n"); grid = -1; return; }
        if (hipOccupancyMaxActiveBlocksPerMultiprocessor(&per_cu, (const void*)mk_fwd, NWAVES * 64, LDS_BYTES) != hipSuccess || per_cu < 1) { fprintf(stderr, "kernel_launch: occupancy query says %d\n", per_cu); per_cu = 1; }
        (void)hipGetLastError();
        grid = cus;
    }
    if (grid < 0) return;
    if (hipMemsetAsync((char*)d_ws + WS_CTL, 0, CTL_ZERO_BYTES, stream) != hipSuccess) { fprintf(stderr, "kernel_launch: memset failed\n"); return; }
    Args a{};
    for (int i = 0; i < 24; ++i) a.in[i] = (const float*)d_in[i];
    a.out = (float*)d_out; a.ws = (unsigned char*)d_ws;
#if MK_N_LAUNCHES == 1
    a.ph_lo = 0; a.ph_hi = NPH;
    void* kargs[] = {&a};
    hipError_t e = hipLaunchCooperativeKernel((const void*)mk_fwd, dim3(grid), dim3(NWAVES * 64), kargs, LDS_BYTES, stream);
    if (e != hipSuccess) fprintf(stderr, "kernel_launch: cooperative launch failed: %s (grid %d)\n", hipGetErrorString(e), grid);
#else
    for (int p = 0; p < NPH; ++p) { a.ph_lo = p; a.ph_hi = p + 1; hipLaunchKernelGGL(mk_fwd, dim3(grid), dim3(NWAVES * 64), LDS_BYTES, stream, a); }
#endif
}
```

```cpp
#include <hip/hip_runtime.h>
#include <hip/hip_cooperative_groups.h>
#include <cstdio>
#include <cstdint>
namespace cg = cooperative_groups;
#define MK_N_LAUNCHES 1
namespace pg8 {
#define PG8_LAS __attribute__((address_space(3)))
typedef unsigned short bf16_t;
typedef short bf16x8 __attribute__((ext_vector_type(8)));
typedef float f32x4 __attribute__((ext_vector_type(4)));
typedef unsigned u32x4 __attribute__((ext_vector_type(4)));
constexpr int BM = 256, BK = 64, HALF = 128, HTB = HALF * BK * 2  , STAGE_BYTES = 8 * HTB, NXCD = 8, WGM = 8;

__host__ __device__ __forceinline__ int lds_byte(int r, int c) { const int st = (r >> 4) * 2 + (c >> 5), rr = r & 15, cc = c & 31, ob = rr * 64 + cc * 2; return st * 1024 + (ob ^ (((ob >> 9) & 1) << 5)); }
__host__ __device__ __forceinline__ void stage_rc(int b, int& R, int& C) { const int st = b / 1024, sb = b % 1024, swz = sb ^ (((sb >> 9) & 1) << 5); R = (st >> 1) * 16 + swz / 64; C = (st & 1) * 32 + (swz % 64) / 2; }
__host__ __device__ __forceinline__ int perm32(int rho) { const int n = rho >> 4, i = rho & 15; return 8 * (i >> 2) + 4 * n + (i & 3); }

struct Unit { int pm, pn; };
struct Gemm { const bf16_t* A; const bf16_t* Bt; int M, N, K; };

struct StaticOrder {
    int nM, nN, nwg, G, c;
    __host__ __device__ void init(int M, int N, int G_, int c_) { nM = M / BM; nN = N / BM; nwg = nM * nN; G = G_; c = c_; }
    __host__ __device__ bool next(int i, Unit& u) const {
        const long L = (long)i * G + c; if (L >= nwg) return false;
        int wgid = (int)L; { const int q = nwg / NXCD, r = nwg % NXCD, xcd = wgid % NXCD, off = wgid / NXCD; wgid = (xcd < r ? xcd * (q + 1) : r * (q + 1) + (xcd - r) * q) + off; }
        const int nig = WGM * nN, gid = wgid / nig, fm = gid * WGM, gsz = (nM - fm) < WGM ? (nM - fm) : WGM;
        u.pm = fm + ((wgid % nig) % gsz); u.pn = (wgid % nig) / gsz; return true;
    }
    __device__ __forceinline__ void a_ready(const Unit&) const {}
    __device__ __forceinline__ void done(const Unit&) const {}
};

__device__ __forceinline__ unsigned cvt_pk_bf16(float lo, float hi) { unsigned r; asm volatile("v_cvt_pk_bf16_f32 %0, %1, %2" : "=v"(r) : "v"(lo), "v"(hi)); return r; }
template <class Epi, class Sched, bool ALIGN_EPI = false, bool SP2 = false, bool AGM = false  >
__device__ __forceinline__ void gemm_phase(PG8_LAS unsigned char* lds, const Gemm g, const Sched& S, const Epi& E) {
    const int tid = threadIdx.x, wid = __builtin_amdgcn_readfirstlane(tid >> 6), lane = tid & 63, wr = wid >> 2, wc = wid & 3, fr = lane & 15, fq = lane >> 4;
    const int K = g.K, nt = K / BK;
    unsigned voffA[2], voffB[2];
#pragma unroll
    for (int i = 0; i < 2; ++i) { int R, C; stage_rc(tid * 16 + i * 8192, R, C); const int Rb = Epi::PERM ? ((R & ~31) + perm32(R & 31)) : R;
        voffA[i] = AGM ? (unsigned)((((C >> 4) * g.M + R) * 16 + (C & 15)) * 2) : (unsigned)(R * K + C) * 2u; voffB[i] = (unsigned)(Rb * K + C) * 2u; }
    const size_t kstep = (size_t)(BK * 2);
    const size_t hstep = (size_t)HALF * K * 2;
    const size_t tstep = 2 * hstep;
    const size_t kstepA = AGM ? (size_t)4 * g.M * 32 : kstep, hstepA = AGM ? (size_t)HALF * 32 : hstep, tstepA = 2 * hstepA;
    const unsigned ldsw = (unsigned)wid * 1024u;
    const int aoff = lds_byte(wr * 64 + fr, fq * 8), boff = lds_byte(wc * 32 + fr, fq * 8);
#define PG8_SA(b, h) (((b) * 2 + (h)) * HTB)
#define PG8_SB(b, h) ((4 + (b) * 2 + (h)) * HTB)
#define PG8_STAGE(bufoff, gbase, voff) do { _Pragma("unroll") for (int _i = 0; _i < 2; ++_i) \
        __builtin_amdgcn_global_load_lds((const unsigned*)((const char*)(gbase) + (voff)[_i]), (PG8_LAS unsigned*)(lds + (bufoff) + ldsw + _i * 8192), 16, 0, 0); } while (0)
#define PG8_LDA(dst, b, h) do { _Pragma("unroll") for (int m = 0; m < 4; ++m) _Pragma("unroll") for (int k = 0; k < 2; ++k) dst[m][k] = *(const PG8_LAS bf16x8*)(lds + PG8_SA(b, h) + aoff + m * 2048 + k * 1024); } while (0)
#define PG8_LDB(dst, b, h) do { _Pragma("unroll") for (int n = 0; n < 2; ++n) _Pragma("unroll") for (int k = 0; k < 2; ++k) dst[n][k] = *(const PG8_LAS bf16x8*)(lds + PG8_SB(b, h) + boff + n * 2048 + k * 1024); } while (0)
#define PG8_MMA(ai, bj, At, Bt) do { __builtin_amdgcn_s_setprio(1); _Pragma("unroll") for (int m = 0; m < 4; ++m) _Pragma("unroll") for (int n = 0; n < 2; ++n) _Pragma("unroll") for (int k = 0; k < 2; ++k) \
        acc[ai][bj][m][n] = __builtin_amdgcn_mfma_f32_16x16x32_bf16(Bt[n][k], At[m][k], acc[ai][bj][m][n], 0, 0, 0); __builtin_amdgcn_s_setprio(0); } while (0)
#define PG8_WAIT_V(n) asm volatile("s_waitcnt vmcnt(" #n ")" ::: "memory")
#define PG8_WAIT_L(n) asm volatile("s_waitcnt lgkmcnt(" #n ")" ::: "memory")
#define PG8_BAR __builtin_amdgcn_s_barrier()
#define PG8_SCHED __builtin_amdgcn_sched_barrier(0)
    Unit cur, nxt; int ui = 0;
    if (!S.next(0, cur)) return;
    f32x4 acc[2][2][4][2];
#pragma unroll
    for (int a = 0; a < 2; ++a)
#pragma unroll
        for (int b = 0; b < 2; ++b)
#pragma unroll
            for (int m = 0; m < 4; ++m)
#pragma unroll
                for (int n = 0; n < 2; ++n) acc[a][b][m][n] = (f32x4){0.f, 0.f, 0.f, 0.f};
    bf16x8 At[4][2], B0[2][2], B1[2][2];
    const char* cA = (const char*)g.A + (size_t)cur.pm * tstepA; const char* cB = (const char*)g.Bt + (size_t)cur.pn * tstep;
    S.a_ready(cur);
    if constexpr (SP2) {
        PG8_STAGE(PG8_SB(0, 0), cB, voffB); PG8_STAGE(PG8_SB(0, 1), cB + hstep, voffB); PG8_STAGE(PG8_SA(0, 0), cA, voffA); PG8_STAGE(PG8_SA(0, 1), cA + hstepA, voffA);
        if (wr == 1) PG8_BAR;
        PG8_WAIT_V(2); PG8_BAR;
        PG8_STAGE(PG8_SB(1, 0), cB + kstep, voffB); PG8_STAGE(PG8_SA(1, 0), cA + kstepA, voffA); PG8_STAGE(PG8_SB(1, 1), cB + hstep + kstep, voffB);
        PG8_WAIT_V(6); PG8_BAR;
    } else {
        PG8_STAGE(PG8_SB(0, 0), cB, voffB); PG8_STAGE(PG8_SA(0, 0), cA, voffA); PG8_STAGE(PG8_SB(0, 1), cB + hstep, voffB); PG8_STAGE(PG8_SA(0, 1), cA + hstepA, voffA);
        if (wr == 1) PG8_BAR;
        PG8_WAIT_V(4); PG8_BAR;
        PG8_STAGE(PG8_SB(1, 0), cB + kstep, voffB); PG8_STAGE(PG8_SA(1, 0), cA + kstepA, voffA); PG8_STAGE(PG8_SB(1, 1), cB + hstep + kstep, voffB);
        PG8_WAIT_V(6); PG8_BAR;
    }
    for (;;) {
        const bool has_next = S.next(ui + 1, nxt);
        const char* nA = has_next ? (const char*)g.A + (size_t)nxt.pm * tstepA : cA; const char* nB = has_next ? (const char*)g.Bt + (size_t)nxt.pn * tstep : cB;
        for (int t = 0; t < nt; t += 2) {
            const bool last = (t == nt - 2);
            const char* a1 = cA + (size_t)(t + 1) * kstepA;
            const char* a2 = last ? nA : cA + (size_t)(t + 2) * kstepA; const char* b2 = last ? nB : cB + (size_t)(t + 2) * kstep;
            const char* a3 = a2 + kstepA; const char* b3 = b2 + kstep;
            if (last && has_next) S.a_ready(nxt);
            if constexpr (SP2) {
            PG8_LDB(B0, 0, 0); PG8_LDB(B1, 0, 1); PG8_SCHED; PG8_LDA(At, 0, 0); PG8_STAGE(PG8_SA(1, 1), a1 + hstepA, voffA);
            PG8_WAIT_V(8); PG8_WAIT_L(0); PG8_BAR; PG8_MMA(0, 0, At, B0); PG8_MMA(0, 1, At, B1); PG8_BAR; PG8_SCHED;
            PG8_LDA(At, 0, 1); PG8_STAGE(PG8_SB(0, 0), b2, voffB); PG8_STAGE(PG8_SB(0, 1), b2 + hstep, voffB); PG8_STAGE(PG8_SA(0, 0), a2, voffA);
            PG8_WAIT_V(8); PG8_WAIT_L(0); PG8_BAR; PG8_MMA(1, 0, At, B0); PG8_MMA(1, 1, At, B1); PG8_BAR; PG8_SCHED;
            PG8_LDB(B0, 1, 0); PG8_LDB(B1, 1, 1); PG8_SCHED; PG8_LDA(At, 1, 0); PG8_STAGE(PG8_SA(0, 1), a2 + hstepA, voffA);
            PG8_WAIT_V(8); PG8_WAIT_L(0); PG8_BAR; PG8_MMA(0, 0, At, B0); PG8_MMA(0, 1, At, B1); PG8_BAR; PG8_SCHED;
            PG8_LDA(At, 1, 1); PG8_STAGE(PG8_SB(1, 0), b3, voffB); PG8_STAGE(PG8_SB(1, 1), b3 + hstep, voffB); PG8_STAGE(PG8_SA(1, 0), a3, voffA);
            PG8_WAIT_V(8); PG8_WAIT_L(0); PG8_BAR; PG8_MMA(1, 0, At, B0); PG8_MMA(1, 1, At, B1); PG8_BAR; PG8_SCHED;
            } else {
            PG8_LDB(B0, 0, 0); PG8_SCHED; PG8_LDA(At, 0, 0); PG8_STAGE(PG8_SA(1, 1), a1 + hstepA, voffA);
            PG8_WAIT_L(8); PG8_BAR; PG8_WAIT_L(0); PG8_MMA(0, 0, At, B0); PG8_BAR; PG8_SCHED;
            PG8_LDB(B1, 0, 1); PG8_STAGE(PG8_SB(0, 0), b2, voffB);
            PG8_BAR; PG8_WAIT_L(0); PG8_MMA(0, 1, At, B1); PG8_BAR;
            PG8_LDA(At, 0, 1); PG8_STAGE(PG8_SA(0, 0), a2, voffA);
            PG8_BAR; PG8_WAIT_L(0); PG8_MMA(1, 0, At, B0); PG8_BAR; PG8_SCHED;
            PG8_STAGE(PG8_SB(0, 1), b2 + hstep, voffB);
            PG8_WAIT_V(6); PG8_BAR; PG8_MMA(1, 1, At, B1); PG8_BAR;
            PG8_LDB(B0, 1, 0); PG8_SCHED; PG8_LDA(At, 1, 0); PG8_STAGE(PG8_SA(0, 1), a2 + hstepA, voffA);
            PG8_WAIT_L(8); PG8_BAR; PG8_WAIT_L(0); PG8_MMA(0, 0, At, B0); PG8_BAR; PG8_SCHED;
            PG8_LDB(B1, 1, 1); PG8_STAGE(PG8_SB(1, 0), b3, voffB);
            PG8_BAR; PG8_WAIT_L(0); PG8_MMA(0, 1, At, B1); PG8_BAR;
            PG8_LDA(At, 1, 1); PG8_STAGE(PG8_SA(1, 0), a3, voffA);
            PG8_BAR; PG8_WAIT_L(0); PG8_MMA(1, 0, At, B0); PG8_BAR; PG8_SCHED;
            PG8_STAGE(PG8_SB(1, 1), b3 + hstep, voffB);
            PG8_WAIT_V(6); PG8_BAR; PG8_MMA(1, 1, At, B1); PG8_BAR;
            }
        }
        if constexpr (ALIGN_EPI) { if (wr == 0) PG8_BAR; }
        if constexpr (!Epi::AFTER_DRAIN) { E(acc, cur, wr, wc, fr, fq); S.done(cur); }
        if (!has_next) break;
#pragma unroll
        for (int a = 0; a < 2; ++a)
#pragma unroll
            for (int b = 0; b < 2; ++b)
#pragma unroll
                for (int m = 0; m < 4; ++m)
#pragma unroll
                    for (int n = 0; n < 2; ++n) acc[a][b][m][n] = (f32x4){0.f, 0.f, 0.f, 0.f};
        cur = nxt; cA = nA; cB = nB; ++ui;
        if constexpr (ALIGN_EPI) { if (wr == 1) PG8_BAR; }
    }
    PG8_WAIT_V(0);
    if constexpr (!ALIGN_EPI) { if (wr == 0) PG8_BAR; }
    PG8_BAR;
    if constexpr (Epi::AFTER_DRAIN) { E.fused(acc, cur, wr, wc, fr, fq, lds, wid, lane); S.done(cur); }
#undef PG8_SA
#undef PG8_SB
#undef PG8_STAGE
#undef PG8_LDA
#undef PG8_LDB
#undef PG8_MMA
#undef PG8_WAIT_V
#undef PG8_WAIT_L
#undef PG8_BAR
#undef PG8_SCHED
}
}

#ifndef S5_SIMPLE
#define S5_SIMPLE 0
#endif
#ifndef HG_SIMPLE
#define HG_SIMPLE 0
#endif
#ifndef REP0
#define REP0 1
#define REP1 1
#define REP2 1
#define REP3 1
#define REP4 1
#define REP6 1
#endif
#ifndef REP_S5
#define REP_S5 1
#endif
#ifndef REP_HGA
#define REP_HGA 1
#endif
#ifndef REP_HGC
#define REP_HGC 1
#endif
#ifndef REP_P1
#define REP_P1 1
#endif
#ifndef REP_P6
#define REP_P6 1
#endif
#ifndef REP_P0
#define REP_P0 1
#endif
#ifndef REP_GLU
#define REP_GLU 1
#endif
#ifndef REP_P3
#define REP_P3 1
#endif
#ifndef REP_P5
#define REP_P5 1
#endif
#ifndef REP_P7
#define REP_P7 1
#endif
#ifndef REP_BAR
#define REP_BAR 1
#endif
#ifndef REP_XN
#define REP_XN 1
#endif
#ifndef P6_ALIGN
#define P6_ALIGN true
#endif
#ifndef P6_SP2
#define P6_SP2 true
#endif
#ifndef MK_N_LAUNCHES
#define MK_N_LAUNCHES 1
#endif
constexpr int DM = 1024, PB_B = 8, PB_T = 2048, SB_B = 128, SB_T = 8;
constexpr int MP = PB_B * PB_T, MS = SB_B * SB_T, MTOK = MP + MS;
constexpr int S5W = 512, S5G = 32, S5C = 16, S5N = 64;
constexpr int HGW = 512, HD = 128, HH = 4;
constexpr int INC = 2560, DFF = 2816;
constexpr float EPS = 1e-6f;
constexpr int NPH = 8;
constexpr size_t O_Y = 0, O_PRE = (size_t)MTOK * DM, O_PIM = O_PRE + 16384, O_PHG = O_PIM + 16384, O_SRE = O_PHG + 524288, O_SIM = O_SRE + 262144, O_SHG = O_SIM + 262144;
constexpr size_t MiB = 1u << 20;
constexpr size_t WS_CTL = 0, WS_WIN = 2 * MiB, WS_WGLU = 7 * MiB, WS_WOUT = 8 * MiB, WS_WGU = 10 * MiB, WS_WD = 21 * MiB;
constexpr size_t WS_XN = 27 * MiB, WS_PB = 61 * MiB, WS_FZ = 129 * MiB, WS_ACT = 61 * MiB, WS_GY = 163 * MiB, WS_OH = 180 * MiB, WS_MIX = 197 * MiB, WS_END = 234 * MiB;
constexpr int PBW = 2048;
constexpr int LDS_BYTES = 147456;
constexpr int NWAVES = 8;
constexpr int CW_SS1 = 16384, CW_SS2 = 36864, CW_CNT = 57344, CW_CNTS = 61440;

#define GAS __attribute__((address_space(1)))
#define LAS __attribute__((address_space(3)))
typedef unsigned short bf16;
typedef unsigned v4u __attribute__((ext_vector_type(4)));
typedef unsigned v2u __attribute__((ext_vector_type(2)));
typedef float f32x4 __attribute__((ext_vector_type(4)));
#define LDS_WAIT() asm volatile("s_waitcnt lgkmcnt(0)" ::: "memory")
__device__ __forceinline__ unsigned f2bf(float f) { unsigned u = __builtin_bit_cast(unsigned, f); return (u + 0x7fffu + ((u >> 16) & 1u)) >> 16; }
__device__ __forceinline__ unsigned pk2(float lo, float hi) { return f2bf(lo) | (f2bf(hi) << 16); }
__device__ __forceinline__ float bf2f(unsigned short h) { return __builtin_bit_cast(float, (unsigned)h << 16); }
__device__ __forceinline__ float bflo(unsigned w) { return __builtin_bit_cast(float, w << 16); }
__device__ __forceinline__ float bfhi(unsigned w) { return __builtin_bit_cast(float, w & 0xffff0000u); }
__device__ __forceinline__ float sigmoidf_(float x) { return __builtin_amdgcn_rcpf(1.0f + __builtin_amdgcn_exp2f(-1.4426950408889634f * x)); }
__device__ __forceinline__ float siluf_(float x) { return x * __builtin_amdgcn_rcpf(1.0f + __builtin_amdgcn_exp2f(-1.4426950408889634f * x)); }
__device__ __forceinline__ float gelu_tanh(float x) { const float z = -2.302208198144325f * (x + 0.044715f * x * x * x); return x * __builtin_amdgcn_rcpf(1.0f + __builtin_amdgcn_exp2f(z)); }
__device__ __forceinline__ float wave_sum(float v) {
#pragma unroll
    for (int o = 1; o < 64; o <<= 1) v += __shfl_xor(v, o);
    return v;
}

struct Args { const float* in[24]; float* out; unsigned char* ws; int ph_lo, ph_hi; };

struct Frame {
    LAS unsigned char* lds;
    int tid, lane, wave, G, bid;
    const float* in[24];
    float* out; unsigned char* ws;
};
__device__ __forceinline__ const float* xrow(const Frame& F, int m) { return m < MP ? F.in[0] + (size_t)m * DM : F.in[1] + (size_t)(m - MP) * DM; }

__device__ __forceinline__ void transpose_item(const float* W, int ldw, bf16* WT, int K, int k0, int sn0, int dn0, int lane, const float* kgain = nullptr) {
    const int k = k0 + 4 * (lane & 15), nl = 4 * (lane >> 4);
    f32x4 r[4][4];
#pragma unroll
    for (int nb = 0; nb < 4; ++nb)
#pragma unroll
        for (int j = 0; j < 4; ++j) r[nb][j] = *(const GAS f32x4*)(W + (size_t)(k + j) * ldw + sn0 + nl + 16 * nb);
    f32x4 g = {1.f, 1.f, 1.f, 1.f}; if (kgain) g = *(const GAS f32x4*)(kgain + k);
#pragma unroll
    for (int nb = 0; nb < 4; ++nb) { const f32x4 a = r[nb][0] * g.x, b = r[nb][1] * g.y, c = r[nb][2] * g.z, d = r[nb][3] * g.w;
        bf16* o = WT + (size_t)(dn0 + nl + 16 * nb) * K + k;
        v2u w; w.x = pk2(a.x, b.x); w.y = pk2(c.x, d.x); *(GAS v2u*)o = w;
        w.x = pk2(a.y, b.y); w.y = pk2(c.y, d.y); *(GAS v2u*)(o + K) = w;
        w.x = pk2(a.z, b.z); w.y = pk2(c.z, d.z); *(GAS v2u*)(o + 2 * (size_t)K) = w;
        w.x = pk2(a.w, b.w); w.y = pk2(c.w, d.w); *(GAS v2u*)(o + 3 * (size_t)K) = w; }
}
__device__ __forceinline__ void rms_row4_bf16(const float* x0_, const float* gain, bf16* o0, int lane) {
    f32x4 v[4][4]; float s[4];
#pragma unroll
    for (int r = 0; r < 4; ++r)
#pragma unroll
        for (int j = 0; j < 4; ++j) v[r][j] = ((const GAS f32x4*)(x0_ + (size_t)r * DM))[lane + 64 * j];
#pragma unroll
    for (int r = 0; r < 4; ++r) { s[r] = 0.f;
#pragma unroll
        for (int j = 0; j < 4; ++j) s[r] += (v[r][j].x * v[r][j].x + v[r][j].y * v[r][j].y) + (v[r][j].z * v[r][j].z + v[r][j].w * v[r][j].w); }
#pragma unroll
    for (int o = 1; o < 64; o <<= 1) { s[0] += __shfl_xor(s[0], o); s[1] += __shfl_xor(s[1], o); s[2] += __shfl_xor(s[2], o); s[3] += __shfl_xor(s[3], o); }
#pragma unroll
    for (int j = 0; j < 4; ++j) { const f32x4 g = ((const GAS f32x4*)gain)[lane + 64 * j];
#pragma unroll
        for (int r = 0; r < 4; ++r) { const float rs = 1.0f / sqrtf(s[r] * (1.0f / DM) + EPS);
            v2u w; w.x = pk2(v[r][j].x * rs * g.x, v[r][j].y * rs * g.y); w.y = pk2(v[r][j].z * rs * g.z, v[r][j].w * rs * g.w); ((GAS v2u*)(o0 + (size_t)r * DM))[lane + 64 * j] = w; } }
}

__device__ __forceinline__ void s5_tables_item(Frame& F, int item);
__device__ __forceinline__ void p0_prologue(Frame& F) {
    const int gw = F.bid * NWAVES + F.wave, NGW = F.G * NWAVES;
    bf16* XN = (bf16*)(F.ws + WS_XN);
    for (int m = 4 * gw; m < MTOK; m += 4 * NGW) rms_row4_bf16(xrow(F, m), F.in[6], XN + (size_t)m * DM, F.lane);
#if REP_XN == 2
    for (int m = 4 * gw; m < MTOK; m += 4 * NGW) rms_row4_bf16(xrow(F, m), F.in[6], XN + (size_t)m * DM, F.lane);
#endif
    bf16* WinT = (bf16*)(F.ws + WS_WIN);
    constexpr int I_IN = (DM / 64) * (INC / 64);
    for (int r = gw; r < I_IN; r += NGW) { const int nblk = INC / 64, kb = r / nblk, nb = r % nblk, sn0 = nb * 64; const int seg = sn0 / 512, off = sn0 % 512;
        const int dseg = seg == 0 ? 0 : seg == 1 ? 1 : seg == 2 ? 4 : seg == 3 ? 2 : 3;
        transpose_item(F.in[7], INC, WinT, DM, kb * 64, sn0, dseg * 512 + off, F.lane); }
    for (int it = F.bid; it < 256; it += F.G) s5_tables_item(F, it);
}

template <int PART> __device__ __forceinline__ void deferred_transposes(Frame& F, int gw, int ngw) {
    bf16* WgluT = (bf16*)(F.ws + WS_WGLU); bf16* WoutT = (bf16*)(F.ws + WS_WOUT); bf16* WguT = (bf16*)(F.ws + WS_WGU); bf16* WdT = (bf16*)(F.ws + WS_WD);
    constexpr int I_GLU = (S5W / 64) * (S5W / 64), I_OUT = (DM / 64) * (DM / 64), I_G = (DM / 64) * (DFF / 64), I_D = (DFF / 64) * (DM / 64);
    constexpr int N0 = I_GLU + I_OUT + 2 * I_G, NITEMS = (PART == 0) ? N0 : I_D;
    for (int it = gw; it < NITEMS; it += ngw) {
        int r = (PART == 0) ? it : it + N0;
        if (r < I_GLU) { const int nblk = S5W / 64, kb = r / nblk, nb = r % nblk; transpose_item(F.in[16], S5W, WgluT, S5W, kb * 64, nb * 64, nb * 64, F.lane); continue; } r -= I_GLU;
        if (r < I_OUT) { const int nblk = DM / 64, kb = r / nblk, nb = r % nblk; transpose_item(F.in[18], DM, WoutT, DM, kb * 64, nb * 64, nb * 64, F.lane); continue; } r -= I_OUT;
        if (r < I_G) { const int nblk = DFF / 64, kb = r / nblk, nb = r % nblk, sn0 = nb * 64; transpose_item(F.in[20], DFF, WguT, DM, kb * 64, sn0, 256 * (sn0 / 128) + (sn0 % 128), F.lane, F.in[19]); continue; } r -= I_G;
        if (r < I_G) { const int nblk = DFF / 64, kb = r / nblk, nb = r % nblk, sn0 = nb * 64; transpose_item(F.in[21], DFF, WguT, DM, kb * 64, sn0, 256 * (sn0 / 128) + 128 + (sn0 % 128), F.lane, F.in[19]); continue; } r -= I_G;
        { const int nblk = DM / 64, kb = r / nblk, nb = r % nblk; transpose_item(F.in[22], DM, WdT, DFF, kb * 64, nb * 64, nb * 64, F.lane); }
    }
}

using pg8::Unit; using pg8::u32x4; using pg8::cvt_pk_bf16; using pg8::BM; using pg8::HALF;
struct EpiIn {
    static constexpr bool PERM = true, AFTER_DRAIN = false;
    bf16* PB; float* FZ; bf16* U5;
    __device__ __forceinline__ void operator()(const pg8::f32x4 (&acc)[2][2][4][2], const Unit& u, int wr, int wc, int fr, int fq) const {
        const int row0 = u.pm * BM + wr * 64 + fr;
        if (u.pn < 2) { const int col0 = u.pn * BM + wc * 32 + 8 * fq;
#pragma unroll
            for (int ai = 0; ai < 2; ++ai)
#pragma unroll
                for (int m = 0; m < 4; ++m) { const size_t r = (size_t)(row0 + ai * HALF + m * 16);
#pragma unroll
                    for (int bj = 0; bj < 2; ++bj) { const int col = col0 + bj * HALF; const pg8::f32x4 v0 = acc[ai][bj][m][0], v1 = acc[ai][bj][m][1]; u32x4 w; w.x = cvt_pk_bf16(v0[0], v0[1]); w.y = cvt_pk_bf16(v0[2], v0[3]); w.z = cvt_pk_bf16(v1[0], v1[1]); w.w = cvt_pk_bf16(v1[2], v1[3]);
                        *(u32x4*)(U5 + ((size_t)(col >> 4) * MTOK + r) * 16 + (col & 15)) = w; } }
        } else if (u.pn < 8) { const int col0 = u.pn * BM + wc * 32 + 8 * fq;
#pragma unroll
            for (int ai = 0; ai < 2; ++ai)
#pragma unroll
                for (int m = 0; m < 4; ++m) { bf16* rowp = PB + (size_t)(row0 + ai * HALF + m * 16) * PBW + col0;
#pragma unroll
                    for (int bj = 0; bj < 2; ++bj) { const pg8::f32x4 v0 = acc[ai][bj][m][0], v1 = acc[ai][bj][m][1]; u32x4 w; w.x = cvt_pk_bf16(v0[0], v0[1]); w.y = cvt_pk_bf16(v0[2], v0[3]); w.z = cvt_pk_bf16(v1[0], v1[1]); w.w = cvt_pk_bf16(v1[2], v1[3]);
                        *(u32x4*)(rowp + bj * HALF) = w; } }
        } else { const int col0 = (u.pn - 8) * BM + wc * 32 + 8 * fq;
#pragma unroll
            for (int ai = 0; ai < 2; ++ai)
#pragma unroll
                for (int m = 0; m < 4; ++m) { float* rowp = FZ + (size_t)(row0 + ai * HALF + m * 16) * 512 + col0;
#pragma unroll
                    for (int bj = 0; bj < 2; ++bj)
#pragma unroll
                        for (int n = 0; n < 2; ++n) *(pg8::f32x4*)(rowp + bj * HALF + 4 * n) = acc[ai][bj][m][n]; }
        }
    }
};
struct EpiGlu {
    static constexpr bool PERM = true, AFTER_DRAIN = false;
    const bf16* GY; bf16* MIX;
    __device__ __forceinline__ void operator()(const pg8::f32x4 (&acc)[2][2][4][2], const Unit& u, int wr, int wc, int fr, int fq) const {
        const int row0 = u.pm * BM + wr * 64 + fr, col0 = u.pn * BM + wc * 32 + 8 * fq;
#pragma unroll
        for (int ai = 0; ai < 2; ++ai)
#pragma unroll
            for (int m = 0; m < 4; ++m) { const size_t r = (size_t)(row0 + ai * HALF + m * 16);
#pragma unroll
                for (int bj = 0; bj < 2; ++bj) { const int col = col0 + bj * HALF; const u32x4 g = *(const u32x4*)(GY + ((size_t)(col >> 4) * MTOK + r) * 16 + (col & 15)); const pg8::f32x4 v0 = acc[ai][bj][m][0], v1 = acc[ai][bj][m][1];
                    u32x4 w; w.x = cvt_pk_bf16(bflo(g.x) * sigmoidf_(v0[0]), bfhi(g.x) * sigmoidf_(v0[1])); w.y = cvt_pk_bf16(bflo(g.y) * sigmoidf_(v0[2]), bfhi(g.y) * sigmoidf_(v0[3]));
                    w.z = cvt_pk_bf16(bflo(g.z) * sigmoidf_(v1[0]), bfhi(g.z) * sigmoidf_(v1[1])); w.w = cvt_pk_bf16(bflo(g.w) * sigmoidf_(v1[2]), bfhi(g.w) * sigmoidf_(v1[3]));
                    *(u32x4*)(MIX + r * DM + col0 + bj * HALF) = w; } }
    }
};
__device__ __forceinline__ float rstd_of(float ss) { return 1.0f / sqrtf(ss * (1.0f / DM) + EPS); }
__device__ __forceinline__ float atomic_read_f32(float* p) { return __hip_atomic_fetch_add(p, 0.0f, __ATOMIC_RELAXED, __HIP_MEMORY_SCOPE_AGENT); }
__device__ __forceinline__ void wait_count(unsigned* cnt, unsigned want) {
    for (unsigned sp = 0; sp < (1u << 22); ++sp) { if (__hip_atomic_load(cnt, __ATOMIC_RELAXED, __HIP_MEMORY_SCOPE_AGENT) >= want) break; __builtin_amdgcn_s_sleep(2); }
}
struct EpiOut {
    static constexpr bool PERM = true, AFTER_DRAIN = false;
    const float* xp; bf16* XN; float* SS1;
    __device__ __forceinline__ void operator()(const pg8::f32x4 (&acc)[2][2][4][2], const Unit& u, int wr, int wc, int fr, int fq) const {
        const int row0 = u.pm * BM + wr * 64 + fr, col0 = u.pn * BM + wc * 32 + 8 * fq;
#pragma unroll
        for (int ai = 0; ai < 2; ++ai)
#pragma unroll
            for (int m = 0; m < 4; ++m) { const int row = row0 + ai * HALF + m * 16; const size_t off = (size_t)row * DM + col0; float ss = 0.f;
#pragma unroll
                for (int bj = 0; bj < 2; ++bj) { const pg8::f32x4 x0 = *(const pg8::f32x4*)(xp + off + bj * HALF) + acc[ai][bj][m][0], x1 = *(const pg8::f32x4*)(xp + off + bj * HALF + 4) + acc[ai][bj][m][1];
                    ss += (x0[0] * x0[0] + x0[1] * x0[1]) + (x0[2] * x0[2] + x0[3] * x0[3]) + (x1[0] * x1[0] + x1[1] * x1[1]) + (x1[2] * x1[2] + x1[3] * x1[3]);
                    u32x4 w; w.x = cvt_pk_bf16(x0[0], x0[1]); w.y = cvt_pk_bf16(x0[2], x0[3]); w.z = cvt_pk_bf16(x1[0], x1[1]); w.w = cvt_pk_bf16(x1[2], x1[3]);
                    *(u32x4*)(XN + off + bj * HALF) = w; }
                ss += __shfl_xor(ss, 16); ss += __shfl_xor(ss, 32);
                if (fq == 0) __hip_atomic_fetch_add(SS1 + row, ss, __ATOMIC_RELAXED, __HIP_MEMORY_SCOPE_AGENT); }
    }
};
struct EpiAct {
    static constexpr bool PERM = true, AFTER_DRAIN = false;
    bf16* ACT; const float* SS1;
    __device__ __forceinline__ void operator()(const pg8::f32x4 (&acc)[2][2][4][2], const Unit& u, int wr, int wc, int fr, int fq) const {
        const int row0 = u.pm * BM + wr * 64 + fr, col0 = u.pn * HALF + wc * 32 + 8 * fq;
#pragma unroll
        for (int ai = 0; ai < 2; ++ai)
#pragma unroll
            for (int m = 0; m < 4; ++m) { const int row = row0 + ai * HALF + m * 16; const float rs = rstd_of(SS1[row]);
                const pg8::f32x4 g0 = acc[ai][0][m][0] * rs, g1 = acc[ai][0][m][1] * rs, u0 = acc[ai][1][m][0] * rs, u1 = acc[ai][1][m][1] * rs;
                u32x4 w; w.x = cvt_pk_bf16(siluf_(g0[0]) * u0[0], siluf_(g0[1]) * u0[1]); w.y = cvt_pk_bf16(siluf_(g0[2]) * u0[2], siluf_(g0[3]) * u0[3]);
                w.z = cvt_pk_bf16(siluf_(g1[0]) * u1[0], siluf_(g1[1]) * u1[1]); w.w = cvt_pk_bf16(siluf_(g1[2]) * u1[2], siluf_(g1[3]) * u1[3]);
                *(u32x4*)(ACT + (size_t)row * DFF + col0) = w; }
    }
};
struct EpiDown {
    static constexpr bool PERM = true, AFTER_DRAIN = false;
    const bf16* X1; const float* gain; float* SS2; unsigned* cnt; float* YO;
    __device__ __forceinline__ void operator()(pg8::f32x4 (&acc)[2][2][4][2], const Unit& u, int wr, int wc, int fr, int fq) const {
        const int row0 = u.pm * BM + wr * 64 + fr, col0 = u.pn * BM + wc * 32 + 8 * fq;
#pragma unroll
        for (int ai = 0; ai < 2; ++ai)
#pragma unroll
            for (int m = 0; m < 4; ++m) { const int row = row0 + ai * HALF + m * 16; const size_t off = (size_t)row * DM + col0; float ss = 0.f;
#pragma unroll
                for (int bj = 0; bj < 2; ++bj) { const u32x4 xb = *(const u32x4*)(X1 + off + bj * HALF);
                    const pg8::f32x4 x0 = (pg8::f32x4){bflo(xb.x), bfhi(xb.x), bflo(xb.y), bfhi(xb.y)} + acc[ai][bj][m][0], x1 = (pg8::f32x4){bflo(xb.z), bfhi(xb.z), bflo(xb.w), bfhi(xb.w)} + acc[ai][bj][m][1];
                    acc[ai][bj][m][0] = x0; acc[ai][bj][m][1] = x1;
                    ss += (x0[0] * x0[0] + x0[1] * x0[1]) + (x0[2] * x0[2] + x0[3] * x0[3]) + (x1[0] * x1[0] + x1[1] * x1[1]) + (x1[2] * x1[2] + x1[3] * x1[3]); }
                ss += __shfl_xor(ss, 16); ss += __shfl_xor(ss, 32);
                if (fq == 0) __hip_atomic_fetch_add(SS2 + row, ss, __ATOMIC_RELAXED, __HIP_MEMORY_SCOPE_AGENT); }
        asm volatile("s_waitcnt vmcnt(0)" ::: "memory");
        unsigned* c = cnt + 64 * u.pm;
        if (threadIdx.x % 64 == 0) __hip_atomic_fetch_add(c, 1u, __ATOMIC_RELAXED, __HIP_MEMORY_SCOPE_AGENT);
        wait_count(c, 32u);
        pg8::f32x4 gn[2][2];
#pragma unroll
        for (int bj = 0; bj < 2; ++bj)
#pragma unroll
            for (int n = 0; n < 2; ++n) gn[bj][n] = *(const pg8::f32x4*)(gain + col0 + bj * HALF + 4 * n);
        float rs[2][4];
#pragma unroll
        for (int ai = 0; ai < 2; ++ai)
#pragma unroll
            for (int m = 0; m < 4; ++m) { float s = 0.f; if (fq == 0) s = atomic_read_f32(SS2 + row0 + ai * HALF + m * 16); rs[ai][m] = rstd_of(__shfl(s, fr)); }
#pragma unroll
        for (int ai = 0; ai < 2; ++ai)
#pragma unroll
            for (int m = 0; m < 4; ++m) { const size_t off = (size_t)(row0 + ai * HALF + m * 16) * DM + col0;
#pragma unroll
                for (int bj = 0; bj < 2; ++bj) { *(pg8::f32x4*)(YO + off + bj * HALF) = acc[ai][bj][m][0] * rs[ai][m] * gn[bj][0]; *(pg8::f32x4*)(YO + off + bj * HALF + 4) = acc[ai][bj][m][1] * rs[ai][m] * gn[bj][1]; } }
    }
};

typedef float f32x16 __attribute__((ext_vector_type(16)));
typedef short s16x8 __attribute__((ext_vector_type(8)));
constexpr size_t WS_U5 = WS_OH, WS_T5 = 231 * MiB;
constexpr size_t T5_STRIDE = 73728, T5_VG = 32768, T5_KC = 65536;
constexpr int S5_LD = 136;
__device__ __forceinline__ void s5_tables_item(Frame& F, int item) {
    const int tid = F.tid, g = item >> 3, part = item & 7;
    LAS float* Pre = (LAS float*)F.lds; LAS float* Pim = Pre + 9 * 64; LAS float* Ff = Pim + 9 * 64;
    LAS float* Cre = Ff + 128, * Cim = Cre + 1024, * Bre = Cim + 1024, * Bim = Bre + 1024;
    if (tid < 64) { const int n = tid;
        const float a_re = F.in[8][g * S5N + n], a_im = F.in[9][g * S5N + n], dt = expf(F.in[10][g]);
        const float mag = expf(a_re * dt), ab_re = mag * cosf(a_im * dt), ab_im = mag * sinf(a_im * dt);
        const float den = a_re * a_re + a_im * a_im, nr = ab_re - 1.0f, ni = ab_im;
        Ff[n] = (nr * a_re + ni * a_im) / den; Ff[64 + n] = (ni * a_re - nr * a_im) / den;
        float pr = 1.f, pi = 0.f;
#pragma unroll
        for (int j = 0; j < 9; ++j) { Pre[j * 64 + n] = pr; Pim[j * 64 + n] = pi; const float t = pr * ab_re - pi * ab_im; pi = pr * ab_im + pi * ab_re; pr = t; }
    }
    __syncthreads();
#pragma unroll
    for (int i = 0; i < 2; ++i) { const int idx = tid + 512 * i;
        { const int c = idx >> 6, n = idx & 63; Cre[c * 64 + n] = F.in[13][(size_t)(g * 16 + c) * S5N + n]; Cim[c * 64 + n] = F.in[14][(size_t)(g * 16 + c) * S5N + n]; }
        { const int n = idx >> 4, c = idx & 15; const float br = F.in[11][(size_t)(g * S5N + n) * 16 + c], bi = F.in[12][(size_t)(g * S5N + n) * 16 + c], fr = Ff[n], fi = Ff[64 + n];
          Bre[n * 16 + c] = fr * br - fi * bi; Bim[n * 16 + c] = fr * bi + fi * br; } }
    __syncthreads();
    bf16* WG = (bf16*)(F.ws + WS_T5 + (size_t)g * T5_STRIDE); bf16* VG = (bf16*)(F.ws + WS_T5 + (size_t)g * T5_STRIDE + T5_VG); bf16* KC = (bf16*)(F.ws + WS_T5 + (size_t)g * T5_STRIDE + T5_KC);
    if (tid < 256) { const int j = part, c = tid >> 4, cp = tid & 15; float acc = 0.f;
#pragma unroll 4
        for (int n = 0; n < 64; ++n) { const float cr = Cre[c * 64 + n], ci = Cim[c * 64 + n], pr = Pre[j * 64 + n], pi = Pim[j * 64 + n];
            const float xr = cr * pr - ci * pi, xi = cr * pi + ci * pr; acc += xr * Bre[n * 16 + cp] - xi * Bim[n * 16 + cp]; }
        KC[j * 256 + tid] = (bf16)f2bf(acc);
    } else if (part == 0) KC[2048 + tid - 256] = 0;
#pragma unroll
    for (int i = 0; i < 4; ++i) { const int idx = tid + 512 * i, np = 16 * part + (idx >> 7), k = idx & 127, s = k >> 4, cp = k & 15, n = np & 63;
        const float pr = Pre[(7 - s) * 64 + n], pi = Pim[(7 - s) * 64 + n], br = Bre[n * 16 + cp], bi = Bim[n * 16 + cp];
        WG[np * 128 + k] = (bf16)f2bf(np < 64 ? pr * br - pi * bi : pr * bi + pi * br); }
#pragma unroll
    for (int i = 0; i < 4; ++i) { const int idx = tid + 512 * i, col = 16 * part + (idx >> 7), np = idx & 127, t = col >> 4, c = col & 15, n = np & 63;
        const float pr = Pre[(t + 1) * 64 + n], pi = Pim[(t + 1) * 64 + n], cr = Cre[c * 64 + n], ci = Cim[c * 64 + n];
        VG[col * 128 + np] = (bf16)f2bf(np < 64 ? cr * pr - ci * pi : -(cr * pi + ci * pr)); }
    __syncthreads();
}
constexpr int L5_WG = 0, L5_VG = 34816, L5_KC = 69632, L5_U = 74240, L5_HS = 91648, L5_HL = 109056, L5_L8 = 141824;
__device__ __forceinline__ void s5_item(Frame& F, int item) {
    const int tid = F.tid, lane = F.lane, wave = F.wave;
    const int g = item & 31, b8 = item >> 5;
    LAS bf16* WgT = (LAS bf16*)(F.lds + L5_WG); LAS bf16* VgT = (LAS bf16*)(F.lds + L5_VG); LAS bf16* Kc = (LAS bf16*)(F.lds + L5_KC);
    LAS bf16* Us = (LAS bf16*)(F.lds + L5_U); LAS bf16* HS = (LAS bf16*)(F.lds + L5_HS); LAS float* HL = (LAS float*)(F.lds + L5_HL); LAS float* L8 = (LAS float*)(F.lds + L5_L8);
    LAS bf16* YS = (LAS bf16*)(F.lds + L5_HL);
    const bf16* U5 = (const bf16*)(F.ws + WS_U5) + (size_t)g * MTOK * 16; bf16* GY = (bf16*)(F.ws + WS_GY) + (size_t)g * MTOK * 16;
    { const bf16* WG = (const bf16*)(F.ws + WS_T5 + (size_t)g * T5_STRIDE); const bf16* VG = WG + T5_VG / 2; const bf16* KC = WG + T5_KC / 2;
#pragma unroll
      for (int i = 0; i < 4; ++i) { const int p = tid + 512 * i, r = p >> 4, kg = (p & 15) * 8; *(LAS v4u*)(WgT + r * S5_LD + kg) = *(const v4u*)(WG + r * 128 + kg); *(LAS v4u*)(VgT + r * S5_LD + kg) = *(const v4u*)(VG + r * 128 + kg); }
      if (tid < 288) *(LAS v4u*)(Kc + tid * 8) = *(const v4u*)(KC + tid * 8); }
    float qr[9], qi[9];
    { const float a_re = F.in[8][g * S5N + lane], a_im = F.in[9][g * S5N + lane], dt = expf(F.in[10][g]);
      const float mag = expf(a_re * dt); float p8r = mag * cosf(a_im * dt), p8i = mag * sinf(a_im * dt);
#pragma unroll
      for (int i = 0; i < 3; ++i) { const float t = p8r * p8r - p8i * p8i; p8i = 2.0f * p8r * p8i; p8r = t; }
      qr[0] = 1.f; qi[0] = 0.f;
#pragma unroll
      for (int i = 1; i < 9; ++i) { qr[i] = qr[i - 1] * p8r - qi[i - 1] * p8i; qi[i] = qr[i - 1] * p8i + qi[i - 1] * p8r; } }
    const float dl = F.in[15][g * 16 + (lane & 15)];
    const int rb = wave >> 2, cb = wave & 3, r32 = lane & 31, hh = lane >> 5;
    float h_re = 0.f, h_im = 0.f;
    float sre[2], sim[2];
#pragma unroll
    for (int i = 0; i < 2; ++i) { const size_t idx = (size_t)((16 * b8 + 2 * wave + i) * S5G + g) * S5N + lane; sre[i] = F.in[2][idx]; sim[i] = F.in[3][idx]; }
    v4u un0, un1;
    { const v4u* src = (const v4u*)(U5 + (size_t)(b8 * PB_T) * 16); un0 = src[tid]; un1 = src[tid + 512]; }
    for (int seg = 0; seg < 5; ++seg) {
        const bool samp = (seg == 4);
        const int tok0 = samp ? MP + 128 * b8 : b8 * PB_T + seg * 512;
        { const int p0 = tid, p1 = tid + 512;
          *(LAS v4u*)(Us + (p0 >> 4) * S5_LD + ((p0 >> 1) & 7) * 16 + (p0 & 1) * 8) = un0; *(LAS v4u*)(Us + (p1 >> 4) * S5_LD + ((p1 >> 1) & 7) * 16 + (p1 & 1) * 8) = un1;
          if (seg < 3) { const v4u* src = (const v4u*)(U5 + (size_t)(b8 * PB_T + (seg + 1) * 512) * 16); un0 = src[tid]; un1 = src[tid + 512]; }
          else if (seg == 3) { const v4u* src = (const v4u*)(U5 + (size_t)(MP + 128 * b8) * 16); if (tid < 256) un0 = src[tid]; } }
        __syncthreads();
        { f32x16 acc = {};
#pragma unroll
          for (int s = 0; s < 8; ++s) { const s16x8 a = *(const LAS s16x8*)(Us + (32 * rb + r32) * S5_LD + s * 16 + 8 * hh); const s16x8 b = *(const LAS s16x8*)(WgT + (32 * cb + r32) * S5_LD + s * 16 + 8 * hh);
              acc = __builtin_amdgcn_mfma_f32_32x32x16_bf16(a, b, acc, 0, 0, 0); }
#pragma unroll
          for (int r = 0; r < 16; ++r) HL[(32 * rb + (r & 3) + 8 * (r >> 2) + 4 * hh) * 128 + 32 * cb + r32] = acc[r]; }
        __syncthreads();
        if (!samp) {
            float xr[8], xi[8], lr[9], li[9];
#pragma unroll
            for (int i = 0; i < 8; ++i) { xr[i] = HL[(8 * wave + i) * 128 + lane]; xi[i] = HL[(8 * wave + i) * 128 + 64 + lane]; }
            lr[0] = 0.f; li[0] = 0.f;
#pragma unroll
            for (int i = 0; i < 8; ++i) { lr[i + 1] = qr[1] * lr[i] - qi[1] * li[i] + xr[i]; li[i + 1] = qr[1] * li[i] + qi[1] * lr[i] + xi[i]; }
            L8[wave * 128 + lane] = lr[8]; L8[wave * 128 + 64 + lane] = li[8];
            __syncthreads();
            float cr = h_re, ci = h_im, mr = h_re, mi = h_im;
#pragma unroll
            for (int w = 0; w < 8; ++w) { const float tr = L8[w * 128 + lane], ti = L8[w * 128 + 64 + lane];
                const float nr = qr[8] * cr - qi[8] * ci + tr, ni = qr[8] * ci + qi[8] * cr + ti; cr = nr; ci = ni; if (w + 1 == wave) { mr = cr; mi = ci; } }
            h_re = cr; h_im = ci;
#pragma unroll
            for (int i = 0; i < 8; ++i) { const float sr = lr[i] + qr[i] * mr - qi[i] * mi, si = li[i] + qr[i] * mi + qi[i] * mr;
                HS[(8 * wave + i) * S5_LD + lane] = (bf16)f2bf(sr); HS[(8 * wave + i) * S5_LD + 64 + lane] = (bf16)f2bf(si); }
            if (seg == 3 && wave == 0) { F.out[O_PRE + (size_t)(b8 * S5G + g) * S5N + lane] = h_re; F.out[O_PIM + (size_t)(b8 * S5G + g) * S5N + lane] = h_im; }
        } else {
#pragma unroll
            for (int i = 0; i < 2; ++i) { const int r = 2 * wave + i; const size_t idx = (size_t)((16 * b8 + r) * S5G + g) * S5N + lane;
                HS[r * S5_LD + lane] = (bf16)f2bf(sre[i]); HS[r * S5_LD + 64 + lane] = (bf16)f2bf(sim[i]);
                F.out[O_SRE + idx] = qr[1] * sre[i] - qi[1] * sim[i] + HL[r * 128 + lane]; F.out[O_SIM + idx] = qr[1] * sim[i] + qi[1] * sre[i] + HL[r * 128 + 64 + lane]; }
        }
        __syncthreads();
        if (!(samp && rb == 1)) { f32x16 acc = {};
            const int tl = 2 * cb + ((lane >> 4) & 1), c = lane & 15;
#pragma unroll
            for (int s = 0; s < 8; ++s) if (s <= 2 * cb + 1) { const int j = tl - s, jj = j < 0 ? 8 : j;
                const s16x8 a = *(const LAS s16x8*)(Us + (32 * rb + r32) * S5_LD + s * 16 + 8 * hh); const s16x8 b = *(const LAS s16x8*)(Kc + (jj * 16 + c) * 16 + 8 * hh);
                acc = __builtin_amdgcn_mfma_f32_32x32x16_bf16(a, b, acc, 0, 0, 0); }
#pragma unroll
            for (int kb = 0; kb < 8; ++kb) { const s16x8 a = *(const LAS s16x8*)(HS + (32 * rb + r32) * S5_LD + kb * 16 + 8 * hh); const s16x8 b = *(const LAS s16x8*)(VgT + (32 * cb + r32) * S5_LD + kb * 16 + 8 * hh);
                acc = __builtin_amdgcn_mfma_f32_32x32x16_bf16(a, b, acc, 0, 0, 0); }
#pragma unroll
            for (int r = 0; r < 16; ++r) { const int row = 32 * rb + (r & 3) + 8 * (r >> 2) + 4 * hh;
                const float u = bf2f(Us[row * S5_LD + tl * 16 + c]); YS[row * 128 + 32 * cb + r32] = (bf16)f2bf(gelu_tanh(acc[r] + dl * u)); }
        }
        __syncthreads();
        { v4u* dst = (v4u*)(GY + (size_t)tok0 * 16);
          if (!samp) { dst[tid] = *(const LAS v4u*)(YS + tid * 8); dst[tid + 512] = *(const LAS v4u*)(YS + (tid + 512) * 8); }
          else if (tid < 256) dst[tid] = *(const LAS v4u*)(YS + tid * 8); }
        __syncthreads();
    }
}
typedef float f32x4v __attribute__((ext_vector_type(4)));
constexpr int HG_LDQ = 136, HG_LDT = 72;
constexpr size_t WS_DSC = WS_XN;
constexpr size_t WS_DEC = WS_CTL + 1 * MiB;
struct HgRaw { float fz[16]; unsigned short q[16]; v4u v0, v1; };
template <bool NEEDQ> __device__ __forceinline__ void hg_load_raw(HgRaw& R, const bf16* PB, const float* FZ, int item, int tid) {
    const int bh = item >> 5, chunk = item & 31, b = bh >> 2, h = bh & 3, tok0 = b * PB_T + chunk * 64, ch = tid & 127, tq = tid >> 7, col = h * HD + ch;
#pragma unroll
    for (int i = 0; i < 16; ++i) { const size_t tok = (size_t)(tok0 + 16 * tq + i); R.fz[i] = FZ[tok * 512 + col]; if (NEEDQ) R.q[i] = PB[tok * PBW + 512 + col]; }
    { const int p = tid, vg = p >> 6, tk = p & 63; R.v0 = *(const v4u*)(PB + (size_t)(tok0 + tk) * PBW + 1024 + h * HD + vg * 8); }
    { const int p = tid + 512, vg = p >> 6, tk = p & 63; R.v1 = *(const v4u*)(PB + (size_t)(tok0 + tk) * PBW + 1024 + h * HD + vg * 8); }
}
#define HG_GATES_R(R) \
    float gl[16], kk[16]; float run = 0.f; \
    _Pragma("unroll") for (int i = 0; i < 16; ++i) { const float sg = __builtin_amdgcn_rcpf(1.0f + __builtin_amdgcn_exp2f(-1.4426950408889634f * R.fz[i])), f = lb + (1.0f - lb) * sg; kk[i] = 1.0f - f; run += __log2f(f); gl[i] = run; } \
    TOT[tq * 128 + ch] = run;
#define HG_VT_STORE(R) \
    { const int vg = tid >> 6, tk = tid & 63; LAS bf16* d = Vt + (vg * 8) * HG_LDT + tk; const v4u w = R.v0; d[0] = (bf16)(w.x & 0xffffu); d[HG_LDT] = (bf16)(w.x >> 16); d[2 * HG_LDT] = (bf16)(w.y & 0xffffu); d[3 * HG_LDT] = (bf16)(w.y >> 16); \
        d[4 * HG_LDT] = (bf16)(w.z & 0xffffu); d[5 * HG_LDT] = (bf16)(w.z >> 16); d[6 * HG_LDT] = (bf16)(w.w & 0xffffu); d[7 * HG_LDT] = (bf16)(w.w >> 16); } \
    { const int vg = (tid + 512) >> 6, tk = tid & 63; LAS bf16* d = Vt + (vg * 8) * HG_LDT + tk; const v4u w = R.v1; d[0] = (bf16)(w.x & 0xffffu); d[HG_LDT] = (bf16)(w.x >> 16); d[2 * HG_LDT] = (bf16)(w.y & 0xffffu); d[3 * HG_LDT] = (bf16)(w.y >> 16); \
        d[4 * HG_LDT] = (bf16)(w.z & 0xffffu); d[5 * HG_LDT] = (bf16)(w.z >> 16); d[6 * HG_LDT] = (bf16)(w.w & 0xffffu); d[7 * HG_LDT] = (bf16)(w.w >> 16); }

constexpr int LA_QS = 0, LA_KS = 17408, LA_KT = 34816, LA_VT = 53248, LA_AT = 71680, LA_TOT = 80896;
constexpr size_t OQ_QH = 0, OQ_OI = 4194304;
__device__ __forceinline__ void hgA_loop(Frame& F) {
    const int tid = F.tid, lane = F.lane, wave = F.wave;
    LAS bf16* Qs = (LAS bf16*)(F.lds + LA_QS); LAS bf16* Ks = (LAS bf16*)(F.lds + LA_KS); LAS bf16* Kt = (LAS bf16*)(F.lds + LA_KT); LAS bf16* Vt = (LAS bf16*)(F.lds + LA_VT);
    LAS bf16* At = (LAS bf16*)(F.lds + LA_AT); LAS float* TOT = (LAS float*)(F.lds + LA_TOT);
    const bf16* PB = (const bf16*)(F.ws + WS_PB); const float* FZ = (const float*)(F.ws + WS_FZ);
    const int ch = tid & 127, tq = tid >> 7, r32 = lane & 31, hh = lane >> 5;
    int item = F.bid; if (item >= 1024) return;
    HgRaw R; hg_load_raw<true>(R, PB, FZ, item, tid);
    for (; item < 1024; item += F.G) {
        const int bh = item >> 5, h = bh & 3, col = h * HD + ch;
        bf16* DSC = (bf16*)(F.ws + WS_DSC) + (size_t)item * HD * HD; float* DEC = (float*)(F.ws + WS_DEC) + (size_t)item * HD;
        bf16* QH = (bf16*)(F.out + O_Y + OQ_QH) + (size_t)item * 64 * HD; bf16* OI = (bf16*)(F.out + O_Y + OQ_OI) + (size_t)item * 8192;
        const float lb = 1.0f / (1.0f + __expf(F.in[5][512 + col] - F.in[5][col]));
        HG_GATES_R(R)
        float qq[16];
#pragma unroll
        for (int i = 0; i < 16; ++i) qq[i] = bf2f(R.q[i]);
        HG_VT_STORE(R)
        if (item + F.G < 1024) hg_load_raw<true>(R, PB, FZ, item + F.G, tid);
        __syncthreads();
        { const float t0 = TOT[ch], t1 = TOT[128 + ch], t2 = TOT[256 + ch], t3 = TOT[384 + ch];
          const float gref = t0 + t1, glast = gref + (t2 + t3), off = (tq == 0 ? 0.f : tq == 1 ? t0 : tq == 2 ? gref : gref + t2);
          const float cS = __builtin_amdgcn_exp2f(gref), cK = __builtin_amdgcn_exp2f(glast - gref);
          unsigned kp[8];
#pragma unroll
          for (int i = 0; i < 16; ++i) { const float e1 = __builtin_amdgcn_exp2f(off + gl[i] - gref), e2 = __builtin_amdgcn_rcpf(e1), qs = qq[i] * e1, ks = kk[i] * e2;
              Qs[(16 * tq + i) * HG_LDQ + ch] = (bf16)f2bf(qs); Ks[(16 * tq + i) * HG_LDQ + ch] = (bf16)f2bf(ks);
              QH[(size_t)(16 * tq + i) * HD + ch] = (bf16)f2bf(qs * cS);
              const unsigned kb = f2bf(ks * cK); if (i & 1) kp[i >> 1] |= kb << 16; else kp[i >> 1] = kb; }
          LAS v4u* kd = (LAS v4u*)(Kt + ch * HG_LDT + 16 * tq); v4u a, c2; a.x = kp[0]; a.y = kp[1]; a.z = kp[2]; a.w = kp[3]; c2.x = kp[4]; c2.y = kp[5]; c2.z = kp[6]; c2.w = kp[7]; kd[0] = a; kd[1] = c2;
          if (tq == 0) DEC[ch] = cS * cK; }
        __syncthreads();
        if (wave < 4) { const int tb = wave >> 1, sb = wave & 1; f32x16 acc = {};
            if (sb <= tb) {
#pragma unroll
                for (int ks = 0; ks < 8; ++ks) { const s16x8 a = *(const LAS s16x8*)(Qs + (32 * tb + r32) * HG_LDQ + 16 * ks + 8 * hh); const s16x8 bb = *(const LAS s16x8*)(Ks + (32 * sb + r32) * HG_LDQ + 16 * ks + 8 * hh);
                    acc = __builtin_amdgcn_mfma_f32_32x32x16_bf16(a, bb, acc, 0, 0, 0); } }
            const int s = 32 * sb + r32;
#pragma unroll
            for (int r = 0; r < 16; ++r) { const int t = 32 * tb + (r & 3) + 8 * (r >> 2) + 4 * hh; At[t * HG_LDT + s] = (s <= t) ? (bf16)f2bf(acc[r]) : (bf16)0; } }
        { const int kb = wave >> 1;
#pragma unroll
          for (int vbi = 0; vbi < 2; ++vbi) { const int vb = 2 * (wave & 1) + vbi; f32x16 acc = {};
#pragma unroll
              for (int ks = 0; ks < 4; ++ks) { const s16x8 a = *(const LAS s16x8*)(Kt + (32 * kb + r32) * HG_LDT + 16 * ks + 8 * hh); const s16x8 bb = *(const LAS s16x8*)(Vt + (32 * vb + r32) * HG_LDT + 16 * ks + 8 * hh);
                  acc = __builtin_amdgcn_mfma_f32_32x32x16_bf16(a, bb, acc, 0, 0, 0); }
              bf16* dst = DSC + (size_t)(32 * vb + r32) * HD + 32 * kb + 4 * hh;
#pragma unroll
              for (int q = 0; q < 4; ++q) { v2u w; w.x = pk2(acc[4 * q], acc[4 * q + 1]); w.y = pk2(acc[4 * q + 2], acc[4 * q + 3]); *(v2u*)(dst + 8 * q) = w; } } }
        __syncthreads();
        { const int tb = wave >> 2, vb = wave & 3, t = 32 * tb + r32; f32x16 acc = {};
#pragma unroll
          for (int ks = 0; ks < 4; ++ks) if (ks < 2 * tb + 2) { const s16x8 a = *(const LAS s16x8*)(Vt + (32 * vb + r32) * HG_LDT + 16 * ks + 8 * hh); const s16x8 bb = *(const LAS s16x8*)(At + t * HG_LDT + 16 * ks + 8 * hh);
              acc = __builtin_amdgcn_mfma_f32_32x32x16_bf16(a, bb, acc, 0, 0, 0); }
          v4u w0, w1; w0.x = pk2(acc[0], acc[1]); w0.y = pk2(acc[2], acc[3]); w0.z = pk2(acc[4], acc[5]); w0.w = pk2(acc[6], acc[7]); w1.x = pk2(acc[8], acc[9]); w1.y = pk2(acc[10], acc[11]); w1.z = pk2(acc[12], acc[13]); w1.w = pk2(acc[14], acc[15]);
          v4u* d = (v4u*)(OI + (size_t)(wave * 64 + lane) * 16); d[0] = w0; d[1] = w1; }
        __syncthreads();
    }
}
__device__ __forceinline__ void hg_scan(Frame& F, bf16* DSO, int sb, int nsb) {
    bf16* DSC = (bf16*)(F.ws + WS_DSC); const float* DEC = (const float*)(F.ws + WS_DEC);
    LAS float* DL = (LAS float*)F.lds;
    for (int T0 = sb * 512; T0 < 32 * 4096; T0 += nsb * 512) {
        const int T = T0 + F.tid, bh = T0 >> 12, e = T & 4095, v = e >> 5, k4 = (e & 31) * 4;
        v2u x[32];
#pragma unroll
        for (int c = 0; c < 32; ++c) x[c] = *(const v2u*)(DSC + ((size_t)(bh * 32 + c) * HD + v) * HD + k4);
#pragma unroll
        for (int i = 0; i < 2; ++i) { const int p = F.tid + 512 * i; *(LAS f32x4*)(DL + p * 4) = *(const f32x4*)(DEC + (size_t)bh * 32 * HD + p * 4); }
        __syncthreads();
        f32x4 S = {0.f, 0.f, 0.f, 0.f};
#pragma unroll
        for (int c = 0; c < 32; ++c) { const f32x4 d = *(const LAS f32x4*)(DL + c * HD + k4);
            v2u o; o.x = pk2(S.x, S.y); o.y = pk2(S.z, S.w); *(v2u*)(DSO + ((size_t)(bh * 32 + c) * HD + v) * HD + k4) = o;
            S.x = d.x * S.x + bflo(x[c].x); S.y = d.y * S.y + bfhi(x[c].x); S.z = d.z * S.z + bflo(x[c].y); S.w = d.w * S.w + bfhi(x[c].y); }
        float* o = F.out + O_PHG + (size_t)bh * HD * HD + (size_t)k4 * HD + v;
        o[0] = S.x; o[HD] = S.y; o[2 * HD] = S.z; o[3 * HD] = S.w;
        __syncthreads();
    }
}
constexpr int LC_SC = 0, LC_QH = 34816, LC_SS = 52224, LC_SLOT = 53248;
__device__ __forceinline__ void hgC_loop(Frame& F, unsigned* ctr) {
    const int tid = F.tid, lane = F.lane, wave = F.wave;
    LAS bf16* SC = (LAS bf16*)(F.lds + LC_SC); LAS bf16* Qh = (LAS bf16*)(F.lds + LC_QH); LAS float* SS = (LAS float*)(F.lds + LC_SS);
    volatile LAS int* slot = (volatile LAS int*)(F.lds + LC_SLOT);
    const bf16* PB = (const bf16*)(F.ws + WS_PB); bf16* MIX = (bf16*)(F.ws + WS_MIX);
    const int r32 = lane & 31, hh = lane >> 5, tb = wave >> 2, vb = wave & 3, t = 32 * tb + r32;
    if (tid == 0) { slot[0] = (int)__hip_atomic_fetch_add(ctr, 1u, __ATOMIC_RELAXED, __HIP_MEMORY_SCOPE_AGENT); slot[1] = (int)__hip_atomic_fetch_add(ctr, 1u, __ATOMIC_RELAXED, __HIP_MEMORY_SCOPE_AGENT); }
    __syncthreads();
    int item = slot[0], nxt = slot[1], par = 0;
    if (item >= 1024) return;
    v4u sc[4], qh[2], oi[2]; v2u og[4];
#define HGC_FETCH(IT) do { const int it_ = (IT); const bf16* DSC = (const bf16*)(F.ws + WS_DSC) + (size_t)it_ * HD * HD; const bf16* QH = (const bf16*)(F.out + O_Y + OQ_QH) + (size_t)it_ * 64 * HD; \
        const bf16* OI = (const bf16*)(F.out + O_Y + OQ_OI) + (size_t)it_ * 8192; const int bh_ = it_ >> 5, tok0_ = (bh_ >> 2) * PB_T + (it_ & 31) * 64, h_ = bh_ & 3; \
        _Pragma("unroll") for (int i = 0; i < 4; ++i) { const int p = tid + 512 * i; sc[i] = *(const v4u*)(DSC + (size_t)(p >> 4) * HD + (p & 15) * 8); } \
        _Pragma("unroll") for (int i = 0; i < 2; ++i) { const int p = tid + 512 * i; qh[i] = *(const v4u*)(QH + (size_t)(p >> 4) * HD + (p & 15) * 8); } \
        oi[0] = *(const v4u*)(OI + (size_t)(wave * 64 + lane) * 16); oi[1] = *(const v4u*)(OI + (size_t)(wave * 64 + lane) * 16 + 8); \
        _Pragma("unroll") for (int q = 0; q < 4; ++q) og[q] = *(const v2u*)(PB + (size_t)(tok0_ + t) * PBW + 1536 + h_ * HD + 32 * vb + 8 * q + 4 * hh); } while (0)
    HGC_FETCH(item);
    for (;;) {
        const int bh = item >> 5, chunk = item & 31, b = bh >> 2, h = bh & 3, tok0 = b * PB_T + chunk * 64;
#pragma unroll
        for (int i = 0; i < 4; ++i) { const int p = tid + 512 * i; *(LAS v4u*)(SC + (p >> 4) * HG_LDQ + (p & 15) * 8) = sc[i]; }
#pragma unroll
        for (int i = 0; i < 2; ++i) { const int p = tid + 512 * i; *(LAS v4u*)(Qh + (p >> 4) * HG_LDQ + (p & 15) * 8) = qh[i]; }
        f32x16 acc;
        acc[0] = bflo(oi[0].x); acc[1] = bfhi(oi[0].x); acc[2] = bflo(oi[0].y); acc[3] = bfhi(oi[0].y); acc[4] = bflo(oi[0].z); acc[5] = bfhi(oi[0].z); acc[6] = bflo(oi[0].w); acc[7] = bfhi(oi[0].w);
        acc[8] = bflo(oi[1].x); acc[9] = bfhi(oi[1].x); acc[10] = bflo(oi[1].y); acc[11] = bfhi(oi[1].y); acc[12] = bflo(oi[1].z); acc[13] = bfhi(oi[1].z); acc[14] = bflo(oi[1].w); acc[15] = bfhi(oi[1].w);
        v2u ogc[4];
#pragma unroll
        for (int q = 0; q < 4; ++q) ogc[q] = og[q];
        if (tid == 0) slot[par] = (int)__hip_atomic_fetch_add(ctr, 1u, __ATOMIC_RELAXED, __HIP_MEMORY_SCOPE_AGENT);
        if (nxt < 1024) HGC_FETCH(nxt);
        __syncthreads();
        const int nn = slot[par];
#pragma unroll
        for (int ks = 0; ks < 8; ++ks) { const s16x8 a = *(const LAS s16x8*)(SC + (32 * vb + r32) * HG_LDQ + 16 * ks + 8 * hh); const s16x8 bb = *(const LAS s16x8*)(Qh + t * HG_LDQ + 16 * ks + 8 * hh);
            acc = __builtin_amdgcn_mfma_f32_32x32x16_bf16(a, bb, acc, 0, 0, 0); }
        { float ss = 0.f;
#pragma unroll
          for (int r = 0; r < 16; ++r) ss += acc[r] * acc[r];
          ss += __shfl_xor(ss, 32);
          if (hh == 0) SS[t * 4 + vb] = ss; }
        __syncthreads();
        { const f32x4 s4 = *(const LAS f32x4*)(SS + t * 4); const float rstd = 1.0f / sqrtf(((s4.x + s4.y) + (s4.z + s4.w)) * (1.0f / HD) + EPS);
#pragma unroll
          for (int q = 0; q < 4; ++q) { const int v0 = 32 * vb + 8 * q + 4 * hh; const f32x4 gn = *(const GAS f32x4*)(F.in[17] + v0);
              v2u w; w.x = pk2(acc[4 * q] * rstd * gn.x * siluf_(bflo(ogc[q].x)), acc[4 * q + 1] * rstd * gn.y * siluf_(bfhi(ogc[q].x)));
              w.y = pk2(acc[4 * q + 2] * rstd * gn.z * siluf_(bflo(ogc[q].y)), acc[4 * q + 3] * rstd * gn.w * siluf_(bfhi(ogc[q].y)));
              *(v2u*)(MIX + (size_t)(tok0 + t) * DM + 512 + h * HD + v0) = w; } }
        __syncthreads();
        if (nxt >= 1024) break;
        item = nxt; nxt = nn; par ^= 1;
    }
#undef HGC_FETCH
}
constexpr int LX_Q = 0, LX_K2 = 4096, LX_K3 = 8192, LX_V = 12288, LX_DEC = 16384, LX_ATT = 16896, LX_OP = 17152, LX_OT = 33536;
__device__ __forceinline__ void hgrn_sample_item(Frame& F, int idx) {
    const int tid = F.tid, b = idx >> 2, h = idx & 3;
    LAS float* Qs = (LAS float*)(F.lds + LX_Q); LAS float* K2 = (LAS float*)(F.lds + LX_K2); LAS float* K3 = (LAS float*)(F.lds + LX_K3); LAS float* Vs = (LAS float*)(F.lds + LX_V);
    LAS float* DEC = (LAS float*)(F.lds + LX_DEC); LAS float* ATT = (LAS float*)(F.lds + LX_ATT); LAS float* OP = (LAS float*)(F.lds + LX_OP); LAS float* OT = (LAS float*)(F.lds + LX_OT);
    const bf16* PB = (const bf16*)(F.ws + WS_PB); const float* FZ = (const float*)(F.ws + WS_FZ); bf16* MIX = (bf16*)(F.ws + WS_MIX);
    const float* S0 = F.in[4] + (size_t)idx * HD * HD; float* Sout = F.out + O_SHG + (size_t)idx * HD * HD;
    const int tok0 = MP + b * SB_T;
    const int v = tid & 127, kq = tid >> 7;
    float s0[32];
#pragma unroll
    for (int j = 0; j < 32; ++j) s0[j] = S0[(size_t)(32 * kq + j) * HD + v];
    if (tid < 128) { const int col = h * HD + tid; const float lb = 1.0f / (1.0f + expf(F.in[5][512 + col] - F.in[5][col]));
        float gl[8], kk[8], qq[8]; float run = 0.f;
#pragma unroll
        for (int t = 0; t < 8; ++t) { const size_t tok = (size_t)(tok0 + t); const float fz = FZ[tok * 512 + col]; qq[t] = bf2f(PB[tok * PBW + 512 + col]);
            const float sg = 1.0f / (1.0f + __expf(-fz)), f = lb + (1.0f - lb) * sg; kk[t] = 1.0f - f; run += __log2f(f); gl[t] = run; }
#pragma unroll
        for (int t = 0; t < 8; ++t) { Qs[t * 128 + tid] = qq[t] * __builtin_amdgcn_exp2f(gl[t]); K2[t * 128 + tid] = kk[t] * __builtin_amdgcn_exp2f(-gl[t]); K3[t * 128 + tid] = kk[t] * __builtin_amdgcn_exp2f(run - gl[t]); }
        DEC[tid] = __builtin_amdgcn_exp2f(run);
    } else if (tid < 256) { const int vv = tid - 128;
#pragma unroll
        for (int t = 0; t < 8; ++t) Vs[t * 128 + vv] = bf2f(PB[(size_t)(tok0 + t) * PBW + 1024 + h * HD + vv]);
    }
    __syncthreads();
    { const int p = tid >> 3, part = tid & 7, t = p >> 3, s = p & 7; float a = 0.f;
#pragma unroll
      for (int j = 0; j < 16; ++j) a += Qs[t * 128 + part + 8 * j] * K2[s * 128 + part + 8 * j];
      a += __shfl_xor(a, 1); a += __shfl_xor(a, 2); a += __shfl_xor(a, 4);
      if (part == 0) ATT[p] = (s <= t) ? a : 0.f; }
    float vr[8], o[8];
#pragma unroll
    for (int t = 0; t < 8; ++t) { vr[t] = Vs[t * 128 + v]; o[t] = 0.f; }
#pragma unroll
    for (int j = 0; j < 32; ++j) { const int k = 32 * kq + j; const float sv = s0[j]; float sn = DEC[k] * sv;
#pragma unroll
        for (int t = 0; t < 8; ++t) { o[t] += Qs[t * 128 + k] * sv; sn += K3[t * 128 + k] * vr[t]; }
        Sout[(size_t)k * HD + v] = sn; }
#pragma unroll
    for (int t = 0; t < 8; ++t) OP[(kq * 8 + t) * 128 + v] = o[t];
    __syncthreads();
#pragma unroll
    for (int r = 0; r < 2; ++r) { const int e = tid + 512 * r, t = e >> 7, vv = e & 127;
        float acc = (OP[(0 * 8 + t) * 128 + vv] + OP[(1 * 8 + t) * 128 + vv]) + (OP[(2 * 8 + t) * 128 + vv] + OP[(3 * 8 + t) * 128 + vv]);
#pragma unroll
        for (int s = 0; s < 8; ++s) acc += ATT[t * 8 + s] * Vs[s * 128 + vv];
        OT[t * 128 + vv] = acc; }
    __syncthreads();
    { const int t = F.wave, lane = F.lane; const float o0 = OT[t * 128 + 2 * lane], o1 = OT[t * 128 + 2 * lane + 1];
      const float rstd = 1.0f / sqrtf(wave_sum(o0 * o0 + o1 * o1) * (1.0f / HD) + EPS);
      const unsigned gw2 = *(const unsigned*)(PB + (size_t)(tok0 + t) * PBW + 1536 + h * HD + 2 * lane);
      const float g0 = F.in[17][2 * lane], g1 = F.in[17][2 * lane + 1];
      *(unsigned*)(MIX + (size_t)(tok0 + t) * DM + 512 + h * HD + 2 * lane) = pk2(o0 * rstd * g0 * siluf_(bflo(gw2)), o1 * rstd * g1 * siluf_(bfhi(gw2))); }
    __syncthreads();
}
constexpr int SG_LD = 68;
template <int KSTEPS  >
__device__ __forceinline__ void small_gemm_tile(Frame& F, const bf16* A, int lda, const bf16* Bt, int K, int r0, int c0, float (&v)[8]) {
    const int lane = F.lane, wave = F.wave, fr = lane & 15, fq = lane >> 4;
    f32x4v acc[4][4];
#pragma unroll
    for (int a = 0; a < 4; ++a)
#pragma unroll
        for (int b = 0; b < 4; ++b) acc[a][b] = (f32x4v){0.f, 0.f, 0.f, 0.f};
    const bf16* ap = A + (size_t)(r0 + fr) * lda + wave * (KSTEPS * 32) + 8 * fq;
    const bf16* bp = Bt + (size_t)(c0 + fr) * K + wave * (KSTEPS * 32) + 8 * fq;
#pragma unroll 2
    for (int ks = 0; ks < KSTEPS; ++ks) {
        s16x8 af[4], bf[4];
#pragma unroll
        for (int i = 0; i < 4; ++i) { af[i] = *(const s16x8*)(ap + (size_t)(16 * i) * lda + 32 * ks); bf[i] = *(const s16x8*)(bp + (size_t)(16 * i) * K + 32 * ks); }
#pragma unroll
        for (int a = 0; a < 4; ++a)
#pragma unroll
            for (int b = 0; b < 4; ++b) acc[a][b] = __builtin_amdgcn_mfma_f32_16x16x32_bf16(bf[b], af[a], acc[a][b], 0, 0, 0);
    }
    LAS float* part = (LAS float*)F.lds + wave * (64 * SG_LD);
#pragma unroll
    for (int a = 0; a < 4; ++a)
#pragma unroll
        for (int b = 0; b < 4; ++b) *(LAS f32x4v*)(part + (16 * a + fr) * SG_LD + 16 * b + 4 * fq) = acc[a][b];
    __syncthreads();
    { const int row = F.tid >> 3, cg8 = (F.tid & 7) * 8; const LAS float* p = (const LAS float*)F.lds + row * SG_LD + cg8;
      f32x4v s0 = {0.f, 0.f, 0.f, 0.f}, s1 = {0.f, 0.f, 0.f, 0.f};
#pragma unroll
      for (int w = 0; w < 8; ++w) { s0 += *(const LAS f32x4v*)(p + w * (64 * SG_LD)); s1 += *(const LAS f32x4v*)(p + w * (64 * SG_LD) + 4); }
      v[0] = s0[0]; v[1] = s0[1]; v[2] = s0[2]; v[3] = s0[3]; v[4] = s1[0]; v[5] = s1[1]; v[6] = s1[2]; v[7] = s1[3]; }
    __syncthreads();
}

__device__ __forceinline__ void outproj_sample_tile(Frame& F, int tile, float* SS1) {
    const int rm = tile >> 4, cn = tile & 15; float v[8];
    small_gemm_tile<4>(F, (const bf16*)(F.ws + WS_MIX), DM, (const bf16*)(F.ws + WS_WOUT), DM, MP + 64 * rm, 64 * cn, v);
    const int row = MP + 64 * rm + (F.tid >> 3), col = 64 * cn + 8 * (F.tid & 7); const size_t off = (size_t)row * DM + col;
    const float* xs = F.in[1] + (size_t)(row - MP) * DM + col; bf16* XN = (bf16*)(F.ws + WS_XN);
    const f32x4v xa = *(const f32x4v*)xs, xb = *(const f32x4v*)(xs + 4);
    const f32x4v x0 = {xa[0] + v[0], xa[1] + v[1], xa[2] + v[2], xa[3] + v[3]}, x1 = {xb[0] + v[4], xb[1] + v[5], xb[2] + v[6], xb[3] + v[7]};
    v4u w; w.x = pk2(x0[0], x0[1]); w.y = pk2(x0[2], x0[3]); w.z = pk2(x1[0], x1[1]); w.w = pk2(x1[2], x1[3]);
    *(v4u*)(XN + off) = w;
    float ss = (x0[0] * x0[0] + x0[1] * x0[1]) + (x0[2] * x0[2] + x0[3] * x0[3]) + (x1[0] * x1[0] + x1[1] * x1[1]) + (x1[2] * x1[2] + x1[3] * x1[3]);
    ss += __shfl_xor(ss, 1); ss += __shfl_xor(ss, 2); ss += __shfl_xor(ss, 4);
    if ((F.tid & 7) == 0) __hip_atomic_fetch_add(SS1 + row, ss, __ATOMIC_RELAXED, __HIP_MEMORY_SCOPE_AGENT);
}
__device__ __forceinline__ void down_sample_tile(Frame& F, int tile, float* SS2, unsigned* cntb, float* YO) {
    const int rm = tile >> 4, cn = tile & 15; float v[8];
    small_gemm_tile<11>(F, (const bf16*)(F.ws + WS_ACT), DFF, (const bf16*)(F.ws + WS_WD), DFF, MP + 64 * rm, 64 * cn, v);
    const int row = MP + 64 * rm + (F.tid >> 3), col = 64 * cn + 8 * (F.tid & 7); const size_t off = (size_t)row * DM + col;
    unsigned* cnt = cntb + 64 * rm; const v4u xw = *(const v4u*)((const bf16*)(F.ws + WS_XN) + off);
    const f32x4v xa = {bflo(xw.x), bfhi(xw.x), bflo(xw.y), bfhi(xw.y)}, xb = {bflo(xw.z), bfhi(xw.z), bflo(xw.w), bfhi(xw.w)}, ga = *(const f32x4v*)(F.in[23] + col), gb = *(const f32x4v*)(F.in[23] + col + 4);
    const f32x4v x0 = {xa[0] + v[0], xa[1] + v[1], xa[2] + v[2], xa[3] + v[3]}, x1 = {xb[0] + v[4], xb[1] + v[5], xb[2] + v[6], xb[3] + v[7]};
    float ss = (x0[0] * x0[0] + x0[1] * x0[1]) + (x0[2] * x0[2] + x0[3] * x0[3]) + (x1[0] * x1[0] + x1[1] * x1[1]) + (x1[2] * x1[2] + x1[3] * x1[3]);
    ss += __shfl_xor(ss, 1); ss += __shfl_xor(ss, 2); ss += __shfl_xor(ss, 4);
    if ((F.tid & 7) == 0) __hip_atomic_fetch_add(SS2 + row, ss, __ATOMIC_RELAXED, __HIP_MEMORY_SCOPE_AGENT);
    asm volatile("s_waitcnt vmcnt(0)" ::: "memory");
    __syncthreads();
    if (F.tid == 0) { __hip_atomic_fetch_add(cnt, 1u, __ATOMIC_RELAXED, __HIP_MEMORY_SCOPE_AGENT); wait_count(cnt, 16u); }
    __syncthreads();
    float s = 0.f; if ((F.tid & 7) == 0) s = atomic_read_f32(SS2 + row);
    const float rs = rstd_of(__shfl(s, F.lane & ~7));
    *(f32x4v*)(YO + off) = (f32x4v){x0[0] * rs * ga[0], x0[1] * rs * ga[1], x0[2] * rs * ga[2], x0[3] * rs * ga[3]};
    *(f32x4v*)(YO + off + 4) = (f32x4v){x1[0] * rs * gb[0], x1[1] * rs * gb[1], x1[2] * rs * gb[2], x1[3] * rs * gb[3]};
}
typedef GAS unsigned gu32;
#define RLX_AGENT __ATOMIC_RELAXED, __HIP_MEMORY_SCOPE_AGENT
constexpr int MISC_OFF = LDS_BYTES - 512;
constexpr int CW_QUEUE = 8192;
constexpr int CW_BAR = 4096;
constexpr size_t CTL_ZERO_BYTES = 524288;
constexpr int CW_DUMMY = 65536;
#define XB_TMO      128
#define XB_XCNT(j)  (256  + 64 * (j))
#define XB_XSUB(j)  (1280 + 64 * (j))
#define XB_XGEN(j)  (2304 + 64 * (j))
#define XB_TOP      3328
#define XB_TOPGEN   3392
#define XCD_BAR_WORDS 3456
#define XB_SPIN_CAP (1u << 18)

__device__ __forceinline__ unsigned xb_ld(unsigned* p)              { return __hip_atomic_load(p, __ATOMIC_RELAXED, __HIP_MEMORY_SCOPE_AGENT); }
__device__ __forceinline__ unsigned xb_add(unsigned* p, unsigned v) { return __hip_atomic_fetch_add(p, v, __ATOMIC_RELAXED, __HIP_MEMORY_SCOPE_AGENT); }
__device__ __forceinline__ unsigned xb_xcc_id() { return (unsigned)__builtin_amdgcn_s_getreg((3 << 11) | 20) & 0xFu; }
#define XB_SPIN(cond, bar) do { unsigned _sp = 0; while (cond) { __builtin_amdgcn_s_sleep(1); \
    if ((++_sp & 255u) == 0u) { if (xb_ld(&(bar)[XB_TMO])) break; if (_sp > XB_SPIN_CAP) { atomicAdd(&(bar)[XB_TMO], 1u); break; } } } } while (0)

struct XcdBarrier {
    unsigned* bar; unsigned x;
    volatile LAS unsigned* st;
};

__device__ __forceinline__ XcdBarrier xcd_barrier_post(unsigned* bar, volatile LAS unsigned* st) {
    XcdBarrier b; b.bar = bar; b.x = xb_xcc_id(); b.st = st;
    if (threadIdx.x == 0) (void)xb_add(&bar[XB_XCNT(b.x)], 1u);
    return b;
}
__device__ __forceinline__ void xcd_barrier_complete(unsigned* bar, unsigned x, unsigned& nloc, unsigned& nx) {
    const unsigned G = gridDim.x * gridDim.y * gridDim.z;
    unsigned sum, cnt, mine, sp = 0u;
    for (;;) {
        sum = 0u; cnt = 0u; mine = 0u;
#pragma unroll
        for (unsigned j = 0; j < 16; ++j) { const unsigned c = xb_ld(&bar[XB_XCNT(j)]); sum += c; cnt += (c > 0u) ? 1u : 0u; mine = (j == x) ? c : mine; }
        if (sum == G) break;
        __builtin_amdgcn_s_sleep(1);
        if ((++sp & 255u) == 0u) { if (xb_ld(&bar[XB_TMO])) break; if (sp > XB_SPIN_CAP) { atomicAdd(&bar[XB_TMO], 1u); break; } }
    }
    nloc = mine > 0u ? mine : 1u; nx = cnt > 0u ? cnt : 1u;
}

__device__ __forceinline__ void xcd_barrier(const XcdBarrier& b) {
    asm volatile("s_waitcnt vmcnt(0)" ::: "memory");
    __syncthreads();
    if (threadIdx.x == 0) {
        unsigned* bar = b.bar;
        __builtin_amdgcn_s_waitcnt(0);
        unsigned nloc = b.st[0], nx = b.st[1];
        if (nloc == 0u) { xcd_barrier_complete(bar, b.x, nloc, nx); b.st[0] = nloc; b.st[1] = nx; }
        const unsigned old = xb_add(&bar[XB_XSUB(b.x)], 1u);
        const unsigned gen = old / nloc;
        if (old + 1u == (gen + 1u) * nloc) {
            __builtin_amdgcn_fence(__ATOMIC_RELEASE, "agent");
            asm volatile("s_waitcnt vmcnt(0)" ::: "memory");
            const unsigned og = xb_add(&bar[XB_TOP], 1u);
            const unsigned tg = og / nx;
            if (og + 1u == (tg + 1u) * nx) xb_add(&bar[XB_TOPGEN], 1u);
            else XB_SPIN(xb_ld(&bar[XB_TOPGEN]) == tg, bar);
            __builtin_amdgcn_fence(__ATOMIC_ACQUIRE, "agent");
            xb_add(&bar[XB_XGEN(b.x)], 1u);
            asm volatile("s_waitcnt vmcnt(0)" ::: "memory");
        } else {
            XB_SPIN(xb_ld(&bar[XB_XGEN(b.x)]) == gen, bar);
            __builtin_amdgcn_fence(__ATOMIC_ACQUIRE, "agent");
            asm volatile("s_waitcnt vmcnt(0)" ::: "memory");
        }
    }
    __syncthreads();
}

__global__ void __launch_bounds__(NWAVES * 64, 2) mk_fwd(Args args) {
    extern __shared__ __attribute__((aligned(16))) unsigned char lds[];
    Frame F;
    F.lds = (LAS unsigned char*)lds;
    F.tid = threadIdx.x; F.lane = F.tid & 63; F.wave = __builtin_amdgcn_readfirstlane(F.tid >> 6);
    F.G = gridDim.x; F.bid = blockIdx.x;
#pragma unroll
    for (int i = 0; i < 24; ++i) F.in[i] = args.in[i];
    F.out = args.out; F.ws = args.ws;
    const int lo = args.ph_lo, hi = args.ph_hi;
#define IN(k) (lo <= (k) && (k) < hi)
#if MK_N_LAUNCHES == 1
    volatile LAS unsigned* MISC = (volatile LAS unsigned*)(F.lds + MISC_OFF);
    if (F.tid < 32) MISC[F.tid] = 0u;
    __syncthreads();
    XcdBarrier bar = xcd_barrier_post((unsigned*)(F.ws + WS_CTL) + CW_BAR, MISC + 8);
#if defined(PROBE_PH)
    if (F.bid == 0 && F.tid == 0) { const unsigned long long t_ = __builtin_amdgcn_s_memrealtime(); MISC[32] = (unsigned)t_; MISC[33] = (unsigned)(t_ >> 32); }
#endif
#if defined(PROBE_PH)
#define SEAM(k) do { if (IN(k) && IN((k) + 1)) { xcd_barrier(bar); if (F.bid == 0 && F.tid == 0) { const unsigned long long t_ = __builtin_amdgcn_s_memrealtime(); MISC[32 + 2 * ((k) + 1)] = (unsigned)t_; MISC[33 + 2 * ((k) + 1)] = (unsigned)(t_ >> 32); } } } while (0)
#elif REP_BAR == 2
#define SEAM(k) do { if (IN(k) && IN((k) + 1)) { xcd_barrier(bar); xcd_barrier(bar); } } while (0)
#else
#define SEAM(k) do { if (IN(k) && IN((k) + 1)) xcd_barrier(bar); } while (0)
#endif
#else
#define SEAM(k) do { } while (0)
#endif
    const int gw = F.bid * NWAVES + F.wave, NGW = F.G * NWAVES;
    bf16* XN = (bf16*)(F.ws + WS_XN); bf16* PB = (bf16*)(F.ws + WS_PB); float* FZ = (float*)(F.ws + WS_FZ); bf16* GY = (bf16*)(F.ws + WS_GY);
    bf16* MIX = (bf16*)(F.ws + WS_MIX); bf16* ACT = (bf16*)(F.ws + WS_ACT);

    if (IN(0)) { p0_prologue(F);
#if REP_P0 == 2
        __syncthreads(); p0_prologue(F);
#endif
    } SEAM(0);
    if (IN(1)) {
        pg8::Gemm g{XN, (const bf16*)(F.ws + WS_WIN), MTOK, INC, DM}; pg8::StaticOrder S; S.init(MTOK, INC, F.G, F.bid);
        EpiIn E{PB, FZ, (bf16*)(F.ws + WS_U5)};
        pg8::gemm_phase<EpiIn, pg8::StaticOrder, true, true>(F.lds, g, S, E);
        { const int nunits = (MTOK / 256) * (INC / 256), rem = nunits % F.G;
          if (rem == 0) deferred_transposes<0>(F, gw, NGW); else if (F.bid >= rem) deferred_transposes<0>(F, (F.bid - rem) * NWAVES + F.wave, (F.G - rem) * NWAVES); }
#if REP_P1 == 2
        __syncthreads();
        pg8::gemm_phase<EpiIn, pg8::StaticOrder, true, true>(F.lds, g, S, E);
#endif
    } SEAM(1);
    if (IN(2)) {
        if ((F.bid & 1) == 0) {
            for (int it = F.bid; it < 256; it += F.G) s5_item(F, it);
            hgA_loop(F);
            for (int it = F.bid; it < SB_B * HH; it += F.G) hgrn_sample_item(F, it);
        } else {
            for (int it = F.bid; it < SB_B * HH; it += F.G) hgrn_sample_item(F, it);
            hgA_loop(F);
            __syncthreads();
            for (int it = F.bid; it < 256; it += F.G) s5_item(F, it);
        }
    } SEAM(2);
    if (IN(3)) { hg_scan(F, (bf16*)(F.ws + WS_DSC), F.bid, F.G); } SEAM(3);
    if (IN(4)) {
        pg8::Gemm g{GY, (const bf16*)(F.ws + WS_WGLU), MTOK, S5W, S5W}; pg8::StaticOrder S; S.init(MTOK, S5W, F.G, F.bid);
        EpiGlu E{GY, MIX};
        pg8::gemm_phase<EpiGlu, pg8::StaticOrder, true, true, true>(F.lds, g, S, E);
        __syncthreads();
        hgC_loop(F, (unsigned*)(F.ws + WS_CTL) + CW_QUEUE);
    } SEAM(4);
    if (IN(5)) {
        pg8::Gemm g{MIX, (const bf16*)(F.ws + WS_WOUT), MP, DM, DM}; pg8::StaticOrder S; S.init(MP, DM, F.G, F.bid);
#if REP_P5 >= 2
        { EpiOut E2{F.in[0], XN, (float*)(F.ws + WS_CTL) + CW_DUMMY};
#if REP_P5 == 2 || REP_P5 == 3
          pg8::gemm_phase<EpiOut, pg8::StaticOrder, true, true>(F.lds, g, S, E2);
          __syncthreads();
#endif
#if REP_P5 == 2 || REP_P5 == 4
          for (int it = F.bid; it < 256; it += F.G) outproj_sample_tile(F, it, (float*)(F.ws + WS_CTL) + CW_DUMMY);
          __syncthreads();
#endif
        }
#endif
        EpiOut E{F.in[0], XN, (float*)(F.ws + WS_CTL) + CW_SS1};
        const bool first = (F.G == 256) && ((F.bid & 1) == 0);
        if (first) { outproj_sample_tile(F, F.bid, (float*)(F.ws + WS_CTL) + CW_SS1); __syncthreads(); }
        pg8::gemm_phase<EpiOut, pg8::StaticOrder, true, true>(F.lds, g, S, E);
        __syncthreads();
        if (!first) for (int it = F.bid; it < 256; it += F.G) outproj_sample_tile(F, it, (float*)(F.ws + WS_CTL) + CW_SS1);
    } SEAM(5);
    if (IN(6)) {
        pg8::Gemm g{XN, (const bf16*)(F.ws + WS_WGU), MTOK, 2 * DFF, DM}; pg8::StaticOrder S; S.init(MTOK, 2 * DFF, F.G, F.bid);
        EpiAct E{ACT, (const float*)(F.ws + WS_CTL) + CW_SS1};
        pg8::gemm_phase<EpiAct, pg8::StaticOrder, P6_ALIGN, P6_SP2>(F.lds, g, S, E);
        { const int nunits = (MTOK / 256) * (2 * DFF / 256), rem = nunits % F.G;
          if (rem == 0) deferred_transposes<1>(F, gw, NGW); else if (F.bid >= rem) deferred_transposes<1>(F, (F.bid - rem) * NWAVES + F.wave, (F.G - rem) * NWAVES); }
#if REP_P6 == 2
        __syncthreads();
        pg8::gemm_phase<EpiAct, pg8::StaticOrder, true, true>(F.lds, g, S, E);
#endif
    } SEAM(6);
    if (IN(7)) {
        pg8::Gemm g{ACT, (const bf16*)(F.ws + WS_WD), MP, DM, DFF}; pg8::StaticOrder S; S.init(MP, DM, F.G, F.bid);
#if REP_P7 == 2
        { float* YD = (float*)(F.ws + WS_GY) - 0;
          EpiDown E2{XN, F.in[23], (float*)(F.ws + WS_CTL) + CW_DUMMY, (unsigned*)(F.ws + WS_CTL) + CW_DUMMY + 20480, YD};
          pg8::gemm_phase<EpiDown, pg8::StaticOrder, true, true>(F.lds, g, S, E2);
          __syncthreads();
          for (int it = F.bid; it < 256; it += F.G) down_sample_tile(F, it, (float*)(F.ws + WS_CTL) + CW_DUMMY, (unsigned*)(F.ws + WS_CTL) + CW_DUMMY + 20480 + 4096, YD);
          __syncthreads(); }
#endif
        EpiDown E{XN, F.in[23], (float*)(F.ws + WS_CTL) + CW_SS2, (unsigned*)(F.ws + WS_CTL) + CW_CNT, F.out + O_Y};
        Unit u0; const bool has_u = S.next(0, u0); const int grp = has_u ? (u0.pm & 1) : 0;
        const int stile = (F.G == 256 && has_u) ? grp * 128 + (u0.pm >> 1) * 4 + u0.pn : F.bid;
        if (F.G == 256 && grp == 0) { down_sample_tile(F, stile, (float*)(F.ws + WS_CTL) + CW_SS2, (unsigned*)(F.ws + WS_CTL) + CW_CNTS, F.out + O_Y); __syncthreads(); }
        pg8::gemm_phase<EpiDown, pg8::StaticOrder, true, true>(F.lds, g, S, E);
        __syncthreads();
        if (F.G != 256) { for (int it = F.bid; it < 256; it += F.G) down_sample_tile(F, it, (float*)(F.ws + WS_CTL) + CW_SS2, (unsigned*)(F.ws + WS_CTL) + CW_CNTS, F.out + O_Y); }
        else if (grp == 1) down_sample_tile(F, stile, (float*)(F.ws + WS_CTL) + CW_SS2, (unsigned*)(F.ws + WS_CTL) + CW_CNTS, F.out + O_Y);
    }
#if defined(PROBE_PH)
    if (F.bid == 0 && F.tid == 0) {
        const unsigned long long tn = __builtin_amdgcn_s_memrealtime();
        const unsigned long long t0 = ((unsigned long long)MISC[33 + 2 * PROBE_PH] << 32) | MISC[32 + 2 * PROBE_PH];
        const unsigned long long t1 = (PROBE_PH == NPH - 1) ? tn : (((unsigned long long)MISC[35 + 2 * PROBE_PH] << 32) | MISC[34 + 2 * PROBE_PH]);
        const unsigned long long wait = 4ull * (t1 - t0);
        while (__builtin_amdgcn_s_memrealtime() - tn < wait) __builtin_amdgcn_s_sleep(8);
    }
#endif
#undef IN
#undef SEAM
}

extern "C" void kernel_launch(void* const* d_in, const int* in_sizes, int n_in, void* d_out, int out_size, void* d_ws, size_t ws_size, hipStream_t stream) {
    static int grid = 0;
    if (grid == 0) {
        if (n_in != 24 || ws_size < WS_END) { fprintf(stderr, "kernel_launch: unexpected n_in %d / ws %zu\n", n_in, ws_size); grid = -1; return; }
        int dev = 0, cus = 0, per_cu = 0;
        if (hipGetDevice(&dev) != hipSuccess || hipDeviceGetAttribute(&cus, hipDeviceAttributeMultiprocessorCount, dev) != hipSuccess) { grid = -1; return; }
        if (hipFuncSetAttribute((const void*)mk_fwd, hipFuncAttributeMaxDynamicSharedMemorySize, LDS_BYTES) != hipSuccess) { fprintf(stderr, "kernel_launch: hipFuncSetAttribute failed\n"); grid = -1; return; }
        if (hipOccupancyMaxActiveBlocksPerMultiprocessor(&per_cu, (const void*)mk_fwd, NWAVES * 64, LDS_BYTES) != hipSuccess || per_cu < 1) { fprintf(stderr, "kernel_launch: occupancy query says %d\n", per_cu); per_cu = 1; }
        (void)hipGetLastError();
        grid = cus;
    }
    if (grid < 0) return;
    if (hipMemsetAsync((char*)d_ws + WS_CTL, 0, CTL_ZERO_BYTES, stream) != hipSuccess) { fprintf(stderr, "kernel_launch: memset failed\n"); return; }
    Args a{};
    for (int i = 0; i < 24; ++i) a.in[i] = (const float*)d_in[i];
    a.out = (float*)d_out; a.ws = (unsigned char*)d_ws;
#if MK_N_LAUNCHES == 1
    a.ph_lo = 0; a.ph_hi = NPH;
    void* kargs[] = {&a};
    hipError_t e = hipLaunchCooperativeKernel((const void*)mk_fwd, dim3(grid), dim3(NWAVES * 64), kargs, LDS_BYTES, stream);
    if (e != hipSuccess) fprintf(stderr, "kernel_launch: cooperative launch failed: %s (grid %d)\n", hipGetErrorString(e), grid);
#else
    for (int p = 0; p < NPH; ++p) { a.ph_lo = p; a.ph_hi = p + 1; hipLaunchKernelGGL(mk_fwd, dim3(grid), dim3(NWAVES * 64), LDS_BYTES, stream, a); }
#endif
}
```

```cpp
#include <hip/hip_runtime.h>
#include <hip/hip_cooperative_groups.h>
#include <cstdio>
#include <cstdint>
namespace cg = cooperative_groups;
#ifndef PG8_WGM
#define PG8_WGM 4
#endif
#define MK_N_LAUNCHES 1
namespace pg8 {
#define PG8_LAS __attribute__((address_space(3)))
typedef unsigned short bf16_t;
typedef short bf16x8 __attribute__((ext_vector_type(8)));
typedef float f32x4 __attribute__((ext_vector_type(4)));
typedef unsigned u32x4 __attribute__((ext_vector_type(4)));
constexpr int BM = 256, BK = 64, HALF = 128, HTB = HALF * BK * 2  , STAGE_BYTES = 8 * HTB, NXCD = 8, WGM = PG8_WGM;

__host__ __device__ __forceinline__ int lds_byte(int r, int c) { const int st = (r >> 4) * 2 + (c >> 5), rr = r & 15, cc = c & 31, ob = rr * 64 + cc * 2; return st * 1024 + (ob ^ (((ob >> 9) & 1) << 5)); }
__host__ __device__ __forceinline__ void stage_rc(int b, int& R, int& C) { const int st = b / 1024, sb = b % 1024, swz = sb ^ (((sb >> 9) & 1) << 5); R = (st >> 1) * 16 + swz / 64; C = (st & 1) * 32 + (swz % 64) / 2; }
__host__ __device__ __forceinline__ int perm32(int rho) { const int n = rho >> 4, i = rho & 15; return 8 * (i >> 2) + 4 * n + (i & 3); }

struct Unit { int pm, pn; };
struct Gemm { const bf16_t* A; const bf16_t* Bt; int M, N, K; };

struct StaticOrder {
    int nM, nN, nwg, G, c;
    __host__ __device__ void init(int M, int N, int G_, int c_) { nM = M / BM; nN = N / BM; nwg = nM * nN; G = G_; c = c_; }
    __host__ __device__ bool next(int i, Unit& u) const {
        const long L = (long)i * G + c; if (L >= nwg) return false;
        int wgid = (int)L; { const int q = nwg / NXCD, r = nwg % NXCD, xcd = wgid % NXCD, off = wgid / NXCD; wgid = (xcd < r ? xcd * (q + 1) : r * (q + 1) + (xcd - r) * q) + off; }
        const int nig = WGM * nN, gid = wgid / nig, fm = gid * WGM, gsz = (nM - fm) < WGM ? (nM - fm) : WGM;
        u.pm = fm + ((wgid % nig) % gsz); u.pn = (wgid % nig) / gsz; return true;
    }
    __device__ __forceinline__ void a_ready(const Unit&) const {}
    __device__ __forceinline__ void done(const Unit&) const {}
};

__device__ __forceinline__ unsigned cvt_pk_bf16(float lo, float hi) { unsigned r; asm volatile("v_cvt_pk_bf16_f32 %0, %1, %2" : "=v"(r) : "v"(lo), "v"(hi)); return r; }
template <class Epi, class Sched, bool ALIGN_EPI = false, bool SP2 = false, bool AGM = false  >
__device__ __forceinline__ void gemm_phase(PG8_LAS unsigned char* lds, const Gemm g, const Sched& S, const Epi& E) {
    const int tid = threadIdx.x, wid = __builtin_amdgcn_readfirstlane(tid >> 6), lane = tid & 63, wr = wid >> 2, wc = wid & 3, fr = lane & 15, fq = lane >> 4;
    const int K = g.K, nt = K / BK;
    unsigned voffA[2], voffB[2];
#pragma unroll
    for (int i = 0; i < 2; ++i) { int R, C; stage_rc(tid * 16 + i * 8192, R, C); const int Rb = Epi::PERM ? ((R & ~31) + perm32(R & 31)) : R;
        voffA[i] = AGM ? (unsigned)((((C >> 4) * g.M + R) * 16 + (C & 15)) * 2) : (unsigned)(R * K + C) * 2u; voffB[i] = (unsigned)(Rb * K + C) * 2u; }
    const size_t kstep = (size_t)(BK * 2);
    const size_t hstep = (size_t)HALF * K * 2;
    const size_t tstep = 2 * hstep;
    const size_t kstepA = AGM ? (size_t)4 * g.M * 32 : kstep, hstepA = AGM ? (size_t)HALF * 32 : hstep, tstepA = 2 * hstepA;
    const unsigned ldsw = (unsigned)wid * 1024u;
    const int aoff = lds_byte(wr * 64 + fr, fq * 8), boff = lds_byte(wc * 32 + fr, fq * 8);
#define PG8_SA(b, h) (((b) * 2 + (h)) * HTB)
#define PG8_SB(b, h) ((4 + (b) * 2 + (h)) * HTB)
#define PG8_STAGE(bufoff, gbase, voff) do { _Pragma("unroll") for (int _i = 0; _i < 2; ++_i) \
        __builtin_amdgcn_global_load_lds((const unsigned*)((const char*)(gbase) + (voff)[_i]), (PG8_LAS unsigned*)(lds + (bufoff) + ldsw + _i * 8192), 16, 0, 0); } while (0)
#define PG8_LDA(dst, b, h) do { _Pragma("unroll") for (int m = 0; m < 4; ++m) _Pragma("unroll") for (int k = 0; k < 2; ++k) dst[m][k] = *(const PG8_LAS bf16x8*)(lds + PG8_SA(b, h) + aoff + m * 2048 + k * 1024); } while (0)
#define PG8_LDB(dst, b, h) do { _Pragma("unroll") for (int n = 0; n < 2; ++n) _Pragma("unroll") for (int k = 0; k < 2; ++k) dst[n][k] = *(const PG8_LAS bf16x8*)(lds + PG8_SB(b, h) + boff + n * 2048 + k * 1024); } while (0)
#define PG8_MMA(ai, bj, At, Bt) do { __builtin_amdgcn_s_setprio(1); _Pragma("unroll") for (int m = 0; m < 4; ++m) _Pragma("unroll") for (int n = 0; n < 2; ++n) _Pragma("unroll") for (int k = 0; k < 2; ++k) \
        acc[ai][bj][m][n] = __builtin_amdgcn_mfma_f32_16x16x32_bf16(Bt[n][k], At[m][k], acc[ai][bj][m][n], 0, 0, 0); __builtin_amdgcn_s_setprio(0); } while (0)
#define PG8_WAIT_V(n) asm volatile("s_waitcnt vmcnt(" #n ")" ::: "memory")
#define PG8_WAIT_L(n) asm volatile("s_waitcnt lgkmcnt(" #n ")" ::: "memory")
#define PG8_BAR __builtin_amdgcn_s_barrier()
#define PG8_SCHED __builtin_amdgcn_sched_barrier(0)
    Unit cur, nxt; int ui = 0;
    if (!S.next(0, cur)) return;
    f32x4 acc[2][2][4][2];
#pragma unroll
    for (int a = 0; a < 2; ++a)
#pragma unroll
        for (int b = 0; b < 2; ++b)
#pragma unroll
            for (int m = 0; m < 4; ++m)
#pragma unroll
                for (int n = 0; n < 2; ++n) acc[a][b][m][n] = (f32x4){0.f, 0.f, 0.f, 0.f};
    bf16x8 At[4][2], B0[2][2], B1[2][2];
    const char* cA = (const char*)g.A + (size_t)cur.pm * tstepA; const char* cB = (const char*)g.Bt + (size_t)cur.pn * tstep;
    S.a_ready(cur);
    if constexpr (SP2) {
        PG8_STAGE(PG8_SB(0, 0), cB, voffB); PG8_STAGE(PG8_SB(0, 1), cB + hstep, voffB); PG8_STAGE(PG8_SA(0, 0), cA, voffA); PG8_STAGE(PG8_SA(0, 1), cA + hstepA, voffA);
        if (wr == 1) PG8_BAR;
        PG8_WAIT_V(2); PG8_BAR;
        PG8_STAGE(PG8_SB(1, 0), cB + kstep, voffB); PG8_STAGE(PG8_SA(1, 0), cA + kstepA, voffA); PG8_STAGE(PG8_SB(1, 1), cB + hstep + kstep, voffB);
        PG8_WAIT_V(6); PG8_BAR;
    } else {
        PG8_STAGE(PG8_SB(0, 0), cB, voffB); PG8_STAGE(PG8_SA(0, 0), cA, voffA); PG8_STAGE(PG8_SB(0, 1), cB + hstep, voffB); PG8_STAGE(PG8_SA(0, 1), cA + hstepA, voffA);
        if (wr == 1) PG8_BAR;
        PG8_WAIT_V(4); PG8_BAR;
        PG8_STAGE(PG8_SB(1, 0), cB + kstep, voffB); PG8_STAGE(PG8_SA(1, 0), cA + kstepA, voffA); PG8_STAGE(PG8_SB(1, 1), cB + hstep + kstep, voffB);
        PG8_WAIT_V(6); PG8_BAR;
    }
    for (;;) {
        const bool has_next = S.next(ui + 1, nxt);
        const char* nA = has_next ? (const char*)g.A + (size_t)nxt.pm * tstepA : cA; const char* nB = has_next ? (const char*)g.Bt + (size_t)nxt.pn * tstep : cB;
        for (int t = 0; t < nt; t += 2) {
            const bool last = (t == nt - 2);
            const char* a1 = cA + (size_t)(t + 1) * kstepA;
            const char* a2 = last ? nA : cA + (size_t)(t + 2) * kstepA; const char* b2 = last ? nB : cB + (size_t)(t + 2) * kstep;
            const char* a3 = a2 + kstepA; const char* b3 = b2 + kstep;
            if (last && has_next) S.a_ready(nxt);
            if constexpr (SP2) {
            PG8_LDB(B0, 0, 0); PG8_LDB(B1, 0, 1); PG8_SCHED; PG8_LDA(At, 0, 0); PG8_STAGE(PG8_SA(1, 1), a1 + hstepA, voffA);
            PG8_WAIT_V(8); PG8_WAIT_L(0); PG8_BAR; PG8_MMA(0, 0, At, B0); PG8_MMA(0, 1, At, B1); PG8_BAR; PG8_SCHED;
            PG8_LDA(At, 0, 1); PG8_STAGE(PG8_SB(0, 0), b2, voffB); PG8_STAGE(PG8_SB(0, 1), b2 + hstep, voffB); PG8_STAGE(PG8_SA(0, 0), a2, voffA);
            PG8_WAIT_V(8); PG8_WAIT_L(0); PG8_BAR; PG8_MMA(1, 0, At, B0); PG8_MMA(1, 1, At, B1); PG8_BAR; PG8_SCHED;
            PG8_LDB(B0, 1, 0); PG8_LDB(B1, 1, 1); PG8_SCHED; PG8_LDA(At, 1, 0); PG8_STAGE(PG8_SA(0, 1), a2 + hstepA, voffA);
            PG8_WAIT_V(8); PG8_WAIT_L(0); PG8_BAR; PG8_MMA(0, 0, At, B0); PG8_MMA(0, 1, At, B1); PG8_BAR; PG8_SCHED;
            PG8_LDA(At, 1, 1); PG8_STAGE(PG8_SB(1, 0), b3, voffB); PG8_STAGE(PG8_SB(1, 1), b3 + hstep, voffB); PG8_STAGE(PG8_SA(1, 0), a3, voffA);
            PG8_WAIT_V(8); PG8_WAIT_L(0); PG8_BAR; PG8_MMA(1, 0, At, B0); PG8_MMA(1, 1, At, B1); PG8_BAR; PG8_SCHED;
            } else {
            PG8_LDB(B0, 0, 0); PG8_SCHED; PG8_LDA(At, 0, 0); PG8_STAGE(PG8_SA(1, 1), a1 + hstepA, voffA);
            PG8_WAIT_L(8); PG8_BAR; PG8_WAIT_L(0); PG8_MMA(0, 0, At, B0); PG8_BAR; PG8_SCHED;
            PG8_LDB(B1, 0, 1); PG8_STAGE(PG8_SB(0, 0), b2, voffB);
            PG8_BAR; PG8_WAIT_L(0); PG8_MMA(0, 1, At, B1); PG8_BAR;
            PG8_LDA(At, 0, 1); PG8_STAGE(PG8_SA(0, 0), a2, voffA);
            PG8_BAR; PG8_WAIT_L(0); PG8_MMA(1, 0, At, B0); PG8_BAR; PG8_SCHED;
            PG8_STAGE(PG8_SB(0, 1), b2 + hstep, voffB);
            PG8_WAIT_V(6); PG8_BAR; PG8_MMA(1, 1, At, B1); PG8_BAR;
            PG8_LDB(B0, 1, 0); PG8_SCHED; PG8_LDA(At, 1, 0); PG8_STAGE(PG8_SA(0, 1), a2 + hstepA, voffA);
            PG8_WAIT_L(8); PG8_BAR; PG8_WAIT_L(0); PG8_MMA(0, 0, At, B0); PG8_BAR; PG8_SCHED;
            PG8_LDB(B1, 1, 1); PG8_STAGE(PG8_SB(1, 0), b3, voffB);
            PG8_BAR; PG8_WAIT_L(0); PG8_MMA(0, 1, At, B1); PG8_BAR;
            PG8_LDA(At, 1, 1); PG8_STAGE(PG8_SA(1, 0), a3, voffA);
            PG8_BAR; PG8_WAIT_L(0); PG8_MMA(1, 0, At, B0); PG8_BAR; PG8_SCHED;
            PG8_STAGE(PG8_SB(1, 1), b3 + hstep, voffB);
            PG8_WAIT_V(6); PG8_BAR; PG8_MMA(1, 1, At, B1); PG8_BAR;
            }
        }
        if constexpr (ALIGN_EPI) { if (wr == 0) PG8_BAR; }
        if constexpr (!Epi::AFTER_DRAIN) { E(acc, cur, wr, wc, fr, fq); S.done(cur); }
        if (!has_next) break;
#pragma unroll
        for (int a = 0; a < 2; ++a)
#pragma unroll
            for (int b = 0; b < 2; ++b)
#pragma unroll
                for (int m = 0; m < 4; ++m)
#pragma unroll
                    for (int n = 0; n < 2; ++n) acc[a][b][m][n] = (f32x4){0.f, 0.f, 0.f, 0.f};
        cur = nxt; cA = nA; cB = nB; ++ui;
        if constexpr (ALIGN_EPI) { if (wr == 1) PG8_BAR; }
    }
    PG8_WAIT_V(0);
    if constexpr (!ALIGN_EPI) { if (wr == 0) PG8_BAR; }
    PG8_BAR;
    if constexpr (Epi::AFTER_DRAIN) { E.fused(acc, cur, wr, wc, fr, fq, lds, wid, lane); S.done(cur); }
#undef PG8_SA
#undef PG8_SB
#undef PG8_STAGE
#undef PG8_LDA
#undef PG8_LDB
#undef PG8_MMA
#undef PG8_WAIT_V
#undef PG8_WAIT_L
#undef PG8_BAR
#undef PG8_SCHED
}
}

#ifndef S5_SIMPLE
#define S5_SIMPLE 0
#endif
#ifndef HG_SIMPLE
#define HG_SIMPLE 0
#endif
#ifndef REP0
#define REP0 1
#define REP1 1
#define REP2 1
#define REP3 1
#define REP4 1
#define REP6 1
#endif
#ifndef REP_S5
#define REP_S5 1
#endif
#ifndef REP_HGA
#define REP_HGA 1
#endif
#ifndef REP_HGC
#define REP_HGC 1
#endif
#ifndef REP_P1
#define REP_P1 1
#endif
#ifndef REP_P6
#define REP_P6 1
#endif
#ifndef REP_P0
#define REP_P0 1
#endif
#ifndef REP_GLU
#define REP_GLU 1
#endif
#ifndef REP_P3
#define REP_P3 1
#endif
#ifndef REP_P5
#define REP_P5 1
#endif
#ifndef REP_P7
#define REP_P7 1
#endif
#ifndef REP_BAR
#define REP_BAR 1
#endif
#ifndef REP_XN
#define REP_XN 1
#endif
#ifndef P6_ALIGN
#define P6_ALIGN true
#endif
#ifndef P6_SP2
#define P6_SP2 true
#endif
#ifndef MK_N_LAUNCHES
#define MK_N_LAUNCHES 1
#endif
constexpr int DM = 1024, PB_B = 8, PB_T = 2048, SB_B = 128, SB_T = 8;
constexpr int MP = PB_B * PB_T, MS = SB_B * SB_T, MTOK = MP + MS;
constexpr int S5W = 512, S5G = 32, S5C = 16, S5N = 64;
constexpr int HGW = 512, HD = 128, HH = 4;
constexpr int INC = 2560, DFF = 2816;
constexpr float EPS = 1e-6f;
constexpr int NPH = 8;
constexpr size_t O_Y = 0, O_PRE = (size_t)MTOK * DM, O_PIM = O_PRE + 16384, O_PHG = O_PIM + 16384, O_SRE = O_PHG + 524288, O_SIM = O_SRE + 262144, O_SHG = O_SIM + 262144;
constexpr size_t MiB = 1u << 20;
constexpr size_t WS_CTL = 0, WS_WIN = 2 * MiB, WS_WGLU = 7 * MiB, WS_WOUT = 8 * MiB, WS_WGU = 10 * MiB, WS_WD = 21 * MiB;
constexpr size_t WS_XN = 27 * MiB, WS_PB = 61 * MiB, WS_FZ = 129 * MiB, WS_ACT = 61 * MiB, WS_GY = 163 * MiB, WS_OH = 180 * MiB, WS_MIX = 197 * MiB, WS_END = 234 * MiB;
constexpr int PBW = 2048;
constexpr int LDS_BYTES = 147456;
constexpr int NWAVES = 8;
constexpr int CW_SS1 = 16384, CW_SS2 = 36864, CW_CNT = 57344, CW_CNTS = 61440;

#define GAS __attribute__((address_space(1)))
#define LAS __attribute__((address_space(3)))
typedef unsigned short bf16;
typedef unsigned v4u __attribute__((ext_vector_type(4)));
typedef unsigned v2u __attribute__((ext_vector_type(2)));
typedef float f32x4 __attribute__((ext_vector_type(4)));
#define LDS_WAIT() asm volatile("s_waitcnt lgkmcnt(0)" ::: "memory")
__device__ __forceinline__ unsigned f2bf(float f) { unsigned u = __builtin_bit_cast(unsigned, f); return (u + 0x7fffu + ((u >> 16) & 1u)) >> 16; }
__device__ __forceinline__ unsigned pk2(float lo, float hi) { return f2bf(lo) | (f2bf(hi) << 16); }
__device__ __forceinline__ float bf2f(unsigned short h) { return __builtin_bit_cast(float, (unsigned)h << 16); }
__device__ __forceinline__ float bflo(unsigned w) { return __builtin_bit_cast(float, w << 16); }
__device__ __forceinline__ float bfhi(unsigned w) { return __builtin_bit_cast(float, w & 0xffff0000u); }
__device__ __forceinline__ float sigmoidf_(float x) { return __builtin_amdgcn_rcpf(1.0f + __builtin_amdgcn_exp2f(-1.4426950408889634f * x)); }
__device__ __forceinline__ float siluf_(float x) { return x * __builtin_amdgcn_rcpf(1.0f + __builtin_amdgcn_exp2f(-1.4426950408889634f * x)); }
__device__ __forceinline__ float gelu_tanh(float x) { const float z = -2.302208198144325f * (x + 0.044715f * x * x * x); return x * __builtin_amdgcn_rcpf(1.0f + __builtin_amdgcn_exp2f(z)); }
__device__ __forceinline__ float wave_sum(float v) {
#pragma unroll
    for (int o = 1; o < 64; o <<= 1) v += __shfl_xor(v, o);
    return v;
}

struct Args { const float* in[24]; float* out; unsigned char* ws; int ph_lo, ph_hi; };

struct Frame {
    LAS unsigned char* lds;
    int tid, lane, wave, G, bid;
    const float* in[24];
    float* out; unsigned char* ws;
};
__device__ __forceinline__ const float* xrow(const Frame& F, int m) { return m < MP ? F.in[0] + (size_t)m * DM : F.in[1] + (size_t)(m - MP) * DM; }

__device__ __forceinline__ void transpose_item(const float* W, int ldw, bf16* WT, int K, int k0, int sn0, int dn0, int lane, const float* kgain = nullptr) {
    const int k = k0 + 4 * (lane & 15), nl = 4 * (lane >> 4);
    f32x4 r[4][4];
#pragma unroll
    for (int nb = 0; nb < 4; ++nb)
#pragma unroll
        for (int j = 0; j < 4; ++j) r[nb][j] = *(const GAS f32x4*)(W + (size_t)(k + j) * ldw + sn0 + nl + 16 * nb);
    f32x4 g = {1.f, 1.f, 1.f, 1.f}; if (kgain) g = *(const GAS f32x4*)(kgain + k);
#pragma unroll
    for (int nb = 0; nb < 4; ++nb) { const f32x4 a = r[nb][0] * g.x, b = r[nb][1] * g.y, c = r[nb][2] * g.z, d = r[nb][3] * g.w;
        bf16* o = WT + (size_t)(dn0 + nl + 16 * nb) * K + k;
        v2u w; w.x = pk2(a.x, b.x); w.y = pk2(c.x, d.x); *(GAS v2u*)o = w;
        w.x = pk2(a.y, b.y); w.y = pk2(c.y, d.y); *(GAS v2u*)(o + K) = w;
        w.x = pk2(a.z, b.z); w.y = pk2(c.z, d.z); *(GAS v2u*)(o + 2 * (size_t)K) = w;
        w.x = pk2(a.w, b.w); w.y = pk2(c.w, d.w); *(GAS v2u*)(o + 3 * (size_t)K) = w; }
}
__device__ __forceinline__ void rms_row4_bf16(const float* x0_, const float* gain, bf16* o0, int lane) {
    f32x4 v[4][4]; float s[4];
#pragma unroll
    for (int r = 0; r < 4; ++r)
#pragma unroll
        for (int j = 0; j < 4; ++j) v[r][j] = ((const GAS f32x4*)(x0_ + (size_t)r * DM))[lane + 64 * j];
#pragma unroll
    for (int r = 0; r < 4; ++r) { s[r] = 0.f;
#pragma unroll
        for (int j = 0; j < 4; ++j) s[r] += (v[r][j].x * v[r][j].x + v[r][j].y * v[r][j].y) + (v[r][j].z * v[r][j].z + v[r][j].w * v[r][j].w); }
#pragma unroll
    for (int o = 1; o < 64; o <<= 1) { s[0] += __shfl_xor(s[0], o); s[1] += __shfl_xor(s[1], o); s[2] += __shfl_xor(s[2], o); s[3] += __shfl_xor(s[3], o); }
#pragma unroll
    for (int j = 0; j < 4; ++j) { const f32x4 g = ((const GAS f32x4*)gain)[lane + 64 * j];
#pragma unroll
        for (int r = 0; r < 4; ++r) { const float rs = 1.0f / sqrtf(s[r] * (1.0f / DM) + EPS);
            v2u w; w.x = pk2(v[r][j].x * rs * g.x, v[r][j].y * rs * g.y); w.y = pk2(v[r][j].z * rs * g.z, v[r][j].w * rs * g.w); ((GAS v2u*)(o0 + (size_t)r * DM))[lane + 64 * j] = w; } }
}

__device__ __forceinline__ void s5_tables_item(Frame& F, int item);
__device__ __forceinline__ void p0_prologue(Frame& F) {
    const int gw = F.bid * NWAVES + F.wave, NGW = F.G * NWAVES;
    bf16* XN = (bf16*)(F.ws + WS_XN);
    for (int m = 4 * gw; m < MTOK; m += 4 * NGW) rms_row4_bf16(xrow(F, m), F.in[6], XN + (size_t)m * DM, F.lane);
#if REP_XN == 2
    for (int m = 4 * gw; m < MTOK; m += 4 * NGW) rms_row4_bf16(xrow(F, m), F.in[6], XN + (size_t)m * DM, F.lane);
#endif
    bf16* WinT = (bf16*)(F.ws + WS_WIN);
    constexpr int I_IN = (DM / 64) * (INC / 64);
    for (int r = gw; r < I_IN; r += NGW) { const int nblk = INC / 64, kb = r / nblk, nb = r % nblk, sn0 = nb * 64; const int seg = sn0 / 512, off = sn0 % 512;
        const int dseg = seg == 0 ? 0 : seg == 1 ? 1 : seg == 2 ? 4 : seg == 3 ? 2 : 3;
        transpose_item(F.in[7], INC, WinT, DM, kb * 64, sn0, dseg * 512 + off, F.lane); }
    for (int it = F.bid; it < 256; it += F.G) s5_tables_item(F, it);
}

template <int PART> __device__ __forceinline__ void deferred_transposes(Frame& F, int gw, int ngw) {
    bf16* WgluT = (bf16*)(F.ws + WS_WGLU); bf16* WoutT = (bf16*)(F.ws + WS_WOUT); bf16* WguT = (bf16*)(F.ws + WS_WGU); bf16* WdT = (bf16*)(F.ws + WS_WD);
    constexpr int I_GLU = (S5W / 64) * (S5W / 64), I_OUT = (DM / 64) * (DM / 64), I_G = (DM / 64) * (DFF / 64), I_D = (DFF / 64) * (DM / 64);
    constexpr int N0 = I_GLU + I_OUT + 2 * I_G, NITEMS = (PART == 0) ? N0 : I_D;
    for (int it = gw; it < NITEMS; it += ngw) {
        int r = (PART == 0) ? it : it + N0;
        if (r < I_GLU) { const int nblk = S5W / 64, kb = r / nblk, nb = r % nblk; transpose_item(F.in[16], S5W, WgluT, S5W, kb * 64, nb * 64, nb * 64, F.lane); continue; } r -= I_GLU;
        if (r < I_OUT) { const int nblk = DM / 64, kb = r / nblk, nb = r % nblk; transpose_item(F.in[18], DM, WoutT, DM, kb * 64, nb * 64, nb * 64, F.lane); continue; } r -= I_OUT;
        if (r < I_G) { const int nblk = DFF / 64, kb = r / nblk, nb = r % nblk, sn0 = nb * 64; transpose_item(F.in[20], DFF, WguT, DM, kb * 64, sn0, 256 * (sn0 / 128) + (sn0 % 128), F.lane, F.in[19]); continue; } r -= I_G;
        if (r < I_G) { const int nblk = DFF / 64, kb = r / nblk, nb = r % nblk, sn0 = nb * 64; transpose_item(F.in[21], DFF, WguT, DM, kb * 64, sn0, 256 * (sn0 / 128) + 128 + (sn0 % 128), F.lane, F.in[19]); continue; } r -= I_G;
        { const int nblk = DM / 64, kb = r / nblk, nb = r % nblk; transpose_item(F.in[22], DM, WdT, DFF, kb * 64, nb * 64, nb * 64, F.lane); }
    }
}

using pg8::Unit; using pg8::u32x4; using pg8::cvt_pk_bf16; using pg8::BM; using pg8::HALF;
struct EpiIn {
    static constexpr bool PERM = true, AFTER_DRAIN = false;
    bf16* PB; float* FZ; bf16* U5;
    __device__ __forceinline__ void operator()(const pg8::f32x4 (&acc)[2][2][4][2], const Unit& u, int wr, int wc, int fr, int fq) const {
        const int row0 = u.pm * BM + wr * 64 + fr;
        if (u.pn < 2) { const int col0 = u.pn * BM + wc * 32 + 8 * fq;
#pragma unroll
            for (int ai = 0; ai < 2; ++ai)
#pragma unroll
                for (int m = 0; m < 4; ++m) { const size_t r = (size_t)(row0 + ai * HALF + m * 16);
#pragma unroll
                    for (int bj = 0; bj < 2; ++bj) { const int col = col0 + bj * HALF; const pg8::f32x4 v0 = acc[ai][bj][m][0], v1 = acc[ai][bj][m][1]; u32x4 w; w.x = cvt_pk_bf16(v0[0], v0[1]); w.y = cvt_pk_bf16(v0[2], v0[3]); w.z = cvt_pk_bf16(v1[0], v1[1]); w.w = cvt_pk_bf16(v1[2], v1[3]);
                        *(u32x4*)(U5 + ((size_t)(col >> 4) * MTOK + r) * 16 + (col & 15)) = w; } }
        } else if (u.pn < 8) { const int col0 = u.pn * BM + wc * 32 + 8 * fq;
#pragma unroll
            for (int ai = 0; ai < 2; ++ai)
#pragma unroll
                for (int m = 0; m < 4; ++m) { bf16* rowp = PB + (size_t)(row0 + ai * HALF + m * 16) * PBW + col0;
#pragma unroll
                    for (int bj = 0; bj < 2; ++bj) { const pg8::f32x4 v0 = acc[ai][bj][m][0], v1 = acc[ai][bj][m][1]; u32x4 w; w.x = cvt_pk_bf16(v0[0], v0[1]); w.y = cvt_pk_bf16(v0[2], v0[3]); w.z = cvt_pk_bf16(v1[0], v1[1]); w.w = cvt_pk_bf16(v1[2], v1[3]);
                        *(u32x4*)(rowp + bj * HALF) = w; } }
        } else { const int col0 = (u.pn - 8) * BM + wc * 32 + 8 * fq;
#pragma unroll
            for (int ai = 0; ai < 2; ++ai)
#pragma unroll
                for (int m = 0; m < 4; ++m) { float* rowp = FZ + (size_t)(row0 + ai * HALF + m * 16) * 512 + col0;
#pragma unroll
                    for (int bj = 0; bj < 2; ++bj)
#pragma unroll
                        for (int n = 0; n < 2; ++n) *(pg8::f32x4*)(rowp + bj * HALF + 4 * n) = acc[ai][bj][m][n]; }
        }
    }
};
struct EpiGlu {
    static constexpr bool PERM = true, AFTER_DRAIN = false;
    const bf16* GY; bf16* MIX;
    __device__ __forceinline__ void operator()(const pg8::f32x4 (&acc)[2][2][4][2], const Unit& u, int wr, int wc, int fr, int fq) const {
        const int row0 = u.pm * BM + wr * 64 + fr, col0 = u.pn * BM + wc * 32 + 8 * fq;
#pragma unroll
        for (int ai = 0; ai < 2; ++ai)
#pragma unroll
            for (int m = 0; m < 4; ++m) { const size_t r = (size_t)(row0 + ai * HALF + m * 16);
#pragma unroll
                for (int bj = 0; bj < 2; ++bj) { const int col = col0 + bj * HALF; const u32x4 g = *(const u32x4*)(GY + ((size_t)(col >> 4) * MTOK + r) * 16 + (col & 15)); const pg8::f32x4 v0 = acc[ai][bj][m][0], v1 = acc[ai][bj][m][1];
                    u32x4 w; w.x = cvt_pk_bf16(bflo(g.x) * sigmoidf_(v0[0]), bfhi(g.x) * sigmoidf_(v0[1])); w.y = cvt_pk_bf16(bflo(g.y) * sigmoidf_(v0[2]), bfhi(g.y) * sigmoidf_(v0[3]));
                    w.z = cvt_pk_bf16(bflo(g.z) * sigmoidf_(v1[0]), bfhi(g.z) * sigmoidf_(v1[1])); w.w = cvt_pk_bf16(bflo(g.w) * sigmoidf_(v1[2]), bfhi(g.w) * sigmoidf_(v1[3]));
                    *(u32x4*)(MIX + r * DM + col0 + bj * HALF) = w; } }
    }
};
__device__ __forceinline__ float rstd_of(float ss) { return 1.0f / sqrtf(ss * (1.0f / DM) + EPS); }
__device__ __forceinline__ float atomic_read_f32(float* p) { return __hip_atomic_fetch_add(p, 0.0f, __ATOMIC_RELAXED, __HIP_MEMORY_SCOPE_AGENT); }
__device__ __forceinline__ void wait_count(unsigned* cnt, unsigned want) {
    for (unsigned sp = 0; sp < (1u << 22); ++sp) { if (__hip_atomic_load(cnt, __ATOMIC_RELAXED, __HIP_MEMORY_SCOPE_AGENT) >= want) break; __builtin_amdgcn_s_sleep(2); }
}
struct EpiOut {
    static constexpr bool PERM = true, AFTER_DRAIN = false;
    const float* xp; bf16* XN; float* SS1;
    __device__ __forceinline__ void operator()(const pg8::f32x4 (&acc)[2][2][4][2], const Unit& u, int wr, int wc, int fr, int fq) const {
        const int row0 = u.pm * BM + wr * 64 + fr, col0 = u.pn * BM + wc * 32 + 8 * fq;
#pragma unroll
        for (int ai = 0; ai < 2; ++ai)
#pragma unroll
            for (int m = 0; m < 4; ++m) { const int row = row0 + ai * HALF + m * 16; const size_t off = (size_t)row * DM + col0; float ss = 0.f;
#pragma unroll
                for (int bj = 0; bj < 2; ++bj) { const pg8::f32x4 x0 = *(const pg8::f32x4*)(xp + off + bj * HALF) + acc[ai][bj][m][0], x1 = *(const pg8::f32x4*)(xp + off + bj * HALF + 4) + acc[ai][bj][m][1];
                    ss += (x0[0] * x0[0] + x0[1] * x0[1]) + (x0[2] * x0[2] + x0[3] * x0[3]) + (x1[0] * x1[0] + x1[1] * x1[1]) + (x1[2] * x1[2] + x1[3] * x1[3]);
                    u32x4 w; w.x = cvt_pk_bf16(x0[0], x0[1]); w.y = cvt_pk_bf16(x0[2], x0[3]); w.z = cvt_pk_bf16(x1[0], x1[1]); w.w = cvt_pk_bf16(x1[2], x1[3]);
                    *(u32x4*)(XN + off + bj * HALF) = w; }
                ss += __shfl_xor(ss, 16); ss += __shfl_xor(ss, 32);
                if (fq == 0) __hip_atomic_fetch_add(SS1 + row, ss, __ATOMIC_RELAXED, __HIP_MEMORY_SCOPE_AGENT); }
    }
};
struct EpiAct {
    static constexpr bool PERM = true, AFTER_DRAIN = false;
    bf16* ACT; const float* SS1;
    __device__ __forceinline__ void operator()(const pg8::f32x4 (&acc)[2][2][4][2], const Unit& u, int wr, int wc, int fr, int fq) const {
        const int row0 = u.pm * BM + wr * 64 + fr, col0 = u.pn * HALF + wc * 32 + 8 * fq;
#pragma unroll
        for (int ai = 0; ai < 2; ++ai)
#pragma unroll
            for (int m = 0; m < 4; ++m) { const int row = row0 + ai * HALF + m * 16; const float rs = rstd_of(SS1[row]);
                const pg8::f32x4 g0 = acc[ai][0][m][0] * rs, g1 = acc[ai][0][m][1] * rs, u0 = acc[ai][1][m][0] * rs, u1 = acc[ai][1][m][1] * rs;
                u32x4 w; w.x = cvt_pk_bf16(siluf_(g0[0]) * u0[0], siluf_(g0[1]) * u0[1]); w.y = cvt_pk_bf16(siluf_(g0[2]) * u0[2], siluf_(g0[3]) * u0[3]);
                w.z = cvt_pk_bf16(siluf_(g1[0]) * u1[0], siluf_(g1[1]) * u1[1]); w.w = cvt_pk_bf16(siluf_(g1[2]) * u1[2], siluf_(g1[3]) * u1[3]);
                *(u32x4*)(ACT + (size_t)row * DFF + col0) = w; }
    }
};
struct EpiDown {
    static constexpr bool PERM = true, AFTER_DRAIN = false;
    const bf16* X1; const float* gain; float* SS2; unsigned* cnt; float* YO;
    __device__ __forceinline__ void operator()(pg8::f32x4 (&acc)[2][2][4][2], const Unit& u, int wr, int wc, int fr, int fq) const {
        const int row0 = u.pm * BM + wr * 64 + fr, col0 = u.pn * BM + wc * 32 + 8 * fq;
#pragma unroll
        for (int ai = 0; ai < 2; ++ai)
#pragma unroll
            for (int m = 0; m < 4; ++m) { const int row = row0 + ai * HALF + m * 16; const size_t off = (size_t)row * DM + col0; float ss = 0.f;
#pragma unroll
                for (int bj = 0; bj < 2; ++bj) { const u32x4 xb = *(const u32x4*)(X1 + off + bj * HALF);
                    const pg8::f32x4 x0 = (pg8::f32x4){bflo(xb.x), bfhi(xb.x), bflo(xb.y), bfhi(xb.y)} + acc[ai][bj][m][0], x1 = (pg8::f32x4){bflo(xb.z), bfhi(xb.z), bflo(xb.w), bfhi(xb.w)} + acc[ai][bj][m][1];
                    acc[ai][bj][m][0] = x0; acc[ai][bj][m][1] = x1;
                    ss += (x0[0] * x0[0] + x0[1] * x0[1]) + (x0[2] * x0[2] + x0[3] * x0[3]) + (x1[0] * x1[0] + x1[1] * x1[1]) + (x1[2] * x1[2] + x1[3] * x1[3]); }
                ss += __shfl_xor(ss, 16); ss += __shfl_xor(ss, 32);
                if (fq == 0) __hip_atomic_fetch_add(SS2 + row, ss, __ATOMIC_RELAXED, __HIP_MEMORY_SCOPE_AGENT); }
        asm volatile("s_waitcnt vmcnt(0)" ::: "memory");
        unsigned* c = cnt + 64 * u.pm;
        if (threadIdx.x % 64 == 0) __hip_atomic_fetch_add(c, 1u, __ATOMIC_RELAXED, __HIP_MEMORY_SCOPE_AGENT);
        wait_count(c, 32u);
        pg8::f32x4 gn[2][2];
#pragma unroll
        for (int bj = 0; bj < 2; ++bj)
#pragma unroll
            for (int n = 0; n < 2; ++n) gn[bj][n] = *(const pg8::f32x4*)(gain + col0 + bj * HALF + 4 * n);
        float rs[2][4];
#pragma unroll
        for (int ai = 0; ai < 2; ++ai)
#pragma unroll
            for (int m = 0; m < 4; ++m) { float s = 0.f; if (fq == 0) s = atomic_read_f32(SS2 + row0 + ai * HALF + m * 16); rs[ai][m] = rstd_of(__shfl(s, fr)); }
#pragma unroll
        for (int ai = 0; ai < 2; ++ai)
#pragma unroll
            for (int m = 0; m < 4; ++m) { const size_t off = (size_t)(row0 + ai * HALF + m * 16) * DM + col0;
#pragma unroll
                for (int bj = 0; bj < 2; ++bj) { *(pg8::f32x4*)(YO + off + bj * HALF) = acc[ai][bj][m][0] * rs[ai][m] * gn[bj][0]; *(pg8::f32x4*)(YO + off + bj * HALF + 4) = acc[ai][bj][m][1] * rs[ai][m] * gn[bj][1]; } }
    }
};

typedef float f32x16 __attribute__((ext_vector_type(16)));
typedef short s16x8 __attribute__((ext_vector_type(8)));
constexpr size_t WS_U5 = WS_OH, WS_T5 = 231 * MiB;
constexpr size_t T5_STRIDE = 73728, T5_VG = 32768, T5_KC = 65536;
constexpr int S5_LD = 136;
__device__ __forceinline__ void s5_tables_item(Frame& F, int item) {
    const int tid = F.tid, g = item >> 3, part = item & 7;
    LAS float* Pre = (LAS float*)F.lds; LAS float* Pim = Pre + 9 * 64; LAS float* Ff = Pim + 9 * 64;
    LAS float* Cre = Ff + 128, * Cim = Cre + 1024, * Bre = Cim + 1024, * Bim = Bre + 1024;
    if (tid < 64) { const int n = tid;
        const float a_re = F.in[8][g * S5N + n], a_im = F.in[9][g * S5N + n], dt = expf(F.in[10][g]);
        const float mag = expf(a_re * dt), ab_re = mag * cosf(a_im * dt), ab_im = mag * sinf(a_im * dt);
        const float den = a_re * a_re + a_im * a_im, nr = ab_re - 1.0f, ni = ab_im;
        Ff[n] = (nr * a_re + ni * a_im) / den; Ff[64 + n] = (ni * a_re - nr * a_im) / den;
        float pr = 1.f, pi = 0.f;
#pragma unroll
        for (int j = 0; j < 9; ++j) { Pre[j * 64 + n] = pr; Pim[j * 64 + n] = pi; const float t = pr * ab_re - pi * ab_im; pi = pr * ab_im + pi * ab_re; pr = t; }
    }
    __syncthreads();
#pragma unroll
    for (int i = 0; i < 2; ++i) { const int idx = tid + 512 * i;
        { const int c = idx >> 6, n = idx & 63; Cre[c * 64 + n] = F.in[13][(size_t)(g * 16 + c) * S5N + n]; Cim[c * 64 + n] = F.in[14][(size_t)(g * 16 + c) * S5N + n]; }
        { const int n = idx >> 4, c = idx & 15; const float br = F.in[11][(size_t)(g * S5N + n) * 16 + c], bi = F.in[12][(size_t)(g * S5N + n) * 16 + c], fr = Ff[n], fi = Ff[64 + n];
          Bre[n * 16 + c] = fr * br - fi * bi; Bim[n * 16 + c] = fr * bi + fi * br; } }
    __syncthreads();
    bf16* WG = (bf16*)(F.ws + WS_T5 + (size_t)g * T5_STRIDE); bf16* VG = (bf16*)(F.ws + WS_T5 + (size_t)g * T5_STRIDE + T5_VG); bf16* KC = (bf16*)(F.ws + WS_T5 + (size_t)g * T5_STRIDE + T5_KC);
    if (tid < 256) { const int j = part, c = tid >> 4, cp = tid & 15; float acc = 0.f;
#pragma unroll 4
        for (int n = 0; n < 64; ++n) { const float cr = Cre[c * 64 + n], ci = Cim[c * 64 + n], pr = Pre[j * 64 + n], pi = Pim[j * 64 + n];
            const float xr = cr * pr - ci * pi, xi = cr * pi + ci * pr; acc += xr * Bre[n * 16 + cp] - xi * Bim[n * 16 + cp]; }
        KC[j * 256 + tid] = (bf16)f2bf(acc);
    } else if (part == 0) KC[2048 + tid - 256] = 0;
#pragma unroll
    for (int i = 0; i < 4; ++i) { const int idx = tid + 512 * i, np = 16 * part + (idx >> 7), k = idx & 127, s = k >> 4, cp = k & 15, n = np & 63;
        const float pr = Pre[(7 - s) * 64 + n], pi = Pim[(7 - s) * 64 + n], br = Bre[n * 16 + cp], bi = Bim[n * 16 + cp];
        WG[np * 128 + k] = (bf16)f2bf(np < 64 ? pr * br - pi * bi : pr * bi + pi * br); }
#pragma unroll
    for (int i = 0; i < 4; ++i) { const int idx = tid + 512 * i, col = 16 * part + (idx >> 7), np = idx & 127, t = col >> 4, c = col & 15, n = np & 63;
        const float pr = Pre[(t + 1) * 64 + n], pi = Pim[(t + 1) * 64 + n], cr = Cre[c * 64 + n], ci = Cim[c * 64 + n];
        VG[col * 128 + np] = (bf16)f2bf(np < 64 ? cr * pr - ci * pi : -(cr * pi + ci * pr)); }
    __syncthreads();
}
constexpr int L5_WG = 0, L5_VG = 34816, L5_KC = 69632, L5_U = 74240, L5_HS = 91648, L5_HL = 109056, L5_L8 = 141824;
__device__ __forceinline__ void s5_item(Frame& F, int item) {
    const int tid = F.tid, lane = F.lane, wave = F.wave;
    const int g = item & 31, b8 = item >> 5;
    LAS bf16* WgT = (LAS bf16*)(F.lds + L5_WG); LAS bf16* VgT = (LAS bf16*)(F.lds + L5_VG); LAS bf16* Kc = (LAS bf16*)(F.lds + L5_KC);
    LAS bf16* Us = (LAS bf16*)(F.lds + L5_U); LAS bf16* HS = (LAS bf16*)(F.lds + L5_HS); LAS float* HL = (LAS float*)(F.lds + L5_HL); LAS float* L8 = (LAS float*)(F.lds + L5_L8);
    LAS bf16* YS = (LAS bf16*)(F.lds + L5_HL);
    const bf16* U5 = (const bf16*)(F.ws + WS_U5) + (size_t)g * MTOK * 16; bf16* GY = (bf16*)(F.ws + WS_GY) + (size_t)g * MTOK * 16;
    { const bf16* WG = (const bf16*)(F.ws + WS_T5 + (size_t)g * T5_STRIDE); const bf16* VG = WG + T5_VG / 2; const bf16* KC = WG + T5_KC / 2;
#pragma unroll
      for (int i = 0; i < 4; ++i) { const int p = tid + 512 * i, r = p >> 4, kg = (p & 15) * 8; *(LAS v4u*)(WgT + r * S5_LD + kg) = *(const v4u*)(WG + r * 128 + kg); *(LAS v4u*)(VgT + r * S5_LD + kg) = *(const v4u*)(VG + r * 128 + kg); }
      if (tid < 288) *(LAS v4u*)(Kc + tid * 8) = *(const v4u*)(KC + tid * 8); }
    float qr[9], qi[9];
    { const float a_re = F.in[8][g * S5N + lane], a_im = F.in[9][g * S5N + lane], dt = expf(F.in[10][g]);
      const float mag = expf(a_re * dt); float p8r = mag * cosf(a_im * dt), p8i = mag * sinf(a_im * dt);
#pragma unroll
      for (int i = 0; i < 3; ++i) { const float t = p8r * p8r - p8i * p8i; p8i = 2.0f * p8r * p8i; p8r = t; }
      qr[0] = 1.f; qi[0] = 0.f;
#pragma unroll
      for (int i = 1; i < 9; ++i) { qr[i] = qr[i - 1] * p8r - qi[i - 1] * p8i; qi[i] = qr[i - 1] * p8i + qi[i - 1] * p8r; } }
    const float dl = F.in[15][g * 16 + (lane & 15)];
    const int rb = wave >> 2, cb = wave & 3, r32 = lane & 31, hh = lane >> 5;
    float h_re = 0.f, h_im = 0.f;
    float sre[2], sim[2];
#pragma unroll
    for (int i = 0; i < 2; ++i) { const size_t idx = (size_t)((16 * b8 + 2 * wave + i) * S5G + g) * S5N + lane; sre[i] = F.in[2][idx]; sim[i] = F.in[3][idx]; }
    v4u un0, un1;
    { const v4u* src = (const v4u*)(U5 + (size_t)(b8 * PB_T) * 16); un0 = src[tid]; un1 = src[tid + 512]; }
    for (int seg = 0; seg < 5; ++seg) {
        const bool samp = (seg == 4);
        const int tok0 = samp ? MP + 128 * b8 : b8 * PB_T + seg * 512;
        { const int p0 = tid, p1 = tid + 512;
          *(LAS v4u*)(Us + (p0 >> 4) * S5_LD + ((p0 >> 1) & 7) * 16 + (p0 & 1) * 8) = un0; *(LAS v4u*)(Us + (p1 >> 4) * S5_LD + ((p1 >> 1) & 7) * 16 + (p1 & 1) * 8) = un1;
          if (seg < 3) { const v4u* src = (const v4u*)(U5 + (size_t)(b8 * PB_T + (seg + 1) * 512) * 16); un0 = src[tid]; un1 = src[tid + 512]; }
          else if (seg == 3) { const v4u* src = (const v4u*)(U5 + (size_t)(MP + 128 * b8) * 16); if (tid < 256) un0 = src[tid]; } }
        __syncthreads();
        { f32x16 acc = {};
#pragma unroll
          for (int s = 0; s < 8; ++s) { const s16x8 a = *(const LAS s16x8*)(Us + (32 * rb + r32) * S5_LD + s * 16 + 8 * hh); const s16x8 b = *(const LAS s16x8*)(WgT + (32 * cb + r32) * S5_LD + s * 16 + 8 * hh);
              acc = __builtin_amdgcn_mfma_f32_32x32x16_bf16(a, b, acc, 0, 0, 0); }
#pragma unroll
          for (int r = 0; r < 16; ++r) HL[(32 * rb + (r & 3) + 8 * (r >> 2) + 4 * hh) * 128 + 32 * cb + r32] = acc[r]; }
        __syncthreads();
        if (!samp) {
            float xr[8], xi[8], lr[9], li[9];
#pragma unroll
            for (int i = 0; i < 8; ++i) { xr[i] = HL[(8 * wave + i) * 128 + lane]; xi[i] = HL[(8 * wave + i) * 128 + 64 + lane]; }
            lr[0] = 0.f; li[0] = 0.f;
#pragma unroll
            for (int i = 0; i < 8; ++i) { lr[i + 1] = qr[1] * lr[i] - qi[1] * li[i] + xr[i]; li[i + 1] = qr[1] * li[i] + qi[1] * lr[i] + xi[i]; }
            L8[wave * 128 + lane] = lr[8]; L8[wave * 128 + 64 + lane] = li[8];
            __syncthreads();
            float cr = h_re, ci = h_im, mr = h_re, mi = h_im;
#pragma unroll
            for (int w = 0; w < 8; ++w) { const float tr = L8[w * 128 + lane], ti = L8[w * 128 + 64 + lane];
                const float nr = qr[8] * cr - qi[8] * ci + tr, ni = qr[8] * ci + qi[8] * cr + ti; cr = nr; ci = ni; if (w + 1 == wave) { mr = cr; mi = ci; } }
            h_re = cr; h_im = ci;
#pragma unroll
            for (int i = 0; i < 8; ++i) { const float sr = lr[i] + qr[i] * mr - qi[i] * mi, si = li[i] + qr[i] * mi + qi[i] * mr;
                HS[(8 * wave + i) * S5_LD + lane] = (bf16)f2bf(sr); HS[(8 * wave + i) * S5_LD + 64 + lane] = (bf16)f2bf(si); }
            if (seg == 3 && wave == 0) { F.out[O_PRE + (size_t)(b8 * S5G + g) * S5N + lane] = h_re; F.out[O_PIM + (size_t)(b8 * S5G + g) * S5N + lane] = h_im; }
        } else {
#pragma unroll
            for (int i = 0; i < 2; ++i) { const int r = 2 * wave + i; const size_t idx = (size_t)((16 * b8 + r) * S5G + g) * S5N + lane;
                HS[r * S5_LD + lane] = (bf16)f2bf(sre[i]); HS[r * S5_LD + 64 + lane] = (bf16)f2bf(sim[i]);
                F.out[O_SRE + idx] = qr[1] * sre[i] - qi[1] * sim[i] + HL[r * 128 + lane]; F.out[O_SIM + idx] = qr[1] * sim[i] + qi[1] * sre[i] + HL[r * 128 + 64 + lane]; }
        }
        __syncthreads();
        if (!(samp && rb == 1)) { f32x16 acc = {};
            const int tl = 2 * cb + ((lane >> 4) & 1), c = lane & 15;
#pragma unroll
            for (int s = 0; s < 8; ++s) if (s <= 2 * cb + 1) { const int j = tl - s, jj = j < 0 ? 8 : j;
                const s16x8 a = *(const LAS s16x8*)(Us + (32 * rb + r32) * S5_LD + s * 16 + 8 * hh); const s16x8 b = *(const LAS s16x8*)(Kc + (jj * 16 + c) * 16 + 8 * hh);
                acc = __builtin_amdgcn_mfma_f32_32x32x16_bf16(a, b, acc, 0, 0, 0); }
#pragma unroll
            for (int kb = 0; kb < 8; ++kb) { const s16x8 a = *(const LAS s16x8*)(HS + (32 * rb + r32) * S5_LD + kb * 16 + 8 * hh); const s16x8 b = *(const LAS s16x8*)(VgT + (32 * cb + r32) * S5_LD + kb * 16 + 8 * hh);
                acc = __builtin_amdgcn_mfma_f32_32x32x16_bf16(a, b, acc, 0, 0, 0); }
#pragma unroll
            for (int r = 0; r < 16; ++r) { const int row = 32 * rb + (r & 3) + 8 * (r >> 2) + 4 * hh;
                const float u = bf2f(Us[row * S5_LD + tl * 16 + c]); YS[row * 128 + 32 * cb + r32] = (bf16)f2bf(gelu_tanh(acc[r] + dl * u)); }
        }
        __syncthreads();
        { v4u* dst = (v4u*)(GY + (size_t)tok0 * 16);
          if (!samp) { dst[tid] = *(const LAS v4u*)(YS + tid * 8); dst[tid + 512] = *(const LAS v4u*)(YS + (tid + 512) * 8); }
          else if (tid < 256) dst[tid] = *(const LAS v4u*)(YS + tid * 8); }
        __syncthreads();
    }
}
typedef float f32x4v __attribute__((ext_vector_type(4)));
constexpr int HG_LDQ = 136, HG_LDT = 72;
constexpr size_t WS_DSC = WS_XN;
constexpr size_t WS_DEC = WS_CTL + 1 * MiB;
struct HgRaw { float fz[16]; unsigned short q[16]; v4u v0, v1; };
template <bool NEEDQ> __device__ __forceinline__ void hg_load_raw(HgRaw& R, const bf16* PB, const float* FZ, int item, int tid) {
    const int bh = item >> 5, chunk = item & 31, b = bh >> 2, h = bh & 3, tok0 = b * PB_T + chunk * 64, ch = tid & 127, tq = tid >> 7, col = h * HD + ch;
#pragma unroll
    for (int i = 0; i < 16; ++i) { const size_t tok = (size_t)(tok0 + 16 * tq + i); R.fz[i] = FZ[tok * 512 + col]; if (NEEDQ) R.q[i] = PB[tok * PBW + 512 + col]; }
    { const int p = tid, vg = p >> 6, tk = p & 63; R.v0 = *(const v4u*)(PB + (size_t)(tok0 + tk) * PBW + 1024 + h * HD + vg * 8); }
    { const int p = tid + 512, vg = p >> 6, tk = p & 63; R.v1 = *(const v4u*)(PB + (size_t)(tok0 + tk) * PBW + 1024 + h * HD + vg * 8); }
}
#define HG_GATES_R(R) \
    float gl[16], kk[16]; float run = 0.f; \
    _Pragma("unroll") for (int i = 0; i < 16; ++i) { const float sg = __builtin_amdgcn_rcpf(1.0f + __builtin_amdgcn_exp2f(-1.4426950408889634f * R.fz[i])), f = lb + (1.0f - lb) * sg; kk[i] = 1.0f - f; run += __log2f(f); gl[i] = run; } \
    TOT[tq * 128 + ch] = run;
#define HG_VT_STORE(R) \
    { const int vg = tid >> 6, tk = tid & 63; LAS bf16* d = Vt + (vg * 8) * HG_LDT + tk; const v4u w = R.v0; d[0] = (bf16)(w.x & 0xffffu); d[HG_LDT] = (bf16)(w.x >> 16); d[2 * HG_LDT] = (bf16)(w.y & 0xffffu); d[3 * HG_LDT] = (bf16)(w.y >> 16); \
        d[4 * HG_LDT] = (bf16)(w.z & 0xffffu); d[5 * HG_LDT] = (bf16)(w.z >> 16); d[6 * HG_LDT] = (bf16)(w.w & 0xffffu); d[7 * HG_LDT] = (bf16)(w.w >> 16); } \
    { const int vg = (tid + 512) >> 6, tk = tid & 63; LAS bf16* d = Vt + (vg * 8) * HG_LDT + tk; const v4u w = R.v1; d[0] = (bf16)(w.x & 0xffffu); d[HG_LDT] = (bf16)(w.x >> 16); d[2 * HG_LDT] = (bf16)(w.y & 0xffffu); d[3 * HG_LDT] = (bf16)(w.y >> 16); \
        d[4 * HG_LDT] = (bf16)(w.z & 0xffffu); d[5 * HG_LDT] = (bf16)(w.z >> 16); d[6 * HG_LDT] = (bf16)(w.w & 0xffffu); d[7 * HG_LDT] = (bf16)(w.w >> 16); }

constexpr int LA_QS = 0, LA_KS = 17408, LA_KT = 34816, LA_VT = 53248, LA_AT = 71680, LA_TOT = 80896;
constexpr size_t OQ_QH = 0, OQ_OI = 4194304;
__device__ __forceinline__ void hgA_loop(Frame& F) {
    const int tid = F.tid, lane = F.lane, wave = F.wave;
    LAS bf16* Qs = (LAS bf16*)(F.lds + LA_QS); LAS bf16* Ks = (LAS bf16*)(F.lds + LA_KS); LAS bf16* Kt = (LAS bf16*)(F.lds + LA_KT); LAS bf16* Vt = (LAS bf16*)(F.lds + LA_VT);
    LAS bf16* At = (LAS bf16*)(F.lds + LA_AT); LAS float* TOT = (LAS float*)(F.lds + LA_TOT);
    const bf16* PB = (const bf16*)(F.ws + WS_PB); const float* FZ = (const float*)(F.ws + WS_FZ);
    const int ch = tid & 127, tq = tid >> 7, r32 = lane & 31, hh = lane >> 5;
    int item = F.bid; if (item >= 1024) return;
    HgRaw R; hg_load_raw<true>(R, PB, FZ, item, tid);
    for (; item < 1024; item += F.G) {
        const int bh = item >> 5, h = bh & 3, col = h * HD + ch;
        bf16* DSC = (bf16*)(F.ws + WS_DSC) + (size_t)item * HD * HD; float* DEC = (float*)(F.ws + WS_DEC) + (size_t)item * HD;
        bf16* QH = (bf16*)(F.out + O_Y + OQ_QH) + (size_t)item * 64 * HD; bf16* OI = (bf16*)(F.out + O_Y + OQ_OI) + (size_t)item * 8192;
        const float lb = 1.0f / (1.0f + __expf(F.in[5][512 + col] - F.in[5][col]));
        HG_GATES_R(R)
        float qq[16];
#pragma unroll
        for (int i = 0; i < 16; ++i) qq[i] = bf2f(R.q[i]);
        HG_VT_STORE(R)
        if (item + F.G < 1024) hg_load_raw<true>(R, PB, FZ, item + F.G, tid);
        __syncthreads();
        { const float t0 = TOT[ch], t1 = TOT[128 + ch], t2 = TOT[256 + ch], t3 = TOT[384 + ch];
          const float gref = t0 + t1, glast = gref + (t2 + t3), off = (tq == 0 ? 0.f : tq == 1 ? t0 : tq == 2 ? gref : gref + t2);
          const float cS = __builtin_amdgcn_exp2f(gref), cK = __builtin_amdgcn_exp2f(glast - gref);
          unsigned kp[8];
#pragma unroll
          for (int i = 0; i < 16; ++i) { const float e1 = __builtin_amdgcn_exp2f(off + gl[i] - gref), e2 = __builtin_amdgcn_rcpf(e1), qs = qq[i] * e1, ks = kk[i] * e2;
              Qs[(16 * tq + i) * HG_LDQ + ch] = (bf16)f2bf(qs); Ks[(16 * tq + i) * HG_LDQ + ch] = (bf16)f2bf(ks);
              QH[(size_t)(16 * tq + i) * HD + ch] = (bf16)f2bf(qs * cS);
              const unsigned kb = f2bf(ks * cK); if (i & 1) kp[i >> 1] |= kb << 16; else kp[i >> 1] = kb; }
          LAS v4u* kd = (LAS v4u*)(Kt + ch * HG_LDT + 16 * tq); v4u a, c2; a.x = kp[0]; a.y = kp[1]; a.z = kp[2]; a.w = kp[3]; c2.x = kp[4]; c2.y = kp[5]; c2.z = kp[6]; c2.w = kp[7]; kd[0] = a; kd[1] = c2;
          if (tq == 0) DEC[ch] = cS * cK; }
        __syncthreads();
        if (wave < 4) { const int tb = wave >> 1, sb = wave & 1; f32x16 acc = {};
            if (sb <= tb) {
#pragma unroll
                for (int ks = 0; ks < 8; ++ks) { const s16x8 a = *(const LAS s16x8*)(Qs + (32 * tb + r32) * HG_LDQ + 16 * ks + 8 * hh); const s16x8 bb = *(const LAS s16x8*)(Ks + (32 * sb + r32) * HG_LDQ + 16 * ks + 8 * hh);
                    acc = __builtin_amdgcn_mfma_f32_32x32x16_bf16(a, bb, acc, 0, 0, 0); } }
            const int s = 32 * sb + r32;
#pragma unroll
            for (int r = 0; r < 16; ++r) { const int t = 32 * tb + (r & 3) + 8 * (r >> 2) + 4 * hh; At[t * HG_LDT + s] = (s <= t) ? (bf16)f2bf(acc[r]) : (bf16)0; } }
        { const int kb = wave >> 1;
#pragma unroll
          for (int vbi = 0; vbi < 2; ++vbi) { const int vb = 2 * (wave & 1) + vbi; f32x16 acc = {};
#pragma unroll
              for (int ks = 0; ks < 4; ++ks) { const s16x8 a = *(const LAS s16x8*)(Kt + (32 * kb + r32) * HG_LDT + 16 * ks + 8 * hh); const s16x8 bb = *(const LAS s16x8*)(Vt + (32 * vb + r32) * HG_LDT + 16 * ks + 8 * hh);
                  acc = __builtin_amdgcn_mfma_f32_32x32x16_bf16(a, bb, acc, 0, 0, 0); }
              bf16* dst = DSC + (size_t)(32 * vb + r32) * HD + 32 * kb + 4 * hh;
#pragma unroll
              for (int q = 0; q < 4; ++q) { v2u w; w.x = pk2(acc[4 * q], acc[4 * q + 1]); w.y = pk2(acc[4 * q + 2], acc[4 * q + 3]); *(v2u*)(dst + 8 * q) = w; } } }
        __syncthreads();
        { const int tb = wave >> 2, vb = wave & 3, t = 32 * tb + r32; f32x16 acc = {};
#pragma unroll
          for (int ks = 0; ks < 4; ++ks) if (ks < 2 * tb + 2) { const s16x8 a = *(const LAS s16x8*)(Vt + (32 * vb + r32) * HG_LDT + 16 * ks + 8 * hh); const s16x8 bb = *(const LAS s16x8*)(At + t * HG_LDT + 16 * ks + 8 * hh);
              acc = __builtin_amdgcn_mfma_f32_32x32x16_bf16(a, bb, acc, 0, 0, 0); }
          v4u w0, w1; w0.x = pk2(acc[0], acc[1]); w0.y = pk2(acc[2], acc[3]); w0.z = pk2(acc[4], acc[5]); w0.w = pk2(acc[6], acc[7]); w1.x = pk2(acc[8], acc[9]); w1.y = pk2(acc[10], acc[11]); w1.z = pk2(acc[12], acc[13]); w1.w = pk2(acc[14], acc[15]);
          v4u* d = (v4u*)(OI + (size_t)(wave * 64 + lane) * 16); d[0] = w0; d[1] = w1; }
        __syncthreads();
    }
}
__device__ __forceinline__ void hg_scan(Frame& F, bf16* DSO, int sb, int nsb) {
    bf16* DSC = (bf16*)(F.ws + WS_DSC); const float* DEC = (const float*)(F.ws + WS_DEC);
    LAS float* DL = (LAS float*)F.lds;
    for (int T0 = sb * 512; T0 < 32 * 4096; T0 += nsb * 512) {
        const int T = T0 + F.tid, bh = T0 >> 12, e = T & 4095, v = e >> 5, k4 = (e & 31) * 4;
        v2u x[32];
#pragma unroll
        for (int c = 0; c < 32; ++c) x[c] = *(const v2u*)(DSC + ((size_t)(bh * 32 + c) * HD + v) * HD + k4);
#pragma unroll
        for (int i = 0; i < 2; ++i) { const int p = F.tid + 512 * i; *(LAS f32x4*)(DL + p * 4) = *(const f32x4*)(DEC + (size_t)bh * 32 * HD + p * 4); }
        __syncthreads();
        f32x4 S = {0.f, 0.f, 0.f, 0.f};
#pragma unroll
        for (int c = 0; c < 32; ++c) { const f32x4 d = *(const LAS f32x4*)(DL + c * HD + k4);
            v2u o; o.x = pk2(S.x, S.y); o.y = pk2(S.z, S.w); *(v2u*)(DSO + ((size_t)(bh * 32 + c) * HD + v) * HD + k4) = o;
            S.x = d.x * S.x + bflo(x[c].x); S.y = d.y * S.y + bfhi(x[c].x); S.z = d.z * S.z + bflo(x[c].y); S.w = d.w * S.w + bfhi(x[c].y); }
        float* o = F.out + O_PHG + (size_t)bh * HD * HD + (size_t)k4 * HD + v;
        o[0] = S.x; o[HD] = S.y; o[2 * HD] = S.z; o[3 * HD] = S.w;
        __syncthreads();
    }
}
constexpr int LC_SC = 0, LC_QH = 34816, LC_SS = 52224, LC_SLOT = 53248;
__device__ __forceinline__ void hgC_loop(Frame& F, unsigned* ctr) {
    const int tid = F.tid, lane = F.lane, wave = F.wave;
    LAS bf16* SC = (LAS bf16*)(F.lds + LC_SC); LAS bf16* Qh = (LAS bf16*)(F.lds + LC_QH); LAS float* SS = (LAS float*)(F.lds + LC_SS);
    volatile LAS int* slot = (volatile LAS int*)(F.lds + LC_SLOT);
    const bf16* PB = (const bf16*)(F.ws + WS_PB); bf16* MIX = (bf16*)(F.ws + WS_MIX);
    const int r32 = lane & 31, hh = lane >> 5, tb = wave >> 2, vb = wave & 3, t = 32 * tb + r32;
    if (tid == 0) { slot[0] = (int)__hip_atomic_fetch_add(ctr, 1u, __ATOMIC_RELAXED, __HIP_MEMORY_SCOPE_AGENT); slot[1] = (int)__hip_atomic_fetch_add(ctr, 1u, __ATOMIC_RELAXED, __HIP_MEMORY_SCOPE_AGENT); }
    __syncthreads();
    int item = slot[0], nxt = slot[1], par = 0;
    if (item >= 1024) return;
    v4u sc[4], qh[2], oi[2]; v2u og[4];
#define HGC_FETCH(IT) do { const int it_ = (IT); const bf16* DSC = (const bf16*)(F.ws + WS_DSC) + (size_t)it_ * HD * HD; const bf16* QH = (const bf16*)(F.out + O_Y + OQ_QH) + (size_t)it_ * 64 * HD; \
        const bf16* OI = (const bf16*)(F.out + O_Y + OQ_OI) + (size_t)it_ * 8192; const int bh_ = it_ >> 5, tok0_ = (bh_ >> 2) * PB_T + (it_ & 31) * 64, h_ = bh_ & 3; \
        _Pragma("unroll") for (int i = 0; i < 4; ++i) { const int p = tid + 512 * i; sc[i] = *(const v4u*)(DSC + (size_t)(p >> 4) * HD + (p & 15) * 8); } \
        _Pragma("unroll") for (int i = 0; i < 2; ++i) { const int p = tid + 512 * i; qh[i] = *(const v4u*)(QH + (size_t)(p >> 4) * HD + (p & 15) * 8); } \
        oi[0] = *(const v4u*)(OI + (size_t)(wave * 64 + lane) * 16); oi[1] = *(const v4u*)(OI + (size_t)(wave * 64 + lane) * 16 + 8); \
        _Pragma("unroll") for (int q = 0; q < 4; ++q) og[q] = *(const v2u*)(PB + (size_t)(tok0_ + t) * PBW + 1536 + h_ * HD + 32 * vb + 8 * q + 4 * hh); } while (0)
    HGC_FETCH(item);
    for (;;) {
        const int bh = item >> 5, chunk = item & 31, b = bh >> 2, h = bh & 3, tok0 = b * PB_T + chunk * 64;
#pragma unroll
        for (int i = 0; i < 4; ++i) { const int p = tid + 512 * i; *(LAS v4u*)(SC + (p >> 4) * HG_LDQ + (p & 15) * 8) = sc[i]; }
#pragma unroll
        for (int i = 0; i < 2; ++i) { const int p = tid + 512 * i; *(LAS v4u*)(Qh + (p >> 4) * HG_LDQ + (p & 15) * 8) = qh[i]; }
        f32x16 acc;
        acc[0] = bflo(oi[0].x); acc[1] = bfhi(oi[0].x); acc[2] = bflo(oi[0].y); acc[3] = bfhi(oi[0].y); acc[4] = bflo(oi[0].z); acc[5] = bfhi(oi[0].z); acc[6] = bflo(oi[0].w); acc[7] = bfhi(oi[0].w);
        acc[8] = bflo(oi[1].x); acc[9] = bfhi(oi[1].x); acc[10] = bflo(oi[1].y); acc[11] = bfhi(oi[1].y); acc[12] = bflo(oi[1].z); acc[13] = bfhi(oi[1].z); acc[14] = bflo(oi[1].w); acc[15] = bfhi(oi[1].w);
        v2u ogc[4];
#pragma unroll
        for (int q = 0; q < 4; ++q) ogc[q] = og[q];
        if (tid == 0) slot[par] = (int)__hip_atomic_fetch_add(ctr, 1u, __ATOMIC_RELAXED, __HIP_MEMORY_SCOPE_AGENT);
        if (nxt < 1024) HGC_FETCH(nxt);
        __syncthreads();
        const int nn = slot[par];
#pragma unroll
        for (int ks = 0; ks < 8; ++ks) { const s16x8 a = *(const LAS s16x8*)(SC + (32 * vb + r32) * HG_LDQ + 16 * ks + 8 * hh); const s16x8 bb = *(const LAS s16x8*)(Qh + t * HG_LDQ + 16 * ks + 8 * hh);
            acc = __builtin_amdgcn_mfma_f32_32x32x16_bf16(a, bb, acc, 0, 0, 0); }
        { float ss = 0.f;
#pragma unroll
          for (int r = 0; r < 16; ++r) ss += acc[r] * acc[r];
          ss += __shfl_xor(ss, 32);
          if (hh == 0) SS[t * 4 + vb] = ss; }
        __syncthreads();
        { const f32x4 s4 = *(const LAS f32x4*)(SS + t * 4); const float rstd = 1.0f / sqrtf(((s4.x + s4.y) + (s4.z + s4.w)) * (1.0f / HD) + EPS);
#pragma unroll
          for (int q = 0; q < 4; ++q) { const int v0 = 32 * vb + 8 * q + 4 * hh; const f32x4 gn = *(const GAS f32x4*)(F.in[17] + v0);
              v2u w; w.x = pk2(acc[4 * q] * rstd * gn.x * siluf_(bflo(ogc[q].x)), acc[4 * q + 1] * rstd * gn.y * siluf_(bfhi(ogc[q].x)));
              w.y = pk2(acc[4 * q + 2] * rstd * gn.z * siluf_(bflo(ogc[q].y)), acc[4 * q + 3] * rstd * gn.w * siluf_(bfhi(ogc[q].y)));
              *(v2u*)(MIX + (size_t)(tok0 + t) * DM + 512 + h * HD + v0) = w; } }
        __syncthreads();
        if (nxt >= 1024) break;
        item = nxt; nxt = nn; par ^= 1;
    }
#undef HGC_FETCH
}
constexpr int LX_Q = 0, LX_K2 = 4096, LX_K3 = 8192, LX_V = 12288, LX_DEC = 16384, LX_ATT = 16896, LX_OP = 17152, LX_OT = 33536;
__device__ __forceinline__ void hgrn_sample_item(Frame& F, int idx) {
    const int tid = F.tid, b = idx >> 2, h = idx & 3;
    LAS float* Qs = (LAS float*)(F.lds + LX_Q); LAS float* K2 = (LAS float*)(F.lds + LX_K2); LAS float* K3 = (LAS float*)(F.lds + LX_K3); LAS float* Vs = (LAS float*)(F.lds + LX_V);
    LAS float* DEC = (LAS float*)(F.lds + LX_DEC); LAS float* ATT = (LAS float*)(F.lds + LX_ATT); LAS float* OP = (LAS float*)(F.lds + LX_OP); LAS float* OT = (LAS float*)(F.lds + LX_OT);
    const bf16* PB = (const bf16*)(F.ws + WS_PB); const float* FZ = (const float*)(F.ws + WS_FZ); bf16* MIX = (bf16*)(F.ws + WS_MIX);
    const float* S0 = F.in[4] + (size_t)idx * HD * HD; float* Sout = F.out + O_SHG + (size_t)idx * HD * HD;
    const int tok0 = MP + b * SB_T;
    const int v = tid & 127, kq = tid >> 7;
    float s0[32];
#pragma unroll
    for (int j = 0; j < 32; ++j) s0[j] = S0[(size_t)(32 * kq + j) * HD + v];
    if (tid < 128) { const int col = h * HD + tid; const float lb = 1.0f / (1.0f + expf(F.in[5][512 + col] - F.in[5][col]));
        float gl[8], kk[8], qq[8]; float run = 0.f;
#pragma unroll
        for (int t = 0; t < 8; ++t) { const size_t tok = (size_t)(tok0 + t); const float fz = FZ[tok * 512 + col]; qq[t] = bf2f(PB[tok * PBW + 512 + col]);
            const float sg = 1.0f / (1.0f + __expf(-fz)), f = lb + (1.0f - lb) * sg; kk[t] = 1.0f - f; run += __log2f(f); gl[t] = run; }
#pragma unroll
        for (int t = 0; t < 8; ++t) { Qs[t * 128 + tid] = qq[t] * __builtin_amdgcn_exp2f(gl[t]); K2[t * 128 + tid] = kk[t] * __builtin_amdgcn_exp2f(-gl[t]); K3[t * 128 + tid] = kk[t] * __builtin_amdgcn_exp2f(run - gl[t]); }
        DEC[tid] = __builtin_amdgcn_exp2f(run);
    } else if (tid < 256) { const int vv = tid - 128;
#pragma unroll
        for (int t = 0; t < 8; ++t) Vs[t * 128 + vv] = bf2f(PB[(size_t)(tok0 + t) * PBW + 1024 + h * HD + vv]);
    }
    __syncthreads();
    { const int p = tid >> 3, part = tid & 7, t = p >> 3, s = p & 7; float a = 0.f;
#pragma unroll
      for (int j = 0; j < 16; ++j) a += Qs[t * 128 + part + 8 * j] * K2[s * 128 + part + 8 * j];
      a += __shfl_xor(a, 1); a += __shfl_xor(a, 2); a += __shfl_xor(a, 4);
      if (part == 0) ATT[p] = (s <= t) ? a : 0.f; }
    float vr[8], o[8];
#pragma unroll
    for (int t = 0; t < 8; ++t) { vr[t] = Vs[t * 128 + v]; o[t] = 0.f; }
#pragma unroll
    for (int j = 0; j < 32; ++j) { const int k = 32 * kq + j; const float sv = s0[j]; float sn = DEC[k] * sv;
#pragma unroll
        for (int t = 0; t < 8; ++t) { o[t] += Qs[t * 128 + k] * sv; sn += K3[t * 128 + k] * vr[t]; }
        Sout[(size_t)k * HD + v] = sn; }
#pragma unroll
    for (int t = 0; t < 8; ++t) OP[(kq * 8 + t) * 128 + v] = o[t];
    __syncthreads();
#pragma unroll
    for (int r = 0; r < 2; ++r) { const int e = tid + 512 * r, t = e >> 7, vv = e & 127;
        float acc = (OP[(0 * 8 + t) * 128 + vv] + OP[(1 * 8 + t) * 128 + vv]) + (OP[(2 * 8 + t) * 128 + vv] + OP[(3 * 8 + t) * 128 + vv]);
#pragma unroll
        for (int s = 0; s < 8; ++s) acc += ATT[t * 8 + s] * Vs[s * 128 + vv];
        OT[t * 128 + vv] = acc; }
    __syncthreads();
    { const int t = F.wave, lane = F.lane; const float o0 = OT[t * 128 + 2 * lane], o1 = OT[t * 128 + 2 * lane + 1];
      const float rstd = 1.0f / sqrtf(wave_sum(o0 * o0 + o1 * o1) * (1.0f / HD) + EPS);
      const unsigned gw2 = *(const unsigned*)(PB + (size_t)(tok0 + t) * PBW + 1536 + h * HD + 2 * lane);
      const float g0 = F.in[17][2 * lane], g1 = F.in[17][2 * lane + 1];
      *(unsigned*)(MIX + (size_t)(tok0 + t) * DM + 512 + h * HD + 2 * lane) = pk2(o0 * rstd * g0 * siluf_(bflo(gw2)), o1 * rstd * g1 * siluf_(bfhi(gw2))); }
    __syncthreads();
}
constexpr int SG_LD = 68;
template <int KSTEPS  >
__device__ __forceinline__ void small_gemm_tile(Frame& F, const bf16* A, int lda, const bf16* Bt, int K, int r0, int c0, float (&v)[8]) {
    const int lane = F.lane, wave = F.wave, fr = lane & 15, fq = lane >> 4;
    f32x4v acc[4][4];
#pragma unroll
    for (int a = 0; a < 4; ++a)
#pragma unroll
        for (int b = 0; b < 4; ++b) acc[a][b] = (f32x4v){0.f, 0.f, 0.f, 0.f};
    const bf16* ap = A + (size_t)(r0 + fr) * lda + wave * (KSTEPS * 32) + 8 * fq;
    const bf16* bp = Bt + (size_t)(c0 + fr) * K + wave * (KSTEPS * 32) + 8 * fq;
#pragma unroll 2
    for (int ks = 0; ks < KSTEPS; ++ks) {
        s16x8 af[4], bf[4];
#pragma unroll
        for (int i = 0; i < 4; ++i) { af[i] = *(const s16x8*)(ap + (size_t)(16 * i) * lda + 32 * ks); bf[i] = *(const s16x8*)(bp + (size_t)(16 * i) * K + 32 * ks); }
#pragma unroll
        for (int a = 0; a < 4; ++a)
#pragma unroll
            for (int b = 0; b < 4; ++b) acc[a][b] = __builtin_amdgcn_mfma_f32_16x16x32_bf16(bf[b], af[a], acc[a][b], 0, 0, 0);
    }
    LAS float* part = (LAS float*)F.lds + wave * (64 * SG_LD);
#pragma unroll
    for (int a = 0; a < 4; ++a)
#pragma unroll
        for (int b = 0; b < 4; ++b) *(LAS f32x4v*)(part + (16 * a + fr) * SG_LD + 16 * b + 4 * fq) = acc[a][b];
    __syncthreads();
    { const int row = F.tid >> 3, cg8 = (F.tid & 7) * 8; const LAS float* p = (const LAS float*)F.lds + row * SG_LD + cg8;
      f32x4v s0 = {0.f, 0.f, 0.f, 0.f}, s1 = {0.f, 0.f, 0.f, 0.f};
#pragma unroll
      for (int w = 0; w < 8; ++w) { s0 += *(const LAS f32x4v*)(p + w * (64 * SG_LD)); s1 += *(const LAS f32x4v*)(p + w * (64 * SG_LD) + 4); }
      v[0] = s0[0]; v[1] = s0[1]; v[2] = s0[2]; v[3] = s0[3]; v[4] = s1[0]; v[5] = s1[1]; v[6] = s1[2]; v[7] = s1[3]; }
    __syncthreads();
}

__device__ __forceinline__ void outproj_sample_tile(Frame& F, int tile, float* SS1) {
    const int rm = tile >> 4, cn = tile & 15; float v[8];
    small_gemm_tile<4>(F, (const bf16*)(F.ws + WS_MIX), DM, (const bf16*)(F.ws + WS_WOUT), DM, MP + 64 * rm, 64 * cn, v);
    const int row = MP + 64 * rm + (F.tid >> 3), col = 64 * cn + 8 * (F.tid & 7); const size_t off = (size_t)row * DM + col;
    const float* xs = F.in[1] + (size_t)(row - MP) * DM + col; bf16* XN = (bf16*)(F.ws + WS_XN);
    const f32x4v xa = *(const f32x4v*)xs, xb = *(const f32x4v*)(xs + 4);
    const f32x4v x0 = {xa[0] + v[0], xa[1] + v[1], xa[2] + v[2], xa[3] + v[3]}, x1 = {xb[0] + v[4], xb[1] + v[5], xb[2] + v[6], xb[3] + v[7]};
    v4u w; w.x = pk2(x0[0], x0[1]); w.y = pk2(x0[2], x0[3]); w.z = pk2(x1[0], x1[1]); w.w = pk2(x1[2], x1[3]);
    *(v4u*)(XN + off) = w;
    float ss = (x0[0] * x0[0] + x0[1] * x0[1]) + (x0[2] * x0[2] + x0[3] * x0[3]) + (x1[0] * x1[0] + x1[1] * x1[1]) + (x1[2] * x1[2] + x1[3] * x1[3]);
    ss += __shfl_xor(ss, 1); ss += __shfl_xor(ss, 2); ss += __shfl_xor(ss, 4);
    if ((F.tid & 7) == 0) __hip_atomic_fetch_add(SS1 + row, ss, __ATOMIC_RELAXED, __HIP_MEMORY_SCOPE_AGENT);
}
__device__ __forceinline__ void down_sample_tile(Frame& F, int tile, float* SS2, unsigned* cntb, float* YO) {
    const int rm = tile >> 4, cn = tile & 15; float v[8];
    small_gemm_tile<11>(F, (const bf16*)(F.ws + WS_ACT), DFF, (const bf16*)(F.ws + WS_WD), DFF, MP + 64 * rm, 64 * cn, v);
    const int row = MP + 64 * rm + (F.tid >> 3), col = 64 * cn + 8 * (F.tid & 7); const size_t off = (size_t)row * DM + col;
    unsigned* cnt = cntb + 64 * rm; const v4u xw = *(const v4u*)((const bf16*)(F.ws + WS_XN) + off);
    const f32x4v xa = {bflo(xw.x), bfhi(xw.x), bflo(xw.y), bfhi(xw.y)}, xb = {bflo(xw.z), bfhi(xw.z), bflo(xw.w), bfhi(xw.w)}, ga = *(const f32x4v*)(F.in[23] + col), gb = *(const f32x4v*)(F.in[23] + col + 4);
    const f32x4v x0 = {xa[0] + v[0], xa[1] + v[1], xa[2] + v[2], xa[3] + v[3]}, x1 = {xb[0] + v[4], xb[1] + v[5], xb[2] + v[6], xb[3] + v[7]};
    float ss = (x0[0] * x0[0] + x0[1] * x0[1]) + (x0[2] * x0[2] + x0[3] * x0[3]) + (x1[0] * x1[0] + x1[1] * x1[1]) + (x1[2] * x1[2] + x1[3] * x1[3]);
    ss += __shfl_xor(ss, 1); ss += __shfl_xor(ss, 2); ss += __shfl_xor(ss, 4);
    if ((F.tid & 7) == 0) __hip_atomic_fetch_add(SS2 + row, ss, __ATOMIC_RELAXED, __HIP_MEMORY_SCOPE_AGENT);
    asm volatile("s_waitcnt vmcnt(0)" ::: "memory");
    __syncthreads();
    if (F.tid == 0) { __hip_atomic_fetch_add(cnt, 1u, __ATOMIC_RELAXED, __HIP_MEMORY_SCOPE_AGENT); wait_count(cnt, 16u); }
    __syncthreads();
    float s = 0.f; if ((F.tid & 7) == 0) s = atomic_read_f32(SS2 + row);
    const float rs = rstd_of(__shfl(s, F.lane & ~7));
    *(f32x4v*)(YO + off) = (f32x4v){x0[0] * rs * ga[0], x0[1] * rs * ga[1], x0[2] * rs * ga[2], x0[3] * rs * ga[3]};
    *(f32x4v*)(YO + off + 4) = (f32x4v){x1[0] * rs * gb[0], x1[1] * rs * gb[1], x1[2] * rs * gb[2], x1[3] * rs * gb[3]};
}
typedef GAS unsigned gu32;
#define RLX_AGENT __ATOMIC_RELAXED, __HIP_MEMORY_SCOPE_AGENT
constexpr int MISC_OFF = LDS_BYTES - 512;
constexpr int CW_QUEUE = 8192;
constexpr int CW_BAR = 4096;
constexpr size_t CTL_ZERO_BYTES = 524288;
constexpr int CW_DUMMY = 65536;
#define XB_TMO      128
#define XB_XCNT(j)  (256  + 64 * (j))
#define XB_XSUB(j)  (1280 + 64 * (j))
#define XB_XGEN(j)  (2304 + 64 * (j))
#define XB_TOP      3328
#define XB_TOPGEN   3392
#define XCD_BAR_WORDS 3456
#define XB_SPIN_CAP (1u << 18)

__device__ __forceinline__ unsigned xb_ld(unsigned* p)              { return __hip_atomic_load(p, __ATOMIC_RELAXED, __HIP_MEMORY_SCOPE_AGENT); }
__device__ __forceinline__ unsigned xb_add(unsigned* p, unsigned v) { return __hip_atomic_fetch_add(p, v, __ATOMIC_RELAXED, __HIP_MEMORY_SCOPE_AGENT); }
__device__ __forceinline__ unsigned xb_xcc_id() { return (unsigned)__builtin_amdgcn_s_getreg((3 << 11) | 20) & 0xFu; }
#define XB_SPIN(cond, bar) do { unsigned _sp = 0; while (cond) { __builtin_amdgcn_s_sleep(1); \
    if ((++_sp & 255u) == 0u) { if (xb_ld(&(bar)[XB_TMO])) break; if (_sp > XB_SPIN_CAP) { atomicAdd(&(bar)[XB_TMO], 1u); break; } } } } while (0)

struct XcdBarrier {
    unsigned* bar; unsigned x;
    volatile LAS unsigned* st;
};

__device__ __forceinline__ XcdBarrier xcd_barrier_post(unsigned* bar, volatile LAS unsigned* st) {
    XcdBarrier b; b.bar = bar; b.x = xb_xcc_id(); b.st = st;
    if (threadIdx.x == 0) (void)xb_add(&bar[XB_XCNT(b.x)], 1u);
    return b;
}
__device__ __forceinline__ void xcd_barrier_complete(unsigned* bar, unsigned x, unsigned& nloc, unsigned& nx) {
    const unsigned G = gridDim.x * gridDim.y * gridDim.z;
    unsigned sum, cnt, mine, sp = 0u;
    for (;;) {
        sum = 0u; cnt = 0u; mine = 0u;
#pragma unroll
        for (unsigned j = 0; j < 16; ++j) { const unsigned c = xb_ld(&bar[XB_XCNT(j)]); sum += c; cnt += (c > 0u) ? 1u : 0u; mine = (j == x) ? c : mine; }
        if (sum == G) break;
        __builtin_amdgcn_s_sleep(1);
        if ((++sp & 255u) == 0u) { if (xb_ld(&bar[XB_TMO])) break; if (sp > XB_SPIN_CAP) { atomicAdd(&bar[XB_TMO], 1u); break; } }
    }
    nloc = mine > 0u ? mine : 1u; nx = cnt > 0u ? cnt : 1u;
}

__device__ __forceinline__ void xcd_barrier(const XcdBarrier& b) {
    asm volatile("s_waitcnt vmcnt(0)" ::: "memory");
    __syncthreads();
    if (threadIdx.x == 0) {
        unsigned* bar = b.bar;
        __builtin_amdgcn_s_waitcnt(0);
        unsigned nloc = b.st[0], nx = b.st[1];
        if (nloc == 0u) { xcd_barrier_complete(bar, b.x, nloc, nx); b.st[0] = nloc; b.st[1] = nx; }
        const unsigned old = xb_add(&bar[XB_XSUB(b.x)], 1u);
        const unsigned gen = old / nloc;
        if (old + 1u == (gen + 1u) * nloc) {
            __builtin_amdgcn_fence(__ATOMIC_RELEASE, "agent");
            asm volatile("s_waitcnt vmcnt(0)" ::: "memory");
            const unsigned og = xb_add(&bar[XB_TOP], 1u);
            const unsigned tg = og / nx;
            if (og + 1u == (tg + 1u) * nx) xb_add(&bar[XB_TOPGEN], 1u);
            else XB_SPIN(xb_ld(&bar[XB_TOPGEN]) == tg, bar);
            __builtin_amdgcn_fence(__ATOMIC_ACQUIRE, "agent");
            xb_add(&bar[XB_XGEN(b.x)], 1u);
            asm volatile("s_waitcnt vmcnt(0)" ::: "memory");
        } else {
            XB_SPIN(xb_ld(&bar[XB_XGEN(b.x)]) == gen, bar);
            __builtin_amdgcn_fence(__ATOMIC_ACQUIRE, "agent");
            asm volatile("s_waitcnt vmcnt(0)" ::: "memory");
        }
    }
    __syncthreads();
}

__global__ void __launch_bounds__(NWAVES * 64, 2) mk_fwd(Args args) {
    extern __shared__ __attribute__((aligned(16))) unsigned char lds[];
    Frame F;
    F.lds = (LAS unsigned char*)lds;
    F.tid = threadIdx.x; F.lane = F.tid & 63; F.wave = __builtin_amdgcn_readfirstlane(F.tid >> 6);
    F.G = gridDim.x; F.bid = blockIdx.x;
#pragma unroll
    for (int i = 0; i < 24; ++i) F.in[i] = args.in[i];
    F.out = args.out; F.ws = args.ws;
    const int lo = args.ph_lo, hi = args.ph_hi;
#define IN(k) (lo <= (k) && (k) < hi)
#if MK_N_LAUNCHES == 1
    volatile LAS unsigned* MISC = (volatile LAS unsigned*)(F.lds + MISC_OFF);
    if (F.tid < 32) MISC[F.tid] = 0u;
    __syncthreads();
    XcdBarrier bar = xcd_barrier_post((unsigned*)(F.ws + WS_CTL) + CW_BAR, MISC + 8);
#if defined(PROBE_PH)
    if (F.bid == 0 && F.tid == 0) { const unsigned long long t_ = __builtin_amdgcn_s_memrealtime(); MISC[32] = (unsigned)t_; MISC[33] = (unsigned)(t_ >> 32); }
#endif
#if defined(PROBE_PH)
#define SEAM(k) do { if (IN(k) && IN((k) + 1)) { xcd_barrier(bar); if (F.bid == 0 && F.tid == 0) { const unsigned long long t_ = __builtin_amdgcn_s_memrealtime(); MISC[32 + 2 * ((k) + 1)] = (unsigned)t_; MISC[33 + 2 * ((k) + 1)] = (unsigned)(t_ >> 32); } } } while (0)
#elif REP_BAR == 2
#define SEAM(k) do { if (IN(k) && IN((k) + 1)) { xcd_barrier(bar); xcd_barrier(bar); } } while (0)
#else
#define SEAM(k) do { if (IN(k) && IN((k) + 1)) xcd_barrier(bar); } while (0)
#endif
#else
#define SEAM(k) do { } while (0)
#endif
    const int gw = F.bid * NWAVES + F.wave, NGW = F.G * NWAVES;
    bf16* XN = (bf16*)(F.ws + WS_XN); bf16* PB = (bf16*)(F.ws + WS_PB); float* FZ = (float*)(F.ws + WS_FZ); bf16* GY = (bf16*)(F.ws + WS_GY);
    bf16* MIX = (bf16*)(F.ws + WS_MIX); bf16* ACT = (bf16*)(F.ws + WS_ACT);

    if (IN(0)) { p0_prologue(F);
#if REP_P0 == 2
        __syncthreads(); p0_prologue(F);
#endif
    } SEAM(0);
    if (IN(1)) {
        pg8::Gemm g{XN, (const bf16*)(F.ws + WS_WIN), MTOK, INC, DM}; pg8::StaticOrder S; S.init(MTOK, INC, F.G, F.bid);
        EpiIn E{PB, FZ, (bf16*)(F.ws + WS_U5)};
        pg8::gemm_phase<EpiIn, pg8::StaticOrder, true, true>(F.lds, g, S, E);
        { const int nunits = (MTOK / 256) * (INC / 256), rem = nunits % F.G;
          if (rem == 0) deferred_transposes<0>(F, gw, NGW); else if (F.bid >= rem) deferred_transposes<0>(F, (F.bid - rem) * NWAVES + F.wave, (F.G - rem) * NWAVES); }
#if REP_P1 == 2
        __syncthreads();
        pg8::gemm_phase<EpiIn, pg8::StaticOrder, true, true>(F.lds, g, S, E);
#endif
    } SEAM(1);
    if (IN(2)) {
        if ((F.bid & 1) == 0) {
            for (int it = F.bid; it < 256; it += F.G) s5_item(F, it);
            hgA_loop(F);
            for (int it = F.bid; it < SB_B * HH; it += F.G) hgrn_sample_item(F, it);
        } else {
            for (int it = F.bid; it < SB_B * HH; it += F.G) hgrn_sample_item(F, it);
            hgA_loop(F);
            __syncthreads();
            for (int it = F.bid; it < 256; it += F.G) s5_item(F, it);
        }
    } SEAM(2);
    if (IN(3)) { hg_scan(F, (bf16*)(F.ws + WS_DSC), F.bid, F.G); } SEAM(3);
    if (IN(4)) {
        pg8::Gemm g{GY, (const bf16*)(F.ws + WS_WGLU), MTOK, S5W, S5W}; pg8::StaticOrder S; S.init(MTOK, S5W, F.G, F.bid);
        EpiGlu E{GY, MIX};
        pg8::gemm_phase<EpiGlu, pg8::StaticOrder, true, true, true>(F.lds, g, S, E);
        __syncthreads();
        hgC_loop(F, (unsigned*)(F.ws + WS_CTL) + CW_QUEUE);
    } SEAM(4);
    if (IN(5)) {
        pg8::Gemm g{MIX, (const bf16*)(F.ws + WS_WOUT), MP, DM, DM}; pg8::StaticOrder S; S.init(MP, DM, F.G, F.bid);
#if REP_P5 >= 2
        { EpiOut E2{F.in[0], XN, (float*)(F.ws + WS_CTL) + CW_DUMMY};
#if REP_P5 == 2 || REP_P5 == 3
          pg8::gemm_phase<EpiOut, pg8::StaticOrder, true, true>(F.lds, g, S, E2);
          __syncthreads();
#endif
#if REP_P5 == 2 || REP_P5 == 4
          for (int it = F.bid; it < 256; it += F.G) outproj_sample_tile(F, it, (float*)(F.ws + WS_CTL) + CW_DUMMY);
          __syncthreads();
#endif
        }
#endif
        EpiOut E{F.in[0], XN, (float*)(F.ws + WS_CTL) + CW_SS1};
        const bool first = (F.G == 256) && ((F.bid & 1) == 0);
        if (first) { outproj_sample_tile(F, F.bid, (float*)(F.ws + WS_CTL) + CW_SS1); __syncthreads(); }
        pg8::gemm_phase<EpiOut, pg8::StaticOrder, true, true>(F.lds, g, S, E);
        __syncthreads();
        if (!first) for (int it = F.bid; it < 256; it += F.G) outproj_sample_tile(F, it, (float*)(F.ws + WS_CTL) + CW_SS1);
    } SEAM(5);
    if (IN(6)) {
        pg8::Gemm g{XN, (const bf16*)(F.ws + WS_WGU), MTOK, 2 * DFF, DM}; pg8::StaticOrder S; S.init(MTOK, 2 * DFF, F.G, F.bid);
        EpiAct E{ACT, (const float*)(F.ws + WS_CTL) + CW_SS1};
        pg8::gemm_phase<EpiAct, pg8::StaticOrder, P6_ALIGN, P6_SP2>(F.lds, g, S, E);
        { const int nunits = (MTOK / 256) * (2 * DFF / 256), rem = nunits % F.G;
          if (rem == 0) deferred_transposes<1>(F, gw, NGW); else if (F.bid >= rem) deferred_transposes<1>(F, (F.bid - rem) * NWAVES + F.wave, (F.G - rem) * NWAVES); }
#if REP_P6 == 2
        __syncthreads();
        pg8::gemm_phase<EpiAct, pg8::StaticOrder, true, true>(F.lds, g, S, E);
#endif
    } SEAM(6);
    if (IN(7)) {
        pg8::Gemm g{ACT, (const bf16*)(F.ws + WS_WD), MP, DM, DFF}; pg8::StaticOrder S; S.init(MP, DM, F.G, F.bid);
#if REP_P7 == 2
        { float* YD = (float*)(F.ws + WS_GY) - 0;
          EpiDown E2{XN, F.in[23], (float*)(F.ws + WS_CTL) + CW_DUMMY, (unsigned*)(F.ws + WS_CTL) + CW_DUMMY + 20480, YD};
          pg8::gemm_phase<EpiDown, pg8::StaticOrder, true, true>(F.lds, g, S, E2);
          __syncthreads();
          for (int it = F.bid; it < 256; it += F.G) down_sample_tile(F, it, (float*)(F.ws + WS_CTL) + CW_DUMMY, (unsigned*)(F.ws + WS_CTL) + CW_DUMMY + 20480 + 4096, YD);
          __syncthreads(); }
#endif
        EpiDown E{XN, F.in[23], (float*)(F.ws + WS_CTL) + CW_SS2, (unsigned*)(F.ws + WS_CTL) + CW_CNT, F.out + O_Y};
        Unit u0; const bool has_u = S.next(0, u0); const int grp = has_u ? (u0.pm & 1) : 0;
        const int stile = (F.G == 256 && has_u) ? grp * 128 + (u0.pm >> 1) * 4 + u0.pn : F.bid;
        if (F.G == 256 && grp == 0) { down_sample_tile(F, stile, (float*)(F.ws + WS_CTL) + CW_SS2, (unsigned*)(F.ws + WS_CTL) + CW_CNTS, F.out + O_Y); __syncthreads(); }
        pg8::gemm_phase<EpiDown, pg8::StaticOrder, true, true>(F.lds, g, S, E);
        __syncthreads();
        if (F.G != 256) { for (int it = F.bid; it < 256; it += F.G) down_sample_tile(F, it, (float*)(F.ws + WS_CTL) + CW_SS2, (unsigned*)(F.ws + WS_CTL) + CW_CNTS, F.out + O_Y); }
        else if (grp == 1) down_sample_tile(F, stile, (float*)(F.ws + WS_CTL) + CW_SS2, (unsigned*)(F.ws + WS_CTL) + CW_CNTS, F.out + O_Y);
    }
#if defined(PROBE_PH)
    if (F.bid == 0 && F.tid == 0) {
        const unsigned long long tn = __builtin_amdgcn_s_memrealtime();
        const unsigned long long t0 = ((unsigned long long)MISC[33 + 2 * PROBE_PH] << 32) | MISC[32 + 2 * PROBE_PH];
        const unsigned long long t1 = (PROBE_PH == NPH - 1) ? tn : (((unsigned long long)MISC[35 + 2 * PROBE_PH] << 32) | MISC[34 + 2 * PROBE_PH]);
        const unsigned long long wait = 4ull * (t1 - t0);
        while (__builtin_amdgcn_s_memrealtime() - tn < wait) __builtin_amdgcn_s_sleep(8);
    }
#endif
#undef IN
#undef SEAM
}

extern "C" void kernel_launch(void* const* d_in, const int* in_sizes, int n_in, void* d_out, int out_size, void* d_ws, size_t ws_size, hipStream_t stream) {
    static int grid = 0;
    if (grid == 0) {
        if (n_in != 24 || ws_size < WS_END) { fprintf(stderr, "kernel_launch: unexpected n_in %d / ws %zu\n", n_in, ws_size); grid = -1; return; }
        int dev = 0, cus = 0, per_cu = 0;
        if (hipGetDevice(&dev) != hipSuccess || hipDeviceGetAttribute(&cus, hipDeviceAttributeMultiprocessorCount, dev) != hipSuccess) { grid = -1; return; }
        if (hipFuncSetAttribute((const void*)mk_fwd, hipFuncAttributeMaxDynamicSharedMemorySize, LDS_BYTES) != hipSuccess) { fprintf(stderr, "kernel_launch: hipFuncSetAttribute failed\n"); grid = -1; return; }
        if (hipOccupancyMaxActiveBlocksPerMultiprocessor(&per_cu, (const void*)mk_fwd, NWAVES * 64, LDS_BYTES) != hipSuccess || per_cu < 1) { fprintf(stderr, "kernel_launch: occupancy query says %d\n", per_cu); per_cu = 1; }
        (void)hipGetLastError();
        grid = cus;
    }
    if (grid < 0) return;
    if (hipMemsetAsync((char*)d_ws + WS_CTL, 0, CTL_ZERO_BYTES, stream) != hipSuccess) { fprintf(stderr, "kernel_launch: memset failed\n"); return; }
    Args a{};
    for (int i = 0; i < 24; ++i) a.in[i] = (const float*)d_in[i];
    a.out = (float*)d_out; a.ws = (unsigned char*)d_ws;
#if MK_N_LAUNCHES == 1
    a.ph_lo = 0; a.ph_hi = NPH;
    void* kargs[] = {&a};
    hipError_t e = hipLaunchCooperativeKernel((const void*)mk_fwd, dim3(grid), dim3(NWAVES * 64), kargs, LDS_BYTES, stream);
    if (e != hipSuccess) fprintf(stderr, "kernel_launch: cooperative launch failed: %s (grid %d)\n", hipGetErrorString(e), grid);
#else
    for (int p = 0; p < NPH; ++p) { a.ph_lo = p; a.ph_hi = p + 1; hipLaunchKernelGGL(mk_fwd, dim3(grid), dim3(NWAVES * 64), LDS_BYTES, stream, a); }
#endif
}
```

```cpp
#include <hip/hip_runtime.h>
#include <hip/hip_cooperative_groups.h>
#include <cstdio>
#include <cstdint>
namespace cg = cooperative_groups;
#ifndef PG8_WGM
#define PG8_WGM 4
#endif
#define MK_N_LAUNCHES 1
namespace pg8 {
#define PG8_LAS __attribute__((address_space(3)))
typedef unsigned short bf16_t;
typedef short bf16x8 __attribute__((ext_vector_type(8)));
typedef float f32x4 __attribute__((ext_vector_type(4)));
typedef unsigned u32x4 __attribute__((ext_vector_type(4)));
constexpr int BM = 256, BK = 64, HALF = 128, HTB = HALF * BK * 2  , STAGE_BYTES = 8 * HTB, NXCD = 8, WGM = PG8_WGM;

__host__ __device__ __forceinline__ int lds_byte(int r, int c) { const int st = (r >> 4) * 2 + (c >> 5), rr = r & 15, cc = c & 31, ob = rr * 64 + cc * 2; return st * 1024 + (ob ^ (((ob >> 9) & 1) << 5)); }
__host__ __device__ __forceinline__ void stage_rc(int b, int& R, int& C) { const int st = b / 1024, sb = b % 1024, swz = sb ^ (((sb >> 9) & 1) << 5); R = (st >> 1) * 16 + swz / 64; C = (st & 1) * 32 + (swz % 64) / 2; }
__host__ __device__ __forceinline__ int perm32(int rho) { const int n = rho >> 4, i = rho & 15; return 8 * (i >> 2) + 4 * n + (i & 3); }

struct Unit { int pm, pn; };
struct Gemm { const bf16_t* A; const bf16_t* Bt; int M, N, K; };

struct StaticOrder {
    int nM, nN, nwg, G, c;
    __host__ __device__ void init(int M, int N, int G_, int c_) { nM = M / BM; nN = N / BM; nwg = nM * nN; G = G_; c = c_; }
    __host__ __device__ bool next(int i, Unit& u) const {
        const long L = (long)i * G + c; if (L >= nwg) return false;
        int wgid = (int)L; { const int q = nwg / NXCD, r = nwg % NXCD, xcd = wgid % NXCD, off = wgid / NXCD; wgid = (xcd < r ? xcd * (q + 1) : r * (q + 1) + (xcd - r) * q) + off; }
        const int nig = WGM * nN, gid = wgid / nig, fm = gid * WGM, gsz = (nM - fm) < WGM ? (nM - fm) : WGM;
        u.pm = fm + ((wgid % nig) % gsz); u.pn = (wgid % nig) / gsz; return true;
    }
    __device__ __forceinline__ void a_ready(const Unit&) const {}
    __device__ __forceinline__ void done(const Unit&) const {}
};

__device__ __forceinline__ unsigned cvt_pk_bf16(float lo, float hi) { unsigned r; asm volatile("v_cvt_pk_bf16_f32 %0, %1, %2" : "=v"(r) : "v"(lo), "v"(hi)); return r; }
template <class Epi, class Sched, bool ALIGN_EPI = false, bool SP2 = false, bool AGM = false  >
__device__ __forceinline__ void gemm_phase(PG8_LAS unsigned char* lds, const Gemm g, const Sched& S, const Epi& E) {
    const int tid = threadIdx.x, wid = __builtin_amdgcn_readfirstlane(tid >> 6), lane = tid & 63, wr = wid >> 2, wc = wid & 3, fr = lane & 15, fq = lane >> 4;
    const int K = g.K, nt = K / BK;
    unsigned voffA[2], voffB[2];
#pragma unroll
    for (int i = 0; i < 2; ++i) { int R, C; stage_rc(tid * 16 + i * 8192, R, C); const int Rb = Epi::PERM ? ((R & ~31) + perm32(R & 31)) : R;
        voffA[i] = AGM ? (unsigned)((((C >> 4) * g.M + R) * 16 + (C & 15)) * 2) : (unsigned)(R * K + C) * 2u; voffB[i] = (unsigned)(Rb * K + C) * 2u; }
    const size_t kstep = (size_t)(BK * 2);
    const size_t hstep = (size_t)HALF * K * 2;
    const size_t tstep = 2 * hstep;
    const size_t kstepA = AGM ? (size_t)4 * g.M * 32 : kstep, hstepA = AGM ? (size_t)HALF * 32 : hstep, tstepA = 2 * hstepA;
    const unsigned ldsw = (unsigned)wid * 1024u;
    const int aoff = lds_byte(wr * 64 + fr, fq * 8), boff = lds_byte(wc * 32 + fr, fq * 8);
#define PG8_SA(b, h) (((b) * 2 + (h)) * HTB)
#define PG8_SB(b, h) ((4 + (b) * 2 + (h)) * HTB)
#define PG8_STAGE(bufoff, gbase, voff) do { _Pragma("unroll") for (int _i = 0; _i < 2; ++_i) \
        __builtin_amdgcn_global_load_lds((const unsigned*)((const char*)(gbase) + (voff)[_i]), (PG8_LAS unsigned*)(lds + (bufoff) + ldsw + _i * 8192), 16, 0, 0); } while (0)
#define PG8_LDA(dst, b, h) do { _Pragma("unroll") for (int m = 0; m < 4; ++m) _Pragma("unroll") for (int k = 0; k < 2; ++k) dst[m][k] = *(const PG8_LAS bf16x8*)(lds + PG8_SA(b, h) + aoff + m * 2048 + k * 1024); } while (0)
#define PG8_LDB(dst, b, h) do { _Pragma("unroll") for (int n = 0; n < 2; ++n) _Pragma("unroll") for (int k = 0; k < 2; ++k) dst[n][k] = *(const PG8_LAS bf16x8*)(lds + PG8_SB(b, h) + boff + n * 2048 + k * 1024); } while (0)
#define PG8_MMA(ai, bj, At, Bt) do { __builtin_amdgcn_s_setprio(1); _Pragma("unroll") for (int m = 0; m < 4; ++m) _Pragma("unroll") for (int n = 0; n < 2; ++n) _Pragma("unroll") for (int k = 0; k < 2; ++k) \
        acc[ai][bj][m][n] = __builtin_amdgcn_mfma_f32_16x16x32_bf16(Bt[n][k], At[m][k], acc[ai][bj][m][n], 0, 0, 0); __builtin_amdgcn_s_setprio(0); } while (0)
#define PG8_WAIT_V(n) asm volatile("s_waitcnt vmcnt(" #n ")" ::: "memory")
#define PG8_WAIT_L(n) asm volatile("s_waitcnt lgkmcnt(" #n ")" ::: "memory")
#define PG8_BAR __builtin_amdgcn_s_barrier()
#define PG8_SCHED __builtin_amdgcn_sched_barrier(0)
    Unit cur, nxt; int ui = 0;
    if (!S.next(0, cur)) return;
    f32x4 acc[2][2][4][2];
#pragma unroll
    for (int a = 0; a < 2; ++a)
#pragma unroll
        for (int b = 0; b < 2; ++b)
#pragma unroll
            for (int m = 0; m < 4; ++m)
#pragma unroll
                for (int n = 0; n < 2; ++n) acc[a][b][m][n] = (f32x4){0.f, 0.f, 0.f, 0.f};
    bf16x8 At[4][2], B0[2][2], B1[2][2];
    const char* cA = (const char*)g.A + (size_t)cur.pm * tstepA; const char* cB = (const char*)g.Bt + (size_t)cur.pn * tstep;
    S.a_ready(cur);
    if constexpr (SP2) {
        PG8_STAGE(PG8_SB(0, 0), cB, voffB); PG8_STAGE(PG8_SB(0, 1), cB + hstep, voffB); PG8_STAGE(PG8_SA(0, 0), cA, voffA); PG8_STAGE(PG8_SA(0, 1), cA + hstepA, voffA);
        if (wr == 1) PG8_BAR;
        PG8_WAIT_V(2); PG8_BAR;
        PG8_STAGE(PG8_SB(1, 0), cB + kstep, voffB); PG8_STAGE(PG8_SA(1, 0), cA + kstepA, voffA); PG8_STAGE(PG8_SB(1, 1), cB + hstep + kstep, voffB);
        PG8_WAIT_V(6); PG8_BAR;
    } else {
        PG8_STAGE(PG8_SB(0, 0), cB, voffB); PG8_STAGE(PG8_SA(0, 0), cA, voffA); PG8_STAGE(PG8_SB(0, 1), cB + hstep, voffB); PG8_STAGE(PG8_SA(0, 1), cA + hstepA, voffA);
        if (wr == 1) PG8_BAR;
        PG8_WAIT_V(4); PG8_BAR;
        PG8_STAGE(PG8_SB(1, 0), cB + kstep, voffB); PG8_STAGE(PG8_SA(1, 0), cA + kstepA, voffA); PG8_STAGE(PG8_SB(1, 1), cB + hstep + kstep, voffB);
        PG8_WAIT_V(6); PG8_BAR;
    }
    for (;;) {
        const bool has_next = S.next(ui + 1, nxt);
        const char* nA = has_next ? (const char*)g.A + (size_t)nxt.pm * tstepA : cA; const char* nB = has_next ? (const char*)g.Bt + (size_t)nxt.pn * tstep : cB;
        for (int t = 0; t < nt; t += 2) {
            const bool last = (t == nt - 2);
            const char* a1 = cA + (size_t)(t + 1) * kstepA;
            const char* a2 = last ? nA : cA + (size_t)(t + 2) * kstepA; const char* b2 = last ? nB : cB + (size_t)(t + 2) * kstep;
            const char* a3 = a2 + kstepA; const char* b3 = b2 + kstep;
            if (last && has_next) S.a_ready(nxt);
            if constexpr (SP2) {
            PG8_LDB(B0, 0, 0); PG8_LDB(B1, 0, 1); PG8_SCHED; PG8_LDA(At, 0, 0); PG8_STAGE(PG8_SA(1, 1), a1 + hstepA, voffA);
            PG8_WAIT_V(8); PG8_WAIT_L(0); PG8_BAR; PG8_MMA(0, 0, At, B0); PG8_MMA(0, 1, At, B1); PG8_BAR; PG8_SCHED;
            PG8_LDA(At, 0, 1); PG8_STAGE(PG8_SB(0, 0), b2, voffB); PG8_STAGE(PG8_SB(0, 1), b2 + hstep, voffB); PG8_STAGE(PG8_SA(0, 0), a2, voffA);
            PG8_WAIT_V(8); PG8_WAIT_L(0); PG8_BAR; PG8_MMA(1, 0, At, B0); PG8_MMA(1, 1, At, B1); PG8_BAR; PG8_SCHED;
            PG8_LDB(B0, 1, 0); PG8_LDB(B1, 1, 1); PG8_SCHED; PG8_LDA(At, 1, 0); PG8_STAGE(PG8_SA(0, 1), a2 + hstepA, voffA);
            PG8_WAIT_V(8); PG8_WAIT_L(0); PG8_BAR; PG8_MMA(0, 0, At, B0); PG8_MMA(0, 1, At, B1); PG8_BAR; PG8_SCHED;
            PG8_LDA(At, 1, 1); PG8_STAGE(PG8_SB(1, 0), b3, voffB); PG8_STAGE(PG8_SB(1, 1), b3 + hstep, voffB); PG8_STAGE(PG8_SA(1, 0), a3, voffA);
            PG8_WAIT_V(8); PG8_WAIT_L(0); PG8_BAR; PG8_MMA(1, 0, At, B0); PG8_MMA(1, 1, At, B1); PG8_BAR; PG8_SCHED;
            } else {
            PG8_LDB(B0, 0, 0); PG8_SCHED; PG8_LDA(At, 0, 0); PG8_STAGE(PG8_SA(1, 1), a1 + hstepA, voffA);
            PG8_WAIT_L(8); PG8_BAR; PG8_WAIT_L(0); PG8_MMA(0, 0, At, B0); PG8_BAR; PG8_SCHED;
            PG8_LDB(B1, 0, 1); PG8_STAGE(PG8_SB(0, 0), b2, voffB);
            PG8_BAR; PG8_WAIT_L(0); PG8_MMA(0, 1, At, B1); PG8_BAR;
            PG8_LDA(At, 0, 1); PG8_STAGE(PG8_SA(0, 0), a2, voffA);
            PG8_BAR; PG8_WAIT_L(0); PG8_MMA(1, 0, At, B0); PG8_BAR; PG8_SCHED;
            PG8_STAGE(PG8_SB(0, 1), b2 + hstep, voffB);
            PG8_WAIT_V(6); PG8_BAR; PG8_MMA(1, 1, At, B1); PG8_BAR;
            PG8_LDB(B0, 1, 0); PG8_SCHED; PG8_LDA(At, 1, 0); PG8_STAGE(PG8_SA(0, 1), a2 + hstepA, voffA);
            PG8_WAIT_L(8); PG8_BAR; PG8_WAIT_L(0); PG8_MMA(0, 0, At, B0); PG8_BAR; PG8_SCHED;
            PG8_LDB(B1, 1, 1); PG8_STAGE(PG8_SB(1, 0), b3, voffB);
            PG8_BAR; PG8_WAIT_L(0); PG8_MMA(0, 1, At, B1); PG8_BAR;
            PG8_LDA(At, 1, 1); PG8_STAGE(PG8_SA(1, 0), a3, voffA);
            PG8_BAR; PG8_WAIT_L(0); PG8_MMA(1, 0, At, B0); PG8_BAR; PG8_SCHED;
            PG8_STAGE(PG8_SB(1, 1), b3 + hstep, voffB);
            PG8_WAIT_V(6); PG8_BAR; PG8_MMA(1, 1, At, B1); PG8_BAR;
            }
        }
        if constexpr (ALIGN_EPI) { if (wr == 0) PG8_BAR; }
        if constexpr (!Epi::AFTER_DRAIN) { E(acc, cur, wr, wc, fr, fq); S.done(cur); }
        if (!has_next) break;
#pragma unroll
        for (int a = 0; a < 2; ++a)
#pragma unroll
            for (int b = 0; b < 2; ++b)
#pragma unroll
                for (int m = 0; m < 4; ++m)
#pragma unroll
                    for (int n = 0; n < 2; ++n) acc[a][b][m][n] = (f32x4){0.f, 0.f, 0.f, 0.f};
        cur = nxt; cA = nA; cB = nB; ++ui;
        if constexpr (ALIGN_EPI) { if (wr == 1) PG8_BAR; }
    }
    PG8_WAIT_V(0);
    if constexpr (!ALIGN_EPI) { if (wr == 0) PG8_BAR; }
    PG8_BAR;
    if constexpr (Epi::AFTER_DRAIN) { E.fused(acc, cur, wr, wc, fr, fq, lds, wid, lane); S.done(cur); }
#undef PG8_SA
#undef PG8_SB
#undef PG8_STAGE
#undef PG8_LDA
#undef PG8_LDB
#undef PG8_MMA
#undef PG8_WAIT_V
#undef PG8_WAIT_L
#undef PG8_BAR
#undef PG8_SCHED
}
}

#ifndef S5_SIMPLE
#define S5_SIMPLE 0
#endif
#ifndef HG_SIMPLE
#define HG_SIMPLE 0
#endif
#ifndef REP0
#define REP0 1
#define REP1 1
#define REP2 1
#define REP3 1
#define REP4 1
#define REP6 1
#endif
#ifndef REP_S5
#define REP_S5 1
#endif
#ifndef REP_HGA
#define REP_HGA 1
#endif
#ifndef REP_HGC
#define REP_HGC 1
#endif
#ifndef REP_P1
#define REP_P1 1
#endif
#ifndef REP_P6
#define REP_P6 1
#endif
#ifndef REP_P0
#define REP_P0 1
#endif
#ifndef REP_GLU
#define REP_GLU 1
#endif
#ifndef REP_P3
#define REP_P3 1
#endif
#ifndef REP_P5
#define REP_P5 1
#endif
#ifndef REP_P7
#define REP_P7 1
#endif
#ifndef REP_BAR
#define REP_BAR 1
#endif
#ifndef REP_XN
#define REP_XN 1
#endif
#ifndef P6_ALIGN
#define P6_ALIGN true
#endif
#ifndef P6_SP2
#define P6_SP2 true
#endif
#ifndef REP_MEMSET
#define REP_MEMSET 1
#endif
#ifndef MK_N_LAUNCHES
#define MK_N_LAUNCHES 1
#endif
constexpr int DM = 1024, PB_B = 8, PB_T = 2048, SB_B = 128, SB_T = 8;
constexpr int MP = PB_B * PB_T, MS = SB_B * SB_T, MTOK = MP + MS;
constexpr int S5W = 512, S5G = 32, S5C = 16, S5N = 64;
constexpr int HGW = 512, HD = 128, HH = 4;
constexpr int INC = 2560, DFF = 2816;
constexpr float EPS = 1e-6f;
constexpr int NPH = 8;
constexpr size_t O_Y = 0, O_PRE = (size_t)MTOK * DM, O_PIM = O_PRE + 16384, O_PHG = O_PIM + 16384, O_SRE = O_PHG + 524288, O_SIM = O_SRE + 262144, O_SHG = O_SIM + 262144;
constexpr size_t MiB = 1u << 20;
constexpr size_t WS_CTL = 0, WS_WIN = 2 * MiB, WS_WGLU = 7 * MiB, WS_WOUT = 8 * MiB, WS_WGU = 10 * MiB, WS_WD = 21 * MiB;
constexpr size_t WS_XN = 27 * MiB, WS_PB = 61 * MiB, WS_FZ = 129 * MiB, WS_ACT = 61 * MiB, WS_GY = 163 * MiB, WS_OH = 180 * MiB, WS_MIX = 197 * MiB, WS_END = 234 * MiB;
constexpr int PBW = 2048;
constexpr int LDS_BYTES = 147456;
constexpr int NWAVES = 8;
constexpr int CW_SS1 = 16384, CW_SS2 = 36864, CW_CNT = 57344, CW_CNTS = 61440;

#define GAS __attribute__((address_space(1)))
#define LAS __attribute__((address_space(3)))
typedef unsigned short bf16;
typedef unsigned v4u __attribute__((ext_vector_type(4)));
typedef unsigned v2u __attribute__((ext_vector_type(2)));
typedef float f32x4 __attribute__((ext_vector_type(4)));
#define LDS_WAIT() asm volatile("s_waitcnt lgkmcnt(0)" ::: "memory")
typedef float f32x2_t __attribute__((ext_vector_type(2))); typedef __bf16 bf16x2_t __attribute__((ext_vector_type(2)));
__device__ __forceinline__ unsigned pk2(float lo, float hi) { f32x2_t v = {lo, hi}; bf16x2_t h = __builtin_convertvector(v, bf16x2_t); return __builtin_bit_cast(unsigned, h); }
__device__ __forceinline__ unsigned f2bf(float f) { return pk2(f, 0.f) & 0xffffu; }
__device__ __forceinline__ float bf2f(unsigned short h) { return __builtin_bit_cast(float, (unsigned)h << 16); }
__device__ __forceinline__ float bflo(unsigned w) { return __builtin_bit_cast(float, w << 16); }
__device__ __forceinline__ float bfhi(unsigned w) { return __builtin_bit_cast(float, w & 0xffff0000u); }
__device__ __forceinline__ float sigmoidf_(float x) { return __builtin_amdgcn_rcpf(1.0f + __builtin_amdgcn_exp2f(-1.4426950408889634f * x)); }
__device__ __forceinline__ float siluf_(float x) { return x * __builtin_amdgcn_rcpf(1.0f + __builtin_amdgcn_exp2f(-1.4426950408889634f * x)); }
__device__ __forceinline__ float gelu_tanh(float x) { const float z = -2.302208198144325f * (x + 0.044715f * x * x * x); return x * __builtin_amdgcn_rcpf(1.0f + __builtin_amdgcn_exp2f(z)); }
__device__ __forceinline__ float wave_sum(float v) {
#pragma unroll
    for (int o = 1; o < 64; o <<= 1) v += __shfl_xor(v, o);
    return v;
}

struct Args { const float* in[24]; float* out; unsigned char* ws; int ph_lo, ph_hi; };

struct Frame {
    LAS unsigned char* lds;
    int tid, lane, wave, G, bid;
    const float* in[24];
    float* out; unsigned char* ws;
};
__device__ __forceinline__ const float* xrow(const Frame& F, int m) { return m < MP ? F.in[0] + (size_t)m * DM : F.in[1] + (size_t)(m - MP) * DM; }

__device__ __forceinline__ void transpose_item(const float* W, int ldw, bf16* WT, int K, int k0, int sn0, int dn0, int lane, const float* kgain = nullptr) {
    const int k = k0 + 4 * (lane & 15), nl = 4 * (lane >> 4);
    f32x4 r[4][4];
#pragma unroll
    for (int nb = 0; nb < 4; ++nb)
#pragma unroll
        for (int j = 0; j < 4; ++j) r[nb][j] = *(const GAS f32x4*)(W + (size_t)(k + j) * ldw + sn0 + nl + 16 * nb);
    f32x4 g = {1.f, 1.f, 1.f, 1.f}; if (kgain) g = *(const GAS f32x4*)(kgain + k);
#pragma unroll
    for (int nb = 0; nb < 4; ++nb) { const f32x4 a = r[nb][0] * g.x, b = r[nb][1] * g.y, c = r[nb][2] * g.z, d = r[nb][3] * g.w;
        bf16* o = WT + (size_t)(dn0 + nl + 16 * nb) * K + k;
        v2u w; w.x = pk2(a.x, b.x); w.y = pk2(c.x, d.x); *(GAS v2u*)o = w;
        w.x = pk2(a.y, b.y); w.y = pk2(c.y, d.y); *(GAS v2u*)(o + K) = w;
        w.x = pk2(a.z, b.z); w.y = pk2(c.z, d.z); *(GAS v2u*)(o + 2 * (size_t)K) = w;
        w.x = pk2(a.w, b.w); w.y = pk2(c.w, d.w); *(GAS v2u*)(o + 3 * (size_t)K) = w; }
}
__device__ __forceinline__ void rms_row4_bf16(const float* x0_, const float* gain, bf16* o0, int lane) {
    f32x4 v[4][4]; float s[4];
#pragma unroll
    for (int r = 0; r < 4; ++r)
#pragma unroll
        for (int j = 0; j < 4; ++j) v[r][j] = ((const GAS f32x4*)(x0_ + (size_t)r * DM))[lane + 64 * j];
#pragma unroll
    for (int r = 0; r < 4; ++r) { s[r] = 0.f;
#pragma unroll
        for (int j = 0; j < 4; ++j) s[r] += (v[r][j].x * v[r][j].x + v[r][j].y * v[r][j].y) + (v[r][j].z * v[r][j].z + v[r][j].w * v[r][j].w); }
#pragma unroll
    for (int o = 1; o < 64; o <<= 1) { s[0] += __shfl_xor(s[0], o); s[1] += __shfl_xor(s[1], o); s[2] += __shfl_xor(s[2], o); s[3] += __shfl_xor(s[3], o); }
#pragma unroll
    for (int j = 0; j < 4; ++j) { const f32x4 g = ((const GAS f32x4*)gain)[lane + 64 * j];
#pragma unroll
        for (int r = 0; r < 4; ++r) { const float rs = 1.0f / sqrtf(s[r] * (1.0f / DM) + EPS);
            v2u w; w.x = pk2(v[r][j].x * rs * g.x, v[r][j].y * rs * g.y); w.y = pk2(v[r][j].z * rs * g.z, v[r][j].w * rs * g.w); ((GAS v2u*)(o0 + (size_t)r * DM))[lane + 64 * j] = w; } }
}

__device__ __forceinline__ void s5_tables_item(Frame& F, int item);
__device__ __forceinline__ void p0_prologue(Frame& F) {
    const int gw = F.bid * NWAVES + F.wave, NGW = F.G * NWAVES;
    bf16* XN = (bf16*)(F.ws + WS_XN);
    for (int m = 4 * gw; m < MTOK; m += 4 * NGW) rms_row4_bf16(xrow(F, m), F.in[6], XN + (size_t)m * DM, F.lane);
#if REP_XN == 2
    for (int m = 4 * gw; m < MTOK; m += 4 * NGW) rms_row4_bf16(xrow(F, m), F.in[6], XN + (size_t)m * DM, F.lane);
#endif
    bf16* WinT = (bf16*)(F.ws + WS_WIN);
    constexpr int I_IN = (DM / 64) * (INC / 64);
    for (int r = gw; r < I_IN; r += NGW) { const int nblk = INC / 64, kb = r / nblk, nb = r % nblk, sn0 = nb * 64; const int seg = sn0 / 512, off = sn0 % 512;
        const int dseg = seg == 0 ? 0 : seg == 1 ? 1 : seg == 2 ? 4 : seg == 3 ? 2 : 3;
        transpose_item(F.in[7], INC, WinT, DM, kb * 64, sn0, dseg * 512 + off, F.lane); }
    for (int it = F.bid; it < 256; it += F.G) s5_tables_item(F, it);
}

template <int PART> __device__ __forceinline__ void deferred_transposes(Frame& F, int gw, int ngw) {
    bf16* WgluT = (bf16*)(F.ws + WS_WGLU); bf16* WoutT = (bf16*)(F.ws + WS_WOUT); bf16* WguT = (bf16*)(F.ws + WS_WGU); bf16* WdT = (bf16*)(F.ws + WS_WD);
    constexpr int I_GLU = (S5W / 64) * (S5W / 64), I_OUT = (DM / 64) * (DM / 64), I_G = (DM / 64) * (DFF / 64), I_D = (DFF / 64) * (DM / 64);
    constexpr int N0 = I_GLU + I_OUT + 2 * I_G, NITEMS = (PART == 0) ? N0 : I_D;
    for (int it = gw; it < NITEMS; it += ngw) {
        int r = (PART == 0) ? it : it + N0;
        if (r < I_GLU) { const int nblk = S5W / 64, kb = r / nblk, nb = r % nblk; transpose_item(F.in[16], S5W, WgluT, S5W, kb * 64, nb * 64, nb * 64, F.lane); continue; } r -= I_GLU;
        if (r < I_OUT) { const int nblk = DM / 64, kb = r / nblk, nb = r % nblk; transpose_item(F.in[18], DM, WoutT, DM, kb * 64, nb * 64, nb * 64, F.lane); continue; } r -= I_OUT;
        if (r < I_G) { const int nblk = DFF / 64, kb = r / nblk, nb = r % nblk, sn0 = nb * 64; transpose_item(F.in[20], DFF, WguT, DM, kb * 64, sn0, 256 * (sn0 / 128) + (sn0 % 128), F.lane, F.in[19]); continue; } r -= I_G;
        if (r < I_G) { const int nblk = DFF / 64, kb = r / nblk, nb = r % nblk, sn0 = nb * 64; transpose_item(F.in[21], DFF, WguT, DM, kb * 64, sn0, 256 * (sn0 / 128) + 128 + (sn0 % 128), F.lane, F.in[19]); continue; } r -= I_G;
        { const int nblk = DM / 64, kb = r / nblk, nb = r % nblk; transpose_item(F.in[22], DM, WdT, DFF, kb * 64, nb * 64, nb * 64, F.lane); }
    }
}

using pg8::Unit; using pg8::u32x4; using pg8::cvt_pk_bf16; using pg8::BM; using pg8::HALF;
struct EpiIn {
    static constexpr bool PERM = true, AFTER_DRAIN = false;
    bf16* PB; float* FZ; bf16* U5;
    __device__ __forceinline__ void operator()(const pg8::f32x4 (&acc)[2][2][4][2], const Unit& u, int wr, int wc, int fr, int fq) const {
        const int row0 = u.pm * BM + wr * 64 + fr;
        if (u.pn < 2) { const int col0 = u.pn * BM + wc * 32 + 8 * fq;
#pragma unroll
            for (int ai = 0; ai < 2; ++ai)
#pragma unroll
                for (int m = 0; m < 4; ++m) { const size_t r = (size_t)(row0 + ai * HALF + m * 16);
#pragma unroll
                    for (int bj = 0; bj < 2; ++bj) { const int col = col0 + bj * HALF; const pg8::f32x4 v0 = acc[ai][bj][m][0], v1 = acc[ai][bj][m][1]; u32x4 w; w.x = cvt_pk_bf16(v0[0], v0[1]); w.y = cvt_pk_bf16(v0[2], v0[3]); w.z = cvt_pk_bf16(v1[0], v1[1]); w.w = cvt_pk_bf16(v1[2], v1[3]);
                        *(u32x4*)(U5 + ((size_t)(col >> 4) * MTOK + r) * 16 + (col & 15)) = w; } }
        } else if (u.pn < 8) { const int col0 = u.pn * BM + wc * 32 + 8 * fq;
#pragma unroll
            for (int ai = 0; ai < 2; ++ai)
#pragma unroll
                for (int m = 0; m < 4; ++m) { bf16* rowp = PB + (size_t)(row0 + ai * HALF + m * 16) * PBW + col0;
#pragma unroll
                    for (int bj = 0; bj < 2; ++bj) { const pg8::f32x4 v0 = acc[ai][bj][m][0], v1 = acc[ai][bj][m][1]; u32x4 w; w.x = cvt_pk_bf16(v0[0], v0[1]); w.y = cvt_pk_bf16(v0[2], v0[3]); w.z = cvt_pk_bf16(v1[0], v1[1]); w.w = cvt_pk_bf16(v1[2], v1[3]);
                        *(u32x4*)(rowp + bj * HALF) = w; } }
        } else { const int col0 = (u.pn - 8) * BM + wc * 32 + 8 * fq;
#pragma unroll
            for (int ai = 0; ai < 2; ++ai)
#pragma unroll
                for (int m = 0; m < 4; ++m) { float* rowp = FZ + (size_t)(row0 + ai * HALF + m * 16) * 512 + col0;
#pragma unroll
                    for (int bj = 0; bj < 2; ++bj)
#pragma unroll
                        for (int n = 0; n < 2; ++n) *(pg8::f32x4*)(rowp + bj * HALF + 4 * n) = acc[ai][bj][m][n]; }
        }
    }
};
struct EpiGlu {
    static constexpr bool PERM = true, AFTER_DRAIN = false;
    const bf16* GY; bf16* MIX;
    __device__ __forceinline__ void operator()(const pg8::f32x4 (&acc)[2][2][4][2], const Unit& u, int wr, int wc, int fr, int fq) const {
        const int row0 = u.pm * BM + wr * 64 + fr, col0 = u.pn * BM + wc * 32 + 8 * fq;
#pragma unroll
        for (int ai = 0; ai < 2; ++ai)
#pragma unroll
            for (int m = 0; m < 4; ++m) { const size_t r = (size_t)(row0 + ai * HALF + m * 16);
#pragma unroll
                for (int bj = 0; bj < 2; ++bj) { const int col = col0 + bj * HALF; const u32x4 g = *(const u32x4*)(GY + ((size_t)(col >> 4) * MTOK + r) * 16 + (col & 15)); const pg8::f32x4 v0 = acc[ai][bj][m][0], v1 = acc[ai][bj][m][1];
                    u32x4 w; w.x = cvt_pk_bf16(bflo(g.x) * sigmoidf_(v0[0]), bfhi(g.x) * sigmoidf_(v0[1])); w.y = cvt_pk_bf16(bflo(g.y) * sigmoidf_(v0[2]), bfhi(g.y) * sigmoidf_(v0[3]));
                    w.z = cvt_pk_bf16(bflo(g.z) * sigmoidf_(v1[0]), bfhi(g.z) * sigmoidf_(v1[1])); w.w = cvt_pk_bf16(bflo(g.w) * sigmoidf_(v1[2]), bfhi(g.w) * sigmoidf_(v1[3]));
                    *(u32x4*)(MIX + r * DM + col0 + bj * HALF) = w; } }
    }
};
__device__ __forceinline__ float rstd_of(float ss) { return 1.0f / sqrtf(ss * (1.0f / DM) + EPS); }
__device__ __forceinline__ float atomic_read_f32(float* p) { return __hip_atomic_fetch_add(p, 0.0f, __ATOMIC_RELAXED, __HIP_MEMORY_SCOPE_AGENT); }
__device__ __forceinline__ void wait_count(unsigned* cnt, unsigned want) {
    for (unsigned sp = 0; sp < (1u << 22); ++sp) { if (__hip_atomic_load(cnt, __ATOMIC_RELAXED, __HIP_MEMORY_SCOPE_AGENT) >= want) break; __builtin_amdgcn_s_sleep(2); }
}
struct EpiOut {
    static constexpr bool PERM = true, AFTER_DRAIN = false;
    const float* xp; bf16* XN; float* SS1;
    __device__ __forceinline__ void operator()(const pg8::f32x4 (&acc)[2][2][4][2], const Unit& u, int wr, int wc, int fr, int fq) const {
        const int row0 = u.pm * BM + wr * 64 + fr, col0 = u.pn * BM + wc * 32 + 8 * fq;
#pragma unroll
        for (int ai = 0; ai < 2; ++ai)
#pragma unroll
            for (int m = 0; m < 4; ++m) { const int row = row0 + ai * HALF + m * 16; const size_t off = (size_t)row * DM + col0; float ss = 0.f;
#pragma unroll
                for (int bj = 0; bj < 2; ++bj) { const pg8::f32x4 x0 = *(const pg8::f32x4*)(xp + off + bj * HALF) + acc[ai][bj][m][0], x1 = *(const pg8::f32x4*)(xp + off + bj * HALF + 4) + acc[ai][bj][m][1];
                    ss += (x0[0] * x0[0] + x0[1] * x0[1]) + (x0[2] * x0[2] + x0[3] * x0[3]) + (x1[0] * x1[0] + x1[1] * x1[1]) + (x1[2] * x1[2] + x1[3] * x1[3]);
                    u32x4 w; w.x = cvt_pk_bf16(x0[0], x0[1]); w.y = cvt_pk_bf16(x0[2], x0[3]); w.z = cvt_pk_bf16(x1[0], x1[1]); w.w = cvt_pk_bf16(x1[2], x1[3]);
                    *(u32x4*)(XN + off + bj * HALF) = w; }
                ss += __shfl_xor(ss, 16); ss += __shfl_xor(ss, 32);
                if (fq == 0) __hip_atomic_fetch_add(SS1 + row, ss, __ATOMIC_RELAXED, __HIP_MEMORY_SCOPE_AGENT); }
    }
};
struct EpiAct {
    static constexpr bool PERM = true, AFTER_DRAIN = false;
    bf16* ACT; const float* SS1;
    __device__ __forceinline__ void operator()(const pg8::f32x4 (&acc)[2][2][4][2], const Unit& u, int wr, int wc, int fr, int fq) const {
        const int row0 = u.pm * BM + wr * 64 + fr, col0 = u.pn * HALF + wc * 32 + 8 * fq;
#pragma unroll
        for (int ai = 0; ai < 2; ++ai)
#pragma unroll
            for (int m = 0; m < 4; ++m) { const int row = row0 + ai * HALF + m * 16; const float rs = rstd_of(SS1[row]);
                const pg8::f32x4 g0 = acc[ai][0][m][0] * rs, g1 = acc[ai][0][m][1] * rs, u0 = acc[ai][1][m][0] * rs, u1 = acc[ai][1][m][1] * rs;
                u32x4 w; w.x = cvt_pk_bf16(siluf_(g0[0]) * u0[0], siluf_(g0[1]) * u0[1]); w.y = cvt_pk_bf16(siluf_(g0[2]) * u0[2], siluf_(g0[3]) * u0[3]);
                w.z = cvt_pk_bf16(siluf_(g1[0]) * u1[0], siluf_(g1[1]) * u1[1]); w.w = cvt_pk_bf16(siluf_(g1[2]) * u1[2], siluf_(g1[3]) * u1[3]);
                *(u32x4*)(ACT + (size_t)row * DFF + col0) = w; }
    }
};
struct EpiDown {
    static constexpr bool PERM = true, AFTER_DRAIN = false;
    const bf16* X1; const float* gain; float* SS2; unsigned* cnt; float* YO;
    __device__ __forceinline__ void operator()(pg8::f32x4 (&acc)[2][2][4][2], const Unit& u, int wr, int wc, int fr, int fq) const {
        const int row0 = u.pm * BM + wr * 64 + fr, col0 = u.pn * BM + wc * 32 + 8 * fq;
#pragma unroll
        for (int ai = 0; ai < 2; ++ai)
#pragma unroll
            for (int m = 0; m < 4; ++m) { const int row = row0 + ai * HALF + m * 16; const size_t off = (size_t)row * DM + col0; float ss = 0.f;
#pragma unroll
                for (int bj = 0; bj < 2; ++bj) { const u32x4 xb = *(const u32x4*)(X1 + off + bj * HALF);
                    const pg8::f32x4 x0 = (pg8::f32x4){bflo(xb.x), bfhi(xb.x), bflo(xb.y), bfhi(xb.y)} + acc[ai][bj][m][0], x1 = (pg8::f32x4){bflo(xb.z), bfhi(xb.z), bflo(xb.w), bfhi(xb.w)} + acc[ai][bj][m][1];
                    acc[ai][bj][m][0] = x0; acc[ai][bj][m][1] = x1;
                    ss += (x0[0] * x0[0] + x0[1] * x0[1]) + (x0[2] * x0[2] + x0[3] * x0[3]) + (x1[0] * x1[0] + x1[1] * x1[1]) + (x1[2] * x1[2] + x1[3] * x1[3]); }
                ss += __shfl_xor(ss, 16); ss += __shfl_xor(ss, 32);
                if (fq == 0) __hip_atomic_fetch_add(SS2 + row, ss, __ATOMIC_RELAXED, __HIP_MEMORY_SCOPE_AGENT); }
        asm volatile("s_waitcnt vmcnt(0)" ::: "memory");
        unsigned* c = cnt + 64 * u.pm;
        if (threadIdx.x % 64 == 0) __hip_atomic_fetch_add(c, 1u, __ATOMIC_RELAXED, __HIP_MEMORY_SCOPE_AGENT);
        wait_count(c, 32u);
        pg8::f32x4 gn[2][2];
#pragma unroll
        for (int bj = 0; bj < 2; ++bj)
#pragma unroll
            for (int n = 0; n < 2; ++n) gn[bj][n] = *(const pg8::f32x4*)(gain + col0 + bj * HALF + 4 * n);
        float rs[2][4];
#pragma unroll
        for (int ai = 0; ai < 2; ++ai)
#pragma unroll
            for (int m = 0; m < 4; ++m) { float s = 0.f; if (fq == 0) s = atomic_read_f32(SS2 + row0 + ai * HALF + m * 16); rs[ai][m] = rstd_of(__shfl(s, fr)); }
#pragma unroll
        for (int ai = 0; ai < 2; ++ai)
#pragma unroll
            for (int m = 0; m < 4; ++m) { const size_t off = (size_t)(row0 + ai * HALF + m * 16) * DM + col0;
#pragma unroll
                for (int bj = 0; bj < 2; ++bj) { *(pg8::f32x4*)(YO + off + bj * HALF) = acc[ai][bj][m][0] * rs[ai][m] * gn[bj][0]; *(pg8::f32x4*)(YO + off + bj * HALF + 4) = acc[ai][bj][m][1] * rs[ai][m] * gn[bj][1]; } }
    }
};

typedef float f32x16 __attribute__((ext_vector_type(16)));
typedef short s16x8 __attribute__((ext_vector_type(8)));
constexpr size_t WS_U5 = WS_OH, WS_T5 = 231 * MiB;
constexpr size_t T5_STRIDE = 73728, T5_VG = 32768, T5_KC = 65536;
constexpr int S5_LD = 136;
__device__ __forceinline__ void s5_tables_item(Frame& F, int item) {
    const int tid = F.tid, g = item >> 3, part = item & 7;
    LAS float* Pre = (LAS float*)F.lds; LAS float* Pim = Pre + 9 * 64; LAS float* Ff = Pim + 9 * 64;
    LAS float* Cre = Ff + 128, * Cim = Cre + 1024, * Bre = Cim + 1024, * Bim = Bre + 1024;
    if (tid < 64) { const int n = tid;
        const float a_re = F.in[8][g * S5N + n], a_im = F.in[9][g * S5N + n], dt = expf(F.in[10][g]);
        const float mag = expf(a_re * dt), ab_re = mag * cosf(a_im * dt), ab_im = mag * sinf(a_im * dt);
        const float den = a_re * a_re + a_im * a_im, nr = ab_re - 1.0f, ni = ab_im;
        Ff[n] = (nr * a_re + ni * a_im) / den; Ff[64 + n] = (ni * a_re - nr * a_im) / den;
        float pr = 1.f, pi = 0.f;
#pragma unroll
        for (int j = 0; j < 9; ++j) { Pre[j * 64 + n] = pr; Pim[j * 64 + n] = pi; const float t = pr * ab_re - pi * ab_im; pi = pr * ab_im + pi * ab_re; pr = t; }
    }
    __syncthreads();
#pragma unroll
    for (int i = 0; i < 2; ++i) { const int idx = tid + 512 * i;
        { const int c = idx >> 6, n = idx & 63; Cre[c * 64 + n] = F.in[13][(size_t)(g * 16 + c) * S5N + n]; Cim[c * 64 + n] = F.in[14][(size_t)(g * 16 + c) * S5N + n]; }
        { const int n = idx >> 4, c = idx & 15; const float br = F.in[11][(size_t)(g * S5N + n) * 16 + c], bi = F.in[12][(size_t)(g * S5N + n) * 16 + c], fr = Ff[n], fi = Ff[64 + n];
          Bre[n * 16 + c] = fr * br - fi * bi; Bim[n * 16 + c] = fr * bi + fi * br; } }
    __syncthreads();
    bf16* WG = (bf16*)(F.ws + WS_T5 + (size_t)g * T5_STRIDE); bf16* VG = (bf16*)(F.ws + WS_T5 + (size_t)g * T5_STRIDE + T5_VG); bf16* KC = (bf16*)(F.ws + WS_T5 + (size_t)g * T5_STRIDE + T5_KC);
    if (tid < 256) { const int j = part, c = tid >> 4, cp = tid & 15; float acc = 0.f;
#pragma unroll 4
        for (int n = 0; n < 64; ++n) { const float cr = Cre[c * 64 + n], ci = Cim[c * 64 + n], pr = Pre[j * 64 + n], pi = Pim[j * 64 + n];
            const float xr = cr * pr - ci * pi, xi = cr * pi + ci * pr; acc += xr * Bre[n * 16 + cp] - xi * Bim[n * 16 + cp]; }
        KC[j * 256 + tid] = (bf16)f2bf(acc);
    } else if (part == 0) KC[2048 + tid - 256] = 0;
#pragma unroll
    for (int i = 0; i < 4; ++i) { const int idx = tid + 512 * i, np = 16 * part + (idx >> 7), k = idx & 127, s = k >> 4, cp = k & 15, n = np & 63;
        const float pr = Pre[(7 - s) * 64 + n], pi = Pim[(7 - s) * 64 + n], br = Bre[n * 16 + cp], bi = Bim[n * 16 + cp];
        WG[np * 128 + k] = (bf16)f2bf(np < 64 ? pr * br - pi * bi : pr * bi + pi * br); }
#pragma unroll
    for (int i = 0; i < 4; ++i) { const int idx = tid + 512 * i, col = 16 * part + (idx >> 7), np = idx & 127, t = col >> 4, c = col & 15, n = np & 63;
        const float pr = Pre[(t + 1) * 64 + n], pi = Pim[(t + 1) * 64 + n], cr = Cre[c * 64 + n], ci = Cim[c * 64 + n];
        VG[col * 128 + np] = (bf16)f2bf(np < 64 ? cr * pr - ci * pi : -(cr * pi + ci * pr)); }
    __syncthreads();
}
constexpr int L5_WG = 0, L5_VG = 34816, L5_KC = 69632, L5_U = 74240, L5_HS = 91648, L5_HL = 109056, L5_L8 = 141824;
__device__ __forceinline__ void s5_item(Frame& F, int item) {
    const int tid = F.tid, lane = F.lane, wave = F.wave;
    const int g = item & 31, b8 = item >> 5;
    LAS bf16* WgT = (LAS bf16*)(F.lds + L5_WG); LAS bf16* VgT = (LAS bf16*)(F.lds + L5_VG); LAS bf16* Kc = (LAS bf16*)(F.lds + L5_KC);
    LAS bf16* Us = (LAS bf16*)(F.lds + L5_U); LAS bf16* HS = (LAS bf16*)(F.lds + L5_HS); LAS float* HL = (LAS float*)(F.lds + L5_HL); LAS float* L8 = (LAS float*)(F.lds + L5_L8);
    LAS bf16* YS = (LAS bf16*)(F.lds + L5_HL);
    const bf16* U5 = (const bf16*)(F.ws + WS_U5) + (size_t)g * MTOK * 16; bf16* GY = (bf16*)(F.ws + WS_GY) + (size_t)g * MTOK * 16;
    { const bf16* WG = (const bf16*)(F.ws + WS_T5 + (size_t)g * T5_STRIDE); const bf16* VG = WG + T5_VG / 2; const bf16* KC = WG + T5_KC / 2;
#pragma unroll
      for (int i = 0; i < 4; ++i) { const int p = tid + 512 * i, r = p >> 4, kg = (p & 15) * 8; *(LAS v4u*)(WgT + r * S5_LD + kg) = *(const v4u*)(WG + r * 128 + kg); *(LAS v4u*)(VgT + r * S5_LD + kg) = *(const v4u*)(VG + r * 128 + kg); }
      if (tid < 288) *(LAS v4u*)(Kc + tid * 8) = *(const v4u*)(KC + tid * 8); }
    float qr[9], qi[9];
    { const float a_re = F.in[8][g * S5N + lane], a_im = F.in[9][g * S5N + lane], dt = expf(F.in[10][g]);
      const float mag = expf(a_re * dt); float p8r = mag * cosf(a_im * dt), p8i = mag * sinf(a_im * dt);
#pragma unroll
      for (int i = 0; i < 3; ++i) { const float t = p8r * p8r - p8i * p8i; p8i = 2.0f * p8r * p8i; p8r = t; }
      qr[0] = 1.f; qi[0] = 0.f;
#pragma unroll
      for (int i = 1; i < 9; ++i) { qr[i] = qr[i - 1] * p8r - qi[i - 1] * p8i; qi[i] = qr[i - 1] * p8i + qi[i - 1] * p8r; } }
    const float dl = F.in[15][g * 16 + (lane & 15)];
    const int rb = wave >> 2, cb = wave & 3, r32 = lane & 31, hh = lane >> 5;
    float h_re = 0.f, h_im = 0.f;
    float sre[2], sim[2];
#pragma unroll
    for (int i = 0; i < 2; ++i) { const size_t idx = (size_t)((16 * b8 + 2 * wave + i) * S5G + g) * S5N + lane; sre[i] = F.in[2][idx]; sim[i] = F.in[3][idx]; }
    v4u un0, un1;
    { const v4u* src = (const v4u*)(U5 + (size_t)(b8 * PB_T) * 16); un0 = src[tid]; un1 = src[tid + 512]; }
    for (int seg = 0; seg < 5; ++seg) {
        const bool samp = (seg == 4);
        const int tok0 = samp ? MP + 128 * b8 : b8 * PB_T + seg * 512;
        { const int p0 = tid, p1 = tid + 512;
          *(LAS v4u*)(Us + (p0 >> 4) * S5_LD + ((p0 >> 1) & 7) * 16 + (p0 & 1) * 8) = un0; *(LAS v4u*)(Us + (p1 >> 4) * S5_LD + ((p1 >> 1) & 7) * 16 + (p1 & 1) * 8) = un1;
          if (seg < 3) { const v4u* src = (const v4u*)(U5 + (size_t)(b8 * PB_T + (seg + 1) * 512) * 16); un0 = src[tid]; un1 = src[tid + 512]; }
          else if (seg == 3) { const v4u* src = (const v4u*)(U5 + (size_t)(MP + 128 * b8) * 16); if (tid < 256) un0 = src[tid]; } }
        __syncthreads();
        { f32x16 acc = {};
#pragma unroll
          for (int s = 0; s < 8; ++s) { const s16x8 a = *(const LAS s16x8*)(Us + (32 * rb + r32) * S5_LD + s * 16 + 8 * hh); const s16x8 b = *(const LAS s16x8*)(WgT + (32 * cb + r32) * S5_LD + s * 16 + 8 * hh);
              acc = __builtin_amdgcn_mfma_f32_32x32x16_bf16(a, b, acc, 0, 0, 0); }
#pragma unroll
          for (int r = 0; r < 16; ++r) HL[(32 * rb + (r & 3) + 8 * (r >> 2) + 4 * hh) * 128 + 32 * cb + r32] = acc[r]; }
        __syncthreads();
        if (!samp) {
            float xr[8], xi[8], lr[9], li[9];
#pragma unroll
            for (int i = 0; i < 8; ++i) { xr[i] = HL[(8 * wave + i) * 128 + lane]; xi[i] = HL[(8 * wave + i) * 128 + 64 + lane]; }
            lr[0] = 0.f; li[0] = 0.f;
#pragma unroll
            for (int i = 0; i < 8; ++i) { lr[i + 1] = qr[1] * lr[i] - qi[1] * li[i] + xr[i]; li[i + 1] = qr[1] * li[i] + qi[1] * lr[i] + xi[i]; }
            L8[wave * 128 + lane] = lr[8]; L8[wave * 128 + 64 + lane] = li[8];
            __syncthreads();
            float cr = h_re, ci = h_im, mr = h_re, mi = h_im;
#pragma unroll
            for (int w = 0; w < 8; ++w) { const float tr = L8[w * 128 + lane], ti = L8[w * 128 + 64 + lane];
                const float nr = qr[8] * cr - qi[8] * ci + tr, ni = qr[8] * ci + qi[8] * cr + ti; cr = nr; ci = ni; if (w + 1 == wave) { mr = cr; mi = ci; } }
            h_re = cr; h_im = ci;
#pragma unroll
            for (int i = 0; i < 8; ++i) { const float sr = lr[i] + qr[i] * mr - qi[i] * mi, si = li[i] + qr[i] * mi + qi[i] * mr;
                HS[(8 * wave + i) * S5_LD + lane] = (bf16)f2bf(sr); HS[(8 * wave + i) * S5_LD + 64 + lane] = (bf16)f2bf(si); }
            if (seg == 3 && wave == 0) { F.out[O_PRE + (size_t)(b8 * S5G + g) * S5N + lane] = h_re; F.out[O_PIM + (size_t)(b8 * S5G + g) * S5N + lane] = h_im; }
        } else {
#pragma unroll
            for (int i = 0; i < 2; ++i) { const int r = 2 * wave + i; const size_t idx = (size_t)((16 * b8 + r) * S5G + g) * S5N + lane;
                HS[r * S5_LD + lane] = (bf16)f2bf(sre[i]); HS[r * S5_LD + 64 + lane] = (bf16)f2bf(sim[i]);
                F.out[O_SRE + idx] = qr[1] * sre[i] - qi[1] * sim[i] + HL[r * 128 + lane]; F.out[O_SIM + idx] = qr[1] * sim[i] + qi[1] * sre[i] + HL[r * 128 + 64 + lane]; }
        }
        __syncthreads();
        if (!(samp && rb == 1)) { f32x16 acc = {};
            const int tl = 2 * cb + ((lane >> 4) & 1), c = lane & 15;
#pragma unroll
            for (int s = 0; s < 8; ++s) if (s <= 2 * cb + 1) { const int j = tl - s, jj = j < 0 ? 8 : j;
                const s16x8 a = *(const LAS s16x8*)(Us + (32 * rb + r32) * S5_LD + s * 16 + 8 * hh); const s16x8 b = *(const LAS s16x8*)(Kc + (jj * 16 + c) * 16 + 8 * hh);
                acc = __builtin_amdgcn_mfma_f32_32x32x16_bf16(a, b, acc, 0, 0, 0); }
#pragma unroll
            for (int kb = 0; kb < 8; ++kb) { const s16x8 a = *(const LAS s16x8*)(HS + (32 * rb + r32) * S5_LD + kb * 16 + 8 * hh); const s16x8 b = *(const LAS s16x8*)(VgT + (32 * cb + r32) * S5_LD + kb * 16 + 8 * hh);
                acc = __builtin_amdgcn_mfma_f32_32x32x16_bf16(a, b, acc, 0, 0, 0); }
#pragma unroll
            for (int r = 0; r < 16; ++r) { const int row = 32 * rb + (r & 3) + 8 * (r >> 2) + 4 * hh;
                const float u = bf2f(Us[row * S5_LD + tl * 16 + c]); YS[row * 128 + 32 * cb + r32] = (bf16)f2bf(gelu_tanh(acc[r] + dl * u)); }
        }
        __syncthreads();
        { v4u* dst = (v4u*)(GY + (size_t)tok0 * 16);
          if (!samp) { dst[tid] = *(const LAS v4u*)(YS + tid * 8); dst[tid + 512] = *(const LAS v4u*)(YS + (tid + 512) * 8); }
          else if (tid < 256) dst[tid] = *(const LAS v4u*)(YS + tid * 8); }
        __syncthreads();
    }
}
typedef float f32x4v __attribute__((ext_vector_type(4)));
constexpr int HG_LDQ = 136, HG_LDT = 72;
constexpr size_t WS_DSC = WS_XN;
constexpr size_t WS_DEC = WS_CTL + 1 * MiB;
struct HgRaw { float fz[16]; unsigned short q[16]; v4u v0, v1; };
template <bool NEEDQ> __device__ __forceinline__ void hg_load_raw(HgRaw& R, const bf16* PB, const float* FZ, int item, int tid) {
    const int bh = item >> 5, chunk = item & 31, b = bh >> 2, h = bh & 3, tok0 = b * PB_T + chunk * 64, ch = tid & 127, tq = tid >> 7, col = h * HD + ch;
#pragma unroll
    for (int i = 0; i < 16; ++i) { const size_t tok = (size_t)(tok0 + 16 * tq + i); R.fz[i] = FZ[tok * 512 + col]; if (NEEDQ) R.q[i] = PB[tok * PBW + 512 + col]; }
    { const int p = tid, vg = p >> 6, tk = p & 63; R.v0 = *(const v4u*)(PB + (size_t)(tok0 + tk) * PBW + 1024 + h * HD + vg * 8); }
    { const int p = tid + 512, vg = p >> 6, tk = p & 63; R.v1 = *(const v4u*)(PB + (size_t)(tok0 + tk) * PBW + 1024 + h * HD + vg * 8); }
}
#define HG_GATES_R(R) \
    float gl[16], kk[16]; float run = 0.f; \
    _Pragma("unroll") for (int i = 0; i < 16; ++i) { const float sg = __builtin_amdgcn_rcpf(1.0f + __builtin_amdgcn_exp2f(-1.4426950408889634f * R.fz[i])), f = lb + (1.0f - lb) * sg; kk[i] = 1.0f - f; run += __log2f(f); gl[i] = run; } \
    TOT[tq * 128 + ch] = run;
#define HG_VT_STORE(R) \
    { const int vg = tid >> 6, tk = tid & 63; LAS bf16* d = Vt + (vg * 8) * HG_LDT + tk; const v4u w = R.v0; d[0] = (bf16)(w.x & 0xffffu); d[HG_LDT] = (bf16)(w.x >> 16); d[2 * HG_LDT] = (bf16)(w.y & 0xffffu); d[3 * HG_LDT] = (bf16)(w.y >> 16); \
        d[4 * HG_LDT] = (bf16)(w.z & 0xffffu); d[5 * HG_LDT] = (bf16)(w.z >> 16); d[6 * HG_LDT] = (bf16)(w.w & 0xffffu); d[7 * HG_LDT] = (bf16)(w.w >> 16); } \
    { const int vg = (tid + 512) >> 6, tk = tid & 63; LAS bf16* d = Vt + (vg * 8) * HG_LDT + tk; const v4u w = R.v1; d[0] = (bf16)(w.x & 0xffffu); d[HG_LDT] = (bf16)(w.x >> 16); d[2 * HG_LDT] = (bf16)(w.y & 0xffffu); d[3 * HG_LDT] = (bf16)(w.y >> 16); \
        d[4 * HG_LDT] = (bf16)(w.z & 0xffffu); d[5 * HG_LDT] = (bf16)(w.z >> 16); d[6 * HG_LDT] = (bf16)(w.w & 0xffffu); d[7 * HG_LDT] = (bf16)(w.w >> 16); }

constexpr int LA_QS = 0, LA_KS = 17408, LA_KT = 34816, LA_VT = 53248, LA_AT = 71680, LA_TOT = 80896;
constexpr size_t OQ_QH = 0, OQ_OI = 4194304;
__device__ __forceinline__ void hgA_loop(Frame& F) {
    const int tid = F.tid, lane = F.lane, wave = F.wave;
    LAS bf16* Qs = (LAS bf16*)(F.lds + LA_QS); LAS bf16* Ks = (LAS bf16*)(F.lds + LA_KS); LAS bf16* Kt = (LAS bf16*)(F.lds + LA_KT); LAS bf16* Vt = (LAS bf16*)(F.lds + LA_VT);
    LAS bf16* At = (LAS bf16*)(F.lds + LA_AT); LAS float* TOT = (LAS float*)(F.lds + LA_TOT);
    const bf16* PB = (const bf16*)(F.ws + WS_PB); const float* FZ = (const float*)(F.ws + WS_FZ);
    const int ch = tid & 127, tq = tid >> 7, r32 = lane & 31, hh = lane >> 5;
    int item = F.bid; if (item >= 1024) return;
    HgRaw R; hg_load_raw<true>(R, PB, FZ, item, tid);
    for (; item < 1024; item += F.G) {
        const int bh = item >> 5, h = bh & 3, col = h * HD + ch;
        bf16* DSC = (bf16*)(F.ws + WS_DSC) + (size_t)item * HD * HD; float* DEC = (float*)(F.ws + WS_DEC) + (size_t)item * HD;
        bf16* QH = (bf16*)(F.out + O_Y + OQ_QH) + (size_t)item * 64 * HD; bf16* OI = (bf16*)(F.out + O_Y + OQ_OI) + (size_t)item * 8192;
        const float lb = 1.0f / (1.0f + __expf(F.in[5][512 + col] - F.in[5][col]));
        HG_GATES_R(R)
        float qq[16];
#pragma unroll
        for (int i = 0; i < 16; ++i) qq[i] = bf2f(R.q[i]);
        HG_VT_STORE(R)
        if (item + F.G < 1024) hg_load_raw<true>(R, PB, FZ, item + F.G, tid);
        __syncthreads();
        { const float t0 = TOT[ch], t1 = TOT[128 + ch], t2 = TOT[256 + ch], t3 = TOT[384 + ch];
          const float gref = t0 + t1, glast = gref + (t2 + t3), off = (tq == 0 ? 0.f : tq == 1 ? t0 : tq == 2 ? gref : gref + t2);
          const float cS = __builtin_amdgcn_exp2f(gref), cK = __builtin_amdgcn_exp2f(glast - gref);
          unsigned kp[8];
#pragma unroll
          for (int i = 0; i < 16; ++i) { const float e1 = __builtin_amdgcn_exp2f(off + gl[i] - gref), e2 = __builtin_amdgcn_rcpf(e1), qs = qq[i] * e1, ks = kk[i] * e2;
              Qs[(16 * tq + i) * HG_LDQ + ch] = (bf16)f2bf(qs); Ks[(16 * tq + i) * HG_LDQ + ch] = (bf16)f2bf(ks);
              QH[(size_t)(16 * tq + i) * HD + ch] = (bf16)f2bf(qs * cS);
              const unsigned kb = f2bf(ks * cK); if (i & 1) kp[i >> 1] |= kb << 16; else kp[i >> 1] = kb; }
          LAS v4u* kd = (LAS v4u*)(Kt + ch * HG_LDT + 16 * tq); v4u a, c2; a.x = kp[0]; a.y = kp[1]; a.z = kp[2]; a.w = kp[3]; c2.x = kp[4]; c2.y = kp[5]; c2.z = kp[6]; c2.w = kp[7]; kd[0] = a; kd[1] = c2;
          if (tq == 0) DEC[ch] = cS * cK; }
        __syncthreads();
        if (wave < 4) { const int tb = wave >> 1, sb = wave & 1; f32x16 acc = {};
            if (sb <= tb) {
#pragma unroll
                for (int ks = 0; ks < 8; ++ks) { const s16x8 a = *(const LAS s16x8*)(Qs + (32 * tb + r32) * HG_LDQ + 16 * ks + 8 * hh); const s16x8 bb = *(const LAS s16x8*)(Ks + (32 * sb + r32) * HG_LDQ + 16 * ks + 8 * hh);
                    acc = __builtin_amdgcn_mfma_f32_32x32x16_bf16(a, bb, acc, 0, 0, 0); } }
            const int s = 32 * sb + r32;
#pragma unroll
            for (int r = 0; r < 16; ++r) { const int t = 32 * tb + (r & 3) + 8 * (r >> 2) + 4 * hh; At[t * HG_LDT + s] = (s <= t) ? (bf16)f2bf(acc[r]) : (bf16)0; } }
        { const int kb = wave >> 1;
#pragma unroll
          for (int vbi = 0; vbi < 2; ++vbi) { const int vb = 2 * (wave & 1) + vbi; f32x16 acc = {};
#pragma unroll
              for (int ks = 0; ks < 4; ++ks) { const s16x8 a = *(const LAS s16x8*)(Kt + (32 * kb + r32) * HG_LDT + 16 * ks + 8 * hh); const s16x8 bb = *(const LAS s16x8*)(Vt + (32 * vb + r32) * HG_LDT + 16 * ks + 8 * hh);
                  acc = __builtin_amdgcn_mfma_f32_32x32x16_bf16(a, bb, acc, 0, 0, 0); }
              bf16* dst = DSC + (size_t)(32 * vb + r32) * HD + 32 * kb + 4 * hh;
#pragma unroll
              for (int q = 0; q < 4; ++q) { v2u w; w.x = pk2(acc[4 * q], acc[4 * q + 1]); w.y = pk2(acc[4 * q + 2], acc[4 * q + 3]); *(v2u*)(dst + 8 * q) = w; } } }
        __syncthreads();
        { const int tb = wave >> 2, vb = wave & 3, t = 32 * tb + r32; f32x16 acc = {};
#pragma unroll
          for (int ks = 0; ks < 4; ++ks) if (ks < 2 * tb + 2) { const s16x8 a = *(const LAS s16x8*)(Vt + (32 * vb + r32) * HG_LDT + 16 * ks + 8 * hh); const s16x8 bb = *(const LAS s16x8*)(At + t * HG_LDT + 16 * ks + 8 * hh);
              acc = __builtin_amdgcn_mfma_f32_32x32x16_bf16(a, bb, acc, 0, 0, 0); }
          v4u w0, w1; w0.x = pk2(acc[0], acc[1]); w0.y = pk2(acc[2], acc[3]); w0.z = pk2(acc[4], acc[5]); w0.w = pk2(acc[6], acc[7]); w1.x = pk2(acc[8], acc[9]); w1.y = pk2(acc[10], acc[11]); w1.z = pk2(acc[12], acc[13]); w1.w = pk2(acc[14], acc[15]);
          v4u* d = (v4u*)(OI + (size_t)(wave * 64 + lane) * 16); d[0] = w0; d[1] = w1; }
        __syncthreads();
    }
}
__device__ __forceinline__ void hg_scan(Frame& F, bf16* DSO, int sb, int nsb) {
    bf16* DSC = (bf16*)(F.ws + WS_DSC); const float* DEC = (const float*)(F.ws + WS_DEC);
    LAS float* DL = (LAS float*)F.lds;
    for (int T0 = sb * 512; T0 < 32 * 4096; T0 += nsb * 512) {
        const int T = T0 + F.tid, bh = T0 >> 12, e = T & 4095, v = e >> 5, k4 = (e & 31) * 4;
        v2u x[32];
#pragma unroll
        for (int c = 0; c < 32; ++c) x[c] = *(const v2u*)(DSC + ((size_t)(bh * 32 + c) * HD + v) * HD + k4);
#pragma unroll
        for (int i = 0; i < 2; ++i) { const int p = F.tid + 512 * i; *(LAS f32x4*)(DL + p * 4) = *(const f32x4*)(DEC + (size_t)bh * 32 * HD + p * 4); }
        __syncthreads();
        f32x4 S = {0.f, 0.f, 0.f, 0.f};
#pragma unroll
        for (int c = 0; c < 32; ++c) { const f32x4 d = *(const LAS f32x4*)(DL + c * HD + k4);
            v2u o; o.x = pk2(S.x, S.y); o.y = pk2(S.z, S.w); *(v2u*)(DSO + ((size_t)(bh * 32 + c) * HD + v) * HD + k4) = o;
            S.x = d.x * S.x + bflo(x[c].x); S.y = d.y * S.y + bfhi(x[c].x); S.z = d.z * S.z + bflo(x[c].y); S.w = d.w * S.w + bfhi(x[c].y); }
        float* o = F.out + O_PHG + (size_t)bh * HD * HD + (size_t)k4 * HD + v;
        o[0] = S.x; o[HD] = S.y; o[2 * HD] = S.z; o[3 * HD] = S.w;
        __syncthreads();
    }
}
constexpr int LC_SC = 0, LC_QH = 34816, LC_SS = 52224, LC_SLOT = 53248;
__device__ __forceinline__ void hgC_loop(Frame& F, unsigned* ctr) {
    const int tid = F.tid, lane = F.lane, wave = F.wave;
    LAS bf16* SC = (LAS bf16*)(F.lds + LC_SC); LAS bf16* Qh = (LAS bf16*)(F.lds + LC_QH); LAS float* SS = (LAS float*)(F.lds + LC_SS);
    volatile LAS int* slot = (volatile LAS int*)(F.lds + LC_SLOT);
    const bf16* PB = (const bf16*)(F.ws + WS_PB); bf16* MIX = (bf16*)(F.ws + WS_MIX);
    const int r32 = lane & 31, hh = lane >> 5, tb = wave >> 2, vb = wave & 3, t = 32 * tb + r32;
    if (tid == 0) { slot[0] = (int)__hip_atomic_fetch_add(ctr, 1u, __ATOMIC_RELAXED, __HIP_MEMORY_SCOPE_AGENT); slot[1] = (int)__hip_atomic_fetch_add(ctr, 1u, __ATOMIC_RELAXED, __HIP_MEMORY_SCOPE_AGENT); }
    __syncthreads();
    int item = slot[0], nxt = slot[1], par = 0;
    if (item >= 1024) return;
    v4u sc[4], qh[2], oi[2]; v2u og[4];
#define HGC_FETCH(IT) do { const int it_ = (IT); const bf16* DSC = (const bf16*)(F.ws + WS_DSC) + (size_t)it_ * HD * HD; const bf16* QH = (const bf16*)(F.out + O_Y + OQ_QH) + (size_t)it_ * 64 * HD; \
        const bf16* OI = (const bf16*)(F.out + O_Y + OQ_OI) + (size_t)it_ * 8192; const int bh_ = it_ >> 5, tok0_ = (bh_ >> 2) * PB_T + (it_ & 31) * 64, h_ = bh_ & 3; \
        _Pragma("unroll") for (int i = 0; i < 4; ++i) { const int p = tid + 512 * i; sc[i] = *(const v4u*)(DSC + (size_t)(p >> 4) * HD + (p & 15) * 8); } \
        _Pragma("unroll") for (int i = 0; i < 2; ++i) { const int p = tid + 512 * i; qh[i] = *(const v4u*)(QH + (size_t)(p >> 4) * HD + (p & 15) * 8); } \
        oi[0] = *(const v4u*)(OI + (size_t)(wave * 64 + lane) * 16); oi[1] = *(const v4u*)(OI + (size_t)(wave * 64 + lane) * 16 + 8); \
        _Pragma("unroll") for (int q = 0; q < 4; ++q) og[q] = *(const v2u*)(PB + (size_t)(tok0_ + t) * PBW + 1536 + h_ * HD + 32 * vb + 8 * q + 4 * hh); } while (0)
    HGC_FETCH(item);
    for (;;) {
        const int bh = item >> 5, chunk = item & 31, b = bh >> 2, h = bh & 3, tok0 = b * PB_T + chunk * 64;
#pragma unroll
        for (int i = 0; i < 4; ++i) { const int p = tid + 512 * i; *(LAS v4u*)(SC + (p >> 4) * HG_LDQ + (p & 15) * 8) = sc[i]; }
#pragma unroll
        for (int i = 0; i < 2; ++i) { const int p = tid + 512 * i; *(LAS v4u*)(Qh + (p >> 4) * HG_LDQ + (p & 15) * 8) = qh[i]; }
        f32x16 acc;
        acc[0] = bflo(oi[0].x); acc[1] = bfhi(oi[0].x); acc[2] = bflo(oi[0].y); acc[3] = bfhi(oi[0].y); acc[4] = bflo(oi[0].z); acc[5] = bfhi(oi[0].z); acc[6] = bflo(oi[0].w); acc[7] = bfhi(oi[0].w);
        acc[8] = bflo(oi[1].x); acc[9] = bfhi(oi[1].x); acc[10] = bflo(oi[1].y); acc[11] = bfhi(oi[1].y); acc[12] = bflo(oi[1].z); acc[13] = bfhi(oi[1].z); acc[14] = bflo(oi[1].w); acc[15] = bfhi(oi[1].w);
        v2u ogc[4];
#pragma unroll
        for (int q = 0; q < 4; ++q) ogc[q] = og[q];
        if (tid == 0) slot[par] = (int)__hip_atomic_fetch_add(ctr, 1u, __ATOMIC_RELAXED, __HIP_MEMORY_SCOPE_AGENT);
        if (nxt < 1024) HGC_FETCH(nxt);
        __syncthreads();
        const int nn = slot[par];
#pragma unroll
        for (int ks = 0; ks < 8; ++ks) { const s16x8 a = *(const LAS s16x8*)(SC + (32 * vb + r32) * HG_LDQ + 16 * ks + 8 * hh); const s16x8 bb = *(const LAS s16x8*)(Qh + t * HG_LDQ + 16 * ks + 8 * hh);
            acc = __builtin_amdgcn_mfma_f32_32x32x16_bf16(a, bb, acc, 0, 0, 0); }
        { float ss = 0.f;
#pragma unroll
          for (int r = 0; r < 16; ++r) ss += acc[r] * acc[r];
          ss += __shfl_xor(ss, 32);
          if (hh == 0) SS[t * 4 + vb] = ss; }
        __syncthreads();
        { const f32x4 s4 = *(const LAS f32x4*)(SS + t * 4); const float rstd = 1.0f / sqrtf(((s4.x + s4.y) + (s4.z + s4.w)) * (1.0f / HD) + EPS);
#pragma unroll
          for (int q = 0; q < 4; ++q) { const int v0 = 32 * vb + 8 * q + 4 * hh; const f32x4 gn = *(const GAS f32x4*)(F.in[17] + v0);
              v2u w; w.x = pk2(acc[4 * q] * rstd * gn.x * siluf_(bflo(ogc[q].x)), acc[4 * q + 1] * rstd * gn.y * siluf_(bfhi(ogc[q].x)));
              w.y = pk2(acc[4 * q + 2] * rstd * gn.z * siluf_(bflo(ogc[q].y)), acc[4 * q + 3] * rstd * gn.w * siluf_(bfhi(ogc[q].y)));
              *(v2u*)(MIX + (size_t)(tok0 + t) * DM + 512 + h * HD + v0) = w; } }
        __syncthreads();
        if (nxt >= 1024) break;
        item = nxt; nxt = nn; par ^= 1;
    }
#undef HGC_FETCH
}
constexpr int LX_Q = 0, LX_K2 = 4096, LX_K3 = 8192, LX_V = 12288, LX_DEC = 16384, LX_ATT = 16896, LX_OP = 17152, LX_OT = 33536;
__device__ __forceinline__ void hgrn_sample_item(Frame& F, int idx) {
    const int tid = F.tid, b = idx >> 2, h = idx & 3;
    LAS float* Qs = (LAS float*)(F.lds + LX_Q); LAS float* K2 = (LAS float*)(F.lds + LX_K2); LAS float* K3 = (LAS float*)(F.lds + LX_K3); LAS float* Vs = (LAS float*)(F.lds + LX_V);
    LAS float* DEC = (LAS float*)(F.lds + LX_DEC); LAS float* ATT = (LAS float*)(F.lds + LX_ATT); LAS float* OP = (LAS float*)(F.lds + LX_OP); LAS float* OT = (LAS float*)(F.lds + LX_OT);
    const bf16* PB = (const bf16*)(F.ws + WS_PB); const float* FZ = (const float*)(F.ws + WS_FZ); bf16* MIX = (bf16*)(F.ws + WS_MIX);
    const float* S0 = F.in[4] + (size_t)idx * HD * HD; float* Sout = F.out + O_SHG + (size_t)idx * HD * HD;
    const int tok0 = MP + b * SB_T;
    const int v = tid & 127, kq = tid >> 7;
    float s0[32];
#pragma unroll
    for (int j = 0; j < 32; ++j) s0[j] = S0[(size_t)(32 * kq + j) * HD + v];
    if (tid < 128) { const int col = h * HD + tid; const float lb = 1.0f / (1.0f + expf(F.in[5][512 + col] - F.in[5][col]));
        float gl[8], kk[8], qq[8]; float run = 0.f;
#pragma unroll
        for (int t = 0; t < 8; ++t) { const size_t tok = (size_t)(tok0 + t); const float fz = FZ[tok * 512 + col]; qq[t] = bf2f(PB[tok * PBW + 512 + col]);
            const float sg = 1.0f / (1.0f + __expf(-fz)), f = lb + (1.0f - lb) * sg; kk[t] = 1.0f - f; run += __log2f(f); gl[t] = run; }
#pragma unroll
        for (int t = 0; t < 8; ++t) { Qs[t * 128 + tid] = qq[t] * __builtin_amdgcn_exp2f(gl[t]); K2[t * 128 + tid] = kk[t] * __builtin_amdgcn_exp2f(-gl[t]); K3[t * 128 + tid] = kk[t] * __builtin_amdgcn_exp2f(run - gl[t]); }
        DEC[tid] = __builtin_amdgcn_exp2f(run);
    } else if (tid < 256) { const int vv = tid - 128;
#pragma unroll
        for (int t = 0; t < 8; ++t) Vs[t * 128 + vv] = bf2f(PB[(size_t)(tok0 + t) * PBW + 1024 + h * HD + vv]);
    }
    __syncthreads();
    { const int p = tid >> 3, part = tid & 7, t = p >> 3, s = p & 7; float a = 0.f;
#pragma unroll
      for (int j = 0; j < 16; ++j) a += Qs[t * 128 + part + 8 * j] * K2[s * 128 + part + 8 * j];
      a += __shfl_xor(a, 1); a += __shfl_xor(a, 2); a += __shfl_xor(a, 4);
      if (part == 0) ATT[p] = (s <= t) ? a : 0.f; }
    float vr[8], o[8];
#pragma unroll
    for (int t = 0; t < 8; ++t) { vr[t] = Vs[t * 128 + v]; o[t] = 0.f; }
#pragma unroll
    for (int j = 0; j < 32; ++j) { const int k = 32 * kq + j; const float sv = s0[j]; float sn = DEC[k] * sv;
#pragma unroll
        for (int t = 0; t < 8; ++t) { o[t] += Qs[t * 128 + k] * sv; sn += K3[t * 128 + k] * vr[t]; }
        Sout[(size_t)k * HD + v] = sn; }
#pragma unroll
    for (int t = 0; t < 8; ++t) OP[(kq * 8 + t) * 128 + v] = o[t];
    __syncthreads();
#pragma unroll
    for (int r = 0; r < 2; ++r) { const int e = tid + 512 * r, t = e >> 7, vv = e & 127;
        float acc = (OP[(0 * 8 + t) * 128 + vv] + OP[(1 * 8 + t) * 128 + vv]) + (OP[(2 * 8 + t) * 128 + vv] + OP[(3 * 8 + t) * 128 + vv]);
#pragma unroll
        for (int s = 0; s < 8; ++s) acc += ATT[t * 8 + s] * Vs[s * 128 + vv];
        OT[t * 128 + vv] = acc; }
    __syncthreads();
    { const int t = F.wave, lane = F.lane; const float o0 = OT[t * 128 + 2 * lane], o1 = OT[t * 128 + 2 * lane + 1];
      const float rstd = 1.0f / sqrtf(wave_sum(o0 * o0 + o1 * o1) * (1.0f / HD) + EPS);
      const unsigned gw2 = *(const unsigned*)(PB + (size_t)(tok0 + t) * PBW + 1536 + h * HD + 2 * lane);
      const float g0 = F.in[17][2 * lane], g1 = F.in[17][2 * lane + 1];
      *(unsigned*)(MIX + (size_t)(tok0 + t) * DM + 512 + h * HD + 2 * lane) = pk2(o0 * rstd * g0 * siluf_(bflo(gw2)), o1 * rstd * g1 * siluf_(bfhi(gw2))); }
    __syncthreads();
}
constexpr int SG_LD = 68;
template <int KSTEPS  >
__device__ __forceinline__ void small_gemm_tile(Frame& F, const bf16* A, int lda, const bf16* Bt, int K, int r0, int c0, float (&v)[8]) {
    const int lane = F.lane, wave = F.wave, fr = lane & 15, fq = lane >> 4;
    f32x4v acc[4][4];
#pragma unroll
    for (int a = 0; a < 4; ++a)
#pragma unroll
        for (int b = 0; b < 4; ++b) acc[a][b] = (f32x4v){0.f, 0.f, 0.f, 0.f};
    const bf16* ap = A + (size_t)(r0 + fr) * lda + wave * (KSTEPS * 32) + 8 * fq;
    const bf16* bp = Bt + (size_t)(c0 + fr) * K + wave * (KSTEPS * 32) + 8 * fq;
#pragma unroll 2
    for (int ks = 0; ks < KSTEPS; ++ks) {
        s16x8 af[4], bf[4];
#pragma unroll
        for (int i = 0; i < 4; ++i) { af[i] = *(const s16x8*)(ap + (size_t)(16 * i) * lda + 32 * ks); bf[i] = *(const s16x8*)(bp + (size_t)(16 * i) * K + 32 * ks); }
#pragma unroll
        for (int a = 0; a < 4; ++a)
#pragma unroll
            for (int b = 0; b < 4; ++b) acc[a][b] = __builtin_amdgcn_mfma_f32_16x16x32_bf16(bf[b], af[a], acc[a][b], 0, 0, 0);
    }
    LAS float* part = (LAS float*)F.lds + wave * (64 * SG_LD);
#pragma unroll
    for (int a = 0; a < 4; ++a)
#pragma unroll
        for (int b = 0; b < 4; ++b) *(LAS f32x4v*)(part + (16 * a + fr) * SG_LD + 16 * b + 4 * fq) = acc[a][b];
    __syncthreads();
    { const int row = F.tid >> 3, cg8 = (F.tid & 7) * 8; const LAS float* p = (const LAS float*)F.lds + row * SG_LD + cg8;
      f32x4v s0 = {0.f, 0.f, 0.f, 0.f}, s1 = {0.f, 0.f, 0.f, 0.f};
#pragma unroll
      for (int w = 0; w < 8; ++w) { s0 += *(const LAS f32x4v*)(p + w * (64 * SG_LD)); s1 += *(const LAS f32x4v*)(p + w * (64 * SG_LD) + 4); }
      v[0] = s0[0]; v[1] = s0[1]; v[2] = s0[2]; v[3] = s0[3]; v[4] = s1[0]; v[5] = s1[1]; v[6] = s1[2]; v[7] = s1[3]; }
    __syncthreads();
}

__device__ __forceinline__ void outproj_sample_tile(Frame& F, int tile, float* SS1) {
    const int rm = tile >> 4, cn = tile & 15; float v[8];
    small_gemm_tile<4>(F, (const bf16*)(F.ws + WS_MIX), DM, (const bf16*)(F.ws + WS_WOUT), DM, MP + 64 * rm, 64 * cn, v);
    const int row = MP + 64 * rm + (F.tid >> 3), col = 64 * cn + 8 * (F.tid & 7); const size_t off = (size_t)row * DM + col;
    const float* xs = F.in[1] + (size_t)(row - MP) * DM + col; bf16* XN = (bf16*)(F.ws + WS_XN);
    const f32x4v xa = *(const f32x4v*)xs, xb = *(const f32x4v*)(xs + 4);
    const f32x4v x0 = {xa[0] + v[0], xa[1] + v[1], xa[2] + v[2], xa[3] + v[3]}, x1 = {xb[0] + v[4], xb[1] + v[5], xb[2] + v[6], xb[3] + v[7]};
    v4u w; w.x = pk2(x0[0], x0[1]); w.y = pk2(x0[2], x0[3]); w.z = pk2(x1[0], x1[1]); w.w = pk2(x1[2], x1[3]);
    *(v4u*)(XN + off) = w;
    float ss = (x0[0] * x0[0] + x0[1] * x0[1]) + (x0[2] * x0[2] + x0[3] * x0[3]) + (x1[0] * x1[0] + x1[1] * x1[1]) + (x1[2] * x1[2] + x1[3] * x1[3]);
    ss += __shfl_xor(ss, 1); ss += __shfl_xor(ss, 2); ss += __shfl_xor(ss, 4);
    if ((F.tid & 7) == 0) __hip_atomic_fetch_add(SS1 + row, ss, __ATOMIC_RELAXED, __HIP_MEMORY_SCOPE_AGENT);
}
__device__ __forceinline__ void down_sample_tile(Frame& F, int tile, float* SS2, unsigned* cntb, float* YO) {
    const int rm = tile >> 4, cn = tile & 15; float v[8];
    small_gemm_tile<11>(F, (const bf16*)(F.ws + WS_ACT), DFF, (const bf16*)(F.ws + WS_WD), DFF, MP + 64 * rm, 64 * cn, v);
    const int row = MP + 64 * rm + (F.tid >> 3), col = 64 * cn + 8 * (F.tid & 7); const size_t off = (size_t)row * DM + col;
    unsigned* cnt = cntb + 64 * rm; const v4u xw = *(const v4u*)((const bf16*)(F.ws + WS_XN) + off);
    const f32x4v xa = {bflo(xw.x), bfhi(xw.x), bflo(xw.y), bfhi(xw.y)}, xb = {bflo(xw.z), bfhi(xw.z), bflo(xw.w), bfhi(xw.w)}, ga = *(const f32x4v*)(F.in[23] + col), gb = *(const f32x4v*)(F.in[23] + col + 4);
    const f32x4v x0 = {xa[0] + v[0], xa[1] + v[1], xa[2] + v[2], xa[3] + v[3]}, x1 = {xb[0] + v[4], xb[1] + v[5], xb[2] + v[6], xb[3] + v[7]};
    float ss = (x0[0] * x0[0] + x0[1] * x0[1]) + (x0[2] * x0[2] + x0[3] * x0[3]) + (x1[0] * x1[0] + x1[1] * x1[1]) + (x1[2] * x1[2] + x1[3] * x1[3]);
    ss += __shfl_xor(ss, 1); ss += __shfl_xor(ss, 2); ss += __shfl_xor(ss, 4);
    if ((F.tid & 7) == 0) __hip_atomic_fetch_add(SS2 + row, ss, __ATOMIC_RELAXED, __HIP_MEMORY_SCOPE_AGENT);
    asm volatile("s_waitcnt vmcnt(0)" ::: "memory");
    __syncthreads();
    if (F.tid == 0) { __hip_atomic_fetch_add(cnt, 1u, __ATOMIC_RELAXED, __HIP_MEMORY_SCOPE_AGENT); wait_count(cnt, 16u); }
    __syncthreads();
    float s = 0.f; if ((F.tid & 7) == 0) s = atomic_read_f32(SS2 + row);
    const float rs = rstd_of(__shfl(s, F.lane & ~7));
    *(f32x4v*)(YO + off) = (f32x4v){x0[0] * rs * ga[0], x0[1] * rs * ga[1], x0[2] * rs * ga[2], x0[3] * rs * ga[3]};
    *(f32x4v*)(YO + off + 4) = (f32x4v){x1[0] * rs * gb[0], x1[1] * rs * gb[1], x1[2] * rs * gb[2], x1[3] * rs * gb[3]};
}
typedef GAS unsigned gu32;
#define RLX_AGENT __ATOMIC_RELAXED, __HIP_MEMORY_SCOPE_AGENT
constexpr int MISC_OFF = LDS_BYTES - 512;
constexpr int CW_QUEUE = 8192;
constexpr int CW_BAR = 4096;
constexpr size_t CTL_ZERO_BYTES = 524288;
constexpr int CW_DUMMY = 65536;
#define XB_TMO      128
#define XB_XCNT(j)  (256  + 64 * (j))
#define XB_XSUB(j)  (1280 + 64 * (j))
#define XB_XGEN(j)  (2304 + 64 * (j))
#define XB_TOP      3328
#define XB_TOPGEN   3392
#define XCD_BAR_WORDS 3456
#define XB_SPIN_CAP (1u << 18)

__device__ __forceinline__ unsigned xb_ld(unsigned* p)              { return __hip_atomic_load(p, __ATOMIC_RELAXED, __HIP_MEMORY_SCOPE_AGENT); }
__device__ __forceinline__ unsigned xb_add(unsigned* p, unsigned v) { return __hip_atomic_fetch_add(p, v, __ATOMIC_RELAXED, __HIP_MEMORY_SCOPE_AGENT); }
__device__ __forceinline__ unsigned xb_xcc_id() { return (unsigned)__builtin_amdgcn_s_getreg((3 << 11) | 20) & 0xFu; }
#define XB_SPIN(cond, bar) do { unsigned _sp = 0; while (cond) { __builtin_amdgcn_s_sleep(1); \
    if ((++_sp & 255u) == 0u) { if (xb_ld(&(bar)[XB_TMO])) break; if (_sp > XB_SPIN_CAP) { atomicAdd(&(bar)[XB_TMO], 1u); break; } } } } while (0)

struct XcdBarrier {
    unsigned* bar; unsigned x;
    volatile LAS unsigned* st;
};

__device__ __forceinline__ XcdBarrier xcd_barrier_post(unsigned* bar, volatile LAS unsigned* st) {
    XcdBarrier b; b.bar = bar; b.x = xb_xcc_id(); b.st = st;
    if (threadIdx.x == 0) (void)xb_add(&bar[XB_XCNT(b.x)], 1u);
    return b;
}
__device__ __forceinline__ void xcd_barrier_complete(unsigned* bar, unsigned x, unsigned& nloc, unsigned& nx) {
    const unsigned G = gridDim.x * gridDim.y * gridDim.z;
    unsigned sum, cnt, mine, sp = 0u;
    for (;;) {
        sum = 0u; cnt = 0u; mine = 0u;
#pragma unroll
        for (unsigned j = 0; j < 16; ++j) { const unsigned c = xb_ld(&bar[XB_XCNT(j)]); sum += c; cnt += (c > 0u) ? 1u : 0u; mine = (j == x) ? c : mine; }
        if (sum == G) break;
        __builtin_amdgcn_s_sleep(1);
        if ((++sp & 255u) == 0u) { if (xb_ld(&bar[XB_TMO])) break; if (sp > XB_SPIN_CAP) { atomicAdd(&bar[XB_TMO], 1u); break; } }
    }
    nloc = mine > 0u ? mine : 1u; nx = cnt > 0u ? cnt : 1u;
}

__device__ __forceinline__ void xcd_barrier(const XcdBarrier& b) {
    asm volatile("s_waitcnt vmcnt(0)" ::: "memory");
    __syncthreads();
    if (threadIdx.x == 0) {
        unsigned* bar = b.bar;
        __builtin_amdgcn_s_waitcnt(0);
        unsigned nloc = b.st[0], nx = b.st[1];
        if (nloc == 0u) { xcd_barrier_complete(bar, b.x, nloc, nx); b.st[0] = nloc; b.st[1] = nx; }
        const unsigned old = xb_add(&bar[XB_XSUB(b.x)], 1u);
        const unsigned gen = old / nloc;
        if (old + 1u == (gen + 1u) * nloc) {
            __builtin_amdgcn_fence(__ATOMIC_RELEASE, "agent");
            asm volatile("s_waitcnt vmcnt(0)" ::: "memory");
            const unsigned og = xb_add(&bar[XB_TOP], 1u);
            const unsigned tg = og / nx;
            if (og + 1u == (tg + 1u) * nx) xb_add(&bar[XB_TOPGEN], 1u);
            else XB_SPIN(xb_ld(&bar[XB_TOPGEN]) == tg, bar);
            __builtin_amdgcn_fence(__ATOMIC_ACQUIRE, "agent");
            xb_add(&bar[XB_XGEN(b.x)], 1u);
            asm volatile("s_waitcnt vmcnt(0)" ::: "memory");
        } else {
            XB_SPIN(xb_ld(&bar[XB_XGEN(b.x)]) == gen, bar);
            __builtin_amdgcn_fence(__ATOMIC_ACQUIRE, "agent");
            asm volatile("s_waitcnt vmcnt(0)" ::: "memory");
        }
    }
    __syncthreads();
}

__global__ void __launch_bounds__(NWAVES * 64, 2) mk_fwd(Args args) {
    extern __shared__ __attribute__((aligned(16))) unsigned char lds[];
    Frame F;
    F.lds = (LAS unsigned char*)lds;
    F.tid = threadIdx.x; F.lane = F.tid & 63; F.wave = __builtin_amdgcn_readfirstlane(F.tid >> 6);
    F.G = gridDim.x; F.bid = blockIdx.x;
#pragma unroll
    for (int i = 0; i < 24; ++i) F.in[i] = args.in[i];
    F.out = args.out; F.ws = args.ws;
    const int lo = args.ph_lo, hi = args.ph_hi;
#define IN(k) (lo <= (k) && (k) < hi)
#if MK_N_LAUNCHES == 1
    volatile LAS unsigned* MISC = (volatile LAS unsigned*)(F.lds + MISC_OFF);
    if (F.tid < 32) MISC[F.tid] = 0u;
    __syncthreads();
    XcdBarrier bar = xcd_barrier_post((unsigned*)(F.ws + WS_CTL) + CW_BAR, MISC + 8);
#if defined(PROBE_PH)
    if (F.bid == 0 && F.tid == 0) { const unsigned long long t_ = __builtin_amdgcn_s_memrealtime(); MISC[32] = (unsigned)t_; MISC[33] = (unsigned)(t_ >> 32); }
#endif
#if defined(PROBE_PH)
#define SEAM(k) do { if (IN(k) && IN((k) + 1)) { xcd_barrier(bar); if (F.bid == 0 && F.tid == 0) { const unsigned long long t_ = __builtin_amdgcn_s_memrealtime(); MISC[32 + 2 * ((k) + 1)] = (unsigned)t_; MISC[33 + 2 * ((k) + 1)] = (unsigned)(t_ >> 32); } } } while (0)
#elif REP_BAR == 2
#define SEAM(k) do { if (IN(k) && IN((k) + 1)) { xcd_barrier(bar); xcd_barrier(bar); } } while (0)
#else
#define SEAM(k) do { if (IN(k) && IN((k) + 1)) xcd_barrier(bar); } while (0)
#endif
#else
#define SEAM(k) do { } while (0)
#endif
    const int gw = F.bid * NWAVES + F.wave, NGW = F.G * NWAVES;
    bf16* XN = (bf16*)(F.ws + WS_XN); bf16* PB = (bf16*)(F.ws + WS_PB); float* FZ = (float*)(F.ws + WS_FZ); bf16* GY = (bf16*)(F.ws + WS_GY);
    bf16* MIX = (bf16*)(F.ws + WS_MIX); bf16* ACT = (bf16*)(F.ws + WS_ACT);

    if (IN(0)) { p0_prologue(F);
#if REP_P0 == 2
        __syncthreads(); p0_prologue(F);
#endif
    } SEAM(0);
    if (IN(1)) {
        pg8::Gemm g{XN, (const bf16*)(F.ws + WS_WIN), MTOK, INC, DM}; pg8::StaticOrder S; S.init(MTOK, INC, F.G, F.bid);
        EpiIn E{PB, FZ, (bf16*)(F.ws + WS_U5)};
        pg8::gemm_phase<EpiIn, pg8::StaticOrder, true, true>(F.lds, g, S, E);
        { const int nunits = (MTOK / 256) * (INC / 256), rem = nunits % F.G;
          if (rem == 0) deferred_transposes<0>(F, gw, NGW); else if (F.bid >= rem) deferred_transposes<0>(F, (F.bid - rem) * NWAVES + F.wave, (F.G - rem) * NWAVES); }
#if REP_P1 == 2
        __syncthreads();
        pg8::gemm_phase<EpiIn, pg8::StaticOrder, true, true>(F.lds, g, S, E);
#endif
    } SEAM(1);
    if (IN(2)) {
        if ((F.bid & 1) == 0) {
            for (int it = F.bid; it < 256; it += F.G) s5_item(F, it);
            hgA_loop(F);
            for (int it = F.bid; it < SB_B * HH; it += F.G) hgrn_sample_item(F, it);
        } else {
            for (int it = F.bid; it < SB_B * HH; it += F.G) hgrn_sample_item(F, it);
            hgA_loop(F);
            __syncthreads();
            for (int it = F.bid; it < 256; it += F.G) s5_item(F, it);
        }
    } SEAM(2);
    if (IN(3)) { hg_scan(F, (bf16*)(F.ws + WS_DSC), F.bid, F.G); } SEAM(3);
    if (IN(4)) {
        pg8::Gemm g{GY, (const bf16*)(F.ws + WS_WGLU), MTOK, S5W, S5W}; pg8::StaticOrder S; S.init(MTOK, S5W, F.G, F.bid);
        EpiGlu E{GY, MIX};
        pg8::gemm_phase<EpiGlu, pg8::StaticOrder, true, true, true>(F.lds, g, S, E);
        __syncthreads();
        hgC_loop(F, (unsigned*)(F.ws + WS_CTL) + CW_QUEUE);
    } SEAM(4);
    if (IN(5)) {
        pg8::Gemm g{MIX, (const bf16*)(F.ws + WS_WOUT), MP, DM, DM}; pg8::StaticOrder S; S.init(MP, DM, F.G, F.bid);
#if REP_P5 >= 2
        { EpiOut E2{F.in[0], XN, (float*)(F.ws + WS_CTL) + CW_DUMMY};
#if REP_P5 == 2 || REP_P5 == 3
          pg8::gemm_phase<EpiOut, pg8::StaticOrder, true, true>(F.lds, g, S, E2);
          __syncthreads();
#endif
#if REP_P5 == 2 || REP_P5 == 4
          for (int it = F.bid; it < 256; it += F.G) outproj_sample_tile(F, it, (float*)(F.ws + WS_CTL) + CW_DUMMY);
          __syncthreads();
#endif
        }
#endif
        EpiOut E{F.in[0], XN, (float*)(F.ws + WS_CTL) + CW_SS1};
        const bool first = (F.G == 256) && ((F.bid & 1) == 0);
        if (first) { outproj_sample_tile(F, F.bid, (float*)(F.ws + WS_CTL) + CW_SS1); __syncthreads(); }
        pg8::gemm_phase<EpiOut, pg8::StaticOrder, true, true>(F.lds, g, S, E);
        __syncthreads();
        if (!first) for (int it = F.bid; it < 256; it += F.G) outproj_sample_tile(F, it, (float*)(F.ws + WS_CTL) + CW_SS1);
    } SEAM(5);
    if (IN(6)) {
        pg8::Gemm g{XN, (const bf16*)(F.ws + WS_WGU), MTOK, 2 * DFF, DM}; pg8::StaticOrder S; S.init(MTOK, 2 * DFF, F.G, F.bid);
        EpiAct E{ACT, (const float*)(F.ws + WS_CTL) + CW_SS1};
        pg8::gemm_phase<EpiAct, pg8::StaticOrder, P6_ALIGN, P6_SP2>(F.lds, g, S, E);
        { const int nunits = (MTOK / 256) * (2 * DFF / 256), rem = nunits % F.G;
          if (rem == 0) deferred_transposes<1>(F, gw, NGW); else if (F.bid >= rem) deferred_transposes<1>(F, (F.bid - rem) * NWAVES + F.wave, (F.G - rem) * NWAVES); }
#if REP_P6 == 2
        __syncthreads();
        pg8::gemm_phase<EpiAct, pg8::StaticOrder, true, true>(F.lds, g, S, E);
#endif
    } SEAM(6);
    if (IN(7)) {
        pg8::Gemm g{ACT, (const bf16*)(F.ws + WS_WD), MP, DM, DFF}; pg8::StaticOrder S; S.init(MP, DM, F.G, F.bid);
#if REP_P7 == 2
        { float* YD = (float*)(F.ws + WS_GY) - 0;
          EpiDown E2{XN, F.in[23], (float*)(F.ws + WS_CTL) + CW_DUMMY, (unsigned*)(F.ws + WS_CTL) + CW_DUMMY + 20480, YD};
          pg8::gemm_phase<EpiDown, pg8::StaticOrder, true, true>(F.lds, g, S, E2);
          __syncthreads();
          for (int it = F.bid; it < 256; it += F.G) down_sample_tile(F, it, (float*)(F.ws + WS_CTL) + CW_DUMMY, (unsigned*)(F.ws + WS_CTL) + CW_DUMMY + 20480 + 4096, YD);
          __syncthreads(); }
#endif
        EpiDown E{XN, F.in[23], (float*)(F.ws + WS_CTL) + CW_SS2, (unsigned*)(F.ws + WS_CTL) + CW_CNT, F.out + O_Y};
        Unit u0; const bool has_u = S.next(0, u0); const int grp = has_u ? (u0.pm & 1) : 0;
        const int stile = (F.G == 256 && has_u) ? grp * 128 + (u0.pm >> 1) * 4 + u0.pn : F.bid;
        if (F.G == 256 && grp == 0) { down_sample_tile(F, stile, (float*)(F.ws + WS_CTL) + CW_SS2, (unsigned*)(F.ws + WS_CTL) + CW_CNTS, F.out + O_Y); __syncthreads(); }
        pg8::gemm_phase<EpiDown, pg8::StaticOrder, true, true>(F.lds, g, S, E);
        __syncthreads();
        if (F.G != 256) { for (int it = F.bid; it < 256; it += F.G) down_sample_tile(F, it, (float*)(F.ws + WS_CTL) + CW_SS2, (unsigned*)(F.ws + WS_CTL) + CW_CNTS, F.out + O_Y); }
        else if (grp == 1) down_sample_tile(F, stile, (float*)(F.ws + WS_CTL) + CW_SS2, (unsigned*)(F.ws + WS_CTL) + CW_CNTS, F.out + O_Y);
    }
#if defined(PROBE_PH)
    if (F.bid == 0 && F.tid == 0) {
        const unsigned long long tn = __builtin_amdgcn_s_memrealtime();
        const unsigned long long t0 = ((unsigned long long)MISC[33 + 2 * PROBE_PH] << 32) | MISC[32 + 2 * PROBE_PH];
        const unsigned long long t1 = (PROBE_PH == NPH - 1) ? tn : (((unsigned long long)MISC[35 + 2 * PROBE_PH] << 32) | MISC[34 + 2 * PROBE_PH]);
        const unsigned long long wait = 4ull * (t1 - t0);
        while (__builtin_amdgcn_s_memrealtime() - tn < wait) __builtin_amdgcn_s_sleep(8);
    }
#endif
#undef IN
#undef SEAM
}

extern "C" void kernel_launch(void* const* d_in, const int* in_sizes, int n_in, void* d_out, int out_size, void* d_ws, size_t ws_size, hipStream_t stream) {
    static int grid = 0;
    if (grid == 0) {
        if (n_in != 24 || ws_size < WS_END) { fprintf(stderr, "kernel_launch: unexpected n_in %d / ws %zu\n", n_in, ws_size); grid = -1; return; }
        int dev = 0, cus = 0, per_cu = 0;
        if (hipGetDevice(&dev) != hipSuccess || hipDeviceGetAttribute(&cus, hipDeviceAttributeMultiprocessorCount, dev) != hipSuccess) { grid = -1; return; }
        if (hipFuncSetAttribute((const void*)mk_fwd, hipFuncAttributeMaxDynamicSharedMemorySize, LDS_BYTES) != hipSuccess) { fprintf(stderr, "kernel_launch: hipFuncSetAttribute failed\n"); grid = -1; return; }
        if (hipOccupancyMaxActiveBlocksPerMultiprocessor(&per_cu, (const void*)mk_fwd, NWAVES * 64, LDS_BYTES) != hipSuccess || per_cu < 1) { fprintf(stderr, "kernel_launch: occupancy query says %d\n", per_cu); per_cu = 1; }
        (void)hipGetLastError();
        grid = cus;
    }
    if (grid < 0) return;
#if REP_MEMSET == 2
    (void)hipMemsetAsync((char*)d_ws + WS_CTL + 1048576 + 524288, 0, CTL_ZERO_BYTES, stream);
#endif
    if (hipMemsetAsync((char*)d_ws + WS_CTL, 0, CTL_ZERO_BYTES, stream) != hipSuccess) { fprintf(stderr, "kernel_launch: memset failed\n"); return; }
    Args a{};
    for (int i = 0; i < 24; ++i) a.in[i] = (const float*)d_in[i];
    a.out = (float*)d_out; a.ws = (unsigned char*)d_ws;
#if MK_N_LAUNCHES == 1
    a.ph_lo = 0; a.ph_hi = NPH;
    void* kargs[] = {&a};
    hipError_t e = hipLaunchCooperativeKernel((const void*)mk_fwd, dim3(grid), dim3(NWAVES * 64), kargs, LDS_BYTES, stream);
    if (e != hipSuccess) fprintf(stderr, "kernel_launch: cooperative launch failed: %s (grid %d)\n", hipGetErrorString(e), grid);
#else
    for (int p = 0; p < NPH; ++p) { a.ph_lo = p; a.ph_hi = p + 1; hipLaunchKernelGGL(mk_fwd, dim3(grid), dim3(NWAVES * 64), LDS_BYTES, stream, a); }
#endif
}
```

```cpp
#include <hip/hip_runtime.h>
#include <hip/hip_cooperative_groups.h>
#include <cstdio>
#include <cstdint>
namespace cg = cooperative_groups;
#ifndef PG8_WGM
#define PG8_WGM 4
#endif
#define MK_N_LAUNCHES 1
namespace pg8 {
#define PG8_LAS __attribute__((address_space(3)))
typedef unsigned short bf16_t;
typedef short bf16x8 __attribute__((ext_vector_type(8)));
typedef float f32x4 __attribute__((ext_vector_type(4)));
typedef unsigned u32x4 __attribute__((ext_vector_type(4)));
constexpr int BM = 256, BK = 64, HALF = 128, HTB = HALF * BK * 2  , STAGE_BYTES = 8 * HTB, NXCD = 8, WGM = PG8_WGM;

__host__ __device__ __forceinline__ int lds_byte(int r, int c) { const int st = (r >> 4) * 2 + (c >> 5), rr = r & 15, cc = c & 31, ob = rr * 64 + cc * 2; return st * 1024 + (ob ^ (((ob >> 9) & 1) << 5)); }
__host__ __device__ __forceinline__ void stage_rc(int b, int& R, int& C) { const int st = b / 1024, sb = b % 1024, swz = sb ^ (((sb >> 9) & 1) << 5); R = (st >> 1) * 16 + swz / 64; C = (st & 1) * 32 + (swz % 64) / 2; }
__host__ __device__ __forceinline__ int perm32(int rho) { const int n = rho >> 4, i = rho & 15; return 8 * (i >> 2) + 4 * n + (i & 3); }

struct Unit { int pm, pn; };
struct Gemm { const bf16_t* A; const bf16_t* Bt; int M, N, K; };

struct StaticOrder {
    int nM, nN, nwg, G, c;
    __host__ __device__ void init(int M, int N, int G_, int c_) { nM = M / BM; nN = N / BM; nwg = nM * nN; G = G_; c = c_; }
    __host__ __device__ bool next(int i, Unit& u) const {
        const long L = (long)i * G + c; if (L >= nwg) return false;
        int wgid = (int)L; { const int q = nwg / NXCD, r = nwg % NXCD, xcd = wgid % NXCD, off = wgid / NXCD; wgid = (xcd < r ? xcd * (q + 1) : r * (q + 1) + (xcd - r) * q) + off; }
        const int nig = WGM * nN, gid = wgid / nig, fm = gid * WGM, gsz = (nM - fm) < WGM ? (nM - fm) : WGM;
        u.pm = fm + ((wgid % nig) % gsz); u.pn = (wgid % nig) / gsz; return true;
    }
    __device__ __forceinline__ void a_ready(const Unit&) const {}
    __device__ __forceinline__ void done(const Unit&) const {}
};

__device__ __forceinline__ unsigned cvt_pk_bf16(float lo, float hi) { unsigned r; asm volatile("v_cvt_pk_bf16_f32 %0, %1, %2" : "=v"(r) : "v"(lo), "v"(hi)); return r; }
template <class Epi, class Sched, bool ALIGN_EPI = false, bool SP2 = false, bool AGM = false  >
__device__ __forceinline__ void gemm_phase(PG8_LAS unsigned char* lds, const Gemm g, const Sched& S, const Epi& E) {
    const int tid = threadIdx.x, wid = __builtin_amdgcn_readfirstlane(tid >> 6), lane = tid & 63, wr = wid >> 2, wc = wid & 3, fr = lane & 15, fq = lane >> 4;
    const int K = g.K, nt = K / BK;
    unsigned voffA[2], voffB[2];
#pragma unroll
    for (int i = 0; i < 2; ++i) { int R, C; stage_rc(tid * 16 + i * 8192, R, C); const int Rb = Epi::PERM ? ((R & ~31) + perm32(R & 31)) : R;
        voffA[i] = AGM ? (unsigned)((((C >> 4) * g.M + R) * 16 + (C & 15)) * 2) : (unsigned)(R * K + C) * 2u; voffB[i] = (unsigned)(Rb * K + C) * 2u; }
    const size_t kstep = (size_t)(BK * 2);
    const size_t hstep = (size_t)HALF * K * 2;
    const size_t tstep = 2 * hstep;
    const size_t kstepA = AGM ? (size_t)4 * g.M * 32 : kstep, hstepA = AGM ? (size_t)HALF * 32 : hstep, tstepA = 2 * hstepA;
    const unsigned ldsw = (unsigned)wid * 1024u;
    const int aoff = lds_byte(wr * 64 + fr, fq * 8), boff = lds_byte(wc * 32 + fr, fq * 8);
#define PG8_SA(b, h) (((b) * 2 + (h)) * HTB)
#define PG8_SB(b, h) ((4 + (b) * 2 + (h)) * HTB)
#define PG8_STAGE(bufoff, gbase, voff) do { _Pragma("unroll") for (int _i = 0; _i < 2; ++_i) \
        __builtin_amdgcn_global_load_lds((const unsigned*)((const char*)(gbase) + (voff)[_i]), (PG8_LAS unsigned*)(lds + (bufoff) + ldsw + _i * 8192), 16, 0, 0); } while (0)
#define PG8_LDA(dst, b, h) do { _Pragma("unroll") for (int m = 0; m < 4; ++m) _Pragma("unroll") for (int k = 0; k < 2; ++k) dst[m][k] = *(const PG8_LAS bf16x8*)(lds + PG8_SA(b, h) + aoff + m * 2048 + k * 1024); } while (0)
#define PG8_LDB(dst, b, h) do { _Pragma("unroll") for (int n = 0; n < 2; ++n) _Pragma("unroll") for (int k = 0; k < 2; ++k) dst[n][k] = *(const PG8_LAS bf16x8*)(lds + PG8_SB(b, h) + boff + n * 2048 + k * 1024); } while (0)
#define PG8_MMA(ai, bj, At, Bt) do { __builtin_amdgcn_s_setprio(1); _Pragma("unroll") for (int m = 0; m < 4; ++m) _Pragma("unroll") for (int n = 0; n < 2; ++n) _Pragma("unroll") for (int k = 0; k < 2; ++k) \
        acc[ai][bj][m][n] = __builtin_amdgcn_mfma_f32_16x16x32_bf16(Bt[n][k], At[m][k], acc[ai][bj][m][n], 0, 0, 0); __builtin_amdgcn_s_setprio(0); } while (0)
#define PG8_WAIT_V(n) asm volatile("s_waitcnt vmcnt(" #n ")" ::: "memory")
#define PG8_WAIT_L(n) asm volatile("s_waitcnt lgkmcnt(" #n ")" ::: "memory")
#define PG8_BAR __builtin_amdgcn_s_barrier()
#define PG8_SCHED __builtin_amdgcn_sched_barrier(0)
    Unit cur, nxt; int ui = 0;
    if (!S.next(0, cur)) return;
    f32x4 acc[2][2][4][2];
#pragma unroll
    for (int a = 0; a < 2; ++a)
#pragma unroll
        for (int b = 0; b < 2; ++b)
#pragma unroll
            for (int m = 0; m < 4; ++m)
#pragma unroll
                for (int n = 0; n < 2; ++n) acc[a][b][m][n] = (f32x4){0.f, 0.f, 0.f, 0.f};
    bf16x8 At[4][2], B0[2][2], B1[2][2];
    const char* cA = (const char*)g.A + (size_t)cur.pm * tstepA; const char* cB = (const char*)g.Bt + (size_t)cur.pn * tstep;
    S.a_ready(cur);
    if constexpr (SP2) {
        PG8_STAGE(PG8_SB(0, 0), cB, voffB); PG8_STAGE(PG8_SB(0, 1), cB + hstep, voffB); PG8_STAGE(PG8_SA(0, 0), cA, voffA); PG8_STAGE(PG8_SA(0, 1), cA + hstepA, voffA);
        if (wr == 1) PG8_BAR;
        PG8_WAIT_V(2); PG8_BAR;
        PG8_STAGE(PG8_SB(1, 0), cB + kstep, voffB); PG8_STAGE(PG8_SA(1, 0), cA + kstepA, voffA); PG8_STAGE(PG8_SB(1, 1), cB + hstep + kstep, voffB);
        PG8_WAIT_V(6); PG8_BAR;
    } else {
        PG8_STAGE(PG8_SB(0, 0), cB, voffB); PG8_STAGE(PG8_SA(0, 0), cA, voffA); PG8_STAGE(PG8_SB(0, 1), cB + hstep, voffB); PG8_STAGE(PG8_SA(0, 1), cA + hstepA, voffA);
        if (wr == 1) PG8_BAR;
        PG8_WAIT_V(4); PG8_BAR;
        PG8_STAGE(PG8_SB(1, 0), cB + kstep, voffB); PG8_STAGE(PG8_SA(1, 0), cA + kstepA, voffA); PG8_STAGE(PG8_SB(1, 1), cB + hstep + kstep, voffB);
        PG8_WAIT_V(6); PG8_BAR;
    }
    for (;;) {
        const bool has_next = S.next(ui + 1, nxt);
        const char* nA = has_next ? (const char*)g.A + (size_t)nxt.pm * tstepA : cA; const char* nB = has_next ? (const char*)g.Bt + (size_t)nxt.pn * tstep : cB;
        for (int t = 0; t < nt; t += 2) {
            const bool last = (t == nt - 2);
            const char* a1 = cA + (size_t)(t + 1) * kstepA;
            const char* a2 = last ? nA : cA + (size_t)(t + 2) * kstepA; const char* b2 = last ? nB : cB + (size_t)(t + 2) * kstep;
            const char* a3 = a2 + kstepA; const char* b3 = b2 + kstep;
            if (last && has_next) S.a_ready(nxt);
            if constexpr (SP2) {
            PG8_LDB(B0, 0, 0); PG8_LDB(B1, 0, 1); PG8_SCHED; PG8_LDA(At, 0, 0); PG8_STAGE(PG8_SA(1, 1), a1 + hstepA, voffA);
            PG8_WAIT_V(8); PG8_WAIT_L(0); PG8_BAR; PG8_MMA(0, 0, At, B0); PG8_MMA(0, 1, At, B1); PG8_BAR; PG8_SCHED;
            PG8_LDA(At, 0, 1); PG8_STAGE(PG8_SB(0, 0), b2, voffB); PG8_STAGE(PG8_SB(0, 1), b2 + hstep, voffB); PG8_STAGE(PG8_SA(0, 0), a2, voffA);
            PG8_WAIT_V(8); PG8_WAIT_L(0); PG8_BAR; PG8_MMA(1, 0, At, B0); PG8_MMA(1, 1, At, B1); PG8_BAR; PG8_SCHED;
            PG8_LDB(B0, 1, 0); PG8_LDB(B1, 1, 1); PG8_SCHED; PG8_LDA(At, 1, 0); PG8_STAGE(PG8_SA(0, 1), a2 + hstepA, voffA);
            PG8_WAIT_V(8); PG8_WAIT_L(0); PG8_BAR; PG8_MMA(0, 0, At, B0); PG8_MMA(0, 1, At, B1); PG8_BAR; PG8_SCHED;
            PG8_LDA(At, 1, 1); PG8_STAGE(PG8_SB(1, 0), b3, voffB); PG8_STAGE(PG8_SB(1, 1), b3 + hstep, voffB); PG8_STAGE(PG8_SA(1, 0), a3, voffA);
            PG8_WAIT_V(8); PG8_WAIT_L(0); PG8_BAR; PG8_MMA(1, 0, At, B0); PG8_MMA(1, 1, At, B1); PG8_BAR; PG8_SCHED;
            } else {
            PG8_LDB(B0, 0, 0); PG8_SCHED; PG8_LDA(At, 0, 0); PG8_STAGE(PG8_SA(1, 1), a1 + hstepA, voffA);
            PG8_WAIT_L(8); PG8_BAR; PG8_WAIT_L(0); PG8_MMA(0, 0, At, B0); PG8_BAR; PG8_SCHED;
            PG8_LDB(B1, 0, 1); PG8_STAGE(PG8_SB(0, 0), b2, voffB);
            PG8_BAR; PG8_WAIT_L(0); PG8_MMA(0, 1, At, B1); PG8_BAR;
            PG8_LDA(At, 0, 1); PG8_STAGE(PG8_SA(0, 0), a2, voffA);
            PG8_BAR; PG8_WAIT_L(0); PG8_MMA(1, 0, At, B0); PG8_BAR; PG8_SCHED;
            PG8_STAGE(PG8_SB(0, 1), b2 + hstep, voffB);
            PG8_WAIT_V(6); PG8_BAR; PG8_MMA(1, 1, At, B1); PG8_BAR;
            PG8_LDB(B0, 1, 0); PG8_SCHED; PG8_LDA(At, 1, 0); PG8_STAGE(PG8_SA(0, 1), a2 + hstepA, voffA);
            PG8_WAIT_L(8); PG8_BAR; PG8_WAIT_L(0); PG8_MMA(0, 0, At, B0); PG8_BAR; PG8_SCHED;
            PG8_LDB(B1, 1, 1); PG8_STAGE(PG8_SB(1, 0), b3, voffB);
            PG8_BAR; PG8_WAIT_L(0); PG8_MMA(0, 1, At, B1); PG8_BAR;
            PG8_LDA(At, 1, 1); PG8_STAGE(PG8_SA(1, 0), a3, voffA);
            PG8_BAR; PG8_WAIT_L(0); PG8_MMA(1, 0, At, B0); PG8_BAR; PG8_SCHED;
            PG8_STAGE(PG8_SB(1, 1), b3 + hstep, voffB);
            PG8_WAIT_V(6); PG8_BAR; PG8_MMA(1, 1, At, B1); PG8_BAR;
            }
        }
        if constexpr (ALIGN_EPI) { if (wr == 0) PG8_BAR; }
        if constexpr (!Epi::AFTER_DRAIN) { E(acc, cur, wr, wc, fr, fq); S.done(cur); }
        if (!has_next) break;
#pragma unroll
        for (int a = 0; a < 2; ++a)
#pragma unroll
            for (int b = 0; b < 2; ++b)
#pragma unroll
                for (int m = 0; m < 4; ++m)
#pragma unroll
                    for (int n = 0; n < 2; ++n) acc[a][b][m][n] = (f32x4){0.f, 0.f, 0.f, 0.f};
        cur = nxt; cA = nA; cB = nB; ++ui;
        if constexpr (ALIGN_EPI) { if (wr == 1) PG8_BAR; }
    }
    PG8_WAIT_V(0);
    if constexpr (!ALIGN_EPI) { if (wr == 0) PG8_BAR; }
    PG8_BAR;
    if constexpr (Epi::AFTER_DRAIN) { E.fused(acc, cur, wr, wc, fr, fq, lds, wid, lane); S.done(cur); }
#undef PG8_SA
#undef PG8_SB
#undef PG8_STAGE
#undef PG8_LDA
#undef PG8_LDB
#undef PG8_MMA
#undef PG8_WAIT_V
#undef PG8_WAIT_L
#undef PG8_BAR
#undef PG8_SCHED
}
}

#ifndef S5_SIMPLE
#define S5_SIMPLE 0
#endif
#ifndef HG_SIMPLE
#define HG_SIMPLE 0
#endif
#ifndef REP0
#define REP0 1
#define REP1 1
#define REP2 1
#define REP3 1
#define REP4 1
#define REP6 1
#endif
#ifndef REP_S5
#define REP_S5 1
#endif
#ifndef REP_HGA
#define REP_HGA 1
#endif
#ifndef REP_HGC
#define REP_HGC 1
#endif
#ifndef REP_P1
#define REP_P1 1
#endif
#ifndef REP_P6
#define REP_P6 1
#endif
#ifndef REP_P0
#define REP_P0 1
#endif
#ifndef REP_GLU
#define REP_GLU 1
#endif
#ifndef REP_P3
#define REP_P3 1
#endif
#ifndef REP_P5
#define REP_P5 1
#endif
#ifndef REP_P7
#define REP_P7 1
#endif
#ifndef REP_BAR
#define REP_BAR 1
#endif
#ifndef REP_XN
#define REP_XN 1
#endif
#ifndef P6_ALIGN
#define P6_ALIGN true
#endif
#ifndef P6_SP2
#define P6_SP2 true
#endif
#ifndef REP_MEMSET
#define REP_MEMSET 1
#endif
#ifndef MK_N_LAUNCHES
#define MK_N_LAUNCHES 1
#endif
constexpr int DM = 1024, PB_B = 8, PB_T = 2048, SB_B = 128, SB_T = 8;
constexpr int MP = PB_B * PB_T, MS = SB_B * SB_T, MTOK = MP + MS;
constexpr int S5W = 512, S5G = 32, S5C = 16, S5N = 64;
constexpr int HGW = 512, HD = 128, HH = 4;
constexpr int INC = 2560, DFF = 2816;
constexpr float EPS = 1e-6f;
constexpr int NPH = 8;
constexpr size_t O_Y = 0, O_PRE = (size_t)MTOK * DM, O_PIM = O_PRE + 16384, O_PHG = O_PIM + 16384, O_SRE = O_PHG + 524288, O_SIM = O_SRE + 262144, O_SHG = O_SIM + 262144;
constexpr size_t MiB = 1u << 20;
constexpr size_t WS_CTL = 0, WS_WIN = 2 * MiB, WS_WGLU = 7 * MiB, WS_WOUT = 8 * MiB, WS_WGU = 10 * MiB, WS_WD = 21 * MiB;
constexpr size_t WS_XN = 27 * MiB, WS_PB = 61 * MiB, WS_FZ = 129 * MiB, WS_ACT = 61 * MiB, WS_GY = 163 * MiB, WS_OH = 180 * MiB, WS_MIX = 197 * MiB, WS_END = 234 * MiB;
constexpr int PBW = 2048;
constexpr int LDS_BYTES = 147456;
constexpr int NWAVES = 8;
constexpr int CW_SS1 = 16384, CW_SS2 = 36864, CW_CNT = 57344, CW_CNTS = 61440;

#define GAS __attribute__((address_space(1)))
#define LAS __attribute__((address_space(3)))
typedef unsigned short bf16;
typedef unsigned v4u __attribute__((ext_vector_type(4)));
typedef unsigned v2u __attribute__((ext_vector_type(2)));
typedef float f32x4 __attribute__((ext_vector_type(4)));
#define LDS_WAIT() asm volatile("s_waitcnt lgkmcnt(0)" ::: "memory")
typedef float f32x2_t __attribute__((ext_vector_type(2))); typedef __bf16 bf16x2_t __attribute__((ext_vector_type(2)));
__device__ __forceinline__ unsigned pk2(float lo, float hi) { f32x2_t v = {lo, hi}; bf16x2_t h = __builtin_convertvector(v, bf16x2_t); return __builtin_bit_cast(unsigned, h); }
__device__ __forceinline__ unsigned f2bf(float f) { return pk2(f, 0.f) & 0xffffu; }
__device__ __forceinline__ float bf2f(unsigned short h) { return __builtin_bit_cast(float, (unsigned)h << 16); }
__device__ __forceinline__ float bflo(unsigned w) { return __builtin_bit_cast(float, w << 16); }
__device__ __forceinline__ float bfhi(unsigned w) { return __builtin_bit_cast(float, w & 0xffff0000u); }
__device__ __forceinline__ float sigmoidf_(float x) { return __builtin_amdgcn_rcpf(1.0f + __builtin_amdgcn_exp2f(-1.4426950408889634f * x)); }
__device__ __forceinline__ float siluf_(float x) { return x * __builtin_amdgcn_rcpf(1.0f + __builtin_amdgcn_exp2f(-1.4426950408889634f * x)); }
__device__ __forceinline__ float gelu_tanh(float x) { const float z = -2.302208198144325f * (x + 0.044715f * x * x * x); return x * __builtin_amdgcn_rcpf(1.0f + __builtin_amdgcn_exp2f(z)); }
__device__ __forceinline__ float wave_sum(float v) {
#pragma unroll
    for (int o = 1; o < 64; o <<= 1) v += __shfl_xor(v, o);
    return v;
}

struct Args { const float* in[24]; float* out; unsigned char* ws; int ph_lo, ph_hi; };

struct Frame {
    LAS unsigned char* lds;
    int tid, lane, wave, G, bid;
    const float* in[24];
    float* out; unsigned char* ws;
};
__device__ __forceinline__ const float* xrow(const Frame& F, int m) { return m < MP ? F.in[0] + (size_t)m * DM : F.in[1] + (size_t)(m - MP) * DM; }

__device__ __forceinline__ void transpose_item(const float* W, int ldw, bf16* WT, int K, int k0, int sn0, int dn0, int lane, const float* kgain = nullptr) {
    const int k = k0 + 4 * (lane & 15), nl = 4 * (lane >> 4);
    f32x4 r[4][4];
#pragma unroll
    for (int nb = 0; nb < 4; ++nb)
#pragma unroll
        for (int j = 0; j < 4; ++j) r[nb][j] = *(const GAS f32x4*)(W + (size_t)(k + j) * ldw + sn0 + nl + 16 * nb);
    f32x4 g = {1.f, 1.f, 1.f, 1.f}; if (kgain) g = *(const GAS f32x4*)(kgain + k);
#pragma unroll
    for (int nb = 0; nb < 4; ++nb) { const f32x4 a = r[nb][0] * g.x, b = r[nb][1] * g.y, c = r[nb][2] * g.z, d = r[nb][3] * g.w;
        bf16* o = WT + (size_t)(dn0 + nl + 16 * nb) * K + k;
        v2u w; w.x = pk2(a.x, b.x); w.y = pk2(c.x, d.x); *(GAS v2u*)o = w;
        w.x = pk2(a.y, b.y); w.y = pk2(c.y, d.y); *(GAS v2u*)(o + K) = w;
        w.x = pk2(a.z, b.z); w.y = pk2(c.z, d.z); *(GAS v2u*)(o + 2 * (size_t)K) = w;
        w.x = pk2(a.w, b.w); w.y = pk2(c.w, d.w); *(GAS v2u*)(o + 3 * (size_t)K) = w; }
}
__device__ __forceinline__ void rms_row4_bf16(const float* x0_, const float* gain, bf16* o0, int lane) {
    f32x4 v[4][4]; float s[4];
#pragma unroll
    for (int r = 0; r < 4; ++r)
#pragma unroll
        for (int j = 0; j < 4; ++j) v[r][j] = ((const GAS f32x4*)(x0_ + (size_t)r * DM))[lane + 64 * j];
#pragma unroll
    for (int r = 0; r < 4; ++r) { s[r] = 0.f;
#pragma unroll
        for (int j = 0; j < 4; ++j) s[r] += (v[r][j].x * v[r][j].x + v[r][j].y * v[r][j].y) + (v[r][j].z * v[r][j].z + v[r][j].w * v[r][j].w); }
#pragma unroll
    for (int o = 1; o < 64; o <<= 1) { s[0] += __shfl_xor(s[0], o); s[1] += __shfl_xor(s[1], o); s[2] += __shfl_xor(s[2], o); s[3] += __shfl_xor(s[3], o); }
#pragma unroll
    for (int r = 0; r < 4; ++r) s[r] = __builtin_amdgcn_rsqf(s[r] * (1.0f / DM) + EPS);
#pragma unroll
    for (int j = 0; j < 4; ++j) { const f32x4 g = ((const GAS f32x4*)gain)[lane + 64 * j];
#pragma unroll
        for (int r = 0; r < 4; ++r) { const float rs = s[r];
            v2u w; w.x = pk2(v[r][j].x * rs * g.x, v[r][j].y * rs * g.y); w.y = pk2(v[r][j].z * rs * g.z, v[r][j].w * rs * g.w); ((GAS v2u*)(o0 + (size_t)r * DM))[lane + 64 * j] = w; } }
}

__device__ __forceinline__ void s5_tables_item(Frame& F, int item);
__device__ __forceinline__ void p0_prologue(Frame& F) {
    const int gw = F.bid * NWAVES + F.wave, NGW = F.G * NWAVES;
    bf16* XN = (bf16*)(F.ws + WS_XN);
    for (int m = 4 * gw; m < MTOK; m += 4 * NGW) rms_row4_bf16(xrow(F, m), F.in[6], XN + (size_t)m * DM, F.lane);
#if REP_XN == 2
    for (int m = 4 * gw; m < MTOK; m += 4 * NGW) rms_row4_bf16(xrow(F, m), F.in[6], XN + (size_t)m * DM, F.lane);
#endif
    bf16* WinT = (bf16*)(F.ws + WS_WIN);
    constexpr int I_IN = (DM / 64) * (INC / 64);
    for (int r = gw; r < I_IN; r += NGW) { const int nblk = INC / 64, kb = r / nblk, nb = r % nblk, sn0 = nb * 64; const int seg = sn0 / 512, off = sn0 % 512;
        const int dseg = seg == 0 ? 0 : seg == 1 ? 1 : seg == 2 ? 4 : seg == 3 ? 2 : 3;
        transpose_item(F.in[7], INC, WinT, DM, kb * 64, sn0, dseg * 512 + off, F.lane); }
    for (int it = F.bid; it < 256; it += F.G) s5_tables_item(F, it);
}

template <int PART> __device__ __forceinline__ void deferred_transposes(Frame& F, int gw, int ngw) {
    bf16* WgluT = (bf16*)(F.ws + WS_WGLU); bf16* WoutT = (bf16*)(F.ws + WS_WOUT); bf16* WguT = (bf16*)(F.ws + WS_WGU); bf16* WdT = (bf16*)(F.ws + WS_WD);
    constexpr int I_GLU = (S5W / 64) * (S5W / 64), I_OUT = (DM / 64) * (DM / 64), I_G = (DM / 64) * (DFF / 64), I_D = (DFF / 64) * (DM / 64);
    constexpr int N0 = I_GLU + I_OUT + 2 * I_G, NITEMS = (PART == 0) ? N0 : I_D;
    for (int it = gw; it < NITEMS; it += ngw) {
        int r = (PART == 0) ? it : it + N0;
        if (r < I_GLU) { const int nblk = S5W / 64, kb = r / nblk, nb = r % nblk; transpose_item(F.in[16], S5W, WgluT, S5W, kb * 64, nb * 64, nb * 64, F.lane); continue; } r -= I_GLU;
        if (r < I_OUT) { const int nblk = DM / 64, kb = r / nblk, nb = r % nblk; transpose_item(F.in[18], DM, WoutT, DM, kb * 64, nb * 64, nb * 64, F.lane); continue; } r -= I_OUT;
        if (r < I_G) { const int nblk = DFF / 64, kb = r / nblk, nb = r % nblk, sn0 = nb * 64; transpose_item(F.in[20], DFF, WguT, DM, kb * 64, sn0, 256 * (sn0 / 128) + (sn0 % 128), F.lane, F.in[19]); continue; } r -= I_G;
        if (r < I_G) { const int nblk = DFF / 64, kb = r / nblk, nb = r % nblk, sn0 = nb * 64; transpose_item(F.in[21], DFF, WguT, DM, kb * 64, sn0, 256 * (sn0 / 128) + 128 + (sn0 % 128), F.lane, F.in[19]); continue; } r -= I_G;
        { const int nblk = DM / 64, kb = r / nblk, nb = r % nblk; transpose_item(F.in[22], DM, WdT, DFF, kb * 64, nb * 64, nb * 64, F.lane); }
    }
}

using pg8::Unit; using pg8::u32x4; using pg8::cvt_pk_bf16; using pg8::BM; using pg8::HALF;
struct EpiIn {
    static constexpr bool PERM = true, AFTER_DRAIN = false;
    bf16* PB; float* FZ; bf16* U5;
    __device__ __forceinline__ void operator()(const pg8::f32x4 (&acc)[2][2][4][2], const Unit& u, int wr, int wc, int fr, int fq) const {
        const int row0 = u.pm * BM + wr * 64 + fr;
        if (u.pn < 2) { const int col0 = u.pn * BM + wc * 32 + 8 * fq;
#pragma unroll
            for (int ai = 0; ai < 2; ++ai)
#pragma unroll
                for (int m = 0; m < 4; ++m) { const size_t r = (size_t)(row0 + ai * HALF + m * 16);
#pragma unroll
                    for (int bj = 0; bj < 2; ++bj) { const int col = col0 + bj * HALF; const pg8::f32x4 v0 = acc[ai][bj][m][0], v1 = acc[ai][bj][m][1]; u32x4 w; w.x = cvt_pk_bf16(v0[0], v0[1]); w.y = cvt_pk_bf16(v0[2], v0[3]); w.z = cvt_pk_bf16(v1[0], v1[1]); w.w = cvt_pk_bf16(v1[2], v1[3]);
                        *(u32x4*)(U5 + ((size_t)(col >> 4) * MTOK + r) * 16 + (col & 15)) = w; } }
        } else if (u.pn < 8) { const int col0 = u.pn * BM + wc * 32 + 8 * fq;
#pragma unroll
            for (int ai = 0; ai < 2; ++ai)
#pragma unroll
                for (int m = 0; m < 4; ++m) { bf16* rowp = PB + (size_t)(row0 + ai * HALF + m * 16) * PBW + col0;
#pragma unroll
                    for (int bj = 0; bj < 2; ++bj) { const pg8::f32x4 v0 = acc[ai][bj][m][0], v1 = acc[ai][bj][m][1]; u32x4 w; w.x = cvt_pk_bf16(v0[0], v0[1]); w.y = cvt_pk_bf16(v0[2], v0[3]); w.z = cvt_pk_bf16(v1[0], v1[1]); w.w = cvt_pk_bf16(v1[2], v1[3]);
                        *(u32x4*)(rowp + bj * HALF) = w; } }
        } else { const int col0 = (u.pn - 8) * BM + wc * 32 + 8 * fq;
#pragma unroll
            for (int ai = 0; ai < 2; ++ai)
#pragma unroll
                for (int m = 0; m < 4; ++m) { float* rowp = FZ + (size_t)(row0 + ai * HALF + m * 16) * 512 + col0;
#pragma unroll
                    for (int bj = 0; bj < 2; ++bj)
#pragma unroll
                        for (int n = 0; n < 2; ++n) *(pg8::f32x4*)(rowp + bj * HALF + 4 * n) = acc[ai][bj][m][n]; }
        }
    }
};
struct EpiGlu {
    static constexpr bool PERM = true, AFTER_DRAIN = false;
    const bf16* GY; bf16* MIX;
    __device__ __forceinline__ void operator()(const pg8::f32x4 (&acc)[2][2][4][2], const Unit& u, int wr, int wc, int fr, int fq) const {
        const int row0 = u.pm * BM + wr * 64 + fr, col0 = u.pn * BM + wc * 32 + 8 * fq;
#pragma unroll
        for (int ai = 0; ai < 2; ++ai)
#pragma unroll
            for (int m = 0; m < 4; ++m) { const size_t r = (size_t)(row0 + ai * HALF + m * 16);
#pragma unroll
                for (int bj = 0; bj < 2; ++bj) { const int col = col0 + bj * HALF; const u32x4 g = *(const u32x4*)(GY + ((size_t)(col >> 4) * MTOK + r) * 16 + (col & 15)); const pg8::f32x4 v0 = acc[ai][bj][m][0], v1 = acc[ai][bj][m][1];
                    u32x4 w; w.x = cvt_pk_bf16(bflo(g.x) * sigmoidf_(v0[0]), bfhi(g.x) * sigmoidf_(v0[1])); w.y = cvt_pk_bf16(bflo(g.y) * sigmoidf_(v0[2]), bfhi(g.y) * sigmoidf_(v0[3]));
                    w.z = cvt_pk_bf16(bflo(g.z) * sigmoidf_(v1[0]), bfhi(g.z) * sigmoidf_(v1[1])); w.w = cvt_pk_bf16(bflo(g.w) * sigmoidf_(v1[2]), bfhi(g.w) * sigmoidf_(v1[3]));
                    *(u32x4*)(MIX + r * DM + col0 + bj * HALF) = w; } }
    }
};
__device__ __forceinline__ float rstd_of(float ss) { return __builtin_amdgcn_rsqf(ss * (1.0f / DM) + EPS); }
__device__ __forceinline__ float atomic_read_f32(float* p) { return __hip_atomic_fetch_add(p, 0.0f, __ATOMIC_RELAXED, __HIP_MEMORY_SCOPE_AGENT); }
__device__ __forceinline__ void wait_count(unsigned* cnt, unsigned want) {
    for (unsigned sp = 0; sp < (1u << 22); ++sp) { if (__hip_atomic_load(cnt, __ATOMIC_RELAXED, __HIP_MEMORY_SCOPE_AGENT) >= want) break; __builtin_amdgcn_s_sleep(2); }
}
struct EpiOut {
    static constexpr bool PERM = true, AFTER_DRAIN = false;
    const float* xp; bf16* XN; float* SS1;
    __device__ __forceinline__ void operator()(const pg8::f32x4 (&acc)[2][2][4][2], const Unit& u, int wr, int wc, int fr, int fq) const {
        const int row0 = u.pm * BM + wr * 64 + fr, col0 = u.pn * BM + wc * 32 + 8 * fq;
#pragma unroll
        for (int ai = 0; ai < 2; ++ai)
#pragma unroll
            for (int m = 0; m < 4; ++m) { const int row = row0 + ai * HALF + m * 16; const size_t off = (size_t)row * DM + col0; float ss = 0.f;
#pragma unroll
                for (int bj = 0; bj < 2; ++bj) { const pg8::f32x4 x0 = *(const pg8::f32x4*)(xp + off + bj * HALF) + acc[ai][bj][m][0], x1 = *(const pg8::f32x4*)(xp + off + bj * HALF + 4) + acc[ai][bj][m][1];
                    ss += (x0[0] * x0[0] + x0[1] * x0[1]) + (x0[2] * x0[2] + x0[3] * x0[3]) + (x1[0] * x1[0] + x1[1] * x1[1]) + (x1[2] * x1[2] + x1[3] * x1[3]);
                    u32x4 w; w.x = cvt_pk_bf16(x0[0], x0[1]); w.y = cvt_pk_bf16(x0[2], x0[3]); w.z = cvt_pk_bf16(x1[0], x1[1]); w.w = cvt_pk_bf16(x1[2], x1[3]);
                    *(u32x4*)(XN + off + bj * HALF) = w; }
                ss += __shfl_xor(ss, 16); ss += __shfl_xor(ss, 32);
                if (fq == 0) __hip_atomic_fetch_add(SS1 + row, ss, __ATOMIC_RELAXED, __HIP_MEMORY_SCOPE_AGENT); }
    }
};
struct EpiAct {
    static constexpr bool PERM = true, AFTER_DRAIN = false;
    bf16* ACT; const float* SS1;
    __device__ __forceinline__ void operator()(const pg8::f32x4 (&acc)[2][2][4][2], const Unit& u, int wr, int wc, int fr, int fq) const {
        const int row0 = u.pm * BM + wr * 64 + fr, col0 = u.pn * HALF + wc * 32 + 8 * fq;
#pragma unroll
        for (int ai = 0; ai < 2; ++ai)
#pragma unroll
            for (int m = 0; m < 4; ++m) { const int row = row0 + ai * HALF + m * 16; const float rs = rstd_of(SS1[row]);
                const pg8::f32x4 g0 = acc[ai][0][m][0] * rs, g1 = acc[ai][0][m][1] * rs, u0 = acc[ai][1][m][0] * rs, u1 = acc[ai][1][m][1] * rs;
                u32x4 w; w.x = cvt_pk_bf16(siluf_(g0[0]) * u0[0], siluf_(g0[1]) * u0[1]); w.y = cvt_pk_bf16(siluf_(g0[2]) * u0[2], siluf_(g0[3]) * u0[3]);
                w.z = cvt_pk_bf16(siluf_(g1[0]) * u1[0], siluf_(g1[1]) * u1[1]); w.w = cvt_pk_bf16(siluf_(g1[2]) * u1[2], siluf_(g1[3]) * u1[3]);
                *(u32x4*)(ACT + (size_t)row * DFF + col0) = w; }
    }
};
struct EpiDown {
    static constexpr bool PERM = true, AFTER_DRAIN = false;
    const bf16* X1; const float* gain; float* SS2; unsigned* cnt; float* YO;
    __device__ __forceinline__ void operator()(pg8::f32x4 (&acc)[2][2][4][2], const Unit& u, int wr, int wc, int fr, int fq) const {
        const int row0 = u.pm * BM + wr * 64 + fr, col0 = u.pn * BM + wc * 32 + 8 * fq;
#pragma unroll
        for (int ai = 0; ai < 2; ++ai)
#pragma unroll
            for (int m = 0; m < 4; ++m) { const int row = row0 + ai * HALF + m * 16; const size_t off = (size_t)row * DM + col0; float ss = 0.f;
#pragma unroll
                for (int bj = 0; bj < 2; ++bj) { const u32x4 xb = *(const u32x4*)(X1 + off + bj * HALF);
                    const pg8::f32x4 x0 = (pg8::f32x4){bflo(xb.x), bfhi(xb.x), bflo(xb.y), bfhi(xb.y)} + acc[ai][bj][m][0], x1 = (pg8::f32x4){bflo(xb.z), bfhi(xb.z), bflo(xb.w), bfhi(xb.w)} + acc[ai][bj][m][1];
                    acc[ai][bj][m][0] = x0; acc[ai][bj][m][1] = x1;
                    ss += (x0[0] * x0[0] + x0[1] * x0[1]) + (x0[2] * x0[2] + x0[3] * x0[3]) + (x1[0] * x1[0] + x1[1] * x1[1]) + (x1[2] * x1[2] + x1[3] * x1[3]); }
                ss += __shfl_xor(ss, 16); ss += __shfl_xor(ss, 32);
                if (fq == 0) __hip_atomic_fetch_add(SS2 + row, ss, __ATOMIC_RELAXED, __HIP_MEMORY_SCOPE_AGENT); }
        asm volatile("s_waitcnt vmcnt(0)" ::: "memory");
        unsigned* c = cnt + 64 * u.pm;
        if (threadIdx.x % 64 == 0) __hip_atomic_fetch_add(c, 1u, __ATOMIC_RELAXED, __HIP_MEMORY_SCOPE_AGENT);
        wait_count(c, 32u);
        pg8::f32x4 gn[2][2];
#pragma unroll
        for (int bj = 0; bj < 2; ++bj)
#pragma unroll
            for (int n = 0; n < 2; ++n) gn[bj][n] = *(const pg8::f32x4*)(gain + col0 + bj * HALF + 4 * n);
        float rs[2][4];
#pragma unroll
        for (int ai = 0; ai < 2; ++ai)
#pragma unroll
            for (int m = 0; m < 4; ++m) { float s = 0.f; if (fq == 0) s = atomic_read_f32(SS2 + row0 + ai * HALF + m * 16); rs[ai][m] = rstd_of(__shfl(s, fr)); }
#pragma unroll
        for (int ai = 0; ai < 2; ++ai)
#pragma unroll
            for (int m = 0; m < 4; ++m) { const size_t off = (size_t)(row0 + ai * HALF + m * 16) * DM + col0;
#pragma unroll
                for (int bj = 0; bj < 2; ++bj) { *(pg8::f32x4*)(YO + off + bj * HALF) = acc[ai][bj][m][0] * rs[ai][m] * gn[bj][0]; *(pg8::f32x4*)(YO + off + bj * HALF + 4) = acc[ai][bj][m][1] * rs[ai][m] * gn[bj][1]; } }
    }
};

typedef float f32x16 __attribute__((ext_vector_type(16)));
typedef short s16x8 __attribute__((ext_vector_type(8)));
constexpr size_t WS_U5 = WS_OH, WS_T5 = 231 * MiB;
constexpr size_t T5_STRIDE = 73728, T5_VG = 32768, T5_KC = 65536;
constexpr int S5_LD = 136;
__device__ __forceinline__ void s5_tables_item(Frame& F, int item) {
    const int tid = F.tid, g = item >> 3, part = item & 7;
    LAS float* Pre = (LAS float*)F.lds; LAS float* Pim = Pre + 9 * 64; LAS float* Ff = Pim + 9 * 64;
    LAS float* Cre = Ff + 128, * Cim = Cre + 1024, * Bre = Cim + 1024, * Bim = Bre + 1024;
    if (tid < 64) { const int n = tid;
        const float a_re = F.in[8][g * S5N + n], a_im = F.in[9][g * S5N + n], dt = expf(F.in[10][g]);
        const float mag = expf(a_re * dt), ab_re = mag * cosf(a_im * dt), ab_im = mag * sinf(a_im * dt);
        const float den = a_re * a_re + a_im * a_im, nr = ab_re - 1.0f, ni = ab_im;
        Ff[n] = (nr * a_re + ni * a_im) / den; Ff[64 + n] = (ni * a_re - nr * a_im) / den;
        float pr = 1.f, pi = 0.f;
#pragma unroll
        for (int j = 0; j < 9; ++j) { Pre[j * 64 + n] = pr; Pim[j * 64 + n] = pi; const float t = pr * ab_re - pi * ab_im; pi = pr * ab_im + pi * ab_re; pr = t; }
    }
    __syncthreads();
#pragma unroll
    for (int i = 0; i < 2; ++i) { const int idx = tid + 512 * i;
        { const int c = idx >> 6, n = idx & 63; Cre[c * 64 + n] = F.in[13][(size_t)(g * 16 + c) * S5N + n]; Cim[c * 64 + n] = F.in[14][(size_t)(g * 16 + c) * S5N + n]; }
        { const int n = idx >> 4, c = idx & 15; const float br = F.in[11][(size_t)(g * S5N + n) * 16 + c], bi = F.in[12][(size_t)(g * S5N + n) * 16 + c], fr = Ff[n], fi = Ff[64 + n];
          Bre[n * 16 + c] = fr * br - fi * bi; Bim[n * 16 + c] = fr * bi + fi * br; } }
    __syncthreads();
    bf16* WG = (bf16*)(F.ws + WS_T5 + (size_t)g * T5_STRIDE); bf16* VG = (bf16*)(F.ws + WS_T5 + (size_t)g * T5_STRIDE + T5_VG); bf16* KC = (bf16*)(F.ws + WS_T5 + (size_t)g * T5_STRIDE + T5_KC);
    if (tid < 256) { const int j = part, c = tid >> 4, cp = tid & 15; float acc = 0.f;
#pragma unroll 4
        for (int n = 0; n < 64; ++n) { const float cr = Cre[c * 64 + n], ci = Cim[c * 64 + n], pr = Pre[j * 64 + n], pi = Pim[j * 64 + n];
            const float xr = cr * pr - ci * pi, xi = cr * pi + ci * pr; acc += xr * Bre[n * 16 + cp] - xi * Bim[n * 16 + cp]; }
        KC[j * 256 + tid] = (bf16)f2bf(acc);
    } else if (part == 0) KC[2048 + tid - 256] = 0;
#pragma unroll
    for (int i = 0; i < 4; ++i) { const int idx = tid + 512 * i, np = 16 * part + (idx >> 7), k = idx & 127, s = k >> 4, cp = k & 15, n = np & 63;
        const float pr = Pre[(7 - s) * 64 + n], pi = Pim[(7 - s) * 64 + n], br = Bre[n * 16 + cp], bi = Bim[n * 16 + cp];
        WG[np * 128 + k] = (bf16)f2bf(np < 64 ? pr * br - pi * bi : pr * bi + pi * br); }
#pragma unroll
    for (int i = 0; i < 4; ++i) { const int idx = tid + 512 * i, col = 16 * part + (idx >> 7), np = idx & 127, t = col >> 4, c = col & 15, n = np & 63;
        const float pr = Pre[(t + 1) * 64 + n], pi = Pim[(t + 1) * 64 + n], cr = Cre[c * 64 + n], ci = Cim[c * 64 + n];
        VG[col * 128 + np] = (bf16)f2bf(np < 64 ? cr * pr - ci * pi : -(cr * pi + ci * pr)); }
    __syncthreads();
}
constexpr int L5_WG = 0, L5_VG = 34816, L5_KC = 69632, L5_U = 74240, L5_HS = 91648, L5_HL = 109056, L5_L8 = 141824;
__device__ __forceinline__ void s5_item(Frame& F, int item) {
    const int tid = F.tid, lane = F.lane, wave = F.wave;
    const int g = item & 31, b8 = item >> 5;
    LAS bf16* WgT = (LAS bf16*)(F.lds + L5_WG); LAS bf16* VgT = (LAS bf16*)(F.lds + L5_VG); LAS bf16* Kc = (LAS bf16*)(F.lds + L5_KC);
    LAS bf16* Us = (LAS bf16*)(F.lds + L5_U); LAS bf16* HS = (LAS bf16*)(F.lds + L5_HS); LAS float* HL = (LAS float*)(F.lds + L5_HL); LAS float* L8 = (LAS float*)(F.lds + L5_L8);
    LAS bf16* YS = (LAS bf16*)(F.lds + L5_HL);
    const bf16* U5 = (const bf16*)(F.ws + WS_U5) + (size_t)g * MTOK * 16; bf16* GY = (bf16*)(F.ws + WS_GY) + (size_t)g * MTOK * 16;
    { const bf16* WG = (const bf16*)(F.ws + WS_T5 + (size_t)g * T5_STRIDE); const bf16* VG = WG + T5_VG / 2; const bf16* KC = WG + T5_KC / 2;
#pragma unroll
      for (int i = 0; i < 4; ++i) { const int p = tid + 512 * i, r = p >> 4, kg = (p & 15) * 8; *(LAS v4u*)(WgT + r * S5_LD + kg) = *(const v4u*)(WG + r * 128 + kg); *(LAS v4u*)(VgT + r * S5_LD + kg) = *(const v4u*)(VG + r * 128 + kg); }
      if (tid < 288) *(LAS v4u*)(Kc + tid * 8) = *(const v4u*)(KC + tid * 8); }
    float qr[9], qi[9];
    { const float a_re = F.in[8][g * S5N + lane], a_im = F.in[9][g * S5N + lane], dt = expf(F.in[10][g]);
      const float mag = expf(a_re * dt); float p8r = mag * cosf(a_im * dt), p8i = mag * sinf(a_im * dt);
#pragma unroll
      for (int i = 0; i < 3; ++i) { const float t = p8r * p8r - p8i * p8i; p8i = 2.0f * p8r * p8i; p8r = t; }
      qr[0] = 1.f; qi[0] = 0.f;
#pragma unroll
      for (int i = 1; i < 9; ++i) { qr[i] = qr[i - 1] * p8r - qi[i - 1] * p8i; qi[i] = qr[i - 1] * p8i + qi[i - 1] * p8r; } }
    const float dl = F.in[15][g * 16 + (lane & 15)];
    const int rb = wave >> 2, cb = wave & 3, r32 = lane & 31, hh = lane >> 5;
    float h_re = 0.f, h_im = 0.f;
    float sre[2], sim[2];
#pragma unroll
    for (int i = 0; i < 2; ++i) { const size_t idx = (size_t)((16 * b8 + 2 * wave + i) * S5G + g) * S5N + lane; sre[i] = F.in[2][idx]; sim[i] = F.in[3][idx]; }
    v4u un0, un1;
    { const v4u* src = (const v4u*)(U5 + (size_t)(b8 * PB_T) * 16); un0 = src[tid]; un1 = src[tid + 512]; }
    for (int seg = 0; seg < 5; ++seg) {
        const bool samp = (seg == 4);
        const int tok0 = samp ? MP + 128 * b8 : b8 * PB_T + seg * 512;
        { const int p0 = tid, p1 = tid + 512;
          *(LAS v4u*)(Us + (p0 >> 4) * S5_LD + ((p0 >> 1) & 7) * 16 + (p0 & 1) * 8) = un0; *(LAS v4u*)(Us + (p1 >> 4) * S5_LD + ((p1 >> 1) & 7) * 16 + (p1 & 1) * 8) = un1;
          if (seg < 3) { const v4u* src = (const v4u*)(U5 + (size_t)(b8 * PB_T + (seg + 1) * 512) * 16); un0 = src[tid]; un1 = src[tid + 512]; }
          else if (seg == 3) { const v4u* src = (const v4u*)(U5 + (size_t)(MP + 128 * b8) * 16); if (tid < 256) un0 = src[tid]; } }
        __syncthreads();
        { f32x16 acc = {};
#pragma unroll
          for (int s = 0; s < 8; ++s) { const s16x8 a = *(const LAS s16x8*)(Us + (32 * rb + r32) * S5_LD + s * 16 + 8 * hh); const s16x8 b = *(const LAS s16x8*)(WgT + (32 * cb + r32) * S5_LD + s * 16 + 8 * hh);
              acc = __builtin_amdgcn_mfma_f32_32x32x16_bf16(a, b, acc, 0, 0, 0); }
#pragma unroll
          for (int r = 0; r < 16; ++r) HL[(32 * rb + (r & 3) + 8 * (r >> 2) + 4 * hh) * 128 + 32 * cb + r32] = acc[r]; }
        __syncthreads();
        if (!samp) {
            float xr[8], xi[8], lr[9], li[9];
#pragma unroll
            for (int i = 0; i < 8; ++i) { xr[i] = HL[(8 * wave + i) * 128 + lane]; xi[i] = HL[(8 * wave + i) * 128 + 64 + lane]; }
            lr[0] = 0.f; li[0] = 0.f;
#pragma unroll
            for (int i = 0; i < 8; ++i) { lr[i + 1] = qr[1] * lr[i] - qi[1] * li[i] + xr[i]; li[i + 1] = qr[1] * li[i] + qi[1] * lr[i] + xi[i]; }
            L8[wave * 128 + lane] = lr[8]; L8[wave * 128 + 64 + lane] = li[8];
            __syncthreads();
            float cr = h_re, ci = h_im, mr = h_re, mi = h_im;
#pragma unroll
            for (int w = 0; w < 8; ++w) { const float tr = L8[w * 128 + lane], ti = L8[w * 128 + 64 + lane];
                const float nr = qr[8] * cr - qi[8] * ci + tr, ni = qr[8] * ci + qi[8] * cr + ti; cr = nr; ci = ni; if (w + 1 == wave) { mr = cr; mi = ci; } }
            h_re = cr; h_im = ci;
#pragma unroll
            for (int i = 0; i < 8; ++i) { const float sr = lr[i] + qr[i] * mr - qi[i] * mi, si = li[i] + qr[i] * mi + qi[i] * mr;
                HS[(8 * wave + i) * S5_LD + lane] = (bf16)f2bf(sr); HS[(8 * wave + i) * S5_LD + 64 + lane] = (bf16)f2bf(si); }
            if (seg == 3 && wave == 0) { F.out[O_PRE + (size_t)(b8 * S5G + g) * S5N + lane] = h_re; F.out[O_PIM + (size_t)(b8 * S5G + g) * S5N + lane] = h_im; }
        } else {
#pragma unroll
            for (int i = 0; i < 2; ++i) { const int r = 2 * wave + i; const size_t idx = (size_t)((16 * b8 + r) * S5G + g) * S5N + lane;
                HS[r * S5_LD + lane] = (bf16)f2bf(sre[i]); HS[r * S5_LD + 64 + lane] = (bf16)f2bf(sim[i]);
                F.out[O_SRE + idx] = qr[1] * sre[i] - qi[1] * sim[i] + HL[r * 128 + lane]; F.out[O_SIM + idx] = qr[1] * sim[i] + qi[1] * sre[i] + HL[r * 128 + 64 + lane]; }
        }
        __syncthreads();
        if (!(samp && rb == 1)) { f32x16 acc = {};
            const int tl = 2 * cb + ((lane >> 4) & 1), c = lane & 15;
#pragma unroll
            for (int s = 0; s < 8; ++s) if (s <= 2 * cb + 1) { const int j = tl - s, jj = j < 0 ? 8 : j;
                const s16x8 a = *(const LAS s16x8*)(Us + (32 * rb + r32) * S5_LD + s * 16 + 8 * hh); const s16x8 b = *(const LAS s16x8*)(Kc + (jj * 16 + c) * 16 + 8 * hh);
                acc = __builtin_amdgcn_mfma_f32_32x32x16_bf16(a, b, acc, 0, 0, 0); }
#pragma unroll
            for (int kb = 0; kb < 8; ++kb) { const s16x8 a = *(const LAS s16x8*)(HS + (32 * rb + r32) * S5_LD + kb * 16 + 8 * hh); const s16x8 b = *(const LAS s16x8*)(VgT + (32 * cb + r32) * S5_LD + kb * 16 + 8 * hh);
                acc = __builtin_amdgcn_mfma_f32_32x32x16_bf16(a, b, acc, 0, 0, 0); }
#pragma unroll
            for (int r = 0; r < 16; ++r) { const int row = 32 * rb + (r & 3) + 8 * (r >> 2) + 4 * hh;
                const float u = bf2f(Us[row * S5_LD + tl * 16 + c]); YS[row * 128 + 32 * cb + r32] = (bf16)f2bf(gelu_tanh(acc[r] + dl * u)); }
        }
        __syncthreads();
        { v4u* dst = (v4u*)(GY + (size_t)tok0 * 16);
          if (!samp) { dst[tid] = *(const LAS v4u*)(YS + tid * 8); dst[tid + 512] = *(const LAS v4u*)(YS + (tid + 512) * 8); }
          else if (tid < 256) dst[tid] = *(const LAS v4u*)(YS + tid * 8); }
    }
    __syncthreads();
}
typedef float f32x4v __attribute__((ext_vector_type(4)));
constexpr int HG_LDQ = 136, HG_LDT = 72;
constexpr size_t WS_DSC = WS_XN;
constexpr size_t WS_DEC = WS_CTL + 1 * MiB;
struct HgRaw { float fz[16]; unsigned short q[16]; v4u v0, v1; };
template <bool NEEDQ> __device__ __forceinline__ void hg_load_raw(HgRaw& R, const bf16* PB, const float* FZ, int item, int tid) {
    const int bh = item >> 5, chunk = item & 31, b = bh >> 2, h = bh & 3, tok0 = b * PB_T + chunk * 64, ch = tid & 127, tq = tid >> 7, col = h * HD + ch;
#pragma unroll
    for (int i = 0; i < 16; ++i) { const size_t tok = (size_t)(tok0 + 16 * tq + i); R.fz[i] = FZ[tok * 512 + col]; if (NEEDQ) R.q[i] = PB[tok * PBW + 512 + col]; }
    { const int p = tid, vg = p >> 6, tk = p & 63; R.v0 = *(const v4u*)(PB + (size_t)(tok0 + tk) * PBW + 1024 + h * HD + vg * 8); }
    { const int p = tid + 512, vg = p >> 6, tk = p & 63; R.v1 = *(const v4u*)(PB + (size_t)(tok0 + tk) * PBW + 1024 + h * HD + vg * 8); }
}
#define HG_GATES_R(R) \
    float gl[16], kk[16]; float run = 0.f; \
    _Pragma("unroll") for (int i = 0; i < 16; ++i) { const float sg = __builtin_amdgcn_rcpf(1.0f + __builtin_amdgcn_exp2f(-1.4426950408889634f * R.fz[i])), f = lb + (1.0f - lb) * sg; kk[i] = 1.0f - f; run += __log2f(f); gl[i] = run; } \
    TOT[tq * 128 + ch] = run;
#define HG_VT_STORE(R) \
    { const int vg = tid >> 6, tk = tid & 63; LAS bf16* d = Vt + (vg * 8) * HG_LDT + tk; const v4u w = R.v0; d[0] = (bf16)(w.x & 0xffffu); d[HG_LDT] = (bf16)(w.x >> 16); d[2 * HG_LDT] = (bf16)(w.y & 0xffffu); d[3 * HG_LDT] = (bf16)(w.y >> 16); \
        d[4 * HG_LDT] = (bf16)(w.z & 0xffffu); d[5 * HG_LDT] = (bf16)(w.z >> 16); d[6 * HG_LDT] = (bf16)(w.w & 0xffffu); d[7 * HG_LDT] = (bf16)(w.w >> 16); } \
    { const int vg = (tid + 512) >> 6, tk = tid & 63; LAS bf16* d = Vt + (vg * 8) * HG_LDT + tk; const v4u w = R.v1; d[0] = (bf16)(w.x & 0xffffu); d[HG_LDT] = (bf16)(w.x >> 16); d[2 * HG_LDT] = (bf16)(w.y & 0xffffu); d[3 * HG_LDT] = (bf16)(w.y >> 16); \
        d[4 * HG_LDT] = (bf16)(w.z & 0xffffu); d[5 * HG_LDT] = (bf16)(w.z >> 16); d[6 * HG_LDT] = (bf16)(w.w & 0xffffu); d[7 * HG_LDT] = (bf16)(w.w >> 16); }

constexpr int LA_QS = 0, LA_KS = 17408, LA_KT = 34816, LA_VT = 53248, LA_AT = 71680, LA_TOT = 80896;
constexpr size_t OQ_QH = 0, OQ_OI = 4194304;
__device__ __forceinline__ void hgA_loop(Frame& F, int j0, int j1) {
    const int tid = F.tid, lane = F.lane, wave = F.wave;
    LAS bf16* Qs = (LAS bf16*)(F.lds + LA_QS); LAS bf16* Ks = (LAS bf16*)(F.lds + LA_KS); LAS bf16* Kt = (LAS bf16*)(F.lds + LA_KT); LAS bf16* Vt = (LAS bf16*)(F.lds + LA_VT);
    LAS bf16* At = (LAS bf16*)(F.lds + LA_AT); LAS float* TOT = (LAS float*)(F.lds + LA_TOT);
    const bf16* PB = (const bf16*)(F.ws + WS_PB); const float* FZ = (const float*)(F.ws + WS_FZ);
    const int ch = tid & 127, tq = tid >> 7, r32 = lane & 31, hh = lane >> 5;
    const int iend = (F.bid + j1 * F.G < 1024) ? F.bid + j1 * F.G : 1024;
    int item = F.bid + j0 * F.G; if (item >= iend) return;
    HgRaw R; hg_load_raw<true>(R, PB, FZ, item, tid);
    for (; item < iend; item += F.G) {
        const int bh = item >> 5, h = bh & 3, col = h * HD + ch;
        bf16* DSC = (bf16*)(F.ws + WS_DSC) + (size_t)item * HD * HD; float* DEC = (float*)(F.ws + WS_DEC) + (size_t)item * HD;
        bf16* QH = (bf16*)(F.out + O_Y + OQ_QH) + (size_t)item * 64 * HD; bf16* OI = (bf16*)(F.out + O_Y + OQ_OI) + (size_t)item * 8192;
        const float lb = 1.0f / (1.0f + __expf(F.in[5][512 + col] - F.in[5][col]));
        HG_GATES_R(R)
        float qq[16];
#pragma unroll
        for (int i = 0; i < 16; ++i) qq[i] = bf2f(R.q[i]);
        HG_VT_STORE(R)
        if (item + F.G < iend) hg_load_raw<true>(R, PB, FZ, item + F.G, tid);
        __syncthreads();
        { const float t0 = TOT[ch], t1 = TOT[128 + ch], t2 = TOT[256 + ch], t3 = TOT[384 + ch];
          const float gref = t0 + t1, glast = gref + (t2 + t3), off = (tq == 0 ? 0.f : tq == 1 ? t0 : tq == 2 ? gref : gref + t2);
          const float cS = __builtin_amdgcn_exp2f(gref), cK = __builtin_amdgcn_exp2f(glast - gref);
          unsigned kp[8];
#pragma unroll
          for (int i = 0; i < 16; ++i) { const float e1 = __builtin_amdgcn_exp2f(off + gl[i] - gref), e2 = __builtin_amdgcn_rcpf(e1), qs = qq[i] * e1, ks = kk[i] * e2;
              Qs[(16 * tq + i) * HG_LDQ + ch] = (bf16)f2bf(qs); Ks[(16 * tq + i) * HG_LDQ + ch] = (bf16)f2bf(ks);
              QH[(size_t)(16 * tq + i) * HD + ch] = (bf16)f2bf(qs * cS);
              const unsigned kb = f2bf(ks * cK); if (i & 1) kp[i >> 1] |= kb << 16; else kp[i >> 1] = kb; }
          LAS v4u* kd = (LAS v4u*)(Kt + ch * HG_LDT + 16 * tq); v4u a, c2; a.x = kp[0]; a.y = kp[1]; a.z = kp[2]; a.w = kp[3]; c2.x = kp[4]; c2.y = kp[5]; c2.z = kp[6]; c2.w = kp[7]; kd[0] = a; kd[1] = c2;
          if (tq == 0) DEC[ch] = cS * cK; }
        __syncthreads();
        if (wave < 4) { const int tb = wave >> 1, sb = wave & 1; f32x16 acc = {};
            if (sb <= tb) {
#pragma unroll
                for (int ks = 0; ks < 8; ++ks) { const s16x8 a = *(const LAS s16x8*)(Qs + (32 * tb + r32) * HG_LDQ + 16 * ks + 8 * hh); const s16x8 bb = *(const LAS s16x8*)(Ks + (32 * sb + r32) * HG_LDQ + 16 * ks + 8 * hh);
                    acc = __builtin_amdgcn_mfma_f32_32x32x16_bf16(a, bb, acc, 0, 0, 0); } }
            const int s = 32 * sb + r32;
#pragma unroll
            for (int r = 0; r < 16; ++r) { const int t = 32 * tb + (r & 3) + 8 * (r >> 2) + 4 * hh; At[t * HG_LDT + s] = (s <= t) ? (bf16)f2bf(acc[r]) : (bf16)0; } }
        { const int kb = wave >> 1;
#pragma unroll
          for (int vbi = 0; vbi < 2; ++vbi) { const int vb = 2 * (wave & 1) + vbi; f32x16 acc = {};
#pragma unroll
              for (int ks = 0; ks < 4; ++ks) { const s16x8 a = *(const LAS s16x8*)(Kt + (32 * kb + r32) * HG_LDT + 16 * ks + 8 * hh); const s16x8 bb = *(const LAS s16x8*)(Vt + (32 * vb + r32) * HG_LDT + 16 * ks + 8 * hh);
                  acc = __builtin_amdgcn_mfma_f32_32x32x16_bf16(a, bb, acc, 0, 0, 0); }
              bf16* dst = DSC + (size_t)(32 * vb + r32) * HD + 32 * kb + 4 * hh;
#pragma unroll
              for (int q = 0; q < 4; ++q) { v2u w; w.x = pk2(acc[4 * q], acc[4 * q + 1]); w.y = pk2(acc[4 * q + 2], acc[4 * q + 3]); *(v2u*)(dst + 8 * q) = w; } } }
        __syncthreads();
        { const int tb = wave >> 2, vb = wave & 3, t = 32 * tb + r32; f32x16 acc = {};
#pragma unroll
          for (int ks = 0; ks < 4; ++ks) if (ks < 2 * tb + 2) { const s16x8 a = *(const LAS s16x8*)(Vt + (32 * vb + r32) * HG_LDT + 16 * ks + 8 * hh); const s16x8 bb = *(const LAS s16x8*)(At + t * HG_LDT + 16 * ks + 8 * hh);
              acc = __builtin_amdgcn_mfma_f32_32x32x16_bf16(a, bb, acc, 0, 0, 0); }
          v4u w0, w1; w0.x = pk2(acc[0], acc[1]); w0.y = pk2(acc[2], acc[3]); w0.z = pk2(acc[4], acc[5]); w0.w = pk2(acc[6], acc[7]); w1.x = pk2(acc[8], acc[9]); w1.y = pk2(acc[10], acc[11]); w1.z = pk2(acc[12], acc[13]); w1.w = pk2(acc[14], acc[15]);
          v4u* d = (v4u*)(OI + (size_t)(wave * 64 + lane) * 16); d[0] = w0; d[1] = w1; }
        __syncthreads();
    }
}
__device__ __forceinline__ void hg_scan(Frame& F, bf16* DSO, int sb, int nsb) {
    bf16* DSC = (bf16*)(F.ws + WS_DSC); const float* DEC = (const float*)(F.ws + WS_DEC);
    LAS float* DL = (LAS float*)F.lds;
    for (int T0 = sb * 512; T0 < 32 * 4096; T0 += nsb * 512) {
        const int T = T0 + F.tid, bh = T0 >> 12, e = T & 4095, v = e >> 5, k4 = (e & 31) * 4;
        v2u x[32];
#pragma unroll
        for (int c = 0; c < 32; ++c) x[c] = *(const v2u*)(DSC + ((size_t)(bh * 32 + c) * HD + v) * HD + k4);
#pragma unroll
        for (int i = 0; i < 2; ++i) { const int p = F.tid + 512 * i; *(LAS f32x4*)(DL + p * 4) = *(const f32x4*)(DEC + (size_t)bh * 32 * HD + p * 4); }
        __syncthreads();
        f32x4 S = {0.f, 0.f, 0.f, 0.f};
#pragma unroll
        for (int c = 0; c < 32; ++c) { const f32x4 d = *(const LAS f32x4*)(DL + c * HD + k4);
            v2u o; o.x = pk2(S.x, S.y); o.y = pk2(S.z, S.w); *(v2u*)(DSO + ((size_t)(bh * 32 + c) * HD + v) * HD + k4) = o;
            S.x = d.x * S.x + bflo(x[c].x); S.y = d.y * S.y + bfhi(x[c].x); S.z = d.z * S.z + bflo(x[c].y); S.w = d.w * S.w + bfhi(x[c].y); }
        float* o = F.out + O_PHG + (size_t)bh * HD * HD + (size_t)k4 * HD + v;
        o[0] = S.x; o[HD] = S.y; o[2 * HD] = S.z; o[3 * HD] = S.w;
        __syncthreads();
    }
}
constexpr int LC_SC = 0, LC_QH = 34816, LC_SS = 52224, LC_SLOT = 53248;
struct HgcRegs { v4u sc[4], qh[2], oi[2]; v2u og[4]; };
__device__ __forceinline__ void hgC_loop(Frame& F, unsigned* ctr) {
    const int tid = F.tid, lane = F.lane, wave = F.wave;
    LAS bf16* SC = (LAS bf16*)(F.lds + LC_SC); LAS bf16* Qh = (LAS bf16*)(F.lds + LC_QH); LAS float* SS = (LAS float*)(F.lds + LC_SS);
    volatile LAS int* slot = (volatile LAS int*)(F.lds + LC_SLOT);
    const bf16* PB = (const bf16*)(F.ws + WS_PB); bf16* MIX = (bf16*)(F.ws + WS_MIX);
    const int r32 = lane & 31, hh = lane >> 5, tb = wave >> 2, vb = wave & 3, t = 32 * tb + r32;
    if (tid == 0) { slot[0] = (int)__hip_atomic_fetch_add(ctr, 1u, __ATOMIC_RELAXED, __HIP_MEMORY_SCOPE_AGENT); slot[1] = (int)__hip_atomic_fetch_add(ctr, 1u, __ATOMIC_RELAXED, __HIP_MEMORY_SCOPE_AGENT);
                    slot[2] = (int)__hip_atomic_fetch_add(ctr, 1u, __ATOMIC_RELAXED, __HIP_MEMORY_SCOPE_AGENT); }
    __syncthreads();
    int item = slot[0], n1 = slot[1], n2 = slot[2], par = 0;
    if (item >= 1024) return;
    HgcRegs RA, RB;
#define HGC_FETCH(R, IT) do { const int it_ = (IT); const bf16* DSC = (const bf16*)(F.ws + WS_DSC) + (size_t)it_ * HD * HD; const bf16* QH = (const bf16*)(F.out + O_Y + OQ_QH) + (size_t)it_ * 64 * HD; \
        const bf16* OI = (const bf16*)(F.out + O_Y + OQ_OI) + (size_t)it_ * 8192; const int bh_ = it_ >> 5, tok0_ = (bh_ >> 2) * PB_T + (it_ & 31) * 64, h_ = bh_ & 3; \
        _Pragma("unroll") for (int i = 0; i < 4; ++i) { const int p = tid + 512 * i; R.sc[i] = *(const v4u*)(DSC + (size_t)(p >> 4) * HD + (p & 15) * 8); } \
        _Pragma("unroll") for (int i = 0; i < 2; ++i) { const int p = tid + 512 * i; R.qh[i] = *(const v4u*)(QH + (size_t)(p >> 4) * HD + (p & 15) * 8); } \
        R.oi[0] = *(const v4u*)(OI + (size_t)(wave * 64 + lane) * 16); R.oi[1] = *(const v4u*)(OI + (size_t)(wave * 64 + lane) * 16 + 8); \
        _Pragma("unroll") for (int q = 0; q < 4; ++q) R.og[q] = *(const v2u*)(PB + (size_t)(tok0_ + t) * PBW + 1536 + h_ * HD + 32 * vb + 8 * q + 4 * hh); } while (0)
#define HGC_STEP(R) do { \
        const int bh = item >> 5, chunk = item & 31, b = bh >> 2, h = bh & 3, tok0 = b * PB_T + chunk * 64; \
        _Pragma("unroll") for (int i = 0; i < 4; ++i) { const int p = tid + 512 * i; *(LAS v4u*)(SC + (p >> 4) * HG_LDQ + (p & 15) * 8) = R.sc[i]; } \
        _Pragma("unroll") for (int i = 0; i < 2; ++i) { const int p = tid + 512 * i; *(LAS v4u*)(Qh + (p >> 4) * HG_LDQ + (p & 15) * 8) = R.qh[i]; } \
        f32x16 acc; \
        acc[0] = bflo(R.oi[0].x); acc[1] = bfhi(R.oi[0].x); acc[2] = bflo(R.oi[0].y); acc[3] = bfhi(R.oi[0].y); acc[4] = bflo(R.oi[0].z); acc[5] = bfhi(R.oi[0].z); acc[6] = bflo(R.oi[0].w); acc[7] = bfhi(R.oi[0].w); \
        acc[8] = bflo(R.oi[1].x); acc[9] = bfhi(R.oi[1].x); acc[10] = bflo(R.oi[1].y); acc[11] = bfhi(R.oi[1].y); acc[12] = bflo(R.oi[1].z); acc[13] = bfhi(R.oi[1].z); acc[14] = bflo(R.oi[1].w); acc[15] = bfhi(R.oi[1].w); \
        v2u ogc[4]; \
        _Pragma("unroll") for (int q = 0; q < 4; ++q) ogc[q] = R.og[q]; \
        if (tid == 0) slot[par] = (int)__hip_atomic_fetch_add(ctr, 1u, __ATOMIC_RELAXED, __HIP_MEMORY_SCOPE_AGENT); \
        if (n2 < 1024) HGC_FETCH(R, n2); \
        __syncthreads(); \
        const int nn = slot[par]; \
        _Pragma("unroll") for (int ks = 0; ks < 8; ++ks) { const s16x8 a = *(const LAS s16x8*)(SC + (32 * vb + r32) * HG_LDQ + 16 * ks + 8 * hh); const s16x8 bb = *(const LAS s16x8*)(Qh + t * HG_LDQ + 16 * ks + 8 * hh); \
            acc = __builtin_amdgcn_mfma_f32_32x32x16_bf16(a, bb, acc, 0, 0, 0); } \
        { float ss = 0.f; \
          _Pragma("unroll") for (int r = 0; r < 16; ++r) ss += acc[r] * acc[r]; \
          ss += __shfl_xor(ss, 32); \
          if (hh == 0) SS[t * 4 + vb] = ss; } \
        __syncthreads(); \
        { const f32x4 s4 = *(const LAS f32x4*)(SS + t * 4); const float rstd = __builtin_amdgcn_rsqf(((s4.x + s4.y) + (s4.z + s4.w)) * (1.0f / HD) + EPS); \
          _Pragma("unroll") for (int q = 0; q < 4; ++q) { const int v0 = 32 * vb + 8 * q + 4 * hh; const f32x4 gn = *(const GAS f32x4*)(F.in[17] + v0); \
              v2u w; w.x = pk2(acc[4 * q] * rstd * gn.x * siluf_(bflo(ogc[q].x)), acc[4 * q + 1] * rstd * gn.y * siluf_(bfhi(ogc[q].x))); \
              w.y = pk2(acc[4 * q + 2] * rstd * gn.z * siluf_(bflo(ogc[q].y)), acc[4 * q + 3] * rstd * gn.w * siluf_(bfhi(ogc[q].y))); \
              *(v2u*)(MIX + (size_t)(tok0 + t) * DM + 512 + h * HD + v0) = w; } } \
        __syncthreads(); \
        item = n1; n1 = n2; n2 = nn; par = (par == 2) ? 0 : par + 1; } while (0)
    HGC_FETCH(RA, item);
    if (n1 < 1024) HGC_FETCH(RB, n1);
    for (;;) {
        HGC_STEP(RA); if (item >= 1024) break;
        HGC_STEP(RB); if (item >= 1024) break;
    }
#undef HGC_FETCH
#undef HGC_STEP
}
constexpr int LX_Q = 0, LX_K2 = 4096, LX_K3 = 8192, LX_V = 12288, LX_DEC = 16384, LX_ATT = 16896, LX_OP = 17152, LX_OT = 33536;
__device__ __forceinline__ void hgrn_sample_item(Frame& F, int idx) {
    const int tid = F.tid, b = idx >> 2, h = idx & 3;
    LAS float* Qs = (LAS float*)(F.lds + LX_Q); LAS float* K2 = (LAS float*)(F.lds + LX_K2); LAS float* K3 = (LAS float*)(F.lds + LX_K3); LAS float* Vs = (LAS float*)(F.lds + LX_V);
    LAS float* DEC = (LAS float*)(F.lds + LX_DEC); LAS float* ATT = (LAS float*)(F.lds + LX_ATT); LAS float* OP = (LAS float*)(F.lds + LX_OP); LAS float* OT = (LAS float*)(F.lds + LX_OT);
    const bf16* PB = (const bf16*)(F.ws + WS_PB); const float* FZ = (const float*)(F.ws + WS_FZ); bf16* MIX = (bf16*)(F.ws + WS_MIX);
    const float* S0 = F.in[4] + (size_t)idx * HD * HD; float* Sout = F.out + O_SHG + (size_t)idx * HD * HD;
    const int tok0 = MP + b * SB_T;
    const int v = tid & 127, kq = tid >> 7;
    float s0[32];
#pragma unroll
    for (int j = 0; j < 32; ++j) s0[j] = S0[(size_t)(32 * kq + j) * HD + v];
    if (tid < 128) { const int col = h * HD + tid; const float lb = 1.0f / (1.0f + expf(F.in[5][512 + col] - F.in[5][col]));
        float gl[8], kk[8], qq[8]; float run = 0.f;
#pragma unroll
        for (int t = 0; t < 8; ++t) { const size_t tok = (size_t)(tok0 + t); const float fz = FZ[tok * 512 + col]; qq[t] = bf2f(PB[tok * PBW + 512 + col]);
            const float sg = 1.0f / (1.0f + __expf(-fz)), f = lb + (1.0f - lb) * sg; kk[t] = 1.0f - f; run += __log2f(f); gl[t] = run; }
#pragma unroll
        for (int t = 0; t < 8; ++t) { Qs[t * 128 + tid] = qq[t] * __builtin_amdgcn_exp2f(gl[t]); K2[t * 128 + tid] = kk[t] * __builtin_amdgcn_exp2f(-gl[t]); K3[t * 128 + tid] = kk[t] * __builtin_amdgcn_exp2f(run - gl[t]); }
        DEC[tid] = __builtin_amdgcn_exp2f(run);
    } else if (tid < 256) { const int vv = tid - 128;
#pragma unroll
        for (int t = 0; t < 8; ++t) Vs[t * 128 + vv] = bf2f(PB[(size_t)(tok0 + t) * PBW + 1024 + h * HD + vv]);
    }
    __syncthreads();
    { const int p = tid >> 3, part = tid & 7, t = p >> 3, s = p & 7; float a = 0.f;
#pragma unroll
      for (int j = 0; j < 16; ++j) a += Qs[t * 128 + part + 8 * j] * K2[s * 128 + part + 8 * j];
      a += __shfl_xor(a, 1); a += __shfl_xor(a, 2); a += __shfl_xor(a, 4);
      if (part == 0) ATT[p] = (s <= t) ? a : 0.f; }
    float vr[8], o[8];
#pragma unroll
    for (int t = 0; t < 8; ++t) { vr[t] = Vs[t * 128 + v]; o[t] = 0.f; }
#pragma unroll
    for (int j = 0; j < 32; ++j) { const int k = 32 * kq + j; const float sv = s0[j]; float sn = DEC[k] * sv;
#pragma unroll
        for (int t = 0; t < 8; ++t) { o[t] += Qs[t * 128 + k] * sv; sn += K3[t * 128 + k] * vr[t]; }
        Sout[(size_t)k * HD + v] = sn; }
#pragma unroll
    for (int t = 0; t < 8; ++t) OP[(kq * 8 + t) * 128 + v] = o[t];
    __syncthreads();
#pragma unroll
    for (int r = 0; r < 2; ++r) { const int e = tid + 512 * r, t = e >> 7, vv = e & 127;
        float acc = (OP[(0 * 8 + t) * 128 + vv] + OP[(1 * 8 + t) * 128 + vv]) + (OP[(2 * 8 + t) * 128 + vv] + OP[(3 * 8 + t) * 128 + vv]);
#pragma unroll
        for (int s = 0; s < 8; ++s) acc += ATT[t * 8 + s] * Vs[s * 128 + vv];
        OT[t * 128 + vv] = acc; }
    __syncthreads();
    { const int t = F.wave, lane = F.lane; const float o0 = OT[t * 128 + 2 * lane], o1 = OT[t * 128 + 2 * lane + 1];
      const float rstd = __builtin_amdgcn_rsqf(wave_sum(o0 * o0 + o1 * o1) * (1.0f / HD) + EPS);
      const unsigned gw2 = *(const unsigned*)(PB + (size_t)(tok0 + t) * PBW + 1536 + h * HD + 2 * lane);
      const float g0 = F.in[17][2 * lane], g1 = F.in[17][2 * lane + 1];
      *(unsigned*)(MIX + (size_t)(tok0 + t) * DM + 512 + h * HD + 2 * lane) = pk2(o0 * rstd * g0 * siluf_(bflo(gw2)), o1 * rstd * g1 * siluf_(bfhi(gw2))); }
    __syncthreads();
}
constexpr int SG_LD = 68;
template <int KSTEPS  >
__device__ __forceinline__ void small_gemm_tile(Frame& F, const bf16* A, int lda, const bf16* Bt, int K, int r0, int c0, float (&v)[8]) {
    const int lane = F.lane, wave = F.wave, fr = lane & 15, fq = lane >> 4;
    f32x4v acc[4][4];
#pragma unroll
    for (int a = 0; a < 4; ++a)
#pragma unroll
        for (int b = 0; b < 4; ++b) acc[a][b] = (f32x4v){0.f, 0.f, 0.f, 0.f};
    const bf16* ap = A + (size_t)(r0 + fr) * lda + wave * (KSTEPS * 32) + 8 * fq;
    const bf16* bp = Bt + (size_t)(c0 + fr) * K + wave * (KSTEPS * 32) + 8 * fq;
#pragma unroll 2
    for (int ks = 0; ks < KSTEPS; ++ks) {
        s16x8 af[4], bf[4];
#pragma unroll
        for (int i = 0; i < 4; ++i) { af[i] = *(const s16x8*)(ap + (size_t)(16 * i) * lda + 32 * ks); bf[i] = *(const s16x8*)(bp + (size_t)(16 * i) * K + 32 * ks); }
#pragma unroll
        for (int a = 0; a < 4; ++a)
#pragma unroll
            for (int b = 0; b < 4; ++b) acc[a][b] = __builtin_amdgcn_mfma_f32_16x16x32_bf16(bf[b], af[a], acc[a][b], 0, 0, 0);
    }
    LAS float* part = (LAS float*)F.lds + wave * (64 * SG_LD);
#pragma unroll
    for (int a = 0; a < 4; ++a)
#pragma unroll
        for (int b = 0; b < 4; ++b) *(LAS f32x4v*)(part + (16 * a + fr) * SG_LD + 16 * b + 4 * fq) = acc[a][b];
    __syncthreads();
    { const int row = F.tid >> 3, cg8 = (F.tid & 7) * 8; const LAS float* p = (const LAS float*)F.lds + row * SG_LD + cg8;
      f32x4v s0 = {0.f, 0.f, 0.f, 0.f}, s1 = {0.f, 0.f, 0.f, 0.f};
#pragma unroll
      for (int w = 0; w < 8; ++w) { s0 += *(const LAS f32x4v*)(p + w * (64 * SG_LD)); s1 += *(const LAS f32x4v*)(p + w * (64 * SG_LD) + 4); }
      v[0] = s0[0]; v[1] = s0[1]; v[2] = s0[2]; v[3] = s0[3]; v[4] = s1[0]; v[5] = s1[1]; v[6] = s1[2]; v[7] = s1[3]; }
    __syncthreads();
}

__device__ __forceinline__ void outproj_sample_tile(Frame& F, int tile, float* SS1) {
    const int rm = tile >> 4, cn = tile & 15; float v[8];
    small_gemm_tile<4>(F, (const bf16*)(F.ws + WS_MIX), DM, (const bf16*)(F.ws + WS_WOUT), DM, MP + 64 * rm, 64 * cn, v);
    const int row = MP + 64 * rm + (F.tid >> 3), col = 64 * cn + 8 * (F.tid & 7); const size_t off = (size_t)row * DM + col;
    const float* xs = F.in[1] + (size_t)(row - MP) * DM + col; bf16* XN = (bf16*)(F.ws + WS_XN);
    const f32x4v xa = *(const f32x4v*)xs, xb = *(const f32x4v*)(xs + 4);
    const f32x4v x0 = {xa[0] + v[0], xa[1] + v[1], xa[2] + v[2], xa[3] + v[3]}, x1 = {xb[0] + v[4], xb[1] + v[5], xb[2] + v[6], xb[3] + v[7]};
    v4u w; w.x = pk2(x0[0], x0[1]); w.y = pk2(x0[2], x0[3]); w.z = pk2(x1[0], x1[1]); w.w = pk2(x1[2], x1[3]);
    *(v4u*)(XN + off) = w;
    float ss = (x0[0] * x0[0] + x0[1] * x0[1]) + (x0[2] * x0[2] + x0[3] * x0[3]) + (x1[0] * x1[0] + x1[1] * x1[1]) + (x1[2] * x1[2] + x1[3] * x1[3]);
    ss += __shfl_xor(ss, 1); ss += __shfl_xor(ss, 2); ss += __shfl_xor(ss, 4);
    if ((F.tid & 7) == 0) __hip_atomic_fetch_add(SS1 + row, ss, __ATOMIC_RELAXED, __HIP_MEMORY_SCOPE_AGENT);
}
__device__ __forceinline__ void down_sample_tile(Frame& F, int tile, float* SS2, unsigned* cntb, float* YO) {
    const int rm = tile >> 4, cn = tile & 15; float v[8];
    small_gemm_tile<11>(F, (const bf16*)(F.ws + WS_ACT), DFF, (const bf16*)(F.ws + WS_WD), DFF, MP + 64 * rm, 64 * cn, v);
    const int row = MP + 64 * rm + (F.tid >> 3), col = 64 * cn + 8 * (F.tid & 7); const size_t off = (size_t)row * DM + col;
    unsigned* cnt = cntb + 64 * rm; const v4u xw = *(const v4u*)((const bf16*)(F.ws + WS_XN) + off);
    const f32x4v xa = {bflo(xw.x), bfhi(xw.x), bflo(xw.y), bfhi(xw.y)}, xb = {bflo(xw.z), bfhi(xw.z), bflo(xw.w), bfhi(xw.w)}, ga = *(const f32x4v*)(F.in[23] + col), gb = *(const f32x4v*)(F.in[23] + col + 4);
    const f32x4v x0 = {xa[0] + v[0], xa[1] + v[1], xa[2] + v[2], xa[3] + v[3]}, x1 = {xb[0] + v[4], xb[1] + v[5], xb[2] + v[6], xb[3] + v[7]};
    float ss = (x0[0] * x0[0] + x0[1] * x0[1]) + (x0[2] * x0[2] + x0[3] * x0[3]) + (x1[0] * x1[0] + x1[1] * x1[1]) + (x1[2] * x1[2] + x1[3] * x1[3]);
    ss += __shfl_xor(ss, 1); ss += __shfl_xor(ss, 2); ss += __shfl_xor(ss, 4);
    if ((F.tid & 7) == 0) __hip_atomic_fetch_add(SS2 + row, ss, __ATOMIC_RELAXED, __HIP_MEMORY_SCOPE_AGENT);
    asm volatile("s_waitcnt vmcnt(0)" ::: "memory");
    __syncthreads();
    if (F.tid == 0) { __hip_atomic_fetch_add(cnt, 1u, __ATOMIC_RELAXED, __HIP_MEMORY_SCOPE_AGENT); wait_count(cnt, 16u); }
    __syncthreads();
    float s = 0.f; if ((F.tid & 7) == 0) s = atomic_read_f32(SS2 + row);
    const float rs = rstd_of(__shfl(s, F.lane & ~7));
    *(f32x4v*)(YO + off) = (f32x4v){x0[0] * rs * ga[0], x0[1] * rs * ga[1], x0[2] * rs * ga[2], x0[3] * rs * ga[3]};
    *(f32x4v*)(YO + off + 4) = (f32x4v){x1[0] * rs * gb[0], x1[1] * rs * gb[1], x1[2] * rs * gb[2], x1[3] * rs * gb[3]};
}
typedef GAS unsigned gu32;
#define RLX_AGENT __ATOMIC_RELAXED, __HIP_MEMORY_SCOPE_AGENT
constexpr int MISC_OFF = LDS_BYTES - 512;
constexpr int CW_QUEUE = 8192;
constexpr int CW_BAR = 4096;
constexpr size_t CTL_ZERO_BYTES = 524288;
constexpr int CW_DUMMY = 65536;
#define XB_TMO      128
#define XB_XCNT(j)  (256  + 64 * (j))
#define XB_XSUB(j)  (1280 + 64 * (j))
#define XB_XGEN(j)  (2304 + 64 * (j))
#define XB_TOP      3328
#define XB_TOPGEN   3392
#define XCD_BAR_WORDS 3456
#define XB_SPIN_CAP (1u << 18)

__device__ __forceinline__ unsigned xb_ld(unsigned* p)              { return __hip_atomic_load(p, __ATOMIC_RELAXED, __HIP_MEMORY_SCOPE_AGENT); }
__device__ __forceinline__ unsigned xb_add(unsigned* p, unsigned v) { return __hip_atomic_fetch_add(p, v, __ATOMIC_RELAXED, __HIP_MEMORY_SCOPE_AGENT); }
__device__ __forceinline__ unsigned xb_xcc_id() { return (unsigned)__builtin_amdgcn_s_getreg((3 << 11) | 20) & 0xFu; }
#define XB_SPIN(cond, bar) do { unsigned _sp = 0; while (cond) { __builtin_amdgcn_s_sleep(1); \
    if ((++_sp & 255u) == 0u) { if (xb_ld(&(bar)[XB_TMO])) break; if (_sp > XB_SPIN_CAP) { atomicAdd(&(bar)[XB_TMO], 1u); break; } } } } while (0)

struct XcdBarrier {
    unsigned* bar; unsigned x;
    volatile LAS unsigned* st;
};

__device__ __forceinline__ XcdBarrier xcd_barrier_post(unsigned* bar, volatile LAS unsigned* st) {
    XcdBarrier b; b.bar = bar; b.x = xb_xcc_id(); b.st = st;
    if (threadIdx.x == 0) (void)xb_add(&bar[XB_XCNT(b.x)], 1u);
    return b;
}
__device__ __forceinline__ void xcd_barrier_complete(unsigned* bar, unsigned x, unsigned& nloc, unsigned& nx) {
    const unsigned G = gridDim.x * gridDim.y * gridDim.z;
    unsigned sum, cnt, mine, sp = 0u;
    for (;;) {
        sum = 0u; cnt = 0u; mine = 0u;
#pragma unroll
        for (unsigned j = 0; j < 16; ++j) { const unsigned c = xb_ld(&bar[XB_XCNT(j)]); sum += c; cnt += (c > 0u) ? 1u : 0u; mine = (j == x) ? c : mine; }
        if (sum == G) break;
        __builtin_amdgcn_s_sleep(1);
        if ((++sp & 255u) == 0u) { if (xb_ld(&bar[XB_TMO])) break; if (sp > XB_SPIN_CAP) { atomicAdd(&bar[XB_TMO], 1u); break; } }
    }
    nloc = mine > 0u ? mine : 1u; nx = cnt > 0u ? cnt : 1u;
}

__device__ __forceinline__ void xcd_barrier(const XcdBarrier& b) {
    asm volatile("s_waitcnt vmcnt(0)" ::: "memory");
    __syncthreads();
    if (threadIdx.x == 0) {
        unsigned* bar = b.bar;
        __builtin_amdgcn_s_waitcnt(0);
        unsigned nloc = b.st[0], nx = b.st[1];
        if (nloc == 0u) { xcd_barrier_complete(bar, b.x, nloc, nx); b.st[0] = nloc; b.st[1] = nx; }
        const unsigned old = xb_add(&bar[XB_XSUB(b.x)], 1u);
        const unsigned gen = old / nloc;
        if (old + 1u == (gen + 1u) * nloc) {
            __builtin_amdgcn_fence(__ATOMIC_RELEASE, "agent");
            asm volatile("s_waitcnt vmcnt(0)" ::: "memory");
            const unsigned og = xb_add(&bar[XB_TOP], 1u);
            const unsigned tg = og / nx;
            if (og + 1u == (tg + 1u) * nx) xb_add(&bar[XB_TOPGEN], 1u);
            else XB_SPIN(xb_ld(&bar[XB_TOPGEN]) == tg, bar);
            __builtin_amdgcn_fence(__ATOMIC_ACQUIRE, "agent");
            xb_add(&bar[XB_XGEN(b.x)], 1u);
            asm volatile("s_waitcnt vmcnt(0)" ::: "memory");
        } else {
            XB_SPIN(xb_ld(&bar[XB_XGEN(b.x)]) == gen, bar);
            __builtin_amdgcn_fence(__ATOMIC_ACQUIRE, "agent");
            asm volatile("s_waitcnt vmcnt(0)" ::: "memory");
        }
    }
    __syncthreads();
}

__global__ void __launch_bounds__(NWAVES * 64, 2) mk_fwd(Args args) {
    extern __shared__ __attribute__((aligned(16))) unsigned char lds[];
    Frame F;
    F.lds = (LAS unsigned char*)lds;
    F.tid = threadIdx.x; F.lane = F.tid & 63; F.wave = __builtin_amdgcn_readfirstlane(F.tid >> 6);
    F.G = gridDim.x; F.bid = blockIdx.x;
#pragma unroll
    for (int i = 0; i < 24; ++i) F.in[i] = args.in[i];
    F.out = args.out; F.ws = args.ws;
    const int lo = args.ph_lo, hi = args.ph_hi;
#define IN(k) (lo <= (k) && (k) < hi)
#if MK_N_LAUNCHES == 1
    volatile LAS unsigned* MISC = (volatile LAS unsigned*)(F.lds + MISC_OFF);
    if (F.tid < 32) MISC[F.tid] = 0u;
    __syncthreads();
    XcdBarrier bar = xcd_barrier_post((unsigned*)(F.ws + WS_CTL) + CW_BAR, MISC + 8);
#if defined(PROBE_PH)
    if (F.bid == 0 && F.tid == 0) { const unsigned long long t_ = __builtin_amdgcn_s_memrealtime(); MISC[32] = (unsigned)t_; MISC[33] = (unsigned)(t_ >> 32); }
#endif
#if defined(PROBE_PH)
#define SEAM(k) do { if (IN(k) && IN((k) + 1)) { xcd_barrier(bar); if (F.bid == 0 && F.tid == 0) { const unsigned long long t_ = __builtin_amdgcn_s_memrealtime(); MISC[32 + 2 * ((k) + 1)] = (unsigned)t_; MISC[33 + 2 * ((k) + 1)] = (unsigned)(t_ >> 32); } } } while (0)
#elif REP_BAR == 2
#define SEAM(k) do { if (IN(k) && IN((k) + 1)) { xcd_barrier(bar); xcd_barrier(bar); } } while (0)
#else
#define SEAM(k) do { if (IN(k) && IN((k) + 1)) xcd_barrier(bar); } while (0)
#endif
#else
#define SEAM(k) do { } while (0)
#endif
    const int gw = F.bid * NWAVES + F.wave, NGW = F.G * NWAVES;
    bf16* XN = (bf16*)(F.ws + WS_XN); bf16* PB = (bf16*)(F.ws + WS_PB); float* FZ = (float*)(F.ws + WS_FZ); bf16* GY = (bf16*)(F.ws + WS_GY);
    bf16* MIX = (bf16*)(F.ws + WS_MIX); bf16* ACT = (bf16*)(F.ws + WS_ACT);

    if (IN(0)) { p0_prologue(F);
#if REP_P0 == 2
        __syncthreads(); p0_prologue(F);
#endif
    } SEAM(0);
    if (IN(1)) {
        pg8::Gemm g{XN, (const bf16*)(F.ws + WS_WIN), MTOK, INC, DM}; pg8::StaticOrder S; S.init(MTOK, INC, F.G, F.bid);
        EpiIn E{PB, FZ, (bf16*)(F.ws + WS_U5)};
        pg8::gemm_phase<EpiIn, pg8::StaticOrder, true, true>(F.lds, g, S, E);
        { const int nunits = (MTOK / 256) * (INC / 256), rem = nunits % F.G;
          if (rem == 0) deferred_transposes<0>(F, gw, NGW); else if (F.bid >= rem) deferred_transposes<0>(F, (F.bid - rem) * NWAVES + F.wave, (F.G - rem) * NWAVES); }
#if REP_P1 == 2
        __syncthreads();
        pg8::gemm_phase<EpiIn, pg8::StaticOrder, true, true>(F.lds, g, S, E);
#endif
    } SEAM(1);
    if (IN(2)) {
        const int nper = (1024 + F.G - 1) / F.G, rot = F.bid % 3;
        if (rot == 0) {
            for (int it = F.bid; it < 256; it += F.G) s5_item(F, it);
            hgA_loop(F, 0, nper);
            for (int it = F.bid; it < SB_B * HH; it += F.G) hgrn_sample_item(F, it);
        } else if (rot == 1) {
            for (int it = F.bid; it < SB_B * HH; it += F.G) hgrn_sample_item(F, it);
            hgA_loop(F, 0, nper);
            __syncthreads();
            for (int it = F.bid; it < 256; it += F.G) s5_item(F, it);
        } else {
            hgA_loop(F, 0, nper / 2);
            __syncthreads();
            for (int it = F.bid; it < 256; it += F.G) s5_item(F, it);
            hgA_loop(F, nper / 2, nper);
            for (int it = F.bid; it < SB_B * HH; it += F.G) hgrn_sample_item(F, it);
        }
    } SEAM(2);
    if (IN(3)) { hg_scan(F, (bf16*)(F.ws + WS_DSC), F.bid, F.G); } SEAM(3);
    if (IN(4)) {
        pg8::Gemm g{GY, (const bf16*)(F.ws + WS_WGLU), MTOK, S5W, S5W}; pg8::StaticOrder S; S.init(MTOK, S5W, F.G, F.bid);
        EpiGlu E{GY, MIX};
        pg8::gemm_phase<EpiGlu, pg8::StaticOrder, true, true, true>(F.lds, g, S, E);
        __syncthreads();
        hgC_loop(F, (unsigned*)(F.ws + WS_CTL) + CW_QUEUE);
    } SEAM(4);
    if (IN(5)) {
        pg8::Gemm g{MIX, (const bf16*)(F.ws + WS_WOUT), MP, DM, DM}; pg8::StaticOrder S; S.init(MP, DM, F.G, F.bid);
#if REP_P5 >= 2
        { EpiOut E2{F.in[0], XN, (float*)(F.ws + WS_CTL) + CW_DUMMY};
#if REP_P5 == 2 || REP_P5 == 3
          pg8::gemm_phase<EpiOut, pg8::StaticOrder, true, true>(F.lds, g, S, E2);
          __syncthreads();
#endif
#if REP_P5 == 2 || REP_P5 == 4
          for (int it = F.bid; it < 256; it += F.G) outproj_sample_tile(F, it, (float*)(F.ws + WS_CTL) + CW_DUMMY);
          __syncthreads();
#endif
        }
#endif
        EpiOut E{F.in[0], XN, (float*)(F.ws + WS_CTL) + CW_SS1};
        const bool first = (F.G == 256) && ((F.bid & 1) == 0);
        if (first) { outproj_sample_tile(F, F.bid, (float*)(F.ws + WS_CTL) + CW_SS1); __syncthreads(); }
        pg8::gemm_phase<EpiOut, pg8::StaticOrder, true, true>(F.lds, g, S, E);
        __syncthreads();
        if (!first) for (int it = F.bid; it < 256; it += F.G) outproj_sample_tile(F, it, (float*)(F.ws + WS_CTL) + CW_SS1);
    } SEAM(5);
    if (IN(6)) {
        pg8::Gemm g{XN, (const bf16*)(F.ws + WS_WGU), MTOK, 2 * DFF, DM}; pg8::StaticOrder S; S.init(MTOK, 2 * DFF, F.G, F.bid);
        EpiAct E{ACT, (const float*)(F.ws + WS_CTL) + CW_SS1};
        pg8::gemm_phase<EpiAct, pg8::StaticOrder, P6_ALIGN, P6_SP2>(F.lds, g, S, E);
        { const int nunits = (MTOK / 256) * (2 * DFF / 256), rem = nunits % F.G;
          if (rem == 0) deferred_transposes<1>(F, gw, NGW); else if (F.bid >= rem) deferred_transposes<1>(F, (F.bid - rem) * NWAVES + F.wave, (F.G - rem) * NWAVES); }
#if REP_P6 == 2
        __syncthreads();
        pg8::gemm_phase<EpiAct, pg8::StaticOrder, true, true>(F.lds, g, S, E);
#endif
    } SEAM(6);
    if (IN(7)) {
        pg8::Gemm g{ACT, (const bf16*)(F.ws + WS_WD), MP, DM, DFF}; pg8::StaticOrder S; S.init(MP, DM, F.G, F.bid);
#if REP_P7 == 2
        { float* YD = (float*)(F.ws + WS_GY) - 0;
          EpiDown E2{XN, F.in[23], (float*)(F.ws + WS_CTL) + CW_DUMMY, (unsigned*)(F.ws + WS_CTL) + CW_DUMMY + 20480, YD};
          pg8::gemm_phase<EpiDown, pg8::StaticOrder, true, true>(F.lds, g, S, E2);
          __syncthreads();
          for (int it = F.bid; it < 256; it += F.G) down_sample_tile(F, it, (float*)(F.ws + WS_CTL) + CW_DUMMY, (unsigned*)(F.ws + WS_CTL) + CW_DUMMY + 20480 + 4096, YD);
          __syncthreads(); }
#endif
        EpiDown E{XN, F.in[23], (float*)(F.ws + WS_CTL) + CW_SS2, (unsigned*)(F.ws + WS_CTL) + CW_CNT, F.out + O_Y};
        Unit u0; const bool has_u = S.next(0, u0); const int grp = has_u ? (u0.pm & 1) : 0;
        const int stile = (F.G == 256 && has_u) ? grp * 128 + (u0.pm >> 1) * 4 + u0.pn : F.bid;
        if (F.G == 256 && grp == 0) { down_sample_tile(F, stile, (float*)(F.ws + WS_CTL) + CW_SS2, (unsigned*)(F.ws + WS_CTL) + CW_CNTS, F.out + O_Y); __syncthreads(); }
        pg8::gemm_phase<EpiDown, pg8::StaticOrder, true, true>(F.lds, g, S, E);
        __syncthreads();
        if (F.G != 256) { for (int it = F.bid; it < 256; it += F.G) down_sample_tile(F, it, (float*)(F.ws + WS_CTL) + CW_SS2, (unsigned*)(F.ws + WS_CTL) + CW_CNTS, F.out + O_Y); }
        else if (grp == 1) down_sample_tile(F, stile, (float*)(F.ws + WS_CTL) + CW_SS2, (unsigned*)(F.ws + WS_CTL) + CW_CNTS, F.out + O_Y);
    }
#if defined(PROBE_PH)
    if (F.bid == 0 && F.tid == 0) {
        const unsigned long long tn = __builtin_amdgcn_s_memrealtime();
        const unsigned long long t0 = ((unsigned long long)MISC[33 + 2 * PROBE_PH] << 32) | MISC[32 + 2 * PROBE_PH];
        const unsigned long long t1 = (PROBE_PH == NPH - 1) ? tn : (((unsigned long long)MISC[35 + 2 * PROBE_PH] << 32) | MISC[34 + 2 * PROBE_PH]);
        const unsigned long long wait = 4ull * (t1 - t0);
        while (__builtin_amdgcn_s_memrealtime() - tn < wait) __builtin_amdgcn_s_sleep(8);
    }
#endif
#undef IN
#undef SEAM
}

extern "C" void kernel_launch(void* const* d_in, const int* in_sizes, int n_in, void* d_out, int out_size, void* d_ws, size_t ws_size, hipStream_t stream) {
    static int grid = 0;
    if (grid == 0) {
        if (n_in != 24 || ws_size < WS_END) { fprintf(stderr, "kernel_launch: unexpected n_in %d / ws %zu\n", n_in, ws_size); grid = -1; return; }
        int dev = 0, cus = 0, per_cu = 0;
        if (hipGetDevice(&dev) != hipSuccess || hipDeviceGetAttribute(&cus, hipDeviceAttributeMultiprocessorCount, dev) != hipSuccess) { grid = -1; return; }
        if (hipFuncSetAttribute((const void*)mk_fwd, hipFuncAttributeMaxDynamicSharedMemorySize, LDS_BYTES) != hipSuccess) { fprintf(stderr, "kernel_launch: hipFuncSetAttribute failed\n"); grid = -1; return; }
        if (hipOccupancyMaxActiveBlocksPerMultiprocessor(&per_cu, (const void*)mk_fwd, NWAVES * 64, LDS_BYTES) != hipSuccess || per_cu < 1) { fprintf(stderr, "kernel_launch: occupancy query says %d\n", per_cu); per_cu = 1; }
        (void)hipGetLastError();
        grid = cus;
    }
    if (grid < 0) return;
#if REP_MEMSET == 2
    (void)hipMemsetAsync((char*)d_ws + WS_CTL + 1048576 + 524288, 0, CTL_ZERO_BYTES, stream);
#endif
    if (hipMemsetAsync((char*)d_ws + WS_CTL, 0, CTL_ZERO_BYTES, stream) != hipSuccess) { fprintf(stderr, "kernel_launch: memset failed\n"); return; }
    Args a{};
    for (int i = 0; i < 24; ++i) a.in[i] = (const float*)d_in[i];
    a.out = (float*)d_out; a.ws = (unsigned char*)d_ws;
#if MK_N_LAUNCHES == 1
    a.ph_lo = 0; a.ph_hi = NPH;
    void* kargs[] = {&a};
    hipError_t e = hipLaunchCooperativeKernel((const void*)mk_fwd, dim3(grid), dim3(NWAVES * 64), kargs, LDS_BYTES, stream);
    if (e != hipSuccess) fprintf(stderr, "kernel_launch: cooperative launch failed: %s (grid %d)\n", hipGetErrorString(e), grid);
#else
    for (int p = 0; p < NPH; ++p) { a.ph_lo = p; a.ph_hi = p + 1; hipLaunchKernelGGL(mk_fwd, dim3(grid), dim3(NWAVES * 64), LDS_BYTES, stream, a); }
#endif
}
```

```cpp
#include <hip/hip_runtime.h>
#include <hip/hip_cooperative_groups.h>
#include <cstdio>
#include <cstdint>
namespace cg = cooperative_groups;
#ifndef PG8_WGM
#define PG8_WGM 4
#endif
#define MK_N_LAUNCHES 1
namespace pg8 {
#define PG8_LAS __attribute__((address_space(3)))
typedef unsigned short bf16_t;
typedef short bf16x8 __attribute__((ext_vector_type(8)));
typedef float f32x4 __attribute__((ext_vector_type(4)));
typedef unsigned u32x4 __attribute__((ext_vector_type(4)));
constexpr int BM = 256, BK = 64, HALF = 128, HTB = HALF * BK * 2  , STAGE_BYTES = 8 * HTB, NXCD = 8, WGM = PG8_WGM;

__host__ __device__ __forceinline__ int lds_byte(int r, int c) { const int st = (r >> 4) * 2 + (c >> 5), rr = r & 15, cc = c & 31, ob = rr * 64 + cc * 2; return st * 1024 + (ob ^ (((ob >> 9) & 1) << 5)); }
__host__ __device__ __forceinline__ void stage_rc(int b, int& R, int& C) { const int st = b / 1024, sb = b % 1024, swz = sb ^ (((sb >> 9) & 1) << 5); R = (st >> 1) * 16 + swz / 64; C = (st & 1) * 32 + (swz % 64) / 2; }
__host__ __device__ __forceinline__ int perm32(int rho) { const int n = rho >> 4, i = rho & 15; return 8 * (i >> 2) + 4 * n + (i & 3); }

struct Unit { int pm, pn; };
struct Gemm { const bf16_t* A; const bf16_t* Bt; int M, N, K; };

struct StaticOrder {
    int nM, nN, nwg, G, c;
    __host__ __device__ void init(int M, int N, int G_, int c_) { nM = M / BM; nN = N / BM; nwg = nM * nN; G = G_; c = c_; }
    __host__ __device__ bool next(int i, Unit& u) const {
        const long L = (long)i * G + c; if (L >= nwg) return false;
        int wgid = (int)L; { const int q = nwg / NXCD, r = nwg % NXCD, xcd = wgid % NXCD, off = wgid / NXCD; wgid = (xcd < r ? xcd * (q + 1) : r * (q + 1) + (xcd - r) * q) + off; }
        const int nig = WGM * nN, gid = wgid / nig, fm = gid * WGM, gsz = (nM - fm) < WGM ? (nM - fm) : WGM;
        u.pm = fm + ((wgid % nig) % gsz); u.pn = (wgid % nig) / gsz; return true;
    }
    __device__ __forceinline__ void a_ready(const Unit&) const {}
    __device__ __forceinline__ void done(const Unit&) const {}
};

__device__ __forceinline__ unsigned cvt_pk_bf16(float lo, float hi) { unsigned r; asm volatile("v_cvt_pk_bf16_f32 %0, %1, %2" : "=v"(r) : "v"(lo), "v"(hi)); return r; }
template <class Epi, class Sched, bool ALIGN_EPI = false, bool SP2 = false, bool AGM = false  >
__device__ __forceinline__ void gemm_phase(PG8_LAS unsigned char* lds, const Gemm g, const Sched& S, const Epi& E) {
    const int tid = threadIdx.x, wid = __builtin_amdgcn_readfirstlane(tid >> 6), lane = tid & 63, wr = wid >> 2, wc = wid & 3, fr = lane & 15, fq = lane >> 4;
    const int K = g.K, nt = K / BK;
    unsigned voffA[2], voffB[2];
#pragma unroll
    for (int i = 0; i < 2; ++i) { int R, C; stage_rc(tid * 16 + i * 8192, R, C); const int Rb = Epi::PERM ? ((R & ~31) + perm32(R & 31)) : R;
        voffA[i] = AGM ? (unsigned)((((C >> 4) * g.M + R) * 16 + (C & 15)) * 2) : (unsigned)(R * K + C) * 2u; voffB[i] = (unsigned)(Rb * K + C) * 2u; }
    const size_t kstep = (size_t)(BK * 2);
    const size_t hstep = (size_t)HALF * K * 2;
    const size_t tstep = 2 * hstep;
    const size_t kstepA = AGM ? (size_t)4 * g.M * 32 : kstep, hstepA = AGM ? (size_t)HALF * 32 : hstep, tstepA = 2 * hstepA;
    const unsigned ldsw = (unsigned)wid * 1024u;
    const int aoff = lds_byte(wr * 64 + fr, fq * 8), boff = lds_byte(wc * 32 + fr, fq * 8);
#define PG8_SA(b, h) (((b) * 2 + (h)) * HTB)
#define PG8_SB(b, h) ((4 + (b) * 2 + (h)) * HTB)
#define PG8_STAGE(bufoff, gbase, voff) do { _Pragma("unroll") for (int _i = 0; _i < 2; ++_i) \
        __builtin_amdgcn_global_load_lds((const unsigned*)((const char*)(gbase) + (voff)[_i]), (PG8_LAS unsigned*)(lds + (bufoff) + ldsw + _i * 8192), 16, 0, 0); } while (0)
#define PG8_LDA(dst, b, h) do { _Pragma("unroll") for (int m = 0; m < 4; ++m) _Pragma("unroll") for (int k = 0; k < 2; ++k) dst[m][k] = *(const PG8_LAS bf16x8*)(lds + PG8_SA(b, h) + aoff + m * 2048 + k * 1024); } while (0)
#define PG8_LDB(dst, b, h) do { _Pragma("unroll") for (int n = 0; n < 2; ++n) _Pragma("unroll") for (int k = 0; k < 2; ++k) dst[n][k] = *(const PG8_LAS bf16x8*)(lds + PG8_SB(b, h) + boff + n * 2048 + k * 1024); } while (0)
#define PG8_MMA(ai, bj, At, Bt) do { __builtin_amdgcn_s_setprio(1); _Pragma("unroll") for (int m = 0; m < 4; ++m) _Pragma("unroll") for (int n = 0; n < 2; ++n) _Pragma("unroll") for (int k = 0; k < 2; ++k) \
        acc[ai][bj][m][n] = __builtin_amdgcn_mfma_f32_16x16x32_bf16(Bt[n][k], At[m][k], acc[ai][bj][m][n], 0, 0, 0); __builtin_amdgcn_s_setprio(0); } while (0)
#define PG8_WAIT_V(n) asm volatile("s_waitcnt vmcnt(" #n ")" ::: "memory")
#define PG8_WAIT_L(n) asm volatile("s_waitcnt lgkmcnt(" #n ")" ::: "memory")
#define PG8_BAR __builtin_amdgcn_s_barrier()
#define PG8_SCHED __builtin_amdgcn_sched_barrier(0)
    Unit cur, nxt; int ui = 0;
    if (!S.next(0, cur)) return;
    f32x4 acc[2][2][4][2];
#pragma unroll
    for (int a = 0; a < 2; ++a)
#pragma unroll
        for (int b = 0; b < 2; ++b)
#pragma unroll
            for (int m = 0; m < 4; ++m)
#pragma unroll
                for (int n = 0; n < 2; ++n) acc[a][b][m][n] = (f32x4){0.f, 0.f, 0.f, 0.f};
    bf16x8 At[4][2], B0[2][2], B1[2][2];
    const char* cA = (const char*)g.A + (size_t)cur.pm * tstepA; const char* cB = (const char*)g.Bt + (size_t)cur.pn * tstep;
    S.a_ready(cur);
    if constexpr (SP2) {
        PG8_STAGE(PG8_SB(0, 0), cB, voffB); PG8_STAGE(PG8_SB(0, 1), cB + hstep, voffB); PG8_STAGE(PG8_SA(0, 0), cA, voffA); PG8_STAGE(PG8_SA(0, 1), cA + hstepA, voffA);
        if (wr == 1) PG8_BAR;
        PG8_WAIT_V(2); PG8_BAR;
        PG8_STAGE(PG8_SB(1, 0), cB + kstep, voffB); PG8_STAGE(PG8_SA(1, 0), cA + kstepA, voffA); PG8_STAGE(PG8_SB(1, 1), cB + hstep + kstep, voffB);
        PG8_WAIT_V(6); PG8_BAR;
    } else {
        PG8_STAGE(PG8_SB(0, 0), cB, voffB); PG8_STAGE(PG8_SA(0, 0), cA, voffA); PG8_STAGE(PG8_SB(0, 1), cB + hstep, voffB); PG8_STAGE(PG8_SA(0, 1), cA + hstepA, voffA);
        if (wr == 1) PG8_BAR;
        PG8_WAIT_V(4); PG8_BAR;
        PG8_STAGE(PG8_SB(1, 0), cB + kstep, voffB); PG8_STAGE(PG8_SA(1, 0), cA + kstepA, voffA); PG8_STAGE(PG8_SB(1, 1), cB + hstep + kstep, voffB);
        PG8_WAIT_V(6); PG8_BAR;
    }
    for (;;) {
        const bool has_next = S.next(ui + 1, nxt);
        const char* nA = has_next ? (const char*)g.A + (size_t)nxt.pm * tstepA : cA; const char* nB = has_next ? (const char*)g.Bt + (size_t)nxt.pn * tstep : cB;
        for (int t = 0; t < nt; t += 2) {
            const bool last = (t == nt - 2);
            const char* a1 = cA + (size_t)(t + 1) * kstepA;
            const char* a2 = last ? nA : cA + (size_t)(t + 2) * kstepA; const char* b2 = last ? nB : cB + (size_t)(t + 2) * kstep;
            const char* a3 = a2 + kstepA; const char* b3 = b2 + kstep;
            if (last && has_next) S.a_ready(nxt);
            if constexpr (SP2) {
            PG8_LDB(B0, 0, 0); PG8_LDB(B1, 0, 1); PG8_SCHED; PG8_LDA(At, 0, 0); PG8_STAGE(PG8_SA(1, 1), a1 + hstepA, voffA);
            PG8_WAIT_V(8); PG8_WAIT_L(0); PG8_BAR; PG8_MMA(0, 0, At, B0); PG8_MMA(0, 1, At, B1); PG8_BAR; PG8_SCHED;
            PG8_LDA(At, 0, 1); PG8_STAGE(PG8_SB(0, 0), b2, voffB); PG8_STAGE(PG8_SB(0, 1), b2 + hstep, voffB); PG8_STAGE(PG8_SA(0, 0), a2, voffA);
            PG8_WAIT_V(8); PG8_WAIT_L(0); PG8_BAR; PG8_MMA(1, 0, At, B0); PG8_MMA(1, 1, At, B1); PG8_BAR; PG8_SCHED;
            PG8_LDB(B0, 1, 0); PG8_LDB(B1, 1, 1); PG8_SCHED; PG8_LDA(At, 1, 0); PG8_STAGE(PG8_SA(0, 1), a2 + hstepA, voffA);
            PG8_WAIT_V(8); PG8_WAIT_L(0); PG8_BAR; PG8_MMA(0, 0, At, B0); PG8_MMA(0, 1, At, B1); PG8_BAR; PG8_SCHED;
            PG8_LDA(At, 1, 1); PG8_STAGE(PG8_SB(1, 0), b3, voffB); PG8_STAGE(PG8_SB(1, 1), b3 + hstep, voffB); PG8_STAGE(PG8_SA(1, 0), a3, voffA);
            PG8_WAIT_V(8); PG8_WAIT_L(0); PG8_BAR; PG8_MMA(1, 0, At, B0); PG8_MMA(1, 1, At, B1); PG8_BAR; PG8_SCHED;
            } else {
            PG8_LDB(B0, 0, 0); PG8_SCHED; PG8_LDA(At, 0, 0); PG8_STAGE(PG8_SA(1, 1), a1 + hstepA, voffA);
            PG8_WAIT_L(8); PG8_BAR; PG8_WAIT_L(0); PG8_MMA(0, 0, At, B0); PG8_BAR; PG8_SCHED;
            PG8_LDB(B1, 0, 1); PG8_STAGE(PG8_SB(0, 0), b2, voffB);
            PG8_BAR; PG8_WAIT_L(0); PG8_MMA(0, 1, At, B1); PG8_BAR;
            PG8_LDA(At, 0, 1); PG8_STAGE(PG8_SA(0, 0), a2, voffA);
            PG8_BAR; PG8_WAIT_L(0); PG8_MMA(1, 0, At, B0); PG8_BAR; PG8_SCHED;
            PG8_STAGE(PG8_SB(0, 1), b2 + hstep, voffB);
            PG8_WAIT_V(6); PG8_BAR; PG8_MMA(1, 1, At, B1); PG8_BAR;
            PG8_LDB(B0, 1, 0); PG8_SCHED; PG8_LDA(At, 1, 0); PG8_STAGE(PG8_SA(0, 1), a2 + hstepA, voffA);
            PG8_WAIT_L(8); PG8_BAR; PG8_WAIT_L(0); PG8_MMA(0, 0, At, B0); PG8_BAR; PG8_SCHED;
            PG8_LDB(B1, 1, 1); PG8_STAGE(PG8_SB(1, 0), b3, voffB);
            PG8_BAR; PG8_WAIT_L(0); PG8_MMA(0, 1, At, B1); PG8_BAR;
            PG8_LDA(At, 1, 1); PG8_STAGE(PG8_SA(1, 0), a3, voffA);
            PG8_BAR; PG8_WAIT_L(0); PG8_MMA(1, 0, At, B0); PG8_BAR; PG8_SCHED;
            PG8_STAGE(PG8_SB(1, 1), b3 + hstep, voffB);
            PG8_WAIT_V(6); PG8_BAR; PG8_MMA(1, 1, At, B1); PG8_BAR;
            }
        }
        if constexpr (ALIGN_EPI) { if (wr == 0) PG8_BAR; }
        if constexpr (!Epi::AFTER_DRAIN) { E(acc, cur, wr, wc, fr, fq); S.done(cur); }
        if (!has_next) break;
#pragma unroll
        for (int a = 0; a < 2; ++a)
#pragma unroll
            for (int b = 0; b < 2; ++b)
#pragma unroll
                for (int m = 0; m < 4; ++m)
#pragma unroll
                    for (int n = 0; n < 2; ++n) acc[a][b][m][n] = (f32x4){0.f, 0.f, 0.f, 0.f};
        cur = nxt; cA = nA; cB = nB; ++ui;
        if constexpr (ALIGN_EPI) { if (wr == 1) PG8_BAR; }
    }
    PG8_WAIT_V(0);
    if constexpr (!ALIGN_EPI) { if (wr == 0) PG8_BAR; }
    PG8_BAR;
    if constexpr (Epi::AFTER_DRAIN) { E.fused(acc, cur, wr, wc, fr, fq, lds, wid, lane); S.done(cur); }
#undef PG8_SA
#undef PG8_SB
#undef PG8_STAGE
#undef PG8_LDA
#undef PG8_LDB
#undef PG8_MMA
#undef PG8_WAIT_V
#undef PG8_WAIT_L
#undef PG8_BAR
#undef PG8_SCHED
}
}

#ifndef S5_SIMPLE
#define S5_SIMPLE 0
#endif
#ifndef HG_SIMPLE
#define HG_SIMPLE 0
#endif
#ifndef REP0
#define REP0 1
#define REP1 1
#define REP2 1
#define REP3 1
#define REP4 1
#define REP6 1
#endif
#ifndef REP_S5
#define REP_S5 1
#endif
#ifndef REP_HGA
#define REP_HGA 1
#endif
#ifndef REP_HGC
#define REP_HGC 1
#endif
#ifndef REP_P1
#define REP_P1 1
#endif
#ifndef REP_P6
#define REP_P6 1
#endif
#ifndef REP_P0
#define REP_P0 1
#endif
#ifndef REP_GLU
#define REP_GLU 1
#endif
#ifndef REP_P3
#define REP_P3 1
#endif
#ifndef REP_P5
#define REP_P5 1
#endif
#ifndef REP_P7
#define REP_P7 1
#endif
#ifndef REP_BAR
#define REP_BAR 1
#endif
#ifndef REP_XN
#define REP_XN 1
#endif
#ifndef P6_ALIGN
#define P6_ALIGN true
#endif
#ifndef P6_SP2
#define P6_SP2 true
#endif
#ifndef REP_MEMSET
#define REP_MEMSET 1
#endif
#ifndef ONEUNIT_ALIGN
#define ONEUNIT_ALIGN true
#endif
#ifndef MK_N_LAUNCHES
#define MK_N_LAUNCHES 1
#endif
constexpr int DM = 1024, PB_B = 8, PB_T = 2048, SB_B = 128, SB_T = 8;
constexpr int MP = PB_B * PB_T, MS = SB_B * SB_T, MTOK = MP + MS;
constexpr int S5W = 512, S5G = 32, S5C = 16, S5N = 64;
constexpr int HGW = 512, HD = 128, HH = 4;
constexpr int INC = 2560, DFF = 2816;
constexpr float EPS = 1e-6f;
constexpr int NPH = 8;
constexpr size_t O_Y = 0, O_PRE = (size_t)MTOK * DM, O_PIM = O_PRE + 16384, O_PHG = O_PIM + 16384, O_SRE = O_PHG + 524288, O_SIM = O_SRE + 262144, O_SHG = O_SIM + 262144;
constexpr size_t MiB = 1u << 20;
constexpr size_t WS_CTL = 0, WS_WIN = 2 * MiB, WS_WGLU = 7 * MiB, WS_WOUT = 8 * MiB, WS_WGU = 10 * MiB, WS_WD = 21 * MiB;
constexpr size_t WS_XN = 27 * MiB, WS_PB = 61 * MiB, WS_FZ = 129 * MiB, WS_ACT = 61 * MiB, WS_GY = 163 * MiB, WS_OH = 180 * MiB, WS_MIX = 197 * MiB, WS_END = 234 * MiB;
constexpr int PBW = 2048;
constexpr int LDS_BYTES = 147456;
constexpr int NWAVES = 8;
constexpr int CW_SS1 = 16384, CW_SS2 = 36864, CW_CNT = 57344, CW_CNTS = 61440;

#define GAS __attribute__((address_space(1)))
#define LAS __attribute__((address_space(3)))
typedef unsigned short bf16;
typedef unsigned v4u __attribute__((ext_vector_type(4)));
typedef unsigned v2u __attribute__((ext_vector_type(2)));
typedef float f32x4 __attribute__((ext_vector_type(4)));
#define LDS_WAIT() asm volatile("s_waitcnt lgkmcnt(0)" ::: "memory")
typedef float f32x2_t __attribute__((ext_vector_type(2))); typedef __bf16 bf16x2_t __attribute__((ext_vector_type(2)));
__device__ __forceinline__ unsigned pk2(float lo, float hi) { f32x2_t v = {lo, hi}; bf16x2_t h = __builtin_convertvector(v, bf16x2_t); return __builtin_bit_cast(unsigned, h); }
__device__ __forceinline__ unsigned f2bf(float f) { return pk2(f, 0.f) & 0xffffu; }
__device__ __forceinline__ float bf2f(unsigned short h) { return __builtin_bit_cast(float, (unsigned)h << 16); }
__device__ __forceinline__ float bflo(unsigned w) { return __builtin_bit_cast(float, w << 16); }
__device__ __forceinline__ float bfhi(unsigned w) { return __builtin_bit_cast(float, w & 0xffff0000u); }
__device__ __forceinline__ float sigmoidf_(float x) { return __builtin_amdgcn_rcpf(1.0f + __builtin_amdgcn_exp2f(-1.4426950408889634f * x)); }
__device__ __forceinline__ float siluf_(float x) { return x * __builtin_amdgcn_rcpf(1.0f + __builtin_amdgcn_exp2f(-1.4426950408889634f * x)); }
__device__ __forceinline__ float gelu_tanh(float x) { const float z = -2.302208198144325f * (x + 0.044715f * x * x * x); return x * __builtin_amdgcn_rcpf(1.0f + __builtin_amdgcn_exp2f(z)); }
__device__ __forceinline__ float wave_sum(float v) {
#pragma unroll
    for (int o = 1; o < 64; o <<= 1) v += __shfl_xor(v, o);
    return v;
}

#if defined(AMP_A)
#define STAMP(i) do { if (F.bid == AMP_BLK && F.tid == 0) { const unsigned long long t_ = __builtin_amdgcn_s_memrealtime(); volatile LAS unsigned* M_ = (volatile LAS unsigned*)(F.lds + LDS_BYTES - 512); M_[64 + 2 * (i)] = (unsigned)t_; M_[65 + 2 * (i)] = (unsigned)(t_ >> 32); } } while (0)
#else
#define STAMP(i) do { } while (0)
#endif
#ifndef AMP_BLK
#define AMP_BLK 0
#endif
struct Args { const float* in[24]; float* out; unsigned char* ws; int ph_lo, ph_hi; };

struct Frame {
    LAS unsigned char* lds;
    int tid, lane, wave, G, bid;
    const float* in[24];
    float* out; unsigned char* ws;
};
__device__ __forceinline__ const float* xrow(const Frame& F, int m) { return m < MP ? F.in[0] + (size_t)m * DM : F.in[1] + (size_t)(m - MP) * DM; }

__device__ __forceinline__ void transpose_item(const float* W, int ldw, bf16* WT, int K, int k0, int sn0, int dn0, int lane, const float* kgain = nullptr) {
    const int k = k0 + 4 * (lane & 15), nl = 4 * (lane >> 4);
    f32x4 r[4][4];
#pragma unroll
    for (int nb = 0; nb < 4; ++nb)
#pragma unroll
        for (int j = 0; j < 4; ++j) r[nb][j] = *(const GAS f32x4*)(W + (size_t)(k + j) * ldw + sn0 + nl + 16 * nb);
    f32x4 g = {1.f, 1.f, 1.f, 1.f}; if (kgain) g = *(const GAS f32x4*)(kgain + k);
#pragma unroll
    for (int nb = 0; nb < 4; ++nb) { const f32x4 a = r[nb][0] * g.x, b = r[nb][1] * g.y, c = r[nb][2] * g.z, d = r[nb][3] * g.w;
        bf16* o = WT + (size_t)(dn0 + nl + 16 * nb) * K + k;
        v2u w; w.x = pk2(a.x, b.x); w.y = pk2(c.x, d.x); *(GAS v2u*)o = w;
        w.x = pk2(a.y, b.y); w.y = pk2(c.y, d.y); *(GAS v2u*)(o + K) = w;
        w.x = pk2(a.z, b.z); w.y = pk2(c.z, d.z); *(GAS v2u*)(o + 2 * (size_t)K) = w;
        w.x = pk2(a.w, b.w); w.y = pk2(c.w, d.w); *(GAS v2u*)(o + 3 * (size_t)K) = w; }
}
__device__ __forceinline__ void rms_row4_bf16(const float* x0_, const float* gain, bf16* o0, int lane) {
    f32x4 v[4][4]; float s[4];
#pragma unroll
    for (int r = 0; r < 4; ++r)
#pragma unroll
        for (int j = 0; j < 4; ++j) v[r][j] = ((const GAS f32x4*)(x0_ + (size_t)r * DM))[lane + 64 * j];
#pragma unroll
    for (int r = 0; r < 4; ++r) { s[r] = 0.f;
#pragma unroll
        for (int j = 0; j < 4; ++j) s[r] += (v[r][j].x * v[r][j].x + v[r][j].y * v[r][j].y) + (v[r][j].z * v[r][j].z + v[r][j].w * v[r][j].w); }
#pragma unroll
    for (int o = 1; o < 64; o <<= 1) { s[0] += __shfl_xor(s[0], o); s[1] += __shfl_xor(s[1], o); s[2] += __shfl_xor(s[2], o); s[3] += __shfl_xor(s[3], o); }
#pragma unroll
    for (int r = 0; r < 4; ++r) s[r] = __builtin_amdgcn_rsqf(s[r] * (1.0f / DM) + EPS);
#pragma unroll
    for (int j = 0; j < 4; ++j) { const f32x4 g = ((const GAS f32x4*)gain)[lane + 64 * j];
#pragma unroll
        for (int r = 0; r < 4; ++r) { const float rs = s[r];
            v2u w; w.x = pk2(v[r][j].x * rs * g.x, v[r][j].y * rs * g.y); w.y = pk2(v[r][j].z * rs * g.z, v[r][j].w * rs * g.w); ((GAS v2u*)(o0 + (size_t)r * DM))[lane + 64 * j] = w; } }
}

__device__ __forceinline__ void s5_tables_item(Frame& F, int item);
__device__ __forceinline__ void p0_prologue(Frame& F) {
    const int gw = F.bid * NWAVES + F.wave, NGW = F.G * NWAVES;
    bf16* XN = (bf16*)(F.ws + WS_XN);
    STAMP(0);
    for (int m = 4 * gw; m < MTOK; m += 4 * NGW) rms_row4_bf16(xrow(F, m), F.in[6], XN + (size_t)m * DM, F.lane);
    STAMP(1);
#if REP_XN == 2
    for (int m = 4 * gw; m < MTOK; m += 4 * NGW) rms_row4_bf16(xrow(F, m), F.in[6], XN + (size_t)m * DM, F.lane);
#endif
    bf16* WinT = (bf16*)(F.ws + WS_WIN);
    constexpr int I_IN = (DM / 64) * (INC / 64);
    for (int r = gw; r < I_IN; r += NGW) { const int nblk = INC / 64, kb = r / nblk, nb = r % nblk, sn0 = nb * 64; const int seg = sn0 / 512, off = sn0 % 512;
        const int dseg = seg == 0 ? 0 : seg == 1 ? 1 : seg == 2 ? 4 : seg == 3 ? 2 : 3;
        transpose_item(F.in[7], INC, WinT, DM, kb * 64, sn0, dseg * 512 + off, F.lane); }
    STAMP(2);
    for (int it = F.bid; it < 256; it += F.G) s5_tables_item(F, it);
    STAMP(3);
}

template <int PART> __device__ __forceinline__ void deferred_transposes(Frame& F, int gw, int ngw) {
    bf16* WgluT = (bf16*)(F.ws + WS_WGLU); bf16* WoutT = (bf16*)(F.ws + WS_WOUT); bf16* WguT = (bf16*)(F.ws + WS_WGU); bf16* WdT = (bf16*)(F.ws + WS_WD);
    constexpr int I_GLU = (S5W / 64) * (S5W / 64), I_OUT = (DM / 64) * (DM / 64), I_G = (DM / 64) * (DFF / 64), I_D = (DFF / 64) * (DM / 64);
    constexpr int N0 = I_GLU + I_OUT + 2 * I_G, NITEMS = (PART == 0) ? N0 : I_D;
    for (int it = gw; it < NITEMS; it += ngw) {
        int r = (PART == 0) ? it : it + N0;
        if (r < I_GLU) { const int nblk = S5W / 64, kb = r / nblk, nb = r % nblk; transpose_item(F.in[16], S5W, WgluT, S5W, kb * 64, nb * 64, nb * 64, F.lane); continue; } r -= I_GLU;
        if (r < I_OUT) { const int nblk = DM / 64, kb = r / nblk, nb = r % nblk; transpose_item(F.in[18], DM, WoutT, DM, kb * 64, nb * 64, nb * 64, F.lane); continue; } r -= I_OUT;
        if (r < I_G) { const int nblk = DFF / 64, kb = r / nblk, nb = r % nblk, sn0 = nb * 64; transpose_item(F.in[20], DFF, WguT, DM, kb * 64, sn0, 256 * (sn0 / 128) + (sn0 % 128), F.lane, F.in[19]); continue; } r -= I_G;
        if (r < I_G) { const int nblk = DFF / 64, kb = r / nblk, nb = r % nblk, sn0 = nb * 64; transpose_item(F.in[21], DFF, WguT, DM, kb * 64, sn0, 256 * (sn0 / 128) + 128 + (sn0 % 128), F.lane, F.in[19]); continue; } r -= I_G;
        { const int nblk = DM / 64, kb = r / nblk, nb = r % nblk; transpose_item(F.in[22], DM, WdT, DFF, kb * 64, nb * 64, nb * 64, F.lane); }
    }
}

using pg8::Unit; using pg8::u32x4; using pg8::cvt_pk_bf16; using pg8::BM; using pg8::HALF;
struct EpiIn {
    static constexpr bool PERM = true, AFTER_DRAIN = false;
    bf16* PB; float* FZ; bf16* U5;
    __device__ __forceinline__ void operator()(const pg8::f32x4 (&acc)[2][2][4][2], const Unit& u, int wr, int wc, int fr, int fq) const {
        const int row0 = u.pm * BM + wr * 64 + fr;
        if (u.pn < 2) { const int col0 = u.pn * BM + wc * 32 + 8 * fq;
#pragma unroll
            for (int ai = 0; ai < 2; ++ai)
#pragma unroll
                for (int m = 0; m < 4; ++m) { const size_t r = (size_t)(row0 + ai * HALF + m * 16);
#pragma unroll
                    for (int bj = 0; bj < 2; ++bj) { const int col = col0 + bj * HALF; const pg8::f32x4 v0 = acc[ai][bj][m][0], v1 = acc[ai][bj][m][1]; u32x4 w; w.x = cvt_pk_bf16(v0[0], v0[1]); w.y = cvt_pk_bf16(v0[2], v0[3]); w.z = cvt_pk_bf16(v1[0], v1[1]); w.w = cvt_pk_bf16(v1[2], v1[3]);
                        *(u32x4*)(U5 + ((size_t)(col >> 4) * MTOK + r) * 16 + (col & 15)) = w; } }
        } else if (u.pn < 8) { const int col0 = u.pn * BM + wc * 32 + 8 * fq;
#pragma unroll
            for (int ai = 0; ai < 2; ++ai)
#pragma unroll
                for (int m = 0; m < 4; ++m) { bf16* rowp = PB + (size_t)(row0 + ai * HALF + m * 16) * PBW + col0;
#pragma unroll
                    for (int bj = 0; bj < 2; ++bj) { const pg8::f32x4 v0 = acc[ai][bj][m][0], v1 = acc[ai][bj][m][1]; u32x4 w; w.x = cvt_pk_bf16(v0[0], v0[1]); w.y = cvt_pk_bf16(v0[2], v0[3]); w.z = cvt_pk_bf16(v1[0], v1[1]); w.w = cvt_pk_bf16(v1[2], v1[3]);
                        *(u32x4*)(rowp + bj * HALF) = w; } }
        } else { const int col0 = (u.pn - 8) * BM + wc * 32 + 8 * fq;
#pragma unroll
            for (int ai = 0; ai < 2; ++ai)
#pragma unroll
                for (int m = 0; m < 4; ++m) { float* rowp = FZ + (size_t)(row0 + ai * HALF + m * 16) * 512 + col0;
#pragma unroll
                    for (int bj = 0; bj < 2; ++bj)
#pragma unroll
                        for (int n = 0; n < 2; ++n) *(pg8::f32x4*)(rowp + bj * HALF + 4 * n) = acc[ai][bj][m][n]; }
        }
    }
};
struct EpiGlu {
    static constexpr bool PERM = true, AFTER_DRAIN = false;
    const bf16* GY; bf16* MIX;
    __device__ __forceinline__ void operator()(const pg8::f32x4 (&acc)[2][2][4][2], const Unit& u, int wr, int wc, int fr, int fq) const {
        const int row0 = u.pm * BM + wr * 64 + fr, col0 = u.pn * BM + wc * 32 + 8 * fq;
#pragma unroll
        for (int ai = 0; ai < 2; ++ai)
#pragma unroll
            for (int m = 0; m < 4; ++m) { const size_t r = (size_t)(row0 + ai * HALF + m * 16);
#pragma unroll
                for (int bj = 0; bj < 2; ++bj) { const int col = col0 + bj * HALF; const u32x4 g = *(const u32x4*)(GY + ((size_t)(col >> 4) * MTOK + r) * 16 + (col & 15)); const pg8::f32x4 v0 = acc[ai][bj][m][0], v1 = acc[ai][bj][m][1];
                    u32x4 w; w.x = cvt_pk_bf16(bflo(g.x) * sigmoidf_(v0[0]), bfhi(g.x) * sigmoidf_(v0[1])); w.y = cvt_pk_bf16(bflo(g.y) * sigmoidf_(v0[2]), bfhi(g.y) * sigmoidf_(v0[3]));
                    w.z = cvt_pk_bf16(bflo(g.z) * sigmoidf_(v1[0]), bfhi(g.z) * sigmoidf_(v1[1])); w.w = cvt_pk_bf16(bflo(g.w) * sigmoidf_(v1[2]), bfhi(g.w) * sigmoidf_(v1[3]));
                    *(u32x4*)(MIX + r * DM + col0 + bj * HALF) = w; } }
    }
};
__device__ __forceinline__ float rstd_of(float ss) { return __builtin_amdgcn_rsqf(ss * (1.0f / DM) + EPS); }
__device__ __forceinline__ float atomic_read_f32(float* p) { return __hip_atomic_fetch_add(p, 0.0f, __ATOMIC_RELAXED, __HIP_MEMORY_SCOPE_AGENT); }
__device__ __forceinline__ void wait_count(unsigned* cnt, unsigned want) {
    for (unsigned sp = 0; sp < (1u << 22); ++sp) { if (__hip_atomic_load(cnt, __ATOMIC_RELAXED, __HIP_MEMORY_SCOPE_AGENT) >= want) break; __builtin_amdgcn_s_sleep(2); }
}
struct EpiOut {
    static constexpr bool PERM = true, AFTER_DRAIN = false;
    const float* xp; bf16* XN; float* SS1;
    __device__ __forceinline__ void operator()(const pg8::f32x4 (&acc)[2][2][4][2], const Unit& u, int wr, int wc, int fr, int fq) const {
        const int row0 = u.pm * BM + wr * 64 + fr, col0 = u.pn * BM + wc * 32 + 8 * fq;
#pragma unroll
        for (int ai = 0; ai < 2; ++ai)
#pragma unroll
            for (int m = 0; m < 4; ++m) { const int row = row0 + ai * HALF + m * 16; const size_t off = (size_t)row * DM + col0; float ss = 0.f;
#pragma unroll
                for (int bj = 0; bj < 2; ++bj) { const pg8::f32x4 x0 = *(const pg8::f32x4*)(xp + off + bj * HALF) + acc[ai][bj][m][0], x1 = *(const pg8::f32x4*)(xp + off + bj * HALF + 4) + acc[ai][bj][m][1];
                    ss += (x0[0] * x0[0] + x0[1] * x0[1]) + (x0[2] * x0[2] + x0[3] * x0[3]) + (x1[0] * x1[0] + x1[1] * x1[1]) + (x1[2] * x1[2] + x1[3] * x1[3]);
                    u32x4 w; w.x = cvt_pk_bf16(x0[0], x0[1]); w.y = cvt_pk_bf16(x0[2], x0[3]); w.z = cvt_pk_bf16(x1[0], x1[1]); w.w = cvt_pk_bf16(x1[2], x1[3]);
                    *(u32x4*)(XN + off + bj * HALF) = w; }
                ss += __shfl_xor(ss, 16); ss += __shfl_xor(ss, 32);
                if (fq == 0) __hip_atomic_fetch_add(SS1 + row, ss, __ATOMIC_RELAXED, __HIP_MEMORY_SCOPE_AGENT); }
    }
};
struct EpiAct {
    static constexpr bool PERM = true, AFTER_DRAIN = false;
    bf16* ACT; const float* SS1;
    __device__ __forceinline__ void operator()(const pg8::f32x4 (&acc)[2][2][4][2], const Unit& u, int wr, int wc, int fr, int fq) const {
        const int row0 = u.pm * BM + wr * 64 + fr, col0 = u.pn * HALF + wc * 32 + 8 * fq;
#pragma unroll
        for (int ai = 0; ai < 2; ++ai)
#pragma unroll
            for (int m = 0; m < 4; ++m) { const int row = row0 + ai * HALF + m * 16; const float rs = rstd_of(SS1[row]);
                const pg8::f32x4 g0 = acc[ai][0][m][0] * rs, g1 = acc[ai][0][m][1] * rs, u0 = acc[ai][1][m][0] * rs, u1 = acc[ai][1][m][1] * rs;
                u32x4 w; w.x = cvt_pk_bf16(siluf_(g0[0]) * u0[0], siluf_(g0[1]) * u0[1]); w.y = cvt_pk_bf16(siluf_(g0[2]) * u0[2], siluf_(g0[3]) * u0[3]);
                w.z = cvt_pk_bf16(siluf_(g1[0]) * u1[0], siluf_(g1[1]) * u1[1]); w.w = cvt_pk_bf16(siluf_(g1[2]) * u1[2], siluf_(g1[3]) * u1[3]);
                *(u32x4*)(ACT + (size_t)row * DFF + col0) = w; }
    }
};
struct EpiDown {
    static constexpr bool PERM = true, AFTER_DRAIN = false;
    const bf16* X1; const float* gain; float* SS2; unsigned* cnt; float* YO;
    __device__ __forceinline__ void operator()(pg8::f32x4 (&acc)[2][2][4][2], const Unit& u, int wr, int wc, int fr, int fq) const {
        const int row0 = u.pm * BM + wr * 64 + fr, col0 = u.pn * BM + wc * 32 + 8 * fq;
#pragma unroll
        for (int ai = 0; ai < 2; ++ai)
#pragma unroll
            for (int m = 0; m < 4; ++m) { const int row = row0 + ai * HALF + m * 16; const size_t off = (size_t)row * DM + col0; float ss = 0.f;
#pragma unroll
                for (int bj = 0; bj < 2; ++bj) { const u32x4 xb = *(const u32x4*)(X1 + off + bj * HALF);
                    const pg8::f32x4 x0 = (pg8::f32x4){bflo(xb.x), bfhi(xb.x), bflo(xb.y), bfhi(xb.y)} + acc[ai][bj][m][0], x1 = (pg8::f32x4){bflo(xb.z), bfhi(xb.z), bflo(xb.w), bfhi(xb.w)} + acc[ai][bj][m][1];
                    acc[ai][bj][m][0] = x0; acc[ai][bj][m][1] = x1;
                    ss += (x0[0] * x0[0] + x0[1] * x0[1]) + (x0[2] * x0[2] + x0[3] * x0[3]) + (x1[0] * x1[0] + x1[1] * x1[1]) + (x1[2] * x1[2] + x1[3] * x1[3]); }
                ss += __shfl_xor(ss, 16); ss += __shfl_xor(ss, 32);
                if (fq == 0) __hip_atomic_fetch_add(SS2 + row, ss, __ATOMIC_RELAXED, __HIP_MEMORY_SCOPE_AGENT); }
        asm volatile("s_waitcnt vmcnt(0)" ::: "memory");
        unsigned* c = cnt + 64 * u.pm;
        if (threadIdx.x % 64 == 0) __hip_atomic_fetch_add(c, 1u, __ATOMIC_RELAXED, __HIP_MEMORY_SCOPE_AGENT);
        wait_count(c, 32u);
        pg8::f32x4 gn[2][2];
#pragma unroll
        for (int bj = 0; bj < 2; ++bj)
#pragma unroll
            for (int n = 0; n < 2; ++n) gn[bj][n] = *(const pg8::f32x4*)(gain + col0 + bj * HALF + 4 * n);
        float rs[2][4];
#pragma unroll
        for (int ai = 0; ai < 2; ++ai)
#pragma unroll
            for (int m = 0; m < 4; ++m) { float s = 0.f; if (fq == 0) s = atomic_read_f32(SS2 + row0 + ai * HALF + m * 16); rs[ai][m] = rstd_of(__shfl(s, fr)); }
#pragma unroll
        for (int ai = 0; ai < 2; ++ai)
#pragma unroll
            for (int m = 0; m < 4; ++m) { const size_t off = (size_t)(row0 + ai * HALF + m * 16) * DM + col0;
#pragma unroll
                for (int bj = 0; bj < 2; ++bj) { *(pg8::f32x4*)(YO + off + bj * HALF) = acc[ai][bj][m][0] * rs[ai][m] * gn[bj][0]; *(pg8::f32x4*)(YO + off + bj * HALF + 4) = acc[ai][bj][m][1] * rs[ai][m] * gn[bj][1]; } }
    }
};

typedef float f32x16 __attribute__((ext_vector_type(16)));
typedef short s16x8 __attribute__((ext_vector_type(8)));
constexpr size_t WS_U5 = WS_OH, WS_T5 = 231 * MiB;
constexpr size_t T5_STRIDE = 73728, T5_VG = 32768, T5_KC = 65536;
constexpr int S5_LD = 136;
__device__ __forceinline__ void s5_tables_item(Frame& F, int item) {
    const int tid = F.tid, g = item >> 3, part = item & 7;
    LAS float* Pre = (LAS float*)F.lds; LAS float* Pim = Pre + 9 * 64; LAS float* Ff = Pim + 9 * 64;
    LAS float* Cre = Ff + 128, * Cim = Cre + 1024, * Bre = Cim + 1024, * Bim = Bre + 1024;
    if (tid < 64) { const int n = tid;
        const float a_re = F.in[8][g * S5N + n], a_im = F.in[9][g * S5N + n], dt = expf(F.in[10][g]);
        const float mag = expf(a_re * dt), ab_re = mag * cosf(a_im * dt), ab_im = mag * sinf(a_im * dt);
        const float den = a_re * a_re + a_im * a_im, nr = ab_re - 1.0f, ni = ab_im;
        Ff[n] = (nr * a_re + ni * a_im) / den; Ff[64 + n] = (ni * a_re - nr * a_im) / den;
        float pr = 1.f, pi = 0.f;
#pragma unroll
        for (int j = 0; j < 9; ++j) { Pre[j * 64 + n] = pr; Pim[j * 64 + n] = pi; const float t = pr * ab_re - pi * ab_im; pi = pr * ab_im + pi * ab_re; pr = t; }
    }
    __syncthreads();
#pragma unroll
    for (int i = 0; i < 2; ++i) { const int idx = tid + 512 * i;
        { const int c = idx >> 6, n = idx & 63; Cre[c * 64 + n] = F.in[13][(size_t)(g * 16 + c) * S5N + n]; Cim[c * 64 + n] = F.in[14][(size_t)(g * 16 + c) * S5N + n]; }
        { const int n = idx >> 4, c = idx & 15; const float br = F.in[11][(size_t)(g * S5N + n) * 16 + c], bi = F.in[12][(size_t)(g * S5N + n) * 16 + c], fr = Ff[n], fi = Ff[64 + n];
          Bre[n * 16 + c] = fr * br - fi * bi; Bim[n * 16 + c] = fr * bi + fi * br; } }
    __syncthreads();
    bf16* WG = (bf16*)(F.ws + WS_T5 + (size_t)g * T5_STRIDE); bf16* VG = (bf16*)(F.ws + WS_T5 + (size_t)g * T5_STRIDE + T5_VG); bf16* KC = (bf16*)(F.ws + WS_T5 + (size_t)g * T5_STRIDE + T5_KC);
    if (tid < 256) { const int j = part, c = tid >> 4, cp = tid & 15; float acc = 0.f;
#pragma unroll 4
        for (int n = 0; n < 64; ++n) { const float cr = Cre[c * 64 + n], ci = Cim[c * 64 + n], pr = Pre[j * 64 + n], pi = Pim[j * 64 + n];
            const float xr = cr * pr - ci * pi, xi = cr * pi + ci * pr; acc += xr * Bre[n * 16 + cp] - xi * Bim[n * 16 + cp]; }
        KC[j * 256 + tid] = (bf16)f2bf(acc);
    } else if (part == 0) KC[2048 + tid - 256] = 0;
#pragma unroll
    for (int i = 0; i < 4; ++i) { const int idx = tid + 512 * i, np = 16 * part + (idx >> 7), k = idx & 127, s = k >> 4, cp = k & 15, n = np & 63;
        const float pr = Pre[(7 - s) * 64 + n], pi = Pim[(7 - s) * 64 + n], br = Bre[n * 16 + cp], bi = Bim[n * 16 + cp];
        WG[np * 128 + k] = (bf16)f2bf(np < 64 ? pr * br - pi * bi : pr * bi + pi * br); }
#pragma unroll
    for (int i = 0; i < 4; ++i) { const int idx = tid + 512 * i, col = 16 * part + (idx >> 7), np = idx & 127, t = col >> 4, c = col & 15, n = np & 63;
        const float pr = Pre[(t + 1) * 64 + n], pi = Pim[(t + 1) * 64 + n], cr = Cre[c * 64 + n], ci = Cim[c * 64 + n];
        VG[col * 128 + np] = (bf16)f2bf(np < 64 ? cr * pr - ci * pi : -(cr * pi + ci * pr)); }
    __syncthreads();
}
constexpr int L5_WG = 0, L5_VG = 34816, L5_KC = 69632, L5_U = 74240, L5_HS = 91648, L5_HL = 109056, L5_L8 = 141824;
__device__ __forceinline__ void s5_item(Frame& F, int item) {
    const int tid = F.tid, lane = F.lane, wave = F.wave;
    const int g = item & 31, b8 = item >> 5;
    LAS bf16* WgT = (LAS bf16*)(F.lds + L5_WG); LAS bf16* VgT = (LAS bf16*)(F.lds + L5_VG); LAS bf16* Kc = (LAS bf16*)(F.lds + L5_KC);
    LAS bf16* Us = (LAS bf16*)(F.lds + L5_U); LAS bf16* HS = (LAS bf16*)(F.lds + L5_HS); LAS float* HL = (LAS float*)(F.lds + L5_HL); LAS float* L8 = (LAS float*)(F.lds + L5_L8);
    LAS bf16* YS = (LAS bf16*)(F.lds + L5_HL);
    const bf16* U5 = (const bf16*)(F.ws + WS_U5) + (size_t)g * MTOK * 16; bf16* GY = (bf16*)(F.ws + WS_GY) + (size_t)g * MTOK * 16;
    { const bf16* WG = (const bf16*)(F.ws + WS_T5 + (size_t)g * T5_STRIDE); const bf16* VG = WG + T5_VG / 2; const bf16* KC = WG + T5_KC / 2;
#pragma unroll
      for (int i = 0; i < 4; ++i) { const int p = tid + 512 * i, r = p >> 4, kg = (p & 15) * 8; *(LAS v4u*)(WgT + r * S5_LD + kg) = *(const v4u*)(WG + r * 128 + kg); *(LAS v4u*)(VgT + r * S5_LD + kg) = *(const v4u*)(VG + r * 128 + kg); }
      if (tid < 288) *(LAS v4u*)(Kc + tid * 8) = *(const v4u*)(KC + tid * 8); }
    float qr[9], qi[9];
    { const float a_re = F.in[8][g * S5N + lane], a_im = F.in[9][g * S5N + lane], dt = expf(F.in[10][g]);
      const float mag = expf(a_re * dt); float p8r = mag * cosf(a_im * dt), p8i = mag * sinf(a_im * dt);
#pragma unroll
      for (int i = 0; i < 3; ++i) { const float t = p8r * p8r - p8i * p8i; p8i = 2.0f * p8r * p8i; p8r = t; }
      qr[0] = 1.f; qi[0] = 0.f;
#pragma unroll
      for (int i = 1; i < 9; ++i) { qr[i] = qr[i - 1] * p8r - qi[i - 1] * p8i; qi[i] = qr[i - 1] * p8i + qi[i - 1] * p8r; } }
    const float dl = F.in[15][g * 16 + (lane & 15)];
    const int rb = wave >> 2, cb = wave & 3, r32 = lane & 31, hh = lane >> 5;
    float h_re = 0.f, h_im = 0.f;
    float sre[2], sim[2];
#pragma unroll
    for (int i = 0; i < 2; ++i) { const size_t idx = (size_t)((16 * b8 + 2 * wave + i) * S5G + g) * S5N + lane; sre[i] = F.in[2][idx]; sim[i] = F.in[3][idx]; }
    v4u un0, un1;
    { const v4u* src = (const v4u*)(U5 + (size_t)(b8 * PB_T) * 16); un0 = src[tid]; un1 = src[tid + 512]; }
    for (int seg = 0; seg < 5; ++seg) {
        const bool samp = (seg == 4);
        const int tok0 = samp ? MP + 128 * b8 : b8 * PB_T + seg * 512;
        { const int p0 = tid, p1 = tid + 512;
          *(LAS v4u*)(Us + (p0 >> 4) * S5_LD + ((p0 >> 1) & 7) * 16 + (p0 & 1) * 8) = un0; *(LAS v4u*)(Us + (p1 >> 4) * S5_LD + ((p1 >> 1) & 7) * 16 + (p1 & 1) * 8) = un1;
          if (seg < 3) { const v4u* src = (const v4u*)(U5 + (size_t)(b8 * PB_T + (seg + 1) * 512) * 16); un0 = src[tid]; un1 = src[tid + 512]; }
          else if (seg == 3) { const v4u* src = (const v4u*)(U5 + (size_t)(MP + 128 * b8) * 16); if (tid < 256) un0 = src[tid]; } }
        __syncthreads();
        { f32x16 acc = {};
#pragma unroll
          for (int s = 0; s < 8; ++s) { const s16x8 a = *(const LAS s16x8*)(Us + (32 * rb + r32) * S5_LD + s * 16 + 8 * hh); const s16x8 b = *(const LAS s16x8*)(WgT + (32 * cb + r32) * S5_LD + s * 16 + 8 * hh);
              acc = __builtin_amdgcn_mfma_f32_32x32x16_bf16(a, b, acc, 0, 0, 0); }
#pragma unroll
          for (int r = 0; r < 16; ++r) HL[(32 * rb + (r & 3) + 8 * (r >> 2) + 4 * hh) * 128 + 32 * cb + r32] = acc[r]; }
        __syncthreads();
        if (!samp) {
            float xr[8], xi[8], lr[9], li[9];
#pragma unroll
            for (int i = 0; i < 8; ++i) { xr[i] = HL[(8 * wave + i) * 128 + lane]; xi[i] = HL[(8 * wave + i) * 128 + 64 + lane]; }
            lr[0] = 0.f; li[0] = 0.f;
#pragma unroll
            for (int i = 0; i < 8; ++i) { lr[i + 1] = qr[1] * lr[i] - qi[1] * li[i] + xr[i]; li[i + 1] = qr[1] * li[i] + qi[1] * lr[i] + xi[i]; }
            L8[wave * 128 + lane] = lr[8]; L8[wave * 128 + 64 + lane] = li[8];
            __syncthreads();
            float cr = h_re, ci = h_im, mr = h_re, mi = h_im;
#pragma unroll
            for (int w = 0; w < 8; ++w) { const float tr = L8[w * 128 + lane], ti = L8[w * 128 + 64 + lane];
                const float nr = qr[8] * cr - qi[8] * ci + tr, ni = qr[8] * ci + qi[8] * cr + ti; cr = nr; ci = ni; if (w + 1 == wave) { mr = cr; mi = ci; } }
            h_re = cr; h_im = ci;
#pragma unroll
            for (int i = 0; i < 8; ++i) { const float sr = lr[i] + qr[i] * mr - qi[i] * mi, si = li[i] + qr[i] * mi + qi[i] * mr;
                HS[(8 * wave + i) * S5_LD + lane] = (bf16)f2bf(sr); HS[(8 * wave + i) * S5_LD + 64 + lane] = (bf16)f2bf(si); }
            if (seg == 3 && wave == 0) { F.out[O_PRE + (size_t)(b8 * S5G + g) * S5N + lane] = h_re; F.out[O_PIM + (size_t)(b8 * S5G + g) * S5N + lane] = h_im; }
        } else {
#pragma unroll
            for (int i = 0; i < 2; ++i) { const int r = 2 * wave + i; const size_t idx = (size_t)((16 * b8 + r) * S5G + g) * S5N + lane;
                HS[r * S5_LD + lane] = (bf16)f2bf(sre[i]); HS[r * S5_LD + 64 + lane] = (bf16)f2bf(sim[i]);
                F.out[O_SRE + idx] = qr[1] * sre[i] - qi[1] * sim[i] + HL[r * 128 + lane]; F.out[O_SIM + idx] = qr[1] * sim[i] + qi[1] * sre[i] + HL[r * 128 + 64 + lane]; }
        }
        __syncthreads();
        if (!(samp && rb == 1)) { f32x16 acc = {};
            const int tl = 2 * cb + ((lane >> 4) & 1), c = lane & 15;
#pragma unroll
            for (int s = 0; s < 8; ++s) if (s <= 2 * cb + 1) { const int j = tl - s, jj = j < 0 ? 8 : j;
                const s16x8 a = *(const LAS s16x8*)(Us + (32 * rb + r32) * S5_LD + s * 16 + 8 * hh); const s16x8 b = *(const LAS s16x8*)(Kc + (jj * 16 + c) * 16 + 8 * hh);
                acc = __builtin_amdgcn_mfma_f32_32x32x16_bf16(a, b, acc, 0, 0, 0); }
#pragma unroll
            for (int kb = 0; kb < 8; ++kb) { const s16x8 a = *(const LAS s16x8*)(HS + (32 * rb + r32) * S5_LD + kb * 16 + 8 * hh); const s16x8 b = *(const LAS s16x8*)(VgT + (32 * cb + r32) * S5_LD + kb * 16 + 8 * hh);
                acc = __builtin_amdgcn_mfma_f32_32x32x16_bf16(a, b, acc, 0, 0, 0); }
#pragma unroll
            for (int r = 0; r < 16; ++r) { const int row = 32 * rb + (r & 3) + 8 * (r >> 2) + 4 * hh;
                const float u = bf2f(Us[row * S5_LD + tl * 16 + c]); YS[row * 128 + 32 * cb + r32] = (bf16)f2bf(gelu_tanh(acc[r] + dl * u)); }
        }
        __syncthreads();
        { v4u* dst = (v4u*)(GY + (size_t)tok0 * 16);
          if (!samp) { dst[tid] = *(const LAS v4u*)(YS + tid * 8); dst[tid + 512] = *(const LAS v4u*)(YS + (tid + 512) * 8); }
          else if (tid < 256) dst[tid] = *(const LAS v4u*)(YS + tid * 8); }
    }
    __syncthreads();
}
typedef float f32x4v __attribute__((ext_vector_type(4)));
constexpr int HG_LDQ = 136, HG_LDT = 72;
constexpr size_t WS_DSC = WS_XN;
constexpr size_t WS_DEC = WS_CTL + 1 * MiB;
struct HgRaw { float fz[16]; unsigned short q[16]; v4u v0, v1; };
template <bool NEEDQ> __device__ __forceinline__ void hg_load_raw(HgRaw& R, const bf16* PB, const float* FZ, int item, int tid) {
    const int bh = item >> 5, chunk = item & 31, b = bh >> 2, h = bh & 3, tok0 = b * PB_T + chunk * 64, ch = tid & 127, tq = tid >> 7, col = h * HD + ch;
#pragma unroll
    for (int i = 0; i < 16; ++i) { const size_t tok = (size_t)(tok0 + 16 * tq + i); R.fz[i] = FZ[tok * 512 + col]; if (NEEDQ) R.q[i] = PB[tok * PBW + 512 + col]; }
    { const int p = tid, vg = p >> 6, tk = p & 63; R.v0 = *(const v4u*)(PB + (size_t)(tok0 + tk) * PBW + 1024 + h * HD + vg * 8); }
    { const int p = tid + 512, vg = p >> 6, tk = p & 63; R.v1 = *(const v4u*)(PB + (size_t)(tok0 + tk) * PBW + 1024 + h * HD + vg * 8); }
}
#define HG_GATES_R(R) \
    float gl[16], kk[16]; float run = 0.f; \
    _Pragma("unroll") for (int i = 0; i < 16; ++i) { const float sg = __builtin_amdgcn_rcpf(1.0f + __builtin_amdgcn_exp2f(-1.4426950408889634f * R.fz[i])), f = lb + (1.0f - lb) * sg; kk[i] = 1.0f - f; run += __log2f(f); gl[i] = run; } \
    TOT[tq * 128 + ch] = run;
#define HG_VT_STORE(R) \
    { const int vg = tid >> 6, tk = tid & 63; LAS bf16* d = Vt + (vg * 8) * HG_LDT + tk; const v4u w = R.v0; d[0] = (bf16)(w.x & 0xffffu); d[HG_LDT] = (bf16)(w.x >> 16); d[2 * HG_LDT] = (bf16)(w.y & 0xffffu); d[3 * HG_LDT] = (bf16)(w.y >> 16); \
        d[4 * HG_LDT] = (bf16)(w.z & 0xffffu); d[5 * HG_LDT] = (bf16)(w.z >> 16); d[6 * HG_LDT] = (bf16)(w.w & 0xffffu); d[7 * HG_LDT] = (bf16)(w.w >> 16); } \
    { const int vg = (tid + 512) >> 6, tk = tid & 63; LAS bf16* d = Vt + (vg * 8) * HG_LDT + tk; const v4u w = R.v1; d[0] = (bf16)(w.x & 0xffffu); d[HG_LDT] = (bf16)(w.x >> 16); d[2 * HG_LDT] = (bf16)(w.y & 0xffffu); d[3 * HG_LDT] = (bf16)(w.y >> 16); \
        d[4 * HG_LDT] = (bf16)(w.z & 0xffffu); d[5 * HG_LDT] = (bf16)(w.z >> 16); d[6 * HG_LDT] = (bf16)(w.w & 0xffffu); d[7 * HG_LDT] = (bf16)(w.w >> 16); }

constexpr int LA_QS = 0, LA_KS = 17408, LA_KT = 34816, LA_VT = 53248, LA_AT = 71680, LA_TOT = 80896;
constexpr size_t OQ_QH = 0, OQ_OI = 4194304;
__device__ __forceinline__ void hgA_loop(Frame& F, int j0, int j1) {
    const int tid = F.tid, lane = F.lane, wave = F.wave;
    LAS bf16* Qs = (LAS bf16*)(F.lds + LA_QS); LAS bf16* Ks = (LAS bf16*)(F.lds + LA_KS); LAS bf16* Kt = (LAS bf16*)(F.lds + LA_KT); LAS bf16* Vt = (LAS bf16*)(F.lds + LA_VT);
    LAS bf16* At = (LAS bf16*)(F.lds + LA_AT); LAS float* TOT = (LAS float*)(F.lds + LA_TOT);
    const bf16* PB = (const bf16*)(F.ws + WS_PB); const float* FZ = (const float*)(F.ws + WS_FZ);
    const int ch = tid & 127, tq = tid >> 7, r32 = lane & 31, hh = lane >> 5;
    const int iend = (F.bid + j1 * F.G < 1024) ? F.bid + j1 * F.G : 1024;
    int item = F.bid + j0 * F.G; if (item >= iend) return;
    HgRaw R; hg_load_raw<true>(R, PB, FZ, item, tid);
    for (; item < iend; item += F.G) {
        const int bh = item >> 5, h = bh & 3, col = h * HD + ch;
        bf16* DSC = (bf16*)(F.ws + WS_DSC) + (size_t)item * HD * HD; float* DEC = (float*)(F.ws + WS_DEC) + (size_t)item * HD;
        bf16* QH = (bf16*)(F.out + O_Y + OQ_QH) + (size_t)item * 64 * HD; bf16* OI = (bf16*)(F.out + O_Y + OQ_OI) + (size_t)item * 8192;
        const float lb = 1.0f / (1.0f + __expf(F.in[5][512 + col] - F.in[5][col]));
        HG_GATES_R(R)
        float qq[16];
#pragma unroll
        for (int i = 0; i < 16; ++i) qq[i] = bf2f(R.q[i]);
        HG_VT_STORE(R)
        if (item + F.G < iend) hg_load_raw<true>(R, PB, FZ, item + F.G, tid);
        __syncthreads();
        { const float t0 = TOT[ch], t1 = TOT[128 + ch], t2 = TOT[256 + ch], t3 = TOT[384 + ch];
          const float gref = t0 + t1, glast = gref + (t2 + t3), off = (tq == 0 ? 0.f : tq == 1 ? t0 : tq == 2 ? gref : gref + t2);
          const float cS = __builtin_amdgcn_exp2f(gref), cK = __builtin_amdgcn_exp2f(glast - gref);
          unsigned kp[8];
#pragma unroll
          for (int i = 0; i < 16; ++i) { const float e1 = __builtin_amdgcn_exp2f(off + gl[i] - gref), e2 = __builtin_amdgcn_rcpf(e1), qs = qq[i] * e1, ks = kk[i] * e2;
              Qs[(16 * tq + i) * HG_LDQ + ch] = (bf16)f2bf(qs); Ks[(16 * tq + i) * HG_LDQ + ch] = (bf16)f2bf(ks);
              QH[(size_t)(16 * tq + i) * HD + ch] = (bf16)f2bf(qs * cS);
              const unsigned kb = f2bf(ks * cK); if (i & 1) kp[i >> 1] |= kb << 16; else kp[i >> 1] = kb; }
          LAS v4u* kd = (LAS v4u*)(Kt + ch * HG_LDT + 16 * tq); v4u a, c2; a.x = kp[0]; a.y = kp[1]; a.z = kp[2]; a.w = kp[3]; c2.x = kp[4]; c2.y = kp[5]; c2.z = kp[6]; c2.w = kp[7]; kd[0] = a; kd[1] = c2;
          if (tq == 0) DEC[ch] = cS * cK; }
        __syncthreads();
        if (wave < 4) { const int tb = wave >> 1, sb = wave & 1; f32x16 acc = {};
            if (sb <= tb) {
#pragma unroll
                for (int ks = 0; ks < 8; ++ks) { const s16x8 a = *(const LAS s16x8*)(Qs + (32 * tb + r32) * HG_LDQ + 16 * ks + 8 * hh); const s16x8 bb = *(const LAS s16x8*)(Ks + (32 * sb + r32) * HG_LDQ + 16 * ks + 8 * hh);
                    acc = __builtin_amdgcn_mfma_f32_32x32x16_bf16(a, bb, acc, 0, 0, 0); } }
            const int s = 32 * sb + r32;
#pragma unroll
            for (int r = 0; r < 16; ++r) { const int t = 32 * tb + (r & 3) + 8 * (r >> 2) + 4 * hh; At[t * HG_LDT + s] = (s <= t) ? (bf16)f2bf(acc[r]) : (bf16)0; } }
        { const int kb = wave >> 1;
#pragma unroll
          for (int vbi = 0; vbi < 2; ++vbi) { const int vb = 2 * (wave & 1) + vbi; f32x16 acc = {};
#pragma unroll
              for (int ks = 0; ks < 4; ++ks) { const s16x8 a = *(const LAS s16x8*)(Kt + (32 * kb + r32) * HG_LDT + 16 * ks + 8 * hh); const s16x8 bb = *(const LAS s16x8*)(Vt + (32 * vb + r32) * HG_LDT + 16 * ks + 8 * hh);
                  acc = __builtin_amdgcn_mfma_f32_32x32x16_bf16(a, bb, acc, 0, 0, 0); }
              bf16* dst = DSC + (size_t)(32 * vb + r32) * HD + 32 * kb + 4 * hh;
#pragma unroll
              for (int q = 0; q < 4; ++q) { v2u w; w.x = pk2(acc[4 * q], acc[4 * q + 1]); w.y = pk2(acc[4 * q + 2], acc[4 * q + 3]); *(v2u*)(dst + 8 * q) = w; } } }
        __syncthreads();
        { const int tb = wave >> 2, vb = wave & 3, t = 32 * tb + r32; f32x16 acc = {};
#pragma unroll
          for (int ks = 0; ks < 4; ++ks) if (ks < 2 * tb + 2) { const s16x8 a = *(const LAS s16x8*)(Vt + (32 * vb + r32) * HG_LDT + 16 * ks + 8 * hh); const s16x8 bb = *(const LAS s16x8*)(At + t * HG_LDT + 16 * ks + 8 * hh);
              acc = __builtin_amdgcn_mfma_f32_32x32x16_bf16(a, bb, acc, 0, 0, 0); }
          v4u w0, w1; w0.x = pk2(acc[0], acc[1]); w0.y = pk2(acc[2], acc[3]); w0.z = pk2(acc[4], acc[5]); w0.w = pk2(acc[6], acc[7]); w1.x = pk2(acc[8], acc[9]); w1.y = pk2(acc[10], acc[11]); w1.z = pk2(acc[12], acc[13]); w1.w = pk2(acc[14], acc[15]);
          v4u* d = (v4u*)(OI + (size_t)(wave * 64 + lane) * 16); d[0] = w0; d[1] = w1; }
        __syncthreads();
    }
}
__device__ __forceinline__ void hg_scan(Frame& F, bf16* DSO, int sb, int nsb) {
    bf16* DSC = (bf16*)(F.ws + WS_DSC); const float* DEC = (const float*)(F.ws + WS_DEC);
    LAS float* DL = (LAS float*)F.lds;
    for (int T0 = sb * 512; T0 < 32 * 4096; T0 += nsb * 512) {
        const int T = T0 + F.tid, bh = T0 >> 12, e = T & 4095, v = e >> 5, k4 = (e & 31) * 4;
        v2u x[32];
#pragma unroll
        for (int c = 0; c < 32; ++c) x[c] = *(const v2u*)(DSC + ((size_t)(bh * 32 + c) * HD + v) * HD + k4);
#pragma unroll
        for (int i = 0; i < 2; ++i) { const int p = F.tid + 512 * i; *(LAS f32x4*)(DL + p * 4) = *(const f32x4*)(DEC + (size_t)bh * 32 * HD + p * 4); }
        __syncthreads();
        f32x4 S = {0.f, 0.f, 0.f, 0.f};
#pragma unroll
        for (int c = 0; c < 32; ++c) { const f32x4 d = *(const LAS f32x4*)(DL + c * HD + k4);
            v2u o; o.x = pk2(S.x, S.y); o.y = pk2(S.z, S.w); *(v2u*)(DSO + ((size_t)(bh * 32 + c) * HD + v) * HD + k4) = o;
            S.x = d.x * S.x + bflo(x[c].x); S.y = d.y * S.y + bfhi(x[c].x); S.z = d.z * S.z + bflo(x[c].y); S.w = d.w * S.w + bfhi(x[c].y); }
        float* o = F.out + O_PHG + (size_t)bh * HD * HD + (size_t)k4 * HD + v;
        o[0] = S.x; o[HD] = S.y; o[2 * HD] = S.z; o[3 * HD] = S.w;
        __syncthreads();
    }
}
constexpr int LC_SC = 0, LC_QH = 34816, LC_SS = 52224, LC_SLOT = 53248;
__device__ __forceinline__ void hgC_loop(Frame& F, unsigned* ctr) {
    const int tid = F.tid, lane = F.lane, wave = F.wave;
    LAS bf16* SC = (LAS bf16*)(F.lds + LC_SC); LAS bf16* Qh = (LAS bf16*)(F.lds + LC_QH); LAS float* SS = (LAS float*)(F.lds + LC_SS);
    volatile LAS int* slot = (volatile LAS int*)(F.lds + LC_SLOT);
    const bf16* PB = (const bf16*)(F.ws + WS_PB); bf16* MIX = (bf16*)(F.ws + WS_MIX);
    const int r32 = lane & 31, hh = lane >> 5, tb = wave >> 2, vb = wave & 3, t = 32 * tb + r32;
    if (tid == 0) { slot[0] = (int)__hip_atomic_fetch_add(ctr, 1u, __ATOMIC_RELAXED, __HIP_MEMORY_SCOPE_AGENT); slot[1] = (int)__hip_atomic_fetch_add(ctr, 1u, __ATOMIC_RELAXED, __HIP_MEMORY_SCOPE_AGENT); }
    __syncthreads();
    int item = slot[0], nxt = slot[1], par = 0;
    if (item >= 1024) return;
    v4u sc[4], qh[2], oi[2]; v2u og[4];
#define HGC_FETCH(IT) do { const int it_ = (IT); const bf16* DSC = (const bf16*)(F.ws + WS_DSC) + (size_t)it_ * HD * HD; const bf16* QH = (const bf16*)(F.out + O_Y + OQ_QH) + (size_t)it_ * 64 * HD; \
        const bf16* OI = (const bf16*)(F.out + O_Y + OQ_OI) + (size_t)it_ * 8192; const int bh_ = it_ >> 5, tok0_ = (bh_ >> 2) * PB_T + (it_ & 31) * 64, h_ = bh_ & 3; \
        _Pragma("unroll") for (int i = 0; i < 4; ++i) { const int p = tid + 512 * i; sc[i] = *(const v4u*)(DSC + (size_t)(p >> 4) * HD + (p & 15) * 8); } \
        _Pragma("unroll") for (int i = 0; i < 2; ++i) { const int p = tid + 512 * i; qh[i] = *(const v4u*)(QH + (size_t)(p >> 4) * HD + (p & 15) * 8); } \
        oi[0] = *(const v4u*)(OI + (size_t)(wave * 64 + lane) * 16); oi[1] = *(const v4u*)(OI + (size_t)(wave * 64 + lane) * 16 + 8); \
        _Pragma("unroll") for (int q = 0; q < 4; ++q) og[q] = *(const v2u*)(PB + (size_t)(tok0_ + t) * PBW + 1536 + h_ * HD + 32 * vb + 8 * q + 4 * hh); } while (0)
    HGC_FETCH(item);
    for (;;) {
        const int bh = item >> 5, chunk = item & 31, b = bh >> 2, h = bh & 3, tok0 = b * PB_T + chunk * 64;
#pragma unroll
        for (int i = 0; i < 4; ++i) { const int p = tid + 512 * i; *(LAS v4u*)(SC + (p >> 4) * HG_LDQ + (p & 15) * 8) = sc[i]; }
#pragma unroll
        for (int i = 0; i < 2; ++i) { const int p = tid + 512 * i; *(LAS v4u*)(Qh + (p >> 4) * HG_LDQ + (p & 15) * 8) = qh[i]; }
        f32x16 acc;
        acc[0] = bflo(oi[0].x); acc[1] = bfhi(oi[0].x); acc[2] = bflo(oi[0].y); acc[3] = bfhi(oi[0].y); acc[4] = bflo(oi[0].z); acc[5] = bfhi(oi[0].z); acc[6] = bflo(oi[0].w); acc[7] = bfhi(oi[0].w);
        acc[8] = bflo(oi[1].x); acc[9] = bfhi(oi[1].x); acc[10] = bflo(oi[1].y); acc[11] = bfhi(oi[1].y); acc[12] = bflo(oi[1].z); acc[13] = bfhi(oi[1].z); acc[14] = bflo(oi[1].w); acc[15] = bfhi(oi[1].w);
        v2u ogc[4];
#pragma unroll
        for (int q = 0; q < 4; ++q) ogc[q] = og[q];
        if (tid == 0) slot[par] = (int)__hip_atomic_fetch_add(ctr, 1u, __ATOMIC_RELAXED, __HIP_MEMORY_SCOPE_AGENT);
        if (nxt < 1024) HGC_FETCH(nxt);
        __syncthreads();
        const int nn = slot[par];
#pragma unroll
        for (int ks = 0; ks < 8; ++ks) { const s16x8 a = *(const LAS s16x8*)(SC + (32 * vb + r32) * HG_LDQ + 16 * ks + 8 * hh); const s16x8 bb = *(const LAS s16x8*)(Qh + t * HG_LDQ + 16 * ks + 8 * hh);
            acc = __builtin_amdgcn_mfma_f32_32x32x16_bf16(a, bb, acc, 0, 0, 0); }
        { float ss = 0.f;
#pragma unroll
          for (int r = 0; r < 16; ++r) ss += acc[r] * acc[r];
          ss += __shfl_xor(ss, 32);
          if (hh == 0) SS[t * 4 + vb] = ss; }
        __syncthreads();
        { const f32x4 s4 = *(const LAS f32x4*)(SS + t * 4); const float rstd = __builtin_amdgcn_rsqf(((s4.x + s4.y) + (s4.z + s4.w)) * (1.0f / HD) + EPS);
#pragma unroll
          for (int q = 0; q < 4; ++q) { const int v0 = 32 * vb + 8 * q + 4 * hh; const f32x4 gn = *(const GAS f32x4*)(F.in[17] + v0);
              v2u w; w.x = pk2(acc[4 * q] * rstd * gn.x * siluf_(bflo(ogc[q].x)), acc[4 * q + 1] * rstd * gn.y * siluf_(bfhi(ogc[q].x)));
              w.y = pk2(acc[4 * q + 2] * rstd * gn.z * siluf_(bflo(ogc[q].y)), acc[4 * q + 3] * rstd * gn.w * siluf_(bfhi(ogc[q].y)));
              *(v2u*)(MIX + (size_t)(tok0 + t) * DM + 512 + h * HD + v0) = w; } }
        __syncthreads();
        if (nxt >= 1024) break;
        item = nxt; nxt = nn; par ^= 1;
    }
#undef HGC_FETCH
}
constexpr int LX_Q = 0, LX_K2 = 4096, LX_QT = 8192, LX_K3T = 12288, LX_V = 16384, LX_DEC = 20480, LX_ATT = 20992, LX_OT = 21248, LX_OP = 25344;
__device__ __forceinline__ void hgrn_sample_loop(Frame& F) {
    const int tid = F.tid;
    LAS float* Qs = (LAS float*)(F.lds + LX_Q); LAS float* K2 = (LAS float*)(F.lds + LX_K2); LAS float* QT = (LAS float*)(F.lds + LX_QT); LAS float* K3T = (LAS float*)(F.lds + LX_K3T); LAS float* Vs = (LAS float*)(F.lds + LX_V);
    LAS float* DEC = (LAS float*)(F.lds + LX_DEC); LAS float* ATT = (LAS float*)(F.lds + LX_ATT); LAS float* OP = (LAS float*)(F.lds + LX_OP); LAS float* OT = (LAS float*)(F.lds + LX_OT);
    const bf16* PB = (const bf16*)(F.ws + WS_PB); const float* FZ = (const float*)(F.ws + WS_FZ); bf16* MIX = (bf16*)(F.ws + WS_MIX);
    const int v4 = (tid & 31) * 4, kg = tid >> 5;
    int idx = F.bid; if (idx >= SB_B * HH) return;
    f32x4 s0[8];
#pragma unroll
    for (int j = 0; j < 8; ++j) s0[j] = *(const GAS f32x4*)(F.in[4] + (size_t)idx * HD * HD + (size_t)(8 * kg + j) * HD + v4);
    for (; idx < SB_B * HH; idx += F.G) {
        const int b = idx >> 2, h = idx & 3, tok0 = MP + b * SB_T;
        float* Sout = F.out + O_SHG + (size_t)idx * HD * HD;
        if (tid < 128) { const int col = h * HD + tid; const float lb = 1.0f / (1.0f + __expf(F.in[5][512 + col] - F.in[5][col]));
            float gl[8], kk[8], qq[8]; float run = 0.f;
#pragma unroll
            for (int t = 0; t < 8; ++t) { const size_t tok = (size_t)(tok0 + t); const float fz = FZ[tok * 512 + col]; qq[t] = bf2f(PB[tok * PBW + 512 + col]);
                const float sg = __builtin_amdgcn_rcpf(1.0f + __builtin_amdgcn_exp2f(-1.4426950408889634f * fz)), f = lb + (1.0f - lb) * sg; kk[t] = 1.0f - f; run += __log2f(f); gl[t] = run; }
            float qt[8], k3[8];
#pragma unroll
            for (int t = 0; t < 8; ++t) { qt[t] = qq[t] * __builtin_amdgcn_exp2f(gl[t]); k3[t] = kk[t] * __builtin_amdgcn_exp2f(run - gl[t]); Qs[t * 128 + tid] = qt[t]; K2[t * 128 + tid] = kk[t] * __builtin_amdgcn_exp2f(-gl[t]); }
            *(LAS f32x4*)(QT + tid * 8) = (f32x4){qt[0], qt[1], qt[2], qt[3]}; *(LAS f32x4*)(QT + tid * 8 + 4) = (f32x4){qt[4], qt[5], qt[6], qt[7]};
            *(LAS f32x4*)(K3T + tid * 8) = (f32x4){k3[0], k3[1], k3[2], k3[3]}; *(LAS f32x4*)(K3T + tid * 8 + 4) = (f32x4){k3[4], k3[5], k3[6], k3[7]};
            DEC[tid] = __builtin_amdgcn_exp2f(run);
        } else if (tid < 256) { const int vv = tid - 128;
#pragma unroll
            for (int t = 0; t < 8; ++t) Vs[t * 128 + vv] = bf2f(PB[(size_t)(tok0 + t) * PBW + 1024 + h * HD + vv]);
        }
        __syncthreads();
        { const int p = tid >> 3, part = tid & 7, t = p >> 3, s = p & 7; float a = 0.f;
#pragma unroll
          for (int j = 0; j < 16; ++j) a += Qs[t * 128 + part + 8 * j] * K2[s * 128 + part + 8 * j];
          a += __shfl_xor(a, 1); a += __shfl_xor(a, 2); a += __shfl_xor(a, 4);
          if (part == 0) ATT[p] = (s <= t) ? a : 0.f; }
        f32x4 vr[8], o[8];
#pragma unroll
        for (int t = 0; t < 8; ++t) { vr[t] = *(const LAS f32x4*)(Vs + t * 128 + v4); o[t] = (f32x4){0.f, 0.f, 0.f, 0.f}; }
#pragma unroll
        for (int j = 0; j < 8; ++j) { const int k = 8 * kg + j; const f32x4 sv = s0[j]; const f32x4 qa = *(const LAS f32x4*)(QT + k * 8), qb = *(const LAS f32x4*)(QT + k * 8 + 4), ka = *(const LAS f32x4*)(K3T + k * 8), kb = *(const LAS f32x4*)(K3T + k * 8 + 4);
            f32x4 sn = sv * DEC[k];
            o[0] += sv * qa.x; o[1] += sv * qa.y; o[2] += sv * qa.z; o[3] += sv * qa.w; o[4] += sv * qb.x; o[5] += sv * qb.y; o[6] += sv * qb.z; o[7] += sv * qb.w;
            sn += vr[0] * ka.x; sn += vr[1] * ka.y; sn += vr[2] * ka.z; sn += vr[3] * ka.w; sn += vr[4] * kb.x; sn += vr[5] * kb.y; sn += vr[6] * kb.z; sn += vr[7] * kb.w;
            *(GAS f32x4*)(Sout + (size_t)k * HD + v4) = sn; }
        if (idx + F.G < SB_B * HH) {
#pragma unroll
            for (int j = 0; j < 8; ++j) s0[j] = *(const GAS f32x4*)(F.in[4] + (size_t)(idx + F.G) * HD * HD + (size_t)(8 * kg + j) * HD + v4); }
#pragma unroll
        for (int t = 0; t < 8; ++t) *(LAS f32x4*)(OP + (kg * 8 + t) * 128 + v4) = o[t];
        __syncthreads();
#pragma unroll
        for (int r = 0; r < 2; ++r) { const int e = tid + 512 * r, t = e >> 7, vv = e & 127; float acc = 0.f;
#pragma unroll
            for (int g2 = 0; g2 < 16; ++g2) acc += OP[(g2 * 8 + t) * 128 + vv];
#pragma unroll
            for (int s = 0; s < 8; ++s) acc += ATT[t * 8 + s] * Vs[s * 128 + vv];
            OT[t * 128 + vv] = acc; }
        __syncthreads();
        { const int t = F.wave, lane = F.lane; const float o0 = OT[t * 128 + 2 * lane], o1 = OT[t * 128 + 2 * lane + 1];
          const float rstd = __builtin_amdgcn_rsqf(wave_sum(o0 * o0 + o1 * o1) * (1.0f / HD) + EPS);
          const unsigned gw2 = *(const unsigned*)(PB + (size_t)(tok0 + t) * PBW + 1536 + h * HD + 2 * lane);
          const float g0 = F.in[17][2 * lane], g1 = F.in[17][2 * lane + 1];
          *(unsigned*)(MIX + (size_t)(tok0 + t) * DM + 512 + h * HD + 2 * lane) = pk2(o0 * rstd * g0 * siluf_(bflo(gw2)), o1 * rstd * g1 * siluf_(bfhi(gw2))); }
        __syncthreads();
    }
}
constexpr int SG_LD = 68;
template <int KSTEPS  >
__device__ __forceinline__ void small_gemm_tile(Frame& F, const bf16* A, int lda, const bf16* Bt, int K, int r0, int c0, float (&v)[8]) {
    const int lane = F.lane, wave = F.wave, fr = lane & 15, fq = lane >> 4;
    f32x4v acc[4][4];
#pragma unroll
    for (int a = 0; a < 4; ++a)
#pragma unroll
        for (int b = 0; b < 4; ++b) acc[a][b] = (f32x4v){0.f, 0.f, 0.f, 0.f};
    const bf16* ap = A + (size_t)(r0 + fr) * lda + wave * (KSTEPS * 32) + 8 * fq;
    const bf16* bp = Bt + (size_t)(c0 + fr) * K + wave * (KSTEPS * 32) + 8 * fq;
#pragma unroll 2
    for (int ks = 0; ks < KSTEPS; ++ks) {
        s16x8 af[4], bf[4];
#pragma unroll
        for (int i = 0; i < 4; ++i) { af[i] = *(const s16x8*)(ap + (size_t)(16 * i) * lda + 32 * ks); bf[i] = *(const s16x8*)(bp + (size_t)(16 * i) * K + 32 * ks); }
#pragma unroll
        for (int a = 0; a < 4; ++a)
#pragma unroll
            for (int b = 0; b < 4; ++b) acc[a][b] = __builtin_amdgcn_mfma_f32_16x16x32_bf16(bf[b], af[a], acc[a][b], 0, 0, 0);
    }
    LAS float* part = (LAS float*)F.lds + wave * (64 * SG_LD);
#pragma unroll
    for (int a = 0; a < 4; ++a)
#pragma unroll
        for (int b = 0; b < 4; ++b) *(LAS f32x4v*)(part + (16 * a + fr) * SG_LD + 16 * b + 4 * fq) = acc[a][b];
    __syncthreads();
    { const int row = F.tid >> 3, cg8 = (F.tid & 7) * 8; const LAS float* p = (const LAS float*)F.lds + row * SG_LD + cg8;
      f32x4v s0 = {0.f, 0.f, 0.f, 0.f}, s1 = {0.f, 0.f, 0.f, 0.f};
#pragma unroll
      for (int w = 0; w < 8; ++w) { s0 += *(const LAS f32x4v*)(p + w * (64 * SG_LD)); s1 += *(const LAS f32x4v*)(p + w * (64 * SG_LD) + 4); }
      v[0] = s0[0]; v[1] = s0[1]; v[2] = s0[2]; v[3] = s0[3]; v[4] = s1[0]; v[5] = s1[1]; v[6] = s1[2]; v[7] = s1[3]; }
    __syncthreads();
}

__device__ __forceinline__ void outproj_sample_tile(Frame& F, int tile, float* SS1) {
    const int rm = tile >> 4, cn = tile & 15; float v[8];
    small_gemm_tile<4>(F, (const bf16*)(F.ws + WS_MIX), DM, (const bf16*)(F.ws + WS_WOUT), DM, MP + 64 * rm, 64 * cn, v);
    const int row = MP + 64 * rm + (F.tid >> 3), col = 64 * cn + 8 * (F.tid & 7); const size_t off = (size_t)row * DM + col;
    const float* xs = F.in[1] + (size_t)(row - MP) * DM + col; bf16* XN = (bf16*)(F.ws + WS_XN);
    const f32x4v xa = *(const f32x4v*)xs, xb = *(const f32x4v*)(xs + 4);
    const f32x4v x0 = {xa[0] + v[0], xa[1] + v[1], xa[2] + v[2], xa[3] + v[3]}, x1 = {xb[0] + v[4], xb[1] + v[5], xb[2] + v[6], xb[3] + v[7]};
    v4u w; w.x = pk2(x0[0], x0[1]); w.y = pk2(x0[2], x0[3]); w.z = pk2(x1[0], x1[1]); w.w = pk2(x1[2], x1[3]);
    *(v4u*)(XN + off) = w;
    float ss = (x0[0] * x0[0] + x0[1] * x0[1]) + (x0[2] * x0[2] + x0[3] * x0[3]) + (x1[0] * x1[0] + x1[1] * x1[1]) + (x1[2] * x1[2] + x1[3] * x1[3]);
    ss += __shfl_xor(ss, 1); ss += __shfl_xor(ss, 2); ss += __shfl_xor(ss, 4);
    if ((F.tid & 7) == 0) __hip_atomic_fetch_add(SS1 + row, ss, __ATOMIC_RELAXED, __HIP_MEMORY_SCOPE_AGENT);
}
__device__ __forceinline__ void down_sample_tile(Frame& F, int tile, float* SS2, unsigned* cntb, float* YO) {
    const int rm = tile >> 4, cn = tile & 15; float v[8];
    small_gemm_tile<11>(F, (const bf16*)(F.ws + WS_ACT), DFF, (const bf16*)(F.ws + WS_WD), DFF, MP + 64 * rm, 64 * cn, v);
    const int row = MP + 64 * rm + (F.tid >> 3), col = 64 * cn + 8 * (F.tid & 7); const size_t off = (size_t)row * DM + col;
    unsigned* cnt = cntb + 64 * rm; const v4u xw = *(const v4u*)((const bf16*)(F.ws + WS_XN) + off);
    const f32x4v xa = {bflo(xw.x), bfhi(xw.x), bflo(xw.y), bfhi(xw.y)}, xb = {bflo(xw.z), bfhi(xw.z), bflo(xw.w), bfhi(xw.w)}, ga = *(const f32x4v*)(F.in[23] + col), gb = *(const f32x4v*)(F.in[23] + col + 4);
    const f32x4v x0 = {xa[0] + v[0], xa[1] + v[1], xa[2] + v[2], xa[3] + v[3]}, x1 = {xb[0] + v[4], xb[1] + v[5], xb[2] + v[6], xb[3] + v[7]};
    float ss = (x0[0] * x0[0] + x0[1] * x0[1]) + (x0[2] * x0[2] + x0[3] * x0[3]) + (x1[0] * x1[0] + x1[1] * x1[1]) + (x1[2] * x1[2] + x1[3] * x1[3]);
    ss += __shfl_xor(ss, 1); ss += __shfl_xor(ss, 2); ss += __shfl_xor(ss, 4);
    if ((F.tid & 7) == 0) __hip_atomic_fetch_add(SS2 + row, ss, __ATOMIC_RELAXED, __HIP_MEMORY_SCOPE_AGENT);
    asm volatile("s_waitcnt vmcnt(0)" ::: "memory");
    __syncthreads();
    if (F.tid == 0) { __hip_atomic_fetch_add(cnt, 1u, __ATOMIC_RELAXED, __HIP_MEMORY_SCOPE_AGENT); wait_count(cnt, 16u); }
    __syncthreads();
    float s = 0.f; if ((F.tid & 7) == 0) s = atomic_read_f32(SS2 + row);
    const float rs = rstd_of(__shfl(s, F.lane & ~7));
    *(f32x4v*)(YO + off) = (f32x4v){x0[0] * rs * ga[0], x0[1] * rs * ga[1], x0[2] * rs * ga[2], x0[3] * rs * ga[3]};
    *(f32x4v*)(YO + off + 4) = (f32x4v){x1[0] * rs * gb[0], x1[1] * rs * gb[1], x1[2] * rs * gb[2], x1[3] * rs * gb[3]};
}
typedef GAS unsigned gu32;
#define RLX_AGENT __ATOMIC_RELAXED, __HIP_MEMORY_SCOPE_AGENT
constexpr int MISC_OFF = LDS_BYTES - 512;
constexpr int CW_QUEUE = 8192;
constexpr int CW_BAR = 4096;
constexpr size_t CTL_ZERO_BYTES = 524288;
constexpr int CW_DUMMY = 65536;
#define XB_TMO      128
#define XB_XCNT(j)  (256  + 64 * (j))
#define XB_XSUB(j)  (1280 + 64 * (j))
#define XB_XGEN(j)  (2304 + 64 * (j))
#define XB_TOP      3328
#define XB_TOPGEN   3392
#define XCD_BAR_WORDS 3456
#define XB_SPIN_CAP (1u << 18)

__device__ __forceinline__ unsigned xb_ld(unsigned* p)              { return __hip_atomic_load(p, __ATOMIC_RELAXED, __HIP_MEMORY_SCOPE_AGENT); }
__device__ __forceinline__ unsigned xb_add(unsigned* p, unsigned v) { return __hip_atomic_fetch_add(p, v, __ATOMIC_RELAXED, __HIP_MEMORY_SCOPE_AGENT); }
__device__ __forceinline__ unsigned xb_xcc_id() { return (unsigned)__builtin_amdgcn_s_getreg((3 << 11) | 20) & 0xFu; }
#define XB_SPIN(cond, bar) do { unsigned _sp = 0; while (cond) { __builtin_amdgcn_s_sleep(1); \
    if ((++_sp & 255u) == 0u) { if (xb_ld(&(bar)[XB_TMO])) break; if (_sp > XB_SPIN_CAP) { atomicAdd(&(bar)[XB_TMO], 1u); break; } } } } while (0)

struct XcdBarrier {
    unsigned* bar; unsigned x;
    volatile LAS unsigned* st;
};

__device__ __forceinline__ XcdBarrier xcd_barrier_post(unsigned* bar, volatile LAS unsigned* st) {
    XcdBarrier b; b.bar = bar; b.x = xb_xcc_id(); b.st = st;
    if (threadIdx.x == 0) (void)xb_add(&bar[XB_XCNT(b.x)], 1u);
    return b;
}
__device__ __forceinline__ void xcd_barrier_complete(unsigned* bar, unsigned x, unsigned& nloc, unsigned& nx) {
    const unsigned G = gridDim.x * gridDim.y * gridDim.z;
    unsigned sum, cnt, mine, sp = 0u;
    for (;;) {
        sum = 0u; cnt = 0u; mine = 0u;
#pragma unroll
        for (unsigned j = 0; j < 16; ++j) { const unsigned c = xb_ld(&bar[XB_XCNT(j)]); sum += c; cnt += (c > 0u) ? 1u : 0u; mine = (j == x) ? c : mine; }
        if (sum == G) break;
        __builtin_amdgcn_s_sleep(1);
        if ((++sp & 255u) == 0u) { if (xb_ld(&bar[XB_TMO])) break; if (sp > XB_SPIN_CAP) { atomicAdd(&bar[XB_TMO], 1u); break; } }
    }
    nloc = mine > 0u ? mine : 1u; nx = cnt > 0u ? cnt : 1u;
}

__device__ __forceinline__ void xcd_barrier(const XcdBarrier& b) {
    asm volatile("s_waitcnt vmcnt(0)" ::: "memory");
    __syncthreads();
    if (threadIdx.x == 0) {
        unsigned* bar = b.bar;
        __builtin_amdgcn_s_waitcnt(0);
        unsigned nloc = b.st[0], nx = b.st[1];
        if (nloc == 0u) { xcd_barrier_complete(bar, b.x, nloc, nx); b.st[0] = nloc; b.st[1] = nx; }
        const unsigned old = xb_add(&bar[XB_XSUB(b.x)], 1u);
        const unsigned gen = old / nloc;
        if (old + 1u == (gen + 1u) * nloc) {
            __builtin_amdgcn_fence(__ATOMIC_RELEASE, "agent");
            asm volatile("s_waitcnt vmcnt(0)" ::: "memory");
            const unsigned og = xb_add(&bar[XB_TOP], 1u);
            const unsigned tg = og / nx;
            if (og + 1u == (tg + 1u) * nx) xb_add(&bar[XB_TOPGEN], 1u);
            else XB_SPIN(xb_ld(&bar[XB_TOPGEN]) == tg, bar);
            __builtin_amdgcn_fence(__ATOMIC_ACQUIRE, "agent");
            xb_add(&bar[XB_XGEN(b.x)], 1u);
            asm volatile("s_waitcnt vmcnt(0)" ::: "memory");
        } else {
            XB_SPIN(xb_ld(&bar[XB_XGEN(b.x)]) == gen, bar);
            __builtin_amdgcn_fence(__ATOMIC_ACQUIRE, "agent");
            asm volatile("s_waitcnt vmcnt(0)" ::: "memory");
        }
    }
    __syncthreads();
}

__global__ void __launch_bounds__(NWAVES * 64, 2) mk_fwd(Args args) {
    extern __shared__ __attribute__((aligned(16))) unsigned char lds[];
    Frame F;
    F.lds = (LAS unsigned char*)lds;
    F.tid = threadIdx.x; F.lane = F.tid & 63; F.wave = __builtin_amdgcn_readfirstlane(F.tid >> 6);
    F.G = gridDim.x; F.bid = blockIdx.x;
#pragma unroll
    for (int i = 0; i < 24; ++i) F.in[i] = args.in[i];
    F.out = args.out; F.ws = args.ws;
    const int lo = args.ph_lo, hi = args.ph_hi;
#define IN(k) (lo <= (k) && (k) < hi)
#if MK_N_LAUNCHES == 1
    volatile LAS unsigned* MISC = (volatile LAS unsigned*)(F.lds + MISC_OFF);
    if (F.tid < 32) MISC[F.tid] = 0u;
    __syncthreads();
    XcdBarrier bar = xcd_barrier_post((unsigned*)(F.ws + WS_CTL) + CW_BAR, MISC + 8);
#if defined(PROBE_PH)
    if (F.bid == 0 && F.tid == 0) { const unsigned long long t_ = __builtin_amdgcn_s_memrealtime(); MISC[32] = (unsigned)t_; MISC[33] = (unsigned)(t_ >> 32); }
#endif
#if defined(CLK_PH)
#define SEAM(k) do { if (IN(k) && IN((k) + 1)) { xcd_barrier(bar); if (F.bid == 0 && F.tid == 0) { const unsigned long long t_ = __builtin_amdgcn_s_memtime(); MISC[32 + 2 * ((k) + 1)] = (unsigned)t_; MISC[33 + 2 * ((k) + 1)] = (unsigned)(t_ >> 32); } } } while (0)
#elif defined(PROBE_PH)
#define SEAM(k) do { if (IN(k) && IN((k) + 1)) { xcd_barrier(bar); if (F.bid == 0 && F.tid == 0) { const unsigned long long t_ = __builtin_amdgcn_s_memrealtime(); MISC[32 + 2 * ((k) + 1)] = (unsigned)t_; MISC[33 + 2 * ((k) + 1)] = (unsigned)(t_ >> 32); } } } while (0)
#elif REP_BAR == 2
#define SEAM(k) do { if (IN(k) && IN((k) + 1)) { xcd_barrier(bar); xcd_barrier(bar); } } while (0)
#else
#define SEAM(k) do { if (IN(k) && IN((k) + 1)) xcd_barrier(bar); } while (0)
#endif
#else
#define SEAM(k) do { } while (0)
#endif
    const int gw = F.bid * NWAVES + F.wave, NGW = F.G * NWAVES;
    bf16* XN = (bf16*)(F.ws + WS_XN); bf16* PB = (bf16*)(F.ws + WS_PB); float* FZ = (float*)(F.ws + WS_FZ); bf16* GY = (bf16*)(F.ws + WS_GY);
    bf16* MIX = (bf16*)(F.ws + WS_MIX); bf16* ACT = (bf16*)(F.ws + WS_ACT);

    if (IN(0)) { p0_prologue(F);
#if REP_P0 == 2
        __syncthreads(); p0_prologue(F);
#endif
    } SEAM(0);
    if (IN(1)) {
        pg8::Gemm g{XN, (const bf16*)(F.ws + WS_WIN), MTOK, INC, DM}; pg8::StaticOrder S; S.init(MTOK, INC, F.G, F.bid);
        EpiIn E{PB, FZ, (bf16*)(F.ws + WS_U5)};
        pg8::gemm_phase<EpiIn, pg8::StaticOrder, true, true>(F.lds, g, S, E);
        { const int nunits = (MTOK / 256) * (INC / 256), rem = nunits % F.G;
          if (rem == 0) deferred_transposes<0>(F, gw, NGW); else if (F.bid >= rem) deferred_transposes<0>(F, (F.bid - rem) * NWAVES + F.wave, (F.G - rem) * NWAVES); }
#if REP_P1 == 2
        __syncthreads();
        pg8::gemm_phase<EpiIn, pg8::StaticOrder, true, true>(F.lds, g, S, E);
#endif
    } SEAM(1);
    if (IN(2)) {
        const int nper = (1024 + F.G - 1) / F.G, rot = F.bid % 3;
        if (rot == 0) {
            STAMP(4);
            for (int it = F.bid; it < 256; it += F.G) s5_item(F, it);
            STAMP(5);
            hgA_loop(F, 0, nper);
            STAMP(6);
            hgrn_sample_loop(F);
            STAMP(7);
        } else if (rot == 1) {
            hgrn_sample_loop(F);
            hgA_loop(F, 0, nper);
            __syncthreads();
            for (int it = F.bid; it < 256; it += F.G) s5_item(F, it);
        } else {
            hgA_loop(F, 0, nper / 2);
            __syncthreads();
            for (int it = F.bid; it < 256; it += F.G) s5_item(F, it);
            hgA_loop(F, nper / 2, nper);
            hgrn_sample_loop(F);
        }
    } SEAM(2);
    if (IN(3)) { hg_scan(F, (bf16*)(F.ws + WS_DSC), F.bid, F.G); } SEAM(3);
    if (IN(4)) {
        pg8::Gemm g{GY, (const bf16*)(F.ws + WS_WGLU), MTOK, S5W, S5W}; pg8::StaticOrder S; S.init(MTOK, S5W, F.G, F.bid);
        EpiGlu E{GY, MIX};
        pg8::gemm_phase<EpiGlu, pg8::StaticOrder, true, true, true>(F.lds, g, S, E);
        __syncthreads();
        hgC_loop(F, (unsigned*)(F.ws + WS_CTL) + CW_QUEUE);
    } SEAM(4);
    if (IN(5)) {
        pg8::Gemm g{MIX, (const bf16*)(F.ws + WS_WOUT), MP, DM, DM}; pg8::StaticOrder S; S.init(MP, DM, F.G, F.bid);
#if REP_P5 >= 2
        { EpiOut E2{F.in[0], XN, (float*)(F.ws + WS_CTL) + CW_DUMMY};
#if REP_P5 == 2 || REP_P5 == 3
          pg8::gemm_phase<EpiOut, pg8::StaticOrder, true, true>(F.lds, g, S, E2);
          __syncthreads();
#endif
#if REP_P5 == 2 || REP_P5 == 4
          for (int it = F.bid; it < 256; it += F.G) outproj_sample_tile(F, it, (float*)(F.ws + WS_CTL) + CW_DUMMY);
          __syncthreads();
#endif
        }
#endif
        EpiOut E{F.in[0], XN, (float*)(F.ws + WS_CTL) + CW_SS1};
        const bool first = (F.G == 256) && ((F.bid & 1) == 0);
        if (first) { outproj_sample_tile(F, F.bid, (float*)(F.ws + WS_CTL) + CW_SS1); __syncthreads(); }
        pg8::gemm_phase<EpiOut, pg8::StaticOrder, ONEUNIT_ALIGN, true>(F.lds, g, S, E);
        __syncthreads();
        if (!first) for (int it = F.bid; it < 256; it += F.G) outproj_sample_tile(F, it, (float*)(F.ws + WS_CTL) + CW_SS1);
    } SEAM(5);
    if (IN(6)) {
        pg8::Gemm g{XN, (const bf16*)(F.ws + WS_WGU), MTOK, 2 * DFF, DM}; pg8::StaticOrder S; S.init(MTOK, 2 * DFF, F.G, F.bid);
        EpiAct E{ACT, (const float*)(F.ws + WS_CTL) + CW_SS1};
        pg8::gemm_phase<EpiAct, pg8::StaticOrder, P6_ALIGN, P6_SP2>(F.lds, g, S, E);
        { const int nunits = (MTOK / 256) * (2 * DFF / 256), rem = nunits % F.G;
          if (rem == 0) deferred_transposes<1>(F, gw, NGW); else if (F.bid >= rem) deferred_transposes<1>(F, (F.bid - rem) * NWAVES + F.wave, (F.G - rem) * NWAVES); }
#if REP_P6 == 2
        __syncthreads();
        pg8::gemm_phase<EpiAct, pg8::StaticOrder, true, true>(F.lds, g, S, E);
#endif
    } SEAM(6);
    if (IN(7)) {
        pg8::Gemm g{ACT, (const bf16*)(F.ws + WS_WD), MP, DM, DFF}; pg8::StaticOrder S; S.init(MP, DM, F.G, F.bid);
#if REP_P7 == 2
        { float* YD = (float*)(F.ws + WS_GY) - 0;
          EpiDown E2{XN, F.in[23], (float*)(F.ws + WS_CTL) + CW_DUMMY, (unsigned*)(F.ws + WS_CTL) + CW_DUMMY + 20480, YD};
          pg8::gemm_phase<EpiDown, pg8::StaticOrder, true, true>(F.lds, g, S, E2);
          __syncthreads();
          for (int it = F.bid; it < 256; it += F.G) down_sample_tile(F, it, (float*)(F.ws + WS_CTL) + CW_DUMMY, (unsigned*)(F.ws + WS_CTL) + CW_DUMMY + 20480 + 4096, YD);
          __syncthreads(); }
#endif
        EpiDown E{XN, F.in[23], (float*)(F.ws + WS_CTL) + CW_SS2, (unsigned*)(F.ws + WS_CTL) + CW_CNT, F.out + O_Y};
        Unit u0; const bool has_u = S.next(0, u0); const int grp = has_u ? (u0.pm & 1) : 0;
        const int stile = (F.G == 256 && has_u) ? grp * 128 + (u0.pm >> 1) * 4 + u0.pn : F.bid;
        if (F.G == 256 && grp == 0) { down_sample_tile(F, stile, (float*)(F.ws + WS_CTL) + CW_SS2, (unsigned*)(F.ws + WS_CTL) + CW_CNTS, F.out + O_Y); __syncthreads(); }
        pg8::gemm_phase<EpiDown, pg8::StaticOrder, ONEUNIT_ALIGN, true>(F.lds, g, S, E);
        __syncthreads();
        if (F.G != 256) { for (int it = F.bid; it < 256; it += F.G) down_sample_tile(F, it, (float*)(F.ws + WS_CTL) + CW_SS2, (unsigned*)(F.ws + WS_CTL) + CW_CNTS, F.out + O_Y); }
        else if (grp == 1) down_sample_tile(F, stile, (float*)(F.ws + WS_CTL) + CW_SS2, (unsigned*)(F.ws + WS_CTL) + CW_CNTS, F.out + O_Y);
    }
#if defined(AMP_A)
    if (F.bid == AMP_BLK && F.tid == 0) { volatile LAS unsigned* M_ = (volatile LAS unsigned*)(F.lds + LDS_BYTES - 512);
        const unsigned long long a = ((unsigned long long)M_[65 + 2 * AMP_A] << 32) | M_[64 + 2 * AMP_A], bq = ((unsigned long long)M_[65 + 2 * AMP_B] << 32) | M_[64 + 2 * AMP_B];
        const unsigned long long wait = 4ull * (bq - a), tn = __builtin_amdgcn_s_memrealtime();
        while (__builtin_amdgcn_s_memrealtime() - tn < wait) __builtin_amdgcn_s_sleep(8); }
#endif
#if defined(CLK_PH)
    if (F.bid == 0 && F.tid == 0) {
        const unsigned long long c0 = ((unsigned long long)MISC[33 + 2 * CLK_PH] << 32) | MISC[32 + 2 * CLK_PH], c1 = ((unsigned long long)MISC[35 + 2 * CLK_PH] << 32) | MISC[34 + 2 * CLK_PH];
        const unsigned long long wait = (c1 - c0) / 5ull, tn = __builtin_amdgcn_s_memrealtime();
        while (__builtin_amdgcn_s_memrealtime() - tn < wait) __builtin_amdgcn_s_sleep(8);
    }
#endif
#if defined(PROBE_PH)
    if (F.bid == 0 && F.tid == 0) {
        const unsigned long long tn = __builtin_amdgcn_s_memrealtime();
        const unsigned long long t0 = ((unsigned long long)MISC[33 + 2 * PROBE_PH] << 32) | MISC[32 + 2 * PROBE_PH];
        const unsigned long long t1 = (PROBE_PH == NPH - 1) ? tn : (((unsigned long long)MISC[35 + 2 * PROBE_PH] << 32) | MISC[34 + 2 * PROBE_PH]);
        const unsigned long long wait = 4ull * (t1 - t0);
        while (__builtin_amdgcn_s_memrealtime() - tn < wait) __builtin_amdgcn_s_sleep(8);
    }
#endif
#undef IN
#undef SEAM
}

extern "C" void kernel_launch(void* const* d_in, const int* in_sizes, int n_in, void* d_out, int out_size, void* d_ws, size_t ws_size, hipStream_t stream) {
    static int grid = 0;
    if (grid == 0) {
        if (n_in != 24 || ws_size < WS_END) { fprintf(stderr, "kernel_launch: unexpected n_in %d / ws %zu\n", n_in, ws_size); grid = -1; return; }
        int dev = 0, cus = 0, per_cu = 0;
        if (hipGetDevice(&dev) != hipSuccess || hipDeviceGetAttribute(&cus, hipDeviceAttributeMultiprocessorCount, dev) != hipSuccess) { grid = -1; return; }
        if (hipFuncSetAttribute((const void*)mk_fwd, hipFuncAttributeMaxDynamicSharedMemorySize, LDS_BYTES) != hipSuccess) { fprintf(stderr, "kernel_launch: hipFuncSetAttribute failed\n"); grid = -1; return; }
        if (hipOccupancyMaxActiveBlocksPerMultiprocessor(&per_cu, (const void*)mk_fwd, NWAVES * 64, LDS_BYTES) != hipSuccess || per_cu < 1) { fprintf(stderr, "kernel_launch: occupancy query says %d\n", per_cu); per_cu = 1; }
        (void)hipGetLastError();
        grid = cus;
    }
    if (grid < 0) return;
#if REP_MEMSET == 2
    (void)hipMemsetAsync((char*)d_ws + WS_CTL + 1048576 + 524288, 0, CTL_ZERO_BYTES, stream);
#endif
    if (hipMemsetAsync((char*)d_ws + WS_CTL, 0, CTL_ZERO_BYTES, stream) != hipSuccess) { fprintf(stderr, "kernel_launch: memset failed\n"); return; }
    Args a{};
    for (int i = 0; i < 24; ++i) a.in[i] = (const float*)d_in[i];
    a.out = (float*)d_out; a.ws = (unsigned char*)d_ws;
#if MK_N_LAUNCHES == 1
    a.ph_lo = 0; a.ph_hi = NPH;
    void* kargs[] = {&a};
    hipError_t e = hipLaunchCooperativeKernel((const void*)mk_fwd, dim3(grid), dim3(NWAVES * 64), kargs, LDS_BYTES, stream);
    if (e != hipSuccess) fprintf(stderr, "kernel_launch: cooperative launch failed: %s (grid %d)\n", hipGetErrorString(e), grid);
#else
    for (int p = 0; p < NPH; ++p) { a.ph_lo = p; a.ph_hi = p + 1; hipLaunchKernelGGL(mk_fwd, dim3(grid), dim3(NWAVES * 64), LDS_BYTES, stream, a); }
#endif
}
```

```cpp
#include <hip/hip_runtime.h>
#include <hip/hip_cooperative_groups.h>
#include <cstdio>
#include <cstdint>
namespace cg = cooperative_groups;
#ifndef PG8_WGM
#define PG8_WGM 4
#endif
#define MK_N_LAUNCHES 1
namespace pg8 {
#define PG8_LAS __attribute__((address_space(3)))
typedef unsigned short bf16_t;
typedef short bf16x8 __attribute__((ext_vector_type(8)));
typedef float f32x4 __attribute__((ext_vector_type(4)));
typedef unsigned u32x4 __attribute__((ext_vector_type(4)));
constexpr int BM = 256, BK = 64, HALF = 128, HTB = HALF * BK * 2  , STAGE_BYTES = 8 * HTB, NXCD = 8, WGM = PG8_WGM;

__host__ __device__ __forceinline__ int lds_byte(int r, int c) { const int st = (r >> 4) * 2 + (c >> 5), rr = r & 15, cc = c & 31, ob = rr * 64 + cc * 2; return st * 1024 + (ob ^ (((ob >> 9) & 1) << 5)); }
__host__ __device__ __forceinline__ void stage_rc(int b, int& R, int& C) { const int st = b / 1024, sb = b % 1024, swz = sb ^ (((sb >> 9) & 1) << 5); R = (st >> 1) * 16 + swz / 64; C = (st & 1) * 32 + (swz % 64) / 2; }
__host__ __device__ __forceinline__ int perm32(int rho) { const int n = rho >> 4, i = rho & 15; return 8 * (i >> 2) + 4 * n + (i & 3); }

struct Unit { int pm, pn; };
struct Gemm { const bf16_t* A; const bf16_t* Bt; int M, N, K; };

struct StaticOrder {
    int nM, nN, nwg, G, c;
    __host__ __device__ void init(int M, int N, int G_, int c_) { nM = M / BM; nN = N / BM; nwg = nM * nN; G = G_; c = c_; }
    __host__ __device__ bool next(int i, Unit& u) const {
        const long L = (long)i * G + c; if (L >= nwg) return false;
        int wgid = (int)L; { const int q = nwg / NXCD, r = nwg % NXCD, xcd = wgid % NXCD, off = wgid / NXCD; wgid = (xcd < r ? xcd * (q + 1) : r * (q + 1) + (xcd - r) * q) + off; }
        const int nig = WGM * nN, gid = wgid / nig, fm = gid * WGM, gsz = (nM - fm) < WGM ? (nM - fm) : WGM;
        u.pm = fm + ((wgid % nig) % gsz); u.pn = (wgid % nig) / gsz; return true;
    }
    __device__ __forceinline__ void a_ready(const Unit&) const {}
    __device__ __forceinline__ void done(const Unit&) const {}
};

__device__ __forceinline__ unsigned cvt_pk_bf16(float lo, float hi) { unsigned r; asm volatile("v_cvt_pk_bf16_f32 %0, %1, %2" : "=v"(r) : "v"(lo), "v"(hi)); return r; }
template <class Epi, class Sched, bool ALIGN_EPI = false, bool SP2 = false, bool AGM = false  >
__device__ __forceinline__ void gemm_phase(PG8_LAS unsigned char* lds, const Gemm g, const Sched& S, const Epi& E) {
    const int tid = threadIdx.x, wid = __builtin_amdgcn_readfirstlane(tid >> 6), lane = tid & 63, wr = wid >> 2, wc = wid & 3, fr = lane & 15, fq = lane >> 4;
    const int K = g.K, nt = K / BK;
    unsigned voffA[2], voffB[2];
#pragma unroll
    for (int i = 0; i < 2; ++i) { int R, C; stage_rc(tid * 16 + i * 8192, R, C); const int Rb = Epi::PERM ? ((R & ~31) + perm32(R & 31)) : R;
        voffA[i] = AGM ? (unsigned)((((C >> 4) * g.M + R) * 16 + (C & 15)) * 2) : (unsigned)(R * K + C) * 2u; voffB[i] = (unsigned)(Rb * K + C) * 2u; }
    const size_t kstep = (size_t)(BK * 2);
    const size_t hstep = (size_t)HALF * K * 2;
    const size_t tstep = 2 * hstep;
    const size_t kstepA = AGM ? (size_t)4 * g.M * 32 : kstep, hstepA = AGM ? (size_t)HALF * 32 : hstep, tstepA = 2 * hstepA;
    const unsigned ldsw = (unsigned)wid * 1024u;
    const int aoff = lds_byte(wr * 64 + fr, fq * 8), boff = lds_byte(wc * 32 + fr, fq * 8);
#define PG8_SA(b, h) (((b) * 2 + (h)) * HTB)
#define PG8_SB(b, h) ((4 + (b) * 2 + (h)) * HTB)
#define PG8_STAGE(bufoff, gbase, voff) do { _Pragma("unroll") for (int _i = 0; _i < 2; ++_i) \
        __builtin_amdgcn_global_load_lds((const unsigned*)((const char*)(gbase) + (voff)[_i]), (PG8_LAS unsigned*)(lds + (bufoff) + ldsw + _i * 8192), 16, 0, 0); } while (0)
#define PG8_LDA(dst, b, h) do { _Pragma("unroll") for (int m = 0; m < 4; ++m) _Pragma("unroll") for (int k = 0; k < 2; ++k) dst[m][k] = *(const PG8_LAS bf16x8*)(lds + PG8_SA(b, h) + aoff + m * 2048 + k * 1024); } while (0)
#define PG8_LDB(dst, b, h) do { _Pragma("unroll") for (int n = 0; n < 2; ++n) _Pragma("unroll") for (int k = 0; k < 2; ++k) dst[n][k] = *(const PG8_LAS bf16x8*)(lds + PG8_SB(b, h) + boff + n * 2048 + k * 1024); } while (0)
#define PG8_MMA(ai, bj, At, Bt) do { __builtin_amdgcn_s_setprio(1); _Pragma("unroll") for (int m = 0; m < 4; ++m) _Pragma("unroll") for (int n = 0; n < 2; ++n) _Pragma("unroll") for (int k = 0; k < 2; ++k) \
        acc[ai][bj][m][n] = __builtin_amdgcn_mfma_f32_16x16x32_bf16(Bt[n][k], At[m][k], acc[ai][bj][m][n], 0, 0, 0); __builtin_amdgcn_s_setprio(0); } while (0)
#define PG8_WAIT_V(n) asm volatile("s_waitcnt vmcnt(" #n ")" ::: "memory")
#define PG8_WAIT_L(n) asm volatile("s_waitcnt lgkmcnt(" #n ")" ::: "memory")
#define PG8_BAR __builtin_amdgcn_s_barrier()
#define PG8_SCHED __builtin_amdgcn_sched_barrier(0)
    Unit cur, nxt; int ui = 0;
    if (!S.next(0, cur)) return;
    f32x4 acc[2][2][4][2];
#pragma unroll
    for (int a = 0; a < 2; ++a)
#pragma unroll
        for (int b = 0; b < 2; ++b)
#pragma unroll
            for (int m = 0; m < 4; ++m)
#pragma unroll
                for (int n = 0; n < 2; ++n) acc[a][b][m][n] = (f32x4){0.f, 0.f, 0.f, 0.f};
    bf16x8 At[4][2], B0[2][2], B1[2][2];
    const char* cA = (const char*)g.A + (size_t)cur.pm * tstepA; const char* cB = (const char*)g.Bt + (size_t)cur.pn * tstep;
    S.a_ready(cur);
    if constexpr (SP2) {
        PG8_STAGE(PG8_SB(0, 0), cB, voffB); PG8_STAGE(PG8_SB(0, 1), cB + hstep, voffB); PG8_STAGE(PG8_SA(0, 0), cA, voffA); PG8_STAGE(PG8_SA(0, 1), cA + hstepA, voffA);
        if (wr == 1) PG8_BAR;
        PG8_WAIT_V(2); PG8_BAR;
        PG8_STAGE(PG8_SB(1, 0), cB + kstep, voffB); PG8_STAGE(PG8_SA(1, 0), cA + kstepA, voffA); PG8_STAGE(PG8_SB(1, 1), cB + hstep + kstep, voffB);
        PG8_WAIT_V(6); PG8_BAR;
    } else {
        PG8_STAGE(PG8_SB(0, 0), cB, voffB); PG8_STAGE(PG8_SA(0, 0), cA, voffA); PG8_STAGE(PG8_SB(0, 1), cB + hstep, voffB); PG8_STAGE(PG8_SA(0, 1), cA + hstepA, voffA);
        if (wr == 1) PG8_BAR;
        PG8_WAIT_V(4); PG8_BAR;
        PG8_STAGE(PG8_SB(1, 0), cB + kstep, voffB); PG8_STAGE(PG8_SA(1, 0), cA + kstepA, voffA); PG8_STAGE(PG8_SB(1, 1), cB + hstep + kstep, voffB);
        PG8_WAIT_V(6); PG8_BAR;
    }
    for (;;) {
        const bool has_next = S.next(ui + 1, nxt);
        const char* nA = has_next ? (const char*)g.A + (size_t)nxt.pm * tstepA : cA; const char* nB = has_next ? (const char*)g.Bt + (size_t)nxt.pn * tstep : cB;
        for (int t = 0; t < nt; t += 2) {
            const bool last = (t == nt - 2);
            const char* a1 = cA + (size_t)(t + 1) * kstepA;
            const char* a2 = last ? nA : cA + (size_t)(t + 2) * kstepA; const char* b2 = last ? nB : cB + (size_t)(t + 2) * kstep;
            const char* a3 = a2 + kstepA; const char* b3 = b2 + kstep;
            if (last && has_next) S.a_ready(nxt);
            if constexpr (SP2) {
            PG8_LDB(B0, 0, 0); PG8_LDB(B1, 0, 1); PG8_SCHED; PG8_LDA(At, 0, 0); PG8_STAGE(PG8_SA(1, 1), a1 + hstepA, voffA);
            PG8_WAIT_V(8); PG8_WAIT_L(0); PG8_BAR; PG8_MMA(0, 0, At, B0); PG8_MMA(0, 1, At, B1); PG8_BAR; PG8_SCHED;
            PG8_LDA(At, 0, 1); PG8_STAGE(PG8_SB(0, 0), b2, voffB); PG8_STAGE(PG8_SB(0, 1), b2 + hstep, voffB); PG8_STAGE(PG8_SA(0, 0), a2, voffA);
            PG8_WAIT_V(8); PG8_WAIT_L(0); PG8_BAR; PG8_MMA(1, 0, At, B0); PG8_MMA(1, 1, At, B1); PG8_BAR; PG8_SCHED;
            PG8_LDB(B0, 1, 0); PG8_LDB(B1, 1, 1); PG8_SCHED; PG8_LDA(At, 1, 0); PG8_STAGE(PG8_SA(0, 1), a2 + hstepA, voffA);
            PG8_WAIT_V(8); PG8_WAIT_L(0); PG8_BAR; PG8_MMA(0, 0, At, B0); PG8_MMA(0, 1, At, B1); PG8_BAR; PG8_SCHED;
            PG8_LDA(At, 1, 1); PG8_STAGE(PG8_SB(1, 0), b3, voffB); PG8_STAGE(PG8_SB(1, 1), b3 + hstep, voffB); PG8_STAGE(PG8_SA(1, 0), a3, voffA);
            PG8_WAIT_V(8); PG8_WAIT_L(0); PG8_BAR; PG8_MMA(1, 0, At, B0); PG8_MMA(1, 1, At, B1); PG8_BAR; PG8_SCHED;
            } else {
            PG8_LDB(B0, 0, 0); PG8_SCHED; PG8_LDA(At, 0, 0); PG8_STAGE(PG8_SA(1, 1), a1 + hstepA, voffA);
            PG8_WAIT_L(8); PG8_BAR; PG8_WAIT_L(0); PG8_MMA(0, 0, At, B0); PG8_BAR; PG8_SCHED;
            PG8_LDB(B1, 0, 1); PG8_STAGE(PG8_SB(0, 0), b2, voffB);
            PG8_BAR; PG8_WAIT_L(0); PG8_MMA(0, 1, At, B1); PG8_BAR;
            PG8_LDA(At, 0, 1); PG8_STAGE(PG8_SA(0, 0), a2, voffA);
            PG8_BAR; PG8_WAIT_L(0); PG8_MMA(1, 0, At, B0); PG8_BAR; PG8_SCHED;
            PG8_STAGE(PG8_SB(0, 1), b2 + hstep, voffB);
            PG8_WAIT_V(6); PG8_BAR; PG8_MMA(1, 1, At, B1); PG8_BAR;
            PG8_LDB(B0, 1, 0); PG8_SCHED; PG8_LDA(At, 1, 0); PG8_STAGE(PG8_SA(0, 1), a2 + hstepA, voffA);
            PG8_WAIT_L(8); PG8_BAR; PG8_WAIT_L(0); PG8_MMA(0, 0, At, B0); PG8_BAR; PG8_SCHED;
            PG8_LDB(B1, 1, 1); PG8_STAGE(PG8_SB(1, 0), b3, voffB);
            PG8_BAR; PG8_WAIT_L(0); PG8_MMA(0, 1, At, B1); PG8_BAR;
            PG8_LDA(At, 1, 1); PG8_STAGE(PG8_SA(1, 0), a3, voffA);
            PG8_BAR; PG8_WAIT_L(0); PG8_MMA(1, 0, At, B0); PG8_BAR; PG8_SCHED;
            PG8_STAGE(PG8_SB(1, 1), b3 + hstep, voffB);
            PG8_WAIT_V(6); PG8_BAR; PG8_MMA(1, 1, At, B1); PG8_BAR;
            }
        }
        if constexpr (ALIGN_EPI) { if (wr == 0) PG8_BAR; }
        if constexpr (!Epi::AFTER_DRAIN) { E(acc, cur, wr, wc, fr, fq); S.done(cur); }
        if (!has_next) break;
#pragma unroll
        for (int a = 0; a < 2; ++a)
#pragma unroll
            for (int b = 0; b < 2; ++b)
#pragma unroll
                for (int m = 0; m < 4; ++m)
#pragma unroll
                    for (int n = 0; n < 2; ++n) acc[a][b][m][n] = (f32x4){0.f, 0.f, 0.f, 0.f};
        cur = nxt; cA = nA; cB = nB; ++ui;
        if constexpr (ALIGN_EPI) { if (wr == 1) PG8_BAR; }
    }
    PG8_WAIT_V(0);
    if constexpr (!ALIGN_EPI) { if (wr == 0) PG8_BAR; }
    PG8_BAR;
    if constexpr (Epi::AFTER_DRAIN) { E.fused(acc, cur, wr, wc, fr, fq, lds, wid, lane); S.done(cur); }
#undef PG8_SA
#undef PG8_SB
#undef PG8_STAGE
#undef PG8_LDA
#undef PG8_LDB
#undef PG8_MMA
#undef PG8_WAIT_V
#undef PG8_WAIT_L
#undef PG8_BAR
#undef PG8_SCHED
}
}

#ifndef S5_SIMPLE
#define S5_SIMPLE 0
#endif
#ifndef HG_SIMPLE
#define HG_SIMPLE 0
#endif
#ifndef REP0
#define REP0 1
#define REP1 1
#define REP2 1
#define REP3 1
#define REP4 1
#define REP6 1
#endif
#ifndef REP_S5
#define REP_S5 1
#endif
#ifndef REP_HGA
#define REP_HGA 1
#endif
#ifndef REP_HGC
#define REP_HGC 1
#endif
#ifndef REP_P1
#define REP_P1 1
#endif
#ifndef REP_P6
#define REP_P6 1
#endif
#ifndef REP_P0
#define REP_P0 1
#endif
#ifndef REP_GLU
#define REP_GLU 1
#endif
#ifndef REP_P3
#define REP_P3 1
#endif
#ifndef REP_P5
#define REP_P5 1
#endif
#ifndef REP_P7
#define REP_P7 1
#endif
#ifndef REP_BAR
#define REP_BAR 1
#endif
#ifndef REP_XN
#define REP_XN 1
#endif
#ifndef P6_ALIGN
#define P6_ALIGN true
#endif
#ifndef P6_SP2
#define P6_SP2 true
#endif
#ifndef REP_MEMSET
#define REP_MEMSET 1
#endif
#ifndef ONEUNIT_ALIGN
#define ONEUNIT_ALIGN true
#endif
#ifndef MK_N_LAUNCHES
#define MK_N_LAUNCHES 1
#endif
constexpr int DM = 1024, PB_B = 8, PB_T = 2048, SB_B = 128, SB_T = 8;
constexpr int MP = PB_B * PB_T, MS = SB_B * SB_T, MTOK = MP + MS;
constexpr int S5W = 512, S5G = 32, S5C = 16, S5N = 64;
constexpr int HGW = 512, HD = 128, HH = 4;
constexpr int INC = 2560, DFF = 2816;
constexpr float EPS = 1e-6f;
constexpr int NPH = 8;
constexpr size_t O_Y = 0, O_PRE = (size_t)MTOK * DM, O_PIM = O_PRE + 16384, O_PHG = O_PIM + 16384, O_SRE = O_PHG + 524288, O_SIM = O_SRE + 262144, O_SHG = O_SIM + 262144;
constexpr size_t MiB = 1u << 20;
constexpr size_t WS_CTL = 0, WS_WIN = 2 * MiB, WS_WGLU = 7 * MiB, WS_WOUT = 8 * MiB, WS_WGU = 10 * MiB, WS_WD = 21 * MiB;
constexpr size_t WS_XN = 27 * MiB, WS_PB = 61 * MiB, WS_FZ = 129 * MiB, WS_ACT = 61 * MiB, WS_GY = 163 * MiB, WS_OH = 180 * MiB, WS_MIX = 197 * MiB, WS_END = 234 * MiB;
constexpr int PBW = 2048;
constexpr int LDS_BYTES = 148480;
constexpr int EPI_SCR = 131072;
constexpr int NWAVES = 8;
constexpr int CW_SS1 = 16384, CW_SS2 = 36864, CW_CNT = 57344, CW_CNTS = 61440;

#define GAS __attribute__((address_space(1)))
#define LAS __attribute__((address_space(3)))
typedef unsigned short bf16;
typedef unsigned v4u __attribute__((ext_vector_type(4)));
typedef unsigned v2u __attribute__((ext_vector_type(2)));
typedef float f32x4 __attribute__((ext_vector_type(4)));
#define LDS_WAIT() asm volatile("s_waitcnt lgkmcnt(0)" ::: "memory")
typedef float f32x2_t __attribute__((ext_vector_type(2))); typedef __bf16 bf16x2_t __attribute__((ext_vector_type(2)));
__device__ __forceinline__ unsigned pk2(float lo, float hi) { f32x2_t v = {lo, hi}; bf16x2_t h = __builtin_convertvector(v, bf16x2_t); return __builtin_bit_cast(unsigned, h); }
__device__ __forceinline__ unsigned f2bf(float f) { return pk2(f, 0.f) & 0xffffu; }
__device__ __forceinline__ float bf2f(unsigned short h) { return __builtin_bit_cast(float, (unsigned)h << 16); }
__device__ __forceinline__ float bflo(unsigned w) { return __builtin_bit_cast(float, w << 16); }
__device__ __forceinline__ float bfhi(unsigned w) { return __builtin_bit_cast(float, w & 0xffff0000u); }
__device__ __forceinline__ float sigmoidf_(float x) { return __builtin_amdgcn_rcpf(1.0f + __builtin_amdgcn_exp2f(-1.4426950408889634f * x)); }
__device__ __forceinline__ float siluf_(float x) { return x * __builtin_amdgcn_rcpf(1.0f + __builtin_amdgcn_exp2f(-1.4426950408889634f * x)); }
__device__ __forceinline__ float gelu_tanh(float x) { const float z = -2.302208198144325f * (x + 0.044715f * x * x * x); return x * __builtin_amdgcn_rcpf(1.0f + __builtin_amdgcn_exp2f(z)); }
__device__ __forceinline__ float wave_sum(float v) {
#pragma unroll
    for (int o = 1; o < 64; o <<= 1) v += __shfl_xor(v, o);
    return v;
}

#if defined(AMP_A)
#define STAMP(i) do { if (F.bid == AMP_BLK && F.tid == 0) { const unsigned long long t_ = __builtin_amdgcn_s_memrealtime(); volatile LAS unsigned* M_ = (volatile LAS unsigned*)(F.lds + LDS_BYTES - 512); M_[64 + 2 * (i)] = (unsigned)t_; M_[65 + 2 * (i)] = (unsigned)(t_ >> 32); } } while (0)
#else
#define STAMP(i) do { } while (0)
#endif
#ifndef AMP_BLK
#define AMP_BLK 0
#endif
struct Args { const float* in[24]; float* out; unsigned char* ws; int ph_lo, ph_hi; };

struct Frame {
    LAS unsigned char* lds;
    int tid, lane, wave, G, bid;
    const float* in[24];
    float* out; unsigned char* ws;
};
__device__ __forceinline__ const float* xrow(const Frame& F, int m) { return m < MP ? F.in[0] + (size_t)m * DM : F.in[1] + (size_t)(m - MP) * DM; }

__device__ __forceinline__ void transpose_item(const float* W, int ldw, bf16* WT, int K, int k0, int sn0, int dn0, int lane, const float* kgain = nullptr) {
    const int k = k0 + 4 * (lane & 15), nl = 4 * (lane >> 4);
    f32x4 r[4][4];
#pragma unroll
    for (int nb = 0; nb < 4; ++nb)
#pragma unroll
        for (int j = 0; j < 4; ++j) r[nb][j] = *(const GAS f32x4*)(W + (size_t)(k + j) * ldw + sn0 + nl + 16 * nb);
    f32x4 g = {1.f, 1.f, 1.f, 1.f}; if (kgain) g = *(const GAS f32x4*)(kgain + k);
#pragma unroll
    for (int nb = 0; nb < 4; ++nb) { const f32x4 a = r[nb][0] * g.x, b = r[nb][1] * g.y, c = r[nb][2] * g.z, d = r[nb][3] * g.w;
        bf16* o = WT + (size_t)(dn0 + nl + 16 * nb) * K + k;
        v2u w; w.x = pk2(a.x, b.x); w.y = pk2(c.x, d.x); *(GAS v2u*)o = w;
        w.x = pk2(a.y, b.y); w.y = pk2(c.y, d.y); *(GAS v2u*)(o + K) = w;
        w.x = pk2(a.z, b.z); w.y = pk2(c.z, d.z); *(GAS v2u*)(o + 2 * (size_t)K) = w;
        w.x = pk2(a.w, b.w); w.y = pk2(c.w, d.w); *(GAS v2u*)(o + 3 * (size_t)K) = w; }
}
__device__ __forceinline__ void rms_row4_bf16(const float* x0_, const float* gain, bf16* o0, int lane) {
    f32x4 v[4][4]; float s[4];
#pragma unroll
    for (int r = 0; r < 4; ++r)
#pragma unroll
        for (int j = 0; j < 4; ++j) v[r][j] = ((const GAS f32x4*)(x0_ + (size_t)r * DM))[lane + 64 * j];
#pragma unroll
    for (int r = 0; r < 4; ++r) { s[r] = 0.f;
#pragma unroll
        for (int j = 0; j < 4; ++j) s[r] += (v[r][j].x * v[r][j].x + v[r][j].y * v[r][j].y) + (v[r][j].z * v[r][j].z + v[r][j].w * v[r][j].w); }
#pragma unroll
    for (int o = 1; o < 64; o <<= 1) { s[0] += __shfl_xor(s[0], o); s[1] += __shfl_xor(s[1], o); s[2] += __shfl_xor(s[2], o); s[3] += __shfl_xor(s[3], o); }
#pragma unroll
    for (int r = 0; r < 4; ++r) s[r] = __builtin_amdgcn_rsqf(s[r] * (1.0f / DM) + EPS);
#pragma unroll
    for (int j = 0; j < 4; ++j) { const f32x4 g = ((const GAS f32x4*)gain)[lane + 64 * j];
#pragma unroll
        for (int r = 0; r < 4; ++r) { const float rs = s[r];
            v2u w; w.x = pk2(v[r][j].x * rs * g.x, v[r][j].y * rs * g.y); w.y = pk2(v[r][j].z * rs * g.z, v[r][j].w * rs * g.w); ((GAS v2u*)(o0 + (size_t)r * DM))[lane + 64 * j] = w; } }
}

__device__ __forceinline__ void s5_tables_item(Frame& F, int item);
__device__ __forceinline__ void p0_prologue(Frame& F) {
    const int gw = F.bid * NWAVES + F.wave, NGW = F.G * NWAVES;
    bf16* XN = (bf16*)(F.ws + WS_XN);
    STAMP(0);
    for (int m = 4 * gw; m < MTOK; m += 4 * NGW) rms_row4_bf16(xrow(F, m), F.in[6], XN + (size_t)m * DM, F.lane);
    STAMP(1);
#if REP_XN == 2
    for (int m = 4 * gw; m < MTOK; m += 4 * NGW) rms_row4_bf16(xrow(F, m), F.in[6], XN + (size_t)m * DM, F.lane);
#endif
    bf16* WinT = (bf16*)(F.ws + WS_WIN);
    constexpr int I_IN = (DM / 64) * (INC / 64);
    for (int r = gw; r < I_IN; r += NGW) { const int nblk = INC / 64, kb = r / nblk, nb = r % nblk, sn0 = nb * 64; const int seg = sn0 / 512, off = sn0 % 512;
        const int dseg = seg == 0 ? 0 : seg == 1 ? 1 : seg == 2 ? 4 : seg == 3 ? 2 : 3;
        transpose_item(F.in[7], INC, WinT, DM, kb * 64, sn0, dseg * 512 + off, F.lane); }
    STAMP(2);
    for (int it = F.bid; it < 256; it += F.G) s5_tables_item(F, it);
    STAMP(3);
}

template <int PART> __device__ __forceinline__ void deferred_transposes(Frame& F, int gw, int ngw) {
    bf16* WgluT = (bf16*)(F.ws + WS_WGLU); bf16* WoutT = (bf16*)(F.ws + WS_WOUT); bf16* WguT = (bf16*)(F.ws + WS_WGU); bf16* WdT = (bf16*)(F.ws + WS_WD);
    constexpr int I_GLU = (S5W / 64) * (S5W / 64), I_OUT = (DM / 64) * (DM / 64), I_G = (DM / 64) * (DFF / 64), I_D = (DFF / 64) * (DM / 64);
    constexpr int N0 = I_GLU + I_OUT + 2 * I_G, NITEMS = (PART == 0) ? N0 : I_D;
    for (int it = gw; it < NITEMS; it += ngw) {
        int r = (PART == 0) ? it : it + N0;
        if (r < I_GLU) { const int nblk = S5W / 64, kb = r / nblk, nb = r % nblk; transpose_item(F.in[16], S5W, WgluT, S5W, kb * 64, nb * 64, nb * 64, F.lane); continue; } r -= I_GLU;
        if (r < I_OUT) { const int nblk = DM / 64, kb = r / nblk, nb = r % nblk; transpose_item(F.in[18], DM, WoutT, DM, kb * 64, nb * 64, nb * 64, F.lane); continue; } r -= I_OUT;
        if (r < I_G) { const int nblk = DFF / 64, kb = r / nblk, nb = r % nblk, sn0 = nb * 64; transpose_item(F.in[20], DFF, WguT, DM, kb * 64, sn0, 256 * (sn0 / 128) + (sn0 % 128), F.lane, F.in[19]); continue; } r -= I_G;
        if (r < I_G) { const int nblk = DFF / 64, kb = r / nblk, nb = r % nblk, sn0 = nb * 64; transpose_item(F.in[21], DFF, WguT, DM, kb * 64, sn0, 256 * (sn0 / 128) + 128 + (sn0 % 128), F.lane, F.in[19]); continue; } r -= I_G;
        { const int nblk = DM / 64, kb = r / nblk, nb = r % nblk; transpose_item(F.in[22], DM, WdT, DFF, kb * 64, nb * 64, nb * 64, F.lane); }
    }
}

using pg8::Unit; using pg8::u32x4; using pg8::cvt_pk_bf16; using pg8::BM; using pg8::HALF;
__device__ __forceinline__ LAS unsigned char* epi_slot(LAS unsigned char* W, int r, int s) { return W + r * 128 + ((s ^ (r & 7)) << 4); }
struct EpiIn {
    static constexpr bool PERM = true, AFTER_DRAIN = false;
    bf16* PB; float* FZ; bf16* U5;
    __device__ __forceinline__ void operator()(const pg8::f32x4 (&acc)[2][2][4][2], const Unit& u, int wr, int wc, int fr, int fq) const {
        const int row0 = u.pm * BM + wr * 64 + fr;
        if (u.pn < 2) { const int col0 = u.pn * BM + wc * 32 + 8 * fq;
#pragma unroll
            for (int ai = 0; ai < 2; ++ai)
#pragma unroll
                for (int m = 0; m < 4; ++m) { const size_t r = (size_t)(row0 + ai * HALF + m * 16);
#pragma unroll
                    for (int bj = 0; bj < 2; ++bj) { const int col = col0 + bj * HALF; const pg8::f32x4 v0 = acc[ai][bj][m][0], v1 = acc[ai][bj][m][1]; u32x4 w; w.x = cvt_pk_bf16(v0[0], v0[1]); w.y = cvt_pk_bf16(v0[2], v0[3]); w.z = cvt_pk_bf16(v1[0], v1[1]); w.w = cvt_pk_bf16(v1[2], v1[3]);
                        *(u32x4*)(U5 + ((size_t)(col >> 4) * MTOK + r) * 16 + (col & 15)) = w; } }
        } else if (u.pn < 8) { const int col0 = u.pn * BM + wc * 32 + 8 * fq;
#pragma unroll
            for (int ai = 0; ai < 2; ++ai)
#pragma unroll
                for (int m = 0; m < 4; ++m) { bf16* rowp = PB + (size_t)(row0 + ai * HALF + m * 16) * PBW + col0;
#pragma unroll
                    for (int bj = 0; bj < 2; ++bj) { const pg8::f32x4 v0 = acc[ai][bj][m][0], v1 = acc[ai][bj][m][1]; u32x4 w; w.x = cvt_pk_bf16(v0[0], v0[1]); w.y = cvt_pk_bf16(v0[2], v0[3]); w.z = cvt_pk_bf16(v1[0], v1[1]); w.w = cvt_pk_bf16(v1[2], v1[3]);
                        *(u32x4*)(rowp + bj * HALF) = w; } }
        } else { const int col0 = (u.pn - 8) * BM + wc * 32 + 8 * fq;
#pragma unroll
            for (int ai = 0; ai < 2; ++ai)
#pragma unroll
                for (int m = 0; m < 4; ++m) { float* rowp = FZ + (size_t)(row0 + ai * HALF + m * 16) * 512 + col0;
#pragma unroll
                    for (int bj = 0; bj < 2; ++bj)
#pragma unroll
                        for (int n = 0; n < 2; ++n) *(pg8::f32x4*)(rowp + bj * HALF + 4 * n) = acc[ai][bj][m][n]; }
        }
    }
};
struct EpiGlu {
    static constexpr bool PERM = true, AFTER_DRAIN = false;
    const bf16* GY; bf16* MIX;
    __device__ __forceinline__ void operator()(const pg8::f32x4 (&acc)[2][2][4][2], const Unit& u, int wr, int wc, int fr, int fq) const {
        const int row0 = u.pm * BM + wr * 64 + fr, col0 = u.pn * BM + wc * 32 + 8 * fq;
#pragma unroll
        for (int ai = 0; ai < 2; ++ai)
#pragma unroll
            for (int m = 0; m < 4; ++m) { const size_t r = (size_t)(row0 + ai * HALF + m * 16);
#pragma unroll
                for (int bj = 0; bj < 2; ++bj) { const int col = col0 + bj * HALF; const u32x4 g = *(const u32x4*)(GY + ((size_t)(col >> 4) * MTOK + r) * 16 + (col & 15)); const pg8::f32x4 v0 = acc[ai][bj][m][0], v1 = acc[ai][bj][m][1];
                    u32x4 w; w.x = cvt_pk_bf16(bflo(g.x) * sigmoidf_(v0[0]), bfhi(g.x) * sigmoidf_(v0[1])); w.y = cvt_pk_bf16(bflo(g.y) * sigmoidf_(v0[2]), bfhi(g.y) * sigmoidf_(v0[3]));
                    w.z = cvt_pk_bf16(bflo(g.z) * sigmoidf_(v1[0]), bfhi(g.z) * sigmoidf_(v1[1])); w.w = cvt_pk_bf16(bflo(g.w) * sigmoidf_(v1[2]), bfhi(g.w) * sigmoidf_(v1[3]));
                    *(u32x4*)(MIX + r * DM + col0 + bj * HALF) = w; } }
    }
};
__device__ __forceinline__ float rstd_of(float ss) { return __builtin_amdgcn_rsqf(ss * (1.0f / DM) + EPS); }
__device__ __forceinline__ float atomic_read_f32(float* p) { return __hip_atomic_fetch_add(p, 0.0f, __ATOMIC_RELAXED, __HIP_MEMORY_SCOPE_AGENT); }
__device__ __forceinline__ void wait_count(unsigned* cnt, unsigned want) {
    for (unsigned sp = 0; sp < (1u << 22); ++sp) { if (__hip_atomic_load(cnt, __ATOMIC_RELAXED, __HIP_MEMORY_SCOPE_AGENT) >= want) break; __builtin_amdgcn_s_sleep(2); }
}
struct EpiOut {
    static constexpr bool PERM = true, AFTER_DRAIN = false;
    const float* xp; bf16* XN; float* SS1;
    __device__ __forceinline__ void operator()(const pg8::f32x4 (&acc)[2][2][4][2], const Unit& u, int wr, int wc, int fr, int fq) const {
        const int row0 = u.pm * BM + wr * 64 + fr, col0 = u.pn * BM + wc * 32 + 8 * fq;
#pragma unroll
        for (int ai = 0; ai < 2; ++ai)
#pragma unroll
            for (int m = 0; m < 4; ++m) { const int row = row0 + ai * HALF + m * 16; const size_t off = (size_t)row * DM + col0; float ss = 0.f;
#pragma unroll
                for (int bj = 0; bj < 2; ++bj) { const pg8::f32x4 x0 = *(const pg8::f32x4*)(xp + off + bj * HALF) + acc[ai][bj][m][0], x1 = *(const pg8::f32x4*)(xp + off + bj * HALF + 4) + acc[ai][bj][m][1];
                    ss += (x0[0] * x0[0] + x0[1] * x0[1]) + (x0[2] * x0[2] + x0[3] * x0[3]) + (x1[0] * x1[0] + x1[1] * x1[1]) + (x1[2] * x1[2] + x1[3] * x1[3]);
                    u32x4 w; w.x = cvt_pk_bf16(x0[0], x0[1]); w.y = cvt_pk_bf16(x0[2], x0[3]); w.z = cvt_pk_bf16(x1[0], x1[1]); w.w = cvt_pk_bf16(x1[2], x1[3]);
                    *(u32x4*)(XN + off + bj * HALF) = w; }
                ss += __shfl_xor(ss, 16); ss += __shfl_xor(ss, 32);
                if (fq == 0) __hip_atomic_fetch_add(SS1 + row, ss, __ATOMIC_RELAXED, __HIP_MEMORY_SCOPE_AGENT); }
    }
};
struct EpiAct {
    static constexpr bool PERM = true, AFTER_DRAIN = false;
    bf16* ACT; const float* SS1; LAS unsigned char* scr;
    __device__ __forceinline__ void operator()(const pg8::f32x4 (&acc)[2][2][4][2], const Unit& u, int wr, int wc, int fr, int fq) const {
        const int row0 = u.pm * BM + wr * 64, lane = fr + 16 * fq, rr = lane >> 2, sl = lane & 3;
        LAS unsigned char* W = scr + (wr * 4 + wc) * 2048;
        bf16* outp = ACT + (size_t)(row0 + rr) * DFF + u.pn * HALF + wc * 32 + sl * 8;
#pragma unroll
        for (int ai = 0; ai < 2; ++ai)
#pragma unroll
            for (int m = 0; m < 4; ++m) { const int rg = ai * HALF + m * 16; const float rs = rstd_of(SS1[row0 + rg + fr]);
                const pg8::f32x4 g0 = acc[ai][0][m][0] * rs, g1 = acc[ai][0][m][1] * rs, u0 = acc[ai][1][m][0] * rs, u1 = acc[ai][1][m][1] * rs;
                u32x4 w; w.x = cvt_pk_bf16(siluf_(g0[0]) * u0[0], siluf_(g0[1]) * u0[1]); w.y = cvt_pk_bf16(siluf_(g0[2]) * u0[2], siluf_(g0[3]) * u0[3]);
                w.z = cvt_pk_bf16(siluf_(g1[0]) * u1[0], siluf_(g1[1]) * u1[1]); w.w = cvt_pk_bf16(siluf_(g1[2]) * u1[2], siluf_(g1[3]) * u1[3]);
                *(LAS u32x4*)epi_slot(W, fr, fq + 4 * (m & 1)) = w;
                const u32x4 o = *(const LAS u32x4*)epi_slot(W, rr, sl + 4 * (m & 1));
                *(u32x4*)(outp + (size_t)rg * DFF) = o; }
    }
};
struct EpiDown {
    static constexpr bool PERM = true, AFTER_DRAIN = false;
    const bf16* X1; const float* gain; float* SS2; unsigned* cnt; float* YO;
    __device__ __forceinline__ void operator()(pg8::f32x4 (&acc)[2][2][4][2], const Unit& u, int wr, int wc, int fr, int fq) const {
        const int row0 = u.pm * BM + wr * 64 + fr, col0 = u.pn * BM + wc * 32 + 8 * fq;
#pragma unroll
        for (int ai = 0; ai < 2; ++ai)
#pragma unroll
            for (int m = 0; m < 4; ++m) { const int row = row0 + ai * HALF + m * 16; const size_t off = (size_t)row * DM + col0; float ss = 0.f;
#pragma unroll
                for (int bj = 0; bj < 2; ++bj) { const u32x4 xb = *(const u32x4*)(X1 + off + bj * HALF);
                    const pg8::f32x4 x0 = (pg8::f32x4){bflo(xb.x), bfhi(xb.x), bflo(xb.y), bfhi(xb.y)} + acc[ai][bj][m][0], x1 = (pg8::f32x4){bflo(xb.z), bfhi(xb.z), bflo(xb.w), bfhi(xb.w)} + acc[ai][bj][m][1];
                    acc[ai][bj][m][0] = x0; acc[ai][bj][m][1] = x1;
                    ss += (x0[0] * x0[0] + x0[1] * x0[1]) + (x0[2] * x0[2] + x0[3] * x0[3]) + (x1[0] * x1[0] + x1[1] * x1[1]) + (x1[2] * x1[2] + x1[3] * x1[3]); }
                ss += __shfl_xor(ss, 16); ss += __shfl_xor(ss, 32);
                if (fq == 0) __hip_atomic_fetch_add(SS2 + row, ss, __ATOMIC_RELAXED, __HIP_MEMORY_SCOPE_AGENT); }
        asm volatile("s_waitcnt vmcnt(0)" ::: "memory");
        unsigned* c = cnt + 64 * u.pm;
        if (threadIdx.x % 64 == 0) __hip_atomic_fetch_add(c, 1u, __ATOMIC_RELAXED, __HIP_MEMORY_SCOPE_AGENT);
        wait_count(c, 32u);
        pg8::f32x4 gn[2][2];
#pragma unroll
        for (int bj = 0; bj < 2; ++bj)
#pragma unroll
            for (int n = 0; n < 2; ++n) gn[bj][n] = *(const pg8::f32x4*)(gain + col0 + bj * HALF + 4 * n);
        float rs[2][4];
#pragma unroll
        for (int ai = 0; ai < 2; ++ai)
#pragma unroll
            for (int m = 0; m < 4; ++m) { float s = 0.f; if (fq == 0) s = atomic_read_f32(SS2 + row0 + ai * HALF + m * 16); rs[ai][m] = rstd_of(__shfl(s, fr)); }
#pragma unroll
        for (int ai = 0; ai < 2; ++ai)
#pragma unroll
            for (int m = 0; m < 4; ++m) { const size_t off = (size_t)(row0 + ai * HALF + m * 16) * DM + col0;
#pragma unroll
                for (int bj = 0; bj < 2; ++bj) { *(pg8::f32x4*)(YO + off + bj * HALF) = acc[ai][bj][m][0] * rs[ai][m] * gn[bj][0]; *(pg8::f32x4*)(YO + off + bj * HALF + 4) = acc[ai][bj][m][1] * rs[ai][m] * gn[bj][1]; } }
    }
};

typedef float f32x16 __attribute__((ext_vector_type(16)));
typedef short s16x8 __attribute__((ext_vector_type(8)));
constexpr size_t WS_U5 = WS_OH, WS_T5 = 231 * MiB;
constexpr size_t T5_STRIDE = 73728, T5_VG = 32768, T5_KC = 65536;
constexpr int S5_LD = 136;
__device__ __forceinline__ void s5_tables_item(Frame& F, int item) {
    const int tid = F.tid, g = item >> 3, part = item & 7;
    LAS float* Pre = (LAS float*)F.lds; LAS float* Pim = Pre + 9 * 64; LAS float* Ff = Pim + 9 * 64;
    LAS float* Cre = Ff + 128, * Cim = Cre + 1024, * Bre = Cim + 1024, * Bim = Bre + 1024;
    if (tid < 64) { const int n = tid;
        const float a_re = F.in[8][g * S5N + n], a_im = F.in[9][g * S5N + n], dt = expf(F.in[10][g]);
        const float mag = expf(a_re * dt), ab_re = mag * cosf(a_im * dt), ab_im = mag * sinf(a_im * dt);
        const float den = a_re * a_re + a_im * a_im, nr = ab_re - 1.0f, ni = ab_im;
        Ff[n] = (nr * a_re + ni * a_im) / den; Ff[64 + n] = (ni * a_re - nr * a_im) / den;
        float pr = 1.f, pi = 0.f;
#pragma unroll
        for (int j = 0; j < 9; ++j) { Pre[j * 64 + n] = pr; Pim[j * 64 + n] = pi; const float t = pr * ab_re - pi * ab_im; pi = pr * ab_im + pi * ab_re; pr = t; }
    }
    __syncthreads();
#pragma unroll
    for (int i = 0; i < 2; ++i) { const int idx = tid + 512 * i;
        { const int c = idx >> 6, n = idx & 63; Cre[c * 64 + n] = F.in[13][(size_t)(g * 16 + c) * S5N + n]; Cim[c * 64 + n] = F.in[14][(size_t)(g * 16 + c) * S5N + n]; }
        { const int n = idx >> 4, c = idx & 15; const float br = F.in[11][(size_t)(g * S5N + n) * 16 + c], bi = F.in[12][(size_t)(g * S5N + n) * 16 + c], fr = Ff[n], fi = Ff[64 + n];
          Bre[n * 16 + c] = fr * br - fi * bi; Bim[n * 16 + c] = fr * bi + fi * br; } }
    __syncthreads();
    bf16* WG = (bf16*)(F.ws + WS_T5 + (size_t)g * T5_STRIDE); bf16* VG = (bf16*)(F.ws + WS_T5 + (size_t)g * T5_STRIDE + T5_VG); bf16* KC = (bf16*)(F.ws + WS_T5 + (size_t)g * T5_STRIDE + T5_KC);
    if (tid < 256) { const int j = part, c = tid >> 4, cp = tid & 15; float acc = 0.f;
#pragma unroll 4
        for (int n = 0; n < 64; ++n) { const float cr = Cre[c * 64 + n], ci = Cim[c * 64 + n], pr = Pre[j * 64 + n], pi = Pim[j * 64 + n];
            const float xr = cr * pr - ci * pi, xi = cr * pi + ci * pr; acc += xr * Bre[n * 16 + cp] - xi * Bim[n * 16 + cp]; }
        KC[j * 256 + tid] = (bf16)f2bf(acc);
    } else if (part == 0) KC[2048 + tid - 256] = 0;
#pragma unroll
    for (int i = 0; i < 4; ++i) { const int idx = tid + 512 * i, np = 16 * part + (idx >> 7), k = idx & 127, s = k >> 4, cp = k & 15, n = np & 63;
        const float pr = Pre[(7 - s) * 64 + n], pi = Pim[(7 - s) * 64 + n], br = Bre[n * 16 + cp], bi = Bim[n * 16 + cp];
        WG[np * 128 + k] = (bf16)f2bf(np < 64 ? pr * br - pi * bi : pr * bi + pi * br); }
#pragma unroll
    for (int i = 0; i < 4; ++i) { const int idx = tid + 512 * i, col = 16 * part + (idx >> 7), np = idx & 127, t = col >> 4, c = col & 15, n = np & 63;
        const float pr = Pre[(t + 1) * 64 + n], pi = Pim[(t + 1) * 64 + n], cr = Cre[c * 64 + n], ci = Cim[c * 64 + n];
        VG[col * 128 + np] = (bf16)f2bf(np < 64 ? cr * pr - ci * pi : -(cr * pi + ci * pr)); }
    __syncthreads();
}
constexpr int L5_WG = 0, L5_VG = 34816, L5_KC = 69632, L5_U = 74240, L5_HS = 91648, L5_HL = 109056, L5_L8 = 141824;
__device__ __forceinline__ void s5_item(Frame& F, int item) {
    const int tid = F.tid, lane = F.lane, wave = F.wave;
    const int g = item & 31, b8 = item >> 5;
    LAS bf16* WgT = (LAS bf16*)(F.lds + L5_WG); LAS bf16* VgT = (LAS bf16*)(F.lds + L5_VG); LAS bf16* Kc = (LAS bf16*)(F.lds + L5_KC);
    LAS bf16* Us = (LAS bf16*)(F.lds + L5_U); LAS bf16* HS = (LAS bf16*)(F.lds + L5_HS); LAS float* HL = (LAS float*)(F.lds + L5_HL); LAS float* L8 = (LAS float*)(F.lds + L5_L8);
    LAS bf16* YS = (LAS bf16*)(F.lds + L5_HL);
    const bf16* U5 = (const bf16*)(F.ws + WS_U5) + (size_t)g * MTOK * 16; bf16* GY = (bf16*)(F.ws + WS_GY) + (size_t)g * MTOK * 16;
    { const bf16* WG = (const bf16*)(F.ws + WS_T5 + (size_t)g * T5_STRIDE); const bf16* VG = WG + T5_VG / 2; const bf16* KC = WG + T5_KC / 2;
#pragma unroll
      for (int i = 0; i < 4; ++i) { const int p = tid + 512 * i, r = p >> 4, kg = (p & 15) * 8; *(LAS v4u*)(WgT + r * S5_LD + kg) = *(const v4u*)(WG + r * 128 + kg); *(LAS v4u*)(VgT + r * S5_LD + kg) = *(const v4u*)(VG + r * 128 + kg); }
      if (tid < 288) *(LAS v4u*)(Kc + tid * 8) = *(const v4u*)(KC + tid * 8); }
    float qr[9], qi[9];
    { const float a_re = F.in[8][g * S5N + lane], a_im = F.in[9][g * S5N + lane], dt = expf(F.in[10][g]);
      const float mag = expf(a_re * dt); float p8r = mag * cosf(a_im * dt), p8i = mag * sinf(a_im * dt);
#pragma unroll
      for (int i = 0; i < 3; ++i) { const float t = p8r * p8r - p8i * p8i; p8i = 2.0f * p8r * p8i; p8r = t; }
      qr[0] = 1.f; qi[0] = 0.f;
#pragma unroll
      for (int i = 1; i < 9; ++i) { qr[i] = qr[i - 1] * p8r - qi[i - 1] * p8i; qi[i] = qr[i - 1] * p8i + qi[i - 1] * p8r; } }
    const float dl = F.in[15][g * 16 + (lane & 15)];
    const int rb = wave >> 2, cb = wave & 3, r32 = lane & 31, hh = lane >> 5;
    float h_re = 0.f, h_im = 0.f;
    float sre[2], sim[2];
#pragma unroll
    for (int i = 0; i < 2; ++i) { const size_t idx = (size_t)((16 * b8 + 2 * wave + i) * S5G + g) * S5N + lane; sre[i] = F.in[2][idx]; sim[i] = F.in[3][idx]; }
    v4u ua[5], ub[4];
#pragma unroll
    for (int s = 0; s < 4; ++s) { const v4u* src = (const v4u*)(U5 + (size_t)(b8 * PB_T + s * 512) * 16); ua[s] = src[tid]; ub[s] = src[tid + 512]; }
    { const v4u* src = (const v4u*)(U5 + (size_t)(MP + 128 * b8) * 16); ua[4] = src[tid & 255]; }
    STAMP(9);
    for (int seg = 0; seg < 5; ++seg) {
        if (seg == 1) STAMP(10);
        if (seg == 4) STAMP(11);
        const bool samp = (seg == 4);
        const int tok0 = samp ? MP + 128 * b8 : b8 * PB_T + seg * 512;
        { const int p0 = tid, p1 = tid + 512;
          v4u x0 = ua[0], x1 = ub[0];
          if (seg == 1) { x0 = ua[1]; x1 = ub[1]; } else if (seg == 2) { x0 = ua[2]; x1 = ub[2]; } else if (seg == 3) { x0 = ua[3]; x1 = ub[3]; } else if (seg == 4) { x0 = ua[4]; }
          *(LAS v4u*)(Us + (p0 >> 4) * S5_LD + ((p0 >> 1) & 7) * 16 + (p0 & 1) * 8) = x0; if (seg < 4) *(LAS v4u*)(Us + (p1 >> 4) * S5_LD + ((p1 >> 1) & 7) * 16 + (p1 & 1) * 8) = x1; }
        __syncthreads();
        { f32x16 acc = {};
#pragma unroll
          for (int s = 0; s < 8; ++s) { const s16x8 a = *(const LAS s16x8*)(Us + (32 * rb + r32) * S5_LD + s * 16 + 8 * hh); const s16x8 b = *(const LAS s16x8*)(WgT + (32 * cb + r32) * S5_LD + s * 16 + 8 * hh);
              acc = __builtin_amdgcn_mfma_f32_32x32x16_bf16(a, b, acc, 0, 0, 0); }
#pragma unroll
          for (int r = 0; r < 16; ++r) HL[(32 * rb + (r & 3) + 8 * (r >> 2) + 4 * hh) * 128 + 32 * cb + r32] = acc[r]; }
        __syncthreads();
        if (!samp) {
            float xr[8], xi[8], lr[9], li[9];
#pragma unroll
            for (int i = 0; i < 8; ++i) { xr[i] = HL[(8 * wave + i) * 128 + lane]; xi[i] = HL[(8 * wave + i) * 128 + 64 + lane]; }
            lr[0] = 0.f; li[0] = 0.f;
#pragma unroll
            for (int i = 0; i < 8; ++i) { lr[i + 1] = qr[1] * lr[i] - qi[1] * li[i] + xr[i]; li[i + 1] = qr[1] * li[i] + qi[1] * lr[i] + xi[i]; }
            L8[wave * 128 + lane] = lr[8]; L8[wave * 128 + 64 + lane] = li[8];
            __syncthreads();
            float cr = h_re, ci = h_im, mr = h_re, mi = h_im;
#pragma unroll
            for (int w = 0; w < 8; ++w) { const float tr = L8[w * 128 + lane], ti = L8[w * 128 + 64 + lane];
                const float nr = qr[8] * cr - qi[8] * ci + tr, ni = qr[8] * ci + qi[8] * cr + ti; cr = nr; ci = ni; if (w + 1 == wave) { mr = cr; mi = ci; } }
            h_re = cr; h_im = ci;
#pragma unroll
            for (int i = 0; i < 8; ++i) { const float sr = lr[i] + qr[i] * mr - qi[i] * mi, si = li[i] + qr[i] * mi + qi[i] * mr;
                HS[(8 * wave + i) * S5_LD + lane] = (bf16)f2bf(sr); HS[(8 * wave + i) * S5_LD + 64 + lane] = (bf16)f2bf(si); }
            if (seg == 3 && wave == 0) { F.out[O_PRE + (size_t)(b8 * S5G + g) * S5N + lane] = h_re; F.out[O_PIM + (size_t)(b8 * S5G + g) * S5N + lane] = h_im; }
        } else {
#pragma unroll
            for (int i = 0; i < 2; ++i) { const int r = 2 * wave + i; const size_t idx = (size_t)((16 * b8 + r) * S5G + g) * S5N + lane;
                HS[r * S5_LD + lane] = (bf16)f2bf(sre[i]); HS[r * S5_LD + 64 + lane] = (bf16)f2bf(sim[i]);
                F.out[O_SRE + idx] = qr[1] * sre[i] - qi[1] * sim[i] + HL[r * 128 + lane]; F.out[O_SIM + idx] = qr[1] * sim[i] + qi[1] * sre[i] + HL[r * 128 + 64 + lane]; }
        }
        __syncthreads();
        if (!(samp && rb == 1)) { f32x16 acc = {};
            const int tl = 2 * cb + ((lane >> 4) & 1), c = lane & 15;
#pragma unroll
            for (int s = 0; s < 8; ++s) if (s <= 2 * cb + 1) { const int j = tl - s, jj = j < 0 ? 8 : j;
                const s16x8 a = *(const LAS s16x8*)(Us + (32 * rb + r32) * S5_LD + s * 16 + 8 * hh); const s16x8 b = *(const LAS s16x8*)(Kc + (jj * 16 + c) * 16 + 8 * hh);
                acc = __builtin_amdgcn_mfma_f32_32x32x16_bf16(a, b, acc, 0, 0, 0); }
#pragma unroll
            for (int kb = 0; kb < 8; ++kb) { const s16x8 a = *(const LAS s16x8*)(HS + (32 * rb + r32) * S5_LD + kb * 16 + 8 * hh); const s16x8 b = *(const LAS s16x8*)(VgT + (32 * cb + r32) * S5_LD + kb * 16 + 8 * hh);
                acc = __builtin_amdgcn_mfma_f32_32x32x16_bf16(a, b, acc, 0, 0, 0); }
#pragma unroll
            for (int r = 0; r < 16; ++r) { const int row = 32 * rb + (r & 3) + 8 * (r >> 2) + 4 * hh;
                const float u = bf2f(Us[row * S5_LD + tl * 16 + c]); YS[row * 128 + 32 * cb + r32] = (bf16)f2bf(gelu_tanh(acc[r] + dl * u)); }
        }
        __syncthreads();
        { v4u* dst = (v4u*)(GY + (size_t)tok0 * 16);
          if (!samp) { dst[tid] = *(const LAS v4u*)(YS + tid * 8); dst[tid + 512] = *(const LAS v4u*)(YS + (tid + 512) * 8); }
          else if (tid < 256) dst[tid] = *(const LAS v4u*)(YS + tid * 8); }
    }
    __syncthreads();
}
typedef float f32x4v __attribute__((ext_vector_type(4)));
constexpr int HG_LDQ = 136, HG_LDT = 72;
constexpr size_t WS_DSC = WS_XN;
constexpr size_t WS_DEC = WS_CTL + 1 * MiB;
struct HgRaw { float fz[16]; unsigned short q[16]; v4u v0, v1; };
template <bool NEEDQ> __device__ __forceinline__ void hg_load_raw(HgRaw& R, const bf16* PB, const float* FZ, int item, int tid) {
    const int bh = item >> 5, chunk = item & 31, b = bh >> 2, h = bh & 3, tok0 = b * PB_T + chunk * 64, ch = tid & 127, tq = tid >> 7, col = h * HD + ch;
#pragma unroll
    for (int i = 0; i < 16; ++i) { const size_t tok = (size_t)(tok0 + 16 * tq + i); R.fz[i] = FZ[tok * 512 + col]; if (NEEDQ) R.q[i] = PB[tok * PBW + 512 + col]; }
    { const int p = tid, vg = p >> 6, tk = p & 63; R.v0 = *(const v4u*)(PB + (size_t)(tok0 + tk) * PBW + 1024 + h * HD + vg * 8); }
    { const int p = tid + 512, vg = p >> 6, tk = p & 63; R.v1 = *(const v4u*)(PB + (size_t)(tok0 + tk) * PBW + 1024 + h * HD + vg * 8); }
}
#define HG_GATES_R(R) \
    float gl[16], kk[16]; float run = 0.f; \
    _Pragma("unroll") for (int i = 0; i < 16; ++i) { const float sg = __builtin_amdgcn_rcpf(1.0f + __builtin_amdgcn_exp2f(-1.4426950408889634f * R.fz[i])), f = lb + (1.0f - lb) * sg; kk[i] = 1.0f - f; run += __log2f(f); gl[i] = run; } \
    TOT[tq * 128 + ch] = run;
#define HG_VT_STORE(R) \
    { const int vg = tid >> 6, tk = tid & 63; LAS bf16* d = Vt + (vg * 8) * HG_LDT + tk; const v4u w = R.v0; d[0] = (bf16)(w.x & 0xffffu); d[HG_LDT] = (bf16)(w.x >> 16); d[2 * HG_LDT] = (bf16)(w.y & 0xffffu); d[3 * HG_LDT] = (bf16)(w.y >> 16); \
        d[4 * HG_LDT] = (bf16)(w.z & 0xffffu); d[5 * HG_LDT] = (bf16)(w.z >> 16); d[6 * HG_LDT] = (bf16)(w.w & 0xffffu); d[7 * HG_LDT] = (bf16)(w.w >> 16); } \
    { const int vg = (tid + 512) >> 6, tk = tid & 63; LAS bf16* d = Vt + (vg * 8) * HG_LDT + tk; const v4u w = R.v1; d[0] = (bf16)(w.x & 0xffffu); d[HG_LDT] = (bf16)(w.x >> 16); d[2 * HG_LDT] = (bf16)(w.y & 0xffffu); d[3 * HG_LDT] = (bf16)(w.y >> 16); \
        d[4 * HG_LDT] = (bf16)(w.z & 0xffffu); d[5 * HG_LDT] = (bf16)(w.z >> 16); d[6 * HG_LDT] = (bf16)(w.w & 0xffffu); d[7 * HG_LDT] = (bf16)(w.w >> 16); }

constexpr int LA_QS = 0, LA_KS = 17408, LA_KT = 34816, LA_VT = 53248, LA_AT = 71680, LA_TOT = 80896;
constexpr size_t OQ_QH = 0, OQ_OI = 4194304;
__device__ __forceinline__ void hgA_loop(Frame& F, int j0, int j1) {
    const int tid = F.tid, lane = F.lane, wave = F.wave;
    LAS bf16* Qs = (LAS bf16*)(F.lds + LA_QS); LAS bf16* Ks = (LAS bf16*)(F.lds + LA_KS); LAS bf16* Kt = (LAS bf16*)(F.lds + LA_KT); LAS bf16* Vt = (LAS bf16*)(F.lds + LA_VT);
    LAS bf16* At = (LAS bf16*)(F.lds + LA_AT); LAS float* TOT = (LAS float*)(F.lds + LA_TOT);
    const bf16* PB = (const bf16*)(F.ws + WS_PB); const float* FZ = (const float*)(F.ws + WS_FZ);
    const int ch = tid & 127, tq = tid >> 7, r32 = lane & 31, hh = lane >> 5;
    const int iend = (F.bid + j1 * F.G < 1024) ? F.bid + j1 * F.G : 1024;
    int item = F.bid + j0 * F.G; if (item >= iend) return;
    HgRaw R; hg_load_raw<true>(R, PB, FZ, item, tid);
    for (; item < iend; item += F.G) {
        const int bh = item >> 5, h = bh & 3, col = h * HD + ch;
        bf16* DSC = (bf16*)(F.ws + WS_DSC) + (size_t)item * HD * HD; float* DEC = (float*)(F.ws + WS_DEC) + (size_t)item * HD;
        bf16* QH = (bf16*)(F.out + O_Y + OQ_QH) + (size_t)item * 64 * HD; bf16* OI = (bf16*)(F.out + O_Y + OQ_OI) + (size_t)item * 8192;
        const float lb = 1.0f / (1.0f + __expf(F.in[5][512 + col] - F.in[5][col]));
        HG_GATES_R(R)
        float qq[16];
#pragma unroll
        for (int i = 0; i < 16; ++i) qq[i] = bf2f(R.q[i]);
        HG_VT_STORE(R)
        if (item + F.G < iend) hg_load_raw<true>(R, PB, FZ, item + F.G, tid);
        __syncthreads();
        { const float t0 = TOT[ch], t1 = TOT[128 + ch], t2 = TOT[256 + ch], t3 = TOT[384 + ch];
          const float gref = t0 + t1, glast = gref + (t2 + t3), off = (tq == 0 ? 0.f : tq == 1 ? t0 : tq == 2 ? gref : gref + t2);
          const float cS = __builtin_amdgcn_exp2f(gref), cK = __builtin_amdgcn_exp2f(glast - gref);
          unsigned kp[8];
#pragma unroll
          for (int i = 0; i < 16; ++i) { const float e1 = __builtin_amdgcn_exp2f(off + gl[i] - gref), e2 = __builtin_amdgcn_rcpf(e1), qs = qq[i] * e1, ks = kk[i] * e2;
              Qs[(16 * tq + i) * HG_LDQ + ch] = (bf16)f2bf(qs); Ks[(16 * tq + i) * HG_LDQ + ch] = (bf16)f2bf(ks);
              QH[(size_t)(16 * tq + i) * HD + ch] = (bf16)f2bf(qs * cS);
              const unsigned kb = f2bf(ks * cK); if (i & 1) kp[i >> 1] |= kb << 16; else kp[i >> 1] = kb; }
          LAS v4u* kd = (LAS v4u*)(Kt + ch * HG_LDT + 16 * tq); v4u a, c2; a.x = kp[0]; a.y = kp[1]; a.z = kp[2]; a.w = kp[3]; c2.x = kp[4]; c2.y = kp[5]; c2.z = kp[6]; c2.w = kp[7]; kd[0] = a; kd[1] = c2;
          if (tq == 0) DEC[ch] = cS * cK; }
        __syncthreads();
        if (wave < 4) { const int tb = wave >> 1, sb = wave & 1; f32x16 acc = {};
            if (sb <= tb) {
#pragma unroll
                for (int ks = 0; ks < 8; ++ks) { const s16x8 a = *(const LAS s16x8*)(Qs + (32 * tb + r32) * HG_LDQ + 16 * ks + 8 * hh); const s16x8 bb = *(const LAS s16x8*)(Ks + (32 * sb + r32) * HG_LDQ + 16 * ks + 8 * hh);
                    acc = __builtin_amdgcn_mfma_f32_32x32x16_bf16(a, bb, acc, 0, 0, 0); } }
            const int s = 32 * sb + r32;
#pragma unroll
            for (int r = 0; r < 16; ++r) { const int t = 32 * tb + (r & 3) + 8 * (r >> 2) + 4 * hh; At[t * HG_LDT + s] = (s <= t) ? (bf16)f2bf(acc[r]) : (bf16)0; } }
        { const int kb = wave >> 1;
#pragma unroll
          for (int vbi = 0; vbi < 2; ++vbi) { const int vb = 2 * (wave & 1) + vbi; f32x16 acc = {};
#pragma unroll
              for (int ks = 0; ks < 4; ++ks) { const s16x8 a = *(const LAS s16x8*)(Kt + (32 * kb + r32) * HG_LDT + 16 * ks + 8 * hh); const s16x8 bb = *(const LAS s16x8*)(Vt + (32 * vb + r32) * HG_LDT + 16 * ks + 8 * hh);
                  acc = __builtin_amdgcn_mfma_f32_32x32x16_bf16(a, bb, acc, 0, 0, 0); }
              bf16* dst = DSC + (size_t)(32 * vb + r32) * HD + 32 * kb + 4 * hh;
#pragma unroll
              for (int q = 0; q < 4; ++q) { v2u w; w.x = pk2(acc[4 * q], acc[4 * q + 1]); w.y = pk2(acc[4 * q + 2], acc[4 * q + 3]); *(v2u*)(dst + 8 * q) = w; } } }
        __syncthreads();
        { const int tb = wave >> 2, vb = wave & 3, t = 32 * tb + r32; f32x16 acc = {};
#pragma unroll
          for (int ks = 0; ks < 4; ++ks) if (ks < 2 * tb + 2) { const s16x8 a = *(const LAS s16x8*)(Vt + (32 * vb + r32) * HG_LDT + 16 * ks + 8 * hh); const s16x8 bb = *(const LAS s16x8*)(At + t * HG_LDT + 16 * ks + 8 * hh);
              acc = __builtin_amdgcn_mfma_f32_32x32x16_bf16(a, bb, acc, 0, 0, 0); }
          v4u w0, w1; w0.x = pk2(acc[0], acc[1]); w0.y = pk2(acc[2], acc[3]); w0.z = pk2(acc[4], acc[5]); w0.w = pk2(acc[6], acc[7]); w1.x = pk2(acc[8], acc[9]); w1.y = pk2(acc[10], acc[11]); w1.z = pk2(acc[12], acc[13]); w1.w = pk2(acc[14], acc[15]);
          v4u* d = (v4u*)(OI + (size_t)(wave * 64 + lane) * 16); d[0] = w0; d[1] = w1; }
        __syncthreads();
    }
}
__device__ __forceinline__ void hg_scan(Frame& F, bf16* DSO, int sb, int nsb) {
    bf16* DSC = (bf16*)(F.ws + WS_DSC); const float* DEC = (const float*)(F.ws + WS_DEC);
    LAS float* DL = (LAS float*)F.lds;
    for (int T0 = sb * 512; T0 < 32 * 4096; T0 += nsb * 512) {
        const int T = T0 + F.tid, bh = T0 >> 12, e = T & 4095, v = e >> 5, k4 = (e & 31) * 4;
        v2u x[32];
#pragma unroll
        for (int c = 0; c < 32; ++c) x[c] = *(const v2u*)(DSC + ((size_t)(bh * 32 + c) * HD + v) * HD + k4);
#pragma unroll
        for (int i = 0; i < 2; ++i) { const int p = F.tid + 512 * i; *(LAS f32x4*)(DL + p * 4) = *(const f32x4*)(DEC + (size_t)bh * 32 * HD + p * 4); }
        __syncthreads();
        f32x4 S = {0.f, 0.f, 0.f, 0.f};
#pragma unroll
        for (int c = 0; c < 32; ++c) { const f32x4 d = *(const LAS f32x4*)(DL + c * HD + k4);
            v2u o; o.x = pk2(S.x, S.y); o.y = pk2(S.z, S.w); *(v2u*)(DSO + ((size_t)(bh * 32 + c) * HD + v) * HD + k4) = o;
            S.x = d.x * S.x + bflo(x[c].x); S.y = d.y * S.y + bfhi(x[c].x); S.z = d.z * S.z + bflo(x[c].y); S.w = d.w * S.w + bfhi(x[c].y); }
        float* o = F.out + O_PHG + (size_t)bh * HD * HD + (size_t)k4 * HD + v;
        o[0] = S.x; o[HD] = S.y; o[2 * HD] = S.z; o[3 * HD] = S.w;
        __syncthreads();
    }
}
constexpr int LC_SC = 0, LC_QH = 34816, LC_SS = 52224, LC_SLOT = 53248;
__device__ __forceinline__ void hgC_loop(Frame& F, unsigned* ctr) {
    const int tid = F.tid, lane = F.lane, wave = F.wave;
    LAS bf16* SC = (LAS bf16*)(F.lds + LC_SC); LAS bf16* Qh = (LAS bf16*)(F.lds + LC_QH); LAS float* SS = (LAS float*)(F.lds + LC_SS);
    volatile LAS int* slot = (volatile LAS int*)(F.lds + LC_SLOT);
    const bf16* PB = (const bf16*)(F.ws + WS_PB); bf16* MIX = (bf16*)(F.ws + WS_MIX);
    const int r32 = lane & 31, hh = lane >> 5, tb = wave >> 2, vb = wave & 3, t = 32 * tb + r32;
    if (tid == 0) { slot[0] = (int)__hip_atomic_fetch_add(ctr, 1u, __ATOMIC_RELAXED, __HIP_MEMORY_SCOPE_AGENT); slot[1] = (int)__hip_atomic_fetch_add(ctr, 1u, __ATOMIC_RELAXED, __HIP_MEMORY_SCOPE_AGENT); }
    __syncthreads();
    int item = slot[0], nxt = slot[1], par = 0;
    if (item >= 1024) return;
    v4u sc[4], qh[2], oi[2]; v2u og[4];
#define HGC_FETCH(IT) do { const int it_ = (IT); const bf16* DSC = (const bf16*)(F.ws + WS_DSC) + (size_t)it_ * HD * HD; const bf16* QH = (const bf16*)(F.out + O_Y + OQ_QH) + (size_t)it_ * 64 * HD; \
        const bf16* OI = (const bf16*)(F.out + O_Y + OQ_OI) + (size_t)it_ * 8192; const int bh_ = it_ >> 5, tok0_ = (bh_ >> 2) * PB_T + (it_ & 31) * 64, h_ = bh_ & 3; \
        _Pragma("unroll") for (int i = 0; i < 4; ++i) { const int p = tid + 512 * i; sc[i] = *(const v4u*)(DSC + (size_t)(p >> 4) * HD + (p & 15) * 8); } \
        _Pragma("unroll") for (int i = 0; i < 2; ++i) { const int p = tid + 512 * i; qh[i] = *(const v4u*)(QH + (size_t)(p >> 4) * HD + (p & 15) * 8); } \
        oi[0] = *(const v4u*)(OI + (size_t)(wave * 64 + lane) * 16); oi[1] = *(const v4u*)(OI + (size_t)(wave * 64 + lane) * 16 + 8); \
        _Pragma("unroll") for (int q = 0; q < 4; ++q) og[q] = *(const v2u*)(PB + (size_t)(tok0_ + t) * PBW + 1536 + h_ * HD + 32 * vb + 8 * q + 4 * hh); } while (0)
    HGC_FETCH(item);
    for (;;) {
        const int bh = item >> 5, chunk = item & 31, b = bh >> 2, h = bh & 3, tok0 = b * PB_T + chunk * 64;
#pragma unroll
        for (int i = 0; i < 4; ++i) { const int p = tid + 512 * i; *(LAS v4u*)(SC + (p >> 4) * HG_LDQ + (p & 15) * 8) = sc[i]; }
#pragma unroll
        for (int i = 0; i < 2; ++i) { const int p = tid + 512 * i; *(LAS v4u*)(Qh + (p >> 4) * HG_LDQ + (p & 15) * 8) = qh[i]; }
        f32x16 acc;
        acc[0] = bflo(oi[0].x); acc[1] = bfhi(oi[0].x); acc[2] = bflo(oi[0].y); acc[3] = bfhi(oi[0].y); acc[4] = bflo(oi[0].z); acc[5] = bfhi(oi[0].z); acc[6] = bflo(oi[0].w); acc[7] = bfhi(oi[0].w);
        acc[8] = bflo(oi[1].x); acc[9] = bfhi(oi[1].x); acc[10] = bflo(oi[1].y); acc[11] = bfhi(oi[1].y); acc[12] = bflo(oi[1].z); acc[13] = bfhi(oi[1].z); acc[14] = bflo(oi[1].w); acc[15] = bfhi(oi[1].w);
        v2u ogc[4];
#pragma unroll
        for (int q = 0; q < 4; ++q) ogc[q] = og[q];
        if (tid == 0) slot[par] = (int)__hip_atomic_fetch_add(ctr, 1u, __ATOMIC_RELAXED, __HIP_MEMORY_SCOPE_AGENT);
        if (nxt < 1024) HGC_FETCH(nxt);
        __syncthreads();
        const int nn = slot[par];
#pragma unroll
        for (int ks = 0; ks < 8; ++ks) { const s16x8 a = *(const LAS s16x8*)(SC + (32 * vb + r32) * HG_LDQ + 16 * ks + 8 * hh); const s16x8 bb = *(const LAS s16x8*)(Qh + t * HG_LDQ + 16 * ks + 8 * hh);
            acc = __builtin_amdgcn_mfma_f32_32x32x16_bf16(a, bb, acc, 0, 0, 0); }
        { float ss = 0.f;
#pragma unroll
          for (int r = 0; r < 16; ++r) ss += acc[r] * acc[r];
          ss += __shfl_xor(ss, 32);
          if (hh == 0) SS[t * 4 + vb] = ss; }
        __syncthreads();
        { const f32x4 s4 = *(const LAS f32x4*)(SS + t * 4); const float rstd = __builtin_amdgcn_rsqf(((s4.x + s4.y) + (s4.z + s4.w)) * (1.0f / HD) + EPS);
#pragma unroll
          for (int q = 0; q < 4; ++q) { const int v0 = 32 * vb + 8 * q + 4 * hh; const f32x4 gn = *(const GAS f32x4*)(F.in[17] + v0);
              v2u w; w.x = pk2(acc[4 * q] * rstd * gn.x * siluf_(bflo(ogc[q].x)), acc[4 * q + 1] * rstd * gn.y * siluf_(bfhi(ogc[q].x)));
              w.y = pk2(acc[4 * q + 2] * rstd * gn.z * siluf_(bflo(ogc[q].y)), acc[4 * q + 3] * rstd * gn.w * siluf_(bfhi(ogc[q].y)));
              *(v2u*)(MIX + (size_t)(tok0 + t) * DM + 512 + h * HD + v0) = w; } }
        __syncthreads();
        if (nxt >= 1024) break;
        item = nxt; nxt = nn; par ^= 1;
    }
#undef HGC_FETCH
}
constexpr int LX_Q = 0, LX_K2 = 4096, LX_QT = 8192, LX_K3T = 12288, LX_V = 16384, LX_DEC = 20480, LX_ATT = 20992, LX_OT = 21248, LX_OP = 25344;
__device__ __forceinline__ void hgrn_sample_loop(Frame& F) {
    const int tid = F.tid;
    LAS float* Qs = (LAS float*)(F.lds + LX_Q); LAS float* K2 = (LAS float*)(F.lds + LX_K2); LAS float* QT = (LAS float*)(F.lds + LX_QT); LAS float* K3T = (LAS float*)(F.lds + LX_K3T); LAS float* Vs = (LAS float*)(F.lds + LX_V);
    LAS float* DEC = (LAS float*)(F.lds + LX_DEC); LAS float* ATT = (LAS float*)(F.lds + LX_ATT); LAS float* OP = (LAS float*)(F.lds + LX_OP); LAS float* OT = (LAS float*)(F.lds + LX_OT);
    const bf16* PB = (const bf16*)(F.ws + WS_PB); const float* FZ = (const float*)(F.ws + WS_FZ); bf16* MIX = (bf16*)(F.ws + WS_MIX);
    const int v4 = (tid & 31) * 4, kg = tid >> 5;
    int idx = F.bid; if (idx >= SB_B * HH) return;
    f32x4 s0[8];
#pragma unroll
    for (int j = 0; j < 8; ++j) s0[j] = *(const GAS f32x4*)(F.in[4] + (size_t)idx * HD * HD + (size_t)(8 * kg + j) * HD + v4);
    for (; idx < SB_B * HH; idx += F.G) {
        const int b = idx >> 2, h = idx & 3, tok0 = MP + b * SB_T;
        float* Sout = F.out + O_SHG + (size_t)idx * HD * HD;
        if (tid < 128) { const int col = h * HD + tid; const float lb = 1.0f / (1.0f + __expf(F.in[5][512 + col] - F.in[5][col]));
            float gl[8], kk[8], qq[8]; float run = 0.f;
#pragma unroll
            for (int t = 0; t < 8; ++t) { const size_t tok = (size_t)(tok0 + t); const float fz = FZ[tok * 512 + col]; qq[t] = bf2f(PB[tok * PBW + 512 + col]);
                const float sg = __builtin_amdgcn_rcpf(1.0f + __builtin_amdgcn_exp2f(-1.4426950408889634f * fz)), f = lb + (1.0f - lb) * sg; kk[t] = 1.0f - f; run += __log2f(f); gl[t] = run; }
            float qt[8], k3[8];
#pragma unroll
            for (int t = 0; t < 8; ++t) { qt[t] = qq[t] * __builtin_amdgcn_exp2f(gl[t]); k3[t] = kk[t] * __builtin_amdgcn_exp2f(run - gl[t]); Qs[t * 128 + tid] = qt[t]; K2[t * 128 + tid] = kk[t] * __builtin_amdgcn_exp2f(-gl[t]); }
            *(LAS f32x4*)(QT + tid * 8) = (f32x4){qt[0], qt[1], qt[2], qt[3]}; *(LAS f32x4*)(QT + tid * 8 + 4) = (f32x4){qt[4], qt[5], qt[6], qt[7]};
            *(LAS f32x4*)(K3T + tid * 8) = (f32x4){k3[0], k3[1], k3[2], k3[3]}; *(LAS f32x4*)(K3T + tid * 8 + 4) = (f32x4){k3[4], k3[5], k3[6], k3[7]};
            DEC[tid] = __builtin_amdgcn_exp2f(run);
        } else if (tid < 256) { const int vv = tid - 128;
#pragma unroll
            for (int t = 0; t < 8; ++t) Vs[t * 128 + vv] = bf2f(PB[(size_t)(tok0 + t) * PBW + 1024 + h * HD + vv]);
        }
        __syncthreads();
        { const int p = tid >> 3, part = tid & 7, t = p >> 3, s = p & 7; float a = 0.f;
#pragma unroll
          for (int j = 0; j < 16; ++j) a += Qs[t * 128 + part + 8 * j] * K2[s * 128 + part + 8 * j];
          a += __shfl_xor(a, 1); a += __shfl_xor(a, 2); a += __shfl_xor(a, 4);
          if (part == 0) ATT[p] = (s <= t) ? a : 0.f; }
        f32x4 vr[8], o[8];
#pragma unroll
        for (int t = 0; t < 8; ++t) { vr[t] = *(const LAS f32x4*)(Vs + t * 128 + v4); o[t] = (f32x4){0.f, 0.f, 0.f, 0.f}; }
#pragma unroll
        for (int j = 0; j < 8; ++j) { const int k = 8 * kg + j; const f32x4 sv = s0[j]; const f32x4 qa = *(const LAS f32x4*)(QT + k * 8), qb = *(const LAS f32x4*)(QT + k * 8 + 4), ka = *(const LAS f32x4*)(K3T + k * 8), kb = *(const LAS f32x4*)(K3T + k * 8 + 4);
            f32x4 sn = sv * DEC[k];
            o[0] += sv * qa.x; o[1] += sv * qa.y; o[2] += sv * qa.z; o[3] += sv * qa.w; o[4] += sv * qb.x; o[5] += sv * qb.y; o[6] += sv * qb.z; o[7] += sv * qb.w;
            sn += vr[0] * ka.x; sn += vr[1] * ka.y; sn += vr[2] * ka.z; sn += vr[3] * ka.w; sn += vr[4] * kb.x; sn += vr[5] * kb.y; sn += vr[6] * kb.z; sn += vr[7] * kb.w;
            *(GAS f32x4*)(Sout + (size_t)k * HD + v4) = sn; }
        if (idx + F.G < SB_B * HH) {
#pragma unroll
            for (int j = 0; j < 8; ++j) s0[j] = *(const GAS f32x4*)(F.in[4] + (size_t)(idx + F.G) * HD * HD + (size_t)(8 * kg + j) * HD + v4); }
#pragma unroll
        for (int t = 0; t < 8; ++t) *(LAS f32x4*)(OP + (kg * 8 + t) * 128 + v4) = o[t];
        __syncthreads();
#pragma unroll
        for (int r = 0; r < 2; ++r) { const int e = tid + 512 * r, t = e >> 7, vv = e & 127; float acc = 0.f;
#pragma unroll
            for (int g2 = 0; g2 < 16; ++g2) acc += OP[(g2 * 8 + t) * 128 + vv];
#pragma unroll
            for (int s = 0; s < 8; ++s) acc += ATT[t * 8 + s] * Vs[s * 128 + vv];
            OT[t * 128 + vv] = acc; }
        __syncthreads();
        { const int t = F.wave, lane = F.lane; const float o0 = OT[t * 128 + 2 * lane], o1 = OT[t * 128 + 2 * lane + 1];
          const float rstd = __builtin_amdgcn_rsqf(wave_sum(o0 * o0 + o1 * o1) * (1.0f / HD) + EPS);
          const unsigned gw2 = *(const unsigned*)(PB + (size_t)(tok0 + t) * PBW + 1536 + h * HD + 2 * lane);
          const float g0 = F.in[17][2 * lane], g1 = F.in[17][2 * lane + 1];
          *(unsigned*)(MIX + (size_t)(tok0 + t) * DM + 512 + h * HD + 2 * lane) = pk2(o0 * rstd * g0 * siluf_(bflo(gw2)), o1 * rstd * g1 * siluf_(bfhi(gw2))); }
        __syncthreads();
    }
}
constexpr int SG_LD = 68;
template <int KSTEPS  >
__device__ __forceinline__ void small_gemm_tile(Frame& F, const bf16* A, int lda, const bf16* Bt, int K, int r0, int c0, float (&v)[8]) {
    const int lane = F.lane, wave = F.wave, fr = lane & 15, fq = lane >> 4, lr = lane >> 2, lp = lane & 3;
    f32x4v acc[4][4];
#pragma unroll
    for (int a = 0; a < 4; ++a)
#pragma unroll
        for (int b = 0; b < 4; ++b) acc[a][b] = (f32x4v){0.f, 0.f, 0.f, 0.f};
    constexpr int D = KSTEPS < 3 ? KSTEPS : 3;
    const bf16* ap = A + (size_t)(r0 + lr) * lda + wave * (KSTEPS * 32) + 8 * lp;
    const bf16* bp = Bt + (size_t)(c0 + lr) * K + wave * (KSTEPS * 32) + 8 * lp;
    LAS unsigned char* SWA = F.lds + wave * 10240; LAS unsigned char* SWB = SWA + 5120;
    v4u ra[D][4], rb[D][4];
#pragma unroll
    for (int s = 0; s < D - 1; ++s)
#pragma unroll
        for (int i = 0; i < 4; ++i) { ra[s][i] = *(const v4u*)(ap + (size_t)(16 * i) * lda + 32 * s); rb[s][i] = *(const v4u*)(bp + (size_t)(16 * i) * K + 32 * s); }
#pragma unroll
    for (int s = 0; s < KSTEPS; ++s) {
        if (s + D - 1 < KSTEPS) {
#pragma unroll
            for (int i = 0; i < 4; ++i) { ra[(s + D - 1) % D][i] = *(const v4u*)(ap + (size_t)(16 * i) * lda + 32 * (s + D - 1)); rb[(s + D - 1) % D][i] = *(const v4u*)(bp + (size_t)(16 * i) * K + 32 * (s + D - 1)); } }
#pragma unroll
        for (int i = 0; i < 4; ++i) { *(LAS v4u*)(SWA + (16 * i + lr) * 80 + lp * 16) = ra[s % D][i]; *(LAS v4u*)(SWB + (16 * i + lr) * 80 + lp * 16) = rb[s % D][i]; }
        s16x8 af[4], bf[4];
#pragma unroll
        for (int i = 0; i < 4; ++i) { af[i] = *(const LAS s16x8*)(SWA + (16 * i + fr) * 80 + fq * 16); bf[i] = *(const LAS s16x8*)(SWB + (16 * i + fr) * 80 + fq * 16); }
#pragma unroll
        for (int a = 0; a < 4; ++a)
#pragma unroll
            for (int bb = 0; bb < 4; ++bb) acc[a][bb] = __builtin_amdgcn_mfma_f32_16x16x32_bf16(bf[bb], af[a], acc[a][bb], 0, 0, 0);
    }
    __syncthreads();
    if (KSTEPS == 4) STAMP(26);
    LAS float* part = (LAS float*)F.lds + wave * (64 * SG_LD);
#pragma unroll
    for (int a = 0; a < 4; ++a)
#pragma unroll
        for (int b = 0; b < 4; ++b) *(LAS f32x4v*)(part + (16 * a + fr) * SG_LD + 16 * b + 4 * fq) = acc[a][b];
    __syncthreads();
    { const int row = F.tid >> 3, cg8 = (F.tid & 7) * 8; const LAS float* p = (const LAS float*)F.lds + row * SG_LD + cg8;
      f32x4v s0 = {0.f, 0.f, 0.f, 0.f}, s1 = {0.f, 0.f, 0.f, 0.f};
#pragma unroll
      for (int w = 0; w < 8; ++w) { s0 += *(const LAS f32x4v*)(p + w * (64 * SG_LD)); s1 += *(const LAS f32x4v*)(p + w * (64 * SG_LD) + 4); }
      v[0] = s0[0]; v[1] = s0[1]; v[2] = s0[2]; v[3] = s0[3]; v[4] = s1[0]; v[5] = s1[1]; v[6] = s1[2]; v[7] = s1[3]; }
    __syncthreads();
}

__device__ __forceinline__ void outproj_sample_tile(Frame& F, int tile, float* SS1) {
    const int rm = tile >> 4, cn = tile & 15; float v[8];
    STAMP(24);
    small_gemm_tile<4>(F, (const bf16*)(F.ws + WS_MIX), DM, (const bf16*)(F.ws + WS_WOUT), DM, MP + 64 * rm, 64 * cn, v);
    STAMP(25);
    const int row = MP + 64 * rm + (F.tid >> 3), col = 64 * cn + 8 * (F.tid & 7); const size_t off = (size_t)row * DM + col;
    const float* xs = F.in[1] + (size_t)(row - MP) * DM + col; bf16* XN = (bf16*)(F.ws + WS_XN);
    const f32x4v xa = *(const f32x4v*)xs, xb = *(const f32x4v*)(xs + 4);
    const f32x4v x0 = {xa[0] + v[0], xa[1] + v[1], xa[2] + v[2], xa[3] + v[3]}, x1 = {xb[0] + v[4], xb[1] + v[5], xb[2] + v[6], xb[3] + v[7]};
    v4u w; w.x = pk2(x0[0], x0[1]); w.y = pk2(x0[2], x0[3]); w.z = pk2(x1[0], x1[1]); w.w = pk2(x1[2], x1[3]);
    *(v4u*)(XN + off) = w;
    float ss = (x0[0] * x0[0] + x0[1] * x0[1]) + (x0[2] * x0[2] + x0[3] * x0[3]) + (x1[0] * x1[0] + x1[1] * x1[1]) + (x1[2] * x1[2] + x1[3] * x1[3]);
    ss += __shfl_xor(ss, 1); ss += __shfl_xor(ss, 2); ss += __shfl_xor(ss, 4);
    if ((F.tid & 7) == 0) __hip_atomic_fetch_add(SS1 + row, ss, __ATOMIC_RELAXED, __HIP_MEMORY_SCOPE_AGENT);
}
__device__ __forceinline__ void down_sample_tile(Frame& F, int tile, float* SS2, unsigned* cntb, float* YO) {
    const int rm = tile >> 4, cn = tile & 15; float v[8];
    small_gemm_tile<11>(F, (const bf16*)(F.ws + WS_ACT), DFF, (const bf16*)(F.ws + WS_WD), DFF, MP + 64 * rm, 64 * cn, v);
    const int row = MP + 64 * rm + (F.tid >> 3), col = 64 * cn + 8 * (F.tid & 7); const size_t off = (size_t)row * DM + col;
    unsigned* cnt = cntb + 64 * rm; const v4u xw = *(const v4u*)((const bf16*)(F.ws + WS_XN) + off);
    const f32x4v xa = {bflo(xw.x), bfhi(xw.x), bflo(xw.y), bfhi(xw.y)}, xb = {bflo(xw.z), bfhi(xw.z), bflo(xw.w), bfhi(xw.w)}, ga = *(const f32x4v*)(F.in[23] + col), gb = *(const f32x4v*)(F.in[23] + col + 4);
    const f32x4v x0 = {xa[0] + v[0], xa[1] + v[1], xa[2] + v[2], xa[3] + v[3]}, x1 = {xb[0] + v[4], xb[1] + v[5], xb[2] + v[6], xb[3] + v[7]};
    float ss = (x0[0] * x0[0] + x0[1] * x0[1]) + (x0[2] * x0[2] + x0[3] * x0[3]) + (x1[0] * x1[0] + x1[1] * x1[1]) + (x1[2] * x1[2] + x1[3] * x1[3]);
    ss += __shfl_xor(ss, 1); ss += __shfl_xor(ss, 2); ss += __shfl_xor(ss, 4);
    if ((F.tid & 7) == 0) __hip_atomic_fetch_add(SS2 + row, ss, __ATOMIC_RELAXED, __HIP_MEMORY_SCOPE_AGENT);
    asm volatile("s_waitcnt vmcnt(0)" ::: "memory");
    __syncthreads();
    if (F.tid == 0) { __hip_atomic_fetch_add(cnt, 1u, __ATOMIC_RELAXED, __HIP_MEMORY_SCOPE_AGENT); wait_count(cnt, 16u); }
    __syncthreads();
    float s = 0.f; if ((F.tid & 7) == 0) s = atomic_read_f32(SS2 + row);
    const float rs = rstd_of(__shfl(s, F.lane & ~7));
    *(f32x4v*)(YO + off) = (f32x4v){x0[0] * rs * ga[0], x0[1] * rs * ga[1], x0[2] * rs * ga[2], x0[3] * rs * ga[3]};
    *(f32x4v*)(YO + off + 4) = (f32x4v){x1[0] * rs * gb[0], x1[1] * rs * gb[1], x1[2] * rs * gb[2], x1[3] * rs * gb[3]};
}
typedef GAS unsigned gu32;
#define RLX_AGENT __ATOMIC_RELAXED, __HIP_MEMORY_SCOPE_AGENT
constexpr int MISC_OFF = LDS_BYTES - 512;
constexpr int CW_QUEUE = 8192;
constexpr int CW_BAR = 4096;
constexpr size_t CTL_ZERO_BYTES = 524288;
constexpr int CW_DUMMY = 65536;
#define XB_TMO      128
#define XB_XCNT(j)  (256  + 64 * (j))
#define XB_XSUB(j)  (1280 + 64 * (j))
#define XB_XGEN(j)  (2304 + 64 * (j))
#define XB_TOP      3328
#define XB_TOPGEN   3392
#define XCD_BAR_WORDS 3456
#define XB_SPIN_CAP (1u << 18)

__device__ __forceinline__ unsigned xb_ld(unsigned* p)              { return __hip_atomic_load(p, __ATOMIC_RELAXED, __HIP_MEMORY_SCOPE_AGENT); }
__device__ __forceinline__ unsigned xb_add(unsigned* p, unsigned v) { return __hip_atomic_fetch_add(p, v, __ATOMIC_RELAXED, __HIP_MEMORY_SCOPE_AGENT); }
__device__ __forceinline__ unsigned xb_xcc_id() { return (unsigned)__builtin_amdgcn_s_getreg((3 << 11) | 20) & 0xFu; }
#define XB_SPIN(cond, bar) do { unsigned _sp = 0; while (cond) { __builtin_amdgcn_s_sleep(1); \
    if ((++_sp & 255u) == 0u) { if (xb_ld(&(bar)[XB_TMO])) break; if (_sp > XB_SPIN_CAP) { atomicAdd(&(bar)[XB_TMO], 1u); break; } } } } while (0)

struct XcdBarrier {
    unsigned* bar; unsigned x;
    volatile LAS unsigned* st;
};

__device__ __forceinline__ XcdBarrier xcd_barrier_post(unsigned* bar, volatile LAS unsigned* st) {
    XcdBarrier b; b.bar = bar; b.x = xb_xcc_id(); b.st = st;
    if (threadIdx.x == 0) (void)xb_add(&bar[XB_XCNT(b.x)], 1u);
    return b;
}
__device__ __forceinline__ void xcd_barrier_complete(unsigned* bar, unsigned x, unsigned& nloc, unsigned& nx) {
    const unsigned G = gridDim.x * gridDim.y * gridDim.z;
    unsigned sum, cnt, mine, sp = 0u;
    for (;;) {
        sum = 0u; cnt = 0u; mine = 0u;
#pragma unroll
        for (unsigned j = 0; j < 16; ++j) { const unsigned c = xb_ld(&bar[XB_XCNT(j)]); sum += c; cnt += (c > 0u) ? 1u : 0u; mine = (j == x) ? c : mine; }
        if (sum == G) break;
        __builtin_amdgcn_s_sleep(1);
        if ((++sp & 255u) == 0u) { if (xb_ld(&bar[XB_TMO])) break; if (sp > XB_SPIN_CAP) { atomicAdd(&bar[XB_TMO], 1u); break; } }
    }
    nloc = mine > 0u ? mine : 1u; nx = cnt > 0u ? cnt : 1u;
}

__device__ __forceinline__ void xcd_barrier(const XcdBarrier& b) {
    asm volatile("s_waitcnt vmcnt(0)" ::: "memory");
    __syncthreads();
    if (threadIdx.x == 0) {
        unsigned* bar = b.bar;
        __builtin_amdgcn_s_waitcnt(0);
        unsigned nloc = b.st[0], nx = b.st[1];
        if (nloc == 0u) { xcd_barrier_complete(bar, b.x, nloc, nx); b.st[0] = nloc; b.st[1] = nx; }
        const unsigned old = xb_add(&bar[XB_XSUB(b.x)], 1u);
        const unsigned gen = old / nloc;
        if (old + 1u == (gen + 1u) * nloc) {
            __builtin_amdgcn_fence(__ATOMIC_RELEASE, "agent");
            asm volatile("s_waitcnt vmcnt(0)" ::: "memory");
            const unsigned og = xb_add(&bar[XB_TOP], 1u);
            const unsigned tg = og / nx;
            if (og + 1u == (tg + 1u) * nx) xb_add(&bar[XB_TOPGEN], 1u);
            else XB_SPIN(xb_ld(&bar[XB_TOPGEN]) == tg, bar);
            __builtin_amdgcn_fence(__ATOMIC_ACQUIRE, "agent");
            xb_add(&bar[XB_XGEN(b.x)], 1u);
            asm volatile("s_waitcnt vmcnt(0)" ::: "memory");
        } else {
            XB_SPIN(xb_ld(&bar[XB_XGEN(b.x)]) == gen, bar);
            __builtin_amdgcn_fence(__ATOMIC_ACQUIRE, "agent");
            asm volatile("s_waitcnt vmcnt(0)" ::: "memory");
        }
    }
    __syncthreads();
}

__global__ void __launch_bounds__(NWAVES * 64, 2) mk_fwd(Args args) {
    extern __shared__ __attribute__((aligned(16))) unsigned char lds[];
    Frame F;
    F.lds = (LAS unsigned char*)lds;
    F.tid = threadIdx.x; F.lane = F.tid & 63; F.wave = __builtin_amdgcn_readfirstlane(F.tid >> 6);
    F.G = gridDim.x; F.bid = blockIdx.x;
#pragma unroll
    for (int i = 0; i < 24; ++i) F.in[i] = args.in[i];
    F.out = args.out; F.ws = args.ws;
    const int lo = args.ph_lo, hi = args.ph_hi;
#define IN(k) (lo <= (k) && (k) < hi)
#if MK_N_LAUNCHES == 1
    volatile LAS unsigned* MISC = (volatile LAS unsigned*)(F.lds + MISC_OFF);
    if (F.tid < 32) MISC[F.tid] = 0u;
    __syncthreads();
    XcdBarrier bar = xcd_barrier_post((unsigned*)(F.ws + WS_CTL) + CW_BAR, MISC + 8);
#if defined(PROBE_PH)
    if (F.bid == 0 && F.tid == 0) { const unsigned long long t_ = __builtin_amdgcn_s_memrealtime(); MISC[32] = (unsigned)t_; MISC[33] = (unsigned)(t_ >> 32); }
#endif
#if defined(CLK_PH)
#define SEAM(k) do { if (IN(k) && IN((k) + 1)) { xcd_barrier(bar); if (F.bid == 0 && F.tid == 0) { const unsigned long long t_ = __builtin_amdgcn_s_memtime(); MISC[32 + 2 * ((k) + 1)] = (unsigned)t_; MISC[33 + 2 * ((k) + 1)] = (unsigned)(t_ >> 32); } } } while (0)
#elif defined(PROBE_PH)
#define SEAM(k) do { if (IN(k) && IN((k) + 1)) { xcd_barrier(bar); if (F.bid == 0 && F.tid == 0) { const unsigned long long t_ = __builtin_amdgcn_s_memrealtime(); MISC[32 + 2 * ((k) + 1)] = (unsigned)t_; MISC[33 + 2 * ((k) + 1)] = (unsigned)(t_ >> 32); } } } while (0)
#elif REP_BAR == 2
#define SEAM(k) do { if (IN(k) && IN((k) + 1)) { xcd_barrier(bar); xcd_barrier(bar); } } while (0)
#else
#define SEAM(k) do { if (IN(k) && IN((k) + 1)) xcd_barrier(bar); } while (0)
#endif
#else
#define SEAM(k) do { } while (0)
#endif
    const int gw = F.bid * NWAVES + F.wave, NGW = F.G * NWAVES;
    bf16* XN = (bf16*)(F.ws + WS_XN); bf16* PB = (bf16*)(F.ws + WS_PB); float* FZ = (float*)(F.ws + WS_FZ); bf16* GY = (bf16*)(F.ws + WS_GY);
    bf16* MIX = (bf16*)(F.ws + WS_MIX); bf16* ACT = (bf16*)(F.ws + WS_ACT);

    if (IN(0)) { p0_prologue(F);
#if REP_P0 == 2
        __syncthreads(); p0_prologue(F);
#endif
    } SEAM(0);
    if (IN(1)) {
        pg8::Gemm g{XN, (const bf16*)(F.ws + WS_WIN), MTOK, INC, DM}; pg8::StaticOrder S; S.init(MTOK, INC, F.G, F.bid);
        EpiIn E{PB, FZ, (bf16*)(F.ws + WS_U5)};
        pg8::gemm_phase<EpiIn, pg8::StaticOrder, true, true>(F.lds, g, S, E);
        { const int nunits = (MTOK / 256) * (INC / 256), rem = nunits % F.G;
          if (rem == 0) deferred_transposes<0>(F, gw, NGW); else if (F.bid >= rem) deferred_transposes<0>(F, (F.bid - rem) * NWAVES + F.wave, (F.G - rem) * NWAVES); }
#if REP_P1 == 2
        __syncthreads();
        pg8::gemm_phase<EpiIn, pg8::StaticOrder, true, true>(F.lds, g, S, E);
#endif
    } SEAM(1);
    if (IN(2)) {
        const int nper = (1024 + F.G - 1) / F.G, rot = F.bid % 3;
        if (rot == 0) {
            STAMP(4);
            for (int it = F.bid; it < 256; it += F.G) s5_item(F, it);
            STAMP(5);
            hgA_loop(F, 0, nper);
            STAMP(6);
            hgrn_sample_loop(F);
            STAMP(7);
        } else if (rot == 1) {
            hgrn_sample_loop(F);
            hgA_loop(F, 0, nper);
            __syncthreads();
            for (int it = F.bid; it < 256; it += F.G) s5_item(F, it);
        } else {
            hgA_loop(F, 0, nper / 2);
            __syncthreads();
            for (int it = F.bid; it < 256; it += F.G) s5_item(F, it);
            hgA_loop(F, nper / 2, nper);
            hgrn_sample_loop(F);
        }
    } SEAM(2);
    if (IN(3)) { hg_scan(F, (bf16*)(F.ws + WS_DSC), F.bid, F.G); } SEAM(3);
    if (IN(4)) {
        pg8::Gemm g{GY, (const bf16*)(F.ws + WS_WGLU), MTOK, S5W, S5W}; pg8::StaticOrder S; S.init(MTOK, S5W, F.G, F.bid);
        EpiGlu E{GY, MIX};
        STAMP(13);
        pg8::gemm_phase<EpiGlu, pg8::StaticOrder, true, true, true>(F.lds, g, S, E);
        __syncthreads();
        STAMP(14);
        hgC_loop(F, (unsigned*)(F.ws + WS_CTL) + CW_QUEUE);
        STAMP(15);
    } SEAM(4);
    if (IN(5)) {
        pg8::Gemm g{MIX, (const bf16*)(F.ws + WS_WOUT), MP, DM, DM}; pg8::StaticOrder S; S.init(MP, DM, F.G, F.bid);
#if REP_P5 >= 2
        { EpiOut E2{F.in[0], XN, (float*)(F.ws + WS_CTL) + CW_DUMMY};
#if REP_P5 == 2 || REP_P5 == 3
          pg8::gemm_phase<EpiOut, pg8::StaticOrder, true, true>(F.lds, g, S, E2);
          __syncthreads();
#endif
#if REP_P5 == 2 || REP_P5 == 4
          for (int it = F.bid; it < 256; it += F.G) outproj_sample_tile(F, it, (float*)(F.ws + WS_CTL) + CW_DUMMY);
          __syncthreads();
#endif
        }
#endif
        EpiOut E{F.in[0], XN, (float*)(F.ws + WS_CTL) + CW_SS1};
        const bool first = (F.G == 256) && ((F.bid & 1) == 0);
        STAMP(16);
        if (first) { outproj_sample_tile(F, F.bid, (float*)(F.ws + WS_CTL) + CW_SS1); __syncthreads(); }
        STAMP(17);
        pg8::gemm_phase<EpiOut, pg8::StaticOrder, ONEUNIT_ALIGN, true>(F.lds, g, S, E);
        __syncthreads();
        STAMP(18);
        if (!first) for (int it = F.bid; it < 256; it += F.G) outproj_sample_tile(F, it, (float*)(F.ws + WS_CTL) + CW_SS1);
        STAMP(23);
    } SEAM(5);
    if (IN(6)) {
        pg8::Gemm g{XN, (const bf16*)(F.ws + WS_WGU), MTOK, 2 * DFF, DM}; pg8::StaticOrder S; S.init(MTOK, 2 * DFF, F.G, F.bid);
        EpiAct E{ACT, (const float*)(F.ws + WS_CTL) + CW_SS1, F.lds + EPI_SCR};
        pg8::gemm_phase<EpiAct, pg8::StaticOrder, P6_ALIGN, P6_SP2>(F.lds, g, S, E);
        { const int nunits = (MTOK / 256) * (2 * DFF / 256), rem = nunits % F.G;
          if (rem == 0) deferred_transposes<1>(F, gw, NGW); else if (F.bid >= rem) deferred_transposes<1>(F, (F.bid - rem) * NWAVES + F.wave, (F.G - rem) * NWAVES); }
#if REP_P6 == 2
        __syncthreads();
        pg8::gemm_phase<EpiAct, pg8::StaticOrder, true, true>(F.lds, g, S, E);
#endif
    } SEAM(6);
    if (IN(7)) {
        pg8::Gemm g{ACT, (const bf16*)(F.ws + WS_WD), MP, DM, DFF}; pg8::StaticOrder S; S.init(MP, DM, F.G, F.bid);
#if REP_P7 == 2
        { float* YD = (float*)(F.ws + WS_GY) - 0;
          EpiDown E2{XN, F.in[23], (float*)(F.ws + WS_CTL) + CW_DUMMY, (unsigned*)(F.ws + WS_CTL) + CW_DUMMY + 20480, YD};
          pg8::gemm_phase<EpiDown, pg8::StaticOrder, true, true>(F.lds, g, S, E2);
          __syncthreads();
          for (int it = F.bid; it < 256; it += F.G) down_sample_tile(F, it, (float*)(F.ws + WS_CTL) + CW_DUMMY, (unsigned*)(F.ws + WS_CTL) + CW_DUMMY + 20480 + 4096, YD);
          __syncthreads(); }
#endif
        EpiDown E{XN, F.in[23], (float*)(F.ws + WS_CTL) + CW_SS2, (unsigned*)(F.ws + WS_CTL) + CW_CNT, F.out + O_Y};
        Unit u0; const bool has_u = S.next(0, u0); const int grp = has_u ? (u0.pm & 1) : 0;
        const int xl = F.bid & 7, jl = ((u0.pm >> 1) & 3) * 4 + u0.pn;
        const int stile = (F.G == 256 && has_u) ? ((4 * (2 * grp + (xl >> 2)) + (jl >> 2)) << 4) | (4 * (xl & 3) + (jl & 3)) : F.bid;
        STAMP(19);
        if (F.G == 256 && grp == 0) { down_sample_tile(F, stile, (float*)(F.ws + WS_CTL) + CW_SS2, (unsigned*)(F.ws + WS_CTL) + CW_CNTS, F.out + O_Y); __syncthreads(); }
        STAMP(20);
        pg8::gemm_phase<EpiDown, pg8::StaticOrder, ONEUNIT_ALIGN, true>(F.lds, g, S, E);
        __syncthreads();
        STAMP(21);
        if (F.G != 256) { for (int it = F.bid; it < 256; it += F.G) down_sample_tile(F, it, (float*)(F.ws + WS_CTL) + CW_SS2, (unsigned*)(F.ws + WS_CTL) + CW_CNTS, F.out + O_Y); }
        else if (grp == 1) down_sample_tile(F, stile, (float*)(F.ws + WS_CTL) + CW_SS2, (unsigned*)(F.ws + WS_CTL) + CW_CNTS, F.out + O_Y);
        STAMP(22);
    }
#if defined(AMP_A)
    if (F.bid == AMP_BLK && F.tid == 0) { volatile LAS unsigned* M_ = (volatile LAS unsigned*)(F.lds + LDS_BYTES - 512);
        const unsigned long long a = ((unsigned long long)M_[65 + 2 * AMP_A] << 32) | M_[64 + 2 * AMP_A], bq = ((unsigned long long)M_[65 + 2 * AMP_B] << 32) | M_[64 + 2 * AMP_B];
        const unsigned long long wait = 4ull * (bq - a), tn = __builtin_amdgcn_s_memrealtime();
        while (__builtin_amdgcn_s_memrealtime() - tn < wait) __builtin_amdgcn_s_sleep(8); }
#endif
#if defined(CLK_PH)
    if (F.bid == 0 && F.tid == 0) {
        const unsigned long long c0 = ((unsigned long long)MISC[33 + 2 * CLK_PH] << 32) | MISC[32 + 2 * CLK_PH], c1 = ((unsigned long long)MISC[35 + 2 * CLK_PH] << 32) | MISC[34 + 2 * CLK_PH];
        const unsigned long long wait = (c1 - c0) / 5ull, tn = __builtin_amdgcn_s_memrealtime();
        while (__builtin_amdgcn_s_memrealtime() - tn < wait) __builtin_amdgcn_s_sleep(8);
    }
#endif
#if defined(PROBE_PH)
    if (F.bid == 0 && F.tid == 0) {
        const unsigned long long tn = __builtin_amdgcn_s_memrealtime();
        const unsigned long long t0 = ((unsigned long long)MISC[33 + 2 * PROBE_PH] << 32) | MISC[32 + 2 * PROBE_PH];
        const unsigned long long t1 = (PROBE_PH == NPH - 1) ? tn : (((unsigned long long)MISC[35 + 2 * PROBE_PH] << 32) | MISC[34 + 2 * PROBE_PH]);
        const unsigned long long wait = 4ull * (t1 - t0);
        while (__builtin_amdgcn_s_memrealtime() - tn < wait) __builtin_amdgcn_s_sleep(8);
    }
#endif
#undef IN
#undef SEAM
}

extern "C" void kernel_launch(void* const* d_in, const int* in_sizes, int n_in, void* d_out, int out_size, void* d_ws, size_t ws_size, hipStream_t stream) {
    static int grid = 0;
    if (grid == 0) {
        if (n_in != 24 || ws_size < WS_END) { fprintf(stderr, "kernel_launch: unexpected n_in %d / ws %zu\n", n_in, ws_size); grid = -1; return; }
        int dev = 0, cus = 0, per_cu = 0;
        if (hipGetDevice(&dev) != hipSuccess || hipDeviceGetAttribute(&cus, hipDeviceAttributeMultiprocessorCount, dev) != hipSuccess) { grid = -1; return; }
        if (hipFuncSetAttribute((const void*)mk_fwd, hipFuncAttributeMaxDynamicSharedMemorySize, LDS_BYTES) != hipSuccess) { fprintf(stderr, "kernel_launch: hipFuncSetAttribute failed\n"); grid = -1; return; }
        if (hipOccupancyMaxActiveBlocksPerMultiprocessor(&per_cu, (const void*)mk_fwd, NWAVES * 64, LDS_BYTES) != hipSuccess || per_cu < 1) { fprintf(stderr, "kernel_launch: occupancy query says %d\n", per_cu); per_cu = 1; }
        (void)hipGetLastError();
        grid = cus;
    }
    if (grid < 0) return;
#if REP_MEMSET == 2
    (void)hipMemsetAsync((char*)d_ws + WS_CTL + 1048576 + 524288, 0, CTL_ZERO_BYTES, stream);
#endif
    if (hipMemsetAsync((char*)d_ws + WS_CTL, 0, CTL_ZERO_BYTES, stream) != hipSuccess) { fprintf(stderr, "kernel_launch: memset failed\n"); return; }
    Args a{};
    for (int i = 0; i < 24; ++i) a.in[i] = (const float*)d_in[i];
    a.out = (float*)d_out; a.ws = (unsigned char*)d_ws;
#if MK_N_LAUNCHES == 1
    a.ph_lo = 0; a.ph_hi = NPH;
    void* kargs[] = {&a};
    hipError_t e = hipLaunchCooperativeKernel((const void*)mk_fwd, dim3(grid), dim3(NWAVES * 64), kargs, LDS_BYTES, stream);
    if (e != hipSuccess) fprintf(stderr, "kernel_launch: cooperative launch failed: %s (grid %d)\n", hipGetErrorString(e), grid);
#else
    for (int p = 0; p < NPH; ++p) { a.ph_lo = p; a.ph_hi = p + 1; hipLaunchKernelGGL(mk_fwd, dim3(grid), dim3(NWAVES * 64), LDS_BYTES, stream, a); }
#endif
}
```
